# Optimizing an MI355X kernel written in HIP

```python
import jax, jax.numpy as jnp
from jax import lax
import numpy as np

D_MODEL = 1024
BATCH = 4
SEQ = 4096
DEPTH = 2

CHUNK = 64
D_MIX = D_MODEL
NH_M = 4
DH_M = 128
D_M = NH_M * DH_M
D_R = D_MIX - D_M
NB_R = 8
DB_R = D_R // NB_R
CONV_W = 4
LRU_C = 8.0
D_FF = 2816
N_EXPERTS = 8
TOP_K = 2
D_FF_E = 2816
MOE_BLOCK = 128
D_PLE = 256
EPS = 1e-6
N_DENSE = (DEPTH + 1) // 2
N_MOE = DEPTH // 2
Q_END = D_M
K_END = 2 * D_M
V_END = 3 * D_M
O_END = 4 * D_M
I_END = O_END + NH_M
F_END = I_END + NH_M
XR_END = F_END + D_R
D_IN = XR_END + D_R

kernel_name = "hymba_mlstm_rglru_moe_ple"


def group_rmsnorm(x, g, n_groups):
    xf = x.astype(jnp.float32)
    xg = xf.reshape(*x.shape[:-1], n_groups, x.shape[-1] // n_groups)
    xg = xg * lax.rsqrt(jnp.mean(xg * xg, axis=-1, keepdims=True) + EPS)
    return (xg.reshape(x.shape) * g.astype(jnp.float32)).astype(x.dtype)


def rmsnorm(x, g):
    return group_rmsnorm(x, g, 1)


def causal_conv(x, w, b):
    S = x.shape[1]
    xp = jnp.pad(x, ((0, 0), (CONV_W - 1, 0), (0, 0)))
    return sum(xp[:, j:j + S] * w[j] for j in range(CONV_W)) + b


def mlstm_chunkwise(q, k, v, i_pre, f_pre):
    B, S, H, Dh = q.shape
    L = CHUNK
    NC = S // L
    f32 = jnp.float32

    def blk(t):
        t = t.astype(f32).reshape(B, NC, L, *t.shape[2:])
        return jnp.moveaxis(t, 2, 3)

    qc = blk(q) * (Dh ** -0.5)
    kc, vc = blk(k), blk(v)
    ig = blk(i_pre)
    b = jnp.cumsum(blk(jax.nn.log_sigmoid(f_pre.astype(f32))), axis=-1)
    b_last = b[..., -1]
    a = b_last[..., None] - b + ig

    def step(carry, xs):
        C, n, m = carry
        bl, a_c, k_c, v_c = xs
        m_new = jnp.maximum(bl + m, a_c.max(-1))
        decay = jnp.exp(bl + m - m_new)
        wk = jnp.exp(a_c - m_new[..., None])
        C_new = decay[..., None, None] * C + jnp.einsum('bhl,bhld,bhle->bhde', wk, k_c, v_c)
        n_new = decay[..., None] * n + jnp.einsum('bhl,bhld->bhd', wk, k_c)
        return (C_new, n_new, m_new), (C, n, m)

    init = (jnp.zeros((B, H, Dh, Dh), f32), jnp.zeros((B, H, Dh), f32), jnp.zeros((B, H), f32))
    xs = (jnp.moveaxis(b_last, 1, 0), jnp.moveaxis(a, 1, 0),
          jnp.moveaxis(kc, 1, 0), jnp.moveaxis(vc, 1, 0))
    _, (C_prev, n_prev, m_prev) = lax.scan(step, init, xs)
    C_prev = jnp.moveaxis(C_prev, 0, 1)
    n_prev = jnp.moveaxis(n_prev, 0, 1)
    m_prev = jnp.moveaxis(m_prev, 0, 1)

    causal = jnp.tril(jnp.ones((L, L), dtype=bool))
    logD = jnp.where(causal, b[..., :, None] - b[..., None, :] + ig[..., None, :], -jnp.inf)
    m_inter = b + m_prev[..., None]
    m_row = jnp.maximum(m_inter, logD.max(-1))
    s = jnp.einsum('bchld,bchmd->bchlm', qc, kc) * jnp.exp(logD - m_row[..., None])
    inter = jnp.exp(m_inter - m_row)
    num = (jnp.einsum('bchlm,bchme->bchle', s, vc)
           + inter[..., None] * jnp.einsum('bchld,bchde->bchle', qc, C_prev))
    den = s.sum(-1) + inter * jnp.einsum('bchld,bchd->bchl', qc, n_prev)
    h = num / jnp.maximum(jnp.abs(den), jnp.exp(-m_row))[..., None]
    h = jnp.moveaxis(h, 3, 2).reshape(B, S, H, Dh)
    return h.astype(q.dtype)


def rglru(x, w_a, b_a, w_x, b_x, lam):
    B, S, _ = x.shape
    xf = x.astype(jnp.float32)
    xb = xf.reshape(B, S, NB_R, DB_R)
    r = jax.nn.sigmoid(jnp.einsum('bsnd,nde->bsne', xb, w_a.astype(jnp.float32)).reshape(B, S, D_R) + b_a)
    i = jax.nn.sigmoid(jnp.einsum('bsnd,nde->bsne', xb, w_x.astype(jnp.float32)).reshape(B, S, D_R) + b_x)
    log_a = -LRU_C * r * jax.nn.softplus(-lam.astype(jnp.float32))
    a = jnp.exp(log_a)
    u = jnp.sqrt(-jnp.expm1(2.0 * log_a)) * (i * xf)

    def combine(left, right):
        a_l, u_l = left
        a_r, u_r = right
        return a_l * a_r, a_r * u_l + u_r

    _, h = lax.associative_scan(combine, (a, u), axis=1)
    return h.astype(x.dtype)


def hybrid_mixer(hn, w_in, b_in, w_conv_qk, b_conv_qk, g_mh, w_conv_r, b_conv_r,
                 w_ra, b_ra, w_ri, b_ri, lam, g_r, w_out):
    B, S, _ = hn.shape
    z = hn @ w_in + b_in
    qk = jax.nn.silu(causal_conv(z[..., :K_END], w_conv_qk, b_conv_qk))
    q = qk[..., :D_M].reshape(B, S, NH_M, DH_M)
    k = qk[..., D_M:].reshape(B, S, NH_M, DH_M)
    v = z[..., K_END:V_END].reshape(B, S, NH_M, DH_M)
    o = jax.nn.sigmoid(z[..., V_END:O_END])
    hm = mlstm_chunkwise(q, k, v, z[..., O_END:I_END], z[..., I_END:F_END]).reshape(B, S, D_M) * o
    hm = group_rmsnorm(hm, g_mh, NH_M)
    xr = causal_conv(z[..., F_END:XR_END], w_conv_r, b_conv_r)
    hr = rglru(xr, w_ra, b_ra, w_ri, b_ri, lam) * jax.nn.gelu(z[..., XR_END:], approximate=True)
    hr = group_rmsnorm(hr, g_r, NB_R)
    return jnp.concatenate([hm, hr], axis=-1) @ w_out


def swiglu(x, w_gate, w_up, w_down):
    return (jax.nn.silu(x @ w_gate) * (x @ w_up)) @ w_down


def moe_swiglu(x, w_router, w_gate, w_up, w_down):
    B, S, D = x.shape
    N = B * S
    A = N * TOP_K
    xt = x.reshape(N, D)
    logits = xt.astype(jnp.float32) @ w_router.astype(jnp.float32)
    top_val, top_idx = lax.top_k(logits, TOP_K)
    gates = jax.nn.softmax(top_val, axis=-1)
    e_flat = top_idx.reshape(A)
    tok_flat = jnp.repeat(jnp.arange(N, dtype=jnp.int32), TOP_K)
    g_flat = gates.reshape(A)
    order = jnp.argsort(e_flat)
    e_sorted, tok_sorted, g_sorted = e_flat[order], tok_flat[order], g_flat[order]
    counts = jnp.bincount(e_flat, length=N_EXPERTS)
    padded = (counts + MOE_BLOCK - 1) // MOE_BLOCK * MOE_BLOCK
    p_end = jnp.cumsum(padded)
    p_start = p_end - padded
    u_start = jnp.cumsum(counts) - counts
    dest = p_start[e_sorted] + jnp.arange(A, dtype=jnp.int32) - u_start[e_sorted]
    P = A + N_EXPERTS * MOE_BLOCK
    n_blocks = P // MOE_BLOCK
    row_tok = jnp.full((P,), N, dtype=jnp.int32).at[dest].set(tok_sorted)
    row_gate = jnp.zeros((P,), jnp.float32).at[dest].set(g_sorted)
    block_expert = jnp.minimum(
        jnp.searchsorted(p_end, jnp.arange(n_blocks, dtype=jnp.int32) * MOE_BLOCK, side='right'),
        N_EXPERTS - 1)
    xpad = jnp.concatenate([xt, jnp.zeros((1, D), xt.dtype)], axis=0)

    def expert_block(args):
        toks, e = args
        xb = xpad[toks]
        return (jax.nn.silu(xb @ w_gate[e]) * (xb @ w_up[e])) @ w_down[e]

    y_rows = lax.map(expert_block, (row_tok.reshape(n_blocks, MOE_BLOCK), block_expert)).reshape(P, D)
    out = jnp.zeros((N + 1, D), jnp.float32).at[row_tok].add(y_rows.astype(jnp.float32) * row_gate[:, None])
    return out[:N].reshape(B, S, D).astype(x.dtype)


def setup_inputs(seed: int = 0) -> dict:
    key = jax.random.key(seed)
    ks = iter(jax.random.split(key, 40))
    nrm = lambda shape, scale: jax.random.normal(next(ks), shape, jnp.float32) * scale
    gain = lambda shape: 1.0 + nrm(shape, 0.02)
    a0 = jax.random.uniform(next(ks), (DEPTH, D_R), jnp.float32, 0.9, 0.999)
    s = a0 ** (1.0 / LRU_C)
    lam = jnp.log(s) - jnp.log1p(-s)
    f_bias = 3.0 + 3.0 * jax.random.uniform(next(ks), (DEPTH, NH_M), jnp.float32)
    b_in = nrm((DEPTH, D_IN), 0.02).at[:, I_END:F_END].set(f_bias)
    return {
        "x": nrm((BATCH, SEQ, D_MODEL), 1.0),
        "p": nrm((DEPTH, BATCH, SEQ, D_PLE), 1.0),
        "g_mix": gain((DEPTH, D_MODEL)),
        "w_in": nrm((DEPTH, D_MODEL, D_IN), D_MODEL ** -0.5),
        "b_in": b_in,
        "w_conv_qk": nrm((DEPTH, CONV_W, 2 * D_M), CONV_W ** -0.5),
        "b_conv_qk": nrm((DEPTH, 2 * D_M), 0.02),
        "g_mh": gain((DEPTH, D_M)),
        "w_conv_r": nrm((DEPTH, CONV_W, D_R), CONV_W ** -0.5),
        "b_conv_r": nrm((DEPTH, D_R), 0.02),
        "w_ra": nrm((DEPTH, NB_R, DB_R, DB_R), DB_R ** -0.5),
        "b_ra": nrm((DEPTH, D_R), 0.02),
        "w_ri": nrm((DEPTH, NB_R, DB_R, DB_R), DB_R ** -0.5),
        "b_ri": nrm((DEPTH, D_R), 0.02),
        "lam": lam,
        "g_r": gain((DEPTH, D_R)),
        "w_out": nrm((DEPTH, D_MIX, D_MODEL), D_MIX ** -0.5),
        "g_ffn": gain((DEPTH, D_MODEL)),
        "w_ff_gate": nrm((N_DENSE, D_MODEL, D_FF), D_MODEL ** -0.5),
        "w_ff_up": nrm((N_DENSE, D_MODEL, D_FF), D_MODEL ** -0.5),
        "w_ff_down": nrm((N_DENSE, D_FF, D_MODEL), D_FF ** -0.5),
        "w_router": nrm((N_MOE, D_MODEL, N_EXPERTS), D_MODEL ** -0.5),
        "w_e_gate": nrm((N_MOE, N_EXPERTS, D_MODEL, D_FF_E), D_MODEL ** -0.5),
        "w_e_up": nrm((N_MOE, N_EXPERTS, D_MODEL, D_FF_E), D_MODEL ** -0.5),
        "w_e_down": nrm((N_MOE, N_EXPERTS, D_FF_E, D_MODEL), D_FF_E ** -0.5),
        "g_ple": gain((DEPTH, D_MODEL)),
        "w_ple_gate": nrm((DEPTH, D_MODEL, D_MODEL), D_MODEL ** -0.5),
        "w_ple_proj": nrm((DEPTH, D_PLE, D_MODEL), D_PLE ** -0.5),
        "g_final": gain((D_MODEL,)),
    }


def reference(x, p, g_mix, w_in, b_in, w_conv_qk, b_conv_qk, g_mh, w_conv_r, b_conv_r,
              w_ra, b_ra, w_ri, b_ri, lam, g_r, w_out, g_ffn, w_ff_gate, w_ff_up, w_ff_down,
              w_router, w_e_gate, w_e_up, w_e_down, g_ple, w_ple_gate, w_ple_proj, g_final):
    h = x
    for i in range(DEPTH):
        hn = rmsnorm(h, g_mix[i])
        h = h + hybrid_mixer(hn, w_in[i], b_in[i], w_conv_qk[i], b_conv_qk[i], g_mh[i],
                             w_conv_r[i], b_conv_r[i], w_ra[i], b_ra[i], w_ri[i], b_ri[i],
                             lam[i], g_r[i], w_out[i])
        hn = rmsnorm(h, g_ffn[i])
        j = i // 2
        if i % 2 == 0:
            h = h + swiglu(hn, w_ff_gate[j], w_ff_up[j], w_ff_down[j])
        else:
            h = h + moe_swiglu(hn, w_router[j], w_e_gate[j], w_e_up[j], w_e_down[j])
        gate = jax.nn.sigmoid(rmsnorm(h, g_ple[i]) @ w_ple_gate[i])
        h = h + gate * (p[i] @ w_ple_proj[i])
    return rmsnorm(h, g_final)
```

```cpp
#include <hip/hip_runtime.h>
#include <hip/hip_cooperative_groups.h>
#include <cstdio>
#include <cstdint>
namespace cg = cooperative_groups;

constexpr int NT = 512;
constexpr int D = 1024, NBATCH = 4, SEQ = 4096, M = NBATCH * SEQ;
constexpr int CH = 64, NC = SEQ / CH, NH = 4, DH = 128, DM = 512, DR = 512, NBR = 8, DBR = 64;
constexpr int DIN = 3080, ZW = 3072, DFF = 2816, NE = 8, DPLE = 256;
constexpr int PMAX = 2 * M + NE * 256, NTILE_MAX = PMAX / 256;
constexpr int EROWS = 129;
constexpr float EPS = 1e-6f;
constexpr int ZQ = 0, ZK = 512, ZV = 1024, ZO = 1536, ZXR = 2048, ZYR = 2560;

constexpr size_t MiB = 1u << 20;
constexpr size_t WS_SMALL = 0;
constexpr size_t WS_W_IN = 4 * MiB;
constexpr size_t WS_W_OUT = 16 * MiB;
constexpr size_t WS_W_FFGU = 20 * MiB;
constexpr size_t WS_W_FFD = 31 * MiB;
constexpr size_t WS_W_PG = WS_W_FFD + 5632 * 1024;
constexpr size_t WS_W_PP = WS_W_PG + 4 * MiB;
constexpr size_t WS_W_EGU = WS_W_PP + 1 * MiB;
constexpr size_t WS_W_ED = WS_W_EGU + 88 * MiB;
constexpr size_t WS_PB = WS_W_ED + 44 * MiB;
constexpr size_t WS_HN = WS_PB + 16 * MiB;
constexpr size_t WS_RF = 222 * MiB;
constexpr size_t WS_Z = WS_RF;
constexpr size_t WS_CT = WS_Z + 96 * MiB;
constexpr size_t WS_DN = WS_CT + 32 * MiB;
constexpr size_t WS_MIX = WS_CT + 72 * MiB;
constexpr size_t WS_HID = WS_RF;
constexpr size_t WS_PP0 = WS_RF + 130 * MiB;
constexpr size_t WS_PP1 = WS_W_IN;
constexpr size_t WS_END = 435 * MiB;
static_assert(WS_HN + (size_t)(M + 1) * D * 2 <= WS_RF, "map");
static_assert(WS_MIX + (size_t)M * D * 2 <= WS_END, "map");
static_assert(WS_HID + (size_t)PMAX * DFF * 2 <= WS_END, "map");
static_assert(WS_DN + 1024 * 128 * 4 <= WS_PP0 && WS_PP0 + (size_t)M * D * 2 <= WS_MIX && WS_HID + (size_t)M * DFF * 2 <= WS_PP0 && WS_PP1 + (size_t)M * D * 2 <= WS_W_PG, "map");
constexpr size_t SM_GATES = 0;
constexpr size_t SM_TOKE = 512 * 1024;
constexpr size_t SM_TOKG = SM_TOKE + 128 * 1024;
constexpr size_t SM_ROWTOK = SM_TOKG + 128 * 1024;
constexpr size_t SM_ROWGATE = SM_ROWTOK + 160 * 1024;
constexpr size_t SM_TILEE = SM_ROWGATE + 160 * 1024;
constexpr size_t SM_ROWSLOT = SM_TILEE + 4 * 1024;
constexpr size_t SM_TOKP = SM_ROWSLOT + 160 * 1024;
constexpr size_t SM_BL = SM_TOKP + 16 * 1024;
constexpr size_t SM_AMAX = SM_BL + 4 * 1024;
constexpr size_t SM_MPREV = SM_AMAX + 4 * 1024;
constexpr size_t SM_RGA = 2 * MiB;
constexpr size_t SM_RGH = SM_RGA + 512 * 1024;
constexpr size_t SM_RGP = SM_RGH + 512 * 1024;
constexpr size_t SM_BAR = SM_RGP + 512 * 1024;
constexpr size_t SM_RGW = SM_BAR + 16 * 1024;
static_assert(SM_MPREV + 4096 <= SM_RGA && SM_RGW + 256 * 1024 <= 4 * MiB, "small map");

constexpr int LDS_BYTES = 147456;

typedef unsigned short bf16_t;
typedef float f32x4 __attribute__((ext_vector_type(4)));
typedef unsigned u32x4 __attribute__((ext_vector_type(4)));
typedef unsigned u32x2 __attribute__((ext_vector_type(2)));

__device__ __forceinline__ float bf2f(unsigned v) { return __uint_as_float(v << 16); }
__device__ __forceinline__ unsigned pk2(float lo, float hi);
__device__ __forceinline__ unsigned f2bf(float f) { return pk2(f, 0.f) & 0xffffu; }
typedef float f32x2_t __attribute__((ext_vector_type(2))); typedef __bf16 bf16x2_t __attribute__((ext_vector_type(2)));
__device__ __forceinline__ unsigned pk2(float lo, float hi) { f32x2_t v = {lo, hi}; bf16x2_t b = __builtin_convertvector(v, bf16x2_t); return __builtin_bit_cast(unsigned, b); }
__device__ __forceinline__ float frcp(float x) { return __builtin_amdgcn_rcpf(x); }
__device__ __forceinline__ float sigmoidf_(float x) { return frcp(1.f + __expf(-x)); }
__device__ __forceinline__ float siluf_(float x) { return x * frcp(1.f + __expf(-x)); }
__device__ __forceinline__ float logsigmoidf_(float x) { return fminf(x, 0.f) - log1pf(__expf(-fabsf(x))); }
__device__ __forceinline__ float gelu_tanh(float y) { const float u2 = 1.5957691216057308f * (y + 0.044715f * y * y * y); return y * frcp(1.f + __expf(-u2)); }
__device__ __forceinline__ float wave_sum(float v) {
#pragma unroll
    for (int o = 1; o < 64; o <<= 1) v += __shfl_xor(v, o);
    return v;
}
__device__ __forceinline__ float wave_max(float v) {
#pragma unroll
    for (int o = 1; o < 64; o <<= 1) v = fmaxf(v, __shfl_xor(v, o));
    return v;
}

__device__ __forceinline__ float dpp_f(float v, const int ctrl_sel) {
    const int x = __float_as_int(v); int r;
    if (ctrl_sel == 0) r = __builtin_amdgcn_update_dpp(x, x, 0xB1, 0xF, 0xF, false);
    else if (ctrl_sel == 1) r = __builtin_amdgcn_update_dpp(x, x, 0x4E, 0xF, 0xF, false);
    else if (ctrl_sel == 2) r = __builtin_amdgcn_update_dpp(x, x, 0x141, 0xF, 0xF, false);
    else r = __builtin_amdgcn_update_dpp(x, x, 0x140, 0xF, 0xF, false);
    return __int_as_float(r);
}
__device__ __forceinline__ float sum4(float v) { v += dpp_f(v, 0); v += dpp_f(v, 1); return v; }
__device__ __forceinline__ float sum8(float v) { v = sum4(v); v += dpp_f(v, 2); return v; }
__device__ __forceinline__ float sum16(float v) { v = sum8(v); v += dpp_f(v, 3); return v; }
__device__ __forceinline__ int otid() { int t = threadIdx.x; asm volatile("" : "+v"(t)); return t; }
__device__ __forceinline__ int oint(int v) { asm volatile("" : "+s"(v)); return v; }
__device__ __forceinline__ const void* okarg() { auto p = __builtin_amdgcn_kernarg_segment_ptr(); asm volatile("" : "+s"(p)); return (const void*)p; }

struct Args { const float* in[29]; float* out; unsigned char* ws; int ph_lo, ph_hi; };
enum { I_X = 0, I_P, I_GMIX, I_WIN, I_BIN, I_WCQK, I_BCQK, I_GMH, I_WCR, I_BCR, I_WRA, I_BRA, I_WRI, I_BRI, I_LAM, I_GR, I_WOUT, I_GFFN,
       I_WFG, I_WFU, I_WFD, I_WROUTER, I_WEG, I_WEU, I_WED, I_GPLE, I_WPG, I_WPP, I_GFINAL };


#define XB_TMO      128
#define XB_XCNT(j)  (256  + 64 * (j))
#define XB_XSUB(j)  (1280 + 64 * (j))
#define XB_XGEN(j)  (2304 + 64 * (j))
#define XB_TOP      3328
#define XB_TOPGEN   3392
#define XCD_BAR_WORDS 3456
#define XB_SPIN_CAP (1u << 18)
#define LAS __attribute__((address_space(3)))
__device__ __forceinline__ unsigned xb_ld(unsigned* p)              { return __hip_atomic_load(p, __ATOMIC_RELAXED, __HIP_MEMORY_SCOPE_AGENT); }
__device__ __forceinline__ unsigned xb_add(unsigned* p, unsigned v) { return __hip_atomic_fetch_add(p, v, __ATOMIC_RELAXED, __HIP_MEMORY_SCOPE_AGENT); }
__device__ __forceinline__ unsigned xb_xcc_id() { return (unsigned)__builtin_amdgcn_s_getreg((3 << 11) | 20) & 0xFu; }
#define XB_SPIN(cond, bar) do { unsigned _sp = 0; while (cond) { __builtin_amdgcn_s_sleep(1); \
    if ((++_sp & 255u) == 0u) { if (xb_ld(&(bar)[XB_TMO])) break; if (_sp > XB_SPIN_CAP) { atomicAdd(&(bar)[XB_TMO], 1u); break; } } } } while (0)
struct XcdBarrier { unsigned* bar; unsigned x; volatile LAS unsigned* st; };
__device__ __forceinline__ XcdBarrier xcd_barrier_post(unsigned* bar, volatile LAS unsigned* st) {
    XcdBarrier b; b.bar = bar; b.x = xb_xcc_id(); b.st = st;
    if (threadIdx.x == 0) (void)xb_add(&bar[XB_XCNT(b.x)], 1u);
    return b;
}
__device__ __forceinline__ void xcd_barrier_complete(unsigned* bar, unsigned x, unsigned& nloc, unsigned& nx) {
    const unsigned G = gridDim.x * gridDim.y * gridDim.z;
    unsigned sum, cnt, mine, sp = 0u;
    for (;;) {
        sum = 0u; cnt = 0u; mine = 0u;
#pragma unroll
        for (unsigned j = 0; j < 16; ++j) { const unsigned c = xb_ld(&bar[XB_XCNT(j)]); sum += c; cnt += (c > 0u) ? 1u : 0u; mine = (j == x) ? c : mine; }
        if (sum == G) break;
        __builtin_amdgcn_s_sleep(1);
        if ((++sp & 255u) == 0u) { if (xb_ld(&bar[XB_TMO])) break; if (sp > XB_SPIN_CAP) { atomicAdd(&bar[XB_TMO], 1u); break; } }
    }
    nloc = mine > 0u ? mine : 1u; nx = cnt > 0u ? cnt : 1u;
}
__device__ __forceinline__ void xcd_barrier(const XcdBarrier& b) {
    asm volatile("s_waitcnt vmcnt(0)" ::: "memory");
    __syncthreads();
    if (threadIdx.x == 0) {
        unsigned* bar = b.bar;
        __builtin_amdgcn_s_waitcnt(0);
        unsigned nloc = b.st[0], nx = b.st[1];
        if (nloc == 0u) { xcd_barrier_complete(bar, b.x, nloc, nx); b.st[0] = nloc; b.st[1] = nx; }
        const unsigned old = xb_add(&bar[XB_XSUB(b.x)], 1u);
        const unsigned gen = old / nloc;
        if (old + 1u == (gen + 1u) * nloc) {
            __builtin_amdgcn_fence(__ATOMIC_RELEASE, "agent");
            asm volatile("s_waitcnt vmcnt(0)" ::: "memory");
            const unsigned og = xb_add(&bar[XB_TOP], 1u);
            const unsigned tg = og / nx;
            if (og + 1u == (tg + 1u) * nx) xb_add(&bar[XB_TOPGEN], 1u);
            else XB_SPIN(xb_ld(&bar[XB_TOPGEN]) == tg, bar);
            __builtin_amdgcn_fence(__ATOMIC_ACQUIRE, "agent");
            xb_add(&bar[XB_XGEN(b.x)], 1u);
            asm volatile("s_waitcnt vmcnt(0)" ::: "memory");
        } else {
            XB_SPIN(xb_ld(&bar[XB_XGEN(b.x)]) == gen, bar);
            __builtin_amdgcn_fence(__ATOMIC_ACQUIRE, "agent");
            asm volatile("s_waitcnt vmcnt(0)" ::: "memory");
        }
    }
    __syncthreads();
}

struct CvtJob { const float* src; bf16_t* dst; int ld, k0, c0, K, n0; };
__device__ __forceinline__ CvtJob cvt_plain_job(const float* src, int K, int N, bf16_t* dst, int tile) {
    const int nt = N / 64, kb = tile / nt, nb = tile % nt; return CvtJob{src, dst, N, kb * 64, nb * 64, K, nb * 64};
}
__device__ __forceinline__ CvtJob cvt_gu_job(const float* g, const float* u, bf16_t* dst, int tile) {
    const int nt = 5632 / 64, kb = tile / nt, nb = tile % nt, n0 = nb * 64, tt = n0 >> 8, half = (n0 >> 7) & 1, w = n0 & 127;
    return CvtJob{half ? u : g, dst, DFF, kb * 64, tt * 128 + w, 1024, n0};
}
__device__ __forceinline__ CvtJob cvt_job(const Args& a, int it) {
    unsigned char* ws = a.ws;
    constexpr int T_IN = 16 * 48, T_OUT = 16 * 16, T_GU = 16 * 88, T_FD = 44 * 16, T_PG = 256, T_PP = 4 * 16;
    int r = it;
    if (r < 2 * T_IN) { const int l = r / T_IN, tile = r % T_IN; const int nt = ZW / 64, kb = tile / nt, nb = tile % nt, n0 = nb * 64;
        return CvtJob{a.in[I_WIN] + (size_t)l * D * DIN, (bf16_t*)(ws + WS_W_IN) + (size_t)l * ZW * D, DIN, kb * 64, n0 < 2048 ? n0 : n0 + 8, D, n0}; }
    r -= 2 * T_IN;
    if (r < 2 * T_OUT) { const int l = r / T_OUT; return cvt_plain_job(a.in[I_WOUT] + (size_t)l * D * D, D, D, (bf16_t*)(ws + WS_W_OUT) + (size_t)l * D * D, r % T_OUT); }
    r -= 2 * T_OUT;
    if (r < T_GU) return cvt_gu_job(a.in[I_WFG], a.in[I_WFU], (bf16_t*)(ws + WS_W_FFGU), r);
    r -= T_GU;
    if (r < T_FD) return cvt_plain_job(a.in[I_WFD], DFF, D, (bf16_t*)(ws + WS_W_FFD), r);
    r -= T_FD;
    if (r < 2 * T_PG) { const int l = r / T_PG; return cvt_plain_job(a.in[I_WPG] + (size_t)l * D * D, D, D, (bf16_t*)(ws + WS_W_PG) + (size_t)l * D * D, r % T_PG); }
    r -= 2 * T_PG;
    if (r < 2 * T_PP) { const int l = r / T_PP; return cvt_plain_job(a.in[I_WPP] + (size_t)l * DPLE * D, DPLE, D, (bf16_t*)(ws + WS_W_PP) + (size_t)l * D * DPLE, r % T_PP); }
    r -= 2 * T_PP;
    if (r < 8 * T_GU) { const int e = r / T_GU; return cvt_gu_job(a.in[I_WEG] + (size_t)e * D * DFF, a.in[I_WEU] + (size_t)e * D * DFF, (bf16_t*)(ws + WS_W_EGU) + (size_t)e * 5632 * D, r % T_GU); }
    r -= 8 * T_GU;
    { const int e = r / T_FD; return cvt_plain_job(a.in[I_WED] + (size_t)e * DFF * D, DFF, D, (bf16_t*)(ws + WS_W_ED) + (size_t)e * D * DFF, r % T_FD); }
}
__device__ __forceinline__ void phase_prologue(const Args& a, unsigned char* lds) {
    unsigned char* ws = a.ws;
    const int G = gridDim.x, t = otid();
    constexpr int T_IN = 16 * 48, T_OUT = 16 * 16, T_GU = 16 * 88, T_FD = 44 * 16, T_PG = 256, T_PP = 4 * 16;
    constexpr int NT_ALL = 2 * T_IN + 2 * T_OUT + T_GU + T_FD + 2 * T_PG + 2 * T_PP + 8 * T_GU + 8 * T_FD;
    constexpr int NB = 4;
    const int kk0 = t >> 4, cc = (t & 15) * 4, n = t >> 3, kg = t & 7;
    for (int it0 = blockIdx.x * NB; it0 < NT_ALL; it0 += G * NB) {
        float4 v[NB][2]; CvtJob jb[NB];
#pragma unroll
        for (int b = 0; b < NB; ++b) { const int it = it0 + b < NT_ALL ? it0 + b : NT_ALL - 1; jb[b] = cvt_job(a, it);
#pragma unroll
            for (int j = 0; j < 2; ++j) v[b][j] = *(const float4*)(jb[b].src + (size_t)(jb[b].k0 + kk0 + 32 * j) * jb[b].ld + jb[b].c0 + cc); }
#pragma unroll
        for (int b = 0; b < NB; ++b) { float* tl = (float*)lds + b * (64 * 65);
#pragma unroll
            for (int j = 0; j < 2; ++j) { float* p = tl + (kk0 + 32 * j) * 65 + cc; p[0] = v[b][j].x; p[1] = v[b][j].y; p[2] = v[b][j].z; p[3] = v[b][j].w; } }
        __syncthreads();
#pragma unroll
        for (int b = 0; b < NB; ++b) { if (it0 + b >= NT_ALL) break; const float* s_ = (const float*)lds + b * (64 * 65) + (8 * kg) * 65 + n;
            u32x4 o; o.x = pk2(s_[0], s_[65]); o.y = pk2(s_[130], s_[195]); o.z = pk2(s_[260], s_[325]); o.w = pk2(s_[390], s_[455]);
            *(u32x4*)(jb[b].dst + (size_t)(jb[b].n0 + n) * jb[b].K + jb[b].k0 + 8 * kg) = o; }
        __syncthreads();
    }
    const size_t np4 = (size_t)2 * M * DPLE / 4;
    for (size_t i = (size_t)blockIdx.x * NT + otid(); i < np4; i += (size_t)G * NT) {
        const float4 v = ((const float4*)a.in[I_P])[i]; u32x2 o; o.x = pk2(v.x, v.y); o.y = pk2(v.z, v.w); ((u32x2*)(ws + WS_PB))[i] = o; }
    for (int i = blockIdx.x * NT + otid(); i < 2 * 8 * 2 * 64 * 64; i += G * NT) {
        const int d = i & 63, e = (i >> 6) & 63, g = (i >> 12) & 1, ln = i >> 13;
        ((bf16_t*)(ws + WS_SMALL + SM_RGW))[i] = (bf16_t)f2bf((g ? a.in[I_WRI] : a.in[I_WRA])[((size_t)ln * 64 + d) * 64 + e]);
    }
    if (blockIdx.x == 0) { for (int i = otid(); i < D / 2; i += NT) ((unsigned*)(ws + WS_HN + (size_t)M * D * 2))[i] = 0u; }
    for (int i = blockIdx.x * NT + otid(); i < PMAX; i += G * NT) { ((int*)(ws + WS_SMALL + SM_ROWTOK))[i] = M; ((float*)(ws + WS_SMALL + SM_ROWGATE))[i] = 0.f; }
}

template <int AUX, bool FINAL, bool ADDY = false>
__device__ __forceinline__ void phase_rowpass(unsigned char* lds, const float* hin, const float* g, bf16_t* hn, const float* auxW, int auxld, const float* auxB,
                              float* gates, int* tok_e, float* tok_g, float* fout) {
    float* wl = (float*)lds;
    const int tid = otid(), lane = tid & 63, wave = tid >> 6;
    if (AUX) {
        for (int i = tid; i < D * 8; i += NT) wl[i] = auxW[(size_t)(i >> 3) * auxld + (i & 7)];
        __syncthreads();
    }
    f32x4 gv[4];
#pragma unroll
    for (int j = 0; j < 4; ++j) gv[j] = *(const f32x4*)(g + 4 * lane + 256 * j);
    for (int row = blockIdx.x * 8 + wave; row < M; row += gridDim.x * 8) {
        const f32x4* xr = (const f32x4*)(hin + (size_t)row * D) + lane;
        f32x4 v[4]; float ss = 0.f;
#pragma unroll
        for (int j = 0; j < 4; ++j) { v[j] = xr[64 * j];
            if (ADDY) {
                const u32x2 y = ((const u32x2*)(hn + (size_t)row * D) + lane)[64 * j];
                v[j].x += bf2f(y.x & 0xffffu); v[j].y += __uint_as_float(y.x & 0xffff0000u); v[j].z += bf2f(y.y & 0xffffu); v[j].w += __uint_as_float(y.y & 0xffff0000u);
                ((f32x4*)(const_cast<float*>(hin) + (size_t)row * D) + lane)[64 * j] = v[j]; }
            ss += (v[j].x * v[j].x + v[j].y * v[j].y) + (v[j].z * v[j].z + v[j].w * v[j].w); }
        const float rstd = rsqrtf(wave_sum(ss) * (1.f / D) + EPS);
#pragma unroll
        for (int j = 0; j < 4; ++j) v[j] = v[j] * rstd * gv[j];
        if (FINAL) {
            f32x4* o = (f32x4*)(fout + (size_t)row * D) + lane;
#pragma unroll
            for (int j = 0; j < 4; ++j) o[64 * j] = v[j];
        } else {
            u32x2* o = (u32x2*)(hn + (size_t)row * D) + lane;
#pragma unroll
            for (int j = 0; j < 4; ++j) { u32x2 w; w.x = pk2(v[j].x, v[j].y); w.y = pk2(v[j].z, v[j].w); o[64 * j] = w; }
        }
        if (AUX) {
            float acc[8];
#pragma unroll
            for (int c = 0; c < 8; ++c) acc[c] = 0.f;
#pragma unroll
            for (int j = 0; j < 4; ++j)
#pragma unroll
                for (int q = 0; q < 4; ++q) {
                    const int k = 4 * lane + 256 * j + q; const float xv = v[j][q];
                    const f32x4 w0 = *(const f32x4*)(wl + k * 8), w1 = *(const f32x4*)(wl + k * 8 + 4);
                    acc[0] += xv * w0.x; acc[1] += xv * w0.y; acc[2] += xv * w0.z; acc[3] += xv * w0.w;
                    acc[4] += xv * w1.x; acc[5] += xv * w1.y; acc[6] += xv * w1.z; acc[7] += xv * w1.w;
                }
#pragma unroll
            for (int c = 0; c < 8; ++c) acc[c] = wave_sum(acc[c]);
            if (AUX == 1) {
                if (lane < 8) { float s = acc[0];
#pragma unroll
                    for (int c = 1; c < 8; ++c) s = (lane == c) ? acc[c] : s;
                    gates[(size_t)row * 8 + lane] = s + auxB[lane]; }
            } else {
                if (lane == 0) {
                    int e1 = 0; float v1 = acc[0];
#pragma unroll
                    for (int c = 1; c < 8; ++c) if (acc[c] > v1) { v1 = acc[c]; e1 = c; }
                    int e2 = -1; float v2 = -INFINITY;
#pragma unroll
                    for (int c = 0; c < 8; ++c) if (c != e1 && acc[c] > v2) { v2 = acc[c]; e2 = c; }
                    const float p2 = __expf(v2 - v1), inv = 1.f / (1.f + p2);
                    ((unsigned char*)tok_e)[row] = (unsigned char)(e1 | (e2 << 4)); tok_g[row * 2] = inv; tok_g[row * 2 + 1] = p2 * inv;
                }
            }
        }
    }
    __syncthreads();
}

struct Unit { int pm, pn; const int* rows; size_t bofs; };
struct GridOrder {
    static constexpr bool GATHER = false;
    int nM, nN, G, c;
    __device__ __forceinline__ bool next(int i, Unit& u) const {
        const int L = i * G + c; if (L >= nM * nN) return false;
        const int grp = L / (8 * nN), fm = grp * 8, gsz = (nM - fm) < 8 ? (nM - fm) : 8, w = L % (8 * nN);
        u.pm = fm + w % gsz; u.pn = w / gsz; u.rows = nullptr; u.bofs = 0; return true;
    }
};
struct TailOrder {
    static constexpr bool GATHER = false;
    int nM, nN, G, c, first;
    __device__ __forceinline__ bool next(int i, Unit& u) const {
        if (c < first) return false; const int L = i * (G - first) + (c - first); if (L >= nM * nN) return false;
        u.pm = L / nN; u.pn = L % nN; u.rows = nullptr; u.bofs = 0; return true;
    }
};
template <bool GATHER_> struct MoeOrder {
    static constexpr bool GATHER = GATHER_;
    int nM, nN, G, c; const int* tile_e; const int* rows; size_t estride;
    __device__ __forceinline__ bool next(int i, Unit& u) const {
        const int L = i * G + c; if (L >= nM * nN) return false;
        const int grp = L / (8 * nN), fm = grp * 8, gsz = (nM - fm) < 8 ? (nM - fm) : 8, w = L % (8 * nN);
        u.pm = fm + w % gsz; u.pn = w / gsz; u.rows = rows; u.bofs = (size_t)tile_e[u.pm] * estride; return true;
    }
};


namespace pg8 {
#define PG8_LAS __attribute__((address_space(3)))
typedef short bf16x8 __attribute__((ext_vector_type(8)));
constexpr int BM = 256, BK = 64, HALF = 128, HTB = HALF * BK * 2, STAGE_BYTES = 8 * HTB;
__device__ __forceinline__ int lds_byte(int r, int c) { const int st = (r >> 4) * 2 + (c >> 5), rr = r & 15, cc = c & 31, ob = rr * 64 + cc * 2; return st * 1024 + (ob ^ (((ob >> 9) & 1) << 5)); }
__device__ __forceinline__ void stage_rc(int b, int& R, int& C) { const int st = b / 1024, sb = b % 1024, swz = sb ^ (((sb >> 9) & 1) << 5); R = (st >> 1) * 16 + swz / 64; C = (st & 1) * 32 + (swz % 64) / 2; }

__device__ __forceinline__ int perm32(int rho) { const int n = rho >> 4, i = rho & 15; return 8 * (i >> 2) + 4 * n + (i & 3); }
__device__ __forceinline__ void unit_voff(const Unit& u, const int (&R)[2], const int (&C)[2], int K, unsigned (&vo)[2][2]) {
#pragma unroll
    for (int h = 0; h < 2; ++h)
#pragma unroll
        for (int i = 0; i < 2; ++i) { int row = u.pm * BM + h * HALF + R[i]; if (u.rows) row = u.rows[row]; vo[h][i] = ((unsigned)row * (unsigned)K + (unsigned)C[i]) * 2u; }
}

template <class Epi, class Sched, bool ALIGN_EPI, bool GATHER>
__device__ __forceinline__ void gemm_phase(unsigned char* lds_, const bf16_t* A_, const bf16_t* Bt_, const int K_, const Sched& S, const Epi& E) {
    PG8_LAS unsigned char* lds = (PG8_LAS unsigned char*)lds_;
    const int K = oint(K_);
    const int tid = otid(), wid = __builtin_amdgcn_readfirstlane(tid >> 6), lane = tid & 63, wr = wid >> 2, wc = wid & 3, fr = lane & 15, fq = lane >> 4;
    const int nt = K / BK;
    int R[2], C[2]; unsigned voffA[2], voffB[2];
#pragma unroll
    for (int i = 0; i < 2; ++i) { stage_rc(tid * 16 + i * 8192, R[i], C[i]); voffA[i] = (unsigned)(R[i] * K + C[i]) * 2u;
        const int Rb = Epi::PERM ? ((R[i] & ~31) + perm32(R[i] & 31)) : R[i]; voffB[i] = (unsigned)(Rb * K + C[i]) * 2u; }
    const size_t kstep = (size_t)(BK * 2);
    const size_t hstep = (size_t)HALF * K * 2;
    const size_t tstep = 2 * hstep;
    const unsigned ldsw = (unsigned)wid * 1024u;
    const int aoff = lds_byte(wr * 64 + fr, fq * 8), boff = lds_byte(wc * 32 + fr, fq * 8);
#define PG8_SA(b, h) (((b) * 2 + (h)) * HTB)
#define PG8_SB(b, h) ((4 + (b) * 2 + (h)) * HTB)
#define PG8_STAGE(bufoff, gbase, voff) do { _Pragma("unroll") for (int _i = 0; _i < 2; ++_i) \
        __builtin_amdgcn_global_load_lds((const unsigned*)((const char*)(gbase) + (voff)[_i]), (PG8_LAS unsigned*)(lds + (bufoff) + ldsw + _i * 8192), 16, 0, 0); } while (0)
#define PG8_STAGE_A(bufoff, base, h, VO) do { if constexpr (GATHER) { PG8_STAGE(bufoff, base, (VO)[h]); } else { PG8_STAGE(bufoff, (base) + (h) * hstep, voffA); } } while (0)
#define PG8_LDA(dst, b, h) do { _Pragma("unroll") for (int m = 0; m < 4; ++m) _Pragma("unroll") for (int k = 0; k < 2; ++k) dst[m][k] = *(const PG8_LAS bf16x8*)(lds + PG8_SA(b, h) + aoff + m * 2048 + k * 1024); } while (0)
#define PG8_LDB(dst, b, h) do { _Pragma("unroll") for (int n = 0; n < 2; ++n) _Pragma("unroll") for (int k = 0; k < 2; ++k) dst[n][k] = *(const PG8_LAS bf16x8*)(lds + PG8_SB(b, h) + boff + n * 2048 + k * 1024); } while (0)
#define PG8_MMA(ai, bj, At, Bt) do { __builtin_amdgcn_s_setprio(1); _Pragma("unroll") for (int m = 0; m < 4; ++m) _Pragma("unroll") for (int n = 0; n < 2; ++n) _Pragma("unroll") for (int k = 0; k < 2; ++k) \
        acc[ai][bj][m][n] = __builtin_amdgcn_mfma_f32_16x16x32_bf16(Bt[n][k], At[m][k], acc[ai][bj][m][n], 0, 0, 0); __builtin_amdgcn_s_setprio(0); } while (0)
#define PG8_WAIT_V(n) asm volatile("s_waitcnt vmcnt(" #n ")" ::: "memory")
#define PG8_WAIT_L(n) asm volatile("s_waitcnt lgkmcnt(" #n ")" ::: "memory")
#define PG8_BAR __builtin_amdgcn_s_barrier()
#define PG8_SCHED __builtin_amdgcn_sched_barrier(0)
    Unit cur, nxt; int ui = 0;
    if (!S.next(0, cur)) return;
    f32x4 acc[2][2][4][2];
#pragma unroll
    for (int a = 0; a < 2; ++a)
#pragma unroll
        for (int b = 0; b < 2; ++b)
#pragma unroll
            for (int m = 0; m < 4; ++m)
#pragma unroll
                for (int n = 0; n < 2; ++n) acc[a][b][m][n] = (f32x4){0.f, 0.f, 0.f, 0.f};
    bf16x8 At[4][2], B0[2][2], B1[2][2];
    unsigned vc[2][2], vn[2][2];
    if constexpr (GATHER) unit_voff(cur, R, C, K, vc);
    const char* cA = GATHER ? (const char*)A_ : (const char*)A_ + (size_t)cur.pm * tstep;
    const char* cB = (const char*)Bt_ + cur.bofs * 2 + (size_t)cur.pn * tstep;
    PG8_STAGE(PG8_SB(0, 0), cB, voffB); PG8_STAGE(PG8_SB(0, 1), cB + hstep, voffB); PG8_STAGE_A(PG8_SA(0, 0), cA, 0, vc); PG8_STAGE_A(PG8_SA(0, 1), cA, 1, vc);
    if (wr == 1) PG8_BAR;
    PG8_WAIT_V(2); PG8_BAR;
    PG8_STAGE(PG8_SB(1, 0), cB + kstep, voffB); PG8_STAGE_A(PG8_SA(1, 0), cA + kstep, 0, vc); PG8_STAGE(PG8_SB(1, 1), cB + hstep + kstep, voffB);
    PG8_WAIT_V(6); PG8_BAR;
    for (;;) {
        const bool has_next = S.next(ui + 1, nxt);
        const char* nA = cA; const char* nB = cB;
        if (has_next) { nB = (const char*)Bt_ + nxt.bofs * 2 + (size_t)nxt.pn * tstep; if constexpr (!GATHER) nA = (const char*)A_ + (size_t)nxt.pm * tstep; }
        if constexpr (GATHER) {
            if (has_next) unit_voff(nxt, R, C, K, vn);
            else {
#pragma unroll
                for (int h = 0; h < 2; ++h)
#pragma unroll
                    for (int i = 0; i < 2; ++i) vn[h][i] = vc[h][i]; } }
        for (int t = 0; t < nt; t += 2) {
            const bool last = (t == nt - 2);
            const char* a1 = cA + (size_t)(t + 1) * kstep;
            const char* a2 = last ? nA : cA + (size_t)(t + 2) * kstep; const char* b2 = last ? nB : cB + (size_t)(t + 2) * kstep;
            const char* a3 = a2 + kstep; const char* b3 = b2 + kstep;
            unsigned v2[2][2];
            if constexpr (GATHER) {
#pragma unroll
                for (int h = 0; h < 2; ++h)
#pragma unroll
                    for (int i = 0; i < 2; ++i) v2[h][i] = last ? vn[h][i] : vc[h][i]; }
            PG8_LDB(B0, 0, 0); PG8_LDB(B1, 0, 1); PG8_SCHED; PG8_LDA(At, 0, 0); PG8_STAGE_A(PG8_SA(1, 1), a1, 1, vc);
            PG8_WAIT_V(8); PG8_WAIT_L(0); PG8_BAR; PG8_MMA(0, 0, At, B0); PG8_MMA(0, 1, At, B1); PG8_BAR; PG8_SCHED;
            PG8_LDA(At, 0, 1); PG8_STAGE(PG8_SB(0, 0), b2, voffB); PG8_STAGE(PG8_SB(0, 1), b2 + hstep, voffB); PG8_STAGE_A(PG8_SA(0, 0), a2, 0, v2);
            PG8_WAIT_V(8); PG8_WAIT_L(0); PG8_BAR; PG8_MMA(1, 0, At, B0); PG8_MMA(1, 1, At, B1); PG8_BAR; PG8_SCHED;
            PG8_LDB(B0, 1, 0); PG8_LDB(B1, 1, 1); PG8_SCHED; PG8_LDA(At, 1, 0); PG8_STAGE_A(PG8_SA(0, 1), a2, 1, v2);
            PG8_WAIT_V(8); PG8_WAIT_L(0); PG8_BAR; PG8_MMA(0, 0, At, B0); PG8_MMA(0, 1, At, B1); PG8_BAR; PG8_SCHED;
            PG8_LDA(At, 1, 1); PG8_STAGE(PG8_SB(1, 0), b3, voffB); PG8_STAGE(PG8_SB(1, 1), b3 + hstep, voffB); PG8_STAGE_A(PG8_SA(1, 0), a3, 0, v2);
            PG8_WAIT_V(8); PG8_WAIT_L(0); PG8_BAR; PG8_MMA(1, 0, At, B0); PG8_MMA(1, 1, At, B1); PG8_BAR; PG8_SCHED;
        }
        if constexpr (ALIGN_EPI) { if (wr == 0) PG8_BAR; }
        E(acc, cur.pm, cur.pn, wr, wc, fr, fq);
        if (!has_next) break;
#pragma unroll
        for (int a = 0; a < 2; ++a)
#pragma unroll
            for (int b = 0; b < 2; ++b)
#pragma unroll
                for (int m = 0; m < 4; ++m)
#pragma unroll
                    for (int n = 0; n < 2; ++n) acc[a][b][m][n] = (f32x4){0.f, 0.f, 0.f, 0.f};
        cur = nxt; cA = nA; cB = nB; ++ui;
        if constexpr (GATHER) {
#pragma unroll
            for (int h = 0; h < 2; ++h)
#pragma unroll
                for (int i = 0; i < 2; ++i) vc[h][i] = vn[h][i]; }
        if constexpr (ALIGN_EPI) { if (wr == 1) PG8_BAR; }
    }
    PG8_WAIT_V(0);
    if constexpr (!ALIGN_EPI) { if (wr == 0) PG8_BAR; }
    PG8_BAR;
#undef PG8_SA
#undef PG8_SB
#undef PG8_STAGE
#undef PG8_STAGE_A
#undef PG8_LDA
#undef PG8_LDB
#undef PG8_MMA
#undef PG8_WAIT_V
#undef PG8_WAIT_L
#undef PG8_BAR
#undef PG8_SCHED
}
}
template <class Epi, class Sched>
__device__ __forceinline__ void gemm_fast(unsigned char* lds, const bf16_t* A, const bf16_t* Bt, int K, const Sched& S, const Epi& E) {
    pg8::gemm_phase<Epi, Sched, true, Sched::GATHER>(lds, A, Bt, K, S, E);
    __syncthreads();
}

typedef f32x4 AccT[2][2][4][2];
#define EPI_ROW(ai, m) (pm * 256 + (ai) * 128 + wr * 64 + (m) * 16 + fr)
struct EpiZ { static constexpr bool PERM = true; bf16_t* z; const float* bin;
    __device__ __forceinline__ void operator()(const AccT& acc, int pm, int pn, int wr, int wc, int fr, int fq) const {
        const int c0 = pn * 256 + wc * 32 + 8 * fq; f32x4 bv[2][2];
#pragma unroll
        for (int bj = 0; bj < 2; ++bj)
#pragma unroll
            for (int n = 0; n < 2; ++n) { const int cc = c0 + bj * 128 + n * 4; bv[bj][n] = *(const f32x4*)(bin + (cc < 2048 ? cc : cc + 8)); }
#pragma unroll
        for (int ai = 0; ai < 2; ++ai)
#pragma unroll
            for (int m = 0; m < 4; ++m) { bf16_t* rp = z + (size_t)EPI_ROW(ai, m) * ZW + c0;
#pragma unroll
                for (int bj = 0; bj < 2; ++bj) { const f32x4 v0 = acc[ai][bj][m][0] + bv[bj][0], v1 = acc[ai][bj][m][1] + bv[bj][1];
                    u32x4 w; w.x = pk2(v0.x, v0.y); w.y = pk2(v0.z, v0.w); w.z = pk2(v1.x, v1.y); w.w = pk2(v1.z, v1.w); *(u32x4*)(rp + bj * 128) = w; } } } };
struct EpiResid { static constexpr bool PERM = false; const float* base; float* out;
    __device__ __forceinline__ void operator()(const AccT& acc, int pm, int pn, int wr, int wc, int fr, int fq) const {
        const int c0 = pn * 256 + wc * 32 + 4 * fq;
#pragma unroll
        for (int ai = 0; ai < 2; ++ai) {
            f32x4 ld[4][2][2];
#pragma unroll
            for (int m = 0; m < 4; ++m)
#pragma unroll
                for (int bj = 0; bj < 2; ++bj)
#pragma unroll
                    for (int n = 0; n < 2; ++n) ld[m][bj][n] = *(const f32x4*)(base + (size_t)EPI_ROW(ai, m) * D + c0 + bj * 128 + n * 16);
#pragma unroll
            for (int m = 0; m < 4; ++m)
#pragma unroll
                for (int bj = 0; bj < 2; ++bj)
#pragma unroll
                    for (int n = 0; n < 2; ++n) *(f32x4*)(out + (size_t)EPI_ROW(ai, m) * D + c0 + bj * 128 + n * 16) = ld[m][bj][n] + acc[ai][bj][m][n];
        } } };
struct EpiSwiglu { static constexpr bool PERM = true; bf16_t* hid;
    __device__ __forceinline__ void operator()(const AccT& acc, int pm, int pn, int wr, int wc, int fr, int fq) const {
        const int c0 = pn * 128 + wc * 32 + 8 * fq;
#pragma unroll
        for (int ai = 0; ai < 2; ++ai)
#pragma unroll
            for (int m = 0; m < 4; ++m) { u32x4 w;
#pragma unroll
                for (int n = 0; n < 2; ++n) { const f32x4 g = acc[ai][0][m][n], u = acc[ai][1][m][n];
                    w[2 * n] = pk2(siluf_(g.x) * u.x, siluf_(g.y) * u.y); w[2 * n + 1] = pk2(siluf_(g.z) * u.z, siluf_(g.w) * u.w); }
                *(u32x4*)(hid + (size_t)EPI_ROW(ai, m) * DFF + c0) = w; } } };
struct EpiMoeDown { static constexpr bool PERM = false; float* h; bf16_t* y1; const int* row_tok; const int* row_slot; const float* row_gate; int tokmask;
    __device__ __forceinline__ void operator()(const AccT& acc, int pm, int pn, int wr, int wc, int fr, int fq) const {
        const int c0 = pn * 256 + wc * 32 + 4 * fq;
        int tok[2][4], slot[2][4]; float gt[2][4];
#pragma unroll
        for (int ai = 0; ai < 2; ++ai)
#pragma unroll
            for (int m = 0; m < 4; ++m) { const int row = EPI_ROW(ai, m); tok[ai][m] = row_tok[row]; slot[ai][m] = row_slot[row]; gt[ai][m] = row_gate[row]; }
#pragma unroll
        for (int ai = 0; ai < 2; ++ai) {
            f32x4 ld[4][2][2];
#pragma unroll
            for (int m = 0; m < 4; ++m) { const bool rmw = tok[ai][m] < M && slot[ai][m] == 0; const float* hp = h + (size_t)(tok[ai][m] & tokmask) * D + c0;
#pragma unroll
                for (int bj = 0; bj < 2; ++bj)
#pragma unroll
                    for (int n = 0; n < 2; ++n) ld[m][bj][n] = rmw ? *(const f32x4*)(hp + bj * 128 + n * 16) : (f32x4){0.f, 0.f, 0.f, 0.f}; }
#pragma unroll
            for (int m = 0; m < 4; ++m) { if (tok[ai][m] >= M) continue; const size_t o = (size_t)(tok[ai][m] & tokmask) * D + c0; const float g = gt[ai][m];
                if (slot[ai][m] == 0) {
#pragma unroll
                    for (int bj = 0; bj < 2; ++bj)
#pragma unroll
                        for (int n = 0; n < 2; ++n) *(f32x4*)(h + o + bj * 128 + n * 16) = ld[m][bj][n] + g * acc[ai][bj][m][n];
                } else {
#pragma unroll
                    for (int bj = 0; bj < 2; ++bj)
#pragma unroll
                        for (int n = 0; n < 2; ++n) { const f32x4 v = g * acc[ai][bj][m][n]; u32x2 w; w.x = pk2(v.x, v.y); w.y = pk2(v.z, v.w); *(u32x2*)(y1 + o + bj * 128 + n * 16) = w; }
                } }
        } } };
struct EpiStoreBf16 { static constexpr bool PERM = true; bf16_t* out;
    __device__ __forceinline__ void operator()(const AccT& acc, int pm, int pn, int wr, int wc, int fr, int fq) const {
        const int c0 = pn * 256 + wc * 32 + 8 * fq;
#pragma unroll
        for (int ai = 0; ai < 2; ++ai)
#pragma unroll
            for (int m = 0; m < 4; ++m)
#pragma unroll
                for (int bj = 0; bj < 2; ++bj) { const f32x4 v0 = acc[ai][bj][m][0], v1 = acc[ai][bj][m][1];
                    u32x4 w; w.x = pk2(v0.x, v0.y); w.y = pk2(v0.z, v0.w); w.z = pk2(v1.x, v1.y); w.w = pk2(v1.z, v1.w); *(u32x4*)(out + (size_t)EPI_ROW(ai, m) * D + c0 + bj * 128) = w; } } };
struct EpiPle { static constexpr bool PERM = false; float* h; const bf16_t* pp;
    __device__ __forceinline__ void operator()(const AccT& acc, int pm, int pn, int wr, int wc, int fr, int fq) const {
        const int c0 = pn * 256 + wc * 32 + 4 * fq;
#pragma unroll
        for (int ai = 0; ai < 2; ++ai)
#pragma unroll
            for (int mh = 0; mh < 2; ++mh) {
                f32x4 lh[2][2][2]; u32x2 lp[2][2][2];
#pragma unroll
                for (int mm = 0; mm < 2; ++mm)
#pragma unroll
                    for (int bj = 0; bj < 2; ++bj)
#pragma unroll
                        for (int n = 0; n < 2; ++n) { const size_t o = (size_t)EPI_ROW(ai, mh * 2 + mm) * D + c0 + bj * 128 + n * 16; lh[mm][bj][n] = *(const f32x4*)(h + o); lp[mm][bj][n] = *(const u32x2*)(pp + o); }
#pragma unroll
                for (int mm = 0; mm < 2; ++mm)
#pragma unroll
                    for (int bj = 0; bj < 2; ++bj)
#pragma unroll
                        for (int n = 0; n < 2; ++n) { const size_t o = (size_t)EPI_ROW(ai, mh * 2 + mm) * D + c0 + bj * 128 + n * 16; const f32x4 v = acc[ai][bj][mh * 2 + mm][n]; f32x4 r = lh[mm][bj][n]; const u32x2 p = lp[mm][bj][n];
                            r.x += sigmoidf_(v.x) * bf2f(p.x & 0xffffu); r.y += sigmoidf_(v.y) * __uint_as_float(p.x & 0xffff0000u); r.z += sigmoidf_(v.z) * bf2f(p.y & 0xffffu); r.w += sigmoidf_(v.w) * __uint_as_float(p.y & 0xffff0000u);
                            *(f32x4*)(h + o) = r; }
            } } };

__device__ __forceinline__ float conv4(const bf16_t* zc, int row, int s, const float* w  , int wstride, float b) {
    float acc = b;
#pragma unroll
    for (int j = 0; j < 4; ++j) { const int ds = 3 - j; if (s - ds >= 0) acc += w[j * wstride] * bf2f(zc[(ptrdiff_t)(row - ds) * ZW]); }
    return acc;
}
__device__ __forceinline__ void chunk_gates(float* sc, const float* gates, int row0, int h, int lane) {
    const float ip = gates[(size_t)(row0 + lane) * 8 + h], fp = gates[(size_t)(row0 + lane) * 8 + 4 + h];
    float b = logsigmoidf_(fp);
#pragma unroll
    for (int o = 1; o < 64; o <<= 1) { const float n = __shfl_up(b, o); if (lane >= o) b += n; }
    sc[lane] = b; sc[64 + lane] = ip;
}
__device__ __forceinline__ void chunk_gates_r(float* sc, float ip, float fp, int lane) {
    float b = logsigmoidf_(fp);
#pragma unroll
    for (int o = 1; o < 64; o <<= 1) { const float n = __shfl_up(b, o); if (lane >= o) b += n; }
    sc[lane] = b; sc[64 + lane] = ip;
}
__device__ __forceinline__ void mlstm_local(const Args& a, unsigned char* lds, int l, int item) {
    const int b = item >> 8, c = (item >> 2) & 63, h = item & 3, row0 = b * SEQ + c * CH, tid = otid(), lane = tid & 63;
    float* Kt = (float*)lds;
    float* Vt = Kt + 64 * 128;
    float* sc = Vt + 64 * 128;
    const bf16_t* z = (const bf16_t*)(a.ws + WS_Z);
    const float* gates = (const float*)(a.ws + WS_SMALL + SM_GATES);
    if (tid < 64) {
        chunk_gates(sc, gates, row0, h, lane);
        const float bl = __shfl(sc[lane], 63), al = bl - sc[lane] + sc[64 + lane];
        const float amax = wave_max(al);
        sc[128 + lane] = __expf(al - amax);
        if (lane == 0) { ((float*)(a.ws + WS_SMALL + SM_BL))[item] = bl; ((float*)(a.ws + WS_SMALL + SM_AMAX))[item] = amax; }
    }
    const float* wc = a.in[I_WCQK] + (size_t)l * 4 * 1024; const float* bc = a.in[I_BCQK] + (size_t)l * 1024;
    for (int i = tid; i < 64 * 128; i += NT) {
        const int ll = i >> 7, d = i & 127, ch = ZK + h * DH + d;
        Kt[i] = siluf_(conv4(z + ch, row0 + ll, c * CH + ll, wc + ch, 1024, bc[ch]));
        Vt[i] = bf2f(z[(size_t)(row0 + ll) * ZW + ZV + h * DH + d]);
    }
    __syncthreads();
    const int d = tid & 127, eg = tid >> 7;
    float acc[33];
#pragma unroll
    for (int i = 0; i < 33; ++i) acc[i] = 0.f;
    for (int ll = 0; ll < 64; ++ll) {
        const float kd = Kt[ll * 128 + d] * sc[128 + ll];
#pragma unroll
        for (int i = 0; i < 32; ++i) acc[i] += Vt[ll * 128 + eg + 4 * i] * kd;
        acc[32] += kd;
    }
    float* ct = (float*)(a.ws + WS_CT) + (size_t)item * EROWS * 128;
#pragma unroll
    for (int i = 0; i < 32; ++i) ct[(eg + 4 * i) * 128 + d] = acc[i];
    if (eg == 0) ct[128 * 128 + d] = acc[32];
    __syncthreads();
}
__device__ __forceinline__ void mlstm_scan(const Args& a, int G) {
    const float* BL = (const float*)(a.ws + WS_SMALL + SM_BL); const float* AM = (const float*)(a.ws + WS_SMALL + SM_AMAX);
    float* MP = (float*)(a.ws + WS_SMALL + SM_MPREV);
    const int tid = otid();
    for (int w = blockIdx.x; w < 16 * 16; w += G) {
        const int bh = w >> 4, sl = w & 15, b = bh >> 2, h = bh & 3;
        unsigned* p = (unsigned*)(a.ws + WS_CT) + (size_t)((b * NC) * NH + h) * 8192 + sl * 512 + tid;
        float s0 = 0.f, s1 = 0.f, m = 0.f;
#pragma unroll 1
        for (int c0 = 0; c0 < NC; c0 += 16) {
            unsigned x[16];
#pragma unroll
            for (int j = 0; j < 16; ++j) x[j] = p[(size_t)(c0 + j) * (NH * 8192)];
#pragma unroll
            for (int j = 0; j < 16; ++j) {
                const int item = (b * NC + c0 + j) * NH + h;
                const float bl = BL[item], am = AM[item];
                const float mn = fmaxf(bl + m, am), dec = __expf(bl + m - mn), scl = __expf(am - mn);
                p[(size_t)(c0 + j) * (NH * 8192)] = pk2(s0, s1);
                if (sl == 0 && tid == 0) MP[item] = m;
                s0 = dec * s0 + scl * bf2f(x[j] & 0xffffu); s1 = dec * s1 + scl * __uint_as_float(x[j] & 0xffff0000u); m = mn;
            }
        }
        if (sl == 1 && tid < 128) {
            float* q = (float*)(a.ws + WS_DN) + (size_t)((b * NC) * NH + h) * 128 + tid;
            float sn = 0.f; m = 0.f;
#pragma unroll 1
            for (int c0 = 0; c0 < NC; c0 += 16) {
                float x[16];
#pragma unroll
                for (int j = 0; j < 16; ++j) x[j] = q[(size_t)(c0 + j) * (NH * 128)];
#pragma unroll
                for (int j = 0; j < 16; ++j) {
                    const int item = (b * NC + c0 + j) * NH + h;
                    const float bl = BL[item], am = AM[item];
                    const float mn = fmaxf(bl + m, am), dec = __expf(bl + m - mn), scl = __expf(am - mn);
                    q[(size_t)(c0 + j) * (NH * 128)] = sn;
                    sn = dec * sn + scl * x[j]; m = mn;
                }
            }
        }
    }
}
__device__ __forceinline__ void mlstm_out(const Args& a, unsigned char* lds, int l, int item) {
    const int b = item >> 8, c = (item >> 2) & 63, h = item & 3, row0 = b * SEQ + c * CH, tid = otid(), lane = tid & 63, wave = tid >> 6;
    float* Q = (float*)lds;
    float* Kt = Q + 64 * 128;
    float* Vt = Kt + 64 * 128;
    float* Sm = Vt + 64 * 128;
    float* sc = Sm + 64 * 64;
    const bf16_t* z = (const bf16_t*)(a.ws + WS_Z);
    const float* gates = (const float*)(a.ws + WS_SMALL + SM_GATES);
    const float mprev = ((const float*)(a.ws + WS_SMALL + SM_MPREV))[item];
    if (tid < 64) {
        chunk_gates(sc, gates, row0, h, lane);
        float g = sc[64 + lane] - sc[lane];
#pragma unroll
        for (int o = 1; o < 64; o <<= 1) { const float n = __shfl_up(g, o); if (lane >= o) g = fmaxf(g, n); }
        const float mrow = sc[lane] + fmaxf(mprev, g);
        sc[128 + lane] = mrow; sc[192 + lane] = __expf(sc[lane] + mprev - mrow);
    }
    const float* wc = a.in[I_WCQK] + (size_t)l * 4 * 1024; const float* bc = a.in[I_BCQK] + (size_t)l * 1024;
    for (int i = tid; i < 64 * 128; i += NT) {
        const int ll = i >> 7, d = i & 127, chq = ZQ + h * DH + d, chk = ZK + h * DH + d;
        Q[i] = siluf_(conv4(z + chq, row0 + ll, c * CH + ll, wc + chq, 1024, bc[chq])) * 0.08838834764831845f;
        Kt[i] = siluf_(conv4(z + chk, row0 + ll, c * CH + ll, wc + chk, 1024, bc[chk]));
        Vt[i] = bf2f(z[(size_t)(row0 + ll) * ZW + ZV + h * DH + d]);
    }
    __syncthreads();
    for (int i = tid; i < 64 * 64; i += NT) {
        const int ll = i >> 6, mm = i & 63; float s = 0.f;
        if (mm <= ll) {
            for (int d = 0; d < 128; ++d) s += Q[ll * 128 + d] * Kt[mm * 128 + d];
            s *= __expf(sc[ll] - sc[mm] + sc[64 + mm] - sc[128 + ll]);
        }
        Sm[i] = s;
    }
    __syncthreads();
    const float* ct = (const float*)(a.ws + WS_CT) + (size_t)item * EROWS * 128;
    if (tid < 64) {
        float di = 0.f, dn = 0.f;
        for (int mm = 0; mm < 64; ++mm) di += Sm[tid * 64 + mm];
        for (int d = 0; d < 128; ++d) dn += Q[tid * 128 + d] * ct[128 * 128 + d];
        const float den = di + sc[192 + tid] * dn;
        sc[256 + tid] = fmaxf(fabsf(den), __expf(-sc[128 + tid]));
    }
    const int e = tid & 127, lg = tid >> 7;
    float acc[16], acc2[16];
#pragma unroll
    for (int i = 0; i < 16; ++i) { acc[i] = 0.f; acc2[i] = 0.f; }
    for (int mm = 0; mm < 64; ++mm) { const float vv = Vt[mm * 128 + e];
#pragma unroll
        for (int i = 0; i < 16; ++i) acc[i] += Sm[(lg * 16 + i) * 64 + mm] * vv; }
    for (int d = 0; d < 128; ++d) { const float cv = ct[e * 128 + d];
#pragma unroll
        for (int i = 0; i < 16; ++i) acc2[i] += Q[(lg * 16 + i) * 128 + d] * cv; }
    __syncthreads();
#pragma unroll
    for (int i = 0; i < 16; ++i) { const int ll = lg * 16 + i;
        const float hv = (acc[i] + sc[192 + ll] * acc2[i]) / sc[256 + ll];
        const float o = sigmoidf_(bf2f(z[(size_t)(row0 + ll) * ZW + ZO + h * DH + e]));
        Kt[ll * 128 + e] = hv * o; }
    __syncthreads();
    const float* gm = a.in[I_GMH] + (size_t)l * DM + h * DH;
    bf16_t* mix = (bf16_t*)(a.ws + WS_MIX);
    for (int ll = wave * 8; ll < wave * 8 + 8; ++ll) {
        const float x0 = Kt[ll * 128 + 2 * lane], x1 = Kt[ll * 128 + 2 * lane + 1];
        const float rs = rsqrtf(wave_sum(x0 * x0 + x1 * x1) * (1.f / 128.f) + EPS);
        *(unsigned*)(mix + (size_t)(row0 + ll) * D + h * DH + 2 * lane) = pk2(x0 * rs * gm[2 * lane], x1 * rs * gm[2 * lane + 1]);
    }
    __syncthreads();
}


typedef short bf16x8 __attribute__((ext_vector_type(8)));
__device__ __forceinline__ f32x4 mfma16(bf16x8 a, bf16x8 b, f32x4 c) { return __builtin_amdgcn_mfma_f32_16x16x32_bf16(a, b, c, 0, 0, 0); }
#define WAVE_LDS_SYNC() asm volatile("s_waitcnt lgkmcnt(0)" ::: "memory")
#define LDS_BARRIER() do { asm volatile("s_waitcnt lgkmcnt(0)" ::: "memory"); __builtin_amdgcn_s_barrier(); asm volatile("" ::: "memory"); } while (0)
__device__ __forceinline__ void conv_load11(const bf16_t* zc, int row0, int l0, bool first_chunk, unsigned (&x)[11]) {
#pragma unroll
    for (int j = 0; j < 11; ++j) { const int ll = l0 - 3 + j; x[j] = (first_chunk && ll < 0) ? 0u : *(const unsigned*)(zc + (ptrdiff_t)(row0 + ll) * ZW); }
}
struct ConvW { float w[4][2]; float b[2]; };
__device__ __forceinline__ void conv_loadw(const float* wc, const float* bc, int col, ConvW& cw) {
#pragma unroll
    for (int j = 0; j < 4; ++j) { cw.w[j][0] = wc[j * 1024 + col]; cw.w[j][1] = wc[j * 1024 + col + 1]; }
    cw.b[0] = bc[col]; cw.b[1] = bc[col + 1];
}
__device__ __forceinline__ void conv_apply(const unsigned (&x)[11], const ConvW& cw, float (&out)[8][2]) {
#pragma unroll
    for (int i = 0; i < 8; ++i) { float a0 = cw.b[0], a1 = cw.b[1];
#pragma unroll
        for (int j = 0; j < 4; ++j) { a0 += cw.w[j][0] * bf2f(x[i + j] & 0xffffu); a1 += cw.w[j][1] * __uint_as_float(x[i + j] & 0xffff0000u); }
        out[i][0] = a0; out[i][1] = a1; }
}
struct MlRegs { unsigned xk[11], v[8]; ConvW cw; float gi, gf; };
__device__ __forceinline__ void ml_load(const Args& a, int l, int item, MlRegs& R) {
    const int b = item >> 8, c = (item >> 2) & 63, h = item & 3, row0 = b * SEQ + c * CH, tid = otid(), lane = tid & 63, wave = tid >> 6;
    const bf16_t* z = (const bf16_t*)(a.ws + WS_Z);
    const float* gates = (const float*)(a.ws + WS_SMALL + SM_GATES);
    const int cp = lane, lg = wave, colk = ZK + h * DH + 2 * cp, colv = ZV + h * DH + 2 * cp;
    conv_load11(z + colk, row0, 8 * lg, c == 0, R.xk);
#pragma unroll
    for (int i = 0; i < 8; ++i) R.v[i] = *(const unsigned*)(z + (size_t)(row0 + 8 * lg + i) * ZW + colv);
    conv_loadw(a.in[I_WCQK] + (size_t)l * 4 * 1024, a.in[I_BCQK] + (size_t)l * 1024, colk, R.cw);
    R.gi = gates[(size_t)(row0 + lane) * 8 + h]; R.gf = gates[(size_t)(row0 + lane) * 8 + 4 + h];
}
__device__ __forceinline__ void ml_compute(const Args& a, unsigned char* lds, int l, int item, MlRegs& R) {
    const int tid = otid(), lane = tid & 63, wave = tid >> 6, fr = lane & 15, fq = lane >> 4;
    unsigned char* KT = lds; unsigned char* VT = lds + 18432; float* RED = (float*)(lds + 36864); float* sc = (float*)(lds + 40960);
    const int cp = lane, lg = wave;
    unsigned (&xk)[11] = R.xk; unsigned (&v)[8] = R.v; ConvW& cw = R.cw;
    if (tid < 64) {
        chunk_gates_r(sc, R.gi, R.gf, lane);
        const float bl = __shfl(sc[lane], 63), al = bl - sc[lane] + sc[64 + lane];
        const float amax = wave_max(al);
        sc[128 + lane] = __expf(al - amax);
        if (lane == 0) { ((float*)(a.ws + WS_SMALL + SM_BL))[item] = bl; ((float*)(a.ws + WS_SMALL + SM_AMAX))[item] = amax; }
    }
    LDS_BARRIER();
    {
        float kk[8][2];
        conv_apply(xk, cw, kk);
        float n0 = 0.f, n1 = 0.f;
#pragma unroll
        for (int i = 0; i < 8; ++i) { const float wl = sc[128 + 8 * lg + i]; kk[i][0] = siluf_(kk[i][0]) * wl; kk[i][1] = siluf_(kk[i][1]) * wl; n0 += kk[i][0]; n1 += kk[i][1]; }
        u32x4 p0, p1;
#pragma unroll
        for (int i = 0; i < 4; ++i) { p0[i] = pk2(kk[2 * i][0], kk[2 * i + 1][0]); p1[i] = pk2(kk[2 * i][1], kk[2 * i + 1][1]); }
        *(u32x4*)(KT + (2 * cp) * 144 + lg * 16) = p0; *(u32x4*)(KT + (2 * cp + 1) * 144 + lg * 16) = p1;
        RED[lg * 128 + 2 * cp] = n0; RED[lg * 128 + 2 * cp + 1] = n1;
#pragma unroll
        for (int i = 0; i < 4; ++i) { p0[i] = (v[2 * i] & 0xffffu) | (v[2 * i + 1] << 16); p1[i] = (v[2 * i] >> 16) | (v[2 * i + 1] & 0xffff0000u); }
        *(u32x4*)(VT + (2 * cp) * 144 + lg * 16) = p0; *(u32x4*)(VT + (2 * cp + 1) * 144 + lg * 16) = p1;
    }
    LDS_BARRIER();
    bf16_t* ct = (bf16_t*)(a.ws + WS_CT) + (size_t)item * 128 * 128;
    {
        const int et0 = 2 * (wave & 3), dt0 = 4 * (wave >> 2);
        bf16x8 Vf[2][2], Kf[4][2];
#pragma unroll
        for (int i = 0; i < 2; ++i)
#pragma unroll
            for (int ks = 0; ks < 2; ++ks) Vf[i][ks] = *(const bf16x8*)(VT + ((et0 + i) * 16 + fr) * 144 + (ks * 32 + 8 * fq) * 2);
#pragma unroll
        for (int j = 0; j < 4; ++j)
#pragma unroll
            for (int ks = 0; ks < 2; ++ks) Kf[j][ks] = *(const bf16x8*)(KT + ((dt0 + j) * 16 + fr) * 144 + (ks * 32 + 8 * fq) * 2);
#pragma unroll
        for (int i = 0; i < 2; ++i)
#pragma unroll
            for (int j = 0; j < 4; ++j) {
                f32x4 acc = {0.f, 0.f, 0.f, 0.f};
                acc = mfma16(Kf[j][0], Vf[i][0], acc); acc = mfma16(Kf[j][1], Vf[i][1], acc);
                u32x2 w; w.x = pk2(acc[0], acc[1]); w.y = pk2(acc[2], acc[3]);
                *(u32x2*)(ct + ((et0 + i) * 16 + fr) * 128 + (dt0 + j) * 16 + 4 * fq) = w;
            }
    }
    if (tid < 128) { float s_ = 0.f;
#pragma unroll
        for (int g = 0; g < 8; ++g) s_ += RED[g * 128 + tid];
        ((float*)(a.ws + WS_DN))[(size_t)item * 128 + tid] = s_; }
    LDS_BARRIER();
}
struct MoRegs { unsigned xq[11], xk[11], v[8], ov[8]; float gi, gf, mprev; };
__device__ __forceinline__ void mo_load(const Args& a, int l, int item, MoRegs& R) {
    const int b = item >> 8, c = (item >> 2) & 63, h = item & 3, row0 = b * SEQ + c * CH, tid = otid(), lane = tid & 63, wave = tid >> 6;
    const bf16_t* z = (const bf16_t*)(a.ws + WS_Z);
    const float* gates = (const float*)(a.ws + WS_SMALL + SM_GATES);
    const int cp = lane, lg = wave, colq = ZQ + h * DH + 2 * cp, colk = ZK + h * DH + 2 * cp, colv = ZV + h * DH + 2 * cp, colo = ZO + h * DH + 2 * cp;
    conv_load11(z + colq, row0, 8 * lg, c == 0, R.xq);
    conv_load11(z + colk, row0, 8 * lg, c == 0, R.xk);
#pragma unroll
    for (int i = 0; i < 8; ++i) { R.v[i] = *(const unsigned*)(z + (size_t)(row0 + 8 * lg + i) * ZW + colv); R.ov[i] = *(const unsigned*)(z + (size_t)(row0 + 8 * lg + i) * ZW + colo); }
    R.gi = gates[(size_t)(row0 + lane) * 8 + h]; R.gf = gates[(size_t)(row0 + lane) * 8 + 4 + h];
    R.mprev = ((const float*)(a.ws + WS_SMALL + SM_MPREV))[item];
}
__device__ __forceinline__ void mo_compute(const Args& a, unsigned char* lds, int l, int item, MoRegs& R, ConvW& cwq, ConvW& cwk, int& hw) {
    const int b = item >> 8, c = (item >> 2) & 63, h = item & 3, row0 = b * SEQ + c * CH, tid = otid(), lane = tid & 63, wave = tid >> 6, fr = lane & 15, fq = lane >> 4;
    unsigned char* QN = lds; unsigned char* KN = lds + 17408; unsigned char* VT = lds + 34816; unsigned char* SP = lds + 53248; unsigned char* ON = lds + 62464;
    float* sc = (float*)(lds + 79872);
    float* SS = (float*)(lds + 79872 + 2048);
    const int cp = lane, lg = wave;
    unsigned (&xq)[11] = R.xq; unsigned (&xk)[11] = R.xk; unsigned (&v)[8] = R.v; unsigned (&ov)[8] = R.ov;
    bf16x8 Cf[4]; f32x4 dnv[4];
    { const bf16_t* ct = (const bf16_t*)(a.ws + WS_CT) + (size_t)item * 128 * 128; const float* dn = (const float*)(a.ws + WS_DN) + (size_t)item * 128;
#pragma unroll
      for (int ks = 0; ks < 4; ++ks) Cf[ks] = *(const bf16x8*)(ct + (wave * 16 + fr) * 128 + ks * 32 + 8 * fq);
#pragma unroll
      for (int j = 0; j < 4; ++j) dnv[j] = *(const f32x4*)(dn + (tid & 7) * 16 + 4 * j); }
    const float gm = a.in[I_GMH][(size_t)l * DM + h * DH + wave * 16 + fr];
    if (hw != h) { const float* wc = a.in[I_WCQK] + (size_t)l * 4 * 1024; const float* bc = a.in[I_BCQK] + (size_t)l * 1024;
        conv_loadw(wc, bc, ZQ + h * DH + 2 * cp, cwq); conv_loadw(wc, bc, ZK + h * DH + 2 * cp, cwk); hw = h; }
    if (tid < 64) {
        const float mprev = R.mprev;
        chunk_gates_r(sc, R.gi, R.gf, lane);
        float g = sc[64 + lane] - sc[lane];
#pragma unroll
        for (int o = 1; o < 64; o <<= 1) { const float n = __shfl_up(g, o); if (lane >= o) g = fmaxf(g, n); }
        const float mrow = sc[lane] + fmaxf(mprev, g);
        sc[128 + lane] = mrow; sc[192 + lane] = __expf(sc[lane] + mprev - mrow);
    }
    {
        float qq[8][2];
        conv_apply(xq, cwq, qq);
#pragma unroll
        for (int i = 0; i < 8; ++i) *(unsigned*)(QN + (8 * lg + i) * 272 + cp * 4) = pk2(siluf_(qq[i][0]) * 0.08838834764831845f, siluf_(qq[i][1]) * 0.08838834764831845f);
        conv_apply(xk, cwk, qq);
#pragma unroll
        for (int i = 0; i < 8; ++i) *(unsigned*)(KN + (8 * lg + i) * 272 + cp * 4) = pk2(siluf_(qq[i][0]), siluf_(qq[i][1]));
        u32x4 p0, p1;
#pragma unroll
        for (int i = 0; i < 4; ++i) { p0[i] = (v[2 * i] & 0xffffu) | (v[2 * i + 1] << 16); p1[i] = (v[2 * i] >> 16) | (v[2 * i + 1] & 0xffff0000u); }
        *(u32x4*)(VT + (2 * cp) * 144 + lg * 16) = p0; *(u32x4*)(VT + (2 * cp + 1) * 144 + lg * 16) = p1;
#pragma unroll
        for (int i = 0; i < 8; ++i) *(unsigned*)(ON + (8 * lg + i) * 272 + cp * 4) = ov[i];
    }
    LDS_BARRIER();
    {
        const int ll = tid >> 3, part = tid & 7; float s_ = 0.f;
#pragma unroll
        for (int j = 0; j < 4; ++j) { const u32x2 qv = *(const u32x2*)(QN + ll * 272 + (part * 16 + 4 * j) * 2);
            s_ += bf2f(qv.x & 0xffffu) * dnv[j].x + __uint_as_float(qv.x & 0xffff0000u) * dnv[j].y + bf2f(qv.y & 0xffffu) * dnv[j].z + __uint_as_float(qv.y & 0xffff0000u) * dnv[j].w; }
        s_ = sum8(s_);
        if (part == 0) sc[384 + ll] = s_;
    }
    {
        const int lt = wave & 3; const int ll = lt * 16 + fr; const float bl_ = sc[ll], mr = sc[128 + ll]; float dsum = 0.f;
#pragma unroll
        for (int mi = 0; mi < 2; ++mi) {
            const int mt = 2 * (wave >> 2) + mi; u32x2 pk = {0u, 0u};
            if (mt <= lt) {
                f32x4 acc = {0.f, 0.f, 0.f, 0.f};
#pragma unroll
                for (int ks = 0; ks < 4; ++ks) { const bf16x8 A = *(const bf16x8*)(KN + (mt * 16 + fr) * 272 + (ks * 32 + 8 * fq) * 2), B = *(const bf16x8*)(QN + (lt * 16 + fr) * 272 + (ks * 32 + 8 * fq) * 2);
                    acc = mfma16(A, B, acc); }
                float sv[4];
#pragma unroll
                for (int r = 0; r < 4; ++r) { const int mm = mt * 16 + 4 * fq + r; const float wgt = (mm <= ll) ? __expf(bl_ - sc[mm] + sc[64 + mm] - mr) : 0.f; sv[r] = acc[r] * wgt; dsum += sv[r]; }
                pk.x = pk2(sv[0], sv[1]); pk.y = pk2(sv[2], sv[3]);
            }
            *(u32x2*)(SP + ll * 144 + (mt * 16 + 4 * fq) * 2) = pk;
        }
        dsum += __shfl_xor(dsum, 16); dsum += __shfl_xor(dsum, 32);
        if (fq == 0) sc[256 + (wave >> 2) * 64 + ll] = dsum;
    }
    LDS_BARRIER();
    if (tid < 64) { const float den = sc[256 + tid] + sc[320 + tid] + sc[192 + tid] * sc[384 + tid]; sc[448 + tid] = fmaxf(fabsf(den), __expf(-sc[128 + tid])); }
    f32x4 acc1[4], acc2[4];
    {
        bf16x8 Vf[2];
#pragma unroll
        for (int ks = 0; ks < 2; ++ks) Vf[ks] = *(const bf16x8*)(VT + (wave * 16 + fr) * 144 + (ks * 32 + 8 * fq) * 2);
#pragma unroll
        for (int lt = 0; lt < 4; ++lt) {
            acc1[lt] = (f32x4){0.f, 0.f, 0.f, 0.f}; acc2[lt] = (f32x4){0.f, 0.f, 0.f, 0.f};
#pragma unroll
            for (int ks = 0; ks < 2; ++ks) acc1[lt] = mfma16(*(const bf16x8*)(SP + (lt * 16 + fr) * 144 + (ks * 32 + 8 * fq) * 2), Vf[ks], acc1[lt]);
#pragma unroll
            for (int ks = 0; ks < 4; ++ks) acc2[lt] = mfma16(*(const bf16x8*)(QN + (lt * 16 + fr) * 272 + (ks * 32 + 8 * fq) * 2), Cf[ks], acc2[lt]);
        }
    }
    LDS_BARRIER();
    float hm[4][4];
#pragma unroll
    for (int lt = 0; lt < 4; ++lt)
#pragma unroll
        for (int r = 0; r < 4; ++r) { const int ll = lt * 16 + 4 * fq + r;
            const float hv = (acc1[lt][r] + sc[192 + ll] * acc2[lt][r]) * frcp(sc[448 + ll]);
            const float o = sigmoidf_(bf2f(*(const bf16_t*)(ON + ll * 272 + (wave * 16 + fr) * 2)));
            hm[lt][r] = hv * o;
            const float q = sum16(hm[lt][r] * hm[lt][r]);
            if (fr == 0) SS[wave * 64 + ll] = q; }
    LDS_BARRIER();
    {
        unsigned char* HM = QN;
#pragma unroll
        for (int lt = 0; lt < 4; ++lt)
#pragma unroll
            for (int r = 0; r < 4; ++r) { const int ll = lt * 16 + 4 * fq + r; float tot = 0.f;
#pragma unroll
                for (int w = 0; w < 8; ++w) tot += SS[w * 64 + ll];
                *(bf16_t*)(HM + ll * 272 + (wave * 16 + fr) * 2) = (bf16_t)f2bf(hm[lt][r] * rsqrtf(tot * (1.f / 128.f) + EPS) * gm); }
        LDS_BARRIER();
        bf16_t* mix = (bf16_t*)(a.ws + WS_MIX);
#pragma unroll
        for (int j = 0; j < 2; ++j) { const int pc = tid + j * NT, ll = pc >> 4, q16 = pc & 15;
            *(u32x4*)(mix + (size_t)(row0 + ll) * D + h * DH + q16 * 8) = *(const u32x4*)(HM + ll * 272 + q16 * 16); }
    }
    LDS_BARRIER();
}

template <int MODE>
__device__ __forceinline__ void rglru_item(const Args& a, unsigned char* lds, int l, int item) {
    const int b = item >> 6, c = item & 63, row0 = b * SEQ + c * CH, ch = otid(), lane = ch & 63, nb = ch >> 6;
    float* xs = (float*)lds + nb * 64 * 64;
    const bf16_t* z = (const bf16_t*)(a.ws + WS_Z);
    const float* wcr = a.in[I_WCR] + (size_t)l * 4 * DR; const float bcr = a.in[I_BCR][l * DR + ch];
    const float w0 = wcr[ch], w1 = wcr[DR + ch], w2 = wcr[2 * DR + ch], w3 = wcr[3 * DR + ch];
    const bf16_t* zc = z + ZXR + ch;
    float xm3 = 0.f, xm2 = 0.f, xm1 = 0.f;
    { const int s0 = c * CH; if (s0 >= 3) { xm3 = bf2f(zc[(size_t)(row0 - 3) * ZW]); xm2 = bf2f(zc[(size_t)(row0 - 2) * ZW]); xm1 = bf2f(zc[(size_t)(row0 - 1) * ZW]); } }
#pragma unroll 4
    for (int t = 0; t < 64; ++t) { const float x0 = bf2f(zc[(size_t)(row0 + t) * ZW]);
        xs[t * 64 + lane] = bcr + w0 * xm3 + w1 * xm2 + w2 * xm1 + w3 * x0; xm3 = xm2; xm2 = xm1; xm1 = x0; }
    unsigned wa[32], wx[32];
    const float* wra = a.in[I_WRA] + ((size_t)(l * NBR + nb) * 64) * 64 + lane; const float* wri = a.in[I_WRI] + ((size_t)(l * NBR + nb) * 64) * 64 + lane;
#pragma unroll
    for (int d = 0; d < 32; ++d) { wa[d] = pk2(wra[(2 * d) * 64], wra[(2 * d + 1) * 64]); wx[d] = pk2(wri[(2 * d) * 64], wri[(2 * d + 1) * 64]); }
    const float ba = a.in[I_BRA][l * DR + ch], bx = a.in[I_BRI][l * DR + ch];
    const float lam = a.in[I_LAM][l * DR + ch];
    const float sp = fmaxf(-lam, 0.f) + log1pf(__expf(-fabsf(lam)));
    float hst = 0.f, ap = 1.f;
    if (MODE == 1) hst = ((const float*)(a.ws + WS_SMALL + SM_RGP))[(size_t)item * DR + ch];
    const float gr = a.in[I_GR][l * DR + ch];
    bf16_t* mix = (bf16_t*)(a.ws + WS_MIX);
    __syncthreads();
#pragma unroll 1
    for (int t = 0; t < 64; ++t) {
        float ra = ba, ia = bx;
#pragma unroll
        for (int d4 = 0; d4 < 16; ++d4) { const f32x4 xv = *(const f32x4*)(xs + t * 64 + 4 * d4);
#pragma unroll
            for (int q = 0; q < 2; ++q) { const unsigned pa = wa[2 * d4 + q], px = wx[2 * d4 + q];
                ra += xv[2 * q] * __uint_as_float(pa << 16) + xv[2 * q + 1] * __uint_as_float(pa & 0xffff0000u);
                ia += xv[2 * q] * __uint_as_float(px << 16) + xv[2 * q + 1] * __uint_as_float(px & 0xffff0000u); } }
        const float xo = xs[t * 64 + lane];
        const float r = sigmoidf_(ra), ig = sigmoidf_(ia), la = -8.f * r * sp, av = __expf(la);
        const float uu = sqrtf(-expm1f(2.f * la)) * (ig * xo);
        hst = av * hst + uu; ap *= av;
        if (MODE == 1) {
            const float y = bf2f(z[(size_t)(row0 + t) * ZW + ZYR + ch]);
            const float o = hst * gelu_tanh(y);
            const float rs = rsqrtf(wave_sum(o * o) * (1.f / 64.f) + EPS);
            mix[(size_t)(row0 + t) * D + DM + ch] = (bf16_t)f2bf(o * rs * gr);
        }
    }
    if (MODE == 0) { ((float*)(a.ws + WS_SMALL + SM_RGA))[(size_t)item * DR + ch] = ap; ((float*)(a.ws + WS_SMALL + SM_RGH))[(size_t)item * DR + ch] = hst; }
    __syncthreads();
}

template <int MODE>
__device__ __forceinline__ void rglru_fast(const Args& a, unsigned char* lds, int l, int item) {
    const int b = item >> 6, c = item & 63, row0 = b * SEQ + c * CH, ch = otid(), lane = ch & 63, nb = ch >> 6, fr = lane & 15, fq = lane >> 4;
    unsigned char* XA = lds + nb * 9216;
    float* GS = (float*)(lds + 73728 + nb * 8448);
    const bf16_t* z = (const bf16_t*)(a.ws + WS_Z);
    unsigned ypk[32];
    {
        const float* wcr = a.in[I_WCR] + (size_t)l * 4 * DR; const float bcr = a.in[I_BCR][l * DR + ch];
        const float w0 = wcr[ch], w1 = wcr[DR + ch], w2 = wcr[2 * DR + ch], w3 = wcr[3 * DR + ch];
        const bf16_t* zc = z + ZXR + ch;
        bf16_t xin[67];
#pragma unroll
        for (int t = 0; t < 67; ++t) xin[t] = (c == 0 && t < 3) ? (bf16_t)0 : zc[(ptrdiff_t)(row0 + t - 3) * ZW];
        if (MODE == 1) {
            bf16_t yb[64];
#pragma unroll
            for (int t = 0; t < 64; ++t) yb[t] = z[(size_t)(row0 + t) * ZW + ZYR + ch];
#pragma unroll
            for (int t = 0; t < 32; ++t) ypk[t] = (unsigned)yb[2 * t] | ((unsigned)yb[2 * t + 1] << 16);
        }
#pragma unroll
        for (int t = 0; t < 64; ++t)
            *(bf16_t*)(XA + t * 144 + lane * 2) = (bf16_t)f2bf(bcr + w0 * bf2f(xin[t]) + w1 * bf2f(xin[t + 1]) + w2 * bf2f(xin[t + 2]) + w3 * bf2f(xin[t + 3]));
    }
    bf16x8 Bf[8][2];
    { const bf16_t* wt = (const bf16_t*)(a.ws + WS_SMALL + SM_RGW) + (size_t)((l * NBR + nb) * 2) * 64 * 64;
#pragma unroll
        for (int ct = 0; ct < 8; ++ct)
#pragma unroll
            for (int ks = 0; ks < 2; ++ks) Bf[ct][ks] = *(const bf16x8*)(wt + (size_t)((ct >> 2) * 64 + (ct & 3) * 16 + fr) * 64 + ks * 32 + 8 * fq); }
    const float ba = a.in[I_BRA][l * DR + ch], bx = a.in[I_BRI][l * DR + ch];
    const float lam = a.in[I_LAM][l * DR + ch];
    const float sp8 = -8.f * (fmaxf(-lam, 0.f) + log1pf(__expf(-fabsf(lam))));
    float hst = 0.f, ap = 1.f;
    if (MODE == 1) hst = ((const float*)(a.ws + WS_SMALL + SM_RGP))[(size_t)item * DR + ch];
    const float gr = a.in[I_GR][l * DR + ch];
    bf16_t* mix = (bf16_t*)(a.ws + WS_MIX);
    WAVE_LDS_SYNC();
#pragma unroll
    for (int rt = 0; rt < 4; ++rt) {
        bf16x8 Af[2];
#pragma unroll
        for (int ks = 0; ks < 2; ++ks) Af[ks] = *(const bf16x8*)(XA + (rt * 16 + fr) * 144 + (ks * 32 + 8 * fq) * 2);
#pragma unroll
        for (int ct = 0; ct < 8; ++ct) {
            f32x4 acc = {0.f, 0.f, 0.f, 0.f};
            acc = mfma16(Af[0], Bf[ct][0], acc); acc = mfma16(Af[1], Bf[ct][1], acc);
#pragma unroll
            for (int r = 0; r < 4; ++r) GS[(4 * fq + r) * 132 + (ct >> 2) * 64 + (ct & 3) * 16 + fr] = acc[r];
        }
        WAVE_LDS_SYNC();
        {
            float ra[16], ia[16], xo[16], ov_[16];
#pragma unroll
            for (int tt = 0; tt < 16; ++tt) { ra[tt] = GS[tt * 132 + lane]; ia[tt] = GS[tt * 132 + 64 + lane]; xo[tt] = bf2f(*(const bf16_t*)(XA + (rt * 16 + tt) * 144 + lane * 2)); }
#pragma unroll
            for (int tt = 0; tt < 16; ++tt) {
                const float r = sigmoidf_(ra[tt] + ba), ig = sigmoidf_(ia[tt] + bx), la = sp8 * r, av = __expf(la);
                const float uu = __builtin_amdgcn_sqrtf(fmaxf(fmaf(-av, av, 1.f), 0.f)) * (ig * xo[tt]);
                hst = av * hst + uu; ap *= av;
                ov_[tt] = hst;
            }
            if (MODE == 1) {
#pragma unroll
                for (int tt = 0; tt < 16; ++tt) *(bf16_t*)(XA + (rt * 16 + tt) * 144 + lane * 2) = (bf16_t)f2bf(ov_[tt] * gelu_tanh((tt & 1) ? __uint_as_float(ypk[rt * 8 + (tt >> 1)] & 0xffff0000u) : bf2f(ypk[rt * 8 + (tt >> 1)] & 0xffffu)));
            }
        }
        WAVE_LDS_SYNC();
    }
    if (MODE == 1) {
        float ss = 0.f;
#pragma unroll
        for (int j = 0; j < 8; ++j) { const u32x4 v = *(const u32x4*)(XA + lane * 144 + j * 16);
#pragma unroll
            for (int q = 0; q < 4; ++q) { const float lo = bf2f(v[q] & 0xffffu), hi = __uint_as_float(v[q] & 0xffff0000u); ss += lo * lo + hi * hi; } }
        const float rs = rsqrtf(ss * (1.f / 64.f) + EPS) ;
#pragma unroll
        for (int t0 = 0; t0 < 64; t0 += 16) { float ovv[16];
#pragma unroll
            for (int tt = 0; tt < 16; ++tt) ovv[tt] = bf2f(*(const bf16_t*)(XA + (t0 + tt) * 144 + lane * 2));
#pragma unroll
            for (int tt = 0; tt < 16; ++tt) { const float rst = __int_as_float(__builtin_amdgcn_readlane(__float_as_int(rs), t0 + tt));
                *(bf16_t*)(XA + (t0 + tt) * 144 + lane * 2) = (bf16_t)f2bf(ovv[tt] * rst * gr); } }
        WAVE_LDS_SYNC();
#pragma unroll
        for (int j = 0; j < 8; ++j) { const int t = j * 8 + (lane >> 3), q16 = lane & 7;
            *(u32x4*)(mix + (size_t)(row0 + t) * D + DM + nb * 64 + q16 * 8) = *(const u32x4*)(XA + t * 144 + q16 * 16); }
    }
    if (MODE == 0) { ((float*)(a.ws + WS_SMALL + SM_RGA))[(size_t)item * DR + ch] = ap; ((float*)(a.ws + WS_SMALL + SM_RGH))[(size_t)item * DR + ch] = hst; }
    LDS_BARRIER();
}
__device__ __forceinline__ void rglru_scan(const Args& a, int G) {
    const int tid = otid();
    for (int i = blockIdx.x * 8 + (tid & 7); i < NBATCH * DR && tid < 8; i += G * 8) {
        const int b = i / DR, ch = i % DR;
        const float* A_ = (const float*)(a.ws + WS_SMALL + SM_RGA) + (size_t)(b * NC) * DR + ch; const float* H_ = (const float*)(a.ws + WS_SMALL + SM_RGH) + (size_t)(b * NC) * DR + ch;
        float* P_ = (float*)(a.ws + WS_SMALL + SM_RGP) + (size_t)(b * NC) * DR + ch;
        float hs = 0.f;
#pragma unroll 1
        for (int c0 = 0; c0 < NC; c0 += 16) {
            float av[16], hv[16];
#pragma unroll
            for (int j = 0; j < 16; ++j) { av[j] = A_[(c0 + j) * DR]; hv[j] = H_[(c0 + j) * DR]; }
#pragma unroll
            for (int j = 0; j < 16; ++j) { P_[(c0 + j) * DR] = hs; hs = av[j] * hs + hv[j]; }
        }
    }
}

__device__ __forceinline__ void phase_route(const Args& a, unsigned char* lds) {
    unsigned* wtot = (unsigned*)lds;
    int* pre = (int*)(lds + 256);
    int* tot = pre + 8;
    int* ce = tot + 16;
    unsigned* pref = (unsigned*)(lds + 2048);
    const int tid = otid(), lane = tid & 63, wave = tid >> 6, G = gridDim.x;
    const unsigned char* tok_p = (const unsigned char*)(a.ws + WS_SMALL + SM_TOKP); const float* tok_g = (const float*)(a.ws + WS_SMALL + SM_TOKG);
    int* row_tok = (int*)(a.ws + WS_SMALL + SM_ROWTOK); float* row_gate = (float*)(a.ws + WS_SMALL + SM_ROWGATE); int* tile_e = (int*)(a.ws + WS_SMALL + SM_TILEE);
    if (tid < 256) {
        unsigned long long hh = 0ull;
#pragma unroll
        for (int j = 0; j < 4; ++j) { const u32x4 v = ((const u32x4*)(tok_p + tid * 64))[j];
#pragma unroll
            for (int q = 0; q < 4; ++q)
#pragma unroll
                for (int bb = 0; bb < 4; ++bb) { const unsigned by = (v[q] >> (8 * bb)) & 0xffu; hh += (1ull << (8 * (by & 15u))) + (1ull << (8 * (by >> 4))); } }
        unsigned w[4];
#pragma unroll
        for (int i = 0; i < 4; ++i) { const unsigned two = (unsigned)(hh >> (16 * i)) & 0xffffu; w[i] = (two & 0xffu) | ((two >> 8) << 16); }
        unsigned inc[4];
#pragma unroll
        for (int i = 0; i < 4; ++i) { unsigned x = w[i];
#pragma unroll
            for (int o = 1; o < 64; o <<= 1) { const unsigned n = __shfl_up(x, o); if (lane >= o) x += n; }
            inc[i] = x; }
        if (lane == 63) {
#pragma unroll
            for (int i = 0; i < 4; ++i) wtot[wave * 4 + i] = inc[i]; }
        __builtin_amdgcn_s_waitcnt(0);
        __builtin_amdgcn_s_barrier();
#pragma unroll
        for (int i = 0; i < 4; ++i) { unsigned base = 0u;
            for (int ww = 0; ww < wave; ++ww) base += wtot[ww * 4 + i];
            pref[tid * 4 + i] = base + inc[i] - w[i];
            if (tid == 255) { const unsigned t2 = base + inc[i]; tot[2 * i] = (int)(t2 & 0xffffu); tot[2 * i + 1] = (int)(t2 >> 16); } }
    } else {
        __builtin_amdgcn_s_barrier();
    }
    __syncthreads();
    if (tid == 0) { int s_ = 0; for (int e = 0; e < 8; ++e) { tot[8 + e] = s_; s_ += (tot[e] + 255) & ~255; }
        if (blockIdx.x == 0) { int t = 0; for (int e = 0; e < 8; ++e) { const int n = (tot[e] + 255) >> 8; for (int j = 0; j < n; ++j) tile_e[t++] = e; } tile_e[255] = t; } }
    __syncthreads();
    for (int ck = blockIdx.x; ck < 256; ck += G) {
        if (tid < 128) { const unsigned by = tok_p[ck * 64 + (tid >> 1)]; ce[tid] = (tid & 1) ? (int)(by >> 4) : (int)(by & 15u); }
        __syncthreads();
        if (tid < 128) { const int e = ce[tid];
            int rank = 0, w0cnt = 0;
#pragma unroll
            for (int q = 0; q < 8; ++q) { const unsigned long long mk = __ballot(e == q); if (e == q) rank = __popcll(mk & ((1ull << lane) - 1ull)); if (wave == 0 && lane == 0) ce[128 + q] = __popcll(mk); }
            __builtin_amdgcn_s_waitcnt(0);
            asm volatile("s_barrier" ::: "memory");
            if (wave == 1) rank += ce[128 + e];
            (void)w0cnt;
            const unsigned pw = pref[ck * 4 + (e >> 1)]; const int pr = (int)((e & 1) ? (pw >> 16) : (pw & 0xffffu));
            const int dest = tot[8 + e] + pr + rank;
            row_tok[dest] = ck * 64 + (tid >> 1); row_gate[dest] = tok_g[ck * 128 + tid]; ((int*)(a.ws + WS_SMALL + SM_ROWSLOT))[dest] = tid & 1; }
        else { asm volatile("s_barrier" ::: "memory"); }
        __syncthreads();
    }
}

#ifndef GEMM
#define GEMM gemm_fast
#endif
__global__ void __launch_bounds__(NT, 2) mk_fwd(Args a0) {
    extern __shared__ __attribute__((aligned(16))) unsigned char lds[];
    const int G = gridDim.x, bid = blockIdx.x, ph_lo = a0.ph_lo, ph_hi = a0.ph_hi;
    volatile LAS unsigned* xst = (volatile LAS unsigned*)(lds + LDS_BYTES - 64);
    if (threadIdx.x < 2) xst[threadIdx.x] = 0u;
    __syncthreads();
    const XcdBarrier xb = xcd_barrier_post((unsigned*)(a0.ws + WS_SMALL + SM_BAR), xst);
    int ph = 0;
#ifndef PROBE_CAT
#define PROBE_CAT 0
#define PROBE_N 1
#endif
#define PHASE_BEGIN(cat) if (ph >= ph_lo && ph < ph_hi) { for (int rep_ = 0; rep_ < ((cat) == PROBE_CAT ? PROBE_N : 1); ++rep_) { const bool lastrep = (rep_ + 1 == ((cat) == PROBE_CAT ? PROBE_N : 1)); (void)lastrep; const Args& a = *(const Args*)okarg(); unsigned char* const ws = a.ws; \
    bf16_t* const hn = (bf16_t*)(ws + WS_HN); bf16_t* const z = (bf16_t*)(ws + WS_Z); bf16_t* const mix = (bf16_t*)(ws + WS_MIX); bf16_t* const hid = (bf16_t*)(ws + WS_HID); \
    float* const gates = (float*)(ws + WS_SMALL + SM_GATES); int* const tok_e = (int*)(ws + WS_SMALL + SM_TOKP); float* const tok_g = (float*)(ws + WS_SMALL + SM_TOKG); \
    const int* const row_tok = (const int*)(ws + WS_SMALL + SM_ROWTOK); const float* const row_gate = (const float*)(ws + WS_SMALL + SM_ROWGATE); const int* const tile_e = (const int*)(ws + WS_SMALL + SM_TILEE); \
    (void)hn; (void)z; (void)mix; (void)hid; (void)gates; (void)tok_e; (void)tok_g; (void)row_tok; (void)row_gate; (void)tile_e;
#define PHASE_END(dosync) } for (int rep_ = 0; rep_ < (PROBE_CAT == 6 ? PROBE_N : 1); ++rep_) if ((dosync) && ph + 1 < ph_hi) { xcd_barrier(xb); } } ++ph;

    PHASE_BEGIN(1) phase_prologue(a, lds); __syncthreads();
        phase_rowpass<1, false>(lds, a.in[I_X], a.in[I_GMIX], hn, a.in[I_WIN] + 2048, DIN, a.in[I_BIN] + 2048, gates, nullptr, nullptr, nullptr); PHASE_END(true)
    { constexpr int l = 0;
        if (l == 1) PHASE_BEGIN(2) const float* hsrc = a.out; phase_rowpass<1, false>(lds, hsrc, a.in[I_GMIX] + l * D, hn, a.in[I_WIN] + (size_t)l * D * DIN + 2048, DIN, a.in[I_BIN] + l * DIN + 2048, gates, nullptr, nullptr, nullptr); PHASE_END(true)
        PHASE_BEGIN(3) { GridOrder S{M / 256, ZW / 256, G, bid}; EpiZ E{z, a.in[I_BIN] + l * DIN};
            GEMM(lds, hn, (const bf16_t*)(ws + WS_W_IN) + (size_t)l * ZW * D, D, S, E); } PHASE_END(true)
        PHASE_BEGIN(4) { MlRegs cur, nxt; int it = bid; if (it < 1024) ml_load(a, l, it, cur); nxt = cur;
            for (; it < 1024; it += G) { if (it + G < 1024) ml_load(a, l, it + G, nxt); ml_compute(a, lds, l, it, cur); cur = nxt; }
            for (; it < 1280; it += G) rglru_fast<0>(a, lds, l, it - 1024); } PHASE_END(true)
        PHASE_BEGIN(0) mlstm_scan(a, G); rglru_scan(a, G); PHASE_END(true)
        PHASE_BEGIN(5) { MoRegs cur, nxt; ConvW cwq, cwk; int hw = -1; int it = bid; if (it < 1024) mo_load(a, l, it, cur); nxt = cur;
            for (; it < 1024; it += G) { if (it + G < 1024) mo_load(a, l, it + G, nxt); mo_compute(a, lds, l, it, cur, cwq, cwk, hw); cur = nxt; }
            for (; it < 1280; it += G) rglru_fast<1>(a, lds, l, it - 1024); } PHASE_END(true)
        PHASE_BEGIN(7) { GridOrder S{M / 256, D / 256, G, bid}; const float* hsrc = l == 0 ? a.in[I_X] : a.out; EpiResid E{hsrc, lastrep ? a.out : (float*)(ws + WS_Z)};
            GEMM(lds, mix, (const bf16_t*)(ws + WS_W_OUT) + (size_t)l * D * D, D, S, E); } PHASE_END(true)
        if (l == 0) {
            PHASE_BEGIN(2) phase_rowpass<0, false>(lds, a.out, a.in[I_GFFN] + l * D, hn, nullptr, 0, nullptr, nullptr, nullptr, nullptr, nullptr); PHASE_END(true)
            PHASE_BEGIN(3) { GridOrder S{M / 256, 2 * DFF / 256, G, bid}; EpiSwiglu E{hid};
                GEMM(lds, hn, (const bf16_t*)(ws + WS_W_FFGU), D, S, E);
                { constexpr int nun = (M / 256) * (2 * DFF / 256); const int first = nun % G;
                  TailOrder S2{M / 256, D / 256, G, bid, first}; EpiStoreBf16 E2{(bf16_t*)(ws + WS_PP0)};
                  GEMM(lds, (const bf16_t*)(ws + WS_PB), (const bf16_t*)(ws + WS_W_PP), DPLE, S2, E2); } } PHASE_END(true)
            PHASE_BEGIN(8) { GridOrder S{M / 256, D / 256, G, bid}; EpiResid E{a.out, lastrep ? a.out : (float*)(ws + WS_RF + 96 * MiB)};
                GEMM(lds, hid, (const bf16_t*)(ws + WS_W_FFD), DFF, S, E); } PHASE_END(true)
        } else {
            PHASE_BEGIN(2) phase_rowpass<2, false>(lds, a.out, a.in[I_GFFN] + l * D, hn, a.in[I_WROUTER], 8, nullptr, nullptr, tok_e, tok_g, nullptr); PHASE_END(true)
            PHASE_BEGIN(12) phase_route(a, lds); PHASE_END(true)
            PHASE_BEGIN(3) { MoeOrder<true> S{tile_e[255], 2 * DFF / 256, G, bid, tile_e, row_tok, (size_t)5632 * D}; EpiSwiglu E{hid};
                GEMM(lds, hn, (const bf16_t*)(ws + WS_W_EGU), D, S, E); } PHASE_END(true)
            PHASE_BEGIN(9) { MoeOrder<false> S{tile_e[255], D / 256, G, bid, tile_e, nullptr, (size_t)D * DFF}; EpiMoeDown E{lastrep ? a.out : (float*)(ws + WS_RF + 188 * MiB), lastrep ? hn : (bf16_t*)(ws + WS_RF + 204 * MiB), row_tok, (const int*)(ws + WS_SMALL + SM_ROWSLOT), row_gate, lastrep ? 0x7fffffff : 2047};
                GEMM(lds, hid, (const bf16_t*)(ws + WS_W_ED), DFF, S, E); }
                { const int nun = tile_e[255] * (D / 256); const int first = nun > 2 * G ? nun - 2 * G : 0;
                  TailOrder S2{M / 256, D / 256, G, bid, first < G ? first : 0}; EpiStoreBf16 E2{(bf16_t*)(ws + WS_PP1)};
                  GEMM(lds, (const bf16_t*)(ws + WS_PB) + (size_t)M * DPLE, (const bf16_t*)(ws + WS_W_PP) + (size_t)D * DPLE, DPLE, S2, E2); } PHASE_END(true)
        }
        PHASE_BEGIN(l == 1 ? 13 : 2) phase_rowpass<0, false, (l == 1)>(lds, a.out, a.in[I_GPLE] + l * D, hn, nullptr, 0, nullptr, nullptr, nullptr, nullptr, nullptr); PHASE_END(true)
        PHASE_BEGIN(10) { GridOrder S{M / 256, D / 256, G, bid};
            EpiPle E{lastrep ? a.out : (float*)(ws + WS_RF + 64 * MiB), (const bf16_t*)(ws + (l == 0 ? WS_PP0 : WS_PP1))}; GEMM(lds, hn, (const bf16_t*)(ws + WS_W_PG) + (size_t)l * D * D, D, S, E); } PHASE_END(true)
        }
    { constexpr int l = 1;
        if (l == 1) PHASE_BEGIN(2) const float* hsrc = a.out; phase_rowpass<1, false>(lds, hsrc, a.in[I_GMIX] + l * D, hn, a.in[I_WIN] + (size_t)l * D * DIN + 2048, DIN, a.in[I_BIN] + l * DIN + 2048, gates, nullptr, nullptr, nullptr); PHASE_END(true)
        PHASE_BEGIN(3) { GridOrder S{M / 256, ZW / 256, G, bid}; EpiZ E{z, a.in[I_BIN] + l * DIN};
            GEMM(lds, hn, (const bf16_t*)(ws + WS_W_IN) + (size_t)l * ZW * D, D, S, E); } PHASE_END(true)
        PHASE_BEGIN(4) { MlRegs cur, nxt; int it = bid; if (it < 1024) ml_load(a, l, it, cur); nxt = cur;
            for (; it < 1024; it += G) { if (it + G < 1024) ml_load(a, l, it + G, nxt); ml_compute(a, lds, l, it, cur); cur = nxt; }
            for (; it < 1280; it += G) rglru_fast<0>(a, lds, l, it - 1024); } PHASE_END(true)
        PHASE_BEGIN(0) mlstm_scan(a, G); rglru_scan(a, G); PHASE_END(true)
        PHASE_BEGIN(5) { MoRegs cur, nxt; ConvW cwq, cwk; int hw = -1; int it = bid; if (it < 1024) mo_load(a, l, it, cur); nxt = cur;
            for (; it < 1024; it += G) { if (it + G < 1024) mo_load(a, l, it + G, nxt); mo_compute(a, lds, l, it, cur, cwq, cwk, hw); cur = nxt; }
            for (; it < 1280; it += G) rglru_fast<1>(a, lds, l, it - 1024); } PHASE_END(true)
        PHASE_BEGIN(7) { GridOrder S{M / 256, D / 256, G, bid}; const float* hsrc = l == 0 ? a.in[I_X] : a.out; EpiResid E{hsrc, lastrep ? a.out : (float*)(ws + WS_Z)};
            GEMM(lds, mix, (const bf16_t*)(ws + WS_W_OUT) + (size_t)l * D * D, D, S, E); } PHASE_END(true)
        if (l == 0) {
            PHASE_BEGIN(2) phase_rowpass<0, false>(lds, a.out, a.in[I_GFFN] + l * D, hn, nullptr, 0, nullptr, nullptr, nullptr, nullptr, nullptr); PHASE_END(true)
            PHASE_BEGIN(3) { GridOrder S{M / 256, 2 * DFF / 256, G, bid}; EpiSwiglu E{hid};
                GEMM(lds, hn, (const bf16_t*)(ws + WS_W_FFGU), D, S, E);
                { constexpr int nun = (M / 256) * (2 * DFF / 256); const int first = nun % G;
                  TailOrder S2{M / 256, D / 256, G, bid, first}; EpiStoreBf16 E2{(bf16_t*)(ws + WS_PP0)};
                  GEMM(lds, (const bf16_t*)(ws + WS_PB), (const bf16_t*)(ws + WS_W_PP), DPLE, S2, E2); } } PHASE_END(true)
            PHASE_BEGIN(8) { GridOrder S{M / 256, D / 256, G, bid}; EpiResid E{a.out, lastrep ? a.out : (float*)(ws + WS_RF + 96 * MiB)};
                GEMM(lds, hid, (const bf16_t*)(ws + WS_W_FFD), DFF, S, E); } PHASE_END(true)
        } else {
            PHASE_BEGIN(2) phase_rowpass<2, false>(lds, a.out, a.in[I_GFFN] + l * D, hn, a.in[I_WROUTER], 8, nullptr, nullptr, tok_e, tok_g, nullptr); PHASE_END(true)
            PHASE_BEGIN(12) phase_route(a, lds); PHASE_END(true)
            PHASE_BEGIN(3) { MoeOrder<true> S{tile_e[255], 2 * DFF / 256, G, bid, tile_e, row_tok, (size_t)5632 * D}; EpiSwiglu E{hid};
                GEMM(lds, hn, (const bf16_t*)(ws + WS_W_EGU), D, S, E); } PHASE_END(true)
            PHASE_BEGIN(9) { MoeOrder<false> S{tile_e[255], D / 256, G, bid, tile_e, nullptr, (size_t)D * DFF}; EpiMoeDown E{lastrep ? a.out : (float*)(ws + WS_RF + 188 * MiB), lastrep ? hn : (bf16_t*)(ws + WS_RF + 204 * MiB), row_tok, (const int*)(ws + WS_SMALL + SM_ROWSLOT), row_gate, lastrep ? 0x7fffffff : 2047};
                GEMM(lds, hid, (const bf16_t*)(ws + WS_W_ED), DFF, S, E); }
                { const int nun = tile_e[255] * (D / 256); const int first = nun > 2 * G ? nun - 2 * G : 0;
                  TailOrder S2{M / 256, D / 256, G, bid, first < G ? first : 0}; EpiStoreBf16 E2{(bf16_t*)(ws + WS_PP1)};
                  GEMM(lds, (const bf16_t*)(ws + WS_PB) + (size_t)M * DPLE, (const bf16_t*)(ws + WS_W_PP) + (size_t)D * DPLE, DPLE, S2, E2); } PHASE_END(true)
        }
        PHASE_BEGIN(l == 1 ? 13 : 2) phase_rowpass<0, false, (l == 1)>(lds, a.out, a.in[I_GPLE] + l * D, hn, nullptr, 0, nullptr, nullptr, nullptr, nullptr, nullptr); PHASE_END(true)
        PHASE_BEGIN(10) { GridOrder S{M / 256, D / 256, G, bid};
            EpiPle E{lastrep ? a.out : (float*)(ws + WS_RF + 64 * MiB), (const bf16_t*)(ws + (l == 0 ? WS_PP0 : WS_PP1))}; GEMM(lds, hn, (const bf16_t*)(ws + WS_W_PG) + (size_t)l * D * D, D, S, E); } PHASE_END(true)
        }
    PHASE_BEGIN(0) phase_rowpass<0, true>(lds, a.out, a.in[I_GFINAL], nullptr, nullptr, 0, nullptr, nullptr, nullptr, nullptr, a.out); PHASE_END(false)
}

extern "C" void kernel_launch(void* const* d_in, const int* in_sizes, int n_in, void* d_out, int out_size,
                              void* d_ws, size_t ws_size, hipStream_t stream) {
    static int grid = 0;
    if (grid == 0) {
        if (n_in != 29 || out_size != M * D || ws_size < WS_END) { fprintf(stderr, "kernel_launch: unexpected problem (n_in %d out %d ws %zu)\n", n_in, out_size, ws_size); grid = -1; return; }
        int dev = 0, cus = 0, per_cu = 0;
        (void)hipGetDevice(&dev);
        (void)hipDeviceGetAttribute(&cus, hipDeviceAttributeMultiprocessorCount, dev);
        (void)hipFuncSetAttribute((const void*)mk_fwd, hipFuncAttributeMaxDynamicSharedMemorySize, LDS_BYTES);
        (void)hipOccupancyMaxActiveBlocksPerMultiprocessor(&per_cu, (const void*)mk_fwd, NT, LDS_BYTES);
        if (per_cu < 1) { fprintf(stderr, "kernel_launch: occupancy query says %d blocks per CU\n", per_cu); per_cu = 1; }
        grid = cus;
    }
    if (grid < 0) return;
    Args a{};
    for (int i = 0; i < 29; ++i) a.in[i] = (const float*)d_in[i];
    a.out = (float*)d_out; a.ws = (unsigned char*)d_ws; a.ph_lo = 0; a.ph_hi = 1000;
    (void)hipMemsetAsync((unsigned char*)d_ws + WS_SMALL + SM_BAR, 0, 16 * 1024, stream);
    void* args[] = {&a};
    hipError_t e = hipLaunchCooperativeKernel((void*)mk_fwd, dim3(grid), dim3(NT), args, LDS_BYTES, stream);
    if (e != hipSuccess) fprintf(stderr, "cooperative launch failed: %s (grid %d)\n", hipGetErrorString(e), grid);
}
```

```cpp
#include <hip/hip_runtime.h>
#include <hip/hip_cooperative_groups.h>
#include <cstdio>
#include <cstdint>
namespace cg = cooperative_groups;

constexpr int NT = 512;
constexpr int D = 1024, NBATCH = 4, SEQ = 4096, M = NBATCH * SEQ;
constexpr int CH = 64, NC = SEQ / CH, NH = 4, DH = 128, DM = 512, DR = 512, NBR = 8, DBR = 64;
constexpr int DIN = 3080, ZW = 3072, DFF = 2816, NE = 8, DPLE = 256;
constexpr int PMAX = 2 * M + NE * 256, NTILE_MAX = PMAX / 256;
constexpr int EROWS = 129;
constexpr float EPS = 1e-6f;
constexpr int ZQ = 0, ZK = 512, ZV = 1024, ZO = 1536, ZXR = 2048, ZYR = 2560;

constexpr size_t MiB = 1u << 20;
constexpr size_t WS_SMALL = 0;
constexpr size_t WS_W_IN0 = 4 * MiB;
constexpr size_t WS_W_OUT0 = 10 * MiB;
constexpr size_t WS_W_FFGU = 12 * MiB;
constexpr size_t WS_W_FFD = 23 * MiB;
constexpr size_t WS_PB0 = WS_W_FFD + 5632 * 1024;
constexpr size_t WS_W_PP0 = WS_PB0 + 8 * MiB;
constexpr size_t WS_H1 = 4 * MiB;
constexpr size_t WS_W_IN1 = 37 * MiB;
constexpr size_t WS_W_OUT1 = 43 * MiB;
constexpr size_t WS_W_PG = 45 * MiB;
constexpr size_t WS_W_PP1 = 49 * MiB;
constexpr size_t WS_W_EGU = WS_W_PP1 + MiB / 2;
constexpr size_t WS_W_ED = WS_W_EGU + 88 * MiB;
constexpr size_t WS_PB1 = WS_W_ED + 44 * MiB;
constexpr size_t WS_HN = WS_PB1 + 8 * MiB;
static_assert(WS_H1 + (size_t)(M + 1) * D * 2 <= WS_W_IN1 && WS_W_PP0 + 1024 * 256 * 2 <= WS_W_IN1, "map");
constexpr size_t WS_RF = 222 * MiB;
constexpr size_t WS_Z = WS_RF;
constexpr size_t WS_CT = WS_Z + 96 * MiB;
constexpr size_t WS_DN = WS_CT + 32 * MiB;
constexpr size_t WS_MIX = WS_CT + 72 * MiB;
constexpr size_t WS_HID = WS_RF;
constexpr size_t WS_PP0 = WS_RF + 130 * MiB;
constexpr size_t WS_SSQ = WS_RF + 201 * MiB;
constexpr size_t SSQ_STRIDE = (size_t)(M + 16) * 64;
constexpr size_t WS_END = 435 * MiB;
static_assert(WS_MIX + (size_t)M * D * 2 <= WS_SSQ && WS_HID + (size_t)PMAX * DFF * 2 <= WS_SSQ && WS_SSQ + 2 * SSQ_STRIDE <= WS_END, "map");
static_assert(WS_HN + (size_t)(M + 1) * D * 2 <= WS_RF, "map");
static_assert(WS_MIX + (size_t)M * D * 2 <= WS_END, "map");
static_assert(WS_HID + (size_t)PMAX * DFF * 2 <= WS_END, "map");
static_assert(WS_DN + 1024 * 128 * 4 <= WS_PP0 && WS_PP0 + (size_t)M * D * 2 <= WS_MIX && WS_HID + (size_t)M * DFF * 2 <= WS_PP0, "map");
constexpr size_t SM_GATES = 0;
constexpr size_t SM_TOKE = 512 * 1024;
constexpr size_t SM_TOKG = SM_TOKE + 128 * 1024;
constexpr size_t SM_ROWTOK = SM_TOKG + 128 * 1024;
constexpr size_t SM_ROWGATE = SM_ROWTOK + 160 * 1024;
constexpr size_t SM_TILEE = SM_ROWGATE + 160 * 1024;
constexpr size_t SM_ROWSLOT = SM_TILEE + 4 * 1024;
constexpr size_t SM_TOKP = SM_ROWSLOT + 160 * 1024;
constexpr size_t SM_BL = SM_TOKP + 16 * 1024;
constexpr size_t SM_AMAX = SM_BL + 4 * 1024;
constexpr size_t SM_MPREV = SM_AMAX + 4 * 1024;
constexpr size_t SM_RGA = 2 * MiB;
constexpr size_t SM_RGH = SM_RGA + 512 * 1024;
constexpr size_t SM_RGP = SM_RGH + 512 * 1024;
constexpr size_t SM_BAR = SM_RGP + 512 * 1024;
constexpr size_t SM_RGW = SM_BAR + 16 * 1024;
static_assert(SM_MPREV + 4096 <= SM_RGA && SM_RGW + 256 * 1024 <= 4 * MiB, "small map");

constexpr int LDS_BYTES = 147456;

typedef unsigned short bf16_t;
typedef float f32x4 __attribute__((ext_vector_type(4)));
typedef unsigned u32x4 __attribute__((ext_vector_type(4)));
typedef unsigned u32x2 __attribute__((ext_vector_type(2)));

__device__ __forceinline__ float bf2f(unsigned v) { return __uint_as_float(v << 16); }
__device__ __forceinline__ unsigned pk2(float lo, float hi);
__device__ __forceinline__ unsigned f2bf(float f) { return pk2(f, 0.f) & 0xffffu; }
typedef float f32x2_t __attribute__((ext_vector_type(2))); typedef __bf16 bf16x2_t __attribute__((ext_vector_type(2)));
__device__ __forceinline__ unsigned pk2(float lo, float hi) { f32x2_t v = {lo, hi}; bf16x2_t b = __builtin_convertvector(v, bf16x2_t); return __builtin_bit_cast(unsigned, b); }
__device__ __forceinline__ float frcp(float x) { return __builtin_amdgcn_rcpf(x); }
__device__ __forceinline__ float sigmoidf_(float x) { return frcp(1.f + __expf(-x)); }
__device__ __forceinline__ float siluf_(float x) { return x * frcp(1.f + __expf(-x)); }
__device__ __forceinline__ float logsigmoidf_(float x) { return fminf(x, 0.f) - log1pf(__expf(-fabsf(x))); }
__device__ __forceinline__ float gelu_tanh(float y) { const float u2 = 1.5957691216057308f * (y + 0.044715f * y * y * y); return y * frcp(1.f + __expf(-u2)); }
__device__ __forceinline__ float wave_sum(float v) {
#pragma unroll
    for (int o = 1; o < 64; o <<= 1) v += __shfl_xor(v, o);
    return v;
}
__device__ __forceinline__ float wave_max(float v) {
#pragma unroll
    for (int o = 1; o < 64; o <<= 1) v = fmaxf(v, __shfl_xor(v, o));
    return v;
}

__device__ __forceinline__ float dpp_f(float v, const int ctrl_sel) {
    const int x = __float_as_int(v); int r;
    if (ctrl_sel == 0) r = __builtin_amdgcn_update_dpp(x, x, 0xB1, 0xF, 0xF, false);
    else if (ctrl_sel == 1) r = __builtin_amdgcn_update_dpp(x, x, 0x4E, 0xF, 0xF, false);
    else if (ctrl_sel == 2) r = __builtin_amdgcn_update_dpp(x, x, 0x141, 0xF, 0xF, false);
    else r = __builtin_amdgcn_update_dpp(x, x, 0x140, 0xF, 0xF, false);
    return __int_as_float(r);
}
__device__ __forceinline__ float sum4(float v) { v += dpp_f(v, 0); v += dpp_f(v, 1); return v; }
__device__ __forceinline__ float sum8(float v) { v = sum4(v); v += dpp_f(v, 2); return v; }
__device__ __forceinline__ float sum16(float v) { v = sum8(v); v += dpp_f(v, 3); return v; }
__device__ __forceinline__ int otid() { int t = threadIdx.x; asm volatile("" : "+v"(t)); return t; }
__device__ __forceinline__ int oint(int v) { asm volatile("" : "+s"(v)); return v; }
__device__ __forceinline__ const void* okarg() { auto p = __builtin_amdgcn_kernarg_segment_ptr(); asm volatile("" : "+s"(p)); return (const void*)p; }

struct Args { const float* in[29]; float* out; unsigned char* ws; int ph_lo, ph_hi; };
enum { I_X = 0, I_P, I_GMIX, I_WIN, I_BIN, I_WCQK, I_BCQK, I_GMH, I_WCR, I_BCR, I_WRA, I_BRA, I_WRI, I_BRI, I_LAM, I_GR, I_WOUT, I_GFFN,
       I_WFG, I_WFU, I_WFD, I_WROUTER, I_WEG, I_WEU, I_WED, I_GPLE, I_WPG, I_WPP, I_GFINAL };


#define XB_TMO      128
#define XB_XCNT(j)  (256  + 64 * (j))
#define XB_XSUB(j)  (1280 + 64 * (j))
#define XB_XGEN(j)  (2304 + 64 * (j))
#define XB_TOP      3328
#define XB_TOPGEN   3392
#define XCD_BAR_WORDS 3456
#define XB_SPIN_CAP (1u << 18)
#define LAS __attribute__((address_space(3)))
__device__ __forceinline__ unsigned xb_ld(unsigned* p)              { return __hip_atomic_load(p, __ATOMIC_RELAXED, __HIP_MEMORY_SCOPE_AGENT); }
__device__ __forceinline__ unsigned xb_add(unsigned* p, unsigned v) { return __hip_atomic_fetch_add(p, v, __ATOMIC_RELAXED, __HIP_MEMORY_SCOPE_AGENT); }
__device__ __forceinline__ unsigned xb_xcc_id() { return (unsigned)__builtin_amdgcn_s_getreg((3 << 11) | 20) & 0xFu; }
#define XB_SPIN(cond, bar) do { unsigned _sp = 0; while (cond) { __builtin_amdgcn_s_sleep(1); \
    if ((++_sp & 255u) == 0u) { if (xb_ld(&(bar)[XB_TMO])) break; if (_sp > XB_SPIN_CAP) { atomicAdd(&(bar)[XB_TMO], 1u); break; } } } } while (0)
struct XcdBarrier { unsigned* bar; unsigned x; volatile LAS unsigned* st; };
__device__ __forceinline__ XcdBarrier xcd_barrier_post(unsigned* bar, volatile LAS unsigned* st) {
    XcdBarrier b; b.bar = bar; b.x = xb_xcc_id(); b.st = st;
    if (threadIdx.x == 0) (void)xb_add(&bar[XB_XCNT(b.x)], 1u);
    return b;
}
__device__ __forceinline__ void xcd_barrier_complete(unsigned* bar, unsigned x, unsigned& nloc, unsigned& nx) {
    const unsigned G = gridDim.x * gridDim.y * gridDim.z;
    unsigned sum, cnt, mine, sp = 0u;
    for (;;) {
        sum = 0u; cnt = 0u; mine = 0u;
#pragma unroll
        for (unsigned j = 0; j < 16; ++j) { const unsigned c = xb_ld(&bar[XB_XCNT(j)]); sum += c; cnt += (c > 0u) ? 1u : 0u; mine = (j == x) ? c : mine; }
        if (sum == G) break;
        __builtin_amdgcn_s_sleep(1);
        if ((++sp & 255u) == 0u) { if (xb_ld(&bar[XB_TMO])) break; if (sp > XB_SPIN_CAP) { atomicAdd(&bar[XB_TMO], 1u); break; } }
    }
    nloc = mine > 0u ? mine : 1u; nx = cnt > 0u ? cnt : 1u;
}
__device__ __forceinline__ void xcd_barrier(const XcdBarrier& b) {
    asm volatile("s_waitcnt vmcnt(0)" ::: "memory");
    __syncthreads();
    if (threadIdx.x == 0) {
        unsigned* bar = b.bar;
        __builtin_amdgcn_s_waitcnt(0);
        unsigned nloc = b.st[0], nx = b.st[1];
        if (nloc == 0u) { xcd_barrier_complete(bar, b.x, nloc, nx); b.st[0] = nloc; b.st[1] = nx; }
        const unsigned old = xb_add(&bar[XB_XSUB(b.x)], 1u);
        const unsigned gen = old / nloc;
        if (old + 1u == (gen + 1u) * nloc) {
            __builtin_amdgcn_fence(__ATOMIC_RELEASE, "agent");
            asm volatile("s_waitcnt vmcnt(0)" ::: "memory");
            const unsigned og = xb_add(&bar[XB_TOP], 1u);
            const unsigned tg = og / nx;
            if (og + 1u == (tg + 1u) * nx) xb_add(&bar[XB_TOPGEN], 1u);
            else XB_SPIN(xb_ld(&bar[XB_TOPGEN]) == tg, bar);
            __builtin_amdgcn_fence(__ATOMIC_ACQUIRE, "agent");
            xb_add(&bar[XB_XGEN(b.x)], 1u);
            asm volatile("s_waitcnt vmcnt(0)" ::: "memory");
        } else {
            XB_SPIN(xb_ld(&bar[XB_XGEN(b.x)]) == gen, bar);
            __builtin_amdgcn_fence(__ATOMIC_ACQUIRE, "agent");
            asm volatile("s_waitcnt vmcnt(0)" ::: "memory");
        }
    }
    __syncthreads();
}

struct CvtJob { const float* src; bf16_t* dst; int ld, k0, c0, K, n0; const float* gain; };
__device__ __forceinline__ CvtJob cvt_plain_job(const float* src, int K, int N, bf16_t* dst, int tile) {
    const int nt = N / 64, kb = tile / nt, nb = tile % nt; return CvtJob{src, dst, N, kb * 64, nb * 64, K, nb * 64, nullptr};
}
__device__ __forceinline__ CvtJob cvt_gu_job(const float* g, const float* u, bf16_t* dst, int tile) {
    const int nt = 5632 / 64, kb = tile / nt, nb = tile % nt, n0 = nb * 64, tt = n0 >> 8, half = (n0 >> 7) & 1, w = n0 & 127;
    return CvtJob{half ? u : g, dst, DFF, kb * 64, tt * 128 + w, 1024, n0, nullptr};
}
__device__ __forceinline__ CvtJob cvt_job(const Args& a, int it) {
    unsigned char* ws = a.ws;
    constexpr int T_IN = 16 * 48, T_OUT = 16 * 16, T_GU = 16 * 88, T_FD = 44 * 16, T_PG = 256, T_PP = 4 * 16;
    int r = it;
    if (r < 2 * T_IN) { const int l = r / T_IN, tile = r % T_IN; const int nt = ZW / 64, kb = tile / nt, nb = tile % nt, n0 = nb * 64;
        return CvtJob{a.in[I_WIN] + (size_t)l * D * DIN, (bf16_t*)(ws + (l ? WS_W_IN1 : WS_W_IN0)), DIN, kb * 64, n0 < 2048 ? n0 : n0 + 8, D, n0, a.in[I_GMIX] + l * D}; }
    r -= 2 * T_IN;
    if (r < 2 * T_OUT) { const int l = r / T_OUT; return cvt_plain_job(a.in[I_WOUT] + (size_t)l * D * D, D, D, (bf16_t*)(ws + (l ? WS_W_OUT1 : WS_W_OUT0)), r % T_OUT); }
    r -= 2 * T_OUT;
    if (r < T_GU) { CvtJob j = cvt_gu_job(a.in[I_WFG], a.in[I_WFU], (bf16_t*)(ws + WS_W_FFGU), r); j.gain = a.in[I_GFFN]; return j; }
    r -= T_GU;
    if (r < T_FD) return cvt_plain_job(a.in[I_WFD], DFF, D, (bf16_t*)(ws + WS_W_FFD), r);
    r -= T_FD;
    if (r < 2 * T_PG) { const int l = r / T_PG; CvtJob j = cvt_plain_job(a.in[I_WPG] + (size_t)l * D * D, D, D, (bf16_t*)(ws + WS_W_PG) + (size_t)l * D * D, r % T_PG); j.gain = a.in[I_GPLE] + l * D; return j; }
    r -= 2 * T_PG;
    if (r < 2 * T_PP) { const int l = r / T_PP; return cvt_plain_job(a.in[I_WPP] + (size_t)l * DPLE * D, DPLE, D, (bf16_t*)(ws + (l ? WS_W_PP1 : WS_W_PP0)), r % T_PP); }
    r -= 2 * T_PP;
    if (r < 8 * T_GU) { const int e = r / T_GU; CvtJob j = cvt_gu_job(a.in[I_WEG] + (size_t)e * D * DFF, a.in[I_WEU] + (size_t)e * D * DFF, (bf16_t*)(ws + WS_W_EGU) + (size_t)e * 5632 * D, r % T_GU); j.gain = a.in[I_GFFN] + D; return j; }
    r -= 8 * T_GU;
    { const int e = r / T_FD; return cvt_plain_job(a.in[I_WED] + (size_t)e * DFF * D, DFF, D, (bf16_t*)(ws + WS_W_ED) + (size_t)e * D * DFF, r % T_FD); }
}
__device__ __forceinline__ void phase_prologue(const Args& a, unsigned char* lds) {
    unsigned char* ws = a.ws;
    const int G = gridDim.x, t = otid();
    constexpr int T_IN = 16 * 48, T_OUT = 16 * 16, T_GU = 16 * 88, T_FD = 44 * 16, T_PG = 256, T_PP = 4 * 16;
    constexpr int NT_ALL = 2 * T_IN + 2 * T_OUT + T_GU + T_FD + 2 * T_PG + 2 * T_PP + 8 * T_GU + 8 * T_FD;
    constexpr int NB = 4;
    const int kk0 = t >> 4, cc = (t & 15) * 4, n = t >> 3, kg = t & 7;
    for (int it0 = blockIdx.x * NB; it0 < NT_ALL; it0 += G * NB) {
        float4 v[NB][2]; CvtJob jb[NB];
#pragma unroll
        for (int b = 0; b < NB; ++b) { const int it = it0 + b < NT_ALL ? it0 + b : NT_ALL - 1; jb[b] = cvt_job(a, it);
#pragma unroll
            for (int j = 0; j < 2; ++j) { v[b][j] = *(const float4*)(jb[b].src + (size_t)(jb[b].k0 + kk0 + 32 * j) * jb[b].ld + jb[b].c0 + cc);
                if (jb[b].gain) { const float gk = jb[b].gain[jb[b].k0 + kk0 + 32 * j]; v[b][j].x *= gk; v[b][j].y *= gk; v[b][j].z *= gk; v[b][j].w *= gk; } } }
#pragma unroll
        for (int b = 0; b < NB; ++b) { float* tl = (float*)lds + b * (64 * 65);
#pragma unroll
            for (int j = 0; j < 2; ++j) { float* p = tl + (kk0 + 32 * j) * 65 + cc; p[0] = v[b][j].x; p[1] = v[b][j].y; p[2] = v[b][j].z; p[3] = v[b][j].w; } }
        __syncthreads();
#pragma unroll
        for (int b = 0; b < NB; ++b) { if (it0 + b >= NT_ALL) break; const float* s_ = (const float*)lds + b * (64 * 65) + (8 * kg) * 65 + n;
            u32x4 o; o.x = pk2(s_[0], s_[65]); o.y = pk2(s_[130], s_[195]); o.z = pk2(s_[260], s_[325]); o.w = pk2(s_[390], s_[455]);
            *(u32x4*)(jb[b].dst + (size_t)(jb[b].n0 + n) * jb[b].K + jb[b].k0 + 8 * kg) = o; }
        __syncthreads();
    }
    const size_t np4 = (size_t)M * DPLE / 4;
    for (size_t i = (size_t)blockIdx.x * NT + otid(); i < 2 * np4; i += (size_t)G * NT) {
        const float4 v = ((const float4*)a.in[I_P])[i]; u32x2 o; o.x = pk2(v.x, v.y); o.y = pk2(v.z, v.w);
        if (i < np4) ((u32x2*)(ws + WS_PB0))[i] = o; else ((u32x2*)(ws + WS_PB1))[i - np4] = o; }
    for (int i = blockIdx.x * NT + otid(); i < 2 * 8 * 2 * 64 * 64; i += G * NT) {
        const int d = i & 63, e = (i >> 6) & 63, g = (i >> 12) & 1, ln = i >> 13;
        ((bf16_t*)(ws + WS_SMALL + SM_RGW))[i] = (bf16_t)f2bf((g ? a.in[I_WRI] : a.in[I_WRA])[((size_t)ln * 64 + d) * 64 + e]);
    }
    if (blockIdx.x == 0) { for (int i = otid(); i < D / 2; i += NT) ((unsigned*)(ws + WS_HN + (size_t)M * D * 2))[i] = 0u; if (otid() < 32) ((float*)(ws + WS_SSQ + (otid() >> 4) * SSQ_STRIDE))[(size_t)M * 16 + (otid() & 15)] = 0.f; }
    for (int i = blockIdx.x * NT + otid(); i < PMAX; i += G * NT) { ((int*)(ws + WS_SMALL + SM_ROWTOK))[i] = M; ((float*)(ws + WS_SMALL + SM_ROWGATE))[i] = 0.f; }
}

template <int IN, int AUX, int WR, bool ADDY>
__device__ __forceinline__ void phase_rowpass(unsigned char* lds, const float* xin, bf16_t* hb, const bf16_t* y1, const float* g, float* ssq,
                                              const float* auxW, int auxld, const float* auxB, float* gates, unsigned char* tok_p, float* tok_g, float* fout) {
    float* wl = (float*)lds;
    const int tid = otid(), lane = tid & 63, wave = tid >> 6;
    if (AUX) {
        for (int i = tid; i < D * 8; i += NT) wl[i] = auxW[(size_t)(i >> 3) * auxld + (i & 7)];
        __syncthreads();
    }
    f32x4 gv[4];
    if (AUX || WR == 2) {
#pragma unroll
        for (int j = 0; j < 4; ++j) gv[j] = *(const f32x4*)(g + 4 * lane + 256 * j);
    }
    for (int row = blockIdx.x * 8 + wave; row < M; row += gridDim.x * 8) {
        f32x4 v[4]; float ss = 0.f;
#pragma unroll
        for (int j = 0; j < 4; ++j) {
            if (IN == 0) v[j] = ((const f32x4*)(xin + (size_t)row * D) + lane)[64 * j];
            else { const u32x2 w = ((const u32x2*)(hb + (size_t)row * D) + lane)[64 * j]; v[j] = (f32x4){bf2f(w.x & 0xffffu), __uint_as_float(w.x & 0xffff0000u), bf2f(w.y & 0xffffu), __uint_as_float(w.y & 0xffff0000u)}; }
            if (ADDY) { const u32x2 y = ((const u32x2*)(y1 + (size_t)row * D) + lane)[64 * j];
                v[j].x += bf2f(y.x & 0xffffu); v[j].y += __uint_as_float(y.x & 0xffff0000u); v[j].z += bf2f(y.y & 0xffffu); v[j].w += __uint_as_float(y.y & 0xffff0000u); }
            ss += (v[j].x * v[j].x + v[j].y * v[j].y) + (v[j].z * v[j].z + v[j].w * v[j].w); }
        const float tot = wave_sum(ss), rstd = rsqrtf(tot * (1.f / D) + EPS);
        if (WR == 1) {
            u32x2* o = (u32x2*)(hb + (size_t)row * D) + lane;
#pragma unroll
            for (int j = 0; j < 4; ++j) { u32x2 w; w.x = pk2(v[j].x, v[j].y); w.y = pk2(v[j].z, v[j].w); o[64 * j] = w; }
            if (lane < 16) ssq[(size_t)row * 16 + lane] = lane == 0 ? tot : 0.f;
        }
        if (AUX || WR == 2) {
#pragma unroll
            for (int j = 0; j < 4; ++j) v[j] = v[j] * rstd * gv[j];
        }
        if (WR == 2) {
            f32x4* o = (f32x4*)(fout + (size_t)row * D) + lane;
#pragma unroll
            for (int j = 0; j < 4; ++j) o[64 * j] = v[j];
        }
        if (AUX) {
            float acc[8];
#pragma unroll
            for (int c = 0; c < 8; ++c) acc[c] = 0.f;
#pragma unroll
            for (int j = 0; j < 4; ++j)
#pragma unroll
                for (int q = 0; q < 4; ++q) {
                    const int k = 4 * lane + 256 * j + q; const float xv = v[j][q];
                    const f32x4 w0 = *(const f32x4*)(wl + k * 8), w1 = *(const f32x4*)(wl + k * 8 + 4);
                    acc[0] += xv * w0.x; acc[1] += xv * w0.y; acc[2] += xv * w0.z; acc[3] += xv * w0.w;
                    acc[4] += xv * w1.x; acc[5] += xv * w1.y; acc[6] += xv * w1.z; acc[7] += xv * w1.w;
                }
#pragma unroll
            for (int c = 0; c < 8; ++c) acc[c] = wave_sum(acc[c]);
            if (AUX == 1) {
                if (lane < 8) { float s_ = acc[0];
#pragma unroll
                    for (int c = 1; c < 8; ++c) s_ = (lane == c) ? acc[c] : s_;
                    gates[(size_t)row * 8 + lane] = s_ + auxB[lane]; }
            } else {
                if (lane == 0) {
                    int e1 = 0; float v1 = acc[0];
#pragma unroll
                    for (int c = 1; c < 8; ++c) if (acc[c] > v1) { v1 = acc[c]; e1 = c; }
                    int e2 = -1; float v2 = -INFINITY;
#pragma unroll
                    for (int c = 0; c < 8; ++c) if (c != e1 && acc[c] > v2) { v2 = acc[c]; e2 = c; }
                    const float p2 = __expf(v2 - v1), inv = 1.f / (1.f + p2);
                    tok_p[row] = (unsigned char)(e1 | (e2 << 4)); tok_g[row * 2] = inv; tok_g[row * 2 + 1] = p2 * inv;
                }
            }
        }
    }
    __syncthreads();
}

struct Unit { int pm, pn; const int* rows; size_t bofs; };
struct GridOrder {
    static constexpr bool GATHER = false;
    int nM, nN, G, c;
    __device__ __forceinline__ bool next(int i, Unit& u) const {
        const int L = i * G + c; if (L >= nM * nN) return false;
        const int grp = L / (8 * nN), fm = grp * 8, gsz = (nM - fm) < 8 ? (nM - fm) : 8, w = L % (8 * nN);
        u.pm = fm + w % gsz; u.pn = w / gsz; u.rows = nullptr; u.bofs = 0; return true;
    }
};
struct TailOrder {
    static constexpr bool GATHER = false;
    int nM, nN, G, c, first;
    __device__ __forceinline__ bool next(int i, Unit& u) const {
        if (c < first) return false; const int L = i * (G - first) + (c - first); if (L >= nM * nN) return false;
        u.pm = L / nN; u.pn = L % nN; u.rows = nullptr; u.bofs = 0; return true;
    }
};
template <bool GATHER_> struct MoeOrder {
    static constexpr bool GATHER = GATHER_;
    int nM, nN, G, c; const int* tile_e; const int* rows; size_t estride;
    __device__ __forceinline__ bool next(int i, Unit& u) const {
        const int L = i * G + c; if (L >= nM * nN) return false;
        const int grp = L / (8 * nN), fm = grp * 8, gsz = (nM - fm) < 8 ? (nM - fm) : 8, w = L % (8 * nN);
        u.pm = fm + w % gsz; u.pn = w / gsz; u.rows = rows; u.bofs = (size_t)tile_e[u.pm] * estride; return true;
    }
};


namespace pg8 {
#define PG8_LAS __attribute__((address_space(3)))
typedef short bf16x8 __attribute__((ext_vector_type(8)));
constexpr int BM = 256, BK = 64, HALF = 128, HTB = HALF * BK * 2, STAGE_BYTES = 8 * HTB;
__device__ __forceinline__ int lds_byte(int r, int c) { const int st = (r >> 4) * 2 + (c >> 5), rr = r & 15, cc = c & 31, ob = rr * 64 + cc * 2; return st * 1024 + (ob ^ (((ob >> 9) & 1) << 5)); }
__device__ __forceinline__ void stage_rc(int b, int& R, int& C) { const int st = b / 1024, sb = b % 1024, swz = sb ^ (((sb >> 9) & 1) << 5); R = (st >> 1) * 16 + swz / 64; C = (st & 1) * 32 + (swz % 64) / 2; }

__device__ __forceinline__ int perm32(int rho) { const int n = rho >> 4, i = rho & 15; return 8 * (i >> 2) + 4 * n + (i & 3); }
__device__ __forceinline__ void unit_voff(const Unit& u, const int (&R)[2], const int (&C)[2], int K, unsigned (&vo)[2][2]) {
#pragma unroll
    for (int h = 0; h < 2; ++h)
#pragma unroll
        for (int i = 0; i < 2; ++i) { int row = u.pm * BM + h * HALF + R[i]; if (u.rows) row = u.rows[row]; vo[h][i] = ((unsigned)row * (unsigned)K + (unsigned)C[i]) * 2u; }
}

template <class Epi, class Sched, bool ALIGN_EPI, bool GATHER>
__device__ __forceinline__ void gemm_phase(unsigned char* lds_, const bf16_t* A_, const bf16_t* Bt_, const int K_, const Sched& S, const Epi& E) {
    PG8_LAS unsigned char* lds = (PG8_LAS unsigned char*)lds_;
    const int K = oint(K_);
    const int tid = otid(), wid = __builtin_amdgcn_readfirstlane(tid >> 6), lane = tid & 63, wr = wid >> 2, wc = wid & 3, fr = lane & 15, fq = lane >> 4;
    const int nt = K / BK;
    int R[2], C[2]; unsigned voffA[2], voffB[2];
#pragma unroll
    for (int i = 0; i < 2; ++i) { stage_rc(tid * 16 + i * 8192, R[i], C[i]); voffA[i] = (unsigned)(R[i] * K + C[i]) * 2u;
        const int Rb = Epi::PERM ? ((R[i] & ~31) + perm32(R[i] & 31)) : R[i]; voffB[i] = (unsigned)(Rb * K + C[i]) * 2u; }
    const size_t kstep = (size_t)(BK * 2);
    const size_t hstep = (size_t)HALF * K * 2;
    const size_t tstep = 2 * hstep;
    const unsigned ldsw = (unsigned)wid * 1024u;
    const int aoff = lds_byte(wr * 64 + fr, fq * 8), boff = lds_byte(wc * 32 + fr, fq * 8);
#define PG8_SA(b, h) (((b) * 2 + (h)) * HTB)
#define PG8_SB(b, h) ((4 + (b) * 2 + (h)) * HTB)
#define PG8_STAGE(bufoff, gbase, voff) do { _Pragma("unroll") for (int _i = 0; _i < 2; ++_i) \
        __builtin_amdgcn_global_load_lds((const unsigned*)((const char*)(gbase) + (voff)[_i]), (PG8_LAS unsigned*)(lds + (bufoff) + ldsw + _i * 8192), 16, 0, 0); } while (0)
#define PG8_STAGE_A(bufoff, base, h, VO) do { if constexpr (GATHER) { PG8_STAGE(bufoff, base, (VO)[h]); } else { PG8_STAGE(bufoff, (base) + (h) * hstep, voffA); } } while (0)
#define PG8_LDA(dst, b, h) do { _Pragma("unroll") for (int m = 0; m < 4; ++m) _Pragma("unroll") for (int k = 0; k < 2; ++k) dst[m][k] = *(const PG8_LAS bf16x8*)(lds + PG8_SA(b, h) + aoff + m * 2048 + k * 1024); } while (0)
#define PG8_LDB(dst, b, h) do { _Pragma("unroll") for (int n = 0; n < 2; ++n) _Pragma("unroll") for (int k = 0; k < 2; ++k) dst[n][k] = *(const PG8_LAS bf16x8*)(lds + PG8_SB(b, h) + boff + n * 2048 + k * 1024); } while (0)
#define PG8_MMA(ai, bj, At, Bt) do { __builtin_amdgcn_s_setprio(1); _Pragma("unroll") for (int m = 0; m < 4; ++m) _Pragma("unroll") for (int n = 0; n < 2; ++n) _Pragma("unroll") for (int k = 0; k < 2; ++k) \
        acc[ai][bj][m][n] = __builtin_amdgcn_mfma_f32_16x16x32_bf16(Bt[n][k], At[m][k], acc[ai][bj][m][n], 0, 0, 0); __builtin_amdgcn_s_setprio(0); } while (0)
#define PG8_WAIT_V(n) asm volatile("s_waitcnt vmcnt(" #n ")" ::: "memory")
#define PG8_WAIT_L(n) asm volatile("s_waitcnt lgkmcnt(" #n ")" ::: "memory")
#define PG8_BAR __builtin_amdgcn_s_barrier()
#define PG8_SCHED __builtin_amdgcn_sched_barrier(0)
    Unit cur, nxt; int ui = 0;
    if (!S.next(0, cur)) return;
    f32x4 acc[2][2][4][2];
#pragma unroll
    for (int a = 0; a < 2; ++a)
#pragma unroll
        for (int b = 0; b < 2; ++b)
#pragma unroll
            for (int m = 0; m < 4; ++m)
#pragma unroll
                for (int n = 0; n < 2; ++n) acc[a][b][m][n] = (f32x4){0.f, 0.f, 0.f, 0.f};
    bf16x8 At[4][2], B0[2][2], B1[2][2];
    unsigned vc[2][2], vn[2][2];
    if constexpr (GATHER) unit_voff(cur, R, C, K, vc);
    const char* cA = GATHER ? (const char*)A_ : (const char*)A_ + (size_t)cur.pm * tstep;
    const char* cB = (const char*)Bt_ + cur.bofs * 2 + (size_t)cur.pn * tstep;
    PG8_STAGE(PG8_SB(0, 0), cB, voffB); PG8_STAGE(PG8_SB(0, 1), cB + hstep, voffB); PG8_STAGE_A(PG8_SA(0, 0), cA, 0, vc); PG8_STAGE_A(PG8_SA(0, 1), cA, 1, vc);
    if (wr == 1) PG8_BAR;
    PG8_WAIT_V(2); PG8_BAR;
    PG8_STAGE(PG8_SB(1, 0), cB + kstep, voffB); PG8_STAGE_A(PG8_SA(1, 0), cA + kstep, 0, vc); PG8_STAGE(PG8_SB(1, 1), cB + hstep + kstep, voffB);
    PG8_WAIT_V(6); PG8_BAR;
    for (;;) {
        const bool has_next = S.next(ui + 1, nxt);
        const char* nA = cA; const char* nB = cB;
        if (has_next) { nB = (const char*)Bt_ + nxt.bofs * 2 + (size_t)nxt.pn * tstep; if constexpr (!GATHER) nA = (const char*)A_ + (size_t)nxt.pm * tstep; }
        if constexpr (GATHER) {
            if (has_next) unit_voff(nxt, R, C, K, vn);
            else {
#pragma unroll
                for (int h = 0; h < 2; ++h)
#pragma unroll
                    for (int i = 0; i < 2; ++i) vn[h][i] = vc[h][i]; } }
        for (int t = 0; t < nt; t += 2) {
            const bool last = (t == nt - 2);
            const char* a1 = cA + (size_t)(t + 1) * kstep;
            const char* a2 = last ? nA : cA + (size_t)(t + 2) * kstep; const char* b2 = last ? nB : cB + (size_t)(t + 2) * kstep;
            const char* a3 = a2 + kstep; const char* b3 = b2 + kstep;
            unsigned v2[2][2];
            if constexpr (GATHER) {
#pragma unroll
                for (int h = 0; h < 2; ++h)
#pragma unroll
                    for (int i = 0; i < 2; ++i) v2[h][i] = last ? vn[h][i] : vc[h][i]; }
            PG8_LDB(B0, 0, 0); PG8_LDB(B1, 0, 1); PG8_SCHED; PG8_LDA(At, 0, 0); PG8_STAGE_A(PG8_SA(1, 1), a1, 1, vc);
            PG8_WAIT_V(8); PG8_WAIT_L(0); PG8_BAR; PG8_MMA(0, 0, At, B0); PG8_MMA(0, 1, At, B1); PG8_BAR; PG8_SCHED;
            PG8_LDA(At, 0, 1); PG8_STAGE(PG8_SB(0, 0), b2, voffB); PG8_STAGE(PG8_SB(0, 1), b2 + hstep, voffB); PG8_STAGE_A(PG8_SA(0, 0), a2, 0, v2);
            PG8_WAIT_V(8); PG8_WAIT_L(0); PG8_BAR; PG8_MMA(1, 0, At, B0); PG8_MMA(1, 1, At, B1); PG8_BAR; PG8_SCHED;
            PG8_LDB(B0, 1, 0); PG8_LDB(B1, 1, 1); PG8_SCHED; PG8_LDA(At, 1, 0); PG8_STAGE_A(PG8_SA(0, 1), a2, 1, v2);
            PG8_WAIT_V(8); PG8_WAIT_L(0); PG8_BAR; PG8_MMA(0, 0, At, B0); PG8_MMA(0, 1, At, B1); PG8_BAR; PG8_SCHED;
            PG8_LDA(At, 1, 1); PG8_STAGE(PG8_SB(1, 0), b3, voffB); PG8_STAGE(PG8_SB(1, 1), b3 + hstep, voffB); PG8_STAGE_A(PG8_SA(1, 0), a3, 0, v2);
            PG8_WAIT_V(8); PG8_WAIT_L(0); PG8_BAR; PG8_MMA(1, 0, At, B0); PG8_MMA(1, 1, At, B1); PG8_BAR; PG8_SCHED;
        }
        if constexpr (ALIGN_EPI) { if (wr == 0) PG8_BAR; }
        { int pm_ = cur.pm, pn_ = cur.pn, fr_ = fr, fq_ = fq;
          asm volatile("" : "+s"(pm_), "+s"(pn_), "+v"(fr_), "+v"(fq_));
          E(acc, pm_, pn_, wr, wc, fr_, fq_); }
        if (!has_next) break;
#pragma unroll
        for (int a = 0; a < 2; ++a)
#pragma unroll
            for (int b = 0; b < 2; ++b)
#pragma unroll
                for (int m = 0; m < 4; ++m)
#pragma unroll
                    for (int n = 0; n < 2; ++n) acc[a][b][m][n] = (f32x4){0.f, 0.f, 0.f, 0.f};
        cur = nxt; cA = nA; cB = nB; ++ui;
        if constexpr (GATHER) {
#pragma unroll
            for (int h = 0; h < 2; ++h)
#pragma unroll
                for (int i = 0; i < 2; ++i) vc[h][i] = vn[h][i]; }
        if constexpr (ALIGN_EPI) { if (wr == 1) PG8_BAR; }
    }
    PG8_WAIT_V(0);
    if constexpr (!ALIGN_EPI) { if (wr == 0) PG8_BAR; }
    PG8_BAR;
#undef PG8_SA
#undef PG8_SB
#undef PG8_STAGE
#undef PG8_STAGE_A
#undef PG8_LDA
#undef PG8_LDB
#undef PG8_MMA
#undef PG8_WAIT_V
#undef PG8_WAIT_L
#undef PG8_BAR
#undef PG8_SCHED
}
}
template <class Epi, class Sched>
__device__ __forceinline__ void gemm_fast(unsigned char* lds, const bf16_t* A, const bf16_t* Bt, int K, const Sched& S, const Epi& E) {
    pg8::gemm_phase<Epi, Sched, true, Sched::GATHER>(lds, A, Bt, K, S, E);
    __syncthreads();
}

typedef f32x4 AccT[2][2][4][2];
#define EPI_ROW(ai, m) (pm * 256 + (ai) * 128 + wr * 64 + (m) * 16 + fr)
__device__ __forceinline__ void unpack8(const u32x4 w, f32x4& lo, f32x4& hi) {
    lo = (f32x4){bf2f(w.x & 0xffffu), __uint_as_float(w.x & 0xffff0000u), bf2f(w.y & 0xffffu), __uint_as_float(w.y & 0xffff0000u)};
    hi = (f32x4){bf2f(w.z & 0xffffu), __uint_as_float(w.z & 0xffff0000u), bf2f(w.w & 0xffffu), __uint_as_float(w.w & 0xffff0000u)};
}
__device__ __forceinline__ u32x4 pack8(const f32x4 v0, const f32x4 v1) { u32x4 w; w.x = pk2(v0.x, v0.y); w.y = pk2(v0.z, v0.w); w.z = pk2(v1.x, v1.y); w.w = pk2(v1.z, v1.w); return w; }
__device__ __forceinline__ float dot8(const f32x4 a, const f32x4 b) { return ((a.x * a.x + a.y * a.y) + (a.z * a.z + a.w * a.w)) + ((b.x * b.x + b.y * b.y) + (b.z * b.z + b.w * b.w)); }
__device__ __forceinline__ void epi_rstd(const float* ssq, const int* rowmap, int pm, int wr, int fr, int fq, float (&rs)[2][4]) {
    f32x4 p[2][4];
#pragma unroll
    for (int ai = 0; ai < 2; ++ai)
#pragma unroll
        for (int m = 0; m < 4; ++m) { int row = EPI_ROW(ai, m); if (rowmap) row = rowmap[row]; p[ai][m] = *(const f32x4*)((const char*)ssq + ((unsigned)row * 16u + 4u * (unsigned)fq) * 4u); }
#pragma unroll
    for (int ai = 0; ai < 2; ++ai)
#pragma unroll
        for (int m = 0; m < 4; ++m) { float t = (p[ai][m].x + p[ai][m].y) + (p[ai][m].z + p[ai][m].w); t += __shfl_xor(t, 16); t += __shfl_xor(t, 32); rs[ai][m] = rsqrtf(t * (1.f / 1024.f) + EPS); }
}
__device__ __forceinline__ void epi_ssq(float* ssq, int row, int slot, float s_, int fq) { s_ += __shfl_xor(s_, 16); s_ += __shfl_xor(s_, 32); if (fq == 0) *(float*)((char*)ssq + ((unsigned)row * 16u + (unsigned)slot) * 4u) = s_; }

struct EpiZ { static constexpr bool PERM = true; bf16_t* z; const float* bin; const float* ssq;
    __device__ __forceinline__ void operator()(const AccT& acc, int pm, int pn, int wr, int wc, int fr, int fq) const {
        const int c0 = pn * 256 + wc * 32 + 8 * fq; f32x4 bv[2][2]; float rs[2][4];
#pragma unroll
        for (int bj = 0; bj < 2; ++bj)
#pragma unroll
            for (int n = 0; n < 2; ++n) { const int cc = c0 + bj * 128 + n * 4; bv[bj][n] = *(const f32x4*)(bin + (cc < 2048 ? cc : cc + 8)); }
        epi_rstd(ssq, nullptr, pm, wr, fr, fq, rs);
#pragma unroll
        for (int ai = 0; ai < 2; ++ai)
#pragma unroll
            for (int m = 0; m < 4; ++m) { bf16_t* rp = z + (size_t)EPI_ROW(ai, m) * ZW + c0; const float r = rs[ai][m];
#pragma unroll
                for (int bj = 0; bj < 2; ++bj) *(u32x4*)(rp + bj * 128) = pack8(acc[ai][bj][m][0] * r + bv[bj][0], acc[ai][bj][m][1] * r + bv[bj][1]); } } };
template <bool XB> struct EpiHres { static constexpr bool PERM = true; const float* xb; bf16_t* hb; float* ssq;
    __device__ __forceinline__ void operator()(const AccT& acc, int pm, int pn, int wr, int wc, int fr, int fq) const {
        const int c0 = pn * 256 + wc * 32 + 8 * fq;
#pragma unroll
        for (int ai = 0; ai < 2; ++ai) {
            f32x4 lx[4][2][2]; u32x4 lh[4][2];
#pragma unroll
            for (int m = 0; m < 4; ++m)
#pragma unroll
                for (int bj = 0; bj < 2; ++bj) { const size_t o = (size_t)EPI_ROW(ai, m) * D + c0 + bj * 128;
                    if (XB) { lx[m][bj][0] = *(const f32x4*)(xb + o); lx[m][bj][1] = *(const f32x4*)(xb + o + 4); } else lh[m][bj] = *(const u32x4*)(hb + o); }
#pragma unroll
            for (int m = 0; m < 4; ++m) { float s_ = 0.f; const int row = EPI_ROW(ai, m);
#pragma unroll
                for (int bj = 0; bj < 2; ++bj) { f32x4 b0, b1; if (XB) { b0 = lx[m][bj][0]; b1 = lx[m][bj][1]; } else unpack8(lh[m][bj], b0, b1);
                    const f32x4 v0 = b0 + acc[ai][bj][m][0], v1 = b1 + acc[ai][bj][m][1]; s_ += dot8(v0, v1);
                    *(u32x4*)(hb + (size_t)row * D + c0 + bj * 128) = pack8(v0, v1); }
                epi_ssq(ssq, row, pn * 4 + wc, s_, fq); }
        } } };
struct EpiSwiglu { static constexpr bool PERM = true; bf16_t* hid; const float* ssq; const int* rowmap;
    __device__ __forceinline__ void operator()(const AccT& acc, int pm, int pn, int wr, int wc, int fr, int fq) const {
        const int c0 = pn * 128 + wc * 32 + 8 * fq; float rs[2][4];
        epi_rstd(ssq, rowmap, pm, wr, fr, fq, rs);
#pragma unroll
        for (int ai = 0; ai < 2; ++ai)
#pragma unroll
            for (int m = 0; m < 4; ++m) { u32x4 w; const float r = rs[ai][m];
#pragma unroll
                for (int n = 0; n < 2; ++n) { const f32x4 g = acc[ai][0][m][n] * r, u = acc[ai][1][m][n] * r;
                    w[2 * n] = pk2(siluf_(g.x) * u.x, siluf_(g.y) * u.y); w[2 * n + 1] = pk2(siluf_(g.z) * u.z, siluf_(g.w) * u.w); }
                *(u32x4*)(hid + (size_t)EPI_ROW(ai, m) * DFF + c0) = w; } } };
struct EpiMoeDown { static constexpr bool PERM = true; bf16_t* hb; bf16_t* y1; const int* row_tok; const int* row_slot; const float* row_gate;
    __device__ __forceinline__ void operator()(const AccT& acc, int pm, int pn, int wr, int wc, int fr, int fq) const {
        const int c0 = pn * 256 + wc * 32 + 8 * fq;
        int tok[2][4], slot[2][4]; float gt[2][4];
#pragma unroll
        for (int ai = 0; ai < 2; ++ai)
#pragma unroll
            for (int m = 0; m < 4; ++m) { const int row = EPI_ROW(ai, m); tok[ai][m] = row_tok[row]; slot[ai][m] = row_slot[row]; gt[ai][m] = row_gate[row]; }
#pragma unroll
        for (int ai = 0; ai < 2; ++ai) {
            u32x4 lh[4][2];
#pragma unroll
            for (int m = 0; m < 4; ++m) { const bool rmw = tok[ai][m] < M && slot[ai][m] == 0;
#pragma unroll
                for (int bj = 0; bj < 2; ++bj) lh[m][bj] = rmw ? *(const u32x4*)(hb + (size_t)tok[ai][m] * D + c0 + bj * 128) : (u32x4){0u, 0u, 0u, 0u}; }
#pragma unroll
            for (int m = 0; m < 4; ++m) { if (tok[ai][m] >= M) continue; const size_t o = (size_t)tok[ai][m] * D + c0; const float g = gt[ai][m];
                if (slot[ai][m] == 0) {
#pragma unroll
                    for (int bj = 0; bj < 2; ++bj) { f32x4 b0, b1; unpack8(lh[m][bj], b0, b1); *(u32x4*)(hb + o + bj * 128) = pack8(b0 + g * acc[ai][bj][m][0], b1 + g * acc[ai][bj][m][1]); }
                } else {
#pragma unroll
                    for (int bj = 0; bj < 2; ++bj) *(u32x4*)(y1 + o + bj * 128) = pack8(g * acc[ai][bj][m][0], g * acc[ai][bj][m][1]);
                } }
        } } };
struct EpiStoreBf16 { static constexpr bool PERM = true; bf16_t* out;
    __device__ __forceinline__ void operator()(const AccT& acc, int pm, int pn, int wr, int wc, int fr, int fq) const {
        const int c0 = pn * 256 + wc * 32 + 8 * fq;
#pragma unroll
        for (int ai = 0; ai < 2; ++ai)
#pragma unroll
            for (int m = 0; m < 4; ++m)
#pragma unroll
                for (int bj = 0; bj < 2; ++bj) *(u32x4*)(out + (size_t)EPI_ROW(ai, m) * D + c0 + bj * 128) = pack8(acc[ai][bj][m][0], acc[ai][bj][m][1]); } };
struct EpiPle { static constexpr bool PERM = true; const bf16_t* hin; bf16_t* hb; const bf16_t* pp; float* ssq; const float* ssq_in;
    __device__ __forceinline__ void operator()(const AccT& acc, int pm, int pn, int wr, int wc, int fr, int fq) const {
        const int c0 = pn * 256 + wc * 32 + 8 * fq; float rs[2][4];
        epi_rstd(ssq_in, nullptr, pm, wr, fr, fq, rs);
        u32x4 sg[2][4][2];
#pragma unroll
        for (int ai = 0; ai < 2; ++ai)
#pragma unroll
            for (int m = 0; m < 4; ++m)
#pragma unroll
                for (int bj = 0; bj < 2; ++bj) { f32x4 a0 = acc[ai][bj][m][0] * rs[ai][m], a1 = acc[ai][bj][m][1] * rs[ai][m];
#pragma unroll
                    for (int q = 0; q < 4; ++q) { a0[q] = sigmoidf_(a0[q]); a1[q] = sigmoidf_(a1[q]); }
                    sg[ai][m][bj] = pack8(a0, a1); }
        asm volatile("" ::: "memory");
#pragma unroll
        for (int ai = 0; ai < 2; ++ai) {
            u32x4 lh[4][2], lp[4][2];
#pragma unroll
            for (int m = 0; m < 4; ++m)
#pragma unroll
                for (int bj = 0; bj < 2; ++bj) { const unsigned ob = ((unsigned)EPI_ROW(ai, m) * D + c0 + bj * 128) * 2u;
                    lh[m][bj] = *(const u32x4*)((const char*)hin + ob); lp[m][bj] = *(const u32x4*)((const char*)pp + ob); }
#pragma unroll
            for (int m = 0; m < 4; ++m) { float s_ = 0.f; const int row = EPI_ROW(ai, m);
#pragma unroll
                for (int bj = 0; bj < 2; ++bj) { f32x4 h0, h1, p0, p1, g0, g1; unpack8(lh[m][bj], h0, h1); unpack8(lp[m][bj], p0, p1); unpack8(sg[ai][m][bj], g0, g1);
                    h0 += g0 * p0; h1 += g1 * p1; s_ += dot8(h0, h1);
                    *(u32x4*)((char*)hb + ((unsigned)row * D + c0 + bj * 128) * 2u) = pack8(h0, h1); }
                epi_ssq(ssq, row, pn * 4 + wc, s_, fq); }
        } } };

__device__ __forceinline__ float conv4(const bf16_t* zc, int row, int s, const float* w  , int wstride, float b) {
    float acc = b;
#pragma unroll
    for (int j = 0; j < 4; ++j) { const int ds = 3 - j; if (s - ds >= 0) acc += w[j * wstride] * bf2f(zc[(ptrdiff_t)(row - ds) * ZW]); }
    return acc;
}
__device__ __forceinline__ void chunk_gates(float* sc, const float* gates, int row0, int h, int lane) {
    const float ip = gates[(size_t)(row0 + lane) * 8 + h], fp = gates[(size_t)(row0 + lane) * 8 + 4 + h];
    float b = logsigmoidf_(fp);
#pragma unroll
    for (int o = 1; o < 64; o <<= 1) { const float n = __shfl_up(b, o); if (lane >= o) b += n; }
    sc[lane] = b; sc[64 + lane] = ip;
}
__device__ __forceinline__ void chunk_gates_r(float* sc, float ip, float fp, int lane) {
    float b = logsigmoidf_(fp);
#pragma unroll
    for (int o = 1; o < 64; o <<= 1) { const float n = __shfl_up(b, o); if (lane >= o) b += n; }
    sc[lane] = b; sc[64 + lane] = ip;
}
__device__ __forceinline__ void mlstm_local(const Args& a, unsigned char* lds, int l, int item) {
    const int b = item >> 8, c = (item >> 2) & 63, h = item & 3, row0 = b * SEQ + c * CH, tid = otid(), lane = tid & 63;
    float* Kt = (float*)lds;
    float* Vt = Kt + 64 * 128;
    float* sc = Vt + 64 * 128;
    const bf16_t* z = (const bf16_t*)(a.ws + WS_Z);
    const float* gates = (const float*)(a.ws + WS_SMALL + SM_GATES);
    if (tid < 64) {
        chunk_gates(sc, gates, row0, h, lane);
        const float bl = __shfl(sc[lane], 63), al = bl - sc[lane] + sc[64 + lane];
        const float amax = wave_max(al);
        sc[128 + lane] = __expf(al - amax);
        if (lane == 0) { ((float*)(a.ws + WS_SMALL + SM_BL))[item] = bl; ((float*)(a.ws + WS_SMALL + SM_AMAX))[item] = amax; }
    }
    const float* wc = a.in[I_WCQK] + (size_t)l * 4 * 1024; const float* bc = a.in[I_BCQK] + (size_t)l * 1024;
    for (int i = tid; i < 64 * 128; i += NT) {
        const int ll = i >> 7, d = i & 127, ch = ZK + h * DH + d;
        Kt[i] = siluf_(conv4(z + ch, row0 + ll, c * CH + ll, wc + ch, 1024, bc[ch]));
        Vt[i] = bf2f(z[(size_t)(row0 + ll) * ZW + ZV + h * DH + d]);
    }
    __syncthreads();
    const int d = tid & 127, eg = tid >> 7;
    float acc[33];
#pragma unroll
    for (int i = 0; i < 33; ++i) acc[i] = 0.f;
    for (int ll = 0; ll < 64; ++ll) {
        const float kd = Kt[ll * 128 + d] * sc[128 + ll];
#pragma unroll
        for (int i = 0; i < 32; ++i) acc[i] += Vt[ll * 128 + eg + 4 * i] * kd;
        acc[32] += kd;
    }
    float* ct = (float*)(a.ws + WS_CT) + (size_t)item * EROWS * 128;
#pragma unroll
    for (int i = 0; i < 32; ++i) ct[(eg + 4 * i) * 128 + d] = acc[i];
    if (eg == 0) ct[128 * 128 + d] = acc[32];
    __syncthreads();
}
__device__ __forceinline__ void mlstm_scan(const Args& a, int G) {
    const float* BL = (const float*)(a.ws + WS_SMALL + SM_BL); const float* AM = (const float*)(a.ws + WS_SMALL + SM_AMAX);
    float* MP = (float*)(a.ws + WS_SMALL + SM_MPREV);
    const int tid = otid();
    for (int w = blockIdx.x; w < 16 * 16; w += G) {
        const int bh = w >> 4, sl = w & 15, b = bh >> 2, h = bh & 3;
        unsigned* p = (unsigned*)(a.ws + WS_CT) + (size_t)((b * NC) * NH + h) * 8192 + sl * 512 + tid;
        float s0 = 0.f, s1 = 0.f, m = 0.f;
#pragma unroll 1
        for (int c0 = 0; c0 < NC; c0 += 16) {
            unsigned x[16];
#pragma unroll
            for (int j = 0; j < 16; ++j) x[j] = p[(size_t)(c0 + j) * (NH * 8192)];
#pragma unroll
            for (int j = 0; j < 16; ++j) {
                const int item = (b * NC + c0 + j) * NH + h;
                const float bl = BL[item], am = AM[item];
                const float mn = fmaxf(bl + m, am), dec = __expf(bl + m - mn), scl = __expf(am - mn);
                p[(size_t)(c0 + j) * (NH * 8192)] = pk2(s0, s1);
                if (sl == 0 && tid == 0) MP[item] = m;
                s0 = dec * s0 + scl * bf2f(x[j] & 0xffffu); s1 = dec * s1 + scl * __uint_as_float(x[j] & 0xffff0000u); m = mn;
            }
        }
        if (sl == 1 && tid < 128) {
            float* q = (float*)(a.ws + WS_DN) + (size_t)((b * NC) * NH + h) * 128 + tid;
            float sn = 0.f; m = 0.f;
#pragma unroll 1
            for (int c0 = 0; c0 < NC; c0 += 16) {
                float x[16];
#pragma unroll
                for (int j = 0; j < 16; ++j) x[j] = q[(size_t)(c0 + j) * (NH * 128)];
#pragma unroll
                for (int j = 0; j < 16; ++j) {
                    const int item = (b * NC + c0 + j) * NH + h;
                    const float bl = BL[item], am = AM[item];
                    const float mn = fmaxf(bl + m, am), dec = __expf(bl + m - mn), scl = __expf(am - mn);
                    q[(size_t)(c0 + j) * (NH * 128)] = sn;
                    sn = dec * sn + scl * x[j]; m = mn;
                }
            }
        }
    }
}
__device__ __forceinline__ void mlstm_out(const Args& a, unsigned char* lds, int l, int item) {
    const int b = item >> 8, c = (item >> 2) & 63, h = item & 3, row0 = b * SEQ + c * CH, tid = otid(), lane = tid & 63, wave = tid >> 6;
    float* Q = (float*)lds;
    float* Kt = Q + 64 * 128;
    float* Vt = Kt + 64 * 128;
    float* Sm = Vt + 64 * 128;
    float* sc = Sm + 64 * 64;
    const bf16_t* z = (const bf16_t*)(a.ws + WS_Z);
    const float* gates = (const float*)(a.ws + WS_SMALL + SM_GATES);
    const float mprev = ((const float*)(a.ws + WS_SMALL + SM_MPREV))[item];
    if (tid < 64) {
        chunk_gates(sc, gates, row0, h, lane);
        float g = sc[64 + lane] - sc[lane];
#pragma unroll
        for (int o = 1; o < 64; o <<= 1) { const float n = __shfl_up(g, o); if (lane >= o) g = fmaxf(g, n); }
        const float mrow = sc[lane] + fmaxf(mprev, g);
        sc[128 + lane] = mrow; sc[192 + lane] = __expf(sc[lane] + mprev - mrow);
    }
    const float* wc = a.in[I_WCQK] + (size_t)l * 4 * 1024; const float* bc = a.in[I_BCQK] + (size_t)l * 1024;
    for (int i = tid; i < 64 * 128; i += NT) {
        const int ll = i >> 7, d = i & 127, chq = ZQ + h * DH + d, chk = ZK + h * DH + d;
        Q[i] = siluf_(conv4(z + chq, row0 + ll, c * CH + ll, wc + chq, 1024, bc[chq])) * 0.08838834764831845f;
        Kt[i] = siluf_(conv4(z + chk, row0 + ll, c * CH + ll, wc + chk, 1024, bc[chk]));
        Vt[i] = bf2f(z[(size_t)(row0 + ll) * ZW + ZV + h * DH + d]);
    }
    __syncthreads();
    for (int i = tid; i < 64 * 64; i += NT) {
        const int ll = i >> 6, mm = i & 63; float s = 0.f;
        if (mm <= ll) {
            for (int d = 0; d < 128; ++d) s += Q[ll * 128 + d] * Kt[mm * 128 + d];
            s *= __expf(sc[ll] - sc[mm] + sc[64 + mm] - sc[128 + ll]);
        }
        Sm[i] = s;
    }
    __syncthreads();
    const float* ct = (const float*)(a.ws + WS_CT) + (size_t)item * EROWS * 128;
    if (tid < 64) {
        float di = 0.f, dn = 0.f;
        for (int mm = 0; mm < 64; ++mm) di += Sm[tid * 64 + mm];
        for (int d = 0; d < 128; ++d) dn += Q[tid * 128 + d] * ct[128 * 128 + d];
        const float den = di + sc[192 + tid] * dn;
        sc[256 + tid] = fmaxf(fabsf(den), __expf(-sc[128 + tid]));
    }
    const int e = tid & 127, lg = tid >> 7;
    float acc[16], acc2[16];
#pragma unroll
    for (int i = 0; i < 16; ++i) { acc[i] = 0.f; acc2[i] = 0.f; }
    for (int mm = 0; mm < 64; ++mm) { const float vv = Vt[mm * 128 + e];
#pragma unroll
        for (int i = 0; i < 16; ++i) acc[i] += Sm[(lg * 16 + i) * 64 + mm] * vv; }
    for (int d = 0; d < 128; ++d) { const float cv = ct[e * 128 + d];
#pragma unroll
        for (int i = 0; i < 16; ++i) acc2[i] += Q[(lg * 16 + i) * 128 + d] * cv; }
    __syncthreads();
#pragma unroll
    for (int i = 0; i < 16; ++i) { const int ll = lg * 16 + i;
        const float hv = (acc[i] + sc[192 + ll] * acc2[i]) / sc[256 + ll];
        const float o = sigmoidf_(bf2f(z[(size_t)(row0 + ll) * ZW + ZO + h * DH + e]));
        Kt[ll * 128 + e] = hv * o; }
    __syncthreads();
    const float* gm = a.in[I_GMH] + (size_t)l * DM + h * DH;
    bf16_t* mix = (bf16_t*)(a.ws + WS_MIX);
    for (int ll = wave * 8; ll < wave * 8 + 8; ++ll) {
        const float x0 = Kt[ll * 128 + 2 * lane], x1 = Kt[ll * 128 + 2 * lane + 1];
        const float rs = rsqrtf(wave_sum(x0 * x0 + x1 * x1) * (1.f / 128.f) + EPS);
        *(unsigned*)(mix + (size_t)(row0 + ll) * D + h * DH + 2 * lane) = pk2(x0 * rs * gm[2 * lane], x1 * rs * gm[2 * lane + 1]);
    }
    __syncthreads();
}


typedef short bf16x8 __attribute__((ext_vector_type(8)));
__device__ __forceinline__ f32x4 mfma16(bf16x8 a, bf16x8 b, f32x4 c) { return __builtin_amdgcn_mfma_f32_16x16x32_bf16(a, b, c, 0, 0, 0); }
#define WAVE_LDS_SYNC() asm volatile("s_waitcnt lgkmcnt(0)" ::: "memory")
#define LDS_BARRIER() do { asm volatile("s_waitcnt lgkmcnt(0)" ::: "memory"); __builtin_amdgcn_s_barrier(); asm volatile("" ::: "memory"); } while (0)
__device__ __forceinline__ void conv_load11(const bf16_t* zc, int row0, int l0, bool first_chunk, unsigned (&x)[11]) {
#pragma unroll
    for (int j = 0; j < 11; ++j) { const int ll = l0 - 3 + j; x[j] = (first_chunk && ll < 0) ? 0u : *(const unsigned*)(zc + (ptrdiff_t)(row0 + ll) * ZW); }
}
struct ConvW { float w[4][2]; float b[2]; };
__device__ __forceinline__ void conv_loadw(const float* wc, const float* bc, int col, ConvW& cw) {
#pragma unroll
    for (int j = 0; j < 4; ++j) { cw.w[j][0] = wc[j * 1024 + col]; cw.w[j][1] = wc[j * 1024 + col + 1]; }
    cw.b[0] = bc[col]; cw.b[1] = bc[col + 1];
}
__device__ __forceinline__ void conv_apply(const unsigned (&x)[11], const ConvW& cw, float (&out)[8][2]) {
#pragma unroll
    for (int i = 0; i < 8; ++i) { float a0 = cw.b[0], a1 = cw.b[1];
#pragma unroll
        for (int j = 0; j < 4; ++j) { a0 += cw.w[j][0] * bf2f(x[i + j] & 0xffffu); a1 += cw.w[j][1] * __uint_as_float(x[i + j] & 0xffff0000u); }
        out[i][0] = a0; out[i][1] = a1; }
}
struct MlRegs { unsigned xk[11], v[8]; ConvW cw; float gi, gf; };
__device__ __forceinline__ void ml_load(const Args& a, int l, int item, MlRegs& R) {
    const int b = item >> 8, c = (item >> 2) & 63, h = item & 3, row0 = b * SEQ + c * CH, tid = otid(), lane = tid & 63, wave = tid >> 6;
    const bf16_t* z = (const bf16_t*)(a.ws + WS_Z);
    const float* gates = (const float*)(a.ws + WS_SMALL + SM_GATES);
    const int cp = lane, lg = wave, colk = ZK + h * DH + 2 * cp, colv = ZV + h * DH + 2 * cp;
    conv_load11(z + colk, row0, 8 * lg, c == 0, R.xk);
#pragma unroll
    for (int i = 0; i < 8; ++i) R.v[i] = *(const unsigned*)(z + (size_t)(row0 + 8 * lg + i) * ZW + colv);
    conv_loadw(a.in[I_WCQK] + (size_t)l * 4 * 1024, a.in[I_BCQK] + (size_t)l * 1024, colk, R.cw);
    R.gi = gates[(size_t)(row0 + lane) * 8 + h]; R.gf = gates[(size_t)(row0 + lane) * 8 + 4 + h];
}
__device__ __forceinline__ void ml_compute(const Args& a, unsigned char* lds, int l, int item, MlRegs& R) {
    const int tid = otid(), lane = tid & 63, wave = tid >> 6, fr = lane & 15, fq = lane >> 4;
    unsigned char* KT = lds; unsigned char* VT = lds + 18432; float* RED = (float*)(lds + 36864); float* sc = (float*)(lds + 40960);
    const int cp = lane, lg = wave;
    unsigned (&xk)[11] = R.xk; unsigned (&v)[8] = R.v; ConvW& cw = R.cw;
    if (tid < 64) {
        chunk_gates_r(sc, R.gi, R.gf, lane);
        const float bl = __shfl(sc[lane], 63), al = bl - sc[lane] + sc[64 + lane];
        const float amax = wave_max(al);
        sc[128 + lane] = __expf(al - amax);
        if (lane == 0) { ((float*)(a.ws + WS_SMALL + SM_BL))[item] = bl; ((float*)(a.ws + WS_SMALL + SM_AMAX))[item] = amax; }
    }
    LDS_BARRIER();
    {
        float kk[8][2];
        conv_apply(xk, cw, kk);
        float n0 = 0.f, n1 = 0.f;
#pragma unroll
        for (int i = 0; i < 8; ++i) { const float wl = sc[128 + 8 * lg + i]; kk[i][0] = siluf_(kk[i][0]) * wl; kk[i][1] = siluf_(kk[i][1]) * wl; n0 += kk[i][0]; n1 += kk[i][1]; }
        u32x4 p0, p1;
#pragma unroll
        for (int i = 0; i < 4; ++i) { p0[i] = pk2(kk[2 * i][0], kk[2 * i + 1][0]); p1[i] = pk2(kk[2 * i][1], kk[2 * i + 1][1]); }
        *(u32x4*)(KT + (2 * cp) * 144 + lg * 16) = p0; *(u32x4*)(KT + (2 * cp + 1) * 144 + lg * 16) = p1;
        RED[lg * 128 + 2 * cp] = n0; RED[lg * 128 + 2 * cp + 1] = n1;
#pragma unroll
        for (int i = 0; i < 4; ++i) { p0[i] = (v[2 * i] & 0xffffu) | (v[2 * i + 1] << 16); p1[i] = (v[2 * i] >> 16) | (v[2 * i + 1] & 0xffff0000u); }
        *(u32x4*)(VT + (2 * cp) * 144 + lg * 16) = p0; *(u32x4*)(VT + (2 * cp + 1) * 144 + lg * 16) = p1;
    }
    LDS_BARRIER();
    bf16_t* ct = (bf16_t*)(a.ws + WS_CT) + (size_t)item * 128 * 128;
    {
        const int et0 = 2 * (wave & 3), dt0 = 4 * (wave >> 2);
        bf16x8 Vf[2][2], Kf[4][2];
#pragma unroll
        for (int i = 0; i < 2; ++i)
#pragma unroll
            for (int ks = 0; ks < 2; ++ks) Vf[i][ks] = *(const bf16x8*)(VT + ((et0 + i) * 16 + fr) * 144 + (ks * 32 + 8 * fq) * 2);
#pragma unroll
        for (int j = 0; j < 4; ++j)
#pragma unroll
            for (int ks = 0; ks < 2; ++ks) Kf[j][ks] = *(const bf16x8*)(KT + ((dt0 + j) * 16 + fr) * 144 + (ks * 32 + 8 * fq) * 2);
#pragma unroll
        for (int i = 0; i < 2; ++i)
#pragma unroll
            for (int j = 0; j < 4; ++j) {
                f32x4 acc = {0.f, 0.f, 0.f, 0.f};
                acc = mfma16(Kf[j][0], Vf[i][0], acc); acc = mfma16(Kf[j][1], Vf[i][1], acc);
                u32x2 w; w.x = pk2(acc[0], acc[1]); w.y = pk2(acc[2], acc[3]);
                *(u32x2*)(ct + ((et0 + i) * 16 + fr) * 128 + (dt0 + j) * 16 + 4 * fq) = w;
            }
    }
    if (tid < 128) { float s_ = 0.f;
#pragma unroll
        for (int g = 0; g < 8; ++g) s_ += RED[g * 128 + tid];
        ((float*)(a.ws + WS_DN))[(size_t)item * 128 + tid] = s_; }
    LDS_BARRIER();
}
struct MoRegs { unsigned xq[11], xk[11], v[8], ov[8]; float gi, gf, mprev; };
__device__ __forceinline__ void mo_load(const Args& a, int l, int item, MoRegs& R) {
    const int b = item >> 8, c = (item >> 2) & 63, h = item & 3, row0 = b * SEQ + c * CH, tid = otid(), lane = tid & 63, wave = tid >> 6;
    const bf16_t* z = (const bf16_t*)(a.ws + WS_Z);
    const float* gates = (const float*)(a.ws + WS_SMALL + SM_GATES);
    const int cp = lane, lg = wave, colq = ZQ + h * DH + 2 * cp, colk = ZK + h * DH + 2 * cp, colv = ZV + h * DH + 2 * cp, colo = ZO + h * DH + 2 * cp;
    conv_load11(z + colq, row0, 8 * lg, c == 0, R.xq);
    conv_load11(z + colk, row0, 8 * lg, c == 0, R.xk);
#pragma unroll
    for (int i = 0; i < 8; ++i) { R.v[i] = *(const unsigned*)(z + (size_t)(row0 + 8 * lg + i) * ZW + colv); R.ov[i] = *(const unsigned*)(z + (size_t)(row0 + 8 * lg + i) * ZW + colo); }
    R.gi = gates[(size_t)(row0 + lane) * 8 + h]; R.gf = gates[(size_t)(row0 + lane) * 8 + 4 + h];
    R.mprev = ((const float*)(a.ws + WS_SMALL + SM_MPREV))[item];
}
__device__ __forceinline__ void mo_compute(const Args& a, unsigned char* lds, int l, int item, MoRegs& R, ConvW& cwq, ConvW& cwk, int& hw) {
    const int b = item >> 8, c = (item >> 2) & 63, h = item & 3, row0 = b * SEQ + c * CH, tid = otid(), lane = tid & 63, wave = tid >> 6, fr = lane & 15, fq = lane >> 4;
    unsigned char* QN = lds; unsigned char* KN = lds + 17408; unsigned char* VT = lds + 34816; unsigned char* SP = lds + 53248; unsigned char* ON = lds + 62464;
    float* sc = (float*)(lds + 79872);
    float* SS = (float*)(lds + 79872 + 2048);
    const int cp = lane, lg = wave;
    unsigned (&xq)[11] = R.xq; unsigned (&xk)[11] = R.xk; unsigned (&v)[8] = R.v; unsigned (&ov)[8] = R.ov;
    bf16x8 Cf[4]; f32x4 dnv[4];
    { const bf16_t* ct = (const bf16_t*)(a.ws + WS_CT) + (size_t)item * 128 * 128; const float* dn = (const float*)(a.ws + WS_DN) + (size_t)item * 128;
#pragma unroll
      for (int ks = 0; ks < 4; ++ks) Cf[ks] = *(const bf16x8*)(ct + (wave * 16 + fr) * 128 + ks * 32 + 8 * fq);
#pragma unroll
      for (int j = 0; j < 4; ++j) dnv[j] = *(const f32x4*)(dn + (tid & 7) * 16 + 4 * j); }
    const float gm = a.in[I_GMH][(size_t)l * DM + h * DH + wave * 16 + fr];
    if (hw != h) { const float* wc = a.in[I_WCQK] + (size_t)l * 4 * 1024; const float* bc = a.in[I_BCQK] + (size_t)l * 1024;
        conv_loadw(wc, bc, ZQ + h * DH + 2 * cp, cwq); conv_loadw(wc, bc, ZK + h * DH + 2 * cp, cwk); hw = h; }
    if (tid < 64) {
        const float mprev = R.mprev;
        chunk_gates_r(sc, R.gi, R.gf, lane);
        float g = sc[64 + lane] - sc[lane];
#pragma unroll
        for (int o = 1; o < 64; o <<= 1) { const float n = __shfl_up(g, o); if (lane >= o) g = fmaxf(g, n); }
        const float mrow = sc[lane] + fmaxf(mprev, g);
        sc[128 + lane] = mrow; sc[192 + lane] = __expf(sc[lane] + mprev - mrow);
    }
    {
        float qq[8][2];
        conv_apply(xq, cwq, qq);
#pragma unroll
        for (int i = 0; i < 8; ++i) *(unsigned*)(QN + (8 * lg + i) * 272 + cp * 4) = pk2(siluf_(qq[i][0]) * 0.08838834764831845f, siluf_(qq[i][1]) * 0.08838834764831845f);
        conv_apply(xk, cwk, qq);
#pragma unroll
        for (int i = 0; i < 8; ++i) *(unsigned*)(KN + (8 * lg + i) * 272 + cp * 4) = pk2(siluf_(qq[i][0]), siluf_(qq[i][1]));
        u32x4 p0, p1;
#pragma unroll
        for (int i = 0; i < 4; ++i) { p0[i] = (v[2 * i] & 0xffffu) | (v[2 * i + 1] << 16); p1[i] = (v[2 * i] >> 16) | (v[2 * i + 1] & 0xffff0000u); }
        *(u32x4*)(VT + (2 * cp) * 144 + lg * 16) = p0; *(u32x4*)(VT + (2 * cp + 1) * 144 + lg * 16) = p1;
#pragma unroll
        for (int i = 0; i < 8; ++i) *(unsigned*)(ON + (8 * lg + i) * 272 + cp * 4) = ov[i];
    }
    LDS_BARRIER();
    {
        const int ll = tid >> 3, part = tid & 7; float s_ = 0.f;
#pragma unroll
        for (int j = 0; j < 4; ++j) { const u32x2 qv = *(const u32x2*)(QN + ll * 272 + (part * 16 + 4 * j) * 2);
            s_ += bf2f(qv.x & 0xffffu) * dnv[j].x + __uint_as_float(qv.x & 0xffff0000u) * dnv[j].y + bf2f(qv.y & 0xffffu) * dnv[j].z + __uint_as_float(qv.y & 0xffff0000u) * dnv[j].w; }
        s_ = sum8(s_);
        if (part == 0) sc[384 + ll] = s_;
    }
    {
        const int lt = wave & 3; const int ll = lt * 16 + fr; const float bl_ = sc[ll], mr = sc[128 + ll]; float dsum = 0.f;
#pragma unroll
        for (int mi = 0; mi < 2; ++mi) {
            const int mt = 2 * (wave >> 2) + mi; u32x2 pk = {0u, 0u};
            if (mt <= lt) {
                f32x4 acc = {0.f, 0.f, 0.f, 0.f};
#pragma unroll
                for (int ks = 0; ks < 4; ++ks) { const bf16x8 A = *(const bf16x8*)(KN + (mt * 16 + fr) * 272 + (ks * 32 + 8 * fq) * 2), B = *(const bf16x8*)(QN + (lt * 16 + fr) * 272 + (ks * 32 + 8 * fq) * 2);
                    acc = mfma16(A, B, acc); }
                float sv[4];
#pragma unroll
                for (int r = 0; r < 4; ++r) { const int mm = mt * 16 + 4 * fq + r; const float wgt = (mm <= ll) ? __expf(bl_ - sc[mm] + sc[64 + mm] - mr) : 0.f; sv[r] = acc[r] * wgt; dsum += sv[r]; }
                pk.x = pk2(sv[0], sv[1]); pk.y = pk2(sv[2], sv[3]);
            }
            *(u32x2*)(SP + ll * 144 + (mt * 16 + 4 * fq) * 2) = pk;
        }
        dsum += __shfl_xor(dsum, 16); dsum += __shfl_xor(dsum, 32);
        if (fq == 0) sc[256 + (wave >> 2) * 64 + ll] = dsum;
    }
    LDS_BARRIER();
    if (tid < 64) { const float den = sc[256 + tid] + sc[320 + tid] + sc[192 + tid] * sc[384 + tid]; sc[448 + tid] = fmaxf(fabsf(den), __expf(-sc[128 + tid])); }
    f32x4 acc1[4], acc2[4];
    {
        bf16x8 Vf[2];
#pragma unroll
        for (int ks = 0; ks < 2; ++ks) Vf[ks] = *(const bf16x8*)(VT + (wave * 16 + fr) * 144 + (ks * 32 + 8 * fq) * 2);
#pragma unroll
        for (int lt = 0; lt < 4; ++lt) {
            acc1[lt] = (f32x4){0.f, 0.f, 0.f, 0.f}; acc2[lt] = (f32x4){0.f, 0.f, 0.f, 0.f};
#pragma unroll
            for (int ks = 0; ks < 2; ++ks) acc1[lt] = mfma16(*(const bf16x8*)(SP + (lt * 16 + fr) * 144 + (ks * 32 + 8 * fq) * 2), Vf[ks], acc1[lt]);
#pragma unroll
            for (int ks = 0; ks < 4; ++ks) acc2[lt] = mfma16(*(const bf16x8*)(QN + (lt * 16 + fr) * 272 + (ks * 32 + 8 * fq) * 2), Cf[ks], acc2[lt]);
        }
    }
    LDS_BARRIER();
    float hm[4][4];
#pragma unroll
    for (int lt = 0; lt < 4; ++lt)
#pragma unroll
        for (int r = 0; r < 4; ++r) { const int ll = lt * 16 + 4 * fq + r;
            const float hv = (acc1[lt][r] + sc[192 + ll] * acc2[lt][r]) * frcp(sc[448 + ll]);
            const float o = sigmoidf_(bf2f(*(const bf16_t*)(ON + ll * 272 + (wave * 16 + fr) * 2)));
            hm[lt][r] = hv * o;
            const float q = sum16(hm[lt][r] * hm[lt][r]);
            if (fr == 0) SS[wave * 64 + ll] = q; }
    LDS_BARRIER();
    {
        unsigned char* HM = QN;
#pragma unroll
        for (int lt = 0; lt < 4; ++lt)
#pragma unroll
            for (int r = 0; r < 4; ++r) { const int ll = lt * 16 + 4 * fq + r; float tot = 0.f;
#pragma unroll
                for (int w = 0; w < 8; ++w) tot += SS[w * 64 + ll];
                *(bf16_t*)(HM + ll * 272 + (wave * 16 + fr) * 2) = (bf16_t)f2bf(hm[lt][r] * rsqrtf(tot * (1.f / 128.f) + EPS) * gm); }
        LDS_BARRIER();
        bf16_t* mix = (bf16_t*)(a.ws + WS_MIX);
#pragma unroll
        for (int j = 0; j < 2; ++j) { const int pc = tid + j * NT, ll = pc >> 4, q16 = pc & 15;
            *(u32x4*)(mix + (size_t)(row0 + ll) * D + h * DH + q16 * 8) = *(const u32x4*)(HM + ll * 272 + q16 * 16); }
    }
    LDS_BARRIER();
}

template <int MODE>
__device__ __forceinline__ void rglru_item(const Args& a, unsigned char* lds, int l, int item) {
    const int b = item >> 6, c = item & 63, row0 = b * SEQ + c * CH, ch = otid(), lane = ch & 63, nb = ch >> 6;
    float* xs = (float*)lds + nb * 64 * 64;
    const bf16_t* z = (const bf16_t*)(a.ws + WS_Z);
    const float* wcr = a.in[I_WCR] + (size_t)l * 4 * DR; const float bcr = a.in[I_BCR][l * DR + ch];
    const float w0 = wcr[ch], w1 = wcr[DR + ch], w2 = wcr[2 * DR + ch], w3 = wcr[3 * DR + ch];
    const bf16_t* zc = z + ZXR + ch;
    float xm3 = 0.f, xm2 = 0.f, xm1 = 0.f;
    { const int s0 = c * CH; if (s0 >= 3) { xm3 = bf2f(zc[(size_t)(row0 - 3) * ZW]); xm2 = bf2f(zc[(size_t)(row0 - 2) * ZW]); xm1 = bf2f(zc[(size_t)(row0 - 1) * ZW]); } }
#pragma unroll 4
    for (int t = 0; t < 64; ++t) { const float x0 = bf2f(zc[(size_t)(row0 + t) * ZW]);
        xs[t * 64 + lane] = bcr + w0 * xm3 + w1 * xm2 + w2 * xm1 + w3 * x0; xm3 = xm2; xm2 = xm1; xm1 = x0; }
    unsigned wa[32], wx[32];
    const float* wra = a.in[I_WRA] + ((size_t)(l * NBR + nb) * 64) * 64 + lane; const float* wri = a.in[I_WRI] + ((size_t)(l * NBR + nb) * 64) * 64 + lane;
#pragma unroll
    for (int d = 0; d < 32; ++d) { wa[d] = pk2(wra[(2 * d) * 64], wra[(2 * d + 1) * 64]); wx[d] = pk2(wri[(2 * d) * 64], wri[(2 * d + 1) * 64]); }
    const float ba = a.in[I_BRA][l * DR + ch], bx = a.in[I_BRI][l * DR + ch];
    const float lam = a.in[I_LAM][l * DR + ch];
    const float sp = fmaxf(-lam, 0.f) + log1pf(__expf(-fabsf(lam)));
    float hst = 0.f, ap = 1.f;
    if (MODE == 1) hst = ((const float*)(a.ws + WS_SMALL + SM_RGP))[(size_t)item * DR + ch];
    const float gr = a.in[I_GR][l * DR + ch];
    bf16_t* mix = (bf16_t*)(a.ws + WS_MIX);
    __syncthreads();
#pragma unroll 1
    for (int t = 0; t < 64; ++t) {
        float ra = ba, ia = bx;
#pragma unroll
        for (int d4 = 0; d4 < 16; ++d4) { const f32x4 xv = *(const f32x4*)(xs + t * 64 + 4 * d4);
#pragma unroll
            for (int q = 0; q < 2; ++q) { const unsigned pa = wa[2 * d4 + q], px = wx[2 * d4 + q];
                ra += xv[2 * q] * __uint_as_float(pa << 16) + xv[2 * q + 1] * __uint_as_float(pa & 0xffff0000u);
                ia += xv[2 * q] * __uint_as_float(px << 16) + xv[2 * q + 1] * __uint_as_float(px & 0xffff0000u); } }
        const float xo = xs[t * 64 + lane];
        const float r = sigmoidf_(ra), ig = sigmoidf_(ia), la = -8.f * r * sp, av = __expf(la);
        const float uu = sqrtf(-expm1f(2.f * la)) * (ig * xo);
        hst = av * hst + uu; ap *= av;
        if (MODE == 1) {
            const float y = bf2f(z[(size_t)(row0 + t) * ZW + ZYR + ch]);
            const float o = hst * gelu_tanh(y);
            const float rs = rsqrtf(wave_sum(o * o) * (1.f / 64.f) + EPS);
            mix[(size_t)(row0 + t) * D + DM + ch] = (bf16_t)f2bf(o * rs * gr);
        }
    }
    if (MODE == 0) { ((float*)(a.ws + WS_SMALL + SM_RGA))[(size_t)item * DR + ch] = ap; ((float*)(a.ws + WS_SMALL + SM_RGH))[(size_t)item * DR + ch] = hst; }
    __syncthreads();
}

template <int MODE>
__device__ __forceinline__ void rglru_fast(const Args& a, unsigned char* lds, int l, int item) {
    const int b = item >> 6, c = item & 63, row0 = b * SEQ + c * CH, ch = otid(), lane = ch & 63, nb = ch >> 6, fr = lane & 15, fq = lane >> 4;
    unsigned char* XA = lds + nb * 9216;
    float* GS = (float*)(lds + 73728 + nb * 8448);
    const bf16_t* z = (const bf16_t*)(a.ws + WS_Z);
    unsigned ypk[32];
    {
        const float* wcr = a.in[I_WCR] + (size_t)l * 4 * DR; const float bcr = a.in[I_BCR][l * DR + ch];
        const float w0 = wcr[ch], w1 = wcr[DR + ch], w2 = wcr[2 * DR + ch], w3 = wcr[3 * DR + ch];
        const bf16_t* zc = z + ZXR + ch;
        bf16_t xin[67];
#pragma unroll
        for (int t = 0; t < 67; ++t) xin[t] = (c == 0 && t < 3) ? (bf16_t)0 : zc[(ptrdiff_t)(row0 + t - 3) * ZW];
        if (MODE == 1) {
            bf16_t yb[64];
#pragma unroll
            for (int t = 0; t < 64; ++t) yb[t] = z[(size_t)(row0 + t) * ZW + ZYR + ch];
#pragma unroll
            for (int t = 0; t < 32; ++t) ypk[t] = (unsigned)yb[2 * t] | ((unsigned)yb[2 * t + 1] << 16);
        }
#pragma unroll
        for (int t = 0; t < 64; ++t)
            *(bf16_t*)(XA + t * 144 + lane * 2) = (bf16_t)f2bf(bcr + w0 * bf2f(xin[t]) + w1 * bf2f(xin[t + 1]) + w2 * bf2f(xin[t + 2]) + w3 * bf2f(xin[t + 3]));
    }
    bf16x8 Bf[8][2];
    { const bf16_t* wt = (const bf16_t*)(a.ws + WS_SMALL + SM_RGW) + (size_t)((l * NBR + nb) * 2) * 64 * 64;
#pragma unroll
        for (int ct = 0; ct < 8; ++ct)
#pragma unroll
            for (int ks = 0; ks < 2; ++ks) Bf[ct][ks] = *(const bf16x8*)(wt + (size_t)((ct >> 2) * 64 + (ct & 3) * 16 + fr) * 64 + ks * 32 + 8 * fq); }
    const float ba = a.in[I_BRA][l * DR + ch], bx = a.in[I_BRI][l * DR + ch];
    const float lam = a.in[I_LAM][l * DR + ch];
    const float sp8 = -8.f * (fmaxf(-lam, 0.f) + log1pf(__expf(-fabsf(lam))));
    float hst = 0.f, ap = 1.f;
    if (MODE == 1) hst = ((const float*)(a.ws + WS_SMALL + SM_RGP))[(size_t)item * DR + ch];
    const float gr = a.in[I_GR][l * DR + ch];
    bf16_t* mix = (bf16_t*)(a.ws + WS_MIX);
    WAVE_LDS_SYNC();
#pragma unroll
    for (int rt = 0; rt < 4; ++rt) {
        bf16x8 Af[2];
#pragma unroll
        for (int ks = 0; ks < 2; ++ks) Af[ks] = *(const bf16x8*)(XA + (rt * 16 + fr) * 144 + (ks * 32 + 8 * fq) * 2);
#pragma unroll
        for (int ct = 0; ct < 8; ++ct) {
            f32x4 acc = {0.f, 0.f, 0.f, 0.f};
            acc = mfma16(Af[0], Bf[ct][0], acc); acc = mfma16(Af[1], Bf[ct][1], acc);
#pragma unroll
            for (int r = 0; r < 4; ++r) GS[(4 * fq + r) * 132 + (ct >> 2) * 64 + (ct & 3) * 16 + fr] = acc[r];
        }
        WAVE_LDS_SYNC();
        {
            float ra[16], ia[16], xo[16], ov_[16];
#pragma unroll
            for (int tt = 0; tt < 16; ++tt) { ra[tt] = GS[tt * 132 + lane]; ia[tt] = GS[tt * 132 + 64 + lane]; xo[tt] = bf2f(*(const bf16_t*)(XA + (rt * 16 + tt) * 144 + lane * 2)); }
#pragma unroll
            for (int tt = 0; tt < 16; ++tt) {
                const float r = sigmoidf_(ra[tt] + ba), ig = sigmoidf_(ia[tt] + bx), la = sp8 * r, av = __expf(la);
                const float uu = __builtin_amdgcn_sqrtf(fmaxf(fmaf(-av, av, 1.f), 0.f)) * (ig * xo[tt]);
                hst = av * hst + uu; ap *= av;
                ov_[tt] = hst;
            }
            if (MODE == 1) {
#pragma unroll
                for (int tt = 0; tt < 16; ++tt) *(bf16_t*)(XA + (rt * 16 + tt) * 144 + lane * 2) = (bf16_t)f2bf(ov_[tt] * gelu_tanh((tt & 1) ? __uint_as_float(ypk[rt * 8 + (tt >> 1)] & 0xffff0000u) : bf2f(ypk[rt * 8 + (tt >> 1)] & 0xffffu)));
            }
        }
        WAVE_LDS_SYNC();
    }
    if (MODE == 1) {
        float ss = 0.f;
#pragma unroll
        for (int j = 0; j < 8; ++j) { const u32x4 v = *(const u32x4*)(XA + lane * 144 + j * 16);
#pragma unroll
            for (int q = 0; q < 4; ++q) { const float lo = bf2f(v[q] & 0xffffu), hi = __uint_as_float(v[q] & 0xffff0000u); ss += lo * lo + hi * hi; } }
        const float rs = rsqrtf(ss * (1.f / 64.f) + EPS) ;
#pragma unroll
        for (int t0 = 0; t0 < 64; t0 += 16) { float ovv[16];
#pragma unroll
            for (int tt = 0; tt < 16; ++tt) ovv[tt] = bf2f(*(const bf16_t*)(XA + (t0 + tt) * 144 + lane * 2));
#pragma unroll
            for (int tt = 0; tt < 16; ++tt) { const float rst = __int_as_float(__builtin_amdgcn_readlane(__float_as_int(rs), t0 + tt));
                *(bf16_t*)(XA + (t0 + tt) * 144 + lane * 2) = (bf16_t)f2bf(ovv[tt] * rst * gr); } }
        WAVE_LDS_SYNC();
#pragma unroll
        for (int j = 0; j < 8; ++j) { const int t = j * 8 + (lane >> 3), q16 = lane & 7;
            *(u32x4*)(mix + (size_t)(row0 + t) * D + DM + nb * 64 + q16 * 8) = *(const u32x4*)(XA + t * 144 + q16 * 16); }
    }
    if (MODE == 0) { ((float*)(a.ws + WS_SMALL + SM_RGA))[(size_t)item * DR + ch] = ap; ((float*)(a.ws + WS_SMALL + SM_RGH))[(size_t)item * DR + ch] = hst; }
    LDS_BARRIER();
}
__device__ __forceinline__ void rglru_scan(const Args& a, int G) {
    const int tid = otid();
    for (int i = blockIdx.x * 8 + (tid & 7); i < NBATCH * DR && tid < 8; i += G * 8) {
        const int b = i / DR, ch = i % DR;
        const float* A_ = (const float*)(a.ws + WS_SMALL + SM_RGA) + (size_t)(b * NC) * DR + ch; const float* H_ = (const float*)(a.ws + WS_SMALL + SM_RGH) + (size_t)(b * NC) * DR + ch;
        float* P_ = (float*)(a.ws + WS_SMALL + SM_RGP) + (size_t)(b * NC) * DR + ch;
        float hs = 0.f;
#pragma unroll 1
        for (int c0 = 0; c0 < NC; c0 += 16) {
            float av[16], hv[16];
#pragma unroll
            for (int j = 0; j < 16; ++j) { av[j] = A_[(c0 + j) * DR]; hv[j] = H_[(c0 + j) * DR]; }
#pragma unroll
            for (int j = 0; j < 16; ++j) { P_[(c0 + j) * DR] = hs; hs = av[j] * hs + hv[j]; }
        }
    }
}

__device__ __forceinline__ void phase_route(const Args& a, unsigned char* lds) {
    unsigned* wtot = (unsigned*)lds;
    int* pre = (int*)(lds + 256);
    int* tot = pre + 8;
    int* ce = tot + 16;
    unsigned* pref = (unsigned*)(lds + 2048);
    const int tid = otid(), lane = tid & 63, wave = tid >> 6, G = gridDim.x;
    const unsigned char* tok_p = (const unsigned char*)(a.ws + WS_SMALL + SM_TOKP); const float* tok_g = (const float*)(a.ws + WS_SMALL + SM_TOKG);
    int* row_tok = (int*)(a.ws + WS_SMALL + SM_ROWTOK); float* row_gate = (float*)(a.ws + WS_SMALL + SM_ROWGATE); int* tile_e = (int*)(a.ws + WS_SMALL + SM_TILEE);
    if (tid < 256) {
        unsigned long long hh = 0ull;
#pragma unroll
        for (int j = 0; j < 4; ++j) { const u32x4 v = ((const u32x4*)(tok_p + tid * 64))[j];
#pragma unroll
            for (int q = 0; q < 4; ++q)
#pragma unroll
                for (int bb = 0; bb < 4; ++bb) { const unsigned by = (v[q] >> (8 * bb)) & 0xffu; hh += (1ull << (8 * (by & 15u))) + (1ull << (8 * (by >> 4))); } }
        unsigned w[4];
#pragma unroll
        for (int i = 0; i < 4; ++i) { const unsigned two = (unsigned)(hh >> (16 * i)) & 0xffffu; w[i] = (two & 0xffu) | ((two >> 8) << 16); }
        unsigned inc[4];
#pragma unroll
        for (int i = 0; i < 4; ++i) { unsigned x = w[i];
#pragma unroll
            for (int o = 1; o < 64; o <<= 1) { const unsigned n = __shfl_up(x, o); if (lane >= o) x += n; }
            inc[i] = x; }
        if (lane == 63) {
#pragma unroll
            for (int i = 0; i < 4; ++i) wtot[wave * 4 + i] = inc[i]; }
        __builtin_amdgcn_s_waitcnt(0);
        __builtin_amdgcn_s_barrier();
#pragma unroll
        for (int i = 0; i < 4; ++i) { unsigned base = 0u;
            for (int ww = 0; ww < wave; ++ww) base += wtot[ww * 4 + i];
            pref[tid * 4 + i] = base + inc[i] - w[i];
            if (tid == 255) { const unsigned t2 = base + inc[i]; tot[2 * i] = (int)(t2 & 0xffffu); tot[2 * i + 1] = (int)(t2 >> 16); } }
    } else {
        __builtin_amdgcn_s_barrier();
    }
    __syncthreads();
    if (tid == 0) { int s_ = 0; for (int e = 0; e < 8; ++e) { tot[8 + e] = s_; s_ += (tot[e] + 255) & ~255; }
        if (blockIdx.x == 0) { int t = 0; for (int e = 0; e < 8; ++e) { const int n = (tot[e] + 255) >> 8; for (int j = 0; j < n; ++j) tile_e[t++] = e; } tile_e[255] = t; } }
    __syncthreads();
    for (int ck = blockIdx.x; ck < 256; ck += G) {
        if (tid < 128) { const unsigned by = tok_p[ck * 64 + (tid >> 1)]; ce[tid] = (tid & 1) ? (int)(by >> 4) : (int)(by & 15u); }
        __syncthreads();
        if (tid < 128) { const int e = ce[tid];
            int rank = 0, w0cnt = 0;
#pragma unroll
            for (int q = 0; q < 8; ++q) { const unsigned long long mk = __ballot(e == q); if (e == q) rank = __popcll(mk & ((1ull << lane) - 1ull)); if (wave == 0 && lane == 0) ce[128 + q] = __popcll(mk); }
            __builtin_amdgcn_s_waitcnt(0);
            asm volatile("s_barrier" ::: "memory");
            if (wave == 1) rank += ce[128 + e];
            (void)w0cnt;
            const unsigned pw = pref[ck * 4 + (e >> 1)]; const int pr = (int)((e & 1) ? (pw >> 16) : (pw & 0xffffu));
            const int dest = tot[8 + e] + pr + rank;
            row_tok[dest] = ck * 64 + (tid >> 1); row_gate[dest] = tok_g[ck * 128 + tid]; ((int*)(a.ws + WS_SMALL + SM_ROWSLOT))[dest] = tid & 1; }
        else { asm volatile("s_barrier" ::: "memory"); }
        __syncthreads();
    }
}

#ifndef GEMM
#define GEMM gemm_fast
#endif
__global__ void __launch_bounds__(NT, 2) mk_fwd(Args a0) {
    extern __shared__ __attribute__((aligned(16))) unsigned char lds[];
    const int G = gridDim.x, bid = blockIdx.x, ph_lo = a0.ph_lo, ph_hi = a0.ph_hi;
    volatile LAS unsigned* xst = (volatile LAS unsigned*)(lds + LDS_BYTES - 64);
    if (threadIdx.x < 2) xst[threadIdx.x] = 0u;
    __syncthreads();
    const XcdBarrier xb = xcd_barrier_post((unsigned*)(a0.ws + WS_SMALL + SM_BAR), xst);
    int ph = 0;
#ifndef PROBE_CAT
#define PROBE_CAT 0
#define PROBE_N 1
#endif
#define PHASE_BEGIN(cat) if (ph >= ph_lo && ph < ph_hi) { for (int rep_ = 0; rep_ < ((cat) == PROBE_CAT ? PROBE_N : 1); ++rep_) { const bool lastrep = (rep_ + 1 == ((cat) == PROBE_CAT ? PROBE_N : 1)); (void)lastrep; const Args& a = *(const Args*)okarg(); unsigned char* const ws = a.ws; \
    bf16_t* const hn = (bf16_t*)(ws + WS_HN); bf16_t* const z = (bf16_t*)(ws + WS_Z); bf16_t* const mix = (bf16_t*)(ws + WS_MIX); bf16_t* const hid = (bf16_t*)(ws + WS_HID); \
    float* const gates = (float*)(ws + WS_SMALL + SM_GATES); int* const tok_e = (int*)(ws + WS_SMALL + SM_TOKP); float* const tok_g = (float*)(ws + WS_SMALL + SM_TOKG); \
    const int* const row_tok = (const int*)(ws + WS_SMALL + SM_ROWTOK); const float* const row_gate = (const float*)(ws + WS_SMALL + SM_ROWGATE); const int* const tile_e = (const int*)(ws + WS_SMALL + SM_TILEE); \
    (void)hn; (void)z; (void)mix; (void)hid; (void)gates; (void)tok_e; (void)tok_g; (void)row_tok; (void)row_gate; (void)tile_e;
#define PHASE_END(dosync) } for (int rep_ = 0; rep_ < (PROBE_CAT == 6 ? PROBE_N : 1); ++rep_) if ((dosync) && ph + 1 < ph_hi) { xcd_barrier(xb); } } ++ph;

    PHASE_BEGIN(1) phase_prologue(a, lds); __syncthreads();
        phase_rowpass<0, 1, 1, false>(lds, a.in[I_X], hn, nullptr, a.in[I_GMIX], (float*)(ws + WS_SSQ), a.in[I_WIN] + 2048, DIN, a.in[I_BIN] + 2048, gates, nullptr, nullptr, nullptr); PHASE_END(true)
    { constexpr int l = 0;
#define LAYER_PTRS bf16_t* const hb = (bf16_t*)(ws + (l ? WS_H1 : WS_HN)); bf16_t* const hbo = (bf16_t*)(ws + (l ? WS_HN : WS_H1)); float* const ssq = (float*)(ws + WS_SSQ + l * SSQ_STRIDE); float* const ssqo = (float*)(ws + WS_SSQ + (1 - l) * SSQ_STRIDE); (void)hb; (void)hbo; (void)ssq; (void)ssqo;
        PHASE_BEGIN(3) LAYER_PTRS { if (l == 1) phase_rowpass<1, 1, 0, false>(lds, nullptr, hb, nullptr, a.in[I_GMIX] + l * D, nullptr, a.in[I_WIN] + (size_t)l * D * DIN + 2048, DIN, a.in[I_BIN] + l * DIN + 2048, gates, nullptr, nullptr, nullptr);
            GridOrder S{M / 256, ZW / 256, G, bid}; EpiZ E{z, a.in[I_BIN] + l * DIN, ssq};
            GEMM(lds, hb, (const bf16_t*)(ws + (l ? WS_W_IN1 : WS_W_IN0)), D, S, E); } PHASE_END(true)
        PHASE_BEGIN(4) LAYER_PTRS { MlRegs cur, nxt; int it = bid; if (it < 1024) ml_load(a, l, it, cur); nxt = cur;
            for (; it < 1024; it += G) { if (it + G < 1024) ml_load(a, l, it + G, nxt); ml_compute(a, lds, l, it, cur); cur = nxt; }
            for (; it < 1280; it += G) rglru_fast<0>(a, lds, l, it - 1024); } PHASE_END(true)
        PHASE_BEGIN(0) LAYER_PTRS mlstm_scan(a, G); rglru_scan(a, G); PHASE_END(true)
        PHASE_BEGIN(5) LAYER_PTRS { MoRegs cur, nxt; ConvW cwq, cwk; int hw = -1; int it = bid; if (it < 1024) mo_load(a, l, it, cur); nxt = cur;
            for (; it < 1024; it += G) { if (it + G < 1024) mo_load(a, l, it + G, nxt); mo_compute(a, lds, l, it, cur, cwq, cwk, hw); cur = nxt; }
            for (; it < 1280; it += G) rglru_fast<1>(a, lds, l, it - 1024); } PHASE_END(true)
        PHASE_BEGIN(0) LAYER_PTRS { GridOrder S{M / 256, D / 256, G, bid}; EpiHres<l == 0> E{l == 0 ? a.in[I_X] : nullptr, hb, ssq};
            GEMM(lds, mix, (const bf16_t*)(ws + (l ? WS_W_OUT1 : WS_W_OUT0)), D, S, E); } PHASE_END(true)
        if (l == 0) {
            PHASE_BEGIN(3) LAYER_PTRS { GridOrder S{M / 256, 2 * DFF / 256, G, bid}; EpiSwiglu E{hid, ssq, nullptr};
                GEMM(lds, hb, (const bf16_t*)(ws + WS_W_FFGU), D, S, E);
                { constexpr int nun = (M / 256) * (2 * DFF / 256); const int first = nun % G;
                  TailOrder S2{M / 256, D / 256, G, bid, first}; EpiStoreBf16 E2{(bf16_t*)(ws + WS_PP0)};
                  GEMM(lds, (const bf16_t*)(ws + WS_PB0), (const bf16_t*)(ws + WS_W_PP0), DPLE, S2, E2); } } PHASE_END(true)
            PHASE_BEGIN(0) LAYER_PTRS { GridOrder S{M / 256, D / 256, G, bid}; EpiHres<false> E{nullptr, hb, ssq};
                GEMM(lds, hid, (const bf16_t*)(ws + WS_W_FFD), DFF, S, E); } PHASE_END(true)
        } else {
            PHASE_BEGIN(2) LAYER_PTRS phase_rowpass<1, 2, 0, false>(lds, nullptr, hb, nullptr, a.in[I_GFFN] + l * D, nullptr, a.in[I_WROUTER], 8, nullptr, nullptr, (unsigned char*)tok_e, tok_g, nullptr); PHASE_END(true)
            PHASE_BEGIN(12) LAYER_PTRS phase_route(a, lds); PHASE_END(true)
            PHASE_BEGIN(3) LAYER_PTRS { MoeOrder<true> S{tile_e[255], 2 * DFF / 256, G, bid, tile_e, row_tok, (size_t)5632 * D}; EpiSwiglu E{hid, ssq, row_tok};
                GEMM(lds, hb, (const bf16_t*)(ws + WS_W_EGU), D, S, E); } PHASE_END(true)
            PHASE_BEGIN(0) LAYER_PTRS { MoeOrder<false> S{tile_e[255], D / 256, G, bid, tile_e, nullptr, (size_t)D * DFF}; EpiMoeDown E{hb, (bf16_t*)a.out, row_tok, (const int*)(ws + WS_SMALL + SM_ROWSLOT), row_gate};
                GEMM(lds, hid, (const bf16_t*)(ws + WS_W_ED), DFF, S, E);
                { const int nun = tile_e[255] * (D / 256); const int first = nun > 2 * G ? nun - 2 * G : 0;
                  TailOrder S2{M / 256, D / 256, G, bid, first < G ? first : 0}; EpiStoreBf16 E2{(bf16_t*)a.out + (size_t)M * D};
                  GEMM(lds, (const bf16_t*)(ws + WS_PB1), (const bf16_t*)(ws + WS_W_PP1), DPLE, S2, E2); } } PHASE_END(true)
            PHASE_BEGIN(0) LAYER_PTRS phase_rowpass<1, 0, 1, true>(lds, nullptr, hb, (const bf16_t*)a.out, nullptr, ssq, nullptr, 0, nullptr, nullptr, nullptr, nullptr, nullptr); PHASE_END(true)
        }
        PHASE_BEGIN(10) LAYER_PTRS { GridOrder S{M / 256, D / 256, G, bid};
            EpiPle E{hb, hbo, l == 0 ? (const bf16_t*)(ws + WS_PP0) : (const bf16_t*)a.out + (size_t)M * D, ssqo, ssq}; GEMM(lds, hb, (const bf16_t*)(ws + WS_W_PG) + (size_t)l * D * D, D, S, E);
            if (l == 0 && bid == 0) { for (int i = otid(); i < D / 2; i += NT) ((unsigned*)(ws + WS_H1 + (size_t)M * D * 2))[i] = 0u; } } PHASE_END(true)
    }
    { constexpr int l = 1;
        PHASE_BEGIN(3) LAYER_PTRS { if (l == 1) phase_rowpass<1, 1, 0, false>(lds, nullptr, hb, nullptr, a.in[I_GMIX] + l * D, nullptr, a.in[I_WIN] + (size_t)l * D * DIN + 2048, DIN, a.in[I_BIN] + l * DIN + 2048, gates, nullptr, nullptr, nullptr);
            GridOrder S{M / 256, ZW / 256, G, bid}; EpiZ E{z, a.in[I_BIN] + l * DIN, ssq};
            GEMM(lds, hb, (const bf16_t*)(ws + (l ? WS_W_IN1 : WS_W_IN0)), D, S, E); } PHASE_END(true)
        PHASE_BEGIN(4) LAYER_PTRS { MlRegs cur, nxt; int it = bid; if (it < 1024) ml_load(a, l, it, cur); nxt = cur;
            for (; it < 1024; it += G) { if (it + G < 1024) ml_load(a, l, it + G, nxt); ml_compute(a, lds, l, it, cur); cur = nxt; }
            for (; it < 1280; it += G) rglru_fast<0>(a, lds, l, it - 1024); } PHASE_END(true)
        PHASE_BEGIN(0) LAYER_PTRS mlstm_scan(a, G); rglru_scan(a, G); PHASE_END(true)
        PHASE_BEGIN(5) LAYER_PTRS { MoRegs cur, nxt; ConvW cwq, cwk; int hw = -1; int it = bid; if (it < 1024) mo_load(a, l, it, cur); nxt = cur;
            for (; it < 1024; it += G) { if (it + G < 1024) mo_load(a, l, it + G, nxt); mo_compute(a, lds, l, it, cur, cwq, cwk, hw); cur = nxt; }
            for (; it < 1280; it += G) rglru_fast<1>(a, lds, l, it - 1024); } PHASE_END(true)
        PHASE_BEGIN(0) LAYER_PTRS { GridOrder S{M / 256, D / 256, G, bid}; EpiHres<l == 0> E{l == 0 ? a.in[I_X] : nullptr, hb, ssq};
            GEMM(lds, mix, (const bf16_t*)(ws + (l ? WS_W_OUT1 : WS_W_OUT0)), D, S, E); } PHASE_END(true)
        if (l == 0) {
            PHASE_BEGIN(3) LAYER_PTRS { GridOrder S{M / 256, 2 * DFF / 256, G, bid}; EpiSwiglu E{hid, ssq, nullptr};
                GEMM(lds, hb, (const bf16_t*)(ws + WS_W_FFGU), D, S, E);
                { constexpr int nun = (M / 256) * (2 * DFF / 256); const int first = nun % G;
                  TailOrder S2{M / 256, D / 256, G, bid, first}; EpiStoreBf16 E2{(bf16_t*)(ws + WS_PP0)};
                  GEMM(lds, (const bf16_t*)(ws + WS_PB0), (const bf16_t*)(ws + WS_W_PP0), DPLE, S2, E2); } } PHASE_END(true)
            PHASE_BEGIN(0) LAYER_PTRS { GridOrder S{M / 256, D / 256, G, bid}; EpiHres<false> E{nullptr, hb, ssq};
                GEMM(lds, hid, (const bf16_t*)(ws + WS_W_FFD), DFF, S, E); } PHASE_END(true)
        } else {
            PHASE_BEGIN(2) LAYER_PTRS phase_rowpass<1, 2, 0, false>(lds, nullptr, hb, nullptr, a.in[I_GFFN] + l * D, nullptr, a.in[I_WROUTER], 8, nullptr, nullptr, (unsigned char*)tok_e, tok_g, nullptr); PHASE_END(true)
            PHASE_BEGIN(12) LAYER_PTRS phase_route(a, lds); PHASE_END(true)
            PHASE_BEGIN(3) LAYER_PTRS { MoeOrder<true> S{tile_e[255], 2 * DFF / 256, G, bid, tile_e, row_tok, (size_t)5632 * D}; EpiSwiglu E{hid, ssq, row_tok};
                GEMM(lds, hb, (const bf16_t*)(ws + WS_W_EGU), D, S, E); } PHASE_END(true)
            PHASE_BEGIN(0) LAYER_PTRS { MoeOrder<false> S{tile_e[255], D / 256, G, bid, tile_e, nullptr, (size_t)D * DFF}; EpiMoeDown E{hb, (bf16_t*)a.out, row_tok, (const int*)(ws + WS_SMALL + SM_ROWSLOT), row_gate};
                GEMM(lds, hid, (const bf16_t*)(ws + WS_W_ED), DFF, S, E);
                { const int nun = tile_e[255] * (D / 256); const int first = nun > 2 * G ? nun - 2 * G : 0;
                  TailOrder S2{M / 256, D / 256, G, bid, first < G ? first : 0}; EpiStoreBf16 E2{(bf16_t*)a.out + (size_t)M * D};
                  GEMM(lds, (const bf16_t*)(ws + WS_PB1), (const bf16_t*)(ws + WS_W_PP1), DPLE, S2, E2); } } PHASE_END(true)
            PHASE_BEGIN(0) LAYER_PTRS phase_rowpass<1, 0, 1, true>(lds, nullptr, hb, (const bf16_t*)a.out, nullptr, ssq, nullptr, 0, nullptr, nullptr, nullptr, nullptr, nullptr); PHASE_END(true)
        }
        PHASE_BEGIN(10) LAYER_PTRS { GridOrder S{M / 256, D / 256, G, bid};
            EpiPle E{hb, hbo, l == 0 ? (const bf16_t*)(ws + WS_PP0) : (const bf16_t*)a.out + (size_t)M * D, ssqo, ssq}; GEMM(lds, hb, (const bf16_t*)(ws + WS_W_PG) + (size_t)l * D * D, D, S, E);
            if (l == 0 && bid == 0) { for (int i = otid(); i < D / 2; i += NT) ((unsigned*)(ws + WS_H1 + (size_t)M * D * 2))[i] = 0u; } } PHASE_END(true)
    }
    PHASE_BEGIN(0) phase_rowpass<1, 0, 2, false>(lds, nullptr, hn, nullptr, a.in[I_GFINAL], nullptr, nullptr, 0, nullptr, nullptr, nullptr, nullptr, a.out); PHASE_END(false)
}

extern "C" void kernel_launch(void* const* d_in, const int* in_sizes, int n_in, void* d_out, int out_size,
                              void* d_ws, size_t ws_size, hipStream_t stream) {
    static int grid = 0;
    if (grid == 0) {
        if (n_in != 29 || out_size != M * D || ws_size < WS_END) { fprintf(stderr, "kernel_launch: unexpected problem (n_in %d out %d ws %zu)\n", n_in, out_size, ws_size); grid = -1; return; }
        int dev = 0, cus = 0, per_cu = 0;
        (void)hipGetDevice(&dev);
        (void)hipDeviceGetAttribute(&cus, hipDeviceAttributeMultiprocessorCount, dev);
        (void)hipFuncSetAttribute((const void*)mk_fwd, hipFuncAttributeMaxDynamicSharedMemorySize, LDS_BYTES);
        (void)hipOccupancyMaxActiveBlocksPerMultiprocessor(&per_cu, (const void*)mk_fwd, NT, LDS_BYTES);
        if (per_cu < 1) { fprintf(stderr, "kernel_launch: occupancy query says %d blocks per CU\n", per_cu); per_cu = 1; }
        grid = cus;
    }
    if (grid < 0) return;
    Args a{};
    for (int i = 0; i < 29; ++i) a.in[i] = (const float*)d_in[i];
    a.out = (float*)d_out; a.ws = (unsigned char*)d_ws; a.ph_lo = 0; a.ph_hi = 1000;
    (void)hipMemsetAsync((unsigned char*)d_ws + WS_SMALL + SM_BAR, 0, 16 * 1024, stream);
    void* args[] = {&a};
    hipError_t e = hipLaunchCooperativeKernel((void*)mk_fwd, dim3(grid), dim3(NT), args, LDS_BYTES, stream);
    if (e != hipSuccess) fprintf(stderr, "cooperative launch failed: %s (grid %d)\n", hipGetErrorString(e), grid);
}
```

```cpp
#include <hip/hip_runtime.h>
#include <hip/hip_cooperative_groups.h>
#include <cstdio>
#include <cstdint>
namespace cg = cooperative_groups;

constexpr int NT = 512;
constexpr int D = 1024, NBATCH = 4, SEQ = 4096, M = NBATCH * SEQ;
constexpr int CH = 64, NC = SEQ / CH, NH = 4, DH = 128, DM = 512, DR = 512, NBR = 8, DBR = 64;
constexpr int DIN = 3080, ZW = 3072, DFF = 2816, NE = 8, DPLE = 256;
constexpr int PMAX = 2 * M + NE * 256, NTILE_MAX = PMAX / 256;
constexpr int EROWS = 129;
constexpr float EPS = 1e-6f;
constexpr int ZQ = 0, ZK = 512, ZV = 1024, ZO = 1536, ZXR = 2048, ZYR = 2560;

constexpr size_t MiB = 1u << 20;
constexpr size_t WS_SMALL = 0;
constexpr size_t WS_W_IN0 = 4 * MiB;
constexpr size_t WS_W_OUT0 = 10 * MiB;
constexpr size_t WS_W_FFGU = 12 * MiB;
constexpr size_t WS_W_FFD = 23 * MiB;
constexpr size_t WS_PB0 = WS_W_FFD + 5632 * 1024;
constexpr size_t WS_W_PP0 = WS_PB0 + 8 * MiB;
constexpr size_t WS_H1 = 4 * MiB;
constexpr size_t WS_W_IN1 = 37 * MiB;
constexpr size_t WS_W_OUT1 = 43 * MiB;
constexpr size_t WS_W_PG = 45 * MiB;
constexpr size_t WS_W_PP1 = 49 * MiB;
constexpr size_t WS_W_EGU = WS_W_PP1 + MiB / 2;
constexpr size_t WS_W_ED = WS_W_EGU + 88 * MiB;
constexpr size_t WS_PB1 = WS_W_ED + 44 * MiB;
constexpr size_t WS_HN = WS_PB1 + 8 * MiB;
static_assert(WS_H1 + (size_t)(M + 1) * D * 2 <= WS_W_IN1 && WS_W_PP0 + 1024 * 256 * 2 <= WS_W_IN1, "map");
constexpr size_t WS_RF = 222 * MiB;
constexpr size_t WS_Z = WS_RF;
constexpr size_t WS_CT = WS_Z + 96 * MiB;
constexpr size_t WS_DN = WS_CT + 32 * MiB;
constexpr size_t WS_MIX = WS_CT + 72 * MiB;
constexpr size_t WS_HID = WS_RF;
constexpr size_t WS_PP0 = WS_RF + 130 * MiB;
constexpr size_t WS_SSQ = WS_RF + 201 * MiB;
constexpr size_t SSQ_STRIDE = (size_t)(M + 16) * 64;
constexpr size_t WS_END = 435 * MiB;
static_assert(WS_MIX + (size_t)M * D * 2 <= WS_SSQ && WS_HID + (size_t)PMAX * DFF * 2 <= WS_SSQ && WS_SSQ + 2 * SSQ_STRIDE <= WS_END, "map");
static_assert(WS_HN + (size_t)(M + 1) * D * 2 <= WS_RF, "map");
static_assert(WS_MIX + (size_t)M * D * 2 <= WS_END, "map");
static_assert(WS_HID + (size_t)PMAX * DFF * 2 <= WS_END, "map");
static_assert(WS_DN + 1024 * 128 * 4 <= WS_PP0 && WS_PP0 + (size_t)M * D * 2 <= WS_MIX && WS_HID + (size_t)M * DFF * 2 <= WS_PP0, "map");
constexpr size_t SM_GATES = 0;
constexpr size_t SM_TOKE = 512 * 1024;
constexpr size_t SM_TOKG = SM_TOKE + 128 * 1024;
constexpr size_t SM_ROWTOK = SM_TOKG + 128 * 1024;
constexpr size_t SM_ROWGATE = SM_ROWTOK + 160 * 1024;
constexpr size_t SM_TILEE = SM_ROWGATE + 160 * 1024;
constexpr size_t SM_ROWSLOT = SM_TILEE + 4 * 1024;
constexpr size_t SM_TOKP = SM_ROWSLOT + 160 * 1024;
constexpr size_t SM_BL = SM_TOKP + 16 * 1024;
constexpr size_t SM_AMAX = SM_BL + 4 * 1024;
constexpr size_t SM_MPREV = SM_AMAX + 4 * 1024;
constexpr size_t SM_RGA = 2 * MiB;
constexpr size_t SM_RGH = SM_RGA + 512 * 1024;
constexpr size_t SM_RGP = SM_RGH + 512 * 1024;
constexpr size_t SM_BAR = SM_RGP + 512 * 1024;
constexpr size_t SM_RGW = SM_BAR + 16 * 1024;
static_assert(SM_MPREV + 4096 <= SM_RGA && SM_RGW + 256 * 1024 <= 4 * MiB, "small map");

constexpr int LDS_BYTES = 147456;

typedef unsigned short bf16_t;
typedef float f32x4 __attribute__((ext_vector_type(4)));
typedef unsigned u32x4 __attribute__((ext_vector_type(4)));
typedef unsigned u32x2 __attribute__((ext_vector_type(2)));

__device__ __forceinline__ float bf2f(unsigned v) { return __uint_as_float(v << 16); }
__device__ __forceinline__ unsigned pk2(float lo, float hi);
__device__ __forceinline__ unsigned f2bf(float f) { return pk2(f, 0.f) & 0xffffu; }
typedef float f32x2_t __attribute__((ext_vector_type(2))); typedef __bf16 bf16x2_t __attribute__((ext_vector_type(2)));
__device__ __forceinline__ unsigned pk2(float lo, float hi) { f32x2_t v = {lo, hi}; bf16x2_t b = __builtin_convertvector(v, bf16x2_t); return __builtin_bit_cast(unsigned, b); }
__device__ __forceinline__ float frcp(float x) { return __builtin_amdgcn_rcpf(x); }
__device__ __forceinline__ float sigmoidf_(float x) { return frcp(1.f + __expf(-x)); }
__device__ __forceinline__ float siluf_(float x) { return x * frcp(1.f + __expf(-x)); }
__device__ __forceinline__ float logsigmoidf_(float x) { return fminf(x, 0.f) - log1pf(__expf(-fabsf(x))); }
__device__ __forceinline__ float gelu_tanh(float y) { const float u2 = 1.5957691216057308f * (y + 0.044715f * y * y * y); return y * frcp(1.f + __expf(-u2)); }
__device__ __forceinline__ float wave_sum(float v) {
#pragma unroll
    for (int o = 1; o < 64; o <<= 1) v += __shfl_xor(v, o);
    return v;
}
__device__ __forceinline__ float wave_max(float v) {
#pragma unroll
    for (int o = 1; o < 64; o <<= 1) v = fmaxf(v, __shfl_xor(v, o));
    return v;
}

__device__ __forceinline__ float dpp_f(float v, const int ctrl_sel) {
    const int x = __float_as_int(v); int r;
    if (ctrl_sel == 0) r = __builtin_amdgcn_update_dpp(x, x, 0xB1, 0xF, 0xF, false);
    else if (ctrl_sel == 1) r = __builtin_amdgcn_update_dpp(x, x, 0x4E, 0xF, 0xF, false);
    else if (ctrl_sel == 2) r = __builtin_amdgcn_update_dpp(x, x, 0x141, 0xF, 0xF, false);
    else r = __builtin_amdgcn_update_dpp(x, x, 0x140, 0xF, 0xF, false);
    return __int_as_float(r);
}
__device__ __forceinline__ float sum4(float v) { v += dpp_f(v, 0); v += dpp_f(v, 1); return v; }
__device__ __forceinline__ float sum8(float v) { v = sum4(v); v += dpp_f(v, 2); return v; }
__device__ __forceinline__ float sum16(float v) { v = sum8(v); v += dpp_f(v, 3); return v; }
#define WAVE_LDS_SYNC() asm volatile("s_waitcnt lgkmcnt(0)" ::: "memory")
#define LDS_BARRIER() do { asm volatile("s_waitcnt lgkmcnt(0)" ::: "memory"); __builtin_amdgcn_s_barrier(); asm volatile("" ::: "memory"); } while (0)
__device__ __forceinline__ int otid() { int t = threadIdx.x; asm volatile("" : "+v"(t)); return t; }
__device__ __forceinline__ int oint(int v) { asm volatile("" : "+s"(v)); return v; }
__device__ __forceinline__ const void* okarg() { auto p = __builtin_amdgcn_kernarg_segment_ptr(); asm volatile("" : "+s"(p)); return (const void*)p; }

struct Args { const float* in[29]; float* out; unsigned char* ws; int ph_lo, ph_hi; };
enum { I_X = 0, I_P, I_GMIX, I_WIN, I_BIN, I_WCQK, I_BCQK, I_GMH, I_WCR, I_BCR, I_WRA, I_BRA, I_WRI, I_BRI, I_LAM, I_GR, I_WOUT, I_GFFN,
       I_WFG, I_WFU, I_WFD, I_WROUTER, I_WEG, I_WEU, I_WED, I_GPLE, I_WPG, I_WPP, I_GFINAL };


#define XB_TMO      128
#define XB_XCNT(j)  (256  + 64 * (j))
#define XB_XSUB(j)  (1280 + 64 * (j))
#define XB_XGEN(j)  (2304 + 64 * (j))
#define XB_TOP      3328
#define XB_TOPGEN   3392
#define XCD_BAR_WORDS 3456
#define XB_SPIN_CAP (1u << 18)
#define LAS __attribute__((address_space(3)))
__device__ __forceinline__ unsigned xb_ld(unsigned* p)              { return __hip_atomic_load(p, __ATOMIC_RELAXED, __HIP_MEMORY_SCOPE_AGENT); }
__device__ __forceinline__ unsigned xb_add(unsigned* p, unsigned v) { return __hip_atomic_fetch_add(p, v, __ATOMIC_RELAXED, __HIP_MEMORY_SCOPE_AGENT); }
__device__ __forceinline__ unsigned xb_xcc_id() { return (unsigned)__builtin_amdgcn_s_getreg((3 << 11) | 20) & 0xFu; }
#define XB_SPIN(cond, bar) do { unsigned _sp = 0; while (cond) { __builtin_amdgcn_s_sleep(1); \
    if ((++_sp & 255u) == 0u) { if (xb_ld(&(bar)[XB_TMO])) break; if (_sp > XB_SPIN_CAP) { atomicAdd(&(bar)[XB_TMO], 1u); break; } } } } while (0)
struct XcdBarrier { unsigned* bar; unsigned x; volatile LAS unsigned* st; };
__device__ __forceinline__ XcdBarrier xcd_barrier_post(unsigned* bar, volatile LAS unsigned* st) {
    XcdBarrier b; b.bar = bar; b.x = xb_xcc_id(); b.st = st;
    if (threadIdx.x == 0) (void)xb_add(&bar[XB_XCNT(b.x)], 1u);
    return b;
}
__device__ __forceinline__ void xcd_barrier_complete(unsigned* bar, unsigned x, unsigned& nloc, unsigned& nx) {
    const unsigned G = gridDim.x * gridDim.y * gridDim.z;
    unsigned sum, cnt, mine, sp = 0u;
    for (;;) {
        sum = 0u; cnt = 0u; mine = 0u;
#pragma unroll
        for (unsigned j = 0; j < 16; ++j) { const unsigned c = xb_ld(&bar[XB_XCNT(j)]); sum += c; cnt += (c > 0u) ? 1u : 0u; mine = (j == x) ? c : mine; }
        if (sum == G) break;
        __builtin_amdgcn_s_sleep(1);
        if ((++sp & 255u) == 0u) { if (xb_ld(&bar[XB_TMO])) break; if (sp > XB_SPIN_CAP) { atomicAdd(&bar[XB_TMO], 1u); break; } }
    }
    nloc = mine > 0u ? mine : 1u; nx = cnt > 0u ? cnt : 1u;
}
__device__ __forceinline__ void xcd_barrier(const XcdBarrier& b) {
    asm volatile("s_waitcnt vmcnt(0)" ::: "memory");
    __syncthreads();
    if (threadIdx.x == 0) {
        unsigned* bar = b.bar;
        __builtin_amdgcn_s_waitcnt(0);
        unsigned nloc = b.st[0], nx = b.st[1];
        if (nloc == 0u) { xcd_barrier_complete(bar, b.x, nloc, nx); b.st[0] = nloc; b.st[1] = nx; }
        const unsigned old = xb_add(&bar[XB_XSUB(b.x)], 1u);
        const unsigned gen = old / nloc;
        if (old + 1u == (gen + 1u) * nloc) {
            __builtin_amdgcn_fence(__ATOMIC_RELEASE, "agent");
            asm volatile("s_waitcnt vmcnt(0)" ::: "memory");
            const unsigned og = xb_add(&bar[XB_TOP], 1u);
            const unsigned tg = og / nx;
            if (og + 1u == (tg + 1u) * nx) xb_add(&bar[XB_TOPGEN], 1u);
            else XB_SPIN(xb_ld(&bar[XB_TOPGEN]) == tg, bar);
            __builtin_amdgcn_fence(__ATOMIC_ACQUIRE, "agent");
            xb_add(&bar[XB_XGEN(b.x)], 1u);
            asm volatile("s_waitcnt vmcnt(0)" ::: "memory");
        } else {
            XB_SPIN(xb_ld(&bar[XB_XGEN(b.x)]) == gen, bar);
            __builtin_amdgcn_fence(__ATOMIC_ACQUIRE, "agent");
            asm volatile("s_waitcnt vmcnt(0)" ::: "memory");
        }
    }
    __syncthreads();
}

struct CvtJob { const float* src; bf16_t* dst; int ld, k0, c0, K, n0; const float* gain; };
__device__ __forceinline__ void cvt_plain_job(CvtJob& o, const float* src, int K, int N, bf16_t* dst, int tile, const float* gain) {
    const int nt = N / 64, kb = tile / nt, nb = tile % nt; o.src = src; o.dst = dst; o.ld = N; o.k0 = kb * 64; o.c0 = nb * 64; o.K = K; o.n0 = nb * 64; o.gain = gain;
}
__device__ __forceinline__ void cvt_gu_job(CvtJob& o, const float* g, const float* u, bf16_t* dst, int tile, const float* gain) {
    const int nt = 5632 / 64, kb = tile / nt, nb = tile % nt, n0 = nb * 64, tt = n0 >> 8, half = (n0 >> 7) & 1, w = n0 & 127;
    o.src = half ? u : g; o.dst = dst; o.ld = DFF; o.k0 = kb * 64; o.c0 = tt * 128 + w; o.K = 1024; o.n0 = n0; o.gain = gain;
}
__device__ __forceinline__ void cvt_job(const Args& a, int it, CvtJob& o) {
    unsigned char* ws = a.ws;
    constexpr int T_IN = 16 * 48, T_OUT = 16 * 16, T_GU = 16 * 88, T_FD = 44 * 16, T_PG = 256, T_PP = 4 * 16;
    int r = it;
    if (r < 2 * T_IN) { const int l = r / T_IN, tile = r % T_IN; const int nt = ZW / 64, kb = tile / nt, nb = tile % nt, n0 = nb * 64;
        o.src = a.in[I_WIN] + (size_t)l * D * DIN; o.dst = (bf16_t*)(ws + (l ? WS_W_IN1 : WS_W_IN0)); o.ld = DIN; o.k0 = kb * 64; o.c0 = n0 < 2048 ? n0 : n0 + 8; o.K = D; o.n0 = n0; o.gain = a.in[I_GMIX] + l * D; return; }
    r -= 2 * T_IN;
    if (r < 2 * T_OUT) { const int l = r / T_OUT; cvt_plain_job(o, a.in[I_WOUT] + (size_t)l * D * D, D, D, (bf16_t*)(ws + (l ? WS_W_OUT1 : WS_W_OUT0)), r % T_OUT, nullptr); return; }
    r -= 2 * T_OUT;
    if (r < T_GU) { cvt_gu_job(o, a.in[I_WFG], a.in[I_WFU], (bf16_t*)(ws + WS_W_FFGU), r, a.in[I_GFFN]); return; }
    r -= T_GU;
    if (r < T_FD) { cvt_plain_job(o, a.in[I_WFD], DFF, D, (bf16_t*)(ws + WS_W_FFD), r, nullptr); return; }
    r -= T_FD;
    if (r < 2 * T_PG) { const int l = r / T_PG; cvt_plain_job(o, a.in[I_WPG] + (size_t)l * D * D, D, D, (bf16_t*)(ws + WS_W_PG) + (size_t)l * D * D, r % T_PG, a.in[I_GPLE] + l * D); return; }
    r -= 2 * T_PG;
    if (r < 2 * T_PP) { const int l = r / T_PP; cvt_plain_job(o, a.in[I_WPP] + (size_t)l * DPLE * D, DPLE, D, (bf16_t*)(ws + (l ? WS_W_PP1 : WS_W_PP0)), r % T_PP, nullptr); return; }
    r -= 2 * T_PP;
    if (r < 8 * T_GU) { const int e = r / T_GU; cvt_gu_job(o, a.in[I_WEG] + (size_t)e * D * DFF, a.in[I_WEU] + (size_t)e * D * DFF, (bf16_t*)(ws + WS_W_EGU) + (size_t)e * 5632 * D, r % T_GU, a.in[I_GFFN] + D); return; }
    r -= 8 * T_GU;
    { const int e = r / T_FD; cvt_plain_job(o, a.in[I_WED] + (size_t)e * DFF * D, DFF, D, (bf16_t*)(ws + WS_W_ED) + (size_t)e * D * DFF, r % T_FD, nullptr); }
}
__device__ __forceinline__ void phase_prologue(const Args& a, unsigned char* lds) {
    unsigned char* ws = a.ws;
    const int G = gridDim.x, t = otid();
    constexpr int T_IN = 16 * 48, T_OUT = 16 * 16, T_GU = 16 * 88, T_FD = 44 * 16, T_PG = 256, T_PP = 4 * 16;
    constexpr int NT_ALL = 2 * T_IN + 2 * T_OUT + T_GU + T_FD + 2 * T_PG + 2 * T_PP + 8 * T_GU + 8 * T_FD;
    constexpr int NB = 4;
    const int kk0 = t >> 4, cc = (t & 15) * 4, n = t >> 3, kg = t & 7;
    float4 v[NB][2], vn[NB][2];
    int it0 = blockIdx.x * NB;
    if (it0 < NT_ALL) {
#pragma unroll
        for (int b = 0; b < NB; ++b) { const int it = it0 + b < NT_ALL ? it0 + b : NT_ALL - 1; CvtJob jq; cvt_job(a, it, jq);
#pragma unroll
            for (int j = 0; j < 2; ++j) v[b][j] = *(const float4*)(jq.src + (size_t)(jq.k0 + kk0 + 32 * j) * jq.ld + jq.c0 + cc); }
    }
    for (; it0 < NT_ALL; it0 += G * NB) {
        const int itn = it0 + G * NB;
        if (itn < NT_ALL) {
#pragma unroll
            for (int b = 0; b < NB; ++b) { const int it = itn + b < NT_ALL ? itn + b : NT_ALL - 1; CvtJob jq; cvt_job(a, it, jq);
#pragma unroll
                for (int j = 0; j < 2; ++j) vn[b][j] = *(const float4*)(jq.src + (size_t)(jq.k0 + kk0 + 32 * j) * jq.ld + jq.c0 + cc); }
        }
#pragma unroll
        for (int b = 0; b < NB; ++b) { float* tl = (float*)lds + b * (64 * 65); const int it = it0 + b < NT_ALL ? it0 + b : NT_ALL - 1; CvtJob jq; cvt_job(a, it, jq);
#pragma unroll
            for (int j = 0; j < 2; ++j) { float4 w = v[b][j];
                if (jq.gain) { const float gk = jq.gain[jq.k0 + kk0 + 32 * j]; w.x *= gk; w.y *= gk; w.z *= gk; w.w *= gk; }
                float* p = tl + (kk0 + 32 * j) * 65 + cc; p[0] = w.x; p[1] = w.y; p[2] = w.z; p[3] = w.w; } }
        LDS_BARRIER();
#pragma unroll
        for (int b = 0; b < NB; ++b) { if (it0 + b >= NT_ALL) break; const float* s_ = (const float*)lds + b * (64 * 65) + (8 * kg) * 65 + n; CvtJob jq; cvt_job(a, it0 + b, jq);
            u32x4 o; o.x = pk2(s_[0], s_[65]); o.y = pk2(s_[130], s_[195]); o.z = pk2(s_[260], s_[325]); o.w = pk2(s_[390], s_[455]);
            *(u32x4*)(jq.dst + (size_t)(jq.n0 + n) * jq.K + jq.k0 + 8 * kg) = o; }
        LDS_BARRIER();
#pragma unroll
        for (int b = 0; b < NB; ++b) { v[b][0] = vn[b][0]; v[b][1] = vn[b][1]; }
    }
    const size_t np4 = (size_t)M * DPLE / 4;
    for (size_t i = (size_t)blockIdx.x * NT + otid(); i < 2 * np4; i += (size_t)G * NT) {
        const float4 v = ((const float4*)a.in[I_P])[i]; u32x2 o; o.x = pk2(v.x, v.y); o.y = pk2(v.z, v.w);
        if (i < np4) ((u32x2*)(ws + WS_PB0))[i] = o; else ((u32x2*)(ws + WS_PB1))[i - np4] = o; }
    for (int i = blockIdx.x * NT + otid(); i < 2 * 8 * 2 * 64 * 64; i += G * NT) {
        const int d = i & 63, e = (i >> 6) & 63, g = (i >> 12) & 1, ln = i >> 13;
        ((bf16_t*)(ws + WS_SMALL + SM_RGW))[i] = (bf16_t)f2bf((g ? a.in[I_WRI] : a.in[I_WRA])[((size_t)ln * 64 + d) * 64 + e]);
    }
    if (blockIdx.x == 0) { for (int i = otid(); i < D / 2; i += NT) ((unsigned*)(ws + WS_HN + (size_t)M * D * 2))[i] = 0u; if (otid() < 32) ((float*)(ws + WS_SSQ + (otid() >> 4) * SSQ_STRIDE))[(size_t)M * 16 + (otid() & 15)] = 0.f; }
    for (int i = blockIdx.x * NT + otid(); i < PMAX; i += G * NT) { ((int*)(ws + WS_SMALL + SM_ROWTOK))[i] = M; ((float*)(ws + WS_SMALL + SM_ROWGATE))[i] = 0.f; }
}

template <int IN, bool ADDY> struct RawRow {
    f32x4 x[IN == 0 ? 4 : 1]; u32x2 h[IN == 1 ? 4 : 1]; u32x2 y[ADDY ? 4 : 1];
    __device__ __forceinline__ void load(const float* xin, const bf16_t* hb, const bf16_t* y1, int r, int lane) {
#pragma unroll
        for (int j = 0; j < 4; ++j) {
            if (IN == 0) x[j] = ((const f32x4*)(xin + (size_t)r * D) + lane)[64 * j]; else h[j] = ((const u32x2*)(hb + (size_t)r * D) + lane)[64 * j];
            if (ADDY) y[j] = ((const u32x2*)(y1 + (size_t)r * D) + lane)[64 * j]; }
    }
    __device__ __forceinline__ void copy_from(const RawRow& o) {
#pragma unroll
        for (int j = 0; j < 4; ++j) { if (IN == 0) x[j] = o.x[j]; else h[j] = o.h[j]; if (ADDY) y[j] = o.y[j]; }
    }
};
template <int IN, int AUX, int WR, bool ADDY>
__device__ __forceinline__ void phase_rowpass(unsigned char* lds, const float* xin, bf16_t* hb, const bf16_t* y1, const float* g, float* ssq,
                                              const float* auxW, int auxld, const float* auxB, float* gates, unsigned char* tok_p, float* tok_g, float* fout) {
    float* wl = (float*)lds;
    const int tid = otid(), lane = tid & 63, wave = tid >> 6;
    if (AUX) {
        for (int i = tid; i < D * 8; i += NT) wl[i] = auxW[(size_t)(i >> 3) * auxld + (i & 7)];
        __syncthreads();
    }
    f32x4 gv[4];
    if (AUX || WR == 2) {
#pragma unroll
        for (int j = 0; j < 4; ++j) gv[j] = *(const f32x4*)(g + 4 * lane + 256 * j);
    }
    RawRow<1, ADDY> cur, nxt;
    const int rstep = gridDim.x * 8; int row = blockIdx.x * 8 + wave;
    if (IN == 1) { if (row < M) cur.load(xin, hb, y1, row, lane); nxt.copy_from(cur); }
    for (; row < M; row += rstep) {
        if (IN == 1) { if (row + rstep < M) nxt.load(xin, hb, y1, row + rstep, lane); }
        f32x4 v[4]; float ss = 0.f;
#pragma unroll
        for (int j = 0; j < 4; ++j) {
            if (IN == 0) v[j] = ((const f32x4*)(xin + (size_t)row * D) + lane)[64 * j];
            else { const u32x2 w = cur.h[j]; v[j] = (f32x4){bf2f(w.x & 0xffffu), __uint_as_float(w.x & 0xffff0000u), bf2f(w.y & 0xffffu), __uint_as_float(w.y & 0xffff0000u)}; }
            if (ADDY) { const u32x2 y = cur.y[j];
                v[j].x += bf2f(y.x & 0xffffu); v[j].y += __uint_as_float(y.x & 0xffff0000u); v[j].z += bf2f(y.y & 0xffffu); v[j].w += __uint_as_float(y.y & 0xffff0000u); }
            ss += (v[j].x * v[j].x + v[j].y * v[j].y) + (v[j].z * v[j].z + v[j].w * v[j].w); }
        if (IN == 1) cur.copy_from(nxt);
        const float tot = wave_sum(ss), rstd = rsqrtf(tot * (1.f / D) + EPS);
        if (WR == 1) {
            u32x2* o = (u32x2*)(hb + (size_t)row * D) + lane;
#pragma unroll
            for (int j = 0; j < 4; ++j) { u32x2 w; w.x = pk2(v[j].x, v[j].y); w.y = pk2(v[j].z, v[j].w); o[64 * j] = w; }
            if (lane < 16) ssq[(size_t)row * 16 + lane] = lane == 0 ? tot : 0.f;
        }
        if (AUX || WR == 2) {
#pragma unroll
            for (int j = 0; j < 4; ++j) v[j] = v[j] * rstd * gv[j];
        }
        if (WR == 2) {
            f32x4* o = (f32x4*)(fout + (size_t)row * D) + lane;
#pragma unroll
            for (int j = 0; j < 4; ++j) o[64 * j] = v[j];
        }
        if (AUX) {
            float acc[8];
#pragma unroll
            for (int c = 0; c < 8; ++c) acc[c] = 0.f;
#pragma unroll
            for (int j = 0; j < 4; ++j)
#pragma unroll
                for (int q = 0; q < 4; ++q) {
                    const int k = 4 * lane + 256 * j + q; const float xv = v[j][q];
                    const f32x4 w0 = *(const f32x4*)(wl + k * 8), w1 = *(const f32x4*)(wl + k * 8 + 4);
                    acc[0] += xv * w0.x; acc[1] += xv * w0.y; acc[2] += xv * w0.z; acc[3] += xv * w0.w;
                    acc[4] += xv * w1.x; acc[5] += xv * w1.y; acc[6] += xv * w1.z; acc[7] += xv * w1.w;
                }
#pragma unroll
            for (int c = 0; c < 8; ++c) acc[c] = wave_sum(acc[c]);
            if (AUX == 1) {
                if (lane < 8) { float s_ = acc[0];
#pragma unroll
                    for (int c = 1; c < 8; ++c) s_ = (lane == c) ? acc[c] : s_;
                    gates[(size_t)row * 8 + lane] = s_ + auxB[lane]; }
            } else {
                if (lane == 0) {
                    int e1 = 0; float v1 = acc[0];
#pragma unroll
                    for (int c = 1; c < 8; ++c) if (acc[c] > v1) { v1 = acc[c]; e1 = c; }
                    int e2 = -1; float v2 = -INFINITY;
#pragma unroll
                    for (int c = 0; c < 8; ++c) if (c != e1 && acc[c] > v2) { v2 = acc[c]; e2 = c; }
                    const float p2 = __expf(v2 - v1), inv = 1.f / (1.f + p2);
                    tok_p[row] = (unsigned char)(e1 | (e2 << 4)); tok_g[row * 2] = inv; tok_g[row * 2 + 1] = p2 * inv;
                }
            }
        }
    }
    __syncthreads();
}

struct Unit { int pm, pn; const int* rows; size_t bofs; };
struct GridOrder {
    static constexpr bool GATHER = false;
    int nM, nN, G, c;
    __device__ __forceinline__ bool next(int i, Unit& u) const {
        const int L = i * G + c; if (L >= nM * nN) return false;
        const int grp = L / (8 * nN), fm = grp * 8, gsz = (nM - fm) < 8 ? (nM - fm) : 8, w = L % (8 * nN);
        u.pm = fm + w % gsz; u.pn = w / gsz; u.rows = nullptr; u.bofs = 0; return true;
    }
};
struct TailOrder {
    static constexpr bool GATHER = false;
    int nM, nN, G, c, first;
    __device__ __forceinline__ bool next(int i, Unit& u) const {
        if (c < first) return false; const int L = i * (G - first) + (c - first); if (L >= nM * nN) return false;
        u.pm = L / nN; u.pn = L % nN; u.rows = nullptr; u.bofs = 0; return true;
    }
};
template <bool GATHER_> struct MoeOrder {
    static constexpr bool GATHER = GATHER_;
    int nM, nN, G, c; const int* tile_e; const int* rows; size_t estride;
    __device__ __forceinline__ bool next(int i, Unit& u) const {
        const int L = i * G + c; if (L >= nM * nN) return false;
        const int grp = L / (8 * nN), fm = grp * 8, gsz = (nM - fm) < 8 ? (nM - fm) : 8, w = L % (8 * nN);
        u.pm = fm + w % gsz; u.pn = w / gsz; u.rows = rows; u.bofs = (size_t)tile_e[u.pm] * estride; return true;
    }
};


namespace pg8 {
#define PG8_LAS __attribute__((address_space(3)))
typedef short bf16x8 __attribute__((ext_vector_type(8)));
constexpr int BM = 256, BK = 64, HALF = 128, HTB = HALF * BK * 2, STAGE_BYTES = 8 * HTB;
__device__ __forceinline__ int lds_byte(int r, int c) { const int st = (r >> 4) * 2 + (c >> 5), rr = r & 15, cc = c & 31, ob = rr * 64 + cc * 2; return st * 1024 + (ob ^ (((ob >> 9) & 1) << 5)); }
__device__ __forceinline__ void stage_rc(int b, int& R, int& C) { const int st = b / 1024, sb = b % 1024, swz = sb ^ (((sb >> 9) & 1) << 5); R = (st >> 1) * 16 + swz / 64; C = (st & 1) * 32 + (swz % 64) / 2; }

__device__ __forceinline__ int perm32(int rho) { const int n = rho >> 4, i = rho & 15; return 8 * (i >> 2) + 4 * n + (i & 3); }
__device__ __forceinline__ void unit_voff(const Unit& u, const int (&R)[2], const int (&C)[2], int K, unsigned (&vo)[2][2]) {
#pragma unroll
    for (int h = 0; h < 2; ++h)
#pragma unroll
        for (int i = 0; i < 2; ++i) { int row = u.pm * BM + h * HALF + R[i]; if (u.rows) row = u.rows[row]; vo[h][i] = ((unsigned)row * (unsigned)K + (unsigned)C[i]) * 2u; }
}

template <class Epi, class Sched, bool ALIGN_EPI, bool GATHER>
__device__ __forceinline__ void gemm_phase(unsigned char* lds_, const bf16_t* A_, const bf16_t* Bt_, const int K_, const Sched& S, const Epi& E) {
    PG8_LAS unsigned char* lds = (PG8_LAS unsigned char*)lds_;
    const int K = oint(K_);
    const int tid = otid(), wid = __builtin_amdgcn_readfirstlane(tid >> 6), lane = tid & 63, wr = wid >> 2, wc = wid & 3, fr = lane & 15, fq = lane >> 4;
    const int nt = K / BK;
    int R[2], C[2]; unsigned voffA[2], voffB[2];
#pragma unroll
    for (int i = 0; i < 2; ++i) { stage_rc(tid * 16 + i * 8192, R[i], C[i]); voffA[i] = (unsigned)(R[i] * K + C[i]) * 2u;
        const int Rb = Epi::PERM ? ((R[i] & ~31) + perm32(R[i] & 31)) : R[i]; voffB[i] = (unsigned)(Rb * K + C[i]) * 2u; }
    const size_t kstep = (size_t)(BK * 2);
    const size_t hstep = (size_t)HALF * K * 2;
    const size_t tstep = 2 * hstep;
    const unsigned ldsw = (unsigned)wid * 1024u;
    const int aoff = lds_byte(wr * 64 + fr, fq * 8), boff = lds_byte(wc * 32 + fr, fq * 8);
#define PG8_SA(b, h) (((b) * 2 + (h)) * HTB)
#define PG8_SB(b, h) ((4 + (b) * 2 + (h)) * HTB)
#define PG8_STAGE(bufoff, gbase, voff) do { _Pragma("unroll") for (int _i = 0; _i < 2; ++_i) \
        __builtin_amdgcn_global_load_lds((const unsigned*)((const char*)(gbase) + (voff)[_i]), (PG8_LAS unsigned*)(lds + (bufoff) + ldsw + _i * 8192), 16, 0, 0); } while (0)
#define PG8_STAGE_A(bufoff, base, h, VO) do { if constexpr (GATHER) { PG8_STAGE(bufoff, base, (VO)[h]); } else { PG8_STAGE(bufoff, (base) + (h) * hstep, voffA); } } while (0)
#define PG8_LDA(dst, b, h) do { _Pragma("unroll") for (int m = 0; m < 4; ++m) _Pragma("unroll") for (int k = 0; k < 2; ++k) dst[m][k] = *(const PG8_LAS bf16x8*)(lds + PG8_SA(b, h) + aoff + m * 2048 + k * 1024); } while (0)
#define PG8_LDB(dst, b, h) do { _Pragma("unroll") for (int n = 0; n < 2; ++n) _Pragma("unroll") for (int k = 0; k < 2; ++k) dst[n][k] = *(const PG8_LAS bf16x8*)(lds + PG8_SB(b, h) + boff + n * 2048 + k * 1024); } while (0)
#define PG8_MMA(ai, bj, At, Bt) do { __builtin_amdgcn_s_setprio(1); _Pragma("unroll") for (int m = 0; m < 4; ++m) _Pragma("unroll") for (int n = 0; n < 2; ++n) _Pragma("unroll") for (int k = 0; k < 2; ++k) \
        acc[ai][bj][m][n] = __builtin_amdgcn_mfma_f32_16x16x32_bf16(Bt[n][k], At[m][k], acc[ai][bj][m][n], 0, 0, 0); __builtin_amdgcn_s_setprio(0); } while (0)
#define PG8_WAIT_V(n) asm volatile("s_waitcnt vmcnt(" #n ")" ::: "memory")
#define PG8_WAIT_L(n) asm volatile("s_waitcnt lgkmcnt(" #n ")" ::: "memory")
#define PG8_BAR __builtin_amdgcn_s_barrier()
#define PG8_SCHED __builtin_amdgcn_sched_barrier(0)
    Unit cur, nxt; int ui = 0;
    if (!S.next(0, cur)) return;
    f32x4 acc[2][2][4][2];
#pragma unroll
    for (int a = 0; a < 2; ++a)
#pragma unroll
        for (int b = 0; b < 2; ++b)
#pragma unroll
            for (int m = 0; m < 4; ++m)
#pragma unroll
                for (int n = 0; n < 2; ++n) acc[a][b][m][n] = (f32x4){0.f, 0.f, 0.f, 0.f};
    bf16x8 At[4][2], B0[2][2], B1[2][2];
    unsigned vc[2][2], vn[2][2];
    if constexpr (GATHER) unit_voff(cur, R, C, K, vc);
    const char* cA = GATHER ? (const char*)A_ : (const char*)A_ + (size_t)cur.pm * tstep;
    const char* cB = (const char*)Bt_ + cur.bofs * 2 + (size_t)cur.pn * tstep;
    PG8_STAGE(PG8_SB(0, 0), cB, voffB); PG8_STAGE(PG8_SB(0, 1), cB + hstep, voffB); PG8_STAGE_A(PG8_SA(0, 0), cA, 0, vc); PG8_STAGE_A(PG8_SA(0, 1), cA, 1, vc);
    if (wr == 1) PG8_BAR;
    PG8_WAIT_V(2); PG8_BAR;
    PG8_STAGE(PG8_SB(1, 0), cB + kstep, voffB); PG8_STAGE_A(PG8_SA(1, 0), cA + kstep, 0, vc); PG8_STAGE(PG8_SB(1, 1), cB + hstep + kstep, voffB);
    PG8_WAIT_V(6); PG8_BAR;
    for (;;) {
        const bool has_next = S.next(ui + 1, nxt);
        const char* nA = cA; const char* nB = cB;
        if (has_next) { nB = (const char*)Bt_ + nxt.bofs * 2 + (size_t)nxt.pn * tstep; if constexpr (!GATHER) nA = (const char*)A_ + (size_t)nxt.pm * tstep; }
        if constexpr (GATHER) {
            if (has_next) unit_voff(nxt, R, C, K, vn);
            else {
#pragma unroll
                for (int h = 0; h < 2; ++h)
#pragma unroll
                    for (int i = 0; i < 2; ++i) vn[h][i] = vc[h][i]; } }
        for (int t = 0; t < nt; t += 2) {
            const bool last = (t == nt - 2);
            const char* a1 = cA + (size_t)(t + 1) * kstep;
            const char* a2 = last ? nA : cA + (size_t)(t + 2) * kstep; const char* b2 = last ? nB : cB + (size_t)(t + 2) * kstep;
            const char* a3 = a2 + kstep; const char* b3 = b2 + kstep;
            unsigned v2[2][2];
            if constexpr (GATHER) {
#pragma unroll
                for (int h = 0; h < 2; ++h)
#pragma unroll
                    for (int i = 0; i < 2; ++i) v2[h][i] = last ? vn[h][i] : vc[h][i]; }
            PG8_LDB(B0, 0, 0); PG8_LDB(B1, 0, 1); PG8_SCHED; PG8_LDA(At, 0, 0); PG8_STAGE_A(PG8_SA(1, 1), a1, 1, vc);
            PG8_WAIT_V(8); PG8_WAIT_L(0); PG8_BAR; PG8_MMA(0, 0, At, B0); PG8_MMA(0, 1, At, B1); PG8_BAR; PG8_SCHED;
            PG8_LDA(At, 0, 1); PG8_STAGE(PG8_SB(0, 0), b2, voffB); PG8_STAGE(PG8_SB(0, 1), b2 + hstep, voffB); PG8_STAGE_A(PG8_SA(0, 0), a2, 0, v2);
            PG8_WAIT_V(8); PG8_WAIT_L(0); PG8_BAR; PG8_MMA(1, 0, At, B0); PG8_MMA(1, 1, At, B1); PG8_BAR; PG8_SCHED;
            PG8_LDB(B0, 1, 0); PG8_LDB(B1, 1, 1); PG8_SCHED; PG8_LDA(At, 1, 0); PG8_STAGE_A(PG8_SA(0, 1), a2, 1, v2);
            PG8_WAIT_V(8); PG8_WAIT_L(0); PG8_BAR; PG8_MMA(0, 0, At, B0); PG8_MMA(0, 1, At, B1); PG8_BAR; PG8_SCHED;
            PG8_LDA(At, 1, 1); PG8_STAGE(PG8_SB(1, 0), b3, voffB); PG8_STAGE(PG8_SB(1, 1), b3 + hstep, voffB); PG8_STAGE_A(PG8_SA(1, 0), a3, 0, v2);
            PG8_WAIT_V(8); PG8_WAIT_L(0); PG8_BAR; PG8_MMA(1, 0, At, B0); PG8_MMA(1, 1, At, B1); PG8_BAR; PG8_SCHED;
        }
        if constexpr (ALIGN_EPI) { if (wr == 0) PG8_BAR; }
        { int pm_ = cur.pm, pn_ = cur.pn, fr_ = fr, fq_ = fq;
          asm volatile("" : "+s"(pm_), "+s"(pn_), "+v"(fr_), "+v"(fq_));
          E(acc, pm_, pn_, wr, wc, fr_, fq_); }
        if (!has_next) break;
#pragma unroll
        for (int a = 0; a < 2; ++a)
#pragma unroll
            for (int b = 0; b < 2; ++b)
#pragma unroll
                for (int m = 0; m < 4; ++m)
#pragma unroll
                    for (int n = 0; n < 2; ++n) acc[a][b][m][n] = (f32x4){0.f, 0.f, 0.f, 0.f};
        cur = nxt; cA = nA; cB = nB; ++ui;
        if constexpr (GATHER) {
#pragma unroll
            for (int h = 0; h < 2; ++h)
#pragma unroll
                for (int i = 0; i < 2; ++i) vc[h][i] = vn[h][i]; }
        if constexpr (ALIGN_EPI) { if (wr == 1) PG8_BAR; }
    }
    PG8_WAIT_V(0);
    if constexpr (!ALIGN_EPI) { if (wr == 0) PG8_BAR; }
    PG8_BAR;
#undef PG8_SA
#undef PG8_SB
#undef PG8_STAGE
#undef PG8_STAGE_A
#undef PG8_LDA
#undef PG8_LDB
#undef PG8_MMA
#undef PG8_WAIT_V
#undef PG8_WAIT_L
#undef PG8_BAR
#undef PG8_SCHED
}
}
template <class Epi, class Sched>
__device__ __forceinline__ void gemm_fast(unsigned char* lds, const bf16_t* A, const bf16_t* Bt, int K, const Sched& S, const Epi& E) {
    pg8::gemm_phase<Epi, Sched, true, Sched::GATHER>(lds, A, Bt, K, S, E);
    __syncthreads();
}

typedef f32x4 AccT[2][2][4][2];
#define EPI_ROW(ai, m) (pm * 256 + (ai) * 128 + wr * 64 + (m) * 16 + fr)
__device__ __forceinline__ void unpack8(const u32x4 w, f32x4& lo, f32x4& hi) {
    lo = (f32x4){bf2f(w.x & 0xffffu), __uint_as_float(w.x & 0xffff0000u), bf2f(w.y & 0xffffu), __uint_as_float(w.y & 0xffff0000u)};
    hi = (f32x4){bf2f(w.z & 0xffffu), __uint_as_float(w.z & 0xffff0000u), bf2f(w.w & 0xffffu), __uint_as_float(w.w & 0xffff0000u)};
}
__device__ __forceinline__ u32x4 pack8(const f32x4 v0, const f32x4 v1) { u32x4 w; w.x = pk2(v0.x, v0.y); w.y = pk2(v0.z, v0.w); w.z = pk2(v1.x, v1.y); w.w = pk2(v1.z, v1.w); return w; }
__device__ __forceinline__ float dot8(const f32x4 a, const f32x4 b) { return ((a.x * a.x + a.y * a.y) + (a.z * a.z + a.w * a.w)) + ((b.x * b.x + b.y * b.y) + (b.z * b.z + b.w * b.w)); }
__device__ __forceinline__ void epi_rstd(const float* ssq, const int* rowmap, int pm, int wr, int fr, int fq, float (&rs)[2][4]) {
    f32x4 p[2][4];
#pragma unroll
    for (int ai = 0; ai < 2; ++ai)
#pragma unroll
        for (int m = 0; m < 4; ++m) { int row = EPI_ROW(ai, m); if (rowmap) row = rowmap[row]; p[ai][m] = *(const f32x4*)((const char*)ssq + ((unsigned)row * 16u + 4u * (unsigned)fq) * 4u); }
#pragma unroll
    for (int ai = 0; ai < 2; ++ai)
#pragma unroll
        for (int m = 0; m < 4; ++m) { float t = (p[ai][m].x + p[ai][m].y) + (p[ai][m].z + p[ai][m].w); t += __shfl_xor(t, 16); t += __shfl_xor(t, 32); rs[ai][m] = rsqrtf(t * (1.f / 1024.f) + EPS); }
}
__device__ __forceinline__ void epi_ssq(float* ssq, int row, int slot, float s_, int fq) { s_ += __shfl_xor(s_, 16); s_ += __shfl_xor(s_, 32); if (fq == 0) *(float*)((char*)ssq + ((unsigned)row * 16u + (unsigned)slot) * 4u) = s_; }

struct EpiZ { static constexpr bool PERM = true; bf16_t* z; const float* bin; const float* ssq;
    __device__ __forceinline__ void operator()(const AccT& acc, int pm, int pn, int wr, int wc, int fr, int fq) const {
        const int c0 = pn * 256 + wc * 32 + 8 * fq; f32x4 bv[2][2]; float rs[2][4];
#pragma unroll
        for (int bj = 0; bj < 2; ++bj)
#pragma unroll
            for (int n = 0; n < 2; ++n) { const int cc = c0 + bj * 128 + n * 4; bv[bj][n] = *(const f32x4*)(bin + (cc < 2048 ? cc : cc + 8)); }
        epi_rstd(ssq, nullptr, pm, wr, fr, fq, rs);
#pragma unroll
        for (int ai = 0; ai < 2; ++ai)
#pragma unroll
            for (int m = 0; m < 4; ++m) { bf16_t* rp = z + (size_t)EPI_ROW(ai, m) * ZW + c0; const float r = rs[ai][m];
#pragma unroll
                for (int bj = 0; bj < 2; ++bj) *(u32x4*)(rp + bj * 128) = pack8(acc[ai][bj][m][0] * r + bv[bj][0], acc[ai][bj][m][1] * r + bv[bj][1]); } } };
template <bool XB> struct EpiHres { static constexpr bool PERM = true; const float* xb; bf16_t* hb; float* ssq;
    __device__ __forceinline__ void operator()(const AccT& acc, int pm, int pn, int wr, int wc, int fr, int fq) const {
        const int c0 = pn * 256 + wc * 32 + 8 * fq;
#pragma unroll
        for (int ai = 0; ai < 2; ++ai) {
            f32x4 lx[4][2][2]; u32x4 lh[4][2];
#pragma unroll
            for (int m = 0; m < 4; ++m)
#pragma unroll
                for (int bj = 0; bj < 2; ++bj) { const size_t o = (size_t)EPI_ROW(ai, m) * D + c0 + bj * 128;
                    if (XB) { lx[m][bj][0] = *(const f32x4*)(xb + o); lx[m][bj][1] = *(const f32x4*)(xb + o + 4); } else lh[m][bj] = *(const u32x4*)(hb + o); }
#pragma unroll
            for (int m = 0; m < 4; ++m) { float s_ = 0.f; const int row = EPI_ROW(ai, m);
#pragma unroll
                for (int bj = 0; bj < 2; ++bj) { f32x4 b0, b1; if (XB) { b0 = lx[m][bj][0]; b1 = lx[m][bj][1]; } else unpack8(lh[m][bj], b0, b1);
                    const f32x4 v0 = b0 + acc[ai][bj][m][0], v1 = b1 + acc[ai][bj][m][1]; s_ += dot8(v0, v1);
                    *(u32x4*)(hb + (size_t)row * D + c0 + bj * 128) = pack8(v0, v1); }
                epi_ssq(ssq, row, pn * 4 + wc, s_, fq); }
        } } };
struct EpiSwiglu { static constexpr bool PERM = true; bf16_t* hid; const float* ssq; const int* rowmap;
    __device__ __forceinline__ void operator()(const AccT& acc, int pm, int pn, int wr, int wc, int fr, int fq) const {
        const int c0 = pn * 128 + wc * 32 + 8 * fq; float rs[2][4];
        epi_rstd(ssq, rowmap, pm, wr, fr, fq, rs);
#pragma unroll
        for (int ai = 0; ai < 2; ++ai)
#pragma unroll
            for (int m = 0; m < 4; ++m) { u32x4 w; const float r = rs[ai][m];
#pragma unroll
                for (int n = 0; n < 2; ++n) { const f32x4 g = acc[ai][0][m][n] * r, u = acc[ai][1][m][n] * r;
                    w[2 * n] = pk2(siluf_(g.x) * u.x, siluf_(g.y) * u.y); w[2 * n + 1] = pk2(siluf_(g.z) * u.z, siluf_(g.w) * u.w); }
                *(u32x4*)(hid + (size_t)EPI_ROW(ai, m) * DFF + c0) = w; } } };
struct EpiMoeDown { static constexpr bool PERM = true; bf16_t* hb; bf16_t* y1; const int* row_tok; const int* row_slot; const float* row_gate;
    __device__ __forceinline__ void operator()(const AccT& acc, int pm, int pn, int wr, int wc, int fr, int fq) const {
        const int c0 = pn * 256 + wc * 32 + 8 * fq;
        int tok[2][4], slot[2][4]; float gt[2][4];
#pragma unroll
        for (int ai = 0; ai < 2; ++ai)
#pragma unroll
            for (int m = 0; m < 4; ++m) { const int row = EPI_ROW(ai, m); tok[ai][m] = row_tok[row]; slot[ai][m] = row_slot[row]; gt[ai][m] = row_gate[row]; }
#pragma unroll
        for (int ai = 0; ai < 2; ++ai) {
            u32x4 lh[4][2];
#pragma unroll
            for (int m = 0; m < 4; ++m) { const bool rmw = tok[ai][m] < M && slot[ai][m] == 0;
#pragma unroll
                for (int bj = 0; bj < 2; ++bj) lh[m][bj] = rmw ? *(const u32x4*)(hb + (size_t)tok[ai][m] * D + c0 + bj * 128) : (u32x4){0u, 0u, 0u, 0u}; }
#pragma unroll
            for (int m = 0; m < 4; ++m) { if (tok[ai][m] >= M) continue; const size_t o = (size_t)tok[ai][m] * D + c0; const float g = gt[ai][m];
                if (slot[ai][m] == 0) {
#pragma unroll
                    for (int bj = 0; bj < 2; ++bj) { f32x4 b0, b1; unpack8(lh[m][bj], b0, b1); *(u32x4*)(hb + o + bj * 128) = pack8(b0 + g * acc[ai][bj][m][0], b1 + g * acc[ai][bj][m][1]); }
                } else {
#pragma unroll
                    for (int bj = 0; bj < 2; ++bj) *(u32x4*)(y1 + o + bj * 128) = pack8(g * acc[ai][bj][m][0], g * acc[ai][bj][m][1]);
                } }
        } } };
struct EpiStoreBf16 { static constexpr bool PERM = true; bf16_t* out;
    __device__ __forceinline__ void operator()(const AccT& acc, int pm, int pn, int wr, int wc, int fr, int fq) const {
        const int c0 = pn * 256 + wc * 32 + 8 * fq;
#pragma unroll
        for (int ai = 0; ai < 2; ++ai)
#pragma unroll
            for (int m = 0; m < 4; ++m)
#pragma unroll
                for (int bj = 0; bj < 2; ++bj) *(u32x4*)(out + (size_t)EPI_ROW(ai, m) * D + c0 + bj * 128) = pack8(acc[ai][bj][m][0], acc[ai][bj][m][1]); } };
struct EpiPle { static constexpr bool PERM = true; const bf16_t* hin; bf16_t* hb; const bf16_t* pp; float* ssq; const float* ssq_in;
    __device__ __forceinline__ void operator()(const AccT& acc, int pm, int pn, int wr, int wc, int fr, int fq) const {
        const int c0 = pn * 256 + wc * 32 + 8 * fq; float rs[2][4];
        epi_rstd(ssq_in, nullptr, pm, wr, fr, fq, rs);
        u32x4 sg[2][4][2];
#pragma unroll
        for (int ai = 0; ai < 2; ++ai)
#pragma unroll
            for (int m = 0; m < 4; ++m)
#pragma unroll
                for (int bj = 0; bj < 2; ++bj) { f32x4 a0 = acc[ai][bj][m][0] * rs[ai][m], a1 = acc[ai][bj][m][1] * rs[ai][m];
#pragma unroll
                    for (int q = 0; q < 4; ++q) { a0[q] = sigmoidf_(a0[q]); a1[q] = sigmoidf_(a1[q]); }
                    sg[ai][m][bj] = pack8(a0, a1); }
        asm volatile("" ::: "memory");
#pragma unroll
        for (int ai = 0; ai < 2; ++ai) {
            u32x4 lh[4][2], lp[4][2];
#pragma unroll
            for (int m = 0; m < 4; ++m)
#pragma unroll
                for (int bj = 0; bj < 2; ++bj) { const unsigned ob = ((unsigned)EPI_ROW(ai, m) * D + c0 + bj * 128) * 2u;
                    lh[m][bj] = *(const u32x4*)((const char*)hin + ob); lp[m][bj] = *(const u32x4*)((const char*)pp + ob); }
#pragma unroll
            for (int m = 0; m < 4; ++m) { float s_ = 0.f; const int row = EPI_ROW(ai, m);
#pragma unroll
                for (int bj = 0; bj < 2; ++bj) { f32x4 h0, h1, p0, p1, g0, g1; unpack8(lh[m][bj], h0, h1); unpack8(lp[m][bj], p0, p1); unpack8(sg[ai][m][bj], g0, g1);
                    h0 += g0 * p0; h1 += g1 * p1; s_ += dot8(h0, h1);
                    *(u32x4*)((char*)hb + ((unsigned)row * D + c0 + bj * 128) * 2u) = pack8(h0, h1); }
                epi_ssq(ssq, row, pn * 4 + wc, s_, fq); }
        } } };

__device__ __forceinline__ float conv4(const bf16_t* zc, int row, int s, const float* w  , int wstride, float b) {
    float acc = b;
#pragma unroll
    for (int j = 0; j < 4; ++j) { const int ds = 3 - j; if (s - ds >= 0) acc += w[j * wstride] * bf2f(zc[(ptrdiff_t)(row - ds) * ZW]); }
    return acc;
}
__device__ __forceinline__ void chunk_gates(float* sc, const float* gates, int row0, int h, int lane) {
    const float ip = gates[(size_t)(row0 + lane) * 8 + h], fp = gates[(size_t)(row0 + lane) * 8 + 4 + h];
    float b = logsigmoidf_(fp);
#pragma unroll
    for (int o = 1; o < 64; o <<= 1) { const float n = __shfl_up(b, o); if (lane >= o) b += n; }
    sc[lane] = b; sc[64 + lane] = ip;
}
__device__ __forceinline__ void chunk_gates_r(float* sc, float ip, float fp, int lane) {
    float b = logsigmoidf_(fp);
#pragma unroll
    for (int o = 1; o < 64; o <<= 1) { const float n = __shfl_up(b, o); if (lane >= o) b += n; }
    sc[lane] = b; sc[64 + lane] = ip;
}
__device__ __forceinline__ void mlstm_local(const Args& a, unsigned char* lds, int l, int item) {
    const int b = item >> 8, c = (item >> 2) & 63, h = item & 3, row0 = b * SEQ + c * CH, tid = otid(), lane = tid & 63;
    float* Kt = (float*)lds;
    float* Vt = Kt + 64 * 128;
    float* sc = Vt + 64 * 128;
    const bf16_t* z = (const bf16_t*)(a.ws + WS_Z);
    const float* gates = (const float*)(a.ws + WS_SMALL + SM_GATES);
    if (tid < 64) {
        chunk_gates(sc, gates, row0, h, lane);
        const float bl = __shfl(sc[lane], 63), al = bl - sc[lane] + sc[64 + lane];
        const float amax = wave_max(al);
        sc[128 + lane] = __expf(al - amax);
        if (lane == 0) { ((float*)(a.ws + WS_SMALL + SM_BL))[item] = bl; ((float*)(a.ws + WS_SMALL + SM_AMAX))[item] = amax; }
    }
    const float* wc = a.in[I_WCQK] + (size_t)l * 4 * 1024; const float* bc = a.in[I_BCQK] + (size_t)l * 1024;
    for (int i = tid; i < 64 * 128; i += NT) {
        const int ll = i >> 7, d = i & 127, ch = ZK + h * DH + d;
        Kt[i] = siluf_(conv4(z + ch, row0 + ll, c * CH + ll, wc + ch, 1024, bc[ch]));
        Vt[i] = bf2f(z[(size_t)(row0 + ll) * ZW + ZV + h * DH + d]);
    }
    __syncthreads();
    const int d = tid & 127, eg = tid >> 7;
    float acc[33];
#pragma unroll
    for (int i = 0; i < 33; ++i) acc[i] = 0.f;
    for (int ll = 0; ll < 64; ++ll) {
        const float kd = Kt[ll * 128 + d] * sc[128 + ll];
#pragma unroll
        for (int i = 0; i < 32; ++i) acc[i] += Vt[ll * 128 + eg + 4 * i] * kd;
        acc[32] += kd;
    }
    float* ct = (float*)(a.ws + WS_CT) + (size_t)item * EROWS * 128;
#pragma unroll
    for (int i = 0; i < 32; ++i) ct[(eg + 4 * i) * 128 + d] = acc[i];
    if (eg == 0) ct[128 * 128 + d] = acc[32];
    __syncthreads();
}
__device__ __forceinline__ void mlstm_scan(const Args& a, int G) {
    const float* BL = (const float*)(a.ws + WS_SMALL + SM_BL); const float* AM = (const float*)(a.ws + WS_SMALL + SM_AMAX);
    float* MP = (float*)(a.ws + WS_SMALL + SM_MPREV);
    const int tid = otid();
    for (int w = blockIdx.x; w < 16 * 16; w += G) {
        const int bh = w >> 4, sl = w & 15, b = bh >> 2, h = bh & 3;
        unsigned* p = (unsigned*)(a.ws + WS_CT) + (size_t)((b * NC) * NH + h) * 8192 + sl * 512 + tid;
        float s0 = 0.f, s1 = 0.f, m = 0.f;
#pragma unroll 1
        for (int c0 = 0; c0 < NC; c0 += 16) {
            unsigned x[16];
#pragma unroll
            for (int j = 0; j < 16; ++j) x[j] = p[(size_t)(c0 + j) * (NH * 8192)];
#pragma unroll
            for (int j = 0; j < 16; ++j) {
                const int item = (b * NC + c0 + j) * NH + h;
                const float bl = BL[item], am = AM[item];
                const float mn = fmaxf(bl + m, am), dec = __expf(bl + m - mn), scl = __expf(am - mn);
                p[(size_t)(c0 + j) * (NH * 8192)] = pk2(s0, s1);
                if (sl == 0 && tid == 0) MP[item] = m;
                s0 = dec * s0 + scl * bf2f(x[j] & 0xffffu); s1 = dec * s1 + scl * __uint_as_float(x[j] & 0xffff0000u); m = mn;
            }
        }
        if (sl == 1 && tid < 128) {
            float* q = (float*)(a.ws + WS_DN) + (size_t)((b * NC) * NH + h) * 128 + tid;
            float sn = 0.f; m = 0.f;
#pragma unroll 1
            for (int c0 = 0; c0 < NC; c0 += 16) {
                float x[16];
#pragma unroll
                for (int j = 0; j < 16; ++j) x[j] = q[(size_t)(c0 + j) * (NH * 128)];
#pragma unroll
                for (int j = 0; j < 16; ++j) {
                    const int item = (b * NC + c0 + j) * NH + h;
                    const float bl = BL[item], am = AM[item];
                    const float mn = fmaxf(bl + m, am), dec = __expf(bl + m - mn), scl = __expf(am - mn);
                    q[(size_t)(c0 + j) * (NH * 128)] = sn;
                    sn = dec * sn + scl * x[j]; m = mn;
                }
            }
        }
    }
}
__device__ __forceinline__ void mlstm_out(const Args& a, unsigned char* lds, int l, int item) {
    const int b = item >> 8, c = (item >> 2) & 63, h = item & 3, row0 = b * SEQ + c * CH, tid = otid(), lane = tid & 63, wave = tid >> 6;
    float* Q = (float*)lds;
    float* Kt = Q + 64 * 128;
    float* Vt = Kt + 64 * 128;
    float* Sm = Vt + 64 * 128;
    float* sc = Sm + 64 * 64;
    const bf16_t* z = (const bf16_t*)(a.ws + WS_Z);
    const float* gates = (const float*)(a.ws + WS_SMALL + SM_GATES);
    const float mprev = ((const float*)(a.ws + WS_SMALL + SM_MPREV))[item];
    if (tid < 64) {
        chunk_gates(sc, gates, row0, h, lane);
        float g = sc[64 + lane] - sc[lane];
#pragma unroll
        for (int o = 1; o < 64; o <<= 1) { const float n = __shfl_up(g, o); if (lane >= o) g = fmaxf(g, n); }
        const float mrow = sc[lane] + fmaxf(mprev, g);
        sc[128 + lane] = mrow; sc[192 + lane] = __expf(sc[lane] + mprev - mrow);
    }
    const float* wc = a.in[I_WCQK] + (size_t)l * 4 * 1024; const float* bc = a.in[I_BCQK] + (size_t)l * 1024;
    for (int i = tid; i < 64 * 128; i += NT) {
        const int ll = i >> 7, d = i & 127, chq = ZQ + h * DH + d, chk = ZK + h * DH + d;
        Q[i] = siluf_(conv4(z + chq, row0 + ll, c * CH + ll, wc + chq, 1024, bc[chq])) * 0.08838834764831845f;
        Kt[i] = siluf_(conv4(z + chk, row0 + ll, c * CH + ll, wc + chk, 1024, bc[chk]));
        Vt[i] = bf2f(z[(size_t)(row0 + ll) * ZW + ZV + h * DH + d]);
    }
    __syncthreads();
    for (int i = tid; i < 64 * 64; i += NT) {
        const int ll = i >> 6, mm = i & 63; float s = 0.f;
        if (mm <= ll) {
            for (int d = 0; d < 128; ++d) s += Q[ll * 128 + d] * Kt[mm * 128 + d];
            s *= __expf(sc[ll] - sc[mm] + sc[64 + mm] - sc[128 + ll]);
        }
        Sm[i] = s;
    }
    __syncthreads();
    const float* ct = (const float*)(a.ws + WS_CT) + (size_t)item * EROWS * 128;
    if (tid < 64) {
        float di = 0.f, dn = 0.f;
        for (int mm = 0; mm < 64; ++mm) di += Sm[tid * 64 + mm];
        for (int d = 0; d < 128; ++d) dn += Q[tid * 128 + d] * ct[128 * 128 + d];
        const float den = di + sc[192 + tid] * dn;
        sc[256 + tid] = fmaxf(fabsf(den), __expf(-sc[128 + tid]));
    }
    const int e = tid & 127, lg = tid >> 7;
    float acc[16], acc2[16];
#pragma unroll
    for (int i = 0; i < 16; ++i) { acc[i] = 0.f; acc2[i] = 0.f; }
    for (int mm = 0; mm < 64; ++mm) { const float vv = Vt[mm * 128 + e];
#pragma unroll
        for (int i = 0; i < 16; ++i) acc[i] += Sm[(lg * 16 + i) * 64 + mm] * vv; }
    for (int d = 0; d < 128; ++d) { const float cv = ct[e * 128 + d];
#pragma unroll
        for (int i = 0; i < 16; ++i) acc2[i] += Q[(lg * 16 + i) * 128 + d] * cv; }
    __syncthreads();
#pragma unroll
    for (int i = 0; i < 16; ++i) { const int ll = lg * 16 + i;
        const float hv = (acc[i] + sc[192 + ll] * acc2[i]) / sc[256 + ll];
        const float o = sigmoidf_(bf2f(z[(size_t)(row0 + ll) * ZW + ZO + h * DH + e]));
        Kt[ll * 128 + e] = hv * o; }
    __syncthreads();
    const float* gm = a.in[I_GMH] + (size_t)l * DM + h * DH;
    bf16_t* mix = (bf16_t*)(a.ws + WS_MIX);
    for (int ll = wave * 8; ll < wave * 8 + 8; ++ll) {
        const float x0 = Kt[ll * 128 + 2 * lane], x1 = Kt[ll * 128 + 2 * lane + 1];
        const float rs = rsqrtf(wave_sum(x0 * x0 + x1 * x1) * (1.f / 128.f) + EPS);
        *(unsigned*)(mix + (size_t)(row0 + ll) * D + h * DH + 2 * lane) = pk2(x0 * rs * gm[2 * lane], x1 * rs * gm[2 * lane + 1]);
    }
    __syncthreads();
}


typedef short bf16x8 __attribute__((ext_vector_type(8)));
__device__ __forceinline__ f32x4 mfma16(bf16x8 a, bf16x8 b, f32x4 c) { return __builtin_amdgcn_mfma_f32_16x16x32_bf16(a, b, c, 0, 0, 0); }

__device__ __forceinline__ void conv_load11(const bf16_t* zc, int row0, int l0, bool first_chunk, unsigned (&x)[11]) {
#pragma unroll
    for (int j = 0; j < 11; ++j) { const int ll = l0 - 3 + j; x[j] = (first_chunk && ll < 0) ? 0u : *(const unsigned*)(zc + (ptrdiff_t)(row0 + ll) * ZW); }
}
struct ConvW { float w[4][2]; float b[2]; };
__device__ __forceinline__ void conv_loadw(const float* wc, const float* bc, int col, ConvW& cw) {
#pragma unroll
    for (int j = 0; j < 4; ++j) { cw.w[j][0] = wc[j * 1024 + col]; cw.w[j][1] = wc[j * 1024 + col + 1]; }
    cw.b[0] = bc[col]; cw.b[1] = bc[col + 1];
}
__device__ __forceinline__ void conv_apply(const unsigned (&x)[11], const ConvW& cw, float (&out)[8][2]) {
#pragma unroll
    for (int i = 0; i < 8; ++i) { float a0 = cw.b[0], a1 = cw.b[1];
#pragma unroll
        for (int j = 0; j < 4; ++j) { a0 += cw.w[j][0] * bf2f(x[i + j] & 0xffffu); a1 += cw.w[j][1] * __uint_as_float(x[i + j] & 0xffff0000u); }
        out[i][0] = a0; out[i][1] = a1; }
}
struct MlRegs { unsigned xk[11], v[8]; ConvW cw; float gi, gf; };
__device__ __forceinline__ void ml_load(const Args& a, int l, int item, MlRegs& R) {
    const int b = item >> 8, c = (item >> 2) & 63, h = item & 3, row0 = b * SEQ + c * CH, tid = otid(), lane = tid & 63, wave = tid >> 6;
    const bf16_t* z = (const bf16_t*)(a.ws + WS_Z);
    const float* gates = (const float*)(a.ws + WS_SMALL + SM_GATES);
    const int cp = lane, lg = wave, colk = ZK + h * DH + 2 * cp, colv = ZV + h * DH + 2 * cp;
    conv_load11(z + colk, row0, 8 * lg, c == 0, R.xk);
#pragma unroll
    for (int i = 0; i < 8; ++i) R.v[i] = *(const unsigned*)(z + (size_t)(row0 + 8 * lg + i) * ZW + colv);
    conv_loadw(a.in[I_WCQK] + (size_t)l * 4 * 1024, a.in[I_BCQK] + (size_t)l * 1024, colk, R.cw);
    R.gi = gates[(size_t)(row0 + lane) * 8 + h]; R.gf = gates[(size_t)(row0 + lane) * 8 + 4 + h];
}
__device__ __forceinline__ void ml_compute(const Args& a, unsigned char* lds, int l, int item, MlRegs& R) {
    const int tid = otid(), lane = tid & 63, wave = tid >> 6, fr = lane & 15, fq = lane >> 4;
    unsigned char* KT = lds; unsigned char* VT = lds + 18432; float* RED = (float*)(lds + 36864); float* sc = (float*)(lds + 40960);
    const int cp = lane, lg = wave;
    unsigned (&xk)[11] = R.xk; unsigned (&v)[8] = R.v; ConvW& cw = R.cw;
    if (tid < 64) {
        chunk_gates_r(sc, R.gi, R.gf, lane);
        const float bl = __shfl(sc[lane], 63), al = bl - sc[lane] + sc[64 + lane];
        const float amax = wave_max(al);
        sc[128 + lane] = __expf(al - amax);
        if (lane == 0) { ((float*)(a.ws + WS_SMALL + SM_BL))[item] = bl; ((float*)(a.ws + WS_SMALL + SM_AMAX))[item] = amax; }
    }
    LDS_BARRIER();
    {
        float kk[8][2];
        conv_apply(xk, cw, kk);
        float n0 = 0.f, n1 = 0.f;
#pragma unroll
        for (int i = 0; i < 8; ++i) { const float wl = sc[128 + 8 * lg + i]; kk[i][0] = siluf_(kk[i][0]) * wl; kk[i][1] = siluf_(kk[i][1]) * wl; n0 += kk[i][0]; n1 += kk[i][1]; }
        u32x4 p0, p1;
#pragma unroll
        for (int i = 0; i < 4; ++i) { p0[i] = pk2(kk[2 * i][0], kk[2 * i + 1][0]); p1[i] = pk2(kk[2 * i][1], kk[2 * i + 1][1]); }
        *(u32x4*)(KT + (2 * cp) * 144 + lg * 16) = p0; *(u32x4*)(KT + (2 * cp + 1) * 144 + lg * 16) = p1;
        RED[lg * 128 + 2 * cp] = n0; RED[lg * 128 + 2 * cp + 1] = n1;
#pragma unroll
        for (int i = 0; i < 4; ++i) { p0[i] = (v[2 * i] & 0xffffu) | (v[2 * i + 1] << 16); p1[i] = (v[2 * i] >> 16) | (v[2 * i + 1] & 0xffff0000u); }
        *(u32x4*)(VT + (2 * cp) * 144 + lg * 16) = p0; *(u32x4*)(VT + (2 * cp + 1) * 144 + lg * 16) = p1;
    }
    LDS_BARRIER();
    bf16_t* ct = (bf16_t*)(a.ws + WS_CT) + (size_t)item * 128 * 128;
    {
        const int et0 = 2 * (wave & 3), dt0 = 4 * (wave >> 2);
        bf16x8 Vf[2][2], Kf[4][2];
#pragma unroll
        for (int i = 0; i < 2; ++i)
#pragma unroll
            for (int ks = 0; ks < 2; ++ks) Vf[i][ks] = *(const bf16x8*)(VT + ((et0 + i) * 16 + fr) * 144 + (ks * 32 + 8 * fq) * 2);
#pragma unroll
        for (int j = 0; j < 4; ++j)
#pragma unroll
            for (int ks = 0; ks < 2; ++ks) Kf[j][ks] = *(const bf16x8*)(KT + ((dt0 + j) * 16 + fr) * 144 + (ks * 32 + 8 * fq) * 2);
#pragma unroll
        for (int i = 0; i < 2; ++i)
#pragma unroll
            for (int j = 0; j < 4; ++j) {
                f32x4 acc = {0.f, 0.f, 0.f, 0.f};
                acc = mfma16(Kf[j][0], Vf[i][0], acc); acc = mfma16(Kf[j][1], Vf[i][1], acc);
                u32x2 w; w.x = pk2(acc[0], acc[1]); w.y = pk2(acc[2], acc[3]);
                *(u32x2*)(ct + ((et0 + i) * 16 + fr) * 128 + (dt0 + j) * 16 + 4 * fq) = w;
            }
    }
    if (tid < 128) { float s_ = 0.f;
#pragma unroll
        for (int g = 0; g < 8; ++g) s_ += RED[g * 128 + tid];
        ((float*)(a.ws + WS_DN))[(size_t)item * 128 + tid] = s_; }
    LDS_BARRIER();
}
struct MoRegs { unsigned xq[11], xk[11], v[8], ov[8]; float gi, gf, mprev; };
__device__ __forceinline__ void mo_load(const Args& a, int l, int item, MoRegs& R) {
    const int b = item >> 8, c = (item >> 2) & 63, h = item & 3, row0 = b * SEQ + c * CH, tid = otid(), lane = tid & 63, wave = tid >> 6;
    const bf16_t* z = (const bf16_t*)(a.ws + WS_Z);
    const float* gates = (const float*)(a.ws + WS_SMALL + SM_GATES);
    const int cp = lane, lg = wave, colq = ZQ + h * DH + 2 * cp, colk = ZK + h * DH + 2 * cp, colv = ZV + h * DH + 2 * cp, colo = ZO + h * DH + 2 * cp;
    conv_load11(z + colq, row0, 8 * lg, c == 0, R.xq);
    conv_load11(z + colk, row0, 8 * lg, c == 0, R.xk);
#pragma unroll
    for (int i = 0; i < 8; ++i) { R.v[i] = *(const unsigned*)(z + (size_t)(row0 + 8 * lg + i) * ZW + colv); R.ov[i] = *(const unsigned*)(z + (size_t)(row0 + 8 * lg + i) * ZW + colo); }
    R.gi = gates[(size_t)(row0 + lane) * 8 + h]; R.gf = gates[(size_t)(row0 + lane) * 8 + 4 + h];
    R.mprev = ((const float*)(a.ws + WS_SMALL + SM_MPREV))[item];
}
__device__ __forceinline__ void mo_compute(const Args& a, unsigned char* lds, int l, int item, MoRegs& R, ConvW& cwq, ConvW& cwk, int& hw) {
    const int b = item >> 8, c = (item >> 2) & 63, h = item & 3, row0 = b * SEQ + c * CH, tid = otid(), lane = tid & 63, wave = tid >> 6, fr = lane & 15, fq = lane >> 4;
    unsigned char* QN = lds; unsigned char* KN = lds + 17408; unsigned char* VT = lds + 34816; unsigned char* SP = lds + 53248; unsigned char* ON = lds + 62464;
    float* sc = (float*)(lds + 79872);
    float* SS = (float*)(lds + 79872 + 2048);
    const int cp = lane, lg = wave;
    unsigned (&xq)[11] = R.xq; unsigned (&xk)[11] = R.xk; unsigned (&v)[8] = R.v; unsigned (&ov)[8] = R.ov;
    bf16x8 Cf[4]; f32x4 dnv[4];
    { const bf16_t* ct = (const bf16_t*)(a.ws + WS_CT) + (size_t)item * 128 * 128; const float* dn = (const float*)(a.ws + WS_DN) + (size_t)item * 128;
#pragma unroll
      for (int ks = 0; ks < 4; ++ks) Cf[ks] = *(const bf16x8*)(ct + (wave * 16 + fr) * 128 + ks * 32 + 8 * fq);
#pragma unroll
      for (int j = 0; j < 4; ++j) dnv[j] = *(const f32x4*)(dn + (tid & 7) * 16 + 4 * j); }
    const float gm = a.in[I_GMH][(size_t)l * DM + h * DH + wave * 16 + fr];
    if (hw != h) { const float* wc = a.in[I_WCQK] + (size_t)l * 4 * 1024; const float* bc = a.in[I_BCQK] + (size_t)l * 1024;
        conv_loadw(wc, bc, ZQ + h * DH + 2 * cp, cwq); conv_loadw(wc, bc, ZK + h * DH + 2 * cp, cwk); hw = h; }
    if (tid < 64) {
        const float mprev = R.mprev;
        chunk_gates_r(sc, R.gi, R.gf, lane);
        float g = sc[64 + lane] - sc[lane];
#pragma unroll
        for (int o = 1; o < 64; o <<= 1) { const float n = __shfl_up(g, o); if (lane >= o) g = fmaxf(g, n); }
        const float mrow = sc[lane] + fmaxf(mprev, g);
        sc[128 + lane] = mrow; sc[192 + lane] = __expf(sc[lane] + mprev - mrow);
    }
    {
        float qq[8][2];
        conv_apply(xq, cwq, qq);
#pragma unroll
        for (int i = 0; i < 8; ++i) *(unsigned*)(QN + (8 * lg + i) * 272 + cp * 4) = pk2(siluf_(qq[i][0]) * 0.08838834764831845f, siluf_(qq[i][1]) * 0.08838834764831845f);
        conv_apply(xk, cwk, qq);
#pragma unroll
        for (int i = 0; i < 8; ++i) *(unsigned*)(KN + (8 * lg + i) * 272 + cp * 4) = pk2(siluf_(qq[i][0]), siluf_(qq[i][1]));
        u32x4 p0, p1;
#pragma unroll
        for (int i = 0; i < 4; ++i) { p0[i] = (v[2 * i] & 0xffffu) | (v[2 * i + 1] << 16); p1[i] = (v[2 * i] >> 16) | (v[2 * i + 1] & 0xffff0000u); }
        *(u32x4*)(VT + (2 * cp) * 144 + lg * 16) = p0; *(u32x4*)(VT + (2 * cp + 1) * 144 + lg * 16) = p1;
#pragma unroll
        for (int i = 0; i < 8; ++i) *(unsigned*)(ON + (8 * lg + i) * 272 + cp * 4) = ov[i];
    }
    LDS_BARRIER();
    {
        const int ll = tid >> 3, part = tid & 7; float s_ = 0.f;
#pragma unroll
        for (int j = 0; j < 4; ++j) { const u32x2 qv = *(const u32x2*)(QN + ll * 272 + (part * 16 + 4 * j) * 2);
            s_ += bf2f(qv.x & 0xffffu) * dnv[j].x + __uint_as_float(qv.x & 0xffff0000u) * dnv[j].y + bf2f(qv.y & 0xffffu) * dnv[j].z + __uint_as_float(qv.y & 0xffff0000u) * dnv[j].w; }
        s_ = sum8(s_);
        if (part == 0) sc[384 + ll] = s_;
    }
    {
        const int lt = wave & 3; const int ll = lt * 16 + fr; const float bl_ = sc[ll], mr = sc[128 + ll]; float dsum = 0.f;
#pragma unroll
        for (int mi = 0; mi < 2; ++mi) {
            const int mt = 2 * (wave >> 2) + mi; u32x2 pk = {0u, 0u};
            if (mt <= lt) {
                f32x4 acc = {0.f, 0.f, 0.f, 0.f};
#pragma unroll
                for (int ks = 0; ks < 4; ++ks) { const bf16x8 A = *(const bf16x8*)(KN + (mt * 16 + fr) * 272 + (ks * 32 + 8 * fq) * 2), B = *(const bf16x8*)(QN + (lt * 16 + fr) * 272 + (ks * 32 + 8 * fq) * 2);
                    acc = mfma16(A, B, acc); }
                float sv[4];
#pragma unroll
                for (int r = 0; r < 4; ++r) { const int mm = mt * 16 + 4 * fq + r; const float wgt = (mm <= ll) ? __expf(bl_ - sc[mm] + sc[64 + mm] - mr) : 0.f; sv[r] = acc[r] * wgt; dsum += sv[r]; }
                pk.x = pk2(sv[0], sv[1]); pk.y = pk2(sv[2], sv[3]);
            }
            *(u32x2*)(SP + ll * 144 + (mt * 16 + 4 * fq) * 2) = pk;
        }
        dsum += __shfl_xor(dsum, 16); dsum += __shfl_xor(dsum, 32);
        if (fq == 0) sc[256 + (wave >> 2) * 64 + ll] = dsum;
    }
    LDS_BARRIER();
    if (tid < 64) { const float den = sc[256 + tid] + sc[320 + tid] + sc[192 + tid] * sc[384 + tid]; sc[448 + tid] = fmaxf(fabsf(den), __expf(-sc[128 + tid])); }
    f32x4 acc1[4], acc2[4];
    {
        bf16x8 Vf[2];
#pragma unroll
        for (int ks = 0; ks < 2; ++ks) Vf[ks] = *(const bf16x8*)(VT + (wave * 16 + fr) * 144 + (ks * 32 + 8 * fq) * 2);
#pragma unroll
        for (int lt = 0; lt < 4; ++lt) {
            acc1[lt] = (f32x4){0.f, 0.f, 0.f, 0.f}; acc2[lt] = (f32x4){0.f, 0.f, 0.f, 0.f};
#pragma unroll
            for (int ks = 0; ks < 2; ++ks) acc1[lt] = mfma16(*(const bf16x8*)(SP + (lt * 16 + fr) * 144 + (ks * 32 + 8 * fq) * 2), Vf[ks], acc1[lt]);
#pragma unroll
            for (int ks = 0; ks < 4; ++ks) acc2[lt] = mfma16(*(const bf16x8*)(QN + (lt * 16 + fr) * 272 + (ks * 32 + 8 * fq) * 2), Cf[ks], acc2[lt]);
        }
    }
    LDS_BARRIER();
    float hm[4][4];
#pragma unroll
    for (int lt = 0; lt < 4; ++lt)
#pragma unroll
        for (int r = 0; r < 4; ++r) { const int ll = lt * 16 + 4 * fq + r;
            const float hv = (acc1[lt][r] + sc[192 + ll] * acc2[lt][r]) * frcp(sc[448 + ll]);
            const float o = sigmoidf_(bf2f(*(const bf16_t*)(ON + ll * 272 + (wave * 16 + fr) * 2)));
            hm[lt][r] = hv * o;
            const float q = sum16(hm[lt][r] * hm[lt][r]);
            if (fr == 0) SS[wave * 64 + ll] = q; }
    LDS_BARRIER();
    {
        unsigned char* HM = QN;
#pragma unroll
        for (int lt = 0; lt < 4; ++lt)
#pragma unroll
            for (int r = 0; r < 4; ++r) { const int ll = lt * 16 + 4 * fq + r; float tot = 0.f;
#pragma unroll
                for (int w = 0; w < 8; ++w) tot += SS[w * 64 + ll];
                *(bf16_t*)(HM + ll * 272 + (wave * 16 + fr) * 2) = (bf16_t)f2bf(hm[lt][r] * rsqrtf(tot * (1.f / 128.f) + EPS) * gm); }
        LDS_BARRIER();
        bf16_t* mix = (bf16_t*)(a.ws + WS_MIX);
#pragma unroll
        for (int j = 0; j < 2; ++j) { const int pc = tid + j * NT, ll = pc >> 4, q16 = pc & 15;
            *(u32x4*)(mix + (size_t)(row0 + ll) * D + h * DH + q16 * 8) = *(const u32x4*)(HM + ll * 272 + q16 * 16); }
    }
    LDS_BARRIER();
}

template <int MODE>
__device__ __forceinline__ void rglru_item(const Args& a, unsigned char* lds, int l, int item) {
    const int b = item >> 6, c = item & 63, row0 = b * SEQ + c * CH, ch = otid(), lane = ch & 63, nb = ch >> 6;
    float* xs = (float*)lds + nb * 64 * 64;
    const bf16_t* z = (const bf16_t*)(a.ws + WS_Z);
    const float* wcr = a.in[I_WCR] + (size_t)l * 4 * DR; const float bcr = a.in[I_BCR][l * DR + ch];
    const float w0 = wcr[ch], w1 = wcr[DR + ch], w2 = wcr[2 * DR + ch], w3 = wcr[3 * DR + ch];
    const bf16_t* zc = z + ZXR + ch;
    float xm3 = 0.f, xm2 = 0.f, xm1 = 0.f;
    { const int s0 = c * CH; if (s0 >= 3) { xm3 = bf2f(zc[(size_t)(row0 - 3) * ZW]); xm2 = bf2f(zc[(size_t)(row0 - 2) * ZW]); xm1 = bf2f(zc[(size_t)(row0 - 1) * ZW]); } }
#pragma unroll 4
    for (int t = 0; t < 64; ++t) { const float x0 = bf2f(zc[(size_t)(row0 + t) * ZW]);
        xs[t * 64 + lane] = bcr + w0 * xm3 + w1 * xm2 + w2 * xm1 + w3 * x0; xm3 = xm2; xm2 = xm1; xm1 = x0; }
    unsigned wa[32], wx[32];
    const float* wra = a.in[I_WRA] + ((size_t)(l * NBR + nb) * 64) * 64 + lane; const float* wri = a.in[I_WRI] + ((size_t)(l * NBR + nb) * 64) * 64 + lane;
#pragma unroll
    for (int d = 0; d < 32; ++d) { wa[d] = pk2(wra[(2 * d) * 64], wra[(2 * d + 1) * 64]); wx[d] = pk2(wri[(2 * d) * 64], wri[(2 * d + 1) * 64]); }
    const float ba = a.in[I_BRA][l * DR + ch], bx = a.in[I_BRI][l * DR + ch];
    const float lam = a.in[I_LAM][l * DR + ch];
    const float sp = fmaxf(-lam, 0.f) + log1pf(__expf(-fabsf(lam)));
    float hst = 0.f, ap = 1.f;
    if (MODE == 1) hst = ((const float*)(a.ws + WS_SMALL + SM_RGP))[(size_t)item * DR + ch];
    const float gr = a.in[I_GR][l * DR + ch];
    bf16_t* mix = (bf16_t*)(a.ws + WS_MIX);
    __syncthreads();
#pragma unroll 1
    for (int t = 0; t < 64; ++t) {
        float ra = ba, ia = bx;
#pragma unroll
        for (int d4 = 0; d4 < 16; ++d4) { const f32x4 xv = *(const f32x4*)(xs + t * 64 + 4 * d4);
#pragma unroll
            for (int q = 0; q < 2; ++q) { const unsigned pa = wa[2 * d4 + q], px = wx[2 * d4 + q];
                ra += xv[2 * q] * __uint_as_float(pa << 16) + xv[2 * q + 1] * __uint_as_float(pa & 0xffff0000u);
                ia += xv[2 * q] * __uint_as_float(px << 16) + xv[2 * q + 1] * __uint_as_float(px & 0xffff0000u); } }
        const float xo = xs[t * 64 + lane];
        const float r = sigmoidf_(ra), ig = sigmoidf_(ia), la = -8.f * r * sp, av = __expf(la);
        const float uu = sqrtf(-expm1f(2.f * la)) * (ig * xo);
        hst = av * hst + uu; ap *= av;
        if (MODE == 1) {
            const float y = bf2f(z[(size_t)(row0 + t) * ZW + ZYR + ch]);
            const float o = hst * gelu_tanh(y);
            const float rs = rsqrtf(wave_sum(o * o) * (1.f / 64.f) + EPS);
            mix[(size_t)(row0 + t) * D + DM + ch] = (bf16_t)f2bf(o * rs * gr);
        }
    }
    if (MODE == 0) { ((float*)(a.ws + WS_SMALL + SM_RGA))[(size_t)item * DR + ch] = ap; ((float*)(a.ws + WS_SMALL + SM_RGH))[(size_t)item * DR + ch] = hst; }
    __syncthreads();
}

template <int MODE>
__device__ __forceinline__ void rglru_fast(const Args& a, unsigned char* lds, int l, int item) {
    const int b = item >> 6, c = item & 63, row0 = b * SEQ + c * CH, ch = otid(), lane = ch & 63, nb = ch >> 6, fr = lane & 15, fq = lane >> 4;
    unsigned char* XA = lds + nb * 9216;
    float* GS = (float*)(lds + 73728 + nb * 8448);
    const bf16_t* z = (const bf16_t*)(a.ws + WS_Z);
    unsigned ypk[32];
    {
        const float* wcr = a.in[I_WCR] + (size_t)l * 4 * DR; const float bcr = a.in[I_BCR][l * DR + ch];
        const float w0 = wcr[ch], w1 = wcr[DR + ch], w2 = wcr[2 * DR + ch], w3 = wcr[3 * DR + ch];
        const bf16_t* zc = z + ZXR + ch;
        bf16_t xin[67];
#pragma unroll
        for (int t = 0; t < 67; ++t) xin[t] = (c == 0 && t < 3) ? (bf16_t)0 : zc[(ptrdiff_t)(row0 + t - 3) * ZW];
        if (MODE == 1) {
            bf16_t yb[64];
#pragma unroll
            for (int t = 0; t < 64; ++t) yb[t] = z[(size_t)(row0 + t) * ZW + ZYR + ch];
#pragma unroll
            for (int t = 0; t < 32; ++t) ypk[t] = (unsigned)yb[2 * t] | ((unsigned)yb[2 * t + 1] << 16);
        }
#pragma unroll
        for (int t = 0; t < 64; ++t)
            *(bf16_t*)(XA + t * 144 + lane * 2) = (bf16_t)f2bf(bcr + w0 * bf2f(xin[t]) + w1 * bf2f(xin[t + 1]) + w2 * bf2f(xin[t + 2]) + w3 * bf2f(xin[t + 3]));
    }
    bf16x8 Bf[8][2];
    { const bf16_t* wt = (const bf16_t*)(a.ws + WS_SMALL + SM_RGW) + (size_t)((l * NBR + nb) * 2) * 64 * 64;
#pragma unroll
        for (int ct = 0; ct < 8; ++ct)
#pragma unroll
            for (int ks = 0; ks < 2; ++ks) Bf[ct][ks] = *(const bf16x8*)(wt + (size_t)((ct >> 2) * 64 + (ct & 3) * 16 + fr) * 64 + ks * 32 + 8 * fq); }
    const float ba = a.in[I_BRA][l * DR + ch], bx = a.in[I_BRI][l * DR + ch];
    const float lam = a.in[I_LAM][l * DR + ch];
    const float sp8 = -8.f * (fmaxf(-lam, 0.f) + log1pf(__expf(-fabsf(lam))));
    float hst = 0.f, ap = 1.f;
    if (MODE == 1) hst = ((const float*)(a.ws + WS_SMALL + SM_RGP))[(size_t)item * DR + ch];
    const float gr = a.in[I_GR][l * DR + ch];
    bf16_t* mix = (bf16_t*)(a.ws + WS_MIX);
    WAVE_LDS_SYNC();
#pragma unroll
    for (int rt = 0; rt < 4; ++rt) {
        bf16x8 Af[2];
#pragma unroll
        for (int ks = 0; ks < 2; ++ks) Af[ks] = *(const bf16x8*)(XA + (rt * 16 + fr) * 144 + (ks * 32 + 8 * fq) * 2);
#pragma unroll
        for (int ct = 0; ct < 8; ++ct) {
            f32x4 acc = {0.f, 0.f, 0.f, 0.f};
            acc = mfma16(Af[0], Bf[ct][0], acc); acc = mfma16(Af[1], Bf[ct][1], acc);
#pragma unroll
            for (int r = 0; r < 4; ++r) GS[(4 * fq + r) * 132 + (ct >> 2) * 64 + (ct & 3) * 16 + fr] = acc[r];
        }
        WAVE_LDS_SYNC();
        {
            float ra[16], ia[16], xo[16], ov_[16];
#pragma unroll
            for (int tt = 0; tt < 16; ++tt) { ra[tt] = GS[tt * 132 + lane]; ia[tt] = GS[tt * 132 + 64 + lane]; xo[tt] = bf2f(*(const bf16_t*)(XA + (rt * 16 + tt) * 144 + lane * 2)); }
#pragma unroll
            for (int tt = 0; tt < 16; ++tt) {
                const float r = sigmoidf_(ra[tt] + ba), ig = sigmoidf_(ia[tt] + bx), la = sp8 * r, av = __expf(la);
                const float uu = __builtin_amdgcn_sqrtf(fmaxf(fmaf(-av, av, 1.f), 0.f)) * (ig * xo[tt]);
                hst = av * hst + uu; ap *= av;
                ov_[tt] = hst;
            }
            if (MODE == 1) {
#pragma unroll
                for (int tt = 0; tt < 16; ++tt) *(bf16_t*)(XA + (rt * 16 + tt) * 144 + lane * 2) = (bf16_t)f2bf(ov_[tt] * gelu_tanh((tt & 1) ? __uint_as_float(ypk[rt * 8 + (tt >> 1)] & 0xffff0000u) : bf2f(ypk[rt * 8 + (tt >> 1)] & 0xffffu)));
            }
        }
        WAVE_LDS_SYNC();
    }
    if (MODE == 1) {
        float ss = 0.f;
#pragma unroll
        for (int j = 0; j < 8; ++j) { const u32x4 v = *(const u32x4*)(XA + lane * 144 + j * 16);
#pragma unroll
            for (int q = 0; q < 4; ++q) { const float lo = bf2f(v[q] & 0xffffu), hi = __uint_as_float(v[q] & 0xffff0000u); ss += lo * lo + hi * hi; } }
        const float rs = rsqrtf(ss * (1.f / 64.f) + EPS) ;
#pragma unroll
        for (int t0 = 0; t0 < 64; t0 += 16) { float ovv[16];
#pragma unroll
            for (int tt = 0; tt < 16; ++tt) ovv[tt] = bf2f(*(const bf16_t*)(XA + (t0 + tt) * 144 + lane * 2));
#pragma unroll
            for (int tt = 0; tt < 16; ++tt) { const float rst = __int_as_float(__builtin_amdgcn_readlane(__float_as_int(rs), t0 + tt));
                *(bf16_t*)(XA + (t0 + tt) * 144 + lane * 2) = (bf16_t)f2bf(ovv[tt] * rst * gr); } }
        WAVE_LDS_SYNC();
#pragma unroll
        for (int j = 0; j < 8; ++j) { const int t = j * 8 + (lane >> 3), q16 = lane & 7;
            *(u32x4*)(mix + (size_t)(row0 + t) * D + DM + nb * 64 + q16 * 8) = *(const u32x4*)(XA + t * 144 + q16 * 16); }
    }
    if (MODE == 0) { ((float*)(a.ws + WS_SMALL + SM_RGA))[(size_t)item * DR + ch] = ap; ((float*)(a.ws + WS_SMALL + SM_RGH))[(size_t)item * DR + ch] = hst; }
    LDS_BARRIER();
}
__device__ __forceinline__ void rglru_scan(const Args& a, int G) {
    const int tid = otid();
    for (int i = blockIdx.x * 8 + (tid & 7); i < NBATCH * DR && tid < 8; i += G * 8) {
        const int b = i / DR, ch = i % DR;
        const float* A_ = (const float*)(a.ws + WS_SMALL + SM_RGA) + (size_t)(b * NC) * DR + ch; const float* H_ = (const float*)(a.ws + WS_SMALL + SM_RGH) + (size_t)(b * NC) * DR + ch;
        float* P_ = (float*)(a.ws + WS_SMALL + SM_RGP) + (size_t)(b * NC) * DR + ch;
        float hs = 0.f;
#pragma unroll 1
        for (int c0 = 0; c0 < NC; c0 += 16) {
            float av[16], hv[16];
#pragma unroll
            for (int j = 0; j < 16; ++j) { av[j] = A_[(c0 + j) * DR]; hv[j] = H_[(c0 + j) * DR]; }
#pragma unroll
            for (int j = 0; j < 16; ++j) { P_[(c0 + j) * DR] = hs; hs = av[j] * hs + hv[j]; }
        }
    }
}

__device__ __forceinline__ void phase_route(const Args& a, unsigned char* lds) {
    unsigned* wtot = (unsigned*)lds;
    int* pre = (int*)(lds + 256);
    int* tot = pre + 8;
    int* ce = tot + 16;
    unsigned* pref = (unsigned*)(lds + 2048);
    const int tid = otid(), lane = tid & 63, wave = tid >> 6, G = gridDim.x;
    const unsigned char* tok_p = (const unsigned char*)(a.ws + WS_SMALL + SM_TOKP); const float* tok_g = (const float*)(a.ws + WS_SMALL + SM_TOKG);
    int* row_tok = (int*)(a.ws + WS_SMALL + SM_ROWTOK); float* row_gate = (float*)(a.ws + WS_SMALL + SM_ROWGATE); int* tile_e = (int*)(a.ws + WS_SMALL + SM_TILEE);
    if (tid < 256) {
        unsigned long long hh = 0ull;
#pragma unroll
        for (int j = 0; j < 4; ++j) { const u32x4 v = ((const u32x4*)(tok_p + tid * 64))[j];
#pragma unroll
            for (int q = 0; q < 4; ++q)
#pragma unroll
                for (int bb = 0; bb < 4; ++bb) { const unsigned by = (v[q] >> (8 * bb)) & 0xffu; hh += (1ull << (8 * (by & 15u))) + (1ull << (8 * (by >> 4))); } }
        unsigned w[4];
#pragma unroll
        for (int i = 0; i < 4; ++i) { const unsigned two = (unsigned)(hh >> (16 * i)) & 0xffffu; w[i] = (two & 0xffu) | ((two >> 8) << 16); }
        unsigned inc[4];
#pragma unroll
        for (int i = 0; i < 4; ++i) { unsigned x = w[i];
#pragma unroll
            for (int o = 1; o < 64; o <<= 1) { const unsigned n = __shfl_up(x, o); if (lane >= o) x += n; }
            inc[i] = x; }
        if (lane == 63) {
#pragma unroll
            for (int i = 0; i < 4; ++i) wtot[wave * 4 + i] = inc[i]; }
        __builtin_amdgcn_s_waitcnt(0);
        __builtin_amdgcn_s_barrier();
#pragma unroll
        for (int i = 0; i < 4; ++i) { unsigned base = 0u;
            for (int ww = 0; ww < wave; ++ww) base += wtot[ww * 4 + i];
            pref[tid * 4 + i] = base + inc[i] - w[i];
            if (tid == 255) { const unsigned t2 = base + inc[i]; tot[2 * i] = (int)(t2 & 0xffffu); tot[2 * i + 1] = (int)(t2 >> 16); } }
    } else {
        __builtin_amdgcn_s_barrier();
    }
    __syncthreads();
    if (tid == 0) { int s_ = 0; for (int e = 0; e < 8; ++e) { tot[8 + e] = s_; s_ += (tot[e] + 255) & ~255; }
        if (blockIdx.x == 0) { int t = 0; for (int e = 0; e < 8; ++e) { const int n = (tot[e] + 255) >> 8; for (int j = 0; j < n; ++j) tile_e[t++] = e; } tile_e[255] = t; } }
    __syncthreads();
    for (int ck = blockIdx.x; ck < 256; ck += G) {
        if (tid < 128) { const unsigned by = tok_p[ck * 64 + (tid >> 1)]; ce[tid] = (tid & 1) ? (int)(by >> 4) : (int)(by & 15u); }
        __syncthreads();
        if (tid < 128) { const int e = ce[tid];
            int rank = 0, w0cnt = 0;
#pragma unroll
            for (int q = 0; q < 8; ++q) { const unsigned long long mk = __ballot(e == q); if (e == q) rank = __popcll(mk & ((1ull << lane) - 1ull)); if (wave == 0 && lane == 0) ce[128 + q] = __popcll(mk); }
            __builtin_amdgcn_s_waitcnt(0);
            asm volatile("s_barrier" ::: "memory");
            if (wave == 1) rank += ce[128 + e];
            (void)w0cnt;
            const unsigned pw = pref[ck * 4 + (e >> 1)]; const int pr = (int)((e & 1) ? (pw >> 16) : (pw & 0xffffu));
            const int dest = tot[8 + e] + pr + rank;
            row_tok[dest] = ck * 64 + (tid >> 1); row_gate[dest] = tok_g[ck * 128 + tid]; ((int*)(a.ws + WS_SMALL + SM_ROWSLOT))[dest] = tid & 1; }
        else { asm volatile("s_barrier" ::: "memory"); }
        __syncthreads();
    }
}

#ifndef GEMM
#define GEMM gemm_fast
#endif
__global__ void __launch_bounds__(NT, 2) mk_fwd(Args a0) {
    extern __shared__ __attribute__((aligned(16))) unsigned char lds[];
    const int G = gridDim.x, bid = blockIdx.x, ph_lo = a0.ph_lo, ph_hi = a0.ph_hi;
    volatile LAS unsigned* xst = (volatile LAS unsigned*)(lds + LDS_BYTES - 64);
    if (threadIdx.x < 2) xst[threadIdx.x] = 0u;
    __syncthreads();
    const XcdBarrier xb = xcd_barrier_post((unsigned*)(a0.ws + WS_SMALL + SM_BAR), xst);
    int ph = 0;
#ifndef PROBE_CAT
#define PROBE_CAT 0
#define PROBE_N 1
#endif
#define PHASE_BEGIN(cat) if (ph >= ph_lo && ph < ph_hi) { for (int rep_ = 0; rep_ < ((cat) == PROBE_CAT ? PROBE_N : 1); ++rep_) { const bool lastrep = (rep_ + 1 == ((cat) == PROBE_CAT ? PROBE_N : 1)); (void)lastrep; const Args& a = *(const Args*)okarg(); unsigned char* const ws = a.ws; \
    bf16_t* const hn = (bf16_t*)(ws + WS_HN); bf16_t* const z = (bf16_t*)(ws + WS_Z); bf16_t* const mix = (bf16_t*)(ws + WS_MIX); bf16_t* const hid = (bf16_t*)(ws + WS_HID); \
    float* const gates = (float*)(ws + WS_SMALL + SM_GATES); int* const tok_e = (int*)(ws + WS_SMALL + SM_TOKP); float* const tok_g = (float*)(ws + WS_SMALL + SM_TOKG); \
    const int* const row_tok = (const int*)(ws + WS_SMALL + SM_ROWTOK); const float* const row_gate = (const float*)(ws + WS_SMALL + SM_ROWGATE); const int* const tile_e = (const int*)(ws + WS_SMALL + SM_TILEE); \
    (void)hn; (void)z; (void)mix; (void)hid; (void)gates; (void)tok_e; (void)tok_g; (void)row_tok; (void)row_gate; (void)tile_e;
#define PHASE_END(dosync) } for (int rep_ = 0; rep_ < (PROBE_CAT == 6 ? PROBE_N : 1); ++rep_) if ((dosync) && ph + 1 < ph_hi) { xcd_barrier(xb); } } ++ph;

    PHASE_BEGIN(1) phase_prologue(a, lds); __syncthreads();
        phase_rowpass<0, 1, 1, false>(lds, a.in[I_X], hn, nullptr, a.in[I_GMIX], (float*)(ws + WS_SSQ), a.in[I_WIN] + 2048, DIN, a.in[I_BIN] + 2048, gates, nullptr, nullptr, nullptr); PHASE_END(true)
    { constexpr int l = 0;
#define LAYER_PTRS bf16_t* const hb = (bf16_t*)(ws + (l ? WS_H1 : WS_HN)); bf16_t* const hbo = (bf16_t*)(ws + (l ? WS_HN : WS_H1)); float* const ssq = (float*)(ws + WS_SSQ + l * SSQ_STRIDE); float* const ssqo = (float*)(ws + WS_SSQ + (1 - l) * SSQ_STRIDE); (void)hb; (void)hbo; (void)ssq; (void)ssqo;
        PHASE_BEGIN(3) LAYER_PTRS { if (l == 1) phase_rowpass<1, 1, 0, false>(lds, nullptr, hb, nullptr, a.in[I_GMIX] + l * D, nullptr, a.in[I_WIN] + (size_t)l * D * DIN + 2048, DIN, a.in[I_BIN] + l * DIN + 2048, gates, nullptr, nullptr, nullptr);
            GridOrder S{M / 256, ZW / 256, G, bid}; EpiZ E{z, a.in[I_BIN] + l * DIN, ssq};
            GEMM(lds, hb, (const bf16_t*)(ws + (l ? WS_W_IN1 : WS_W_IN0)), D, S, E); } PHASE_END(true)
        PHASE_BEGIN(4) LAYER_PTRS { MlRegs cur, nxt; int it = bid; if (it < 1024) ml_load(a, l, it, cur); nxt = cur;
            for (; it < 1024; it += G) { if (it + G < 1024) ml_load(a, l, it + G, nxt); ml_compute(a, lds, l, it, cur); cur = nxt; }
            for (; it < 1280; it += G) rglru_fast<0>(a, lds, l, it - 1024); } PHASE_END(true)
        PHASE_BEGIN(0) LAYER_PTRS mlstm_scan(a, G); rglru_scan(a, G); PHASE_END(true)
        PHASE_BEGIN(5) LAYER_PTRS { MoRegs cur, nxt; ConvW cwq, cwk; int hw = -1; int it = bid; if (it < 1024) mo_load(a, l, it, cur); nxt = cur;
            for (; it < 1024; it += G) { if (it + G < 1024) mo_load(a, l, it + G, nxt); mo_compute(a, lds, l, it, cur, cwq, cwk, hw); cur = nxt; }
            for (; it < 1280; it += G) rglru_fast<1>(a, lds, l, it - 1024); } PHASE_END(true)
        PHASE_BEGIN(0) LAYER_PTRS { GridOrder S{M / 256, D / 256, G, bid}; EpiHres<l == 0> E{l == 0 ? a.in[I_X] : nullptr, hb, ssq};
            GEMM(lds, mix, (const bf16_t*)(ws + (l ? WS_W_OUT1 : WS_W_OUT0)), D, S, E); } PHASE_END(true)
        if (l == 0) {
            PHASE_BEGIN(3) LAYER_PTRS { GridOrder S{M / 256, 2 * DFF / 256, G, bid}; EpiSwiglu E{hid, ssq, nullptr};
                GEMM(lds, hb, (const bf16_t*)(ws + WS_W_FFGU), D, S, E);
                { constexpr int nun = (M / 256) * (2 * DFF / 256); const int first = nun % G;
                  TailOrder S2{M / 256, D / 256, G, bid, first}; EpiStoreBf16 E2{(bf16_t*)(ws + WS_PP0)};
                  GEMM(lds, (const bf16_t*)(ws + WS_PB0), (const bf16_t*)(ws + WS_W_PP0), DPLE, S2, E2); } } PHASE_END(true)
            PHASE_BEGIN(0) LAYER_PTRS { GridOrder S{M / 256, D / 256, G, bid}; EpiHres<false> E{nullptr, hb, ssq};
                GEMM(lds, hid, (const bf16_t*)(ws + WS_W_FFD), DFF, S, E); } PHASE_END(true)
        } else {
            PHASE_BEGIN(2) LAYER_PTRS phase_rowpass<1, 2, 0, false>(lds, nullptr, hb, nullptr, a.in[I_GFFN] + l * D, nullptr, a.in[I_WROUTER], 8, nullptr, nullptr, (unsigned char*)tok_e, tok_g, nullptr); PHASE_END(true)
            PHASE_BEGIN(12) LAYER_PTRS phase_route(a, lds); PHASE_END(true)
            PHASE_BEGIN(3) LAYER_PTRS { MoeOrder<true> S{tile_e[255], 2 * DFF / 256, G, bid, tile_e, row_tok, (size_t)5632 * D}; EpiSwiglu E{hid, ssq, row_tok};
                GEMM(lds, hb, (const bf16_t*)(ws + WS_W_EGU), D, S, E); } PHASE_END(true)
            PHASE_BEGIN(0) LAYER_PTRS { MoeOrder<false> S{tile_e[255], D / 256, G, bid, tile_e, nullptr, (size_t)D * DFF}; EpiMoeDown E{hb, (bf16_t*)a.out, row_tok, (const int*)(ws + WS_SMALL + SM_ROWSLOT), row_gate};
                GEMM(lds, hid, (const bf16_t*)(ws + WS_W_ED), DFF, S, E);
                { const int nun = tile_e[255] * (D / 256); const int first = nun > 2 * G ? nun - 2 * G : 0;
                  TailOrder S2{M / 256, D / 256, G, bid, first < G ? first : 0}; EpiStoreBf16 E2{(bf16_t*)a.out + (size_t)M * D};
                  GEMM(lds, (const bf16_t*)(ws + WS_PB1), (const bf16_t*)(ws + WS_W_PP1), DPLE, S2, E2); } } PHASE_END(true)
            PHASE_BEGIN(0) LAYER_PTRS phase_rowpass<1, 0, 1, true>(lds, nullptr, hb, (const bf16_t*)a.out, nullptr, ssq, nullptr, 0, nullptr, nullptr, nullptr, nullptr, nullptr); PHASE_END(true)
        }
        PHASE_BEGIN(10) LAYER_PTRS { GridOrder S{M / 256, D / 256, G, bid};
            EpiPle E{hb, hbo, l == 0 ? (const bf16_t*)(ws + WS_PP0) : (const bf16_t*)a.out + (size_t)M * D, ssqo, ssq}; GEMM(lds, hb, (const bf16_t*)(ws + WS_W_PG) + (size_t)l * D * D, D, S, E);
            if (l == 0 && bid == 0) { for (int i = otid(); i < D / 2; i += NT) ((unsigned*)(ws + WS_H1 + (size_t)M * D * 2))[i] = 0u; } } PHASE_END(true)
    }
    { constexpr int l = 1;
        PHASE_BEGIN(3) LAYER_PTRS { if (l == 1) phase_rowpass<1, 1, 0, false>(lds, nullptr, hb, nullptr, a.in[I_GMIX] + l * D, nullptr, a.in[I_WIN] + (size_t)l * D * DIN + 2048, DIN, a.in[I_BIN] + l * DIN + 2048, gates, nullptr, nullptr, nullptr);
            GridOrder S{M / 256, ZW / 256, G, bid}; EpiZ E{z, a.in[I_BIN] + l * DIN, ssq};
            GEMM(lds, hb, (const bf16_t*)(ws + (l ? WS_W_IN1 : WS_W_IN0)), D, S, E); } PHASE_END(true)
        PHASE_BEGIN(4) LAYER_PTRS { MlRegs cur, nxt; int it = bid; if (it < 1024) ml_load(a, l, it, cur); nxt = cur;
            for (; it < 1024; it += G) { if (it + G < 1024) ml_load(a, l, it + G, nxt); ml_compute(a, lds, l, it, cur); cur = nxt; }
            for (; it < 1280; it += G) rglru_fast<0>(a, lds, l, it - 1024); } PHASE_END(true)
        PHASE_BEGIN(0) LAYER_PTRS mlstm_scan(a, G); rglru_scan(a, G); PHASE_END(true)
        PHASE_BEGIN(5) LAYER_PTRS { MoRegs cur, nxt; ConvW cwq, cwk; int hw = -1; int it = bid; if (it < 1024) mo_load(a, l, it, cur); nxt = cur;
            for (; it < 1024; it += G) { if (it + G < 1024) mo_load(a, l, it + G, nxt); mo_compute(a, lds, l, it, cur, cwq, cwk, hw); cur = nxt; }
            for (; it < 1280; it += G) rglru_fast<1>(a, lds, l, it - 1024); } PHASE_END(true)
        PHASE_BEGIN(0) LAYER_PTRS { GridOrder S{M / 256, D / 256, G, bid}; EpiHres<l == 0> E{l == 0 ? a.in[I_X] : nullptr, hb, ssq};
            GEMM(lds, mix, (const bf16_t*)(ws + (l ? WS_W_OUT1 : WS_W_OUT0)), D, S, E); } PHASE_END(true)
        if (l == 0) {
            PHASE_BEGIN(3) LAYER_PTRS { GridOrder S{M / 256, 2 * DFF / 256, G, bid}; EpiSwiglu E{hid, ssq, nullptr};
                GEMM(lds, hb, (const bf16_t*)(ws + WS_W_FFGU), D, S, E);
                { constexpr int nun = (M / 256) * (2 * DFF / 256); const int first = nun % G;
                  TailOrder S2{M / 256, D / 256, G, bid, first}; EpiStoreBf16 E2{(bf16_t*)(ws + WS_PP0)};
                  GEMM(lds, (const bf16_t*)(ws + WS_PB0), (const bf16_t*)(ws + WS_W_PP0), DPLE, S2, E2); } } PHASE_END(true)
            PHASE_BEGIN(0) LAYER_PTRS { GridOrder S{M / 256, D / 256, G, bid}; EpiHres<false> E{nullptr, hb, ssq};
                GEMM(lds, hid, (const bf16_t*)(ws + WS_W_FFD), DFF, S, E); } PHASE_END(true)
        } else {
            PHASE_BEGIN(2) LAYER_PTRS phase_rowpass<1, 2, 0, false>(lds, nullptr, hb, nullptr, a.in[I_GFFN] + l * D, nullptr, a.in[I_WROUTER], 8, nullptr, nullptr, (unsigned char*)tok_e, tok_g, nullptr); PHASE_END(true)
            PHASE_BEGIN(12) LAYER_PTRS phase_route(a, lds); PHASE_END(true)
            PHASE_BEGIN(3) LAYER_PTRS { MoeOrder<true> S{tile_e[255], 2 * DFF / 256, G, bid, tile_e, row_tok, (size_t)5632 * D}; EpiSwiglu E{hid, ssq, row_tok};
                GEMM(lds, hb, (const bf16_t*)(ws + WS_W_EGU), D, S, E); } PHASE_END(true)
            PHASE_BEGIN(0) LAYER_PTRS { MoeOrder<false> S{tile_e[255], D / 256, G, bid, tile_e, nullptr, (size_t)D * DFF}; EpiMoeDown E{hb, (bf16_t*)a.out, row_tok, (const int*)(ws + WS_SMALL + SM_ROWSLOT), row_gate};
                GEMM(lds, hid, (const bf16_t*)(ws + WS_W_ED), DFF, S, E);
                { const int nun = tile_e[255] * (D / 256); const int first = nun > 2 * G ? nun - 2 * G : 0;
                  TailOrder S2{M / 256, D / 256, G, bid, first < G ? first : 0}; EpiStoreBf16 E2{(bf16_t*)a.out + (size_t)M * D};
                  GEMM(lds, (const bf16_t*)(ws + WS_PB1), (const bf16_t*)(ws + WS_W_PP1), DPLE, S2, E2); } } PHASE_END(true)
            PHASE_BEGIN(0) LAYER_PTRS phase_rowpass<1, 0, 1, true>(lds, nullptr, hb, (const bf16_t*)a.out, nullptr, ssq, nullptr, 0, nullptr, nullptr, nullptr, nullptr, nullptr); PHASE_END(true)
        }
        PHASE_BEGIN(10) LAYER_PTRS { GridOrder S{M / 256, D / 256, G, bid};
            EpiPle E{hb, hbo, l == 0 ? (const bf16_t*)(ws + WS_PP0) : (const bf16_t*)a.out + (size_t)M * D, ssqo, ssq}; GEMM(lds, hb, (const bf16_t*)(ws + WS_W_PG) + (size_t)l * D * D, D, S, E);
            if (l == 0 && bid == 0) { for (int i = otid(); i < D / 2; i += NT) ((unsigned*)(ws + WS_H1 + (size_t)M * D * 2))[i] = 0u; } } PHASE_END(true)
    }
    PHASE_BEGIN(0) phase_rowpass<1, 0, 2, false>(lds, nullptr, hn, nullptr, a.in[I_GFINAL], nullptr, nullptr, 0, nullptr, nullptr, nullptr, nullptr, a.out); PHASE_END(false)
}

extern "C" void kernel_launch(void* const* d_in, const int* in_sizes, int n_in, void* d_out, int out_size,
                              void* d_ws, size_t ws_size, hipStream_t stream) {
    static int grid = 0;
    if (grid == 0) {
        if (n_in != 29 || out_size != M * D || ws_size < WS_END) { fprintf(stderr, "kernel_launch: unexpected problem (n_in %d out %d ws %zu)\n", n_in, out_size, ws_size); grid = -1; return; }
        int dev = 0, cus = 0, per_cu = 0;
        (void)hipGetDevice(&dev);
        (void)hipDeviceGetAttribute(&cus, hipDeviceAttributeMultiprocessorCount, dev);
        (void)hipFuncSetAttribute((const void*)mk_fwd, hipFuncAttributeMaxDynamicSharedMemorySize, LDS_BYTES);
        (void)hipOccupancyMaxActiveBlocksPerMultiprocessor(&per_cu, (const void*)mk_fwd, NT, LDS_BYTES);
        if (per_cu < 1) { fprintf(stderr, "kernel_launch: occupancy query says %d blocks per CU\n", per_cu); per_cu = 1; }
        grid = cus;
    }
    if (grid < 0) return;
    Args a{};
    for (int i = 0; i < 29; ++i) a.in[i] = (const float*)d_in[i];
    a.out = (float*)d_out; a.ws = (unsigned char*)d_ws; a.ph_lo = 0; a.ph_hi = 1000;
    (void)hipMemsetAsync((unsigned char*)d_ws + WS_SMALL + SM_BAR, 0, 16 * 1024, stream);
    void* args[] = {&a};
    hipError_t e = hipLaunchCooperativeKernel((void*)mk_fwd, dim3(grid), dim3(NT), args, LDS_BYTES, stream);
    if (e != hipSuccess) fprintf(stderr, "cooperative launch failed: %s (grid %d)\n", hipGetErrorString(e), grid);
}
```

```cpp
#include <hip/hip_runtime.h>
#include <hip/hip_cooperative_groups.h>
#include <cstdio>
#include <cstdint>
namespace cg = cooperative_groups;

constexpr int NT = 512;
constexpr int D = 1024, NBATCH = 4, SEQ = 4096, M = NBATCH * SEQ;
constexpr int CH = 64, NC = SEQ / CH, NH = 4, DH = 128, DM = 512, DR = 512, NBR = 8, DBR = 64;
constexpr int DIN = 3080, ZW = 3072, DFF = 2816, NE = 8, DPLE = 256;
constexpr int PMAX = 2 * M + NE * 256, NTILE_MAX = PMAX / 256;
constexpr int EROWS = 129;
constexpr float EPS = 1e-6f;
constexpr int ZQ = 0, ZK = 512, ZV = 1024, ZO = 1536, ZXR = 2048, ZYR = 2560;

constexpr size_t MiB = 1u << 20;
constexpr size_t WS_SMALL = 0;
constexpr size_t WS_W_IN0 = 4 * MiB;
constexpr size_t WS_W_OUT0 = 10 * MiB;
constexpr size_t WS_W_FFGU = 12 * MiB;
constexpr size_t WS_W_FFD = 23 * MiB;
constexpr size_t WS_PB0 = WS_W_FFD + 5632 * 1024;
constexpr size_t WS_W_PP0 = WS_PB0 + 8 * MiB;
constexpr size_t WS_H1 = 4 * MiB;
constexpr size_t WS_W_IN1 = 37 * MiB;
constexpr size_t WS_W_OUT1 = 43 * MiB;
constexpr size_t WS_W_PG = 45 * MiB;
constexpr size_t WS_W_PP1 = 49 * MiB;
constexpr size_t WS_W_EGU = WS_W_PP1 + MiB / 2;
constexpr size_t WS_W_ED = WS_W_EGU + 88 * MiB;
constexpr size_t WS_HN8 = WS_W_EGU + 44 * MiB;
constexpr size_t WS_PB1 = WS_W_ED + 44 * MiB;
constexpr size_t WS_HN = WS_PB1 + 8 * MiB;
static_assert(WS_H1 + (size_t)(M + 1) * D * 2 <= WS_W_IN1 && WS_W_PP0 + 1024 * 256 * 2 <= WS_W_IN1, "map");
constexpr size_t WS_RF = 222 * MiB;
constexpr size_t WS_Z = WS_RF;
constexpr size_t WS_CT = WS_Z + 96 * MiB;
constexpr size_t WS_DN = WS_CT + 32 * MiB;
constexpr size_t WS_MIX = WS_CT + 72 * MiB;
constexpr size_t WS_HID = WS_RF;
constexpr size_t WS_PP0 = WS_RF + 130 * MiB;
constexpr size_t WS_SSQ = WS_RF + 201 * MiB;
constexpr size_t SSQ_STRIDE = (size_t)(M + 16) * 64;
constexpr size_t WS_END = 435 * MiB;
static_assert(WS_MIX + (size_t)M * D * 2 <= WS_SSQ && WS_HID + (size_t)PMAX * DFF * 2 <= WS_SSQ && WS_SSQ + 2 * SSQ_STRIDE <= WS_END, "map");
static_assert(WS_HN + (size_t)(M + 1) * D * 2 <= WS_RF, "map");
static_assert(WS_MIX + (size_t)M * D * 2 <= WS_END, "map");
static_assert(WS_HID + (size_t)PMAX * DFF * 2 <= WS_END, "map");
static_assert(WS_DN + 1024 * 128 * 4 <= WS_PP0 && WS_PP0 + (size_t)M * D * 2 <= WS_MIX && WS_HID + (size_t)M * DFF * 2 <= WS_PP0, "map");
constexpr size_t SM_GATES = 0;
constexpr size_t SM_TOKE = 512 * 1024;
constexpr size_t SM_TOKG = SM_TOKE + 128 * 1024;
constexpr size_t SM_ROWTOK = SM_TOKG + 128 * 1024;
constexpr size_t SM_ROWGATE = SM_ROWTOK + 160 * 1024;
constexpr size_t SM_TILEE = SM_ROWGATE + 160 * 1024;
constexpr size_t SM_ROWSLOT = SM_TILEE + 4 * 1024;
constexpr size_t SM_TOKP = SM_ROWSLOT + 160 * 1024;
constexpr size_t SM_BL = SM_TOKP + 16 * 1024;
constexpr size_t SM_AMAX = SM_BL + 4 * 1024;
constexpr size_t SM_MPREV = SM_AMAX + 4 * 1024;
constexpr size_t SM_RGA = 2 * MiB;
constexpr size_t SM_RGH = SM_RGA + 512 * 1024;
constexpr size_t SM_RGP = SM_RGH + 512 * 1024;
constexpr size_t SM_BAR = SM_RGP + 512 * 1024;
constexpr size_t SM_RGW = SM_BAR + 16 * 1024;
static_assert(SM_MPREV + 4096 <= SM_RGA && SM_RGW + 256 * 1024 <= 4 * MiB, "small map");

constexpr int LDS_BYTES = 147456;

typedef unsigned short bf16_t;
typedef float f32x4 __attribute__((ext_vector_type(4)));
typedef unsigned u32x4 __attribute__((ext_vector_type(4)));
typedef unsigned u32x2 __attribute__((ext_vector_type(2)));

__device__ __forceinline__ float bf2f(unsigned v) { return __uint_as_float(v << 16); }
__device__ __forceinline__ unsigned pk2(float lo, float hi);
__device__ __forceinline__ unsigned f2bf(float f) { return pk2(f, 0.f) & 0xffffu; }
typedef float f32x2_t __attribute__((ext_vector_type(2))); typedef __bf16 bf16x2_t __attribute__((ext_vector_type(2)));
__device__ __forceinline__ unsigned pk2(float lo, float hi) { f32x2_t v = {lo, hi}; bf16x2_t b = __builtin_convertvector(v, bf16x2_t); return __builtin_bit_cast(unsigned, b); }
__device__ __forceinline__ unsigned pk4_fp8(float a, float b, float c, float d) { int w = __builtin_amdgcn_cvt_pk_fp8_f32(a, b, 0, false); w = __builtin_amdgcn_cvt_pk_fp8_f32(c, d, w, true); return (unsigned)w; }
__device__ __forceinline__ float frcp(float x) { return __builtin_amdgcn_rcpf(x); }
__device__ __forceinline__ float sigmoidf_(float x) { return frcp(1.f + __expf(-x)); }
__device__ __forceinline__ float siluf_(float x) { return x * frcp(1.f + __expf(-x)); }
__device__ __forceinline__ float logsigmoidf_(float x) { return fminf(x, 0.f) - log1pf(__expf(-fabsf(x))); }
__device__ __forceinline__ float gelu_tanh(float y) { const float u2 = 1.5957691216057308f * (y + 0.044715f * y * y * y); return y * frcp(1.f + __expf(-u2)); }
__device__ __forceinline__ float wave_sum(float v) {
#pragma unroll
    for (int o = 1; o < 64; o <<= 1) v += __shfl_xor(v, o);
    return v;
}
__device__ __forceinline__ float wave_max(float v) {
#pragma unroll
    for (int o = 1; o < 64; o <<= 1) v = fmaxf(v, __shfl_xor(v, o));
    return v;
}

__device__ __forceinline__ float dpp_f(float v, const int ctrl_sel) {
    const int x = __float_as_int(v); int r;
    if (ctrl_sel == 0) r = __builtin_amdgcn_update_dpp(x, x, 0xB1, 0xF, 0xF, false);
    else if (ctrl_sel == 1) r = __builtin_amdgcn_update_dpp(x, x, 0x4E, 0xF, 0xF, false);
    else if (ctrl_sel == 2) r = __builtin_amdgcn_update_dpp(x, x, 0x141, 0xF, 0xF, false);
    else r = __builtin_amdgcn_update_dpp(x, x, 0x140, 0xF, 0xF, false);
    return __int_as_float(r);
}
__device__ __forceinline__ float sum4(float v) { v += dpp_f(v, 0); v += dpp_f(v, 1); return v; }
__device__ __forceinline__ float sum8(float v) { v = sum4(v); v += dpp_f(v, 2); return v; }
__device__ __forceinline__ float sum16(float v) { v = sum8(v); v += dpp_f(v, 3); return v; }
#define WAVE_LDS_SYNC() asm volatile("s_waitcnt lgkmcnt(0)" ::: "memory")
#define LDS_BARRIER() do { asm volatile("s_waitcnt lgkmcnt(0)" ::: "memory"); __builtin_amdgcn_s_barrier(); asm volatile("" ::: "memory"); } while (0)
__device__ __forceinline__ int otid() { int t = threadIdx.x; asm volatile("" : "+v"(t)); return t; }
__device__ __forceinline__ int oint(int v) { asm volatile("" : "+s"(v)); return v; }
__device__ __forceinline__ const void* okarg() { auto p = __builtin_amdgcn_kernarg_segment_ptr(); asm volatile("" : "+s"(p)); return (const void*)p; }

struct Args { const float* in[29]; float* out; unsigned char* ws; int ph_lo, ph_hi; };
enum { I_X = 0, I_P, I_GMIX, I_WIN, I_BIN, I_WCQK, I_BCQK, I_GMH, I_WCR, I_BCR, I_WRA, I_BRA, I_WRI, I_BRI, I_LAM, I_GR, I_WOUT, I_GFFN,
       I_WFG, I_WFU, I_WFD, I_WROUTER, I_WEG, I_WEU, I_WED, I_GPLE, I_WPG, I_WPP, I_GFINAL };


#define XB_TMO      128
#define XB_XCNT(j)  (256  + 64 * (j))
#define XB_XSUB(j)  (1280 + 64 * (j))
#define XB_XGEN(j)  (2304 + 64 * (j))
#define XB_TOP      3328
#define XB_TOPGEN   3392
#define XCD_BAR_WORDS 3456
#define XB_SPIN_CAP (1u << 18)
#define LAS __attribute__((address_space(3)))
__device__ __forceinline__ unsigned xb_ld(unsigned* p)              { return __hip_atomic_load(p, __ATOMIC_RELAXED, __HIP_MEMORY_SCOPE_AGENT); }
__device__ __forceinline__ unsigned xb_add(unsigned* p, unsigned v) { return __hip_atomic_fetch_add(p, v, __ATOMIC_RELAXED, __HIP_MEMORY_SCOPE_AGENT); }
__device__ __forceinline__ unsigned xb_xcc_id() { return (unsigned)__builtin_amdgcn_s_getreg((3 << 11) | 20) & 0xFu; }
#define XB_SPIN(cond, bar) do { unsigned _sp = 0; while (cond) { __builtin_amdgcn_s_sleep(1); \
    if ((++_sp & 255u) == 0u) { if (xb_ld(&(bar)[XB_TMO])) break; if (_sp > XB_SPIN_CAP) { atomicAdd(&(bar)[XB_TMO], 1u); break; } } } } while (0)
struct XcdBarrier { unsigned* bar; unsigned x; volatile LAS unsigned* st; };
__device__ __forceinline__ XcdBarrier xcd_barrier_post(unsigned* bar, volatile LAS unsigned* st) {
    XcdBarrier b; b.bar = bar; b.x = xb_xcc_id(); b.st = st;
    if (threadIdx.x == 0) (void)xb_add(&bar[XB_XCNT(b.x)], 1u);
    return b;
}
__device__ __forceinline__ void xcd_barrier_complete(unsigned* bar, unsigned x, unsigned& nloc, unsigned& nx) {
    const unsigned G = gridDim.x * gridDim.y * gridDim.z;
    unsigned sum, cnt, mine, sp = 0u;
    for (;;) {
        sum = 0u; cnt = 0u; mine = 0u;
#pragma unroll
        for (unsigned j = 0; j < 16; ++j) { const unsigned c = xb_ld(&bar[XB_XCNT(j)]); sum += c; cnt += (c > 0u) ? 1u : 0u; mine = (j == x) ? c : mine; }
        if (sum == G) break;
        __builtin_amdgcn_s_sleep(1);
        if ((++sp & 255u) == 0u) { if (xb_ld(&bar[XB_TMO])) break; if (sp > XB_SPIN_CAP) { atomicAdd(&bar[XB_TMO], 1u); break; } }
    }
    nloc = mine > 0u ? mine : 1u; nx = cnt > 0u ? cnt : 1u;
}
__device__ __forceinline__ void xcd_barrier(const XcdBarrier& b) {
    asm volatile("s_waitcnt vmcnt(0)" ::: "memory");
    __syncthreads();
    if (threadIdx.x == 0) {
        unsigned* bar = b.bar;
        __builtin_amdgcn_s_waitcnt(0);
        unsigned nloc = b.st[0], nx = b.st[1];
        if (nloc == 0u) { xcd_barrier_complete(bar, b.x, nloc, nx); b.st[0] = nloc; b.st[1] = nx; }
        const unsigned old = xb_add(&bar[XB_XSUB(b.x)], 1u);
        const unsigned gen = old / nloc;
        if (old + 1u == (gen + 1u) * nloc) {
            __builtin_amdgcn_fence(__ATOMIC_RELEASE, "agent");
            asm volatile("s_waitcnt vmcnt(0)" ::: "memory");
            const unsigned og = xb_add(&bar[XB_TOP], 1u);
            const unsigned tg = og / nx;
            if (og + 1u == (tg + 1u) * nx) xb_add(&bar[XB_TOPGEN], 1u);
            else XB_SPIN(xb_ld(&bar[XB_TOPGEN]) == tg, bar);
            __builtin_amdgcn_fence(__ATOMIC_ACQUIRE, "agent");
            xb_add(&bar[XB_XGEN(b.x)], 1u);
            asm volatile("s_waitcnt vmcnt(0)" ::: "memory");
        } else {
            XB_SPIN(xb_ld(&bar[XB_XGEN(b.x)]) == gen, bar);
            __builtin_amdgcn_fence(__ATOMIC_ACQUIRE, "agent");
            asm volatile("s_waitcnt vmcnt(0)" ::: "memory");
        }
    }
    __syncthreads();
}

struct CvtJob { const float* src; bf16_t* dst; int ld, k0, c0, K, n0; const float* gain; int fp8; };
__device__ __forceinline__ void cvt_plain_job(CvtJob& o, const float* src, int K, int N, bf16_t* dst, int tile, const float* gain) {
    const int nt = N / 64, kb = tile / nt, nb = tile % nt; o.src = src; o.dst = dst; o.ld = N; o.k0 = kb * 64; o.c0 = nb * 64; o.K = K; o.n0 = nb * 64; o.gain = gain; o.fp8 = 0;
}
__device__ __forceinline__ void cvt_gu_job(CvtJob& o, const float* g, const float* u, bf16_t* dst, int tile, const float* gain) {
    const int nt = 5632 / 64, kb = tile / nt, nb = tile % nt, n0 = nb * 64, tt = n0 >> 8, half = (n0 >> 7) & 1, w = n0 & 127;
    o.src = half ? u : g; o.dst = dst; o.ld = DFF; o.k0 = kb * 64; o.c0 = tt * 128 + w; o.K = 1024; o.n0 = n0; o.gain = gain; o.fp8 = 0;
}
__device__ __forceinline__ void cvt_job(const Args& a, int it, CvtJob& o) {
    unsigned char* ws = a.ws;
    constexpr int T_IN = 16 * 48, T_OUT = 16 * 16, T_GU = 16 * 88, T_FD = 44 * 16, T_PG = 256, T_PP = 4 * 16;
    int r = it;
    if (r < 2 * T_IN) { const int l = r / T_IN, tile = r % T_IN; const int nt = ZW / 64, kb = tile / nt, nb = tile % nt, n0 = nb * 64;
        o.src = a.in[I_WIN] + (size_t)l * D * DIN; o.dst = (bf16_t*)(ws + (l ? WS_W_IN1 : WS_W_IN0)); o.ld = DIN; o.k0 = kb * 64; o.c0 = n0 < 2048 ? n0 : n0 + 8; o.K = D; o.n0 = n0; o.gain = a.in[I_GMIX] + l * D; o.fp8 = 0; return; }
    r -= 2 * T_IN;
    if (r < 2 * T_OUT) { const int l = r / T_OUT; cvt_plain_job(o, a.in[I_WOUT] + (size_t)l * D * D, D, D, (bf16_t*)(ws + (l ? WS_W_OUT1 : WS_W_OUT0)), r % T_OUT, nullptr); return; }
    r -= 2 * T_OUT;
    if (r < T_GU) { cvt_gu_job(o, a.in[I_WFG], a.in[I_WFU], (bf16_t*)(ws + WS_W_FFGU), r, a.in[I_GFFN]); return; }
    r -= T_GU;
    if (r < T_FD) { cvt_plain_job(o, a.in[I_WFD], DFF, D, (bf16_t*)(ws + WS_W_FFD), r, nullptr); return; }
    r -= T_FD;
    if (r < 2 * T_PG) { const int l = r / T_PG; cvt_plain_job(o, a.in[I_WPG] + (size_t)l * D * D, D, D, (bf16_t*)(ws + WS_W_PG) + (size_t)l * D * D, r % T_PG, a.in[I_GPLE] + l * D); return; }
    r -= 2 * T_PG;
    if (r < 2 * T_PP) { const int l = r / T_PP; cvt_plain_job(o, a.in[I_WPP] + (size_t)l * DPLE * D, DPLE, D, (bf16_t*)(ws + (l ? WS_W_PP1 : WS_W_PP0)), r % T_PP, nullptr); return; }
    r -= 2 * T_PP;
    if (r < 8 * T_GU) { const int e = r / T_GU; cvt_gu_job(o, a.in[I_WEG] + (size_t)e * D * DFF, a.in[I_WEU] + (size_t)e * D * DFF, (bf16_t*)(ws + WS_W_EGU + (size_t)e * 5632 * D), r % T_GU, nullptr); o.fp8 = 1; return; }
    r -= 8 * T_GU;
    { const int e = r / T_FD; cvt_plain_job(o, a.in[I_WED] + (size_t)e * DFF * D, DFF, D, (bf16_t*)(ws + WS_W_ED + (size_t)e * D * DFF), r % T_FD, nullptr); o.fp8 = 1; }
}
__device__ __forceinline__ void phase_prologue(const Args& a, unsigned char* lds) {
    unsigned char* ws = a.ws;
    const int G = gridDim.x, t = otid();
    constexpr int T_IN = 16 * 48, T_OUT = 16 * 16, T_GU = 16 * 88, T_FD = 44 * 16, T_PG = 256, T_PP = 4 * 16;
    constexpr int NT_ALL = 2 * T_IN + 2 * T_OUT + T_GU + T_FD + 2 * T_PG + 2 * T_PP + 8 * T_GU + 8 * T_FD;
    constexpr int NB = 4;
    const int kk0 = t >> 4, cc = (t & 15) * 4, n = t >> 3, kg = t & 7;
    float4 v[NB][2], vn[NB][2];
    int it0 = blockIdx.x * NB;
    if (it0 < NT_ALL) {
#pragma unroll
        for (int b = 0; b < NB; ++b) { const int it = it0 + b < NT_ALL ? it0 + b : NT_ALL - 1; CvtJob jq; cvt_job(a, it, jq);
#pragma unroll
            for (int j = 0; j < 2; ++j) v[b][j] = *(const float4*)(jq.src + (size_t)(jq.k0 + kk0 + 32 * j) * jq.ld + jq.c0 + cc); }
    }
    for (; it0 < NT_ALL; it0 += G * NB) {
        const int itn = it0 + G * NB;
        if (itn < NT_ALL) {
#pragma unroll
            for (int b = 0; b < NB; ++b) { const int it = itn + b < NT_ALL ? itn + b : NT_ALL - 1; CvtJob jq; cvt_job(a, it, jq);
#pragma unroll
                for (int j = 0; j < 2; ++j) vn[b][j] = *(const float4*)(jq.src + (size_t)(jq.k0 + kk0 + 32 * j) * jq.ld + jq.c0 + cc); }
        }
#pragma unroll
        for (int b = 0; b < NB; ++b) { float* tl = (float*)lds + b * (64 * 65); const int it = it0 + b < NT_ALL ? it0 + b : NT_ALL - 1; CvtJob jq; cvt_job(a, it, jq);
#pragma unroll
            for (int j = 0; j < 2; ++j) { float4 w = v[b][j];
                if (jq.gain) { const float gk = jq.gain[jq.k0 + kk0 + 32 * j]; w.x *= gk; w.y *= gk; w.z *= gk; w.w *= gk; }
                float* p = tl + (kk0 + 32 * j) * 65 + cc; p[0] = w.x; p[1] = w.y; p[2] = w.z; p[3] = w.w; } }
        LDS_BARRIER();
#pragma unroll
        for (int b = 0; b < NB; ++b) { if (it0 + b >= NT_ALL) break; const float* s_ = (const float*)lds + b * (64 * 65) + (8 * kg) * 65 + n; CvtJob jq; cvt_job(a, it0 + b, jq);
            if (jq.fp8) { u32x2 o; o.x = pk4_fp8(32.f * s_[0], 32.f * s_[65], 32.f * s_[130], 32.f * s_[195]); o.y = pk4_fp8(32.f * s_[260], 32.f * s_[325], 32.f * s_[390], 32.f * s_[455]);
                *(u32x2*)((unsigned char*)jq.dst + (size_t)(jq.n0 + n) * jq.K + jq.k0 + 8 * kg) = o; }
            else { u32x4 o; o.x = pk2(s_[0], s_[65]); o.y = pk2(s_[130], s_[195]); o.z = pk2(s_[260], s_[325]); o.w = pk2(s_[390], s_[455]);
                *(u32x4*)(jq.dst + (size_t)(jq.n0 + n) * jq.K + jq.k0 + 8 * kg) = o; } }
        LDS_BARRIER();
#pragma unroll
        for (int b = 0; b < NB; ++b) { v[b][0] = vn[b][0]; v[b][1] = vn[b][1]; }
    }
    const size_t np4 = (size_t)M * DPLE / 4;
    for (size_t i = (size_t)blockIdx.x * NT + otid(); i < 2 * np4; i += (size_t)G * NT) {
        const float4 v = ((const float4*)a.in[I_P])[i]; u32x2 o; o.x = pk2(v.x, v.y); o.y = pk2(v.z, v.w);
        if (i < np4) ((u32x2*)(ws + WS_PB0))[i] = o; else ((u32x2*)(ws + WS_PB1))[i - np4] = o; }
    for (int i = blockIdx.x * NT + otid(); i < 2 * 8 * 2 * 64 * 64; i += G * NT) {
        const int d = i & 63, e = (i >> 6) & 63, g = (i >> 12) & 1, ln = i >> 13;
        ((bf16_t*)(ws + WS_SMALL + SM_RGW))[i] = (bf16_t)f2bf((g ? a.in[I_WRI] : a.in[I_WRA])[((size_t)ln * 64 + d) * 64 + e]);
    }
    if (blockIdx.x == 0) { for (int i = otid(); i < D / 4; i += NT) ((unsigned*)(ws + WS_HN8 + (size_t)M * D))[i] = 0u; for (int i = otid(); i < D / 2; i += NT) ((unsigned*)(ws + WS_HN + (size_t)M * D * 2))[i] = 0u; if (otid() < 32) ((float*)(ws + WS_SSQ + (otid() >> 4) * SSQ_STRIDE))[(size_t)M * 16 + (otid() & 15)] = 0.f; }
    for (int i = blockIdx.x * NT + otid(); i < PMAX; i += G * NT) { ((int*)(ws + WS_SMALL + SM_ROWTOK))[i] = M; ((float*)(ws + WS_SMALL + SM_ROWGATE))[i] = 0.f; }
}

template <int IN, bool ADDY> struct RawRow {
    f32x4 x[IN == 0 ? 4 : 1]; u32x2 h[IN == 1 ? 4 : 1]; u32x2 y[ADDY ? 4 : 1];
    __device__ __forceinline__ void load(const float* xin, const bf16_t* hb, const bf16_t* y1, int r, int lane) {
#pragma unroll
        for (int j = 0; j < 4; ++j) {
            if (IN == 0) x[j] = ((const f32x4*)(xin + (size_t)r * D) + lane)[64 * j]; else h[j] = ((const u32x2*)(hb + (size_t)r * D) + lane)[64 * j];
            if (ADDY) y[j] = ((const u32x2*)(y1 + (size_t)r * D) + lane)[64 * j]; }
    }
    __device__ __forceinline__ void copy_from(const RawRow& o) {
#pragma unroll
        for (int j = 0; j < 4; ++j) { if (IN == 0) x[j] = o.x[j]; else h[j] = o.h[j]; if (ADDY) y[j] = o.y[j]; }
    }
};
template <int IN, int AUX, int WR, bool ADDY>
__device__ __forceinline__ void phase_rowpass(unsigned char* lds, const float* xin, bf16_t* hb, const bf16_t* y1, const float* g, float* ssq,
                                              const float* auxW, int auxld, const float* auxB, float* gates, unsigned char* tok_p, float* tok_g, float* fout, unsigned char* h8 = nullptr) {
    float* wl = (float*)lds;
    const int tid = otid(), lane = tid & 63, wave = tid >> 6;
    if (AUX) {
        for (int i = tid; i < D * 8; i += NT) wl[i] = auxW[(size_t)(i >> 3) * auxld + (i & 7)];
        __syncthreads();
    }
    f32x4 gv[4];
    if (AUX || WR == 2) {
#pragma unroll
        for (int j = 0; j < 4; ++j) gv[j] = *(const f32x4*)(g + 4 * lane + 256 * j);
    }
    RawRow<1, ADDY> cur, nxt;
    const int rstep = gridDim.x * 8; int row = blockIdx.x * 8 + wave;
    if (IN == 1) { if (row < M) cur.load(xin, hb, y1, row, lane); nxt.copy_from(cur); }
    for (; row < M; row += rstep) {
        if (IN == 1) { if (row + rstep < M) nxt.load(xin, hb, y1, row + rstep, lane); }
        f32x4 v[4]; float ss = 0.f;
#pragma unroll
        for (int j = 0; j < 4; ++j) {
            if (IN == 0) v[j] = ((const f32x4*)(xin + (size_t)row * D) + lane)[64 * j];
            else { const u32x2 w = cur.h[j]; v[j] = (f32x4){bf2f(w.x & 0xffffu), __uint_as_float(w.x & 0xffff0000u), bf2f(w.y & 0xffffu), __uint_as_float(w.y & 0xffff0000u)}; }
            if (ADDY) { const u32x2 y = cur.y[j];
                v[j].x += bf2f(y.x & 0xffffu); v[j].y += __uint_as_float(y.x & 0xffff0000u); v[j].z += bf2f(y.y & 0xffffu); v[j].w += __uint_as_float(y.y & 0xffff0000u); }
            ss += (v[j].x * v[j].x + v[j].y * v[j].y) + (v[j].z * v[j].z + v[j].w * v[j].w); }
        if (IN == 1) cur.copy_from(nxt);
        float tot; { const int ri = __float_as_int(sum16(ss)); tot = (__int_as_float(__builtin_amdgcn_readlane(ri, 0)) + __int_as_float(__builtin_amdgcn_readlane(ri, 16))) + (__int_as_float(__builtin_amdgcn_readlane(ri, 32)) + __int_as_float(__builtin_amdgcn_readlane(ri, 48))); }
        const float rstd = __builtin_amdgcn_rsqf(tot * (1.f / D) + EPS);
        if (WR == 1) {
            u32x2* o = (u32x2*)(hb + (size_t)row * D) + lane;
#pragma unroll
            for (int j = 0; j < 4; ++j) { u32x2 w; w.x = pk2(v[j].x, v[j].y); w.y = pk2(v[j].z, v[j].w); o[64 * j] = w; }
            if (lane < 16) ssq[(size_t)row * 16 + lane] = lane == 0 ? tot : 0.f;
        }
        if (AUX || WR == 2) {
#pragma unroll
            for (int j = 0; j < 4; ++j) v[j] = v[j] * rstd * gv[j];
        }
        if (AUX == 2 && h8) {
#pragma unroll
            for (int j = 0; j < 4; ++j) ((unsigned*)(h8 + (size_t)row * D) + lane)[64 * j] = pk4_fp8(v[j].x, v[j].y, v[j].z, v[j].w);
        }
        if (WR == 2) {
            f32x4* o = (f32x4*)(fout + (size_t)row * D) + lane;
#pragma unroll
            for (int j = 0; j < 4; ++j) o[64 * j] = v[j];
        }
        if (AUX) {
            float acc[8];
#pragma unroll
            for (int c = 0; c < 8; ++c) acc[c] = 0.f;
#pragma unroll
            for (int j = 0; j < 4; ++j)
#pragma unroll
                for (int q = 0; q < 4; ++q) {
                    const int k = 4 * lane + 256 * j + q; const float xv = v[j][q];
                    const f32x4 w0 = *(const f32x4*)(wl + k * 8), w1 = *(const f32x4*)(wl + k * 8 + 4);
                    acc[0] += xv * w0.x; acc[1] += xv * w0.y; acc[2] += xv * w0.z; acc[3] += xv * w0.w;
                    acc[4] += xv * w1.x; acc[5] += xv * w1.y; acc[6] += xv * w1.z; acc[7] += xv * w1.w;
                }
#pragma unroll
            for (int c = 0; c < 8; ++c) { const float r16 = sum16(acc[c]); const int ri = __float_as_int(r16);
                acc[c] = (__int_as_float(__builtin_amdgcn_readlane(ri, 0)) + __int_as_float(__builtin_amdgcn_readlane(ri, 16))) + (__int_as_float(__builtin_amdgcn_readlane(ri, 32)) + __int_as_float(__builtin_amdgcn_readlane(ri, 48))); }
            if (AUX == 1) {
                if (lane < 8) { float s_ = acc[0];
#pragma unroll
                    for (int c = 1; c < 8; ++c) s_ = (lane == c) ? acc[c] : s_;
                    gates[(size_t)row * 8 + lane] = s_ + auxB[lane]; }
            } else {
                if (lane == 0) {
                    int e1 = 0; float v1 = acc[0];
#pragma unroll
                    for (int c = 1; c < 8; ++c) if (acc[c] > v1) { v1 = acc[c]; e1 = c; }
                    int e2 = -1; float v2 = -INFINITY;
#pragma unroll
                    for (int c = 0; c < 8; ++c) if (c != e1 && acc[c] > v2) { v2 = acc[c]; e2 = c; }
                    const float p2 = __expf(v2 - v1), inv = 1.f / (1.f + p2);
                    tok_p[row] = (unsigned char)(e1 | (e2 << 4)); tok_g[row * 2] = inv; tok_g[row * 2 + 1] = p2 * inv;
                }
            }
        }
    }
    __syncthreads();
}

struct Unit { int pm, pn; const int* rows; size_t bofs; };
struct GridOrder {
    static constexpr bool GATHER = false;
    int nM, nN, G, c;
    __device__ __forceinline__ bool next(int i, Unit& u) const {
        const int L0_ = i * G + c, nwg = nM * nN; if (L0_ >= nwg) return false;
        const int q_ = nwg / 8, r_ = nwg % 8, xcd = L0_ % 8, off = L0_ / 8; const int L = (xcd < r_ ? xcd * (q_ + 1) : r_ * (q_ + 1) + (xcd - r_) * q_) + off;
        const int grp = L / (8 * nN), fm = grp * 8, gsz = (nM - fm) < 8 ? (nM - fm) : 8, w = L % (8 * nN);
        u.pm = fm + w % gsz; u.pn = w / gsz; u.rows = nullptr; u.bofs = 0; return true;
    }
};
struct TailOrder {
    static constexpr bool GATHER = false;
    int nM, nN, G, c, first;
    __device__ __forceinline__ bool next(int i, Unit& u) const {
        if (c < first) return false; const int L = i * (G - first) + (c - first); if (L >= nM * nN) return false;
        u.pm = L / nN; u.pn = L % nN; u.rows = nullptr; u.bofs = 0; return true;
    }
};
template <bool GATHER_> struct MoeOrder {
    static constexpr bool GATHER = GATHER_;
    int nM, nN, G, c; const int* tile_e; const int* rows; size_t estride;
    __device__ __forceinline__ bool next(int i, Unit& u) const {
        const int L0_ = i * G + c, nwg = nM * nN; if (L0_ >= nwg) return false;
        const int q_ = nwg / 8, r_ = nwg % 8, xcd = L0_ % 8, off = L0_ / 8; const int L = (xcd < r_ ? xcd * (q_ + 1) : r_ * (q_ + 1) + (xcd - r_) * q_) + off;
        const int grp = L / (8 * nN), fm = grp * 8, gsz = (nM - fm) < 8 ? (nM - fm) : 8, w = L % (8 * nN);
        u.pm = fm + w % gsz; u.pn = w / gsz; u.rows = rows; u.bofs = (size_t)tile_e[u.pm] * estride; return true;
    }
};


namespace pg8 {
#define PG8_LAS __attribute__((address_space(3)))
typedef short bf16x8 __attribute__((ext_vector_type(8)));
constexpr int BM = 256, BK = 64, HALF = 128, HTB = HALF * BK * 2, STAGE_BYTES = 8 * HTB;
__device__ __forceinline__ int lds_byte(int r, int c) { const int st = (r >> 4) * 2 + (c >> 5), rr = r & 15, cc = c & 31, ob = rr * 64 + cc * 2; return st * 1024 + (ob ^ (((ob >> 9) & 1) << 5)); }
__device__ __forceinline__ void stage_rc(int b, int& R, int& C) { const int st = b / 1024, sb = b % 1024, swz = sb ^ (((sb >> 9) & 1) << 5); R = (st >> 1) * 16 + swz / 64; C = (st & 1) * 32 + (swz % 64) / 2; }

typedef int i32x8 __attribute__((ext_vector_type(8))); typedef int i32x4 __attribute__((ext_vector_type(4)));
__device__ __forceinline__ i32x8 cat8(bf16x8 lo, bf16x8 hi) { return __builtin_shufflevector(__builtin_bit_cast(i32x4, lo), __builtin_bit_cast(i32x4, hi), 0, 1, 2, 3, 4, 5, 6, 7); }
__device__ __forceinline__ int perm32(int rho) { const int n = rho >> 4, i = rho & 15; return 8 * (i >> 2) + 4 * n + (i & 3); }
__device__ __forceinline__ void unit_voff(const Unit& u, const int (&R)[2], const int (&C)[2], int KB  , unsigned (&vo)[2][2]) {
#pragma unroll
    for (int h = 0; h < 2; ++h)
#pragma unroll
        for (int i = 0; i < 2; ++i) { int row = u.pm * BM + h * HALF + R[i]; if (u.rows) row = u.rows[row]; vo[h][i] = (unsigned)row * (unsigned)KB + (unsigned)C[i] * 2u; }
}

template <class Epi, class Sched, bool ALIGN_EPI, bool GATHER, bool FP8 = false>
__device__ __forceinline__ void gemm_phase(unsigned char* lds_, const bf16_t* A_, const bf16_t* Bt_, const int K_, const Sched& S, const Epi& E) {
    PG8_LAS unsigned char* lds = (PG8_LAS unsigned char*)lds_;
    const int K = oint(K_);
    const int tid = otid(), wid = __builtin_amdgcn_readfirstlane(tid >> 6), lane = tid & 63, wr = wid >> 2, wc = wid & 3, fr = lane & 15, fq = lane >> 4;
    const int KB = FP8 ? K : 2 * K;
    const int nt = KB / (BK * 2);
    int R[2], C[2]; unsigned voffA[2], voffB[2];
#pragma unroll
    for (int i = 0; i < 2; ++i) { stage_rc(tid * 16 + i * 8192, R[i], C[i]); voffA[i] = (unsigned)(R[i] * KB + C[i] * 2);
        const int Rb = Epi::PERM ? ((R[i] & ~31) + perm32(R[i] & 31)) : R[i]; voffB[i] = (unsigned)(Rb * KB + C[i] * 2); }
    const size_t kstep = (size_t)(BK * 2);
    const size_t hstep = (size_t)HALF * KB;
    const size_t tstep = 2 * hstep;
    const unsigned ldsw = (unsigned)wid * 1024u;
    const int pc0 = FP8 ? 32 * (fq >> 1) + 16 * (fq & 1) : fq * 8; constexpr int KOFF = FP8 ? 16 : 1024;
    const int aoff = lds_byte(wr * 64 + fr, pc0), boff = lds_byte(wc * 32 + fr, pc0);
#define PG8_SA(b, h) (((b) * 2 + (h)) * HTB)
#define PG8_SB(b, h) ((4 + (b) * 2 + (h)) * HTB)
#define PG8_STAGE(bufoff, gbase, voff) do { _Pragma("unroll") for (int _i = 0; _i < 2; ++_i) \
        __builtin_amdgcn_global_load_lds((const unsigned*)((const char*)(gbase) + (voff)[_i]), (PG8_LAS unsigned*)(lds + (bufoff) + ldsw + _i * 8192), 16, 0, 0); } while (0)
#define PG8_STAGE_A(bufoff, base, h, VO) do { if constexpr (GATHER) { PG8_STAGE(bufoff, base, (VO)[h]); } else { PG8_STAGE(bufoff, (base) + (h) * hstep, voffA); } } while (0)
#define PG8_LDA(dst, b, h) do { _Pragma("unroll") for (int m = 0; m < 4; ++m) _Pragma("unroll") for (int k = 0; k < 2; ++k) dst[m][k] = *(const PG8_LAS bf16x8*)(lds + PG8_SA(b, h) + aoff + m * 2048 + k * KOFF); } while (0)
#define PG8_LDB(dst, b, h) do { _Pragma("unroll") for (int n = 0; n < 2; ++n) _Pragma("unroll") for (int k = 0; k < 2; ++k) dst[n][k] = *(const PG8_LAS bf16x8*)(lds + PG8_SB(b, h) + boff + n * 2048 + k * KOFF); } while (0)
#define PG8_MMA(ai, bj, At, Bt) do { __builtin_amdgcn_s_setprio(1); _Pragma("unroll") for (int m = 0; m < 4; ++m) _Pragma("unroll") for (int n = 0; n < 2; ++n) { \
        if constexpr (FP8) { const i32x8 b8_ = cat8(Bt[n][0], Bt[n][1]), a8_ = cat8(At[m][0], At[m][1]); \
            asm volatile("v_mfma_scale_f32_16x16x128_f8f6f4 %0, %1, %2, %0, %3, %3 op_sel_hi:[0,0,0]" : "+v"(acc[ai][bj][m][n]) : "v"(b8_), "v"(a8_), "v"(scale1)); } \
        else { _Pragma("unroll") for (int k = 0; k < 2; ++k) acc[ai][bj][m][n] = __builtin_amdgcn_mfma_f32_16x16x32_bf16(Bt[n][k], At[m][k], acc[ai][bj][m][n], 0, 0, 0); } } __builtin_amdgcn_s_setprio(0); } while (0)
#define PG8_WAIT_V(n) asm volatile("s_waitcnt vmcnt(" #n ")" ::: "memory")
#define PG8_WAIT_L(n) asm volatile("s_waitcnt lgkmcnt(" #n ")" ::: "memory")
#define PG8_BAR __builtin_amdgcn_s_barrier()
#define PG8_SCHED __builtin_amdgcn_sched_barrier(0)
    const int scale1 = 0x7f7f7f7f;
    Unit cur, nxt; int ui = 0;
    if (!S.next(0, cur)) return;
    f32x4 acc[2][2][4][2];
#pragma unroll
    for (int a = 0; a < 2; ++a)
#pragma unroll
        for (int b = 0; b < 2; ++b)
#pragma unroll
            for (int m = 0; m < 4; ++m)
#pragma unroll
                for (int n = 0; n < 2; ++n) acc[a][b][m][n] = (f32x4){0.f, 0.f, 0.f, 0.f};
    bf16x8 At[4][2], B0[2][2], B1[2][2];
    unsigned vc[2][2], vn[2][2];
    if constexpr (GATHER) unit_voff(cur, R, C, KB, vc);
    const char* cA = GATHER ? (const char*)A_ : (const char*)A_ + (size_t)cur.pm * tstep;
    const char* cB = (const char*)Bt_ + cur.bofs * (FP8 ? 1 : 2) + (size_t)cur.pn * tstep;
    PG8_STAGE(PG8_SB(0, 0), cB, voffB); PG8_STAGE(PG8_SB(0, 1), cB + hstep, voffB); PG8_STAGE_A(PG8_SA(0, 0), cA, 0, vc); PG8_STAGE_A(PG8_SA(0, 1), cA, 1, vc);
    if (wr == 1) PG8_BAR;
    PG8_WAIT_V(2); PG8_BAR;
    PG8_STAGE(PG8_SB(1, 0), cB + kstep, voffB); PG8_STAGE_A(PG8_SA(1, 0), cA + kstep, 0, vc); PG8_STAGE(PG8_SB(1, 1), cB + hstep + kstep, voffB);
    PG8_WAIT_V(6); PG8_BAR;
    for (;;) {
        const bool has_next = S.next(ui + 1, nxt);
        const char* nA = cA; const char* nB = cB;
        if (has_next) { nB = (const char*)Bt_ + nxt.bofs * (FP8 ? 1 : 2) + (size_t)nxt.pn * tstep; if constexpr (!GATHER) nA = (const char*)A_ + (size_t)nxt.pm * tstep; }
        if constexpr (GATHER) {
            if (has_next) unit_voff(nxt, R, C, KB, vn);
            else {
#pragma unroll
                for (int h = 0; h < 2; ++h)
#pragma unroll
                    for (int i = 0; i < 2; ++i) vn[h][i] = vc[h][i]; } }
        for (int t = 0; t < nt; t += 2) {
            const bool last = (t == nt - 2);
            const char* a1 = cA + (size_t)(t + 1) * kstep;
            const char* a2 = last ? nA : cA + (size_t)(t + 2) * kstep; const char* b2 = last ? nB : cB + (size_t)(t + 2) * kstep;
            const char* a3 = a2 + kstep; const char* b3 = b2 + kstep;
            unsigned v2[2][2];
            if constexpr (GATHER) {
#pragma unroll
                for (int h = 0; h < 2; ++h)
#pragma unroll
                    for (int i = 0; i < 2; ++i) v2[h][i] = last ? vn[h][i] : vc[h][i]; }
            PG8_LDB(B0, 0, 0); PG8_LDB(B1, 0, 1); PG8_SCHED; PG8_LDA(At, 0, 0); PG8_STAGE_A(PG8_SA(1, 1), a1, 1, vc);
            PG8_WAIT_V(8); PG8_WAIT_L(0); PG8_BAR; PG8_MMA(0, 0, At, B0); PG8_MMA(0, 1, At, B1); PG8_BAR; PG8_SCHED;
            PG8_LDA(At, 0, 1); PG8_STAGE(PG8_SB(0, 0), b2, voffB); PG8_STAGE(PG8_SB(0, 1), b2 + hstep, voffB); PG8_STAGE_A(PG8_SA(0, 0), a2, 0, v2);
            PG8_WAIT_V(8); PG8_WAIT_L(0); PG8_BAR; PG8_MMA(1, 0, At, B0); PG8_MMA(1, 1, At, B1); PG8_BAR; PG8_SCHED;
            PG8_LDB(B0, 1, 0); PG8_LDB(B1, 1, 1); PG8_SCHED; PG8_LDA(At, 1, 0); PG8_STAGE_A(PG8_SA(0, 1), a2, 1, v2);
            PG8_WAIT_V(8); PG8_WAIT_L(0); PG8_BAR; PG8_MMA(0, 0, At, B0); PG8_MMA(0, 1, At, B1); PG8_BAR; PG8_SCHED;
            PG8_LDA(At, 1, 1); PG8_STAGE(PG8_SB(1, 0), b3, voffB); PG8_STAGE(PG8_SB(1, 1), b3 + hstep, voffB); PG8_STAGE_A(PG8_SA(1, 0), a3, 0, v2);
            PG8_WAIT_V(8); PG8_WAIT_L(0); PG8_BAR; PG8_MMA(1, 0, At, B0); PG8_MMA(1, 1, At, B1); PG8_BAR; PG8_SCHED;
        }
        if constexpr (ALIGN_EPI) { if (wr == 0) PG8_BAR; }
        { int pm_ = cur.pm, pn_ = cur.pn, fr_ = fr, fq_ = fq;
          asm volatile("" : "+s"(pm_), "+s"(pn_), "+v"(fr_), "+v"(fq_));
          E(acc, pm_, pn_, wr, wc, fr_, fq_); }
        if (!has_next) break;
#pragma unroll
        for (int a = 0; a < 2; ++a)
#pragma unroll
            for (int b = 0; b < 2; ++b)
#pragma unroll
                for (int m = 0; m < 4; ++m)
#pragma unroll
                    for (int n = 0; n < 2; ++n) acc[a][b][m][n] = (f32x4){0.f, 0.f, 0.f, 0.f};
        cur = nxt; cA = nA; cB = nB; ++ui;
        if constexpr (GATHER) {
#pragma unroll
            for (int h = 0; h < 2; ++h)
#pragma unroll
                for (int i = 0; i < 2; ++i) vc[h][i] = vn[h][i]; }
        if constexpr (ALIGN_EPI) { if (wr == 1) PG8_BAR; }
    }
    PG8_WAIT_V(0);
    if constexpr (!ALIGN_EPI) { if (wr == 0) PG8_BAR; }
    PG8_BAR;
#undef PG8_SA
#undef PG8_SB
#undef PG8_STAGE
#undef PG8_STAGE_A
#undef PG8_LDA
#undef PG8_LDB
#undef PG8_MMA
#undef PG8_WAIT_V
#undef PG8_WAIT_L
#undef PG8_BAR
#undef PG8_SCHED
}
}
template <bool FP8 = false, class Epi, class Sched>
__device__ __forceinline__ void gemm_fast(unsigned char* lds, const bf16_t* A, const bf16_t* Bt, int K, const Sched& S, const Epi& E) {
    pg8::gemm_phase<Epi, Sched, true, Sched::GATHER, FP8>(lds, A, Bt, K, S, E);
    __syncthreads();
}

typedef f32x4 AccT[2][2][4][2];
#define EPI_ROW(ai, m) (pm * 256 + (ai) * 128 + wr * 64 + (m) * 16 + fr)
__device__ __forceinline__ void unpack8(const u32x4 w, f32x4& lo, f32x4& hi) {
    lo = (f32x4){bf2f(w.x & 0xffffu), __uint_as_float(w.x & 0xffff0000u), bf2f(w.y & 0xffffu), __uint_as_float(w.y & 0xffff0000u)};
    hi = (f32x4){bf2f(w.z & 0xffffu), __uint_as_float(w.z & 0xffff0000u), bf2f(w.w & 0xffffu), __uint_as_float(w.w & 0xffff0000u)};
}
__device__ __forceinline__ u32x4 pack8(const f32x4 v0, const f32x4 v1) { u32x4 w; w.x = pk2(v0.x, v0.y); w.y = pk2(v0.z, v0.w); w.z = pk2(v1.x, v1.y); w.w = pk2(v1.z, v1.w); return w; }
__device__ __forceinline__ float dot8(const f32x4 a, const f32x4 b) { return ((a.x * a.x + a.y * a.y) + (a.z * a.z + a.w * a.w)) + ((b.x * b.x + b.y * b.y) + (b.z * b.z + b.w * b.w)); }
__device__ __forceinline__ void epi_rstd(const float* ssq, const int* rowmap, int pm, int wr, int fr, int fq, float (&rs)[2][4]) {
    f32x4 p[2][4];
#pragma unroll
    for (int ai = 0; ai < 2; ++ai)
#pragma unroll
        for (int m = 0; m < 4; ++m) { int row = EPI_ROW(ai, m); if (rowmap) row = rowmap[row]; p[ai][m] = *(const f32x4*)((const char*)ssq + ((unsigned)row * 16u + 4u * (unsigned)fq) * 4u); }
#pragma unroll
    for (int ai = 0; ai < 2; ++ai)
#pragma unroll
        for (int m = 0; m < 4; ++m) { float t = (p[ai][m].x + p[ai][m].y) + (p[ai][m].z + p[ai][m].w); t += __shfl_xor(t, 16); t += __shfl_xor(t, 32); rs[ai][m] = __builtin_amdgcn_rsqf(t * (1.f / 1024.f) + EPS); }
}
__device__ __forceinline__ void epi_ssq(float* ssq, int row, int slot, float s_, int fq) { s_ += __shfl_xor(s_, 16); s_ += __shfl_xor(s_, 32); if (fq == 0) *(float*)((char*)ssq + ((unsigned)row * 16u + (unsigned)slot) * 4u) = s_; }

struct EpiZ { static constexpr bool PERM = true; bf16_t* z; const float* bin; const float* ssq;
    __device__ __forceinline__ void operator()(const AccT& acc, int pm, int pn, int wr, int wc, int fr, int fq) const {
        const int c0 = pn * 256 + wc * 32 + 8 * fq; f32x4 bv[2][2]; float rs[2][4];
#pragma unroll
        for (int bj = 0; bj < 2; ++bj)
#pragma unroll
            for (int n = 0; n < 2; ++n) { const int cc = c0 + bj * 128 + n * 4; bv[bj][n] = *(const f32x4*)(bin + (cc < 2048 ? cc : cc + 8)); }
        epi_rstd(ssq, nullptr, pm, wr, fr, fq, rs);
#pragma unroll
        for (int ai = 0; ai < 2; ++ai)
#pragma unroll
            for (int m = 0; m < 4; ++m) { bf16_t* rp = z + (size_t)EPI_ROW(ai, m) * ZW + c0; const float r = rs[ai][m];
#pragma unroll
                for (int bj = 0; bj < 2; ++bj) *(u32x4*)(rp + bj * 128) = pack8(acc[ai][bj][m][0] * r + bv[bj][0], acc[ai][bj][m][1] * r + bv[bj][1]); } } };
template <bool XB> struct EpiHres { static constexpr bool PERM = true; const float* xb; bf16_t* hb; float* ssq;
    __device__ __forceinline__ void operator()(const AccT& acc, int pm, int pn, int wr, int wc, int fr, int fq) const {
        const int c0 = pn * 256 + wc * 32 + 8 * fq;
#pragma unroll
        for (int ai = 0; ai < 2; ++ai) {
            f32x4 lx[4][2][2]; u32x4 lh[4][2];
#pragma unroll
            for (int m = 0; m < 4; ++m)
#pragma unroll
                for (int bj = 0; bj < 2; ++bj) { const size_t o = (size_t)EPI_ROW(ai, m) * D + c0 + bj * 128;
                    if (XB) { lx[m][bj][0] = *(const f32x4*)(xb + o); lx[m][bj][1] = *(const f32x4*)(xb + o + 4); } else lh[m][bj] = *(const u32x4*)(hb + o); }
#pragma unroll
            for (int m = 0; m < 4; ++m) { float s_ = 0.f; const int row = EPI_ROW(ai, m);
#pragma unroll
                for (int bj = 0; bj < 2; ++bj) { f32x4 b0, b1; if (XB) { b0 = lx[m][bj][0]; b1 = lx[m][bj][1]; } else unpack8(lh[m][bj], b0, b1);
                    const f32x4 v0 = b0 + acc[ai][bj][m][0], v1 = b1 + acc[ai][bj][m][1]; s_ += dot8(v0, v1);
                    *(u32x4*)(hb + (size_t)row * D + c0 + bj * 128) = pack8(v0, v1); }
                epi_ssq(ssq, row, pn * 4 + wc, s_, fq); }
        } } };
struct EpiSwiglu { static constexpr bool PERM = true; bf16_t* hid; const float* ssq; const int* rowmap;
    __device__ __forceinline__ void operator()(const AccT& acc, int pm, int pn, int wr, int wc, int fr, int fq) const {
        const int c0 = pn * 128 + wc * 32 + 8 * fq; float rs[2][4];
        epi_rstd(ssq, rowmap, pm, wr, fr, fq, rs);
#pragma unroll
        for (int ai = 0; ai < 2; ++ai)
#pragma unroll
            for (int m = 0; m < 4; ++m) { u32x4 w; const float r = rs[ai][m];
#pragma unroll
                for (int n = 0; n < 2; ++n) { const f32x4 g = acc[ai][0][m][n] * r, u = acc[ai][1][m][n] * r;
                    w[2 * n] = pk2(siluf_(g.x) * u.x, siluf_(g.y) * u.y); w[2 * n + 1] = pk2(siluf_(g.z) * u.z, siluf_(g.w) * u.w); }
                *(u32x4*)(hid + (size_t)EPI_ROW(ai, m) * DFF + c0) = w; } } };
struct EpiSwiglu8 { static constexpr bool PERM = true; unsigned char* hid8; float sc;
    __device__ __forceinline__ void operator()(const AccT& acc, int pm, int pn, int wr, int wc, int fr, int fq) const {
        const int c0 = pn * 128 + wc * 32 + 8 * fq;
#pragma unroll
        for (int ai = 0; ai < 2; ++ai)
#pragma unroll
            for (int m = 0; m < 4; ++m) { u32x2 w;
#pragma unroll
                for (int n = 0; n < 2; ++n) { const f32x4 g = acc[ai][0][m][n] * sc, u = acc[ai][1][m][n] * sc;
                    w[n] = pk4_fp8(siluf_(g.x) * u.x, siluf_(g.y) * u.y, siluf_(g.z) * u.z, siluf_(g.w) * u.w); }
                *(u32x2*)(hid8 + (size_t)EPI_ROW(ai, m) * DFF + c0) = w; } } };
struct EpiMoeDown { static constexpr bool PERM = true; bf16_t* hb; bf16_t* y1; const int* row_tok; const int* row_slot; const float* row_gate; float sc;
    __device__ __forceinline__ void operator()(const AccT& acc, int pm, int pn, int wr, int wc, int fr, int fq) const {
        const int c0 = pn * 256 + wc * 32 + 8 * fq;
        int tok[2][4], slot[2][4]; float gt[2][4];
#pragma unroll
        for (int ai = 0; ai < 2; ++ai)
#pragma unroll
            for (int m = 0; m < 4; ++m) { const int row = EPI_ROW(ai, m); tok[ai][m] = row_tok[row]; slot[ai][m] = row_slot[row]; gt[ai][m] = row_gate[row] * sc; }
#pragma unroll
        for (int ai = 0; ai < 2; ++ai) {
            u32x4 lh[4][2];
#pragma unroll
            for (int m = 0; m < 4; ++m) { const bool rmw = tok[ai][m] < M && slot[ai][m] == 0;
#pragma unroll
                for (int bj = 0; bj < 2; ++bj) lh[m][bj] = rmw ? *(const u32x4*)(hb + (size_t)tok[ai][m] * D + c0 + bj * 128) : (u32x4){0u, 0u, 0u, 0u}; }
#pragma unroll
            for (int m = 0; m < 4; ++m) { if (tok[ai][m] >= M) continue; const size_t o = (size_t)tok[ai][m] * D + c0; const float g = gt[ai][m];
                if (slot[ai][m] == 0) {
#pragma unroll
                    for (int bj = 0; bj < 2; ++bj) { f32x4 b0, b1; unpack8(lh[m][bj], b0, b1); *(u32x4*)(hb + o + bj * 128) = pack8(b0 + g * acc[ai][bj][m][0], b1 + g * acc[ai][bj][m][1]); }
                } else {
#pragma unroll
                    for (int bj = 0; bj < 2; ++bj) *(u32x4*)(y1 + o + bj * 128) = pack8(g * acc[ai][bj][m][0], g * acc[ai][bj][m][1]);
                } }
        } } };
struct EpiStoreBf16 { static constexpr bool PERM = true; bf16_t* out;
    __device__ __forceinline__ void operator()(const AccT& acc, int pm, int pn, int wr, int wc, int fr, int fq) const {
        const int c0 = pn * 256 + wc * 32 + 8 * fq;
#pragma unroll
        for (int ai = 0; ai < 2; ++ai)
#pragma unroll
            for (int m = 0; m < 4; ++m)
#pragma unroll
                for (int bj = 0; bj < 2; ++bj) *(u32x4*)(out + (size_t)EPI_ROW(ai, m) * D + c0 + bj * 128) = pack8(acc[ai][bj][m][0], acc[ai][bj][m][1]); } };
struct EpiPle { static constexpr bool PERM = true; const bf16_t* hin; bf16_t* hb; const bf16_t* pp; float* ssq; const float* ssq_in;
    __device__ __forceinline__ void operator()(const AccT& acc, int pm, int pn, int wr, int wc, int fr, int fq) const {
        const int c0 = pn * 256 + wc * 32 + 8 * fq; float rs[2][4];
        epi_rstd(ssq_in, nullptr, pm, wr, fr, fq, rs);
        u32x4 sg[2][4][2];
#pragma unroll
        for (int ai = 0; ai < 2; ++ai)
#pragma unroll
            for (int m = 0; m < 4; ++m)
#pragma unroll
                for (int bj = 0; bj < 2; ++bj) { f32x4 a0 = acc[ai][bj][m][0] * rs[ai][m], a1 = acc[ai][bj][m][1] * rs[ai][m];
#pragma unroll
                    for (int q = 0; q < 4; ++q) { a0[q] = sigmoidf_(a0[q]); a1[q] = sigmoidf_(a1[q]); }
                    sg[ai][m][bj] = pack8(a0, a1); }
        asm volatile("" ::: "memory");
#pragma unroll
        for (int ai = 0; ai < 2; ++ai) {
            u32x4 lh[4][2], lp[4][2];
#pragma unroll
            for (int m = 0; m < 4; ++m)
#pragma unroll
                for (int bj = 0; bj < 2; ++bj) { const unsigned ob = ((unsigned)EPI_ROW(ai, m) * D + c0 + bj * 128) * 2u;
                    lh[m][bj] = *(const u32x4*)((const char*)hin + ob); lp[m][bj] = *(const u32x4*)((const char*)pp + ob); }
#pragma unroll
            for (int m = 0; m < 4; ++m) { float s_ = 0.f; const int row = EPI_ROW(ai, m);
#pragma unroll
                for (int bj = 0; bj < 2; ++bj) { f32x4 h0, h1, p0, p1, g0, g1; unpack8(lh[m][bj], h0, h1); unpack8(lp[m][bj], p0, p1); unpack8(sg[ai][m][bj], g0, g1);
                    h0 += g0 * p0; h1 += g1 * p1; s_ += dot8(h0, h1);
                    *(u32x4*)((char*)hb + ((unsigned)row * D + c0 + bj * 128) * 2u) = pack8(h0, h1); }
                epi_ssq(ssq, row, pn * 4 + wc, s_, fq); }
        } } };

__device__ __forceinline__ float conv4(const bf16_t* zc, int row, int s, const float* w  , int wstride, float b) {
    float acc = b;
#pragma unroll
    for (int j = 0; j < 4; ++j) { const int ds = 3 - j; if (s - ds >= 0) acc += w[j * wstride] * bf2f(zc[(ptrdiff_t)(row - ds) * ZW]); }
    return acc;
}
__device__ __forceinline__ void chunk_gates(float* sc, const float* gates, int row0, int h, int lane) {
    const float ip = gates[(size_t)(row0 + lane) * 8 + h], fp = gates[(size_t)(row0 + lane) * 8 + 4 + h];
    float b = logsigmoidf_(fp);
#pragma unroll
    for (int o = 1; o < 64; o <<= 1) { const float n = __shfl_up(b, o); if (lane >= o) b += n; }
    sc[lane] = b; sc[64 + lane] = ip;
}
__device__ __forceinline__ void chunk_gates_r(float* sc, float ip, float fp, int lane) {
    float b = logsigmoidf_(fp);
#pragma unroll
    for (int o = 1; o < 64; o <<= 1) { const float n = __shfl_up(b, o); if (lane >= o) b += n; }
    sc[lane] = b; sc[64 + lane] = ip;
}
__device__ __forceinline__ void mlstm_local(const Args& a, unsigned char* lds, int l, int item) {
    const int b = item >> 8, c = (item >> 2) & 63, h = item & 3, row0 = b * SEQ + c * CH, tid = otid(), lane = tid & 63;
    float* Kt = (float*)lds;
    float* Vt = Kt + 64 * 128;
    float* sc = Vt + 64 * 128;
    const bf16_t* z = (const bf16_t*)(a.ws + WS_Z);
    const float* gates = (const float*)(a.ws + WS_SMALL + SM_GATES);
    if (tid < 64) {
        chunk_gates(sc, gates, row0, h, lane);
        const float bl = __shfl(sc[lane], 63), al = bl - sc[lane] + sc[64 + lane];
        const float amax = wave_max(al);
        sc[128 + lane] = __expf(al - amax);
        if (lane == 0) { ((float*)(a.ws + WS_SMALL + SM_BL))[item] = bl; ((float*)(a.ws + WS_SMALL + SM_AMAX))[item] = amax; }
    }
    const float* wc = a.in[I_WCQK] + (size_t)l * 4 * 1024; const float* bc = a.in[I_BCQK] + (size_t)l * 1024;
    for (int i = tid; i < 64 * 128; i += NT) {
        const int ll = i >> 7, d = i & 127, ch = ZK + h * DH + d;
        Kt[i] = siluf_(conv4(z + ch, row0 + ll, c * CH + ll, wc + ch, 1024, bc[ch]));
        Vt[i] = bf2f(z[(size_t)(row0 + ll) * ZW + ZV + h * DH + d]);
    }
    __syncthreads();
    const int d = tid & 127, eg = tid >> 7;
    float acc[33];
#pragma unroll
    for (int i = 0; i < 33; ++i) acc[i] = 0.f;
    for (int ll = 0; ll < 64; ++ll) {
        const float kd = Kt[ll * 128 + d] * sc[128 + ll];
#pragma unroll
        for (int i = 0; i < 32; ++i) acc[i] += Vt[ll * 128 + eg + 4 * i] * kd;
        acc[32] += kd;
    }
    float* ct = (float*)(a.ws + WS_CT) + (size_t)item * EROWS * 128;
#pragma unroll
    for (int i = 0; i < 32; ++i) ct[(eg + 4 * i) * 128 + d] = acc[i];
    if (eg == 0) ct[128 * 128 + d] = acc[32];
    __syncthreads();
}
__device__ __forceinline__ void mlstm_scan(const Args& a, int G) {
    const float* BL = (const float*)(a.ws + WS_SMALL + SM_BL); const float* AM = (const float*)(a.ws + WS_SMALL + SM_AMAX);
    float* MP = (float*)(a.ws + WS_SMALL + SM_MPREV);
    const int tid = otid();
    for (int w = blockIdx.x; w < 16 * 16; w += G) {
        const int bh = w >> 4, sl = w & 15, b = bh >> 2, h = bh & 3;
        unsigned* p = (unsigned*)(a.ws + WS_CT) + (size_t)((b * NC) * NH + h) * 8192 + sl * 512 + tid;
        float s0 = 0.f, s1 = 0.f, m = 0.f;
#pragma unroll 1
        for (int c0 = 0; c0 < NC; c0 += 16) {
            unsigned x[16];
#pragma unroll
            for (int j = 0; j < 16; ++j) x[j] = p[(size_t)(c0 + j) * (NH * 8192)];
#pragma unroll
            for (int j = 0; j < 16; ++j) {
                const int item = (b * NC + c0 + j) * NH + h;
                const float bl = BL[item], am = AM[item];
                const float mn = fmaxf(bl + m, am), dec = __expf(bl + m - mn), scl = __expf(am - mn);
                p[(size_t)(c0 + j) * (NH * 8192)] = pk2(s0, s1);
                if (sl == 0 && tid == 0) MP[item] = m;
                s0 = dec * s0 + scl * bf2f(x[j] & 0xffffu); s1 = dec * s1 + scl * __uint_as_float(x[j] & 0xffff0000u); m = mn;
            }
        }
        if (sl == 1 && tid < 128) {
            float* q = (float*)(a.ws + WS_DN) + (size_t)((b * NC) * NH + h) * 128 + tid;
            float sn = 0.f; m = 0.f;
#pragma unroll 1
            for (int c0 = 0; c0 < NC; c0 += 16) {
                float x[16];
#pragma unroll
                for (int j = 0; j < 16; ++j) x[j] = q[(size_t)(c0 + j) * (NH * 128)];
#pragma unroll
                for (int j = 0; j < 16; ++j) {
                    const int item = (b * NC + c0 + j) * NH + h;
                    const float bl = BL[item], am = AM[item];
                    const float mn = fmaxf(bl + m, am), dec = __expf(bl + m - mn), scl = __expf(am - mn);
                    q[(size_t)(c0 + j) * (NH * 128)] = sn;
                    sn = dec * sn + scl * x[j]; m = mn;
                }
            }
        }
    }
}
__device__ __forceinline__ void mlstm_out(const Args& a, unsigned char* lds, int l, int item) {
    const int b = item >> 8, c = (item >> 2) & 63, h = item & 3, row0 = b * SEQ + c * CH, tid = otid(), lane = tid & 63, wave = tid >> 6;
    float* Q = (float*)lds;
    float* Kt = Q + 64 * 128;
    float* Vt = Kt + 64 * 128;
    float* Sm = Vt + 64 * 128;
    float* sc = Sm + 64 * 64;
    const bf16_t* z = (const bf16_t*)(a.ws + WS_Z);
    const float* gates = (const float*)(a.ws + WS_SMALL + SM_GATES);
    const float mprev = ((const float*)(a.ws + WS_SMALL + SM_MPREV))[item];
    if (tid < 64) {
        chunk_gates(sc, gates, row0, h, lane);
        float g = sc[64 + lane] - sc[lane];
#pragma unroll
        for (int o = 1; o < 64; o <<= 1) { const float n = __shfl_up(g, o); if (lane >= o) g = fmaxf(g, n); }
        const float mrow = sc[lane] + fmaxf(mprev, g);
        sc[128 + lane] = mrow; sc[192 + lane] = __expf(sc[lane] + mprev - mrow);
    }
    const float* wc = a.in[I_WCQK] + (size_t)l * 4 * 1024; const float* bc = a.in[I_BCQK] + (size_t)l * 1024;
    for (int i = tid; i < 64 * 128; i += NT) {
        const int ll = i >> 7, d = i & 127, chq = ZQ + h * DH + d, chk = ZK + h * DH + d;
        Q[i] = siluf_(conv4(z + chq, row0 + ll, c * CH + ll, wc + chq, 1024, bc[chq])) * 0.08838834764831845f;
        Kt[i] = siluf_(conv4(z + chk, row0 + ll, c * CH + ll, wc + chk, 1024, bc[chk]));
        Vt[i] = bf2f(z[(size_t)(row0 + ll) * ZW + ZV + h * DH + d]);
    }
    __syncthreads();
    for (int i = tid; i < 64 * 64; i += NT) {
        const int ll = i >> 6, mm = i & 63; float s = 0.f;
        if (mm <= ll) {
            for (int d = 0; d < 128; ++d) s += Q[ll * 128 + d] * Kt[mm * 128 + d];
            s *= __expf(sc[ll] - sc[mm] + sc[64 + mm] - sc[128 + ll]);
        }
        Sm[i] = s;
    }
    __syncthreads();
    const float* ct = (const float*)(a.ws + WS_CT) + (size_t)item * EROWS * 128;
    if (tid < 64) {
        float di = 0.f, dn = 0.f;
        for (int mm = 0; mm < 64; ++mm) di += Sm[tid * 64 + mm];
        for (int d = 0; d < 128; ++d) dn += Q[tid * 128 + d] * ct[128 * 128 + d];
        const float den = di + sc[192 + tid] * dn;
        sc[256 + tid] = fmaxf(fabsf(den), __expf(-sc[128 + tid]));
    }
    const int e = tid & 127, lg = tid >> 7;
    float acc[16], acc2[16];
#pragma unroll
    for (int i = 0; i < 16; ++i) { acc[i] = 0.f; acc2[i] = 0.f; }
    for (int mm = 0; mm < 64; ++mm) { const float vv = Vt[mm * 128 + e];
#pragma unroll
        for (int i = 0; i < 16; ++i) acc[i] += Sm[(lg * 16 + i) * 64 + mm] * vv; }
    for (int d = 0; d < 128; ++d) { const float cv = ct[e * 128 + d];
#pragma unroll
        for (int i = 0; i < 16; ++i) acc2[i] += Q[(lg * 16 + i) * 128 + d] * cv; }
    __syncthreads();
#pragma unroll
    for (int i = 0; i < 16; ++i) { const int ll = lg * 16 + i;
        const float hv = (acc[i] + sc[192 + ll] * acc2[i]) / sc[256 + ll];
        const float o = sigmoidf_(bf2f(z[(size_t)(row0 + ll) * ZW + ZO + h * DH + e]));
        Kt[ll * 128 + e] = hv * o; }
    __syncthreads();
    const float* gm = a.in[I_GMH] + (size_t)l * DM + h * DH;
    bf16_t* mix = (bf16_t*)(a.ws + WS_MIX);
    for (int ll = wave * 8; ll < wave * 8 + 8; ++ll) {
        const float x0 = Kt[ll * 128 + 2 * lane], x1 = Kt[ll * 128 + 2 * lane + 1];
        const float rs = rsqrtf(wave_sum(x0 * x0 + x1 * x1) * (1.f / 128.f) + EPS);
        *(unsigned*)(mix + (size_t)(row0 + ll) * D + h * DH + 2 * lane) = pk2(x0 * rs * gm[2 * lane], x1 * rs * gm[2 * lane + 1]);
    }
    __syncthreads();
}


typedef short bf16x8 __attribute__((ext_vector_type(8)));
__device__ __forceinline__ f32x4 mfma16(bf16x8 a, bf16x8 b, f32x4 c) { return __builtin_amdgcn_mfma_f32_16x16x32_bf16(a, b, c, 0, 0, 0); }

__device__ __forceinline__ void conv_load11(const bf16_t* zc, int row0, int l0, bool first_chunk, unsigned (&x)[11]) {
#pragma unroll
    for (int j = 0; j < 11; ++j) { const int ll = l0 - 3 + j; x[j] = (first_chunk && ll < 0) ? 0u : *(const unsigned*)(zc + (ptrdiff_t)(row0 + ll) * ZW); }
}
struct ConvW { float w[4][2]; float b[2]; };
__device__ __forceinline__ void conv_loadw(const float* wc, const float* bc, int col, ConvW& cw) {
#pragma unroll
    for (int j = 0; j < 4; ++j) { cw.w[j][0] = wc[j * 1024 + col]; cw.w[j][1] = wc[j * 1024 + col + 1]; }
    cw.b[0] = bc[col]; cw.b[1] = bc[col + 1];
}
__device__ __forceinline__ void conv_apply(const unsigned (&x)[11], const ConvW& cw, float (&out)[8][2]) {
#pragma unroll
    for (int i = 0; i < 8; ++i) { float a0 = cw.b[0], a1 = cw.b[1];
#pragma unroll
        for (int j = 0; j < 4; ++j) { a0 += cw.w[j][0] * bf2f(x[i + j] & 0xffffu); a1 += cw.w[j][1] * __uint_as_float(x[i + j] & 0xffff0000u); }
        out[i][0] = a0; out[i][1] = a1; }
}
struct MlRegs { unsigned xk[11], v[8]; ConvW cw; float gi, gf; };
__device__ __forceinline__ void ml_load(const Args& a, int l, int item, MlRegs& R) {
    const int b = item >> 8, c = (item >> 2) & 63, h = item & 3, row0 = b * SEQ + c * CH, tid = otid(), lane = tid & 63, wave = tid >> 6;
    const bf16_t* z = (const bf16_t*)(a.ws + WS_Z);
    const float* gates = (const float*)(a.ws + WS_SMALL + SM_GATES);
    const int cp = lane, lg = wave, colk = ZK + h * DH + 2 * cp, colv = ZV + h * DH + 2 * cp;
    conv_load11(z + colk, row0, 8 * lg, c == 0, R.xk);
#pragma unroll
    for (int i = 0; i < 8; ++i) R.v[i] = *(const unsigned*)(z + (size_t)(row0 + 8 * lg + i) * ZW + colv);
    conv_loadw(a.in[I_WCQK] + (size_t)l * 4 * 1024, a.in[I_BCQK] + (size_t)l * 1024, colk, R.cw);
    R.gi = gates[(size_t)(row0 + lane) * 8 + h]; R.gf = gates[(size_t)(row0 + lane) * 8 + 4 + h];
}
__device__ __forceinline__ void ml_compute(const Args& a, unsigned char* lds, int l, int item, MlRegs& R) {
    const int tid = otid(), lane = tid & 63, wave = tid >> 6, fr = lane & 15, fq = lane >> 4;
    unsigned char* KT = lds; unsigned char* VT = lds + 18432; float* RED = (float*)(lds + 36864); float* sc = (float*)(lds + 40960);
    const int cp = lane, lg = wave;
    unsigned (&xk)[11] = R.xk; unsigned (&v)[8] = R.v; ConvW& cw = R.cw;
    if (tid < 64) {
        chunk_gates_r(sc, R.gi, R.gf, lane);
        const float bl = __shfl(sc[lane], 63), al = bl - sc[lane] + sc[64 + lane];
        const float amax = wave_max(al);
        sc[128 + lane] = __expf(al - amax);
        if (lane == 0) { ((float*)(a.ws + WS_SMALL + SM_BL))[item] = bl; ((float*)(a.ws + WS_SMALL + SM_AMAX))[item] = amax; }
    }
    LDS_BARRIER();
    {
        float kk[8][2];
        conv_apply(xk, cw, kk);
        float n0 = 0.f, n1 = 0.f;
#pragma unroll
        for (int i = 0; i < 8; ++i) { const float wl = sc[128 + 8 * lg + i]; kk[i][0] = siluf_(kk[i][0]) * wl; kk[i][1] = siluf_(kk[i][1]) * wl; n0 += kk[i][0]; n1 += kk[i][1]; }
        u32x4 p0, p1;
#pragma unroll
        for (int i = 0; i < 4; ++i) { p0[i] = pk2(kk[2 * i][0], kk[2 * i + 1][0]); p1[i] = pk2(kk[2 * i][1], kk[2 * i + 1][1]); }
        *(u32x4*)(KT + (2 * cp) * 144 + lg * 16) = p0; *(u32x4*)(KT + (2 * cp + 1) * 144 + lg * 16) = p1;
        RED[lg * 128 + 2 * cp] = n0; RED[lg * 128 + 2 * cp + 1] = n1;
#pragma unroll
        for (int i = 0; i < 4; ++i) { p0[i] = (v[2 * i] & 0xffffu) | (v[2 * i + 1] << 16); p1[i] = (v[2 * i] >> 16) | (v[2 * i + 1] & 0xffff0000u); }
        *(u32x4*)(VT + (2 * cp) * 144 + lg * 16) = p0; *(u32x4*)(VT + (2 * cp + 1) * 144 + lg * 16) = p1;
    }
    LDS_BARRIER();
    bf16_t* ct = (bf16_t*)(a.ws + WS_CT) + (size_t)item * 128 * 128;
    {
        const int et0 = 2 * (wave & 3), dt0 = 4 * (wave >> 2);
        bf16x8 Vf[2][2], Kf[4][2];
#pragma unroll
        for (int i = 0; i < 2; ++i)
#pragma unroll
            for (int ks = 0; ks < 2; ++ks) Vf[i][ks] = *(const bf16x8*)(VT + ((et0 + i) * 16 + fr) * 144 + (ks * 32 + 8 * fq) * 2);
#pragma unroll
        for (int j = 0; j < 4; ++j)
#pragma unroll
            for (int ks = 0; ks < 2; ++ks) Kf[j][ks] = *(const bf16x8*)(KT + ((dt0 + j) * 16 + fr) * 144 + (ks * 32 + 8 * fq) * 2);
#pragma unroll
        for (int i = 0; i < 2; ++i)
#pragma unroll
            for (int j = 0; j < 4; ++j) {
                f32x4 acc = {0.f, 0.f, 0.f, 0.f};
                acc = mfma16(Kf[j][0], Vf[i][0], acc); acc = mfma16(Kf[j][1], Vf[i][1], acc);
                u32x2 w; w.x = pk2(acc[0], acc[1]); w.y = pk2(acc[2], acc[3]);
                *(u32x2*)(ct + ((et0 + i) * 16 + fr) * 128 + (dt0 + j) * 16 + 4 * fq) = w;
            }
    }
    if (tid < 128) { float s_ = 0.f;
#pragma unroll
        for (int g = 0; g < 8; ++g) s_ += RED[g * 128 + tid];
        ((float*)(a.ws + WS_DN))[(size_t)item * 128 + tid] = s_; }
    LDS_BARRIER();
}
struct MoRegs { unsigned xq[11], xk[11], v[8], ov[8]; float gi, gf, mprev; };
__device__ __forceinline__ void mo_load(const Args& a, int l, int item, MoRegs& R) {
    const int b = item >> 8, c = (item >> 2) & 63, h = item & 3, row0 = b * SEQ + c * CH, tid = otid(), lane = tid & 63, wave = tid >> 6;
    const bf16_t* z = (const bf16_t*)(a.ws + WS_Z);
    const float* gates = (const float*)(a.ws + WS_SMALL + SM_GATES);
    const int cp = lane, lg = wave, colq = ZQ + h * DH + 2 * cp, colk = ZK + h * DH + 2 * cp, colv = ZV + h * DH + 2 * cp, colo = ZO + h * DH + 2 * cp;
    conv_load11(z + colq, row0, 8 * lg, c == 0, R.xq);
    conv_load11(z + colk, row0, 8 * lg, c == 0, R.xk);
#pragma unroll
    for (int i = 0; i < 8; ++i) { R.v[i] = *(const unsigned*)(z + (size_t)(row0 + 8 * lg + i) * ZW + colv); R.ov[i] = *(const unsigned*)(z + (size_t)(row0 + 8 * lg + i) * ZW + colo); }
    R.gi = gates[(size_t)(row0 + lane) * 8 + h]; R.gf = gates[(size_t)(row0 + lane) * 8 + 4 + h];
    R.mprev = ((const float*)(a.ws + WS_SMALL + SM_MPREV))[item];
}
__device__ __forceinline__ void mo_compute(const Args& a, unsigned char* lds, int l, int item, MoRegs& R, ConvW& cwq, ConvW& cwk, int& hw) {
    const int b = item >> 8, c = (item >> 2) & 63, h = item & 3, row0 = b * SEQ + c * CH, tid = otid(), lane = tid & 63, wave = tid >> 6, fr = lane & 15, fq = lane >> 4;
    unsigned char* QN = lds; unsigned char* KN = lds + 17408; unsigned char* VT = lds + 34816; unsigned char* SP = lds + 53248; unsigned char* ON = lds + 62464;
    float* sc = (float*)(lds + 79872);
    float* SS = (float*)(lds + 79872 + 2048);
    const int cp = lane, lg = wave;
    unsigned (&xq)[11] = R.xq; unsigned (&xk)[11] = R.xk; unsigned (&v)[8] = R.v; unsigned (&ov)[8] = R.ov;
    bf16x8 Cf[4]; f32x4 dnv[4];
    { const bf16_t* ct = (const bf16_t*)(a.ws + WS_CT) + (size_t)item * 128 * 128; const float* dn = (const float*)(a.ws + WS_DN) + (size_t)item * 128;
#pragma unroll
      for (int ks = 0; ks < 4; ++ks) Cf[ks] = *(const bf16x8*)(ct + (wave * 16 + fr) * 128 + ks * 32 + 8 * fq);
#pragma unroll
      for (int j = 0; j < 4; ++j) dnv[j] = *(const f32x4*)(dn + (tid & 7) * 16 + 4 * j); }
    const float gm = a.in[I_GMH][(size_t)l * DM + h * DH + wave * 16 + fr];
    if (hw != h) { const float* wc = a.in[I_WCQK] + (size_t)l * 4 * 1024; const float* bc = a.in[I_BCQK] + (size_t)l * 1024;
        conv_loadw(wc, bc, ZQ + h * DH + 2 * cp, cwq); conv_loadw(wc, bc, ZK + h * DH + 2 * cp, cwk); hw = h; }
    if (tid < 64) {
        const float mprev = R.mprev;
        chunk_gates_r(sc, R.gi, R.gf, lane);
        float g = sc[64 + lane] - sc[lane];
#pragma unroll
        for (int o = 1; o < 64; o <<= 1) { const float n = __shfl_up(g, o); if (lane >= o) g = fmaxf(g, n); }
        const float mrow = sc[lane] + fmaxf(mprev, g);
        sc[128 + lane] = mrow; sc[192 + lane] = __expf(sc[lane] + mprev - mrow);
    }
    {
        float qq[8][2];
        conv_apply(xq, cwq, qq);
#pragma unroll
        for (int i = 0; i < 8; ++i) *(unsigned*)(QN + (8 * lg + i) * 272 + cp * 4) = pk2(siluf_(qq[i][0]) * 0.08838834764831845f, siluf_(qq[i][1]) * 0.08838834764831845f);
        conv_apply(xk, cwk, qq);
#pragma unroll
        for (int i = 0; i < 8; ++i) *(unsigned*)(KN + (8 * lg + i) * 272 + cp * 4) = pk2(siluf_(qq[i][0]), siluf_(qq[i][1]));
        u32x4 p0, p1;
#pragma unroll
        for (int i = 0; i < 4; ++i) { p0[i] = (v[2 * i] & 0xffffu) | (v[2 * i + 1] << 16); p1[i] = (v[2 * i] >> 16) | (v[2 * i + 1] & 0xffff0000u); }
        *(u32x4*)(VT + (2 * cp) * 144 + lg * 16) = p0; *(u32x4*)(VT + (2 * cp + 1) * 144 + lg * 16) = p1;
#pragma unroll
        for (int i = 0; i < 8; ++i) *(unsigned*)(ON + (8 * lg + i) * 272 + cp * 4) = ov[i];
    }
    LDS_BARRIER();
    {
        const int ll = tid >> 3, part = tid & 7; float s_ = 0.f;
#pragma unroll
        for (int j = 0; j < 4; ++j) { const u32x2 qv = *(const u32x2*)(QN + ll * 272 + (part * 16 + 4 * j) * 2);
            s_ += bf2f(qv.x & 0xffffu) * dnv[j].x + __uint_as_float(qv.x & 0xffff0000u) * dnv[j].y + bf2f(qv.y & 0xffffu) * dnv[j].z + __uint_as_float(qv.y & 0xffff0000u) * dnv[j].w; }
        s_ = sum8(s_);
        if (part == 0) sc[384 + ll] = s_;
    }
    {
        const int lt = wave & 3; const int ll = lt * 16 + fr; const float bl_ = sc[ll], mr = sc[128 + ll]; float dsum = 0.f;
#pragma unroll
        for (int mi = 0; mi < 2; ++mi) {
            const int mt = 2 * (wave >> 2) + mi; u32x2 pk = {0u, 0u};
            if (mt <= lt) {
                f32x4 acc = {0.f, 0.f, 0.f, 0.f};
#pragma unroll
                for (int ks = 0; ks < 4; ++ks) { const bf16x8 A = *(const bf16x8*)(KN + (mt * 16 + fr) * 272 + (ks * 32 + 8 * fq) * 2), B = *(const bf16x8*)(QN + (lt * 16 + fr) * 272 + (ks * 32 + 8 * fq) * 2);
                    acc = mfma16(A, B, acc); }
                float sv[4];
#pragma unroll
                for (int r = 0; r < 4; ++r) { const int mm = mt * 16 + 4 * fq + r; const float wgt = (mm <= ll) ? __expf(bl_ - sc[mm] + sc[64 + mm] - mr) : 0.f; sv[r] = acc[r] * wgt; dsum += sv[r]; }
                pk.x = pk2(sv[0], sv[1]); pk.y = pk2(sv[2], sv[3]);
            }
            *(u32x2*)(SP + ll * 144 + (mt * 16 + 4 * fq) * 2) = pk;
        }
        dsum += __shfl_xor(dsum, 16); dsum += __shfl_xor(dsum, 32);
        if (fq == 0) sc[256 + (wave >> 2) * 64 + ll] = dsum;
    }
    LDS_BARRIER();
    if (tid < 64) { const float den = sc[256 + tid] + sc[320 + tid] + sc[192 + tid] * sc[384 + tid]; sc[448 + tid] = fmaxf(fabsf(den), __expf(-sc[128 + tid])); }
    f32x4 acc1[4], acc2[4];
    {
        bf16x8 Vf[2];
#pragma unroll
        for (int ks = 0; ks < 2; ++ks) Vf[ks] = *(const bf16x8*)(VT + (wave * 16 + fr) * 144 + (ks * 32 + 8 * fq) * 2);
#pragma unroll
        for (int lt = 0; lt < 4; ++lt) {
            acc1[lt] = (f32x4){0.f, 0.f, 0.f, 0.f}; acc2[lt] = (f32x4){0.f, 0.f, 0.f, 0.f};
#pragma unroll
            for (int ks = 0; ks < 2; ++ks) acc1[lt] = mfma16(*(const bf16x8*)(SP + (lt * 16 + fr) * 144 + (ks * 32 + 8 * fq) * 2), Vf[ks], acc1[lt]);
#pragma unroll
            for (int ks = 0; ks < 4; ++ks) acc2[lt] = mfma16(*(const bf16x8*)(QN + (lt * 16 + fr) * 272 + (ks * 32 + 8 * fq) * 2), Cf[ks], acc2[lt]);
        }
    }
    LDS_BARRIER();
    float hm[4][4];
#pragma unroll
    for (int lt = 0; lt < 4; ++lt)
#pragma unroll
        for (int r = 0; r < 4; ++r) { const int ll = lt * 16 + 4 * fq + r;
            const float hv = (acc1[lt][r] + sc[192 + ll] * acc2[lt][r]) * frcp(sc[448 + ll]);
            const float o = sigmoidf_(bf2f(*(const bf16_t*)(ON + ll * 272 + (wave * 16 + fr) * 2)));
            hm[lt][r] = hv * o;
            const float q = sum16(hm[lt][r] * hm[lt][r]);
            if (fr == 0) SS[wave * 64 + ll] = q; }
    LDS_BARRIER();
    {
        unsigned char* HM = QN;
#pragma unroll
        for (int lt = 0; lt < 4; ++lt)
#pragma unroll
            for (int r = 0; r < 4; ++r) { const int ll = lt * 16 + 4 * fq + r; float tot = 0.f;
#pragma unroll
                for (int w = 0; w < 8; ++w) tot += SS[w * 64 + ll];
                *(bf16_t*)(HM + ll * 272 + (wave * 16 + fr) * 2) = (bf16_t)f2bf(hm[lt][r] * rsqrtf(tot * (1.f / 128.f) + EPS) * gm); }
        LDS_BARRIER();
        bf16_t* mix = (bf16_t*)(a.ws + WS_MIX);
#pragma unroll
        for (int j = 0; j < 2; ++j) { const int pc = tid + j * NT, ll = pc >> 4, q16 = pc & 15;
            *(u32x4*)(mix + (size_t)(row0 + ll) * D + h * DH + q16 * 8) = *(const u32x4*)(HM + ll * 272 + q16 * 16); }
    }
    LDS_BARRIER();
}

template <int MODE>
__device__ __forceinline__ void rglru_item(const Args& a, unsigned char* lds, int l, int item) {
    const int b = item >> 6, c = item & 63, row0 = b * SEQ + c * CH, ch = otid(), lane = ch & 63, nb = ch >> 6;
    float* xs = (float*)lds + nb * 64 * 64;
    const bf16_t* z = (const bf16_t*)(a.ws + WS_Z);
    const float* wcr = a.in[I_WCR] + (size_t)l * 4 * DR; const float bcr = a.in[I_BCR][l * DR + ch];
    const float w0 = wcr[ch], w1 = wcr[DR + ch], w2 = wcr[2 * DR + ch], w3 = wcr[3 * DR + ch];
    const bf16_t* zc = z + ZXR + ch;
    float xm3 = 0.f, xm2 = 0.f, xm1 = 0.f;
    { const int s0 = c * CH; if (s0 >= 3) { xm3 = bf2f(zc[(size_t)(row0 - 3) * ZW]); xm2 = bf2f(zc[(size_t)(row0 - 2) * ZW]); xm1 = bf2f(zc[(size_t)(row0 - 1) * ZW]); } }
#pragma unroll 4
    for (int t = 0; t < 64; ++t) { const float x0 = bf2f(zc[(size_t)(row0 + t) * ZW]);
        xs[t * 64 + lane] = bcr + w0 * xm3 + w1 * xm2 + w2 * xm1 + w3 * x0; xm3 = xm2; xm2 = xm1; xm1 = x0; }
    unsigned wa[32], wx[32];
    const float* wra = a.in[I_WRA] + ((size_t)(l * NBR + nb) * 64) * 64 + lane; const float* wri = a.in[I_WRI] + ((size_t)(l * NBR + nb) * 64) * 64 + lane;
#pragma unroll
    for (int d = 0; d < 32; ++d) { wa[d] = pk2(wra[(2 * d) * 64], wra[(2 * d + 1) * 64]); wx[d] = pk2(wri[(2 * d) * 64], wri[(2 * d + 1) * 64]); }
    const float ba = a.in[I_BRA][l * DR + ch], bx = a.in[I_BRI][l * DR + ch];
    const float lam = a.in[I_LAM][l * DR + ch];
    const float sp = fmaxf(-lam, 0.f) + log1pf(__expf(-fabsf(lam)));
    float hst = 0.f, ap = 1.f;
    if (MODE == 1) hst = ((const float*)(a.ws + WS_SMALL + SM_RGP))[(size_t)item * DR + ch];
    const float gr = a.in[I_GR][l * DR + ch];
    bf16_t* mix = (bf16_t*)(a.ws + WS_MIX);
    __syncthreads();
#pragma unroll 1
    for (int t = 0; t < 64; ++t) {
        float ra = ba, ia = bx;
#pragma unroll
        for (int d4 = 0; d4 < 16; ++d4) { const f32x4 xv = *(const f32x4*)(xs + t * 64 + 4 * d4);
#pragma unroll
            for (int q = 0; q < 2; ++q) { const unsigned pa = wa[2 * d4 + q], px = wx[2 * d4 + q];
                ra += xv[2 * q] * __uint_as_float(pa << 16) + xv[2 * q + 1] * __uint_as_float(pa & 0xffff0000u);
                ia += xv[2 * q] * __uint_as_float(px << 16) + xv[2 * q + 1] * __uint_as_float(px & 0xffff0000u); } }
        const float xo = xs[t * 64 + lane];
        const float r = sigmoidf_(ra), ig = sigmoidf_(ia), la = -8.f * r * sp, av = __expf(la);
        const float uu = sqrtf(-expm1f(2.f * la)) * (ig * xo);
        hst = av * hst + uu; ap *= av;
        if (MODE == 1) {
            const float y = bf2f(z[(size_t)(row0 + t) * ZW + ZYR + ch]);
            const float o = hst * gelu_tanh(y);
            const float rs = rsqrtf(wave_sum(o * o) * (1.f / 64.f) + EPS);
            mix[(size_t)(row0 + t) * D + DM + ch] = (bf16_t)f2bf(o * rs * gr);
        }
    }
    if (MODE == 0) { ((float*)(a.ws + WS_SMALL + SM_RGA))[(size_t)item * DR + ch] = ap; ((float*)(a.ws + WS_SMALL + SM_RGH))[(size_t)item * DR + ch] = hst; }
    __syncthreads();
}

template <int MODE>
__device__ __forceinline__ void rglru_fast(const Args& a, unsigned char* lds, int l, int item) {
    const int b = item >> 6, c = item & 63, row0 = b * SEQ + c * CH, ch = otid(), lane = ch & 63, nb = ch >> 6, fr = lane & 15, fq = lane >> 4;
    unsigned char* XA = lds + nb * 9216;
    float* GS = (float*)(lds + 73728 + nb * 8448);
    const bf16_t* z = (const bf16_t*)(a.ws + WS_Z);
    unsigned ypk[32];
    {
        const float* wcr = a.in[I_WCR] + (size_t)l * 4 * DR; const float bcr = a.in[I_BCR][l * DR + ch];
        const float w0 = wcr[ch], w1 = wcr[DR + ch], w2 = wcr[2 * DR + ch], w3 = wcr[3 * DR + ch];
        const bf16_t* zc = z + ZXR + ch;
        bf16_t xin[67];
#pragma unroll
        for (int t = 0; t < 67; ++t) xin[t] = (c == 0 && t < 3) ? (bf16_t)0 : zc[(ptrdiff_t)(row0 + t - 3) * ZW];
        if (MODE == 1) {
            bf16_t yb[64];
#pragma unroll
            for (int t = 0; t < 64; ++t) yb[t] = z[(size_t)(row0 + t) * ZW + ZYR + ch];
#pragma unroll
            for (int t = 0; t < 32; ++t) ypk[t] = (unsigned)yb[2 * t] | ((unsigned)yb[2 * t + 1] << 16);
        }
#pragma unroll
        for (int t = 0; t < 64; ++t)
            *(bf16_t*)(XA + t * 144 + lane * 2) = (bf16_t)f2bf(bcr + w0 * bf2f(xin[t]) + w1 * bf2f(xin[t + 1]) + w2 * bf2f(xin[t + 2]) + w3 * bf2f(xin[t + 3]));
    }
    bf16x8 Bf[8][2];
    { const bf16_t* wt = (const bf16_t*)(a.ws + WS_SMALL + SM_RGW) + (size_t)((l * NBR + nb) * 2) * 64 * 64;
#pragma unroll
        for (int ct = 0; ct < 8; ++ct)
#pragma unroll
            for (int ks = 0; ks < 2; ++ks) Bf[ct][ks] = *(const bf16x8*)(wt + (size_t)((ct >> 2) * 64 + (ct & 3) * 16 + fr) * 64 + ks * 32 + 8 * fq); }
    const float ba = a.in[I_BRA][l * DR + ch], bx = a.in[I_BRI][l * DR + ch];
    const float lam = a.in[I_LAM][l * DR + ch];
    const float sp8 = -8.f * (fmaxf(-lam, 0.f) + log1pf(__expf(-fabsf(lam))));
    float hst = 0.f, ap = 1.f;
    if (MODE == 1) hst = ((const float*)(a.ws + WS_SMALL + SM_RGP))[(size_t)item * DR + ch];
    const float gr = a.in[I_GR][l * DR + ch];
    bf16_t* mix = (bf16_t*)(a.ws + WS_MIX);
    WAVE_LDS_SYNC();
#pragma unroll
    for (int rt = 0; rt < 4; ++rt) {
        bf16x8 Af[2];
#pragma unroll
        for (int ks = 0; ks < 2; ++ks) Af[ks] = *(const bf16x8*)(XA + (rt * 16 + fr) * 144 + (ks * 32 + 8 * fq) * 2);
#pragma unroll
        for (int ct = 0; ct < 8; ++ct) {
            f32x4 acc = {0.f, 0.f, 0.f, 0.f};
            acc = mfma16(Af[0], Bf[ct][0], acc); acc = mfma16(Af[1], Bf[ct][1], acc);
#pragma unroll
            for (int r = 0; r < 4; ++r) GS[(4 * fq + r) * 132 + (ct >> 2) * 64 + (ct & 3) * 16 + fr] = acc[r];
        }
        WAVE_LDS_SYNC();
        {
            float ra[16], ia[16], xo[16], ov_[16];
#pragma unroll
            for (int tt = 0; tt < 16; ++tt) { ra[tt] = GS[tt * 132 + lane]; ia[tt] = GS[tt * 132 + 64 + lane]; xo[tt] = bf2f(*(const bf16_t*)(XA + (rt * 16 + tt) * 144 + lane * 2)); }
#pragma unroll
            for (int tt = 0; tt < 16; ++tt) {
                const float r = sigmoidf_(ra[tt] + ba), ig = sigmoidf_(ia[tt] + bx), la = sp8 * r, av = __expf(la);
                const float uu = __builtin_amdgcn_sqrtf(fmaxf(fmaf(-av, av, 1.f), 0.f)) * (ig * xo[tt]);
                hst = av * hst + uu; ap *= av;
                ov_[tt] = hst;
            }
            if (MODE == 1) {
#pragma unroll
                for (int tt = 0; tt < 16; ++tt) *(bf16_t*)(XA + (rt * 16 + tt) * 144 + lane * 2) = (bf16_t)f2bf(ov_[tt] * gelu_tanh((tt & 1) ? __uint_as_float(ypk[rt * 8 + (tt >> 1)] & 0xffff0000u) : bf2f(ypk[rt * 8 + (tt >> 1)] & 0xffffu)));
            }
        }
        WAVE_LDS_SYNC();
    }
    if (MODE == 1) {
        float ss = 0.f;
#pragma unroll
        for (int j = 0; j < 8; ++j) { const u32x4 v = *(const u32x4*)(XA + lane * 144 + j * 16);
#pragma unroll
            for (int q = 0; q < 4; ++q) { const float lo = bf2f(v[q] & 0xffffu), hi = __uint_as_float(v[q] & 0xffff0000u); ss += lo * lo + hi * hi; } }
        const float rs = rsqrtf(ss * (1.f / 64.f) + EPS) ;
#pragma unroll
        for (int t0 = 0; t0 < 64; t0 += 16) { float ovv[16];
#pragma unroll
            for (int tt = 0; tt < 16; ++tt) ovv[tt] = bf2f(*(const bf16_t*)(XA + (t0 + tt) * 144 + lane * 2));
#pragma unroll
            for (int tt = 0; tt < 16; ++tt) { const float rst = __int_as_float(__builtin_amdgcn_readlane(__float_as_int(rs), t0 + tt));
                *(bf16_t*)(XA + (t0 + tt) * 144 + lane * 2) = (bf16_t)f2bf(ovv[tt] * rst * gr); } }
        WAVE_LDS_SYNC();
#pragma unroll
        for (int j = 0; j < 8; ++j) { const int t = j * 8 + (lane >> 3), q16 = lane & 7;
            *(u32x4*)(mix + (size_t)(row0 + t) * D + DM + nb * 64 + q16 * 8) = *(const u32x4*)(XA + t * 144 + q16 * 16); }
    }
    if (MODE == 0) { ((float*)(a.ws + WS_SMALL + SM_RGA))[(size_t)item * DR + ch] = ap; ((float*)(a.ws + WS_SMALL + SM_RGH))[(size_t)item * DR + ch] = hst; }
    LDS_BARRIER();
}
__device__ __forceinline__ void rglru_scan(const Args& a, int G) {
    const int tid = otid();
    for (int i = blockIdx.x * 8 + (tid & 7); i < NBATCH * DR && tid < 8; i += G * 8) {
        const int b = i / DR, ch = i % DR;
        const float* A_ = (const float*)(a.ws + WS_SMALL + SM_RGA) + (size_t)(b * NC) * DR + ch; const float* H_ = (const float*)(a.ws + WS_SMALL + SM_RGH) + (size_t)(b * NC) * DR + ch;
        float* P_ = (float*)(a.ws + WS_SMALL + SM_RGP) + (size_t)(b * NC) * DR + ch;
        float hs = 0.f;
#pragma unroll 1
        for (int c0 = 0; c0 < NC; c0 += 16) {
            float av[16], hv[16];
#pragma unroll
            for (int j = 0; j < 16; ++j) { av[j] = A_[(c0 + j) * DR]; hv[j] = H_[(c0 + j) * DR]; }
#pragma unroll
            for (int j = 0; j < 16; ++j) { P_[(c0 + j) * DR] = hs; hs = av[j] * hs + hv[j]; }
        }
    }
}

__device__ __forceinline__ void phase_route(const Args& a, unsigned char* lds) {
    unsigned* wtot = (unsigned*)lds;
    int* pre = (int*)(lds + 256);
    int* tot = pre + 8;
    int* ce = tot + 16;
    unsigned* pref = (unsigned*)(lds + 2048);
    const int tid = otid(), lane = tid & 63, wave = tid >> 6, G = gridDim.x;
    const unsigned char* tok_p = (const unsigned char*)(a.ws + WS_SMALL + SM_TOKP); const float* tok_g = (const float*)(a.ws + WS_SMALL + SM_TOKG);
    int* row_tok = (int*)(a.ws + WS_SMALL + SM_ROWTOK); float* row_gate = (float*)(a.ws + WS_SMALL + SM_ROWGATE); int* tile_e = (int*)(a.ws + WS_SMALL + SM_TILEE);
    if (tid < 256) {
        unsigned long long hh = 0ull;
#pragma unroll
        for (int j = 0; j < 4; ++j) { const u32x4 v = ((const u32x4*)(tok_p + tid * 64))[j];
#pragma unroll
            for (int q = 0; q < 4; ++q)
#pragma unroll
                for (int bb = 0; bb < 4; ++bb) { const unsigned by = (v[q] >> (8 * bb)) & 0xffu; hh += (1ull << (8 * (by & 15u))) + (1ull << (8 * (by >> 4))); } }
        unsigned w[4];
#pragma unroll
        for (int i = 0; i < 4; ++i) { const unsigned two = (unsigned)(hh >> (16 * i)) & 0xffffu; w[i] = (two & 0xffu) | ((two >> 8) << 16); }
        unsigned inc[4];
#pragma unroll
        for (int i = 0; i < 4; ++i) { unsigned x = w[i];
#pragma unroll
            for (int o = 1; o < 64; o <<= 1) { const unsigned n = __shfl_up(x, o); if (lane >= o) x += n; }
            inc[i] = x; }
        if (lane == 63) {
#pragma unroll
            for (int i = 0; i < 4; ++i) wtot[wave * 4 + i] = inc[i]; }
        __builtin_amdgcn_s_waitcnt(0);
        __builtin_amdgcn_s_barrier();
#pragma unroll
        for (int i = 0; i < 4; ++i) { unsigned base = 0u;
            for (int ww = 0; ww < wave; ++ww) base += wtot[ww * 4 + i];
            pref[tid * 4 + i] = base + inc[i] - w[i];
            if (tid == 255) { const unsigned t2 = base + inc[i]; tot[2 * i] = (int)(t2 & 0xffffu); tot[2 * i + 1] = (int)(t2 >> 16); } }
    } else {
        __builtin_amdgcn_s_barrier();
    }
    __syncthreads();
    if (tid == 0) { int s_ = 0; for (int e = 0; e < 8; ++e) { tot[8 + e] = s_; s_ += (tot[e] + 255) & ~255; }
        if (blockIdx.x == 0) { int t = 0; for (int e = 0; e < 8; ++e) { const int n = (tot[e] + 255) >> 8; for (int j = 0; j < n; ++j) tile_e[t++] = e; } tile_e[255] = t; } }
    __syncthreads();
    for (int ck = blockIdx.x; ck < 256; ck += G) {
        if (tid < 128) { const unsigned by = tok_p[ck * 64 + (tid >> 1)]; ce[tid] = (tid & 1) ? (int)(by >> 4) : (int)(by & 15u); }
        __syncthreads();
        if (tid < 128) { const int e = ce[tid];
            int rank = 0, w0cnt = 0;
#pragma unroll
            for (int q = 0; q < 8; ++q) { const unsigned long long mk = __ballot(e == q); if (e == q) rank = __popcll(mk & ((1ull << lane) - 1ull)); if (wave == 0 && lane == 0) ce[128 + q] = __popcll(mk); }
            __builtin_amdgcn_s_waitcnt(0);
            asm volatile("s_barrier" ::: "memory");
            if (wave == 1) rank += ce[128 + e];
            (void)w0cnt;
            const unsigned pw = pref[ck * 4 + (e >> 1)]; const int pr = (int)((e & 1) ? (pw >> 16) : (pw & 0xffffu));
            const int dest = tot[8 + e] + pr + rank;
            row_tok[dest] = ck * 64 + (tid >> 1); row_gate[dest] = tok_g[ck * 128 + tid]; ((int*)(a.ws + WS_SMALL + SM_ROWSLOT))[dest] = tid & 1; }
        else { asm volatile("s_barrier" ::: "memory"); }
        __syncthreads();
    }
}

#ifndef GEMM
#define GEMM gemm_fast
#endif
__global__ void __launch_bounds__(NT, 2) mk_fwd(Args a0) {
    extern __shared__ __attribute__((aligned(16))) unsigned char lds[];
    const int G = gridDim.x, bid = blockIdx.x, ph_lo = a0.ph_lo, ph_hi = a0.ph_hi;
    volatile LAS unsigned* xst = (volatile LAS unsigned*)(lds + LDS_BYTES - 64);
    if (threadIdx.x < 2) xst[threadIdx.x] = 0u;
    __syncthreads();
    const XcdBarrier xb = xcd_barrier_post((unsigned*)(a0.ws + WS_SMALL + SM_BAR), xst);
    int ph = 0;
#ifndef PROBE_CAT
#define PROBE_CAT 0
#define PROBE_N 1
#endif
#define PHASE_BEGIN(cat) if (ph >= ph_lo && ph < ph_hi) { for (int rep_ = 0; rep_ < ((cat) == PROBE_CAT ? PROBE_N : 1); ++rep_) { const bool lastrep = (rep_ + 1 == ((cat) == PROBE_CAT ? PROBE_N : 1)); (void)lastrep; const Args& a = *(const Args*)okarg(); unsigned char* const ws = a.ws; \
    bf16_t* const hn = (bf16_t*)(ws + WS_HN); bf16_t* const z = (bf16_t*)(ws + WS_Z); bf16_t* const mix = (bf16_t*)(ws + WS_MIX); bf16_t* const hid = (bf16_t*)(ws + WS_HID); \
    float* const gates = (float*)(ws + WS_SMALL + SM_GATES); int* const tok_e = (int*)(ws + WS_SMALL + SM_TOKP); float* const tok_g = (float*)(ws + WS_SMALL + SM_TOKG); \
    const int* const row_tok = (const int*)(ws + WS_SMALL + SM_ROWTOK); const float* const row_gate = (const float*)(ws + WS_SMALL + SM_ROWGATE); const int* const tile_e = (const int*)(ws + WS_SMALL + SM_TILEE); \
    (void)hn; (void)z; (void)mix; (void)hid; (void)gates; (void)tok_e; (void)tok_g; (void)row_tok; (void)row_gate; (void)tile_e;
#define PHASE_END(dosync) } for (int rep_ = 0; rep_ < (PROBE_CAT == 6 ? PROBE_N : 1); ++rep_) if ((dosync) && ph + 1 < ph_hi) { xcd_barrier(xb); } } ++ph;

    PHASE_BEGIN(1) phase_prologue(a, lds); __syncthreads();
        phase_rowpass<0, 1, 1, false>(lds, a.in[I_X], hn, nullptr, a.in[I_GMIX], (float*)(ws + WS_SSQ), a.in[I_WIN] + 2048, DIN, a.in[I_BIN] + 2048, gates, nullptr, nullptr, nullptr); PHASE_END(true)
    { constexpr int l = 0;
#define LAYER_PTRS bf16_t* const hb = (bf16_t*)(ws + (l ? WS_H1 : WS_HN)); bf16_t* const hbo = (bf16_t*)(ws + (l ? WS_HN : WS_H1)); float* const ssq = (float*)(ws + WS_SSQ + l * SSQ_STRIDE); float* const ssqo = (float*)(ws + WS_SSQ + (1 - l) * SSQ_STRIDE); (void)hb; (void)hbo; (void)ssq; (void)ssqo;
        PHASE_BEGIN(3) LAYER_PTRS { if (l == 1) phase_rowpass<1, 1, 0, false>(lds, nullptr, hb, nullptr, a.in[I_GMIX] + l * D, nullptr, a.in[I_WIN] + (size_t)l * D * DIN + 2048, DIN, a.in[I_BIN] + l * DIN + 2048, gates, nullptr, nullptr, nullptr);
            GridOrder S{M / 256, ZW / 256, G, bid}; EpiZ E{z, a.in[I_BIN] + l * DIN, ssq};
            GEMM(lds, hb, (const bf16_t*)(ws + (l ? WS_W_IN1 : WS_W_IN0)), D, S, E); } PHASE_END(true)
        PHASE_BEGIN(4) LAYER_PTRS { MlRegs cur, nxt; int it = bid; if (it < 1024) ml_load(a, l, it, cur); nxt = cur;
            for (; it < 1024; it += G) { if (it + G < 1024) ml_load(a, l, it + G, nxt); ml_compute(a, lds, l, it, cur); cur = nxt; }
            for (; it < 1280; it += G) rglru_fast<0>(a, lds, l, it - 1024); } PHASE_END(true)
        PHASE_BEGIN(0) LAYER_PTRS mlstm_scan(a, G); rglru_scan(a, G); PHASE_END(true)
        PHASE_BEGIN(5) LAYER_PTRS { MoRegs cur, nxt; ConvW cwq, cwk; int hw = -1; int it = bid; if (it < 1024) mo_load(a, l, it, cur); nxt = cur;
            for (; it < 1024; it += G) { if (it + G < 1024) mo_load(a, l, it + G, nxt); mo_compute(a, lds, l, it, cur, cwq, cwk, hw); cur = nxt; }
            for (; it < 1280; it += G) rglru_fast<1>(a, lds, l, it - 1024); } PHASE_END(true)
        PHASE_BEGIN(0) LAYER_PTRS { GridOrder S{M / 256, D / 256, G, bid}; EpiHres<l == 0> E{l == 0 ? a.in[I_X] : nullptr, hb, ssq};
            GEMM(lds, mix, (const bf16_t*)(ws + (l ? WS_W_OUT1 : WS_W_OUT0)), D, S, E); } PHASE_END(true)
        if (l == 0) {
            PHASE_BEGIN(3) LAYER_PTRS { GridOrder S{M / 256, 2 * DFF / 256, G, bid}; EpiSwiglu E{hid, ssq, nullptr};
                GEMM(lds, hb, (const bf16_t*)(ws + WS_W_FFGU), D, S, E);
                { constexpr int nun = (M / 256) * (2 * DFF / 256); const int first = nun % G;
                  TailOrder S2{M / 256, D / 256, G, bid, first}; EpiStoreBf16 E2{(bf16_t*)(ws + WS_PP0)};
                  GEMM(lds, (const bf16_t*)(ws + WS_PB0), (const bf16_t*)(ws + WS_W_PP0), DPLE, S2, E2); } } PHASE_END(true)
            PHASE_BEGIN(0) LAYER_PTRS { GridOrder S{M / 256, D / 256, G, bid}; EpiHres<false> E{nullptr, hb, ssq};
                GEMM(lds, hid, (const bf16_t*)(ws + WS_W_FFD), DFF, S, E); } PHASE_END(true)
        } else {
            PHASE_BEGIN(2) LAYER_PTRS phase_rowpass<1, 2, 0, false>(lds, nullptr, hb, nullptr, a.in[I_GFFN] + l * D, nullptr, a.in[I_WROUTER], 8, nullptr, nullptr, (unsigned char*)tok_e, tok_g, nullptr, ws + WS_HN8); PHASE_END(true)
            PHASE_BEGIN(12) LAYER_PTRS phase_route(a, lds); PHASE_END(true)
            PHASE_BEGIN(3) LAYER_PTRS { MoeOrder<true> S{tile_e[255], 2 * DFF / 256, G, bid, tile_e, row_tok, (size_t)5632 * D}; EpiSwiglu8 E{ws + WS_HID, 1.f / 32.f};
                gemm_fast<true>(lds, (const bf16_t*)(ws + WS_HN8), (const bf16_t*)(ws + WS_W_EGU), D, S, E); } PHASE_END(true)
            PHASE_BEGIN(0) LAYER_PTRS { MoeOrder<false> S{tile_e[255], D / 256, G, bid, tile_e, nullptr, (size_t)D * DFF}; EpiMoeDown E{hb, (bf16_t*)a.out, row_tok, (const int*)(ws + WS_SMALL + SM_ROWSLOT), row_gate, 1.f / 32.f};
                gemm_fast<true>(lds, (const bf16_t*)(ws + WS_HID), (const bf16_t*)(ws + WS_W_ED), DFF, S, E);
                { const int nun = tile_e[255] * (D / 256); const int first = nun > 2 * G ? nun - 2 * G : 0;
                  TailOrder S2{M / 256, D / 256, G, bid, first < G ? first : 0}; EpiStoreBf16 E2{(bf16_t*)a.out + (size_t)M * D};
                  GEMM(lds, (const bf16_t*)(ws + WS_PB1), (const bf16_t*)(ws + WS_W_PP1), DPLE, S2, E2); } } PHASE_END(true)
            PHASE_BEGIN(0) LAYER_PTRS phase_rowpass<1, 0, 1, true>(lds, nullptr, hb, (const bf16_t*)a.out, nullptr, ssq, nullptr, 0, nullptr, nullptr, nullptr, nullptr, nullptr); PHASE_END(true)
        }
        PHASE_BEGIN(10) LAYER_PTRS { GridOrder S{M / 256, D / 256, G, bid};
            EpiPle E{hb, hbo, l == 0 ? (const bf16_t*)(ws + WS_PP0) : (const bf16_t*)a.out + (size_t)M * D, ssqo, ssq}; GEMM(lds, hb, (const bf16_t*)(ws + WS_W_PG) + (size_t)l * D * D, D, S, E);
            if (l == 0 && bid == 0) { for (int i = otid(); i < D / 2; i += NT) ((unsigned*)(ws + WS_H1 + (size_t)M * D * 2))[i] = 0u; } } PHASE_END(true)
    }
    { constexpr int l = 1;
        PHASE_BEGIN(3) LAYER_PTRS { if (l == 1) phase_rowpass<1, 1, 0, false>(lds, nullptr, hb, nullptr, a.in[I_GMIX] + l * D, nullptr, a.in[I_WIN] + (size_t)l * D * DIN + 2048, DIN, a.in[I_BIN] + l * DIN + 2048, gates, nullptr, nullptr, nullptr);
            GridOrder S{M / 256, ZW / 256, G, bid}; EpiZ E{z, a.in[I_BIN] + l * DIN, ssq};
            GEMM(lds, hb, (const bf16_t*)(ws + (l ? WS_W_IN1 : WS_W_IN0)), D, S, E); } PHASE_END(true)
        PHASE_BEGIN(4) LAYER_PTRS { MlRegs cur, nxt; int it = bid; if (it < 1024) ml_load(a, l, it, cur); nxt = cur;
            for (; it < 1024; it += G) { if (it + G < 1024) ml_load(a, l, it + G, nxt); ml_compute(a, lds, l, it, cur); cur = nxt; }
            for (; it < 1280; it += G) rglru_fast<0>(a, lds, l, it - 1024); } PHASE_END(true)
        PHASE_BEGIN(0) LAYER_PTRS mlstm_scan(a, G); rglru_scan(a, G); PHASE_END(true)
        PHASE_BEGIN(5) LAYER_PTRS { MoRegs cur, nxt; ConvW cwq, cwk; int hw = -1; int it = bid; if (it < 1024) mo_load(a, l, it, cur); nxt = cur;
            for (; it < 1024; it += G) { if (it + G < 1024) mo_load(a, l, it + G, nxt); mo_compute(a, lds, l, it, cur, cwq, cwk, hw); cur = nxt; }
            for (; it < 1280; it += G) rglru_fast<1>(a, lds, l, it - 1024); } PHASE_END(true)
        PHASE_BEGIN(0) LAYER_PTRS { GridOrder S{M / 256, D / 256, G, bid}; EpiHres<l == 0> E{l == 0 ? a.in[I_X] : nullptr, hb, ssq};
            GEMM(lds, mix, (const bf16_t*)(ws + (l ? WS_W_OUT1 : WS_W_OUT0)), D, S, E); } PHASE_END(true)
        if (l == 0) {
            PHASE_BEGIN(3) LAYER_PTRS { GridOrder S{M / 256, 2 * DFF / 256, G, bid}; EpiSwiglu E{hid, ssq, nullptr};
                GEMM(lds, hb, (const bf16_t*)(ws + WS_W_FFGU), D, S, E);
                { constexpr int nun = (M / 256) * (2 * DFF / 256); const int first = nun % G;
                  TailOrder S2{M / 256, D / 256, G, bid, first}; EpiStoreBf16 E2{(bf16_t*)(ws + WS_PP0)};
                  GEMM(lds, (const bf16_t*)(ws + WS_PB0), (const bf16_t*)(ws + WS_W_PP0), DPLE, S2, E2); } } PHASE_END(true)
            PHASE_BEGIN(0) LAYER_PTRS { GridOrder S{M / 256, D / 256, G, bid}; EpiHres<false> E{nullptr, hb, ssq};
                GEMM(lds, hid, (const bf16_t*)(ws + WS_W_FFD), DFF, S, E); } PHASE_END(true)
        } else {
            PHASE_BEGIN(2) LAYER_PTRS phase_rowpass<1, 2, 0, false>(lds, nullptr, hb, nullptr, a.in[I_GFFN] + l * D, nullptr, a.in[I_WROUTER], 8, nullptr, nullptr, (unsigned char*)tok_e, tok_g, nullptr, ws + WS_HN8); PHASE_END(true)
            PHASE_BEGIN(12) LAYER_PTRS phase_route(a, lds); PHASE_END(true)
            PHASE_BEGIN(3) LAYER_PTRS { MoeOrder<true> S{tile_e[255], 2 * DFF / 256, G, bid, tile_e, row_tok, (size_t)5632 * D}; EpiSwiglu8 E{ws + WS_HID, 1.f / 32.f};
                gemm_fast<true>(lds, (const bf16_t*)(ws + WS_HN8), (const bf16_t*)(ws + WS_W_EGU), D, S, E); } PHASE_END(true)
            PHASE_BEGIN(0) LAYER_PTRS { MoeOrder<false> S{tile_e[255], D / 256, G, bid, tile_e, nullptr, (size_t)D * DFF}; EpiMoeDown E{hb, (bf16_t*)a.out, row_tok, (const int*)(ws + WS_SMALL + SM_ROWSLOT), row_gate, 1.f / 32.f};
                gemm_fast<true>(lds, (const bf16_t*)(ws + WS_HID), (const bf16_t*)(ws + WS_W_ED), DFF, S, E);
                { const int nun = tile_e[255] * (D / 256); const int first = nun > 2 * G ? nun - 2 * G : 0;
                  TailOrder S2{M / 256, D / 256, G, bid, first < G ? first : 0}; EpiStoreBf16 E2{(bf16_t*)a.out + (size_t)M * D};
                  GEMM(lds, (const bf16_t*)(ws + WS_PB1), (const bf16_t*)(ws + WS_W_PP1), DPLE, S2, E2); } } PHASE_END(true)
            PHASE_BEGIN(0) LAYER_PTRS phase_rowpass<1, 0, 1, true>(lds, nullptr, hb, (const bf16_t*)a.out, nullptr, ssq, nullptr, 0, nullptr, nullptr, nullptr, nullptr, nullptr); PHASE_END(true)
        }
        PHASE_BEGIN(10) LAYER_PTRS { GridOrder S{M / 256, D / 256, G, bid};
            EpiPle E{hb, hbo, l == 0 ? (const bf16_t*)(ws + WS_PP0) : (const bf16_t*)a.out + (size_t)M * D, ssqo, ssq}; GEMM(lds, hb, (const bf16_t*)(ws + WS_W_PG) + (size_t)l * D * D, D, S, E);
            if (l == 0 && bid == 0) { for (int i = otid(); i < D / 2; i += NT) ((unsigned*)(ws + WS_H1 + (size_t)M * D * 2))[i] = 0u; } } PHASE_END(true)
    }
    PHASE_BEGIN(0) phase_rowpass<1, 0, 2, false>(lds, nullptr, hn, nullptr, a.in[I_GFINAL], nullptr, nullptr, 0, nullptr, nullptr, nullptr, nullptr, a.out); PHASE_END(false)
}

extern "C" void kernel_launch(void* const* d_in, const int* in_sizes, int n_in, void* d_out, int out_size,
                              void* d_ws, size_t ws_size, hipStream_t stream) {
    static int grid = 0;
    if (grid == 0) {
        if (n_in != 29 || out_size != M * D || ws_size < WS_END) { fprintf(stderr, "kernel_launch: unexpected problem (n_in %d out %d ws %zu)\n", n_in, out_size, ws_size); grid = -1; return; }
        int dev = 0, cus = 0, per_cu = 0;
        (void)hipGetDevice(&dev);
        (void)hipDeviceGetAttribute(&cus, hipDeviceAttributeMultiprocessorCount, dev);
        (void)hipFuncSetAttribute((const void*)mk_fwd, hipFuncAttributeMaxDynamicSharedMemorySize, LDS_BYTES);
        (void)hipOccupancyMaxActiveBlocksPerMultiprocessor(&per_cu, (const void*)mk_fwd, NT, LDS_BYTES);
        if (per_cu < 1) { fprintf(stderr, "kernel_launch: occupancy query says %d blocks per CU\n", per_cu); per_cu = 1; }
        grid = cus;
    }
    if (grid < 0) return;
    Args a{};
    for (int i = 0; i < 29; ++i) a.in[i] = (const float*)d_in[i];
    a.out = (float*)d_out; a.ws = (unsigned char*)d_ws; a.ph_lo = 0; a.ph_hi = 1000;
    (void)hipMemsetAsync((unsigned char*)d_ws + WS_SMALL + SM_BAR, 0, 16 * 1024, stream);
    void* args[] = {&a};
    hipError_t e = hipLaunchCooperativeKernel((void*)mk_fwd, dim3(grid), dim3(NT), args, LDS_BYTES, stream);
    if (e != hipSuccess) fprintf(stderr, "cooperative launch failed: %s (grid %d)\n", hipGetErrorString(e), grid);
}
```

```cpp
#include <hip/hip_runtime.h>
#include <hip/hip_cooperative_groups.h>
#include <cstdio>
#include <cstdint>
namespace cg = cooperative_groups;

constexpr int NT = 512;
constexpr int D = 1024, NBATCH = 4, SEQ = 4096, M = NBATCH * SEQ;
constexpr int CH = 64, NC = SEQ / CH, NH = 4, DH = 128, DM = 512, DR = 512, NBR = 8, DBR = 64;
constexpr int DIN = 3080, ZW = 3072, DFF = 2816, NE = 8, DPLE = 256;
constexpr int PMAX = 2 * M + NE * 256, NTILE_MAX = PMAX / 256;
constexpr int EROWS = 129;
constexpr float EPS = 1e-6f;
constexpr int ZQ = 0, ZK = 512, ZV = 1024, ZO = 1536, ZXR = 2048, ZYR = 2560;

constexpr size_t MiB = 1u << 20;
constexpr size_t WS_SMALL = 0;
constexpr size_t WS_W_IN0 = 4 * MiB;
constexpr size_t WS_W_OUT0 = 10 * MiB;
constexpr size_t WS_W_FFGU = 12 * MiB;
constexpr size_t WS_W_FFD = 23 * MiB;
constexpr size_t WS_PB0 = WS_W_FFD + 5632 * 1024;
constexpr size_t WS_W_PP0 = WS_PB0 + 8 * MiB;
constexpr size_t WS_H1 = 4 * MiB;
constexpr size_t WS_W_IN1 = 37 * MiB;
constexpr size_t WS_W_OUT1 = 43 * MiB;
constexpr size_t WS_W_PG = 45 * MiB;
constexpr size_t WS_W_PP1 = 49 * MiB;
constexpr size_t WS_W_EGU = WS_W_PP1 + MiB / 2;
constexpr size_t WS_W_ED = WS_W_EGU + 88 * MiB;
constexpr size_t WS_HN8 = WS_W_EGU + 44 * MiB;
constexpr size_t WS_PB1 = WS_W_ED + 44 * MiB;
constexpr size_t WS_HN = WS_PB1 + 8 * MiB;
static_assert(WS_H1 + (size_t)(M + 1) * D * 2 <= WS_W_IN1 && WS_W_PP0 + 1024 * 256 * 2 <= WS_W_IN1, "map");
constexpr size_t WS_RF = 222 * MiB;
constexpr size_t WS_Z = WS_RF;
constexpr size_t WS_CT = WS_Z + 96 * MiB;
constexpr size_t WS_DN = WS_CT + 32 * MiB;
constexpr size_t WS_MIX = WS_CT + 72 * MiB;
constexpr size_t WS_HID = WS_RF;
constexpr size_t WS_PP0 = WS_RF + 130 * MiB;
constexpr size_t WS_SSQ = WS_RF + 201 * MiB;
constexpr size_t SSQ_STRIDE = (size_t)(M + 16) * 64;
constexpr size_t WS_END = 435 * MiB;
static_assert(WS_MIX + (size_t)M * D * 2 <= WS_SSQ && WS_HID + (size_t)PMAX * DFF * 2 <= WS_SSQ && WS_SSQ + 2 * SSQ_STRIDE <= WS_END, "map");
static_assert(WS_HN + (size_t)(M + 1) * D * 2 <= WS_RF, "map");
static_assert(WS_MIX + (size_t)M * D * 2 <= WS_END, "map");
static_assert(WS_HID + (size_t)PMAX * DFF * 2 <= WS_END, "map");
static_assert(WS_DN + 1024 * 128 * 4 <= WS_PP0 && WS_PP0 + (size_t)M * D * 2 <= WS_MIX && WS_HID + (size_t)M * DFF * 2 <= WS_PP0, "map");
constexpr size_t SM_GATES = 0;
constexpr size_t SM_TOKE = 512 * 1024;
constexpr size_t SM_TOKG = SM_TOKE + 128 * 1024;
constexpr size_t SM_ROWTOK = SM_TOKG + 128 * 1024;
constexpr size_t SM_ROWGATE = SM_ROWTOK + 160 * 1024;
constexpr size_t SM_TILEE = SM_ROWGATE + 160 * 1024;
constexpr size_t SM_ROWSLOT = SM_TILEE + 4 * 1024;
constexpr size_t SM_TOKP = SM_ROWSLOT + 160 * 1024;
constexpr size_t SM_BL = SM_TOKP + 16 * 1024;
constexpr size_t SM_AMAX = SM_BL + 4 * 1024;
constexpr size_t SM_MPREV = SM_AMAX + 4 * 1024;
constexpr size_t SM_RGA = 2 * MiB;
constexpr size_t SM_RGH = SM_RGA + 512 * 1024;
constexpr size_t SM_RGP = SM_RGH + 512 * 1024;
constexpr size_t SM_BAR = SM_RGP + 512 * 1024;
constexpr size_t SM_RGW = SM_BAR + 16 * 1024;
static_assert(SM_MPREV + 4096 <= SM_RGA && SM_RGW + 256 * 1024 <= 4 * MiB, "small map");

constexpr int LDS_BYTES = 147456;

typedef unsigned short bf16_t;
typedef float f32x4 __attribute__((ext_vector_type(4)));
typedef unsigned u32x4 __attribute__((ext_vector_type(4)));
typedef unsigned u32x2 __attribute__((ext_vector_type(2)));

__device__ __forceinline__ float bf2f(unsigned v) { return __uint_as_float(v << 16); }
__device__ __forceinline__ unsigned pk2(float lo, float hi);
__device__ __forceinline__ unsigned f2bf(float f) { return pk2(f, 0.f) & 0xffffu; }
typedef float f32x2_t __attribute__((ext_vector_type(2))); typedef __bf16 bf16x2_t __attribute__((ext_vector_type(2)));
__device__ __forceinline__ unsigned pk2(float lo, float hi) { f32x2_t v = {lo, hi}; bf16x2_t b = __builtin_convertvector(v, bf16x2_t); return __builtin_bit_cast(unsigned, b); }
__device__ __forceinline__ unsigned pk4_fp8(float a, float b, float c, float d) { int w = __builtin_amdgcn_cvt_pk_fp8_f32(a, b, 0, false); w = __builtin_amdgcn_cvt_pk_fp8_f32(c, d, w, true); return (unsigned)w; }
__device__ __forceinline__ float frcp(float x) { return __builtin_amdgcn_rcpf(x); }
__device__ __forceinline__ float sigmoidf_(float x) { return frcp(1.f + __expf(-x)); }
__device__ __forceinline__ float siluf_(float x) { return x * frcp(1.f + __expf(-x)); }
__device__ __forceinline__ float logsigmoidf_(float x) { return fminf(x, 0.f) - log1pf(__expf(-fabsf(x))); }
__device__ __forceinline__ float gelu_tanh(float y) { const float u2 = 1.5957691216057308f * (y + 0.044715f * y * y * y); return y * frcp(1.f + __expf(-u2)); }
__device__ __forceinline__ float wave_sum(float v) {
#pragma unroll
    for (int o = 1; o < 64; o <<= 1) v += __shfl_xor(v, o);
    return v;
}
__device__ __forceinline__ float wave_max(float v) {
#pragma unroll
    for (int o = 1; o < 64; o <<= 1) v = fmaxf(v, __shfl_xor(v, o));
    return v;
}

__device__ __forceinline__ float dpp_f(float v, const int ctrl_sel) {
    const int x = __float_as_int(v); int r;
    if (ctrl_sel == 0) r = __builtin_amdgcn_update_dpp(x, x, 0xB1, 0xF, 0xF, false);
    else if (ctrl_sel == 1) r = __builtin_amdgcn_update_dpp(x, x, 0x4E, 0xF, 0xF, false);
    else if (ctrl_sel == 2) r = __builtin_amdgcn_update_dpp(x, x, 0x141, 0xF, 0xF, false);
    else r = __builtin_amdgcn_update_dpp(x, x, 0x140, 0xF, 0xF, false);
    return __int_as_float(r);
}
__device__ __forceinline__ float sum4(float v) { v += dpp_f(v, 0); v += dpp_f(v, 1); return v; }
__device__ __forceinline__ float sum8(float v) { v = sum4(v); v += dpp_f(v, 2); return v; }
__device__ __forceinline__ float sum16(float v) { v = sum8(v); v += dpp_f(v, 3); return v; }
#define WAVE_LDS_SYNC() asm volatile("s_waitcnt lgkmcnt(0)" ::: "memory")
#define LDS_BARRIER() do { asm volatile("s_waitcnt lgkmcnt(0)" ::: "memory"); __builtin_amdgcn_s_barrier(); asm volatile("" ::: "memory"); } while (0)
__device__ __forceinline__ int otid() { int t = threadIdx.x; asm volatile("" : "+v"(t)); return t; }
__device__ __forceinline__ int oint(int v) { asm volatile("" : "+s"(v)); return v; }
__device__ __forceinline__ const void* okarg() { auto p = __builtin_amdgcn_kernarg_segment_ptr(); asm volatile("" : "+s"(p)); return (const void*)p; }

struct Args { const float* in[29]; float* out; unsigned char* ws; int ph_lo, ph_hi; };
enum { I_X = 0, I_P, I_GMIX, I_WIN, I_BIN, I_WCQK, I_BCQK, I_GMH, I_WCR, I_BCR, I_WRA, I_BRA, I_WRI, I_BRI, I_LAM, I_GR, I_WOUT, I_GFFN,
       I_WFG, I_WFU, I_WFD, I_WROUTER, I_WEG, I_WEU, I_WED, I_GPLE, I_WPG, I_WPP, I_GFINAL };


#define XB_TMO      128
#define XB_XCNT(j)  (256  + 64 * (j))
#define XB_XSUB(j)  (1280 + 64 * (j))
#define XB_XGEN(j)  (2304 + 64 * (j))
#define XB_TOP      3328
#define XB_TOPGEN   3392
#define XCD_BAR_WORDS 3456
#define XB_SPIN_CAP (1u << 18)
#define LAS __attribute__((address_space(3)))
__device__ __forceinline__ unsigned xb_ld(unsigned* p)              { return __hip_atomic_load(p, __ATOMIC_RELAXED, __HIP_MEMORY_SCOPE_AGENT); }
__device__ __forceinline__ unsigned xb_add(unsigned* p, unsigned v) { return __hip_atomic_fetch_add(p, v, __ATOMIC_RELAXED, __HIP_MEMORY_SCOPE_AGENT); }
__device__ __forceinline__ unsigned xb_xcc_id() { return (unsigned)__builtin_amdgcn_s_getreg((3 << 11) | 20) & 0xFu; }
#define XB_SPIN(cond, bar) do { unsigned _sp = 0; while (cond) { __builtin_amdgcn_s_sleep(1); \
    if ((++_sp & 255u) == 0u) { if (xb_ld(&(bar)[XB_TMO])) break; if (_sp > XB_SPIN_CAP) { atomicAdd(&(bar)[XB_TMO], 1u); break; } } } } while (0)
struct XcdBarrier { unsigned* bar; unsigned x; volatile LAS unsigned* st; };
__device__ __forceinline__ XcdBarrier xcd_barrier_post(unsigned* bar, volatile LAS unsigned* st) {
    XcdBarrier b; b.bar = bar; b.x = xb_xcc_id(); b.st = st;
    if (threadIdx.x == 0) (void)xb_add(&bar[XB_XCNT(b.x)], 1u);
    return b;
}
__device__ __forceinline__ void xcd_barrier_complete(unsigned* bar, unsigned x, unsigned& nloc, unsigned& nx) {
    const unsigned G = gridDim.x * gridDim.y * gridDim.z;
    unsigned sum, cnt, mine, sp = 0u;
    for (;;) {
        sum = 0u; cnt = 0u; mine = 0u;
#pragma unroll
        for (unsigned j = 0; j < 16; ++j) { const unsigned c = xb_ld(&bar[XB_XCNT(j)]); sum += c; cnt += (c > 0u) ? 1u : 0u; mine = (j == x) ? c : mine; }
        if (sum == G) break;
        __builtin_amdgcn_s_sleep(1);
        if ((++sp & 255u) == 0u) { if (xb_ld(&bar[XB_TMO])) break; if (sp > XB_SPIN_CAP) { atomicAdd(&bar[XB_TMO], 1u); break; } }
    }
    nloc = mine > 0u ? mine : 1u; nx = cnt > 0u ? cnt : 1u;
}
__device__ __forceinline__ void xcd_barrier(const XcdBarrier& b) {
    asm volatile("s_waitcnt vmcnt(0)" ::: "memory");
    __syncthreads();
    if (threadIdx.x == 0) {
        unsigned* bar = b.bar;
        __builtin_amdgcn_s_waitcnt(0);
        unsigned nloc = b.st[0], nx = b.st[1];
        if (nloc == 0u) { xcd_barrier_complete(bar, b.x, nloc, nx); b.st[0] = nloc; b.st[1] = nx; }
        const unsigned old = xb_add(&bar[XB_XSUB(b.x)], 1u);
        const unsigned gen = old / nloc;
        if (old + 1u == (gen + 1u) * nloc) {
            __builtin_amdgcn_fence(__ATOMIC_RELEASE, "agent");
            asm volatile("s_waitcnt vmcnt(0)" ::: "memory");
            const unsigned og = xb_add(&bar[XB_TOP], 1u);
            const unsigned tg = og / nx;
            if (og + 1u == (tg + 1u) * nx) xb_add(&bar[XB_TOPGEN], 1u);
            else XB_SPIN(xb_ld(&bar[XB_TOPGEN]) == tg, bar);
            __builtin_amdgcn_fence(__ATOMIC_ACQUIRE, "agent");
            xb_add(&bar[XB_XGEN(b.x)], 1u);
            asm volatile("s_waitcnt vmcnt(0)" ::: "memory");
        } else {
            XB_SPIN(xb_ld(&bar[XB_XGEN(b.x)]) == gen, bar);
            __builtin_amdgcn_fence(__ATOMIC_ACQUIRE, "agent");
            asm volatile("s_waitcnt vmcnt(0)" ::: "memory");
        }
    }
    __syncthreads();
}

struct CvtJob { const float* src; bf16_t* dst; int ld, k0, c0, K, n0; const float* gain; int fp8; };
__device__ __forceinline__ void cvt_plain_job(CvtJob& o, const float* src, int K, int N, bf16_t* dst, int tile, const float* gain) {
    const int nt = N / 64, kb = tile / nt, nb = tile % nt; o.src = src; o.dst = dst; o.ld = N; o.k0 = kb * 64; o.c0 = nb * 64; o.K = K; o.n0 = nb * 64; o.gain = gain; o.fp8 = 0;
}
__device__ __forceinline__ void cvt_gu_job(CvtJob& o, const float* g, const float* u, bf16_t* dst, int tile, const float* gain) {
    const int nt = 5632 / 64, kb = tile / nt, nb = tile % nt, n0 = nb * 64, tt = n0 >> 8, half = (n0 >> 7) & 1, w = n0 & 127;
    o.src = half ? u : g; o.dst = dst; o.ld = DFF; o.k0 = kb * 64; o.c0 = tt * 128 + w; o.K = 1024; o.n0 = n0; o.gain = gain; o.fp8 = 0;
}
__device__ __forceinline__ void cvt_job(const Args& a, int it, CvtJob& o) {
    unsigned char* ws = a.ws;
    constexpr int T_IN = 16 * 48, T_OUT = 16 * 16, T_GU = 16 * 88, T_FD = 44 * 16, T_PG = 256, T_PP = 4 * 16;
    int r = it;
    if (r < 2 * T_IN) { const int l = r / T_IN, tile = r % T_IN; const int nt = ZW / 64, kb = tile / nt, nb = tile % nt, n0 = nb * 64;
        o.src = a.in[I_WIN] + (size_t)l * D * DIN; o.dst = (bf16_t*)(ws + (l ? WS_W_IN1 : WS_W_IN0)); o.ld = DIN; o.k0 = kb * 64; o.c0 = n0 < 2048 ? n0 : n0 + 8; o.K = D; o.n0 = n0; o.gain = a.in[I_GMIX] + l * D; o.fp8 = 0; return; }
    r -= 2 * T_IN;
    if (r < 2 * T_OUT) { const int l = r / T_OUT; cvt_plain_job(o, a.in[I_WOUT] + (size_t)l * D * D, D, D, (bf16_t*)(ws + (l ? WS_W_OUT1 : WS_W_OUT0)), r % T_OUT, nullptr); return; }
    r -= 2 * T_OUT;
    if (r < T_GU) { cvt_gu_job(o, a.in[I_WFG], a.in[I_WFU], (bf16_t*)(ws + WS_W_FFGU), r, a.in[I_GFFN]); return; }
    r -= T_GU;
    if (r < T_FD) { cvt_plain_job(o, a.in[I_WFD], DFF, D, (bf16_t*)(ws + WS_W_FFD), r, nullptr); return; }
    r -= T_FD;
    if (r < 2 * T_PG) { const int l = r / T_PG; cvt_plain_job(o, a.in[I_WPG] + (size_t)l * D * D, D, D, (bf16_t*)(ws + WS_W_PG) + (size_t)l * D * D, r % T_PG, a.in[I_GPLE] + l * D); return; }
    r -= 2 * T_PG;
    if (r < 2 * T_PP) { const int l = r / T_PP; cvt_plain_job(o, a.in[I_WPP] + (size_t)l * DPLE * D, DPLE, D, (bf16_t*)(ws + (l ? WS_W_PP1 : WS_W_PP0)), r % T_PP, nullptr); return; }
    r -= 2 * T_PP;
    if (r < 8 * T_GU) { const int e = r / T_GU; cvt_gu_job(o, a.in[I_WEG] + (size_t)e * D * DFF, a.in[I_WEU] + (size_t)e * D * DFF, (bf16_t*)(ws + WS_W_EGU + (size_t)e * 5632 * D), r % T_GU, nullptr); o.fp8 = 1; return; }
    r -= 8 * T_GU;
    { const int e = r / T_FD; cvt_plain_job(o, a.in[I_WED] + (size_t)e * DFF * D, DFF, D, (bf16_t*)(ws + WS_W_ED + (size_t)e * D * DFF), r % T_FD, nullptr); o.fp8 = 1; }
}
__device__ __forceinline__ void phase_prologue(const Args& a, unsigned char* lds) {
    unsigned char* ws = a.ws;
    const int G = gridDim.x, t = otid();
    constexpr int T_IN = 16 * 48, T_OUT = 16 * 16, T_GU = 16 * 88, T_FD = 44 * 16, T_PG = 256, T_PP = 4 * 16;
    constexpr int NT_ALL = 2 * T_IN + 2 * T_OUT + T_GU + T_FD + 2 * T_PG + 2 * T_PP + 8 * T_GU + 8 * T_FD;
    constexpr int NB = 4;
    const int kk0 = t >> 4, cc = (t & 15) * 4, n = t >> 3, kg = t & 7;
    float4 v[NB][2], vn[NB][2];
    int it0 = blockIdx.x * NB;
    if (it0 < NT_ALL) {
#pragma unroll
        for (int b = 0; b < NB; ++b) { const int it = it0 + b < NT_ALL ? it0 + b : NT_ALL - 1; CvtJob jq; cvt_job(a, it, jq);
#pragma unroll
            for (int j = 0; j < 2; ++j) v[b][j] = *(const float4*)(jq.src + (size_t)(jq.k0 + kk0 + 32 * j) * jq.ld + jq.c0 + cc); }
    }
    for (; it0 < NT_ALL; it0 += G * NB) {
        const int itn = it0 + G * NB;
        if (itn < NT_ALL) {
#pragma unroll
            for (int b = 0; b < NB; ++b) { const int it = itn + b < NT_ALL ? itn + b : NT_ALL - 1; CvtJob jq; cvt_job(a, it, jq);
#pragma unroll
                for (int j = 0; j < 2; ++j) vn[b][j] = *(const float4*)(jq.src + (size_t)(jq.k0 + kk0 + 32 * j) * jq.ld + jq.c0 + cc); }
        }
#pragma unroll
        for (int b = 0; b < NB; ++b) { float* tl = (float*)lds + b * (64 * 65); const int it = it0 + b < NT_ALL ? it0 + b : NT_ALL - 1; CvtJob jq; cvt_job(a, it, jq);
#pragma unroll
            for (int j = 0; j < 2; ++j) { float4 w = v[b][j];
                if (jq.gain) { const float gk = jq.gain[jq.k0 + kk0 + 32 * j]; w.x *= gk; w.y *= gk; w.z *= gk; w.w *= gk; }
                float* p = tl + (kk0 + 32 * j) * 65 + cc; p[0] = w.x; p[1] = w.y; p[2] = w.z; p[3] = w.w; } }
        LDS_BARRIER();
#pragma unroll
        for (int b = 0; b < NB; ++b) { if (it0 + b >= NT_ALL) break; const float* s_ = (const float*)lds + b * (64 * 65) + (8 * kg) * 65 + n; CvtJob jq; cvt_job(a, it0 + b, jq);
            if (jq.fp8) { u32x2 o; o.x = pk4_fp8(32.f * s_[0], 32.f * s_[65], 32.f * s_[130], 32.f * s_[195]); o.y = pk4_fp8(32.f * s_[260], 32.f * s_[325], 32.f * s_[390], 32.f * s_[455]);
                *(u32x2*)((unsigned char*)jq.dst + (size_t)(jq.n0 + n) * jq.K + jq.k0 + 8 * kg) = o; }
            else { u32x4 o; o.x = pk2(s_[0], s_[65]); o.y = pk2(s_[130], s_[195]); o.z = pk2(s_[260], s_[325]); o.w = pk2(s_[390], s_[455]);
                *(u32x4*)(jq.dst + (size_t)(jq.n0 + n) * jq.K + jq.k0 + 8 * kg) = o; } }
        LDS_BARRIER();
#pragma unroll
        for (int b = 0; b < NB; ++b) { v[b][0] = vn[b][0]; v[b][1] = vn[b][1]; }
    }
    const size_t np4 = (size_t)M * DPLE / 4;
    for (size_t i = (size_t)blockIdx.x * NT + otid(); i < 2 * np4; i += (size_t)G * NT) {
        const float4 v = ((const float4*)a.in[I_P])[i]; u32x2 o; o.x = pk2(v.x, v.y); o.y = pk2(v.z, v.w);
        if (i < np4) ((u32x2*)(ws + WS_PB0))[i] = o; else ((u32x2*)(ws + WS_PB1))[i - np4] = o; }
    for (int i = blockIdx.x * NT + otid(); i < 2 * 8 * 2 * 64 * 64; i += G * NT) {
        const int d = i & 63, e = (i >> 6) & 63, g = (i >> 12) & 1, ln = i >> 13;
        ((bf16_t*)(ws + WS_SMALL + SM_RGW))[i] = (bf16_t)f2bf((g ? a.in[I_WRI] : a.in[I_WRA])[((size_t)ln * 64 + d) * 64 + e]);
    }
    if (blockIdx.x == 0) { for (int i = otid(); i < D / 4; i += NT) ((unsigned*)(ws + WS_HN8 + (size_t)M * D))[i] = 0u; for (int i = otid(); i < D / 2; i += NT) ((unsigned*)(ws + WS_HN + (size_t)M * D * 2))[i] = 0u; if (otid() < 32) ((float*)(ws + WS_SSQ + (otid() >> 4) * SSQ_STRIDE))[(size_t)M * 16 + (otid() & 15)] = 0.f; }
    for (int i = blockIdx.x * NT + otid(); i < PMAX; i += G * NT) { ((int*)(ws + WS_SMALL + SM_ROWTOK))[i] = M; ((float*)(ws + WS_SMALL + SM_ROWGATE))[i] = 0.f; }
}

template <int IN, bool ADDY> struct RawRow {
    f32x4 x[IN == 0 ? 4 : 1]; u32x2 h[IN == 1 ? 4 : 1]; u32x2 y[ADDY ? 4 : 1];
    __device__ __forceinline__ void load(const float* xin, const bf16_t* hb, const bf16_t* y1, int r, int lane) {
#pragma unroll
        for (int j = 0; j < 4; ++j) {
            if (IN == 0) x[j] = ((const f32x4*)(xin + (size_t)r * D) + lane)[64 * j]; else h[j] = ((const u32x2*)(hb + (size_t)r * D) + lane)[64 * j];
            if (ADDY) y[j] = ((const u32x2*)(y1 + (size_t)r * D) + lane)[64 * j]; }
    }
    __device__ __forceinline__ void copy_from(const RawRow& o) {
#pragma unroll
        for (int j = 0; j < 4; ++j) { if (IN == 0) x[j] = o.x[j]; else h[j] = o.h[j]; if (ADDY) y[j] = o.y[j]; }
    }
};
template <int IN, int AUX, int WR, bool ADDY>
__device__ __forceinline__ void phase_rowpass(unsigned char* lds, const float* xin, bf16_t* hb, const bf16_t* y1, const float* g, float* ssq,
                                              const float* auxW, int auxld, const float* auxB, float* gates, unsigned char* tok_p, float* tok_g, float* fout, unsigned char* h8 = nullptr) {
    float* wl = (float*)lds;
    const int tid = otid(), lane = tid & 63, wave = tid >> 6;
    if (AUX) {
        for (int i = tid; i < D * 8; i += NT) wl[i] = auxW[(size_t)(i >> 3) * auxld + (i & 7)];
        __syncthreads();
    }
    f32x4 gv[4];
    if (AUX || WR == 2) {
#pragma unroll
        for (int j = 0; j < 4; ++j) gv[j] = *(const f32x4*)(g + 4 * lane + 256 * j);
    }
    RawRow<1, ADDY> cur, nxt;
    const int rstep = gridDim.x * 8; int row = blockIdx.x * 8 + wave;
    if (IN == 1) { if (row < M) cur.load(xin, hb, y1, row, lane); nxt.copy_from(cur); }
    for (; row < M; row += rstep) {
        if (IN == 1) { if (row + rstep < M) nxt.load(xin, hb, y1, row + rstep, lane); }
        f32x4 v[4]; float ss = 0.f;
#pragma unroll
        for (int j = 0; j < 4; ++j) {
            if (IN == 0) v[j] = ((const f32x4*)(xin + (size_t)row * D) + lane)[64 * j];
            else { const u32x2 w = cur.h[j]; v[j] = (f32x4){bf2f(w.x & 0xffffu), __uint_as_float(w.x & 0xffff0000u), bf2f(w.y & 0xffffu), __uint_as_float(w.y & 0xffff0000u)}; }
            if (ADDY) { const u32x2 y = cur.y[j];
                v[j].x += bf2f(y.x & 0xffffu); v[j].y += __uint_as_float(y.x & 0xffff0000u); v[j].z += bf2f(y.y & 0xffffu); v[j].w += __uint_as_float(y.y & 0xffff0000u); }
            ss += (v[j].x * v[j].x + v[j].y * v[j].y) + (v[j].z * v[j].z + v[j].w * v[j].w); }
        if (IN == 1) cur.copy_from(nxt);
        float tot; { const int ri = __float_as_int(sum16(ss)); tot = (__int_as_float(__builtin_amdgcn_readlane(ri, 0)) + __int_as_float(__builtin_amdgcn_readlane(ri, 16))) + (__int_as_float(__builtin_amdgcn_readlane(ri, 32)) + __int_as_float(__builtin_amdgcn_readlane(ri, 48))); }
        const float rstd = __builtin_amdgcn_rsqf(tot * (1.f / D) + EPS);
        if (WR == 1) {
            u32x2* o = (u32x2*)(hb + (size_t)row * D) + lane;
#pragma unroll
            for (int j = 0; j < 4; ++j) { u32x2 w; w.x = pk2(v[j].x, v[j].y); w.y = pk2(v[j].z, v[j].w); o[64 * j] = w; }
            if (lane < 16) ssq[(size_t)row * 16 + lane] = lane == 0 ? tot : 0.f;
        }
        if (AUX || WR == 2) {
#pragma unroll
            for (int j = 0; j < 4; ++j) v[j] = v[j] * rstd * gv[j];
        }
        if (AUX == 2 && h8) {
#pragma unroll
            for (int j = 0; j < 4; ++j) ((unsigned*)(h8 + (size_t)row * D) + lane)[64 * j] = pk4_fp8(v[j].x, v[j].y, v[j].z, v[j].w);
        }
        if (WR == 2) {
            f32x4* o = (f32x4*)(fout + (size_t)row * D) + lane;
#pragma unroll
            for (int j = 0; j < 4; ++j) o[64 * j] = v[j];
        }
        if (AUX) {
            float acc[8];
#pragma unroll
            for (int c = 0; c < 8; ++c) acc[c] = 0.f;
#pragma unroll
            for (int j = 0; j < 4; ++j)
#pragma unroll
                for (int q = 0; q < 4; ++q) {
                    const int k = 4 * lane + 256 * j + q; const float xv = v[j][q];
                    const f32x4 w0 = *(const f32x4*)(wl + k * 8), w1 = *(const f32x4*)(wl + k * 8 + 4);
                    acc[0] += xv * w0.x; acc[1] += xv * w0.y; acc[2] += xv * w0.z; acc[3] += xv * w0.w;
                    acc[4] += xv * w1.x; acc[5] += xv * w1.y; acc[6] += xv * w1.z; acc[7] += xv * w1.w;
                }
#pragma unroll
            for (int c = 0; c < 8; ++c) { const float r16 = sum16(acc[c]); const int ri = __float_as_int(r16);
                acc[c] = (__int_as_float(__builtin_amdgcn_readlane(ri, 0)) + __int_as_float(__builtin_amdgcn_readlane(ri, 16))) + (__int_as_float(__builtin_amdgcn_readlane(ri, 32)) + __int_as_float(__builtin_amdgcn_readlane(ri, 48))); }
            if (AUX == 1) {
                if (lane < 8) { float s_ = acc[0];
#pragma unroll
                    for (int c = 1; c < 8; ++c) s_ = (lane == c) ? acc[c] : s_;
                    gates[(size_t)row * 8 + lane] = s_ + auxB[lane]; }
            } else {
                if (lane == 0) {
                    int e1 = 0; float v1 = acc[0];
#pragma unroll
                    for (int c = 1; c < 8; ++c) if (acc[c] > v1) { v1 = acc[c]; e1 = c; }
                    int e2 = -1; float v2 = -INFINITY;
#pragma unroll
                    for (int c = 0; c < 8; ++c) if (c != e1 && acc[c] > v2) { v2 = acc[c]; e2 = c; }
                    const float p2 = __expf(v2 - v1), inv = 1.f / (1.f + p2);
                    tok_p[row] = (unsigned char)(e1 | (e2 << 4)); tok_g[row * 2] = inv; tok_g[row * 2 + 1] = p2 * inv;
                }
            }
        }
    }
    __syncthreads();
}

struct Unit { int pm, pn; const int* rows; size_t bofs; };
struct GridOrder {
    static constexpr bool GATHER = false;
    int nM, nN, G, c;
    __device__ __forceinline__ bool next(int i, Unit& u) const {
        const int L0_ = i * G + c, nwg = nM * nN; if (L0_ >= nwg) return false;
        const int q_ = nwg / 8, r_ = nwg % 8, xcd = L0_ % 8, off = L0_ / 8; const int L = (xcd < r_ ? xcd * (q_ + 1) : r_ * (q_ + 1) + (xcd - r_) * q_) + off;
        const int grp = L / (8 * nN), fm = grp * 8, gsz = (nM - fm) < 8 ? (nM - fm) : 8, w = L % (8 * nN);
        u.pm = fm + w % gsz; u.pn = w / gsz; u.rows = nullptr; u.bofs = 0; return true;
    }
};
struct TailOrder {
    static constexpr bool GATHER = false;
    int nM, nN, G, c, first;
    __device__ __forceinline__ bool next(int i, Unit& u) const {
        if (c < first) return false; const int L = i * (G - first) + (c - first); if (L >= nM * nN) return false;
        u.pm = L / nN; u.pn = L % nN; u.rows = nullptr; u.bofs = 0; return true;
    }
};
template <bool GATHER_> struct MoeOrder {
    static constexpr bool GATHER = GATHER_;
    int nM, nN, G, c; const int* rows; size_t estride; int te[8];
    __device__ __forceinline__ void init(const int* tile_e) {
#pragma unroll
        for (int e = 0; e < 8; ++e) te[e] = __builtin_amdgcn_readfirstlane(tile_e[256 + e]);
    }
    __device__ __forceinline__ bool next(int i, Unit& u) const {
        const int L0_ = i * G + c, nwg = nM * nN; if (L0_ >= nwg) return false;
        const int q_ = nwg / 8, r_ = nwg % 8, xcd = L0_ % 8, off = L0_ / 8; const int L = (xcd < r_ ? xcd * (q_ + 1) : r_ * (q_ + 1) + (xcd - r_) * q_) + off;
        const int grp = L / (8 * nN), fm = grp * 8, gsz = (nM - fm) < 8 ? (nM - fm) : 8, w = L % (8 * nN);
        u.pm = fm + w % gsz; u.pn = w / gsz; u.rows = rows; int e = 0;
#pragma unroll
        for (int q = 0; q < 7; ++q) e += (u.pm >= te[q]) ? 1 : 0;
        u.bofs = (size_t)e * estride; return true;
    }
};


namespace pg8 {
#define PG8_LAS __attribute__((address_space(3)))
typedef short bf16x8 __attribute__((ext_vector_type(8)));
constexpr int BM = 256, BK = 64, HALF = 128, HTB = HALF * BK * 2, STAGE_BYTES = 8 * HTB;
__device__ __forceinline__ int lds_byte(int r, int c) { const int st = (r >> 4) * 2 + (c >> 5), rr = r & 15, cc = c & 31, ob = rr * 64 + cc * 2; return st * 1024 + (ob ^ (((ob >> 9) & 1) << 5)); }
__device__ __forceinline__ void stage_rc(int b, int& R, int& C) { const int st = b / 1024, sb = b % 1024, swz = sb ^ (((sb >> 9) & 1) << 5); R = (st >> 1) * 16 + swz / 64; C = (st & 1) * 32 + (swz % 64) / 2; }

typedef int i32x8 __attribute__((ext_vector_type(8))); typedef int i32x4 __attribute__((ext_vector_type(4)));
__device__ __forceinline__ i32x8 cat8(bf16x8 lo, bf16x8 hi) { return __builtin_shufflevector(__builtin_bit_cast(i32x4, lo), __builtin_bit_cast(i32x4, hi), 0, 1, 2, 3, 4, 5, 6, 7); }
__device__ __forceinline__ int perm32(int rho) { const int n = rho >> 4, i = rho & 15; return 8 * (i >> 2) + 4 * n + (i & 3); }
__device__ __forceinline__ void unit_voff(const Unit& u, const int (&R)[2], const int (&C)[2], int KB  , unsigned (&vo)[2][2]) {
#pragma unroll
    for (int h = 0; h < 2; ++h)
#pragma unroll
        for (int i = 0; i < 2; ++i) { int row = u.pm * BM + h * HALF + R[i]; if (u.rows) row = u.rows[row]; vo[h][i] = (unsigned)row * (unsigned)KB + (unsigned)C[i] * 2u; }
}

template <class Epi, class Sched, bool ALIGN_EPI, bool GATHER, bool FP8 = false>
__device__ __forceinline__ void gemm_phase(unsigned char* lds_, const bf16_t* A_, const bf16_t* Bt_, const int K_, const Sched& S, const Epi& E) {
    PG8_LAS unsigned char* lds = (PG8_LAS unsigned char*)lds_;
    const int K = oint(K_);
    const int tid = otid(), wid = __builtin_amdgcn_readfirstlane(tid >> 6), lane = tid & 63, wr = wid >> 2, wc = wid & 3, fr = lane & 15, fq = lane >> 4;
    const int KB = FP8 ? K : 2 * K;
    const int nt = KB / (BK * 2);
    int R[2], C[2]; unsigned voffA[2], voffB[2];
#pragma unroll
    for (int i = 0; i < 2; ++i) { stage_rc(tid * 16 + i * 8192, R[i], C[i]); voffA[i] = (unsigned)(R[i] * KB + C[i] * 2);
        const int Rb = Epi::PERM ? ((R[i] & ~31) + perm32(R[i] & 31)) : R[i]; voffB[i] = (unsigned)(Rb * KB + C[i] * 2); }
    const size_t kstep = (size_t)(BK * 2);
    const size_t hstep = (size_t)HALF * KB;
    const size_t tstep = 2 * hstep;
    const unsigned ldsw = (unsigned)wid * 1024u;
    const int pc0 = FP8 ? 32 * (fq >> 1) + 16 * (fq & 1) : fq * 8; constexpr int KOFF = FP8 ? 16 : 1024;
    const int aoff = lds_byte(wr * 64 + fr, pc0), boff = lds_byte(wc * 32 + fr, pc0);
#define PG8_SA(b, h) (((b) * 2 + (h)) * HTB)
#define PG8_SB(b, h) ((4 + (b) * 2 + (h)) * HTB)
#define PG8_STAGE(bufoff, gbase, voff) do { _Pragma("unroll") for (int _i = 0; _i < 2; ++_i) \
        __builtin_amdgcn_global_load_lds((const unsigned*)((const char*)(gbase) + (voff)[_i]), (PG8_LAS unsigned*)(lds + (bufoff) + ldsw + _i * 8192), 16, 0, 0); } while (0)
#define PG8_STAGE_A(bufoff, base, h, VO) do { if constexpr (GATHER) { PG8_STAGE(bufoff, base, (VO)[h]); } else { PG8_STAGE(bufoff, (base) + (h) * hstep, voffA); } } while (0)
#define PG8_LDA(dst, b, h) do { _Pragma("unroll") for (int m = 0; m < 4; ++m) _Pragma("unroll") for (int k = 0; k < 2; ++k) dst[m][k] = *(const PG8_LAS bf16x8*)(lds + PG8_SA(b, h) + aoff + m * 2048 + k * KOFF); } while (0)
#define PG8_LDB(dst, b, h) do { _Pragma("unroll") for (int n = 0; n < 2; ++n) _Pragma("unroll") for (int k = 0; k < 2; ++k) dst[n][k] = *(const PG8_LAS bf16x8*)(lds + PG8_SB(b, h) + boff + n * 2048 + k * KOFF); } while (0)
#define PG8_MMA(ai, bj, At, Bt) do { __builtin_amdgcn_s_setprio(1); _Pragma("unroll") for (int m = 0; m < 4; ++m) _Pragma("unroll") for (int n = 0; n < 2; ++n) { \
        if constexpr (FP8) { const i32x8 b8_ = cat8(Bt[n][0], Bt[n][1]), a8_ = cat8(At[m][0], At[m][1]); \
            asm volatile("v_mfma_scale_f32_16x16x128_f8f6f4 %0, %1, %2, %0, %3, %3 op_sel_hi:[0,0,0]" : "+v"(acc[ai][bj][m][n]) : "v"(b8_), "v"(a8_), "v"(scale1)); } \
        else { _Pragma("unroll") for (int k = 0; k < 2; ++k) acc[ai][bj][m][n] = __builtin_amdgcn_mfma_f32_16x16x32_bf16(Bt[n][k], At[m][k], acc[ai][bj][m][n], 0, 0, 0); } } __builtin_amdgcn_s_setprio(0); } while (0)
#define PG8_WAIT_V(n) asm volatile("s_waitcnt vmcnt(" #n ")" ::: "memory")
#define PG8_WAIT_L(n) asm volatile("s_waitcnt lgkmcnt(" #n ")" ::: "memory")
#define PG8_BAR __builtin_amdgcn_s_barrier()
#define PG8_SCHED __builtin_amdgcn_sched_barrier(0)
    const int scale1 = 0x7f7f7f7f;
    Unit cur, nxt; int ui = 0;
    if (!S.next(0, cur)) return;
    f32x4 acc[2][2][4][2];
#pragma unroll
    for (int a = 0; a < 2; ++a)
#pragma unroll
        for (int b = 0; b < 2; ++b)
#pragma unroll
            for (int m = 0; m < 4; ++m)
#pragma unroll
                for (int n = 0; n < 2; ++n) acc[a][b][m][n] = (f32x4){0.f, 0.f, 0.f, 0.f};
    bf16x8 At[4][2], B0[2][2], B1[2][2];
    unsigned vc[2][2], vn[2][2];
    if constexpr (GATHER) unit_voff(cur, R, C, KB, vc);
    const char* cA = GATHER ? (const char*)A_ : (const char*)A_ + (size_t)cur.pm * tstep;
    const char* cB = (const char*)Bt_ + cur.bofs * (FP8 ? 1 : 2) + (size_t)cur.pn * tstep;
    PG8_STAGE(PG8_SB(0, 0), cB, voffB); PG8_STAGE(PG8_SB(0, 1), cB + hstep, voffB); PG8_STAGE_A(PG8_SA(0, 0), cA, 0, vc); PG8_STAGE_A(PG8_SA(0, 1), cA, 1, vc);
    if (wr == 1) PG8_BAR;
    PG8_WAIT_V(2); PG8_BAR;
    PG8_STAGE(PG8_SB(1, 0), cB + kstep, voffB); PG8_STAGE_A(PG8_SA(1, 0), cA + kstep, 0, vc); PG8_STAGE(PG8_SB(1, 1), cB + hstep + kstep, voffB);
    PG8_WAIT_V(6); PG8_BAR;
    for (;;) {
        const bool has_next = S.next(ui + 1, nxt);
        const char* nA = cA; const char* nB = cB;
        if (has_next) { nB = (const char*)Bt_ + nxt.bofs * (FP8 ? 1 : 2) + (size_t)nxt.pn * tstep; if constexpr (!GATHER) nA = (const char*)A_ + (size_t)nxt.pm * tstep; }
        int rn[2][2];
        if constexpr (GATHER) {
#pragma unroll
            for (int h = 0; h < 2; ++h)
#pragma unroll
                for (int i = 0; i < 2; ++i) rn[h][i] = cur.rows[(has_next ? nxt.pm : cur.pm) * BM + h * HALF + R[i]]; }
        for (int t = 0; t < nt; t += 2) {
            const bool last = (t == nt - 2);
            if constexpr (GATHER) { if (last) {
#pragma unroll
                for (int h = 0; h < 2; ++h)
#pragma unroll
                    for (int i = 0; i < 2; ++i) { int r_ = rn[h][i]; asm volatile("" : "+v"(r_));
                        vn[h][i] = (unsigned)r_ * (unsigned)KB + (unsigned)C[i] * 2u; } } }
            const char* a1 = cA + (size_t)(t + 1) * kstep;
            const char* a2 = last ? nA : cA + (size_t)(t + 2) * kstep; const char* b2 = last ? nB : cB + (size_t)(t + 2) * kstep;
            const char* a3 = a2 + kstep; const char* b3 = b2 + kstep;
            unsigned v2[2][2];
            if constexpr (GATHER) {
#pragma unroll
                for (int h = 0; h < 2; ++h)
#pragma unroll
                    for (int i = 0; i < 2; ++i) v2[h][i] = last ? vn[h][i] : vc[h][i]; }
            PG8_LDB(B0, 0, 0); PG8_LDB(B1, 0, 1); PG8_SCHED; PG8_LDA(At, 0, 0); PG8_STAGE_A(PG8_SA(1, 1), a1, 1, vc);
            PG8_WAIT_V(8); PG8_WAIT_L(0); PG8_BAR; PG8_MMA(0, 0, At, B0); PG8_MMA(0, 1, At, B1); PG8_BAR; PG8_SCHED;
            PG8_LDA(At, 0, 1); PG8_STAGE(PG8_SB(0, 0), b2, voffB); PG8_STAGE(PG8_SB(0, 1), b2 + hstep, voffB); PG8_STAGE_A(PG8_SA(0, 0), a2, 0, v2);
            PG8_WAIT_V(8); PG8_WAIT_L(0); PG8_BAR; PG8_MMA(1, 0, At, B0); PG8_MMA(1, 1, At, B1); PG8_BAR; PG8_SCHED;
            PG8_LDB(B0, 1, 0); PG8_LDB(B1, 1, 1); PG8_SCHED; PG8_LDA(At, 1, 0); PG8_STAGE_A(PG8_SA(0, 1), a2, 1, v2);
            PG8_WAIT_V(8); PG8_WAIT_L(0); PG8_BAR; PG8_MMA(0, 0, At, B0); PG8_MMA(0, 1, At, B1); PG8_BAR; PG8_SCHED;
            PG8_LDA(At, 1, 1); PG8_STAGE(PG8_SB(1, 0), b3, voffB); PG8_STAGE(PG8_SB(1, 1), b3 + hstep, voffB); PG8_STAGE_A(PG8_SA(1, 0), a3, 0, v2);
            PG8_WAIT_V(8); PG8_WAIT_L(0); PG8_BAR; PG8_MMA(1, 0, At, B0); PG8_MMA(1, 1, At, B1); PG8_BAR; PG8_SCHED;
        }
        if constexpr (ALIGN_EPI) { if (wr == 0) PG8_BAR; }
        { int pm_ = cur.pm, pn_ = cur.pn, fr_ = fr, fq_ = fq;
          asm volatile("" : "+s"(pm_), "+s"(pn_), "+v"(fr_), "+v"(fq_));
          E(acc, pm_, pn_, wr, wc, fr_, fq_); }
        if (!has_next) break;
#pragma unroll
        for (int a = 0; a < 2; ++a)
#pragma unroll
            for (int b = 0; b < 2; ++b)
#pragma unroll
                for (int m = 0; m < 4; ++m)
#pragma unroll
                    for (int n = 0; n < 2; ++n) acc[a][b][m][n] = (f32x4){0.f, 0.f, 0.f, 0.f};
        cur = nxt; cA = nA; cB = nB; ++ui;
        if constexpr (GATHER) {
#pragma unroll
            for (int h = 0; h < 2; ++h)
#pragma unroll
                for (int i = 0; i < 2; ++i) vc[h][i] = vn[h][i]; }
        if constexpr (ALIGN_EPI) { if (wr == 1) PG8_BAR; }
    }
    PG8_WAIT_V(0);
    if constexpr (!ALIGN_EPI) { if (wr == 0) PG8_BAR; }
    PG8_BAR;
#undef PG8_SA
#undef PG8_SB
#undef PG8_STAGE
#undef PG8_STAGE_A
#undef PG8_LDA
#undef PG8_LDB
#undef PG8_MMA
#undef PG8_WAIT_V
#undef PG8_WAIT_L
#undef PG8_BAR
#undef PG8_SCHED
}
}
template <bool FP8 = false, class Epi, class Sched>
__device__ __forceinline__ void gemm_fast(unsigned char* lds, const bf16_t* A, const bf16_t* Bt, int K, const Sched& S, const Epi& E) {
    pg8::gemm_phase<Epi, Sched, true, Sched::GATHER, FP8>(lds, A, Bt, K, S, E);
    __syncthreads();
}

typedef f32x4 AccT[2][2][4][2];
#define EPI_ROW(ai, m) (pm * 256 + (ai) * 128 + wr * 64 + (m) * 16 + fr)
__device__ __forceinline__ void unpack8(const u32x4 w, f32x4& lo, f32x4& hi) {
    lo = (f32x4){bf2f(w.x & 0xffffu), __uint_as_float(w.x & 0xffff0000u), bf2f(w.y & 0xffffu), __uint_as_float(w.y & 0xffff0000u)};
    hi = (f32x4){bf2f(w.z & 0xffffu), __uint_as_float(w.z & 0xffff0000u), bf2f(w.w & 0xffffu), __uint_as_float(w.w & 0xffff0000u)};
}
__device__ __forceinline__ u32x4 pack8(const f32x4 v0, const f32x4 v1) { u32x4 w; w.x = pk2(v0.x, v0.y); w.y = pk2(v0.z, v0.w); w.z = pk2(v1.x, v1.y); w.w = pk2(v1.z, v1.w); return w; }
__device__ __forceinline__ float dot8(const f32x4 a, const f32x4 b) { return ((a.x * a.x + a.y * a.y) + (a.z * a.z + a.w * a.w)) + ((b.x * b.x + b.y * b.y) + (b.z * b.z + b.w * b.w)); }
__device__ __forceinline__ void epi_rstd(const float* ssq, const int* rowmap, int pm, int wr, int fr, int fq, float (&rs)[2][4]) {
    f32x4 p[2][4];
#pragma unroll
    for (int ai = 0; ai < 2; ++ai)
#pragma unroll
        for (int m = 0; m < 4; ++m) { int row = EPI_ROW(ai, m); if (rowmap) row = rowmap[row]; p[ai][m] = *(const f32x4*)((const char*)ssq + ((unsigned)row * 16u + 4u * (unsigned)fq) * 4u); }
#pragma unroll
    for (int ai = 0; ai < 2; ++ai)
#pragma unroll
        for (int m = 0; m < 4; ++m) { float t = (p[ai][m].x + p[ai][m].y) + (p[ai][m].z + p[ai][m].w); t += __shfl_xor(t, 16); t += __shfl_xor(t, 32); rs[ai][m] = __builtin_amdgcn_rsqf(t * (1.f / 1024.f) + EPS); }
}
__device__ __forceinline__ void epi_ssq(float* ssq, int row, int slot, float s_, int fq) { s_ += __shfl_xor(s_, 16); s_ += __shfl_xor(s_, 32); if (fq == 0) *(float*)((char*)ssq + ((unsigned)row * 16u + (unsigned)slot) * 4u) = s_; }

struct EpiZ { static constexpr bool PERM = true; bf16_t* z; const float* bin; const float* ssq;
    __device__ __forceinline__ void operator()(const AccT& acc, int pm, int pn, int wr, int wc, int fr, int fq) const {
        const int c0 = pn * 256 + wc * 32 + 8 * fq; f32x4 bv[2][2]; float rs[2][4];
#pragma unroll
        for (int bj = 0; bj < 2; ++bj)
#pragma unroll
            for (int n = 0; n < 2; ++n) { const int cc = c0 + bj * 128 + n * 4; bv[bj][n] = *(const f32x4*)(bin + (cc < 2048 ? cc : cc + 8)); }
        epi_rstd(ssq, nullptr, pm, wr, fr, fq, rs);
#pragma unroll
        for (int ai = 0; ai < 2; ++ai)
#pragma unroll
            for (int m = 0; m < 4; ++m) { bf16_t* rp = z + (size_t)EPI_ROW(ai, m) * ZW + c0; const float r = rs[ai][m];
#pragma unroll
                for (int bj = 0; bj < 2; ++bj) *(u32x4*)(rp + bj * 128) = pack8(acc[ai][bj][m][0] * r + bv[bj][0], acc[ai][bj][m][1] * r + bv[bj][1]); } } };
template <bool XB> struct EpiHres { static constexpr bool PERM = true; const float* xb; bf16_t* hb; float* ssq;
    __device__ __forceinline__ void operator()(const AccT& acc, int pm, int pn, int wr, int wc, int fr, int fq) const {
        const int c0 = pn * 256 + wc * 32 + 8 * fq;
#pragma unroll
        for (int ai = 0; ai < 2; ++ai) {
            f32x4 lx[4][2][2]; u32x4 lh[4][2];
#pragma unroll
            for (int m = 0; m < 4; ++m)
#pragma unroll
                for (int bj = 0; bj < 2; ++bj) { const size_t o = (size_t)EPI_ROW(ai, m) * D + c0 + bj * 128;
                    if (XB) { lx[m][bj][0] = *(const f32x4*)(xb + o); lx[m][bj][1] = *(const f32x4*)(xb + o + 4); } else lh[m][bj] = *(const u32x4*)(hb + o); }
#pragma unroll
            for (int m = 0; m < 4; ++m) { float s_ = 0.f; const int row = EPI_ROW(ai, m);
#pragma unroll
                for (int bj = 0; bj < 2; ++bj) { f32x4 b0, b1; if (XB) { b0 = lx[m][bj][0]; b1 = lx[m][bj][1]; } else unpack8(lh[m][bj], b0, b1);
                    const f32x4 v0 = b0 + acc[ai][bj][m][0], v1 = b1 + acc[ai][bj][m][1]; s_ += dot8(v0, v1);
                    *(u32x4*)(hb + (size_t)row * D + c0 + bj * 128) = pack8(v0, v1); }
                epi_ssq(ssq, row, pn * 4 + wc, s_, fq); }
        } } };
struct EpiSwiglu { static constexpr bool PERM = true; bf16_t* hid; const float* ssq; const int* rowmap;
    __device__ __forceinline__ void operator()(const AccT& acc, int pm, int pn, int wr, int wc, int fr, int fq) const {
        const int c0 = pn * 128 + wc * 32 + 8 * fq; float rs[2][4];
        epi_rstd(ssq, rowmap, pm, wr, fr, fq, rs);
#pragma unroll
        for (int ai = 0; ai < 2; ++ai)
#pragma unroll
            for (int m = 0; m < 4; ++m) { u32x4 w; const float r = rs[ai][m];
#pragma unroll
                for (int n = 0; n < 2; ++n) { const f32x4 g = acc[ai][0][m][n] * r, u = acc[ai][1][m][n] * r;
                    w[2 * n] = pk2(siluf_(g.x) * u.x, siluf_(g.y) * u.y); w[2 * n + 1] = pk2(siluf_(g.z) * u.z, siluf_(g.w) * u.w); }
                *(u32x4*)(hid + (size_t)EPI_ROW(ai, m) * DFF + c0) = w; } } };
struct EpiSwiglu8 { static constexpr bool PERM = true; unsigned char* hid8; float sc;
    __device__ __forceinline__ void operator()(const AccT& acc, int pm, int pn, int wr, int wc, int fr, int fq) const {
        const int c0 = pn * 128 + wc * 32 + 8 * fq;
#pragma unroll
        for (int ai = 0; ai < 2; ++ai)
#pragma unroll
            for (int m = 0; m < 4; ++m) { u32x2 w;
#pragma unroll
                for (int n = 0; n < 2; ++n) { const f32x4 g = acc[ai][0][m][n] * sc, u = acc[ai][1][m][n] * sc;
                    w[n] = pk4_fp8(siluf_(g.x) * u.x, siluf_(g.y) * u.y, siluf_(g.z) * u.z, siluf_(g.w) * u.w); }
                *(u32x2*)(hid8 + (size_t)EPI_ROW(ai, m) * DFF + c0) = w; } } };
struct EpiMoeDown { static constexpr bool PERM = true; bf16_t* hb; bf16_t* y1; const int* row_tok; const int* row_slot; const float* row_gate; float sc;
    __device__ __forceinline__ void operator()(const AccT& acc, int pm, int pn, int wr, int wc, int fr, int fq) const {
        const int c0 = pn * 256 + wc * 32 + 8 * fq;
        int tok[2][4], slot[2][4]; float gt[2][4];
#pragma unroll
        for (int ai = 0; ai < 2; ++ai)
#pragma unroll
            for (int m = 0; m < 4; ++m) { const int row = EPI_ROW(ai, m); tok[ai][m] = row_tok[row]; slot[ai][m] = row_slot[row]; gt[ai][m] = row_gate[row] * sc; }
#pragma unroll
        for (int ai = 0; ai < 2; ++ai) {
            u32x4 lh[4][2];
#pragma unroll
            for (int m = 0; m < 4; ++m) { const bool rmw = tok[ai][m] < M && slot[ai][m] == 0;
#pragma unroll
                for (int bj = 0; bj < 2; ++bj) lh[m][bj] = rmw ? *(const u32x4*)(hb + (size_t)tok[ai][m] * D + c0 + bj * 128) : (u32x4){0u, 0u, 0u, 0u}; }
#pragma unroll
            for (int m = 0; m < 4; ++m) { if (tok[ai][m] >= M) continue; const size_t o = (size_t)tok[ai][m] * D + c0; const float g = gt[ai][m];
                if (slot[ai][m] == 0) {
#pragma unroll
                    for (int bj = 0; bj < 2; ++bj) { f32x4 b0, b1; unpack8(lh[m][bj], b0, b1); *(u32x4*)(hb + o + bj * 128) = pack8(b0 + g * acc[ai][bj][m][0], b1 + g * acc[ai][bj][m][1]); }
                } else {
#pragma unroll
                    for (int bj = 0; bj < 2; ++bj) *(u32x4*)(y1 + o + bj * 128) = pack8(g * acc[ai][bj][m][0], g * acc[ai][bj][m][1]);
                } }
        } } };
struct EpiStoreBf16 { static constexpr bool PERM = true; bf16_t* out;
    __device__ __forceinline__ void operator()(const AccT& acc, int pm, int pn, int wr, int wc, int fr, int fq) const {
        const int c0 = pn * 256 + wc * 32 + 8 * fq;
#pragma unroll
        for (int ai = 0; ai < 2; ++ai)
#pragma unroll
            for (int m = 0; m < 4; ++m)
#pragma unroll
                for (int bj = 0; bj < 2; ++bj) *(u32x4*)(out + (size_t)EPI_ROW(ai, m) * D + c0 + bj * 128) = pack8(acc[ai][bj][m][0], acc[ai][bj][m][1]); } };
struct EpiPle { static constexpr bool PERM = true; const bf16_t* hin; bf16_t* hb; const bf16_t* pp; float* ssq; const float* ssq_in;
    __device__ __forceinline__ void operator()(const AccT& acc, int pm, int pn, int wr, int wc, int fr, int fq) const {
        const int c0 = pn * 256 + wc * 32 + 8 * fq; float rs[2][4];
        epi_rstd(ssq_in, nullptr, pm, wr, fr, fq, rs);
        u32x4 sg[2][4][2];
#pragma unroll
        for (int ai = 0; ai < 2; ++ai)
#pragma unroll
            for (int m = 0; m < 4; ++m)
#pragma unroll
                for (int bj = 0; bj < 2; ++bj) { f32x4 a0 = acc[ai][bj][m][0] * rs[ai][m], a1 = acc[ai][bj][m][1] * rs[ai][m];
#pragma unroll
                    for (int q = 0; q < 4; ++q) { a0[q] = sigmoidf_(a0[q]); a1[q] = sigmoidf_(a1[q]); }
                    sg[ai][m][bj] = pack8(a0, a1); }
        asm volatile("" ::: "memory");
#pragma unroll
        for (int ai = 0; ai < 2; ++ai) {
            u32x4 lh[4][2], lp[4][2];
#pragma unroll
            for (int m = 0; m < 4; ++m)
#pragma unroll
                for (int bj = 0; bj < 2; ++bj) { const unsigned ob = ((unsigned)EPI_ROW(ai, m) * D + c0 + bj * 128) * 2u;
                    lh[m][bj] = *(const u32x4*)((const char*)hin + ob); lp[m][bj] = *(const u32x4*)((const char*)pp + ob); }
#pragma unroll
            for (int m = 0; m < 4; ++m) { float s_ = 0.f; const int row = EPI_ROW(ai, m);
#pragma unroll
                for (int bj = 0; bj < 2; ++bj) { f32x4 h0, h1, p0, p1, g0, g1; unpack8(lh[m][bj], h0, h1); unpack8(lp[m][bj], p0, p1); unpack8(sg[ai][m][bj], g0, g1);
                    h0 += g0 * p0; h1 += g1 * p1; s_ += dot8(h0, h1);
                    *(u32x4*)((char*)hb + ((unsigned)row * D + c0 + bj * 128) * 2u) = pack8(h0, h1); }
                epi_ssq(ssq, row, pn * 4 + wc, s_, fq); }
        } } };

__device__ __forceinline__ float conv4(const bf16_t* zc, int row, int s, const float* w  , int wstride, float b) {
    float acc = b;
#pragma unroll
    for (int j = 0; j < 4; ++j) { const int ds = 3 - j; if (s - ds >= 0) acc += w[j * wstride] * bf2f(zc[(ptrdiff_t)(row - ds) * ZW]); }
    return acc;
}
__device__ __forceinline__ void chunk_gates(float* sc, const float* gates, int row0, int h, int lane) {
    const float ip = gates[(size_t)(row0 + lane) * 8 + h], fp = gates[(size_t)(row0 + lane) * 8 + 4 + h];
    float b = logsigmoidf_(fp);
#pragma unroll
    for (int o = 1; o < 64; o <<= 1) { const float n = __shfl_up(b, o); if (lane >= o) b += n; }
    sc[lane] = b; sc[64 + lane] = ip;
}
__device__ __forceinline__ void chunk_gates_r(float* sc, float ip, float fp, int lane) {
    float b = logsigmoidf_(fp);
#pragma unroll
    for (int o = 1; o < 64; o <<= 1) { const float n = __shfl_up(b, o); if (lane >= o) b += n; }
    sc[lane] = b; sc[64 + lane] = ip;
}
__device__ __forceinline__ void mlstm_local(const Args& a, unsigned char* lds, int l, int item) {
    const int b = item >> 8, c = (item >> 2) & 63, h = item & 3, row0 = b * SEQ + c * CH, tid = otid(), lane = tid & 63;
    float* Kt = (float*)lds;
    float* Vt = Kt + 64 * 128;
    float* sc = Vt + 64 * 128;
    const bf16_t* z = (const bf16_t*)(a.ws + WS_Z);
    const float* gates = (const float*)(a.ws + WS_SMALL + SM_GATES);
    if (tid < 64) {
        chunk_gates(sc, gates, row0, h, lane);
        const float bl = __shfl(sc[lane], 63), al = bl - sc[lane] + sc[64 + lane];
        const float amax = wave_max(al);
        sc[128 + lane] = __expf(al - amax);
        if (lane == 0) { ((float*)(a.ws + WS_SMALL + SM_BL))[item] = bl; ((float*)(a.ws + WS_SMALL + SM_AMAX))[item] = amax; }
    }
    const float* wc = a.in[I_WCQK] + (size_t)l * 4 * 1024; const float* bc = a.in[I_BCQK] + (size_t)l * 1024;
    for (int i = tid; i < 64 * 128; i += NT) {
        const int ll = i >> 7, d = i & 127, ch = ZK + h * DH + d;
        Kt[i] = siluf_(conv4(z + ch, row0 + ll, c * CH + ll, wc + ch, 1024, bc[ch]));
        Vt[i] = bf2f(z[(size_t)(row0 + ll) * ZW + ZV + h * DH + d]);
    }
    __syncthreads();
    const int d = tid & 127, eg = tid >> 7;
    float acc[33];
#pragma unroll
    for (int i = 0; i < 33; ++i) acc[i] = 0.f;
    for (int ll = 0; ll < 64; ++ll) {
        const float kd = Kt[ll * 128 + d] * sc[128 + ll];
#pragma unroll
        for (int i = 0; i < 32; ++i) acc[i] += Vt[ll * 128 + eg + 4 * i] * kd;
        acc[32] += kd;
    }
    float* ct = (float*)(a.ws + WS_CT) + (size_t)item * EROWS * 128;
#pragma unroll
    for (int i = 0; i < 32; ++i) ct[(eg + 4 * i) * 128 + d] = acc[i];
    if (eg == 0) ct[128 * 128 + d] = acc[32];
    __syncthreads();
}
__device__ __forceinline__ void mlstm_scan(const Args& a, int G) {
    const float* BL = (const float*)(a.ws + WS_SMALL + SM_BL); const float* AM = (const float*)(a.ws + WS_SMALL + SM_AMAX);
    float* MP = (float*)(a.ws + WS_SMALL + SM_MPREV);
    const int tid = otid();
    for (int w = blockIdx.x; w < 16 * 16; w += G) {
        const int bh = w >> 4, sl = w & 15, b = bh >> 2, h = bh & 3;
        unsigned* p = (unsigned*)(a.ws + WS_CT) + (size_t)((b * NC) * NH + h) * 8192 + sl * 512 + tid;
        float s0 = 0.f, s1 = 0.f, m = 0.f;
#pragma unroll 1
        for (int c0 = 0; c0 < NC; c0 += 16) {
            unsigned x[16];
#pragma unroll
            for (int j = 0; j < 16; ++j) x[j] = p[(size_t)(c0 + j) * (NH * 8192)];
#pragma unroll
            for (int j = 0; j < 16; ++j) {
                const int item = (b * NC + c0 + j) * NH + h;
                const float bl = BL[item], am = AM[item];
                const float mn = fmaxf(bl + m, am), dec = __expf(bl + m - mn), scl = __expf(am - mn);
                p[(size_t)(c0 + j) * (NH * 8192)] = pk2(s0, s1);
                if (sl == 0 && tid == 0) MP[item] = m;
                s0 = dec * s0 + scl * bf2f(x[j] & 0xffffu); s1 = dec * s1 + scl * __uint_as_float(x[j] & 0xffff0000u); m = mn;
            }
        }
        if (sl == 1 && tid < 128) {
            float* q = (float*)(a.ws + WS_DN) + (size_t)((b * NC) * NH + h) * 128 + tid;
            float sn = 0.f; m = 0.f;
#pragma unroll 1
            for (int c0 = 0; c0 < NC; c0 += 16) {
                float x[16];
#pragma unroll
                for (int j = 0; j < 16; ++j) x[j] = q[(size_t)(c0 + j) * (NH * 128)];
#pragma unroll
                for (int j = 0; j < 16; ++j) {
                    const int item = (b * NC + c0 + j) * NH + h;
                    const float bl = BL[item], am = AM[item];
                    const float mn = fmaxf(bl + m, am), dec = __expf(bl + m - mn), scl = __expf(am - mn);
                    q[(size_t)(c0 + j) * (NH * 128)] = sn;
                    sn = dec * sn + scl * x[j]; m = mn;
                }
            }
        }
    }
}
__device__ __forceinline__ void mlstm_out(const Args& a, unsigned char* lds, int l, int item) {
    const int b = item >> 8, c = (item >> 2) & 63, h = item & 3, row0 = b * SEQ + c * CH, tid = otid(), lane = tid & 63, wave = tid >> 6;
    float* Q = (float*)lds;
    float* Kt = Q + 64 * 128;
    float* Vt = Kt + 64 * 128;
    float* Sm = Vt + 64 * 128;
    float* sc = Sm + 64 * 64;
    const bf16_t* z = (const bf16_t*)(a.ws + WS_Z);
    const float* gates = (const float*)(a.ws + WS_SMALL + SM_GATES);
    const float mprev = ((const float*)(a.ws + WS_SMALL + SM_MPREV))[item];
    if (tid < 64) {
        chunk_gates(sc, gates, row0, h, lane);
        float g = sc[64 + lane] - sc[lane];
#pragma unroll
        for (int o = 1; o < 64; o <<= 1) { const float n = __shfl_up(g, o); if (lane >= o) g = fmaxf(g, n); }
        const float mrow = sc[lane] + fmaxf(mprev, g);
        sc[128 + lane] = mrow; sc[192 + lane] = __expf(sc[lane] + mprev - mrow);
    }
    const float* wc = a.in[I_WCQK] + (size_t)l * 4 * 1024; const float* bc = a.in[I_BCQK] + (size_t)l * 1024;
    for (int i = tid; i < 64 * 128; i += NT) {
        const int ll = i >> 7, d = i & 127, chq = ZQ + h * DH + d, chk = ZK + h * DH + d;
        Q[i] = siluf_(conv4(z + chq, row0 + ll, c * CH + ll, wc + chq, 1024, bc[chq])) * 0.08838834764831845f;
        Kt[i] = siluf_(conv4(z + chk, row0 + ll, c * CH + ll, wc + chk, 1024, bc[chk]));
        Vt[i] = bf2f(z[(size_t)(row0 + ll) * ZW + ZV + h * DH + d]);
    }
    __syncthreads();
    for (int i = tid; i < 64 * 64; i += NT) {
        const int ll = i >> 6, mm = i & 63; float s = 0.f;
        if (mm <= ll) {
            for (int d = 0; d < 128; ++d) s += Q[ll * 128 + d] * Kt[mm * 128 + d];
            s *= __expf(sc[ll] - sc[mm] + sc[64 + mm] - sc[128 + ll]);
        }
        Sm[i] = s;
    }
    __syncthreads();
    const float* ct = (const float*)(a.ws + WS_CT) + (size_t)item * EROWS * 128;
    if (tid < 64) {
        float di = 0.f, dn = 0.f;
        for (int mm = 0; mm < 64; ++mm) di += Sm[tid * 64 + mm];
        for (int d = 0; d < 128; ++d) dn += Q[tid * 128 + d] * ct[128 * 128 + d];
        const float den = di + sc[192 + tid] * dn;
        sc[256 + tid] = fmaxf(fabsf(den), __expf(-sc[128 + tid]));
    }
    const int e = tid & 127, lg = tid >> 7;
    float acc[16], acc2[16];
#pragma unroll
    for (int i = 0; i < 16; ++i) { acc[i] = 0.f; acc2[i] = 0.f; }
    for (int mm = 0; mm < 64; ++mm) { const float vv = Vt[mm * 128 + e];
#pragma unroll
        for (int i = 0; i < 16; ++i) acc[i] += Sm[(lg * 16 + i) * 64 + mm] * vv; }
    for (int d = 0; d < 128; ++d) { const float cv = ct[e * 128 + d];
#pragma unroll
        for (int i = 0; i < 16; ++i) acc2[i] += Q[(lg * 16 + i) * 128 + d] * cv; }
    __syncthreads();
#pragma unroll
    for (int i = 0; i < 16; ++i) { const int ll = lg * 16 + i;
        const float hv = (acc[i] + sc[192 + ll] * acc2[i]) / sc[256 + ll];
        const float o = sigmoidf_(bf2f(z[(size_t)(row0 + ll) * ZW + ZO + h * DH + e]));
        Kt[ll * 128 + e] = hv * o; }
    __syncthreads();
    const float* gm = a.in[I_GMH] + (size_t)l * DM + h * DH;
    bf16_t* mix = (bf16_t*)(a.ws + WS_MIX);
    for (int ll = wave * 8; ll < wave * 8 + 8; ++ll) {
        const float x0 = Kt[ll * 128 + 2 * lane], x1 = Kt[ll * 128 + 2 * lane + 1];
        const float rs = rsqrtf(wave_sum(x0 * x0 + x1 * x1) * (1.f / 128.f) + EPS);
        *(unsigned*)(mix + (size_t)(row0 + ll) * D + h * DH + 2 * lane) = pk2(x0 * rs * gm[2 * lane], x1 * rs * gm[2 * lane + 1]);
    }
    __syncthreads();
}


typedef short bf16x8 __attribute__((ext_vector_type(8)));
__device__ __forceinline__ f32x4 mfma16(bf16x8 a, bf16x8 b, f32x4 c) { return __builtin_amdgcn_mfma_f32_16x16x32_bf16(a, b, c, 0, 0, 0); }

__device__ __forceinline__ void conv_load11(const bf16_t* zc, int row0, int l0, bool first_chunk, unsigned (&x)[11]) {
#pragma unroll
    for (int j = 0; j < 11; ++j) { const int ll = l0 - 3 + j; x[j] = (first_chunk && ll < 0) ? 0u : *(const unsigned*)(zc + (ptrdiff_t)(row0 + ll) * ZW); }
}
struct ConvW { float w[4][2]; float b[2]; };
__device__ __forceinline__ void conv_loadw(const float* wc, const float* bc, int col, ConvW& cw) {
#pragma unroll
    for (int j = 0; j < 4; ++j) { cw.w[j][0] = wc[j * 1024 + col]; cw.w[j][1] = wc[j * 1024 + col + 1]; }
    cw.b[0] = bc[col]; cw.b[1] = bc[col + 1];
}
__device__ __forceinline__ void conv_apply(const unsigned (&x)[11], const ConvW& cw, float (&out)[8][2]) {
#pragma unroll
    for (int i = 0; i < 8; ++i) { float a0 = cw.b[0], a1 = cw.b[1];
#pragma unroll
        for (int j = 0; j < 4; ++j) { a0 += cw.w[j][0] * bf2f(x[i + j] & 0xffffu); a1 += cw.w[j][1] * __uint_as_float(x[i + j] & 0xffff0000u); }
        out[i][0] = a0; out[i][1] = a1; }
}
struct MlRegs { unsigned xk[11], v[8]; ConvW cw; float gi, gf; };
__device__ __forceinline__ void ml_load(const Args& a, int l, int item, MlRegs& R) {
    const int b = item >> 8, c = (item >> 2) & 63, h = item & 3, row0 = b * SEQ + c * CH, tid = otid(), lane = tid & 63, wave = tid >> 6;
    const bf16_t* z = (const bf16_t*)(a.ws + WS_Z);
    const float* gates = (const float*)(a.ws + WS_SMALL + SM_GATES);
    const int cp = lane, lg = wave, colk = ZK + h * DH + 2 * cp, colv = ZV + h * DH + 2 * cp;
    conv_load11(z + colk, row0, 8 * lg, c == 0, R.xk);
#pragma unroll
    for (int i = 0; i < 8; ++i) R.v[i] = *(const unsigned*)(z + (size_t)(row0 + 8 * lg + i) * ZW + colv);
    conv_loadw(a.in[I_WCQK] + (size_t)l * 4 * 1024, a.in[I_BCQK] + (size_t)l * 1024, colk, R.cw);
    R.gi = gates[(size_t)(row0 + lane) * 8 + h]; R.gf = gates[(size_t)(row0 + lane) * 8 + 4 + h];
}
__device__ __forceinline__ void ml_compute(const Args& a, unsigned char* lds, int l, int item, MlRegs& R) {
    const int tid = otid(), lane = tid & 63, wave = tid >> 6, fr = lane & 15, fq = lane >> 4;
    unsigned char* KT = lds; unsigned char* VT = lds + 18432; float* RED = (float*)(lds + 36864); float* sc = (float*)(lds + 40960);
    const int cp = lane, lg = wave;
    unsigned (&xk)[11] = R.xk; unsigned (&v)[8] = R.v; ConvW& cw = R.cw;
    if (tid < 64) {
        chunk_gates_r(sc, R.gi, R.gf, lane);
        const float bl = __shfl(sc[lane], 63), al = bl - sc[lane] + sc[64 + lane];
        const float amax = wave_max(al);
        sc[128 + lane] = __expf(al - amax);
        if (lane == 0) { ((float*)(a.ws + WS_SMALL + SM_BL))[item] = bl; ((float*)(a.ws + WS_SMALL + SM_AMAX))[item] = amax; }
    }
    LDS_BARRIER();
    {
        float kk[8][2];
        conv_apply(xk, cw, kk);
        float n0 = 0.f, n1 = 0.f;
#pragma unroll
        for (int i = 0; i < 8; ++i) { const float wl = sc[128 + 8 * lg + i]; kk[i][0] = siluf_(kk[i][0]) * wl; kk[i][1] = siluf_(kk[i][1]) * wl; n0 += kk[i][0]; n1 += kk[i][1]; }
        u32x4 p0, p1;
#pragma unroll
        for (int i = 0; i < 4; ++i) { p0[i] = pk2(kk[2 * i][0], kk[2 * i + 1][0]); p1[i] = pk2(kk[2 * i][1], kk[2 * i + 1][1]); }
        *(u32x4*)(KT + (2 * cp) * 144 + lg * 16) = p0; *(u32x4*)(KT + (2 * cp + 1) * 144 + lg * 16) = p1;
        RED[lg * 128 + 2 * cp] = n0; RED[lg * 128 + 2 * cp + 1] = n1;
#pragma unroll
        for (int i = 0; i < 4; ++i) { p0[i] = (v[2 * i] & 0xffffu) | (v[2 * i + 1] << 16); p1[i] = (v[2 * i] >> 16) | (v[2 * i + 1] & 0xffff0000u); }
        *(u32x4*)(VT + (2 * cp) * 144 + lg * 16) = p0; *(u32x4*)(VT + (2 * cp + 1) * 144 + lg * 16) = p1;
    }
    LDS_BARRIER();
    bf16_t* ct = (bf16_t*)(a.ws + WS_CT) + (size_t)item * 128 * 128;
    {
        const int et0 = 2 * (wave & 3), dt0 = 4 * (wave >> 2);
        bf16x8 Vf[2][2], Kf[4][2];
#pragma unroll
        for (int i = 0; i < 2; ++i)
#pragma unroll
            for (int ks = 0; ks < 2; ++ks) Vf[i][ks] = *(const bf16x8*)(VT + ((et0 + i) * 16 + fr) * 144 + (ks * 32 + 8 * fq) * 2);
#pragma unroll
        for (int j = 0; j < 4; ++j)
#pragma unroll
            for (int ks = 0; ks < 2; ++ks) Kf[j][ks] = *(const bf16x8*)(KT + ((dt0 + j) * 16 + fr) * 144 + (ks * 32 + 8 * fq) * 2);
#pragma unroll
        for (int i = 0; i < 2; ++i)
#pragma unroll
            for (int j = 0; j < 4; ++j) {
                f32x4 acc = {0.f, 0.f, 0.f, 0.f};
                acc = mfma16(Kf[j][0], Vf[i][0], acc); acc = mfma16(Kf[j][1], Vf[i][1], acc);
                u32x2 w; w.x = pk2(acc[0], acc[1]); w.y = pk2(acc[2], acc[3]);
                *(u32x2*)(ct + ((et0 + i) * 16 + fr) * 128 + (dt0 + j) * 16 + 4 * fq) = w;
            }
    }
    if (tid < 128) { float s_ = 0.f;
#pragma unroll
        for (int g = 0; g < 8; ++g) s_ += RED[g * 128 + tid];
        ((float*)(a.ws + WS_DN))[(size_t)item * 128 + tid] = s_; }
    LDS_BARRIER();
}
struct MoRegs { unsigned xq[11], xk[11], v[8], ov[8]; float gi, gf, mprev; };
__device__ __forceinline__ void mo_load(const Args& a, int l, int item, MoRegs& R) {
    const int b = item >> 8, c = (item >> 2) & 63, h = item & 3, row0 = b * SEQ + c * CH, tid = otid(), lane = tid & 63, wave = tid >> 6;
    const bf16_t* z = (const bf16_t*)(a.ws + WS_Z);
    const float* gates = (const float*)(a.ws + WS_SMALL + SM_GATES);
    const int cp = lane, lg = wave, colq = ZQ + h * DH + 2 * cp, colk = ZK + h * DH + 2 * cp, colv = ZV + h * DH + 2 * cp, colo = ZO + h * DH + 2 * cp;
    conv_load11(z + colq, row0, 8 * lg, c == 0, R.xq);
    conv_load11(z + colk, row0, 8 * lg, c == 0, R.xk);
#pragma unroll
    for (int i = 0; i < 8; ++i) { R.v[i] = *(const unsigned*)(z + (size_t)(row0 + 8 * lg + i) * ZW + colv); R.ov[i] = *(const unsigned*)(z + (size_t)(row0 + 8 * lg + i) * ZW + colo); }
    R.gi = gates[(size_t)(row0 + lane) * 8 + h]; R.gf = gates[(size_t)(row0 + lane) * 8 + 4 + h];
    R.mprev = ((const float*)(a.ws + WS_SMALL + SM_MPREV))[item];
}
__device__ __forceinline__ void mo_compute(const Args& a, unsigned char* lds, int l, int item, MoRegs& R, ConvW& cwq, ConvW& cwk, int& hw) {
    const int b = item >> 8, c = (item >> 2) & 63, h = item & 3, row0 = b * SEQ + c * CH, tid = otid(), lane = tid & 63, wave = tid >> 6, fr = lane & 15, fq = lane >> 4;
    unsigned char* QN = lds; unsigned char* KN = lds + 17408; unsigned char* VT = lds + 34816; unsigned char* SP = lds + 53248; unsigned char* ON = lds + 62464;
    float* sc = (float*)(lds + 79872);
    float* SS = (float*)(lds + 79872 + 2048);
    const int cp = lane, lg = wave;
    unsigned (&xq)[11] = R.xq; unsigned (&xk)[11] = R.xk; unsigned (&v)[8] = R.v; unsigned (&ov)[8] = R.ov;
    bf16x8 Cf[4]; f32x4 dnv[4];
    { const bf16_t* ct = (const bf16_t*)(a.ws + WS_CT) + (size_t)item * 128 * 128; const float* dn = (const float*)(a.ws + WS_DN) + (size_t)item * 128;
#pragma unroll
      for (int ks = 0; ks < 4; ++ks) Cf[ks] = *(const bf16x8*)(ct + (wave * 16 + fr) * 128 + ks * 32 + 8 * fq);
#pragma unroll
      for (int j = 0; j < 4; ++j) dnv[j] = *(const f32x4*)(dn + (tid & 7) * 16 + 4 * j); }
    const float gm = a.in[I_GMH][(size_t)l * DM + h * DH + wave * 16 + fr];
    if (hw != h) { const float* wc = a.in[I_WCQK] + (size_t)l * 4 * 1024; const float* bc = a.in[I_BCQK] + (size_t)l * 1024;
        conv_loadw(wc, bc, ZQ + h * DH + 2 * cp, cwq); conv_loadw(wc, bc, ZK + h * DH + 2 * cp, cwk); hw = h; }
    if (tid < 64) {
        const float mprev = R.mprev;
        chunk_gates_r(sc, R.gi, R.gf, lane);
        float g = sc[64 + lane] - sc[lane];
#pragma unroll
        for (int o = 1; o < 64; o <<= 1) { const float n = __shfl_up(g, o); if (lane >= o) g = fmaxf(g, n); }
        const float mrow = sc[lane] + fmaxf(mprev, g);
        sc[128 + lane] = mrow; sc[192 + lane] = __expf(sc[lane] + mprev - mrow);
    }
    {
        float qq[8][2];
        conv_apply(xq, cwq, qq);
#pragma unroll
        for (int i = 0; i < 8; ++i) *(unsigned*)(QN + (8 * lg + i) * 272 + cp * 4) = pk2(siluf_(qq[i][0]) * 0.08838834764831845f, siluf_(qq[i][1]) * 0.08838834764831845f);
        conv_apply(xk, cwk, qq);
#pragma unroll
        for (int i = 0; i < 8; ++i) *(unsigned*)(KN + (8 * lg + i) * 272 + cp * 4) = pk2(siluf_(qq[i][0]), siluf_(qq[i][1]));
        u32x4 p0, p1;
#pragma unroll
        for (int i = 0; i < 4; ++i) { p0[i] = (v[2 * i] & 0xffffu) | (v[2 * i + 1] << 16); p1[i] = (v[2 * i] >> 16) | (v[2 * i + 1] & 0xffff0000u); }
        *(u32x4*)(VT + (2 * cp) * 144 + lg * 16) = p0; *(u32x4*)(VT + (2 * cp + 1) * 144 + lg * 16) = p1;
#pragma unroll
        for (int i = 0; i < 8; ++i) *(unsigned*)(ON + (8 * lg + i) * 272 + cp * 4) = ov[i];
    }
    LDS_BARRIER();
    {
        const int ll = tid >> 3, part = tid & 7; float s_ = 0.f;
#pragma unroll
        for (int j = 0; j < 4; ++j) { const u32x2 qv = *(const u32x2*)(QN + ll * 272 + (part * 16 + 4 * j) * 2);
            s_ += bf2f(qv.x & 0xffffu) * dnv[j].x + __uint_as_float(qv.x & 0xffff0000u) * dnv[j].y + bf2f(qv.y & 0xffffu) * dnv[j].z + __uint_as_float(qv.y & 0xffff0000u) * dnv[j].w; }
        s_ = sum8(s_);
        if (part == 0) sc[384 + ll] = s_;
    }
    {
        const int lt = wave & 3; const int ll = lt * 16 + fr; const float bl_ = sc[ll], mr = sc[128 + ll]; float dsum = 0.f;
#pragma unroll
        for (int mi = 0; mi < 2; ++mi) {
            const int mt = 2 * (wave >> 2) + mi; u32x2 pk = {0u, 0u};
            if (mt <= lt) {
                f32x4 acc = {0.f, 0.f, 0.f, 0.f};
#pragma unroll
                for (int ks = 0; ks < 4; ++ks) { const bf16x8 A = *(const bf16x8*)(KN + (mt * 16 + fr) * 272 + (ks * 32 + 8 * fq) * 2), B = *(const bf16x8*)(QN + (lt * 16 + fr) * 272 + (ks * 32 + 8 * fq) * 2);
                    acc = mfma16(A, B, acc); }
                float sv[4];
#pragma unroll
                for (int r = 0; r < 4; ++r) { const int mm = mt * 16 + 4 * fq + r; const float wgt = (mm <= ll) ? __expf(bl_ - sc[mm] + sc[64 + mm] - mr) : 0.f; sv[r] = acc[r] * wgt; dsum += sv[r]; }
                pk.x = pk2(sv[0], sv[1]); pk.y = pk2(sv[2], sv[3]);
            }
            *(u32x2*)(SP + ll * 144 + (mt * 16 + 4 * fq) * 2) = pk;
        }
        dsum += __shfl_xor(dsum, 16); dsum += __shfl_xor(dsum, 32);
        if (fq == 0) sc[256 + (wave >> 2) * 64 + ll] = dsum;
    }
    LDS_BARRIER();
    if (tid < 64) { const float den = sc[256 + tid] + sc[320 + tid] + sc[192 + tid] * sc[384 + tid]; sc[448 + tid] = fmaxf(fabsf(den), __expf(-sc[128 + tid])); }
    f32x4 acc1[4], acc2[4];
    {
        bf16x8 Vf[2];
#pragma unroll
        for (int ks = 0; ks < 2; ++ks) Vf[ks] = *(const bf16x8*)(VT + (wave * 16 + fr) * 144 + (ks * 32 + 8 * fq) * 2);
#pragma unroll
        for (int lt = 0; lt < 4; ++lt) {
            acc1[lt] = (f32x4){0.f, 0.f, 0.f, 0.f}; acc2[lt] = (f32x4){0.f, 0.f, 0.f, 0.f};
#pragma unroll
            for (int ks = 0; ks < 2; ++ks) acc1[lt] = mfma16(*(const bf16x8*)(SP + (lt * 16 + fr) * 144 + (ks * 32 + 8 * fq) * 2), Vf[ks], acc1[lt]);
#pragma unroll
            for (int ks = 0; ks < 4; ++ks) acc2[lt] = mfma16(*(const bf16x8*)(QN + (lt * 16 + fr) * 272 + (ks * 32 + 8 * fq) * 2), Cf[ks], acc2[lt]);
        }
    }
    LDS_BARRIER();
    float hm[4][4];
#pragma unroll
    for (int lt = 0; lt < 4; ++lt)
#pragma unroll
        for (int r = 0; r < 4; ++r) { const int ll = lt * 16 + 4 * fq + r;
            const float hv = (acc1[lt][r] + sc[192 + ll] * acc2[lt][r]) * frcp(sc[448 + ll]);
            const float o = sigmoidf_(bf2f(*(const bf16_t*)(ON + ll * 272 + (wave * 16 + fr) * 2)));
            hm[lt][r] = hv * o;
            const float q = sum16(hm[lt][r] * hm[lt][r]);
            if (fr == 0) SS[wave * 64 + ll] = q; }
    LDS_BARRIER();
    {
        unsigned char* HM = QN;
#pragma unroll
        for (int lt = 0; lt < 4; ++lt)
#pragma unroll
            for (int r = 0; r < 4; ++r) { const int ll = lt * 16 + 4 * fq + r; float tot = 0.f;
#pragma unroll
                for (int w = 0; w < 8; ++w) tot += SS[w * 64 + ll];
                *(bf16_t*)(HM + ll * 272 + (wave * 16 + fr) * 2) = (bf16_t)f2bf(hm[lt][r] * rsqrtf(tot * (1.f / 128.f) + EPS) * gm); }
        LDS_BARRIER();
        bf16_t* mix = (bf16_t*)(a.ws + WS_MIX);
#pragma unroll
        for (int j = 0; j < 2; ++j) { const int pc = tid + j * NT, ll = pc >> 4, q16 = pc & 15;
            *(u32x4*)(mix + (size_t)(row0 + ll) * D + h * DH + q16 * 8) = *(const u32x4*)(HM + ll * 272 + q16 * 16); }
    }
    LDS_BARRIER();
}

template <int MODE>
__device__ __forceinline__ void rglru_item(const Args& a, unsigned char* lds, int l, int item) {
    const int b = item >> 6, c = item & 63, row0 = b * SEQ + c * CH, ch = otid(), lane = ch & 63, nb = ch >> 6;
    float* xs = (float*)lds + nb * 64 * 64;
    const bf16_t* z = (const bf16_t*)(a.ws + WS_Z);
    const float* wcr = a.in[I_WCR] + (size_t)l * 4 * DR; const float bcr = a.in[I_BCR][l * DR + ch];
    const float w0 = wcr[ch], w1 = wcr[DR + ch], w2 = wcr[2 * DR + ch], w3 = wcr[3 * DR + ch];
    const bf16_t* zc = z + ZXR + ch;
    float xm3 = 0.f, xm2 = 0.f, xm1 = 0.f;
    { const int s0 = c * CH; if (s0 >= 3) { xm3 = bf2f(zc[(size_t)(row0 - 3) * ZW]); xm2 = bf2f(zc[(size_t)(row0 - 2) * ZW]); xm1 = bf2f(zc[(size_t)(row0 - 1) * ZW]); } }
#pragma unroll 4
    for (int t = 0; t < 64; ++t) { const float x0 = bf2f(zc[(size_t)(row0 + t) * ZW]);
        xs[t * 64 + lane] = bcr + w0 * xm3 + w1 * xm2 + w2 * xm1 + w3 * x0; xm3 = xm2; xm2 = xm1; xm1 = x0; }
    unsigned wa[32], wx[32];
    const float* wra = a.in[I_WRA] + ((size_t)(l * NBR + nb) * 64) * 64 + lane; const float* wri = a.in[I_WRI] + ((size_t)(l * NBR + nb) * 64) * 64 + lane;
#pragma unroll
    for (int d = 0; d < 32; ++d) { wa[d] = pk2(wra[(2 * d) * 64], wra[(2 * d + 1) * 64]); wx[d] = pk2(wri[(2 * d) * 64], wri[(2 * d + 1) * 64]); }
    const float ba = a.in[I_BRA][l * DR + ch], bx = a.in[I_BRI][l * DR + ch];
    const float lam = a.in[I_LAM][l * DR + ch];
    const float sp = fmaxf(-lam, 0.f) + log1pf(__expf(-fabsf(lam)));
    float hst = 0.f, ap = 1.f;
    if (MODE == 1) hst = ((const float*)(a.ws + WS_SMALL + SM_RGP))[(size_t)item * DR + ch];
    const float gr = a.in[I_GR][l * DR + ch];
    bf16_t* mix = (bf16_t*)(a.ws + WS_MIX);
    __syncthreads();
#pragma unroll 1
    for (int t = 0; t < 64; ++t) {
        float ra = ba, ia = bx;
#pragma unroll
        for (int d4 = 0; d4 < 16; ++d4) { const f32x4 xv = *(const f32x4*)(xs + t * 64 + 4 * d4);
#pragma unroll
            for (int q = 0; q < 2; ++q) { const unsigned pa = wa[2 * d4 + q], px = wx[2 * d4 + q];
                ra += xv[2 * q] * __uint_as_float(pa << 16) + xv[2 * q + 1] * __uint_as_float(pa & 0xffff0000u);
                ia += xv[2 * q] * __uint_as_float(px << 16) + xv[2 * q + 1] * __uint_as_float(px & 0xffff0000u); } }
        const float xo = xs[t * 64 + lane];
        const float r = sigmoidf_(ra), ig = sigmoidf_(ia), la = -8.f * r * sp, av = __expf(la);
        const float uu = sqrtf(-expm1f(2.f * la)) * (ig * xo);
        hst = av * hst + uu; ap *= av;
        if (MODE == 1) {
            const float y = bf2f(z[(size_t)(row0 + t) * ZW + ZYR + ch]);
            const float o = hst * gelu_tanh(y);
            const float rs = rsqrtf(wave_sum(o * o) * (1.f / 64.f) + EPS);
            mix[(size_t)(row0 + t) * D + DM + ch] = (bf16_t)f2bf(o * rs * gr);
        }
    }
    if (MODE == 0) { ((float*)(a.ws + WS_SMALL + SM_RGA))[(size_t)item * DR + ch] = ap; ((float*)(a.ws + WS_SMALL + SM_RGH))[(size_t)item * DR + ch] = hst; }
    __syncthreads();
}

template <int MODE>
__device__ __forceinline__ void rglru_fast(const Args& a, unsigned char* lds, int l, int item) {
    const int b = item >> 6, c = item & 63, row0 = b * SEQ + c * CH, ch = otid(), lane = ch & 63, nb = ch >> 6, fr = lane & 15, fq = lane >> 4;
    unsigned char* XA = lds + nb * 9216;
    float* GS = (float*)(lds + 73728 + nb * 8448);
    const bf16_t* z = (const bf16_t*)(a.ws + WS_Z);
    unsigned ypk[32];
    {
        const float* wcr = a.in[I_WCR] + (size_t)l * 4 * DR; const float bcr = a.in[I_BCR][l * DR + ch];
        const float w0 = wcr[ch], w1 = wcr[DR + ch], w2 = wcr[2 * DR + ch], w3 = wcr[3 * DR + ch];
        const bf16_t* zc = z + ZXR + ch;
        bf16_t xin[67];
#pragma unroll
        for (int t = 0; t < 67; ++t) xin[t] = (c == 0 && t < 3) ? (bf16_t)0 : zc[(ptrdiff_t)(row0 + t - 3) * ZW];
        if (MODE == 1) {
            bf16_t yb[64];
#pragma unroll
            for (int t = 0; t < 64; ++t) yb[t] = z[(size_t)(row0 + t) * ZW + ZYR + ch];
#pragma unroll
            for (int t = 0; t < 32; ++t) ypk[t] = (unsigned)yb[2 * t] | ((unsigned)yb[2 * t + 1] << 16);
        }
#pragma unroll
        for (int t = 0; t < 64; ++t)
            *(bf16_t*)(XA + t * 144 + lane * 2) = (bf16_t)f2bf(bcr + w0 * bf2f(xin[t]) + w1 * bf2f(xin[t + 1]) + w2 * bf2f(xin[t + 2]) + w3 * bf2f(xin[t + 3]));
    }
    bf16x8 Bf[8][2];
    { const bf16_t* wt = (const bf16_t*)(a.ws + WS_SMALL + SM_RGW) + (size_t)((l * NBR + nb) * 2) * 64 * 64;
#pragma unroll
        for (int ct = 0; ct < 8; ++ct)
#pragma unroll
            for (int ks = 0; ks < 2; ++ks) Bf[ct][ks] = *(const bf16x8*)(wt + (size_t)((ct >> 2) * 64 + (ct & 3) * 16 + fr) * 64 + ks * 32 + 8 * fq); }
    const float ba = a.in[I_BRA][l * DR + ch], bx = a.in[I_BRI][l * DR + ch];
    const float lam = a.in[I_LAM][l * DR + ch];
    const float sp8 = -8.f * (fmaxf(-lam, 0.f) + log1pf(__expf(-fabsf(lam))));
    float hst = 0.f, ap = 1.f;
    if (MODE == 1) hst = ((const float*)(a.ws + WS_SMALL + SM_RGP))[(size_t)item * DR + ch];
    const float gr = a.in[I_GR][l * DR + ch];
    bf16_t* mix = (bf16_t*)(a.ws + WS_MIX);
    WAVE_LDS_SYNC();
#pragma unroll
    for (int rt = 0; rt < 4; ++rt) {
        bf16x8 Af[2];
#pragma unroll
        for (int ks = 0; ks < 2; ++ks) Af[ks] = *(const bf16x8*)(XA + (rt * 16 + fr) * 144 + (ks * 32 + 8 * fq) * 2);
#pragma unroll
        for (int ct = 0; ct < 8; ++ct) {
            f32x4 acc = {0.f, 0.f, 0.f, 0.f};
            acc = mfma16(Af[0], Bf[ct][0], acc); acc = mfma16(Af[1], Bf[ct][1], acc);
#pragma unroll
            for (int r = 0; r < 4; ++r) GS[(4 * fq + r) * 132 + (ct >> 2) * 64 + (ct & 3) * 16 + fr] = acc[r];
        }
        WAVE_LDS_SYNC();
        {
            float ra[16], ia[16], xo[16], ov_[16];
#pragma unroll
            for (int tt = 0; tt < 16; ++tt) { ra[tt] = GS[tt * 132 + lane]; ia[tt] = GS[tt * 132 + 64 + lane]; xo[tt] = bf2f(*(const bf16_t*)(XA + (rt * 16 + tt) * 144 + lane * 2)); }
#pragma unroll
            for (int tt = 0; tt < 16; ++tt) {
                const float r = sigmoidf_(ra[tt] + ba), ig = sigmoidf_(ia[tt] + bx), la = sp8 * r, av = __expf(la);
                const float uu = __builtin_amdgcn_sqrtf(fmaxf(fmaf(-av, av, 1.f), 0.f)) * (ig * xo[tt]);
                hst = av * hst + uu; ap *= av;
                ov_[tt] = hst;
            }
            if (MODE == 1) {
#pragma unroll
                for (int tt = 0; tt < 16; ++tt) *(bf16_t*)(XA + (rt * 16 + tt) * 144 + lane * 2) = (bf16_t)f2bf(ov_[tt] * gelu_tanh((tt & 1) ? __uint_as_float(ypk[rt * 8 + (tt >> 1)] & 0xffff0000u) : bf2f(ypk[rt * 8 + (tt >> 1)] & 0xffffu)));
            }
        }
        WAVE_LDS_SYNC();
    }
    if (MODE == 1) {
        float ss = 0.f;
#pragma unroll
        for (int j = 0; j < 8; ++j) { const u32x4 v = *(const u32x4*)(XA + lane * 144 + j * 16);
#pragma unroll
            for (int q = 0; q < 4; ++q) { const float lo = bf2f(v[q] & 0xffffu), hi = __uint_as_float(v[q] & 0xffff0000u); ss += lo * lo + hi * hi; } }
        const float rs = rsqrtf(ss * (1.f / 64.f) + EPS) ;
#pragma unroll
        for (int t0 = 0; t0 < 64; t0 += 16) { float ovv[16];
#pragma unroll
            for (int tt = 0; tt < 16; ++tt) ovv[tt] = bf2f(*(const bf16_t*)(XA + (t0 + tt) * 144 + lane * 2));
#pragma unroll
            for (int tt = 0; tt < 16; ++tt) { const float rst = __int_as_float(__builtin_amdgcn_readlane(__float_as_int(rs), t0 + tt));
                *(bf16_t*)(XA + (t0 + tt) * 144 + lane * 2) = (bf16_t)f2bf(ovv[tt] * rst * gr); } }
        WAVE_LDS_SYNC();
#pragma unroll
        for (int j = 0; j < 8; ++j) { const int t = j * 8 + (lane >> 3), q16 = lane & 7;
            *(u32x4*)(mix + (size_t)(row0 + t) * D + DM + nb * 64 + q16 * 8) = *(const u32x4*)(XA + t * 144 + q16 * 16); }
    }
    if (MODE == 0) { ((float*)(a.ws + WS_SMALL + SM_RGA))[(size_t)item * DR + ch] = ap; ((float*)(a.ws + WS_SMALL + SM_RGH))[(size_t)item * DR + ch] = hst; }
    LDS_BARRIER();
}
__device__ __forceinline__ void rglru_scan(const Args& a, int G) {
    const int tid = otid();
    for (int i = blockIdx.x * 8 + (tid & 7); i < NBATCH * DR && tid < 8; i += G * 8) {
        const int b = i / DR, ch = i % DR;
        const float* A_ = (const float*)(a.ws + WS_SMALL + SM_RGA) + (size_t)(b * NC) * DR + ch; const float* H_ = (const float*)(a.ws + WS_SMALL + SM_RGH) + (size_t)(b * NC) * DR + ch;
        float* P_ = (float*)(a.ws + WS_SMALL + SM_RGP) + (size_t)(b * NC) * DR + ch;
        float hs = 0.f;
#pragma unroll 1
        for (int c0 = 0; c0 < NC; c0 += 16) {
            float av[16], hv[16];
#pragma unroll
            for (int j = 0; j < 16; ++j) { av[j] = A_[(c0 + j) * DR]; hv[j] = H_[(c0 + j) * DR]; }
#pragma unroll
            for (int j = 0; j < 16; ++j) { P_[(c0 + j) * DR] = hs; hs = av[j] * hs + hv[j]; }
        }
    }
}

__device__ __forceinline__ void phase_route(const Args& a, unsigned char* lds) {
    unsigned* wtot = (unsigned*)lds;
    int* pre = (int*)(lds + 256);
    int* tot = pre + 8;
    int* ce = tot + 16;
    unsigned* pref = (unsigned*)(lds + 2048);
    const int tid = otid(), lane = tid & 63, wave = tid >> 6, G = gridDim.x;
    const unsigned char* tok_p = (const unsigned char*)(a.ws + WS_SMALL + SM_TOKP); const float* tok_g = (const float*)(a.ws + WS_SMALL + SM_TOKG);
    int* row_tok = (int*)(a.ws + WS_SMALL + SM_ROWTOK); float* row_gate = (float*)(a.ws + WS_SMALL + SM_ROWGATE); int* tile_e = (int*)(a.ws + WS_SMALL + SM_TILEE);
    if (tid < 256) {
        unsigned long long hh = 0ull;
#pragma unroll
        for (int j = 0; j < 4; ++j) { const u32x4 v = ((const u32x4*)(tok_p + tid * 64))[j];
#pragma unroll
            for (int q = 0; q < 4; ++q)
#pragma unroll
                for (int bb = 0; bb < 4; ++bb) { const unsigned by = (v[q] >> (8 * bb)) & 0xffu; hh += (1ull << (8 * (by & 15u))) + (1ull << (8 * (by >> 4))); } }
        unsigned w[4];
#pragma unroll
        for (int i = 0; i < 4; ++i) { const unsigned two = (unsigned)(hh >> (16 * i)) & 0xffffu; w[i] = (two & 0xffu) | ((two >> 8) << 16); }
        unsigned inc[4];
#pragma unroll
        for (int i = 0; i < 4; ++i) { unsigned x = w[i];
#pragma unroll
            for (int o = 1; o < 64; o <<= 1) { const unsigned n = __shfl_up(x, o); if (lane >= o) x += n; }
            inc[i] = x; }
        if (lane == 63) {
#pragma unroll
            for (int i = 0; i < 4; ++i) wtot[wave * 4 + i] = inc[i]; }
        __builtin_amdgcn_s_waitcnt(0);
        __builtin_amdgcn_s_barrier();
#pragma unroll
        for (int i = 0; i < 4; ++i) { unsigned base = 0u;
            for (int ww = 0; ww < wave; ++ww) base += wtot[ww * 4 + i];
            pref[tid * 4 + i] = base + inc[i] - w[i];
            if (tid == 255) { const unsigned t2 = base + inc[i]; tot[2 * i] = (int)(t2 & 0xffffu); tot[2 * i + 1] = (int)(t2 >> 16); } }
    } else {
        __builtin_amdgcn_s_barrier();
    }
    __syncthreads();
    if (tid == 0) { int s_ = 0; for (int e = 0; e < 8; ++e) { tot[8 + e] = s_; s_ += (tot[e] + 255) & ~255; }
        if (blockIdx.x == 0) { int t = 0; for (int e = 0; e < 8; ++e) { const int n = (tot[e] + 255) >> 8; for (int j = 0; j < n; ++j) tile_e[t++] = e; tile_e[256 + e] = t; } tile_e[255] = t; } }
    __syncthreads();
    for (int ck = blockIdx.x; ck < 256; ck += G) {
        if (tid < 128) { const unsigned by = tok_p[ck * 64 + (tid >> 1)]; ce[tid] = (tid & 1) ? (int)(by >> 4) : (int)(by & 15u); }
        __syncthreads();
        if (tid < 128) { const int e = ce[tid];
            int rank = 0, w0cnt = 0;
#pragma unroll
            for (int q = 0; q < 8; ++q) { const unsigned long long mk = __ballot(e == q); if (e == q) rank = __popcll(mk & ((1ull << lane) - 1ull)); if (wave == 0 && lane == 0) ce[128 + q] = __popcll(mk); }
            __builtin_amdgcn_s_waitcnt(0);
            asm volatile("s_barrier" ::: "memory");
            if (wave == 1) rank += ce[128 + e];
            (void)w0cnt;
            const unsigned pw = pref[ck * 4 + (e >> 1)]; const int pr = (int)((e & 1) ? (pw >> 16) : (pw & 0xffffu));
            const int dest = tot[8 + e] + pr + rank;
            row_tok[dest] = ck * 64 + (tid >> 1); row_gate[dest] = tok_g[ck * 128 + tid]; ((int*)(a.ws + WS_SMALL + SM_ROWSLOT))[dest] = tid & 1; }
        else { asm volatile("s_barrier" ::: "memory"); }
        __syncthreads();
    }
}

#ifndef GEMM
#define GEMM gemm_fast
#endif
__global__ void __launch_bounds__(NT, 2) mk_fwd(Args a0) {
    extern __shared__ __attribute__((aligned(16))) unsigned char lds[];
    const int G = gridDim.x, bid = blockIdx.x, ph_lo = a0.ph_lo, ph_hi = a0.ph_hi;
    volatile LAS unsigned* xst = (volatile LAS unsigned*)(lds + LDS_BYTES - 64);
    if (threadIdx.x < 2) xst[threadIdx.x] = 0u;
    __syncthreads();
    const XcdBarrier xb = xcd_barrier_post((unsigned*)(a0.ws + WS_SMALL + SM_BAR), xst);
    int ph = 0;
#ifndef PROBE_CAT
#define PROBE_CAT 0
#define PROBE_N 1
#endif
#define PHASE_BEGIN(cat) if (ph >= ph_lo && ph < ph_hi) { for (int rep_ = 0; rep_ < ((cat) == PROBE_CAT ? PROBE_N : 1); ++rep_) { const bool lastrep = (rep_ + 1 == ((cat) == PROBE_CAT ? PROBE_N : 1)); (void)lastrep; const Args& a = *(const Args*)okarg(); unsigned char* const ws = a.ws; \
    bf16_t* const hn = (bf16_t*)(ws + WS_HN); bf16_t* const z = (bf16_t*)(ws + WS_Z); bf16_t* const mix = (bf16_t*)(ws + WS_MIX); bf16_t* const hid = (bf16_t*)(ws + WS_HID); \
    float* const gates = (float*)(ws + WS_SMALL + SM_GATES); int* const tok_e = (int*)(ws + WS_SMALL + SM_TOKP); float* const tok_g = (float*)(ws + WS_SMALL + SM_TOKG); \
    const int* const row_tok = (const int*)(ws + WS_SMALL + SM_ROWTOK); const float* const row_gate = (const float*)(ws + WS_SMALL + SM_ROWGATE); const int* const tile_e = (const int*)(ws + WS_SMALL + SM_TILEE); \
    (void)hn; (void)z; (void)mix; (void)hid; (void)gates; (void)tok_e; (void)tok_g; (void)row_tok; (void)row_gate; (void)tile_e;
#define PHASE_END(dosync) } for (int rep_ = 0; rep_ < (PROBE_CAT == 6 ? PROBE_N : 1); ++rep_) if ((dosync) && ph + 1 < ph_hi) { xcd_barrier(xb); } } ++ph;

    PHASE_BEGIN(1) phase_prologue(a, lds); __syncthreads();
        phase_rowpass<0, 1, 1, false>(lds, a.in[I_X], hn, nullptr, a.in[I_GMIX], (float*)(ws + WS_SSQ), a.in[I_WIN] + 2048, DIN, a.in[I_BIN] + 2048, gates, nullptr, nullptr, nullptr); PHASE_END(true)
    { constexpr int l = 0;
#define LAYER_PTRS bf16_t* const hb = (bf16_t*)(ws + (l ? WS_H1 : WS_HN)); bf16_t* const hbo = (bf16_t*)(ws + (l ? WS_HN : WS_H1)); float* const ssq = (float*)(ws + WS_SSQ + l * SSQ_STRIDE); float* const ssqo = (float*)(ws + WS_SSQ + (1 - l) * SSQ_STRIDE); (void)hb; (void)hbo; (void)ssq; (void)ssqo;
        PHASE_BEGIN(3) LAYER_PTRS { if (l == 1) phase_rowpass<1, 1, 0, false>(lds, nullptr, hb, nullptr, a.in[I_GMIX] + l * D, nullptr, a.in[I_WIN] + (size_t)l * D * DIN + 2048, DIN, a.in[I_BIN] + l * DIN + 2048, gates, nullptr, nullptr, nullptr);
            GridOrder S{M / 256, ZW / 256, G, bid}; EpiZ E{z, a.in[I_BIN] + l * DIN, ssq};
            GEMM(lds, hb, (const bf16_t*)(ws + (l ? WS_W_IN1 : WS_W_IN0)), D, S, E); } PHASE_END(true)
        PHASE_BEGIN(4) LAYER_PTRS { MlRegs cur, nxt; int it = bid; if (it < 1024) ml_load(a, l, it, cur); nxt = cur;
            for (; it < 1024; it += G) { if (it + G < 1024) ml_load(a, l, it + G, nxt); ml_compute(a, lds, l, it, cur); cur = nxt; }
            for (; it < 1280; it += G) rglru_fast<0>(a, lds, l, it - 1024); } PHASE_END(true)
        PHASE_BEGIN(0) LAYER_PTRS mlstm_scan(a, G); rglru_scan(a, G); PHASE_END(true)
        PHASE_BEGIN(5) LAYER_PTRS { MoRegs cur, nxt; ConvW cwq, cwk; int hw = -1; int it = bid; if (it < 1024) mo_load(a, l, it, cur); nxt = cur;
            for (; it < 1024; it += G) { if (it + G < 1024) mo_load(a, l, it + G, nxt); mo_compute(a, lds, l, it, cur, cwq, cwk, hw); cur = nxt; }
            for (; it < 1280; it += G) rglru_fast<1>(a, lds, l, it - 1024); } PHASE_END(true)
        PHASE_BEGIN(0) LAYER_PTRS { GridOrder S{M / 256, D / 256, G, bid}; EpiHres<l == 0> E{l == 0 ? a.in[I_X] : nullptr, hb, ssq};
            GEMM(lds, mix, (const bf16_t*)(ws + (l ? WS_W_OUT1 : WS_W_OUT0)), D, S, E); } PHASE_END(true)
        if (l == 0) {
            PHASE_BEGIN(3) LAYER_PTRS { GridOrder S{M / 256, 2 * DFF / 256, G, bid}; EpiSwiglu E{hid, ssq, nullptr};
                GEMM(lds, hb, (const bf16_t*)(ws + WS_W_FFGU), D, S, E);
                { constexpr int nun = (M / 256) * (2 * DFF / 256); const int first = nun % G;
                  TailOrder S2{M / 256, D / 256, G, bid, first}; EpiStoreBf16 E2{(bf16_t*)(ws + WS_PP0)};
                  GEMM(lds, (const bf16_t*)(ws + WS_PB0), (const bf16_t*)(ws + WS_W_PP0), DPLE, S2, E2); } } PHASE_END(true)
            PHASE_BEGIN(0) LAYER_PTRS { GridOrder S{M / 256, D / 256, G, bid}; EpiHres<false> E{nullptr, hb, ssq};
                GEMM(lds, hid, (const bf16_t*)(ws + WS_W_FFD), DFF, S, E); } PHASE_END(true)
        } else {
            PHASE_BEGIN(2) LAYER_PTRS phase_rowpass<1, 2, 0, false>(lds, nullptr, hb, nullptr, a.in[I_GFFN] + l * D, nullptr, a.in[I_WROUTER], 8, nullptr, nullptr, (unsigned char*)tok_e, tok_g, nullptr, ws + WS_HN8); PHASE_END(true)
            PHASE_BEGIN(12) LAYER_PTRS phase_route(a, lds); PHASE_END(true)
            PHASE_BEGIN(3) LAYER_PTRS { MoeOrder<true> S{tile_e[255], 2 * DFF / 256, G, bid, row_tok, (size_t)5632 * D}; S.init(tile_e); EpiSwiglu8 E{ws + WS_HID, 1.f / 32.f};
                gemm_fast<true>(lds, (const bf16_t*)(ws + WS_HN8), (const bf16_t*)(ws + WS_W_EGU), D, S, E); } PHASE_END(true)
            PHASE_BEGIN(0) LAYER_PTRS { MoeOrder<false> S{tile_e[255], D / 256, G, bid, nullptr, (size_t)D * DFF}; S.init(tile_e); EpiMoeDown E{hb, (bf16_t*)a.out, row_tok, (const int*)(ws + WS_SMALL + SM_ROWSLOT), row_gate, 1.f / 32.f};
                gemm_fast<true>(lds, (const bf16_t*)(ws + WS_HID), (const bf16_t*)(ws + WS_W_ED), DFF, S, E);
                { const int nun = tile_e[255] * (D / 256); const int first = nun > 2 * G ? nun - 2 * G : 0;
                  TailOrder S2{M / 256, D / 256, G, bid, first < G ? first : 0}; EpiStoreBf16 E2{(bf16_t*)a.out + (size_t)M * D};
                  GEMM(lds, (const bf16_t*)(ws + WS_PB1), (const bf16_t*)(ws + WS_W_PP1), DPLE, S2, E2); } } PHASE_END(true)
            PHASE_BEGIN(0) LAYER_PTRS phase_rowpass<1, 0, 1, true>(lds, nullptr, hb, (const bf16_t*)a.out, nullptr, ssq, nullptr, 0, nullptr, nullptr, nullptr, nullptr, nullptr); PHASE_END(true)
        }
        PHASE_BEGIN(10) LAYER_PTRS { GridOrder S{M / 256, D / 256, G, bid};
            EpiPle E{hb, hbo, l == 0 ? (const bf16_t*)(ws + WS_PP0) : (const bf16_t*)a.out + (size_t)M * D, ssqo, ssq}; GEMM(lds, hb, (const bf16_t*)(ws + WS_W_PG) + (size_t)l * D * D, D, S, E);
            if (l == 0 && bid == 0) { for (int i = otid(); i < D / 2; i += NT) ((unsigned*)(ws + WS_H1 + (size_t)M * D * 2))[i] = 0u; } } PHASE_END(true)
    }
    { constexpr int l = 1;
        PHASE_BEGIN(3) LAYER_PTRS { if (l == 1) phase_rowpass<1, 1, 0, false>(lds, nullptr, hb, nullptr, a.in[I_GMIX] + l * D, nullptr, a.in[I_WIN] + (size_t)l * D * DIN + 2048, DIN, a.in[I_BIN] + l * DIN + 2048, gates, nullptr, nullptr, nullptr);
            GridOrder S{M / 256, ZW / 256, G, bid}; EpiZ E{z, a.in[I_BIN] + l * DIN, ssq};
            GEMM(lds, hb, (const bf16_t*)(ws + (l ? WS_W_IN1 : WS_W_IN0)), D, S, E); } PHASE_END(true)
        PHASE_BEGIN(4) LAYER_PTRS { MlRegs cur, nxt; int it = bid; if (it < 1024) ml_load(a, l, it, cur); nxt = cur;
            for (; it < 1024; it += G) { if (it + G < 1024) ml_load(a, l, it + G, nxt); ml_compute(a, lds, l, it, cur); cur = nxt; }
            for (; it < 1280; it += G) rglru_fast<0>(a, lds, l, it - 1024); } PHASE_END(true)
        PHASE_BEGIN(0) LAYER_PTRS mlstm_scan(a, G); rglru_scan(a, G); PHASE_END(true)
        PHASE_BEGIN(5) LAYER_PTRS { MoRegs cur, nxt; ConvW cwq, cwk; int hw = -1; int it = bid; if (it < 1024) mo_load(a, l, it, cur); nxt = cur;
            for (; it < 1024; it += G) { if (it + G < 1024) mo_load(a, l, it + G, nxt); mo_compute(a, lds, l, it, cur, cwq, cwk, hw); cur = nxt; }
            for (; it < 1280; it += G) rglru_fast<1>(a, lds, l, it - 1024); } PHASE_END(true)
        PHASE_BEGIN(0) LAYER_PTRS { GridOrder S{M / 256, D / 256, G, bid}; EpiHres<l == 0> E{l == 0 ? a.in[I_X] : nullptr, hb, ssq};
            GEMM(lds, mix, (const bf16_t*)(ws + (l ? WS_W_OUT1 : WS_W_OUT0)), D, S, E); } PHASE_END(true)
        if (l == 0) {
            PHASE_BEGIN(3) LAYER_PTRS { GridOrder S{M / 256, 2 * DFF / 256, G, bid}; EpiSwiglu E{hid, ssq, nullptr};
                GEMM(lds, hb, (const bf16_t*)(ws + WS_W_FFGU), D, S, E);
                { constexpr int nun = (M / 256) * (2 * DFF / 256); const int first = nun % G;
                  TailOrder S2{M / 256, D / 256, G, bid, first}; EpiStoreBf16 E2{(bf16_t*)(ws + WS_PP0)};
                  GEMM(lds, (const bf16_t*)(ws + WS_PB0), (const bf16_t*)(ws + WS_W_PP0), DPLE, S2, E2); } } PHASE_END(true)
            PHASE_BEGIN(0) LAYER_PTRS { GridOrder S{M / 256, D / 256, G, bid}; EpiHres<false> E{nullptr, hb, ssq};
                GEMM(lds, hid, (const bf16_t*)(ws + WS_W_FFD), DFF, S, E); } PHASE_END(true)
        } else {
            PHASE_BEGIN(2) LAYER_PTRS phase_rowpass<1, 2, 0, false>(lds, nullptr, hb, nullptr, a.in[I_GFFN] + l * D, nullptr, a.in[I_WROUTER], 8, nullptr, nullptr, (unsigned char*)tok_e, tok_g, nullptr, ws + WS_HN8); PHASE_END(true)
            PHASE_BEGIN(12) LAYER_PTRS phase_route(a, lds); PHASE_END(true)
            PHASE_BEGIN(3) LAYER_PTRS { MoeOrder<true> S{tile_e[255], 2 * DFF / 256, G, bid, row_tok, (size_t)5632 * D}; S.init(tile_e); EpiSwiglu8 E{ws + WS_HID, 1.f / 32.f};
                gemm_fast<true>(lds, (const bf16_t*)(ws + WS_HN8), (const bf16_t*)(ws + WS_W_EGU), D, S, E); } PHASE_END(true)
            PHASE_BEGIN(0) LAYER_PTRS { MoeOrder<false> S{tile_e[255], D / 256, G, bid, nullptr, (size_t)D * DFF}; S.init(tile_e); EpiMoeDown E{hb, (bf16_t*)a.out, row_tok, (const int*)(ws + WS_SMALL + SM_ROWSLOT), row_gate, 1.f / 32.f};
                gemm_fast<true>(lds, (const bf16_t*)(ws + WS_HID), (const bf16_t*)(ws + WS_W_ED), DFF, S, E);
                { const int nun = tile_e[255] * (D / 256); const int first = nun > 2 * G ? nun - 2 * G : 0;
                  TailOrder S2{M / 256, D / 256, G, bid, first < G ? first : 0}; EpiStoreBf16 E2{(bf16_t*)a.out + (size_t)M * D};
                  GEMM(lds, (const bf16_t*)(ws + WS_PB1), (const bf16_t*)(ws + WS_W_PP1), DPLE, S2, E2); } } PHASE_END(true)
            PHASE_BEGIN(0) LAYER_PTRS phase_rowpass<1, 0, 1, true>(lds, nullptr, hb, (const bf16_t*)a.out, nullptr, ssq, nullptr, 0, nullptr, nullptr, nullptr, nullptr, nullptr); PHASE_END(true)
        }
        PHASE_BEGIN(10) LAYER_PTRS { GridOrder S{M / 256, D / 256, G, bid};
            EpiPle E{hb, hbo, l == 0 ? (const bf16_t*)(ws + WS_PP0) : (const bf16_t*)a.out + (size_t)M * D, ssqo, ssq}; GEMM(lds, hb, (const bf16_t*)(ws + WS_W_PG) + (size_t)l * D * D, D, S, E);
            if (l == 0 && bid == 0) { for (int i = otid(); i < D / 2; i += NT) ((unsigned*)(ws + WS_H1 + (size_t)M * D * 2))[i] = 0u; } } PHASE_END(true)
    }
    PHASE_BEGIN(0) phase_rowpass<1, 0, 2, false>(lds, nullptr, hn, nullptr, a.in[I_GFINAL], nullptr, nullptr, 0, nullptr, nullptr, nullptr, nullptr, a.out); PHASE_END(false)
}

extern "C" void kernel_launch(void* const* d_in, const int* in_sizes, int n_in, void* d_out, int out_size,
                              void* d_ws, size_t ws_size, hipStream_t stream) {
    static int grid = 0;
    if (grid == 0) {
        if (n_in != 29 || out_size != M * D || ws_size < WS_END) { fprintf(stderr, "kernel_launch: unexpected problem (n_in %d out %d ws %zu)\n", n_in, out_size, ws_size); grid = -1; return; }
        int dev = 0, cus = 0, per_cu = 0;
        (void)hipGetDevice(&dev);
        (void)hipDeviceGetAttribute(&cus, hipDeviceAttributeMultiprocessorCount, dev);
        (void)hipFuncSetAttribute((const void*)mk_fwd, hipFuncAttributeMaxDynamicSharedMemorySize, LDS_BYTES);
        (void)hipOccupancyMaxActiveBlocksPerMultiprocessor(&per_cu, (const void*)mk_fwd, NT, LDS_BYTES);
        if (per_cu < 1) { fprintf(stderr, "kernel_launch: occupancy query says %d blocks per CU\n", per_cu); per_cu = 1; }
        grid = cus;
    }
    if (grid < 0) return;
    Args a{};
    for (int i = 0; i < 29; ++i) a.in[i] = (const float*)d_in[i];
    a.out = (float*)d_out; a.ws = (unsigned char*)d_ws; a.ph_lo = 0; a.ph_hi = 1000;
    (void)hipMemsetAsync((unsigned char*)d_ws + WS_SMALL + SM_BAR, 0, 16 * 1024, stream);
    void* args[] = {&a};
    hipError_t e = hipLaunchCooperativeKernel((void*)mk_fwd, dim3(grid), dim3(NT), args, LDS_BYTES, stream);
    if (e != hipSuccess) fprintf(stderr, "cooperative launch failed: %s (grid %d)\n", hipGetErrorString(e), grid);
}
```

```cpp
#include <hip/hip_runtime.h>
#include <hip/hip_cooperative_groups.h>
#include <cstdio>
#include <cstdint>
namespace cg = cooperative_groups;

constexpr int NT = 512;
constexpr int D = 1024, NBATCH = 4, SEQ = 4096, M = NBATCH * SEQ;
constexpr int CH = 64, NC = SEQ / CH, NH = 4, DH = 128, DM = 512, DR = 512, NBR = 8, DBR = 64;
constexpr int DIN = 3080, ZW = 3072, DFF = 2816, NE = 8, DPLE = 256;
constexpr int PMAX = 2 * M + NE * 256, NTILE_MAX = PMAX / 256;
constexpr int EROWS = 129;
constexpr float EPS = 1e-6f;
constexpr int ZQ = 0, ZK = 512, ZV = 1024, ZO = 1536, ZXR = 2048, ZYR = 2560;

constexpr size_t MiB = 1u << 20;
constexpr size_t WS_SMALL = 0;
constexpr size_t WS_W_IN0 = 4 * MiB;
constexpr size_t WS_W_OUT0 = 10 * MiB;
constexpr size_t WS_W_FFGU = 12 * MiB;
constexpr size_t WS_W_FFD = 23 * MiB;
constexpr size_t WS_PB0 = WS_W_FFD + 5632 * 1024;
constexpr size_t WS_W_PP0 = WS_PB0 + 8 * MiB;
constexpr size_t WS_H1 = 4 * MiB;
constexpr size_t WS_W_IN1 = 37 * MiB;
constexpr size_t WS_W_OUT1 = 43 * MiB;
constexpr size_t WS_W_PG = 45 * MiB;
constexpr size_t WS_W_PP1 = 49 * MiB;
constexpr size_t WS_W_EGU = WS_W_PP1 + MiB / 2;
constexpr size_t WS_W_ED = WS_W_EGU + 88 * MiB;
constexpr size_t WS_HN8 = WS_W_EGU + 44 * MiB;
constexpr size_t WS_PB1 = WS_W_ED + 44 * MiB;
constexpr size_t WS_HN = WS_PB1 + 8 * MiB;
static_assert(WS_H1 + (size_t)(M + 1) * D * 2 <= WS_W_IN1 && WS_W_PP0 + 1024 * 256 * 2 <= WS_W_IN1, "map");
constexpr size_t WS_RF = 222 * MiB;
constexpr size_t WS_Z = WS_RF;
constexpr size_t WS_CT = WS_Z + 96 * MiB;
constexpr size_t WS_DN = WS_CT + 32 * MiB;
constexpr size_t WS_MIX = WS_CT + 72 * MiB;
constexpr size_t WS_HID = WS_RF;
constexpr size_t WS_PP0 = WS_RF + 130 * MiB;
constexpr size_t WS_SSQ = WS_RF + 201 * MiB;
constexpr size_t SSQ_STRIDE = (size_t)(M + 16) * 64;
constexpr size_t WS_SCAL = WS_RF + 204 * MiB;
constexpr size_t WS_END = 435 * MiB;
static_assert(WS_MIX + (size_t)M * D * 2 <= WS_SSQ && WS_HID + (size_t)PMAX * DFF * 2 <= WS_SSQ && WS_SSQ + 2 * SSQ_STRIDE <= WS_END, "map");
static_assert(WS_HN + (size_t)(M + 1) * D * 2 <= WS_RF, "map");
static_assert(WS_MIX + (size_t)M * D * 2 <= WS_END, "map");
static_assert(WS_HID + (size_t)PMAX * DFF * 2 <= WS_END, "map");
static_assert(WS_DN + 1024 * 128 * 4 <= WS_PP0 && WS_PP0 + (size_t)M * D * 2 <= WS_MIX && WS_HID + (size_t)M * DFF * 2 <= WS_PP0, "map");
constexpr size_t SM_GATES = 0;
constexpr size_t SM_TOKE = 512 * 1024;
constexpr size_t SM_TOKG = SM_TOKE + 128 * 1024;
constexpr size_t SM_ROWTOK = SM_TOKG + 128 * 1024;
constexpr size_t SM_ROWGATE = SM_ROWTOK + 160 * 1024;
constexpr size_t SM_TILEE = SM_ROWGATE + 160 * 1024;
constexpr size_t SM_ROWSLOT = SM_TILEE + 4 * 1024;
constexpr size_t SM_TOKP = SM_ROWSLOT + 160 * 1024;
constexpr size_t SM_BL = SM_TOKP + 16 * 1024;
constexpr size_t SM_AMAX = SM_BL + 4 * 1024;
constexpr size_t SM_MPREV = SM_AMAX + 4 * 1024;
constexpr size_t SM_RGA = 2 * MiB;
constexpr size_t SM_RGH = SM_RGA + 512 * 1024;
constexpr size_t SM_RGP = SM_RGH + 512 * 1024;
constexpr size_t SM_BAR = SM_RGP + 512 * 1024;
constexpr size_t SM_RGW = SM_BAR + 16 * 1024;
static_assert(SM_MPREV + 4096 <= SM_RGA && SM_RGW + 256 * 1024 <= 4 * MiB, "small map");

constexpr int LDS_BYTES = 147456;

typedef unsigned short bf16_t;
typedef float f32x4 __attribute__((ext_vector_type(4)));
typedef unsigned u32x4 __attribute__((ext_vector_type(4)));
typedef unsigned u32x2 __attribute__((ext_vector_type(2)));

__device__ __forceinline__ float bf2f(unsigned v) { return __uint_as_float(v << 16); }
__device__ __forceinline__ unsigned pk2(float lo, float hi);
__device__ __forceinline__ unsigned f2bf(float f) { return pk2(f, 0.f) & 0xffffu; }
typedef float f32x2_t __attribute__((ext_vector_type(2))); typedef __bf16 bf16x2_t __attribute__((ext_vector_type(2)));
__device__ __forceinline__ unsigned pk2(float lo, float hi) { f32x2_t v = {lo, hi}; bf16x2_t b = __builtin_convertvector(v, bf16x2_t); return __builtin_bit_cast(unsigned, b); }
__device__ __forceinline__ unsigned pk4_fp8(float a, float b, float c, float d) { int w = __builtin_amdgcn_cvt_pk_fp8_f32(a, b, 0, false); w = __builtin_amdgcn_cvt_pk_fp8_f32(c, d, w, true); return (unsigned)w; }
__device__ __forceinline__ float frcp(float x) { return __builtin_amdgcn_rcpf(x); }
__device__ __forceinline__ float sigmoidf_(float x) { return frcp(1.f + __expf(-x)); }
__device__ __forceinline__ float siluf_(float x) { return x * frcp(1.f + __expf(-x)); }
__device__ __forceinline__ float logsigmoidf_(float x) { return fminf(x, 0.f) - log1pf(__expf(-fabsf(x))); }
__device__ __forceinline__ float gelu_tanh(float y) { const float u2 = 1.5957691216057308f * (y + 0.044715f * y * y * y); return y * frcp(1.f + __expf(-u2)); }
__device__ __forceinline__ float wave_sum(float v) {
#pragma unroll
    for (int o = 1; o < 64; o <<= 1) v += __shfl_xor(v, o);
    return v;
}
__device__ __forceinline__ float wave_max(float v) {
#pragma unroll
    for (int o = 1; o < 64; o <<= 1) v = fmaxf(v, __shfl_xor(v, o));
    return v;
}

__device__ __forceinline__ float dpp_f(float v, const int ctrl_sel) {
    const int x = __float_as_int(v); int r;
    if (ctrl_sel == 0) r = __builtin_amdgcn_update_dpp(x, x, 0xB1, 0xF, 0xF, false);
    else if (ctrl_sel == 1) r = __builtin_amdgcn_update_dpp(x, x, 0x4E, 0xF, 0xF, false);
    else if (ctrl_sel == 2) r = __builtin_amdgcn_update_dpp(x, x, 0x141, 0xF, 0xF, false);
    else r = __builtin_amdgcn_update_dpp(x, x, 0x140, 0xF, 0xF, false);
    return __int_as_float(r);
}
__device__ __forceinline__ float sum4(float v) { v += dpp_f(v, 0); v += dpp_f(v, 1); return v; }
__device__ __forceinline__ float sum8(float v) { v = sum4(v); v += dpp_f(v, 2); return v; }
__device__ __forceinline__ float sum16(float v) { v = sum8(v); v += dpp_f(v, 3); return v; }
#define WAVE_LDS_SYNC() asm volatile("s_waitcnt lgkmcnt(0)" ::: "memory")
#define LDS_BARRIER() do { asm volatile("s_waitcnt lgkmcnt(0)" ::: "memory"); __builtin_amdgcn_s_barrier(); asm volatile("" ::: "memory"); } while (0)
__device__ __forceinline__ int otid() { int t = threadIdx.x; asm volatile("" : "+v"(t)); return t; }
__device__ __forceinline__ int oint(int v) { asm volatile("" : "+s"(v)); return v; }
__device__ __forceinline__ const void* okarg() { auto p = __builtin_amdgcn_kernarg_segment_ptr(); asm volatile("" : "+s"(p)); return (const void*)p; }

struct Args { const float* in[29]; float* out; unsigned char* ws; int ph_lo, ph_hi; };
enum { I_X = 0, I_P, I_GMIX, I_WIN, I_BIN, I_WCQK, I_BCQK, I_GMH, I_WCR, I_BCR, I_WRA, I_BRA, I_WRI, I_BRI, I_LAM, I_GR, I_WOUT, I_GFFN,
       I_WFG, I_WFU, I_WFD, I_WROUTER, I_WEG, I_WEU, I_WED, I_GPLE, I_WPG, I_WPP, I_GFINAL };


#define XB_TMO      128
#define XB_XCNT(j)  (256  + 64 * (j))
#define XB_XSUB(j)  (1280 + 64 * (j))
#define XB_XGEN(j)  (2304 + 64 * (j))
#define XB_TOP      3328
#define XB_TOPGEN   3392
#define XCD_BAR_WORDS 3456
#define XB_SPIN_CAP (1u << 18)
#define LAS __attribute__((address_space(3)))
__device__ __forceinline__ unsigned xb_ld(unsigned* p)              { return __hip_atomic_load(p, __ATOMIC_RELAXED, __HIP_MEMORY_SCOPE_AGENT); }
__device__ __forceinline__ unsigned xb_add(unsigned* p, unsigned v) { return __hip_atomic_fetch_add(p, v, __ATOMIC_RELAXED, __HIP_MEMORY_SCOPE_AGENT); }
__device__ __forceinline__ unsigned xb_xcc_id() { return (unsigned)__builtin_amdgcn_s_getreg((3 << 11) | 20) & 0xFu; }
#define XB_SPIN(cond, bar) do { unsigned _sp = 0; while (cond) { __builtin_amdgcn_s_sleep(1); \
    if ((++_sp & 255u) == 0u) { if (xb_ld(&(bar)[XB_TMO])) break; if (_sp > XB_SPIN_CAP) { atomicAdd(&(bar)[XB_TMO], 1u); break; } } } } while (0)
struct XcdBarrier { unsigned* bar; unsigned x; volatile LAS unsigned* st; };
__device__ __forceinline__ XcdBarrier xcd_barrier_post(unsigned* bar, volatile LAS unsigned* st) {
    XcdBarrier b; b.bar = bar; b.x = xb_xcc_id(); b.st = st;
    if (threadIdx.x == 0) (void)xb_add(&bar[XB_XCNT(b.x)], 1u);
    return b;
}
__device__ __forceinline__ void xcd_barrier_complete(unsigned* bar, unsigned x, unsigned& nloc, unsigned& nx) {
    const unsigned G = gridDim.x * gridDim.y * gridDim.z;
    unsigned sum, cnt, mine, sp = 0u;
    for (;;) {
        sum = 0u; cnt = 0u; mine = 0u;
#pragma unroll
        for (unsigned j = 0; j < 16; ++j) { const unsigned c = xb_ld(&bar[XB_XCNT(j)]); sum += c; cnt += (c > 0u) ? 1u : 0u; mine = (j == x) ? c : mine; }
        if (sum == G) break;
        __builtin_amdgcn_s_sleep(1);
        if ((++sp & 255u) == 0u) { if (xb_ld(&bar[XB_TMO])) break; if (sp > XB_SPIN_CAP) { atomicAdd(&bar[XB_TMO], 1u); break; } }
    }
    nloc = mine > 0u ? mine : 1u; nx = cnt > 0u ? cnt : 1u;
}
__device__ __forceinline__ void xcd_barrier(const XcdBarrier& b) {
    asm volatile("s_waitcnt vmcnt(0)" ::: "memory");
    __syncthreads();
    if (threadIdx.x == 0) {
        unsigned* bar = b.bar;
        __builtin_amdgcn_s_waitcnt(0);
        unsigned nloc = b.st[0], nx = b.st[1];
        if (nloc == 0u) { xcd_barrier_complete(bar, b.x, nloc, nx); b.st[0] = nloc; b.st[1] = nx; }
        const unsigned old = xb_add(&bar[XB_XSUB(b.x)], 1u);
        const unsigned gen = old / nloc;
        if (old + 1u == (gen + 1u) * nloc) {
            __builtin_amdgcn_fence(__ATOMIC_RELEASE, "agent");
            asm volatile("s_waitcnt vmcnt(0)" ::: "memory");
            const unsigned og = xb_add(&bar[XB_TOP], 1u);
            const unsigned tg = og / nx;
            if (og + 1u == (tg + 1u) * nx) xb_add(&bar[XB_TOPGEN], 1u);
            else XB_SPIN(xb_ld(&bar[XB_TOPGEN]) == tg, bar);
            __builtin_amdgcn_fence(__ATOMIC_ACQUIRE, "agent");
            xb_add(&bar[XB_XGEN(b.x)], 1u);
            asm volatile("s_waitcnt vmcnt(0)" ::: "memory");
        } else {
            XB_SPIN(xb_ld(&bar[XB_XGEN(b.x)]) == gen, bar);
            __builtin_amdgcn_fence(__ATOMIC_ACQUIRE, "agent");
            asm volatile("s_waitcnt vmcnt(0)" ::: "memory");
        }
    }
    __syncthreads();
}

struct CvtJob { const float* src; bf16_t* dst; int ld, k0, c0, K, n0; const float* gain; int fp8; };
__device__ __forceinline__ void cvt_plain_job(CvtJob& o, const float* src, int K, int N, bf16_t* dst, int tile, const float* gain) {
    const int nt = N / 64, kb = tile / nt, nb = tile % nt; o.src = src; o.dst = dst; o.ld = N; o.k0 = kb * 64; o.c0 = nb * 64; o.K = K; o.n0 = nb * 64; o.gain = gain; o.fp8 = 0;
}
__device__ __forceinline__ void cvt_gu_job(CvtJob& o, const float* g, const float* u, bf16_t* dst, int tile, const float* gain) {
    const int nt = 5632 / 64, kb = tile / nt, nb = tile % nt, n0 = nb * 64, tt = n0 >> 8, half = (n0 >> 7) & 1, w = n0 & 127;
    o.src = half ? u : g; o.dst = dst; o.ld = DFF; o.k0 = kb * 64; o.c0 = tt * 128 + w; o.K = 1024; o.n0 = n0; o.gain = gain; o.fp8 = 0;
}
__device__ __forceinline__ void cvt_job(const Args& a, int it, CvtJob& o) {
    unsigned char* ws = a.ws;
    constexpr int T_IN = 16 * 48, T_OUT = 16 * 16, T_GU = 16 * 88, T_FD = 44 * 16, T_PG = 256, T_PP = 4 * 16;
    int r = it;
    if (r < 2 * T_IN) { const int l = r / T_IN, tile = r % T_IN; const int nt = ZW / 64, kb = tile / nt, nb = tile % nt, n0 = nb * 64;
        o.src = a.in[I_WIN] + (size_t)l * D * DIN; o.dst = (bf16_t*)(ws + (l ? WS_W_IN1 : WS_W_IN0)); o.ld = DIN; o.k0 = kb * 64; o.c0 = n0 < 2048 ? n0 : n0 + 8; o.K = D; o.n0 = n0; o.gain = a.in[I_GMIX] + l * D; o.fp8 = 0; return; }
    r -= 2 * T_IN;
    if (r < 2 * T_OUT) { const int l = r / T_OUT; cvt_plain_job(o, a.in[I_WOUT] + (size_t)l * D * D, D, D, (bf16_t*)(ws + (l ? WS_W_OUT1 : WS_W_OUT0)), r % T_OUT, nullptr); return; }
    r -= 2 * T_OUT;
    if (r < T_GU) { cvt_gu_job(o, a.in[I_WFG], a.in[I_WFU], (bf16_t*)(ws + WS_W_FFGU), r, a.in[I_GFFN]); return; }
    r -= T_GU;
    if (r < T_FD) { cvt_plain_job(o, a.in[I_WFD], DFF, D, (bf16_t*)(ws + WS_W_FFD), r, nullptr); return; }
    r -= T_FD;
    if (r < 2 * T_PG) { const int l = r / T_PG; cvt_plain_job(o, a.in[I_WPG] + (size_t)l * D * D, D, D, (bf16_t*)(ws + WS_W_PG) + (size_t)l * D * D, r % T_PG, a.in[I_GPLE] + l * D); return; }
    r -= 2 * T_PG;
    if (r < 2 * T_PP) { const int l = r / T_PP; cvt_plain_job(o, a.in[I_WPP] + (size_t)l * DPLE * D, DPLE, D, (bf16_t*)(ws + (l ? WS_W_PP1 : WS_W_PP0)), r % T_PP, nullptr); return; }
    r -= 2 * T_PP;
    if (r < 8 * T_GU) { const int e = r / T_GU; cvt_gu_job(o, a.in[I_WEG] + (size_t)e * D * DFF, a.in[I_WEU] + (size_t)e * D * DFF, (bf16_t*)(ws + WS_W_EGU + (size_t)e * 5632 * D), r % T_GU, nullptr); o.fp8 = 1; return; }
    r -= 8 * T_GU;
    { const int e = r / T_FD; cvt_plain_job(o, a.in[I_WED] + (size_t)e * DFF * D, DFF, D, (bf16_t*)(ws + WS_W_ED + (size_t)e * D * DFF), r % T_FD, nullptr); o.fp8 = 1; }
}
__device__ __forceinline__ void phase_prologue(const Args& a, unsigned char* lds) {
    unsigned char* ws = a.ws;
    const int G = gridDim.x, t = otid();
    constexpr int T_IN = 16 * 48, T_OUT = 16 * 16, T_GU = 16 * 88, T_FD = 44 * 16, T_PG = 256, T_PP = 4 * 16;
    constexpr int NT_ALL = 2 * T_IN + 2 * T_OUT + T_GU + T_FD + 2 * T_PG + 2 * T_PP + 8 * T_GU + 8 * T_FD;
    constexpr int NB = 4;
    const int kk0 = t >> 4, cc = (t & 15) * 4, n = t >> 3, kg = t & 7;
    float4 v[NB][2], vn[NB][2];
    int it0 = blockIdx.x * NB;
    if (it0 < NT_ALL) {
#pragma unroll
        for (int b = 0; b < NB; ++b) { const int it = it0 + b < NT_ALL ? it0 + b : NT_ALL - 1; CvtJob jq; cvt_job(a, it, jq);
#pragma unroll
            for (int j = 0; j < 2; ++j) v[b][j] = *(const float4*)(jq.src + (size_t)(jq.k0 + kk0 + 32 * j) * jq.ld + jq.c0 + cc); }
    }
    for (; it0 < NT_ALL; it0 += G * NB) {
        const int itn = it0 + G * NB;
        if (itn < NT_ALL) {
#pragma unroll
            for (int b = 0; b < NB; ++b) { const int it = itn + b < NT_ALL ? itn + b : NT_ALL - 1; CvtJob jq; cvt_job(a, it, jq);
#pragma unroll
                for (int j = 0; j < 2; ++j) vn[b][j] = *(const float4*)(jq.src + (size_t)(jq.k0 + kk0 + 32 * j) * jq.ld + jq.c0 + cc); }
        }
#pragma unroll
        for (int b = 0; b < NB; ++b) { float* tl = (float*)lds + b * (64 * 65); const int it = it0 + b < NT_ALL ? it0 + b : NT_ALL - 1; CvtJob jq; cvt_job(a, it, jq);
#pragma unroll
            for (int j = 0; j < 2; ++j) { float4 w = v[b][j];
                if (jq.gain) { const float gk = jq.gain[jq.k0 + kk0 + 32 * j]; w.x *= gk; w.y *= gk; w.z *= gk; w.w *= gk; }
                float* p = tl + (kk0 + 32 * j) * 65 + cc; p[0] = w.x; p[1] = w.y; p[2] = w.z; p[3] = w.w; } }
        LDS_BARRIER();
#pragma unroll
        for (int b = 0; b < NB; ++b) { if (it0 + b >= NT_ALL) break; const float* s_ = (const float*)lds + b * (64 * 65) + (8 * kg) * 65 + n; CvtJob jq; cvt_job(a, it0 + b, jq);
            if (jq.fp8) { u32x2 o; o.x = pk4_fp8(32.f * s_[0], 32.f * s_[65], 32.f * s_[130], 32.f * s_[195]); o.y = pk4_fp8(32.f * s_[260], 32.f * s_[325], 32.f * s_[390], 32.f * s_[455]);
                *(u32x2*)((unsigned char*)jq.dst + (size_t)(jq.n0 + n) * jq.K + jq.k0 + 8 * kg) = o; }
            else { u32x4 o; o.x = pk2(s_[0], s_[65]); o.y = pk2(s_[130], s_[195]); o.z = pk2(s_[260], s_[325]); o.w = pk2(s_[390], s_[455]);
                *(u32x4*)(jq.dst + (size_t)(jq.n0 + n) * jq.K + jq.k0 + 8 * kg) = o; } }
        LDS_BARRIER();
#pragma unroll
        for (int b = 0; b < NB; ++b) { v[b][0] = vn[b][0]; v[b][1] = vn[b][1]; }
    }
    const size_t np4 = (size_t)M * DPLE / 4;
    for (size_t i = (size_t)blockIdx.x * NT + otid(); i < 2 * np4; i += (size_t)G * NT) {
        const float4 v = ((const float4*)a.in[I_P])[i]; u32x2 o; o.x = pk2(v.x, v.y); o.y = pk2(v.z, v.w);
        if (i < np4) ((u32x2*)(ws + WS_PB0))[i] = o; else ((u32x2*)(ws + WS_PB1))[i - np4] = o; }
    for (int i = blockIdx.x * NT + otid(); i < 2 * 8 * 2 * 64 * 64; i += G * NT) {
        const int d = i & 63, e = (i >> 6) & 63, g = (i >> 12) & 1, ln = i >> 13;
        ((bf16_t*)(ws + WS_SMALL + SM_RGW))[i] = (bf16_t)f2bf((g ? a.in[I_WRI] : a.in[I_WRA])[((size_t)ln * 64 + d) * 64 + e]);
    }
    if (blockIdx.x == 0) { for (int i = otid(); i < D / 4; i += NT) ((unsigned*)(ws + WS_HN8 + (size_t)M * D))[i] = 0u; for (int i = otid(); i < D / 2; i += NT) ((unsigned*)(ws + WS_HN + (size_t)M * D * 2))[i] = 0u; if (otid() < 32) ((float*)(ws + WS_SSQ + (otid() >> 4) * SSQ_STRIDE))[(size_t)M * 16 + (otid() & 15)] = 0.f; }
    for (int i = blockIdx.x * NT + otid(); i < PMAX; i += G * NT) { ((int*)(ws + WS_SMALL + SM_ROWTOK))[i] = M; ((float*)(ws + WS_SMALL + SM_ROWGATE))[i] = 0.f; }
}

template <int IN, bool ADDY> struct RawRow {
    f32x4 x[IN == 0 ? 4 : 1]; u32x2 h[IN == 1 ? 4 : 1]; u32x2 y[ADDY ? 4 : 1];
    __device__ __forceinline__ void load(const float* xin, const bf16_t* hb, const bf16_t* y1, int r, int lane) {
#pragma unroll
        for (int j = 0; j < 4; ++j) {
            if (IN == 0) x[j] = ((const f32x4*)(xin + (size_t)r * D) + lane)[64 * j]; else h[j] = ((const u32x2*)(hb + (size_t)r * D) + lane)[64 * j];
            if (ADDY) y[j] = ((const u32x2*)(y1 + (size_t)r * D) + lane)[64 * j]; }
    }
    __device__ __forceinline__ void copy_from(const RawRow& o) {
#pragma unroll
        for (int j = 0; j < 4; ++j) { if (IN == 0) x[j] = o.x[j]; else h[j] = o.h[j]; if (ADDY) y[j] = o.y[j]; }
    }
};
template <int IN, int AUX, int WR, bool ADDY>
__device__ __forceinline__ void phase_rowpass(unsigned char* lds, const float* xin, bf16_t* hb, const bf16_t* y1, const float* g, float* ssq,
                                              const float* auxW, int auxld, const float* auxB, float* gates, unsigned char* tok_p, float* tok_g, float* fout, unsigned char* h8 = nullptr) {
    float* wl = (float*)lds;
    const int tid = otid(), lane = tid & 63, wave = tid >> 6;
    if (AUX) {
        for (int i = tid; i < D * 8; i += NT) wl[i] = auxW[(size_t)(i >> 3) * auxld + (i & 7)];
        __syncthreads();
    }
    f32x4 gv[4];
    if (AUX || WR == 2) {
#pragma unroll
        for (int j = 0; j < 4; ++j) gv[j] = *(const f32x4*)(g + 4 * lane + 256 * j);
    }
    RawRow<1, ADDY> cur, nxt;
    const int rstep = gridDim.x * 8; int row = blockIdx.x * 8 + wave;
    if (IN == 1) { if (row < M) cur.load(xin, hb, y1, row, lane); nxt.copy_from(cur); }
    for (; row < M; row += rstep) {
        if (IN == 1) { if (row + rstep < M) nxt.load(xin, hb, y1, row + rstep, lane); }
        f32x4 v[4]; float ss = 0.f;
#pragma unroll
        for (int j = 0; j < 4; ++j) {
            if (IN == 0) v[j] = ((const f32x4*)(xin + (size_t)row * D) + lane)[64 * j];
            else { const u32x2 w = cur.h[j]; v[j] = (f32x4){bf2f(w.x & 0xffffu), __uint_as_float(w.x & 0xffff0000u), bf2f(w.y & 0xffffu), __uint_as_float(w.y & 0xffff0000u)}; }
            if (ADDY) { const u32x2 y = cur.y[j];
                v[j].x += bf2f(y.x & 0xffffu); v[j].y += __uint_as_float(y.x & 0xffff0000u); v[j].z += bf2f(y.y & 0xffffu); v[j].w += __uint_as_float(y.y & 0xffff0000u); }
            ss += (v[j].x * v[j].x + v[j].y * v[j].y) + (v[j].z * v[j].z + v[j].w * v[j].w); }
        if (IN == 1) cur.copy_from(nxt);
        float tot; { const int ri = __float_as_int(sum16(ss)); tot = (__int_as_float(__builtin_amdgcn_readlane(ri, 0)) + __int_as_float(__builtin_amdgcn_readlane(ri, 16))) + (__int_as_float(__builtin_amdgcn_readlane(ri, 32)) + __int_as_float(__builtin_amdgcn_readlane(ri, 48))); }
        const float rstd = __builtin_amdgcn_rsqf(tot * (1.f / D) + EPS);
        if (WR == 1) {
            u32x2* o = (u32x2*)(hb + (size_t)row * D) + lane;
#pragma unroll
            for (int j = 0; j < 4; ++j) { u32x2 w; w.x = pk2(v[j].x, v[j].y); w.y = pk2(v[j].z, v[j].w); o[64 * j] = w; }
            if (lane < 16) ssq[(size_t)row * 16 + lane] = lane == 0 ? tot : 0.f;
        }
        if (AUX || WR == 2) {
#pragma unroll
            for (int j = 0; j < 4; ++j) v[j] = v[j] * rstd * gv[j];
        }
        if (AUX == 2 && h8) {
#pragma unroll
            for (int j = 0; j < 4; ++j) ((unsigned*)(h8 + (size_t)row * D) + lane)[64 * j] = pk4_fp8(v[j].x, v[j].y, v[j].z, v[j].w);
        }
        if (WR == 2) {
            f32x4* o = (f32x4*)(fout + (size_t)row * D) + lane;
#pragma unroll
            for (int j = 0; j < 4; ++j) o[64 * j] = v[j];
        }
        if (AUX) {
            float acc[8];
#pragma unroll
            for (int c = 0; c < 8; ++c) acc[c] = 0.f;
#pragma unroll
            for (int j = 0; j < 4; ++j)
#pragma unroll
                for (int q = 0; q < 4; ++q) {
                    const int k = 4 * lane + 256 * j + q; const float xv = v[j][q];
                    const f32x4 w0 = *(const f32x4*)(wl + k * 8), w1 = *(const f32x4*)(wl + k * 8 + 4);
                    acc[0] += xv * w0.x; acc[1] += xv * w0.y; acc[2] += xv * w0.z; acc[3] += xv * w0.w;
                    acc[4] += xv * w1.x; acc[5] += xv * w1.y; acc[6] += xv * w1.z; acc[7] += xv * w1.w;
                }
#pragma unroll
            for (int c = 0; c < 8; ++c) { const float r16 = sum16(acc[c]); const int ri = __float_as_int(r16);
                acc[c] = (__int_as_float(__builtin_amdgcn_readlane(ri, 0)) + __int_as_float(__builtin_amdgcn_readlane(ri, 16))) + (__int_as_float(__builtin_amdgcn_readlane(ri, 32)) + __int_as_float(__builtin_amdgcn_readlane(ri, 48))); }
            if (AUX == 1) {
                if (lane < 8) { float s_ = acc[0];
#pragma unroll
                    for (int c = 1; c < 8; ++c) s_ = (lane == c) ? acc[c] : s_;
                    gates[(size_t)row * 8 + lane] = s_ + auxB[lane]; }
            } else {
                if (lane == 0) {
                    int e1 = 0; float v1 = acc[0];
#pragma unroll
                    for (int c = 1; c < 8; ++c) if (acc[c] > v1) { v1 = acc[c]; e1 = c; }
                    int e2 = -1; float v2 = -INFINITY;
#pragma unroll
                    for (int c = 0; c < 8; ++c) if (c != e1 && acc[c] > v2) { v2 = acc[c]; e2 = c; }
                    const float p2 = __expf(v2 - v1), inv = 1.f / (1.f + p2);
                    tok_p[row] = (unsigned char)(e1 | (e2 << 4)); tok_g[row * 2] = inv; tok_g[row * 2 + 1] = p2 * inv;
                }
            }
        }
    }
    __syncthreads();
}

struct Unit { int pm, pn; const int* rows; size_t bofs; };
struct GridOrder {
    static constexpr bool GATHER = false;
    int nM, nN, G, c;
    __device__ __forceinline__ bool next(int i, Unit& u) const {
        const int L0_ = i * G + c, nwg = nM * nN; if (L0_ >= nwg) return false;
        const int q_ = nwg / 8, r_ = nwg % 8, xcd = L0_ % 8, off = L0_ / 8; const int L = (xcd < r_ ? xcd * (q_ + 1) : r_ * (q_ + 1) + (xcd - r_) * q_) + off;
        const int grp = L / (8 * nN), fm = grp * 8, gsz = (nM - fm) < 8 ? (nM - fm) : 8, w = L % (8 * nN);
        u.pm = fm + w % gsz; u.pn = w / gsz; u.rows = nullptr; u.bofs = 0; return true;
    }
};
struct TailOrder {
    static constexpr bool GATHER = false;
    int nM, nN, G, c, first;
    __device__ __forceinline__ bool next(int i, Unit& u) const {
        if (c < first) return false; const int L = i * (G - first) + (c - first); if (L >= nM * nN) return false;
        u.pm = L / nN; u.pn = L % nN; u.rows = nullptr; u.bofs = 0; return true;
    }
};
template <bool GATHER_> struct MoeOrder {
    static constexpr bool GATHER = GATHER_;
    int nM, nN, G, c; const int* rows; size_t estride; int te[8];
    __device__ __forceinline__ void init(const int* tile_e) {
#pragma unroll
        for (int e = 0; e < 8; ++e) te[e] = __builtin_amdgcn_readfirstlane(tile_e[256 + e]);
    }
    __device__ __forceinline__ bool next(int i, Unit& u) const {
        const int L0_ = i * G + c, nwg = nM * nN; if (L0_ >= nwg) return false;
        const int q_ = nwg / 8, r_ = nwg % 8, xcd = L0_ % 8, off = L0_ / 8; const int L = (xcd < r_ ? xcd * (q_ + 1) : r_ * (q_ + 1) + (xcd - r_) * q_) + off;
        const int grp = L / (8 * nN), fm = grp * 8, gsz = (nM - fm) < 8 ? (nM - fm) : 8, w = L % (8 * nN);
        u.pm = fm + w % gsz; u.pn = w / gsz; u.rows = rows; int e = 0;
#pragma unroll
        for (int q = 0; q < 7; ++q) e += (u.pm >= te[q]) ? 1 : 0;
        u.bofs = (size_t)e * estride; return true;
    }
};


namespace pg8 {
#define PG8_LAS __attribute__((address_space(3)))
typedef short bf16x8 __attribute__((ext_vector_type(8)));
constexpr int BM = 256, BK = 64, HALF = 128, HTB = HALF * BK * 2, STAGE_BYTES = 8 * HTB;
__device__ __forceinline__ int lds_byte(int r, int c) { const int st = (r >> 4) * 2 + (c >> 5), rr = r & 15, cc = c & 31, ob = rr * 64 + cc * 2; return st * 1024 + (ob ^ (((ob >> 9) & 1) << 5)); }
__device__ __forceinline__ void stage_rc(int b, int& R, int& C) { const int st = b / 1024, sb = b % 1024, swz = sb ^ (((sb >> 9) & 1) << 5); R = (st >> 1) * 16 + swz / 64; C = (st & 1) * 32 + (swz % 64) / 2; }

typedef int i32x8 __attribute__((ext_vector_type(8))); typedef int i32x4 __attribute__((ext_vector_type(4)));
__device__ __forceinline__ i32x8 cat8(bf16x8 lo, bf16x8 hi) { return __builtin_shufflevector(__builtin_bit_cast(i32x4, lo), __builtin_bit_cast(i32x4, hi), 0, 1, 2, 3, 4, 5, 6, 7); }
__device__ __forceinline__ int perm32(int rho) { const int n = rho >> 4, i = rho & 15; return 8 * (i >> 2) + 4 * n + (i & 3); }
__device__ __forceinline__ void unit_voff(const Unit& u, const int (&R)[2], const int (&C)[2], int KB  , unsigned (&vo)[2][2]) {
#pragma unroll
    for (int h = 0; h < 2; ++h)
#pragma unroll
        for (int i = 0; i < 2; ++i) { int row = u.pm * BM + h * HALF + R[i]; if (u.rows) row = u.rows[row]; vo[h][i] = (unsigned)row * (unsigned)KB + (unsigned)C[i] * 2u; }
}

template <class Epi, class Sched, bool ALIGN_EPI, bool GATHER, bool FP8 = false>
__device__ __forceinline__ void gemm_phase(unsigned char* lds_, const bf16_t* A_, const bf16_t* Bt_, const int K_, const Sched& S, const Epi& E) {
    PG8_LAS unsigned char* lds = (PG8_LAS unsigned char*)lds_;
    const int K = oint(K_);
    const int tid = otid(), wid = __builtin_amdgcn_readfirstlane(tid >> 6), lane = tid & 63, wr = wid >> 2, wc = wid & 3, fr = lane & 15, fq = lane >> 4;
    const int KB = FP8 ? K : 2 * K;
    const int nt = KB / (BK * 2);
    int R[2], C[2]; unsigned voffA[2], voffB[2];
#pragma unroll
    for (int i = 0; i < 2; ++i) { stage_rc(tid * 16 + i * 8192, R[i], C[i]); voffA[i] = (unsigned)(R[i] * KB + C[i] * 2);
        const int Rb = Epi::PERM ? ((R[i] & ~31) + perm32(R[i] & 31)) : R[i]; voffB[i] = (unsigned)(Rb * KB + C[i] * 2); }
    const size_t kstep = (size_t)(BK * 2);
    const size_t hstep = (size_t)HALF * KB;
    const size_t tstep = 2 * hstep;
    const unsigned ldsw = (unsigned)wid * 1024u;
    const int pc0 = FP8 ? 32 * (fq >> 1) + 16 * (fq & 1) : fq * 8; constexpr int KOFF = FP8 ? 16 : 1024;
    const int aoff = lds_byte(wr * 64 + fr, pc0), boff = lds_byte(wc * 32 + fr, pc0);
#define PG8_SA(b, h) (((b) * 2 + (h)) * HTB)
#define PG8_SB(b, h) ((4 + (b) * 2 + (h)) * HTB)
#define PG8_STAGE(bufoff, gbase, voff) do { _Pragma("unroll") for (int _i = 0; _i < 2; ++_i) \
        __builtin_amdgcn_global_load_lds((const unsigned*)((const char*)(gbase) + (voff)[_i]), (PG8_LAS unsigned*)(lds + (bufoff) + ldsw + _i * 8192), 16, 0, 0); } while (0)
#define PG8_STAGE_A(bufoff, base, h, VO) do { if constexpr (GATHER) { PG8_STAGE(bufoff, base, (VO)[h]); } else { PG8_STAGE(bufoff, (base) + (h) * hstep, voffA); } } while (0)
#define PG8_LDA(dst, b, h) do { _Pragma("unroll") for (int m = 0; m < 4; ++m) _Pragma("unroll") for (int k = 0; k < 2; ++k) dst[m][k] = *(const PG8_LAS bf16x8*)(lds + PG8_SA(b, h) + aoff + m * 2048 + k * KOFF); } while (0)
#define PG8_LDB(dst, b, h) do { _Pragma("unroll") for (int n = 0; n < 2; ++n) _Pragma("unroll") for (int k = 0; k < 2; ++k) dst[n][k] = *(const PG8_LAS bf16x8*)(lds + PG8_SB(b, h) + boff + n * 2048 + k * KOFF); } while (0)
#define PG8_MMA(ai, bj, At, Bt) do { __builtin_amdgcn_s_setprio(1); _Pragma("unroll") for (int m = 0; m < 4; ++m) _Pragma("unroll") for (int n = 0; n < 2; ++n) { \
        if constexpr (FP8) { const i32x8 b8_ = cat8(Bt[n][0], Bt[n][1]), a8_ = cat8(At[m][0], At[m][1]); \
            asm volatile("v_mfma_scale_f32_16x16x128_f8f6f4 %0, %1, %2, %0, %3, %3 op_sel_hi:[0,0,0]" : "+v"(acc[ai][bj][m][n]) : "v"(b8_), "v"(a8_), "v"(scale1)); } \
        else { _Pragma("unroll") for (int k = 0; k < 2; ++k) acc[ai][bj][m][n] = __builtin_amdgcn_mfma_f32_16x16x32_bf16(Bt[n][k], At[m][k], acc[ai][bj][m][n], 0, 0, 0); } } __builtin_amdgcn_s_setprio(0); } while (0)
#define PG8_WAIT_V(n) asm volatile("s_waitcnt vmcnt(" #n ")" ::: "memory")
#define PG8_WAIT_L(n) asm volatile("s_waitcnt lgkmcnt(" #n ")" ::: "memory")
#define PG8_BAR __builtin_amdgcn_s_barrier()
#define PG8_SCHED __builtin_amdgcn_sched_barrier(0)
    const int scale1 = 0x7f7f7f7f;
    Unit cur, nxt; int ui = 0;
    if (!S.next(0, cur)) return;
    f32x4 acc[2][2][4][2];
#pragma unroll
    for (int a = 0; a < 2; ++a)
#pragma unroll
        for (int b = 0; b < 2; ++b)
#pragma unroll
            for (int m = 0; m < 4; ++m)
#pragma unroll
                for (int n = 0; n < 2; ++n) acc[a][b][m][n] = (f32x4){0.f, 0.f, 0.f, 0.f};
    bf16x8 At[4][2], B0[2][2], B1[2][2];
    unsigned vc[2][2], vn[2][2];
    if constexpr (GATHER) unit_voff(cur, R, C, KB, vc);
    const char* cA = GATHER ? (const char*)A_ : (const char*)A_ + (size_t)cur.pm * tstep;
    const char* cB = (const char*)Bt_ + cur.bofs * (FP8 ? 1 : 2) + (size_t)cur.pn * tstep;
    PG8_STAGE(PG8_SB(0, 0), cB, voffB); PG8_STAGE(PG8_SB(0, 1), cB + hstep, voffB); PG8_STAGE_A(PG8_SA(0, 0), cA, 0, vc); PG8_STAGE_A(PG8_SA(0, 1), cA, 1, vc);
    if (wr == 1) PG8_BAR;
    PG8_WAIT_V(2); PG8_BAR;
    PG8_STAGE(PG8_SB(1, 0), cB + kstep, voffB); PG8_STAGE_A(PG8_SA(1, 0), cA + kstep, 0, vc); PG8_STAGE(PG8_SB(1, 1), cB + hstep + kstep, voffB);
    PG8_WAIT_V(6); PG8_BAR;
    for (;;) {
        const bool has_next = S.next(ui + 1, nxt);
        const char* nA = cA; const char* nB = cB;
        if (has_next) { nB = (const char*)Bt_ + nxt.bofs * (FP8 ? 1 : 2) + (size_t)nxt.pn * tstep; if constexpr (!GATHER) nA = (const char*)A_ + (size_t)nxt.pm * tstep; }
        int rn[2][2];
        if constexpr (GATHER) {
#pragma unroll
            for (int h = 0; h < 2; ++h)
#pragma unroll
                for (int i = 0; i < 2; ++i) rn[h][i] = cur.rows[(has_next ? nxt.pm : cur.pm) * BM + h * HALF + R[i]]; }
        for (int t = 0; t < nt; t += 2) {
            const bool last = (t == nt - 2);
            if constexpr (GATHER) { if (last) {
#pragma unroll
                for (int h = 0; h < 2; ++h)
#pragma unroll
                    for (int i = 0; i < 2; ++i) { int r_ = rn[h][i]; asm volatile("" : "+v"(r_));
                        vn[h][i] = (unsigned)r_ * (unsigned)KB + (unsigned)C[i] * 2u; } } }
            const char* a1 = cA + (size_t)(t + 1) * kstep;
            const char* a2 = last ? nA : cA + (size_t)(t + 2) * kstep; const char* b2 = last ? nB : cB + (size_t)(t + 2) * kstep;
            const char* a3 = a2 + kstep; const char* b3 = b2 + kstep;
            unsigned v2[2][2];
            if constexpr (GATHER) {
#pragma unroll
                for (int h = 0; h < 2; ++h)
#pragma unroll
                    for (int i = 0; i < 2; ++i) v2[h][i] = last ? vn[h][i] : vc[h][i]; }
            PG8_LDB(B0, 0, 0); PG8_LDB(B1, 0, 1); PG8_SCHED; PG8_LDA(At, 0, 0); PG8_STAGE_A(PG8_SA(1, 1), a1, 1, vc);
            PG8_WAIT_V(8); PG8_WAIT_L(0); PG8_BAR; PG8_MMA(0, 0, At, B0); PG8_MMA(0, 1, At, B1); PG8_BAR; PG8_SCHED;
            PG8_LDA(At, 0, 1); PG8_STAGE(PG8_SB(0, 0), b2, voffB); PG8_STAGE(PG8_SB(0, 1), b2 + hstep, voffB); PG8_STAGE_A(PG8_SA(0, 0), a2, 0, v2);
            PG8_WAIT_V(8); PG8_WAIT_L(0); PG8_BAR; PG8_MMA(1, 0, At, B0); PG8_MMA(1, 1, At, B1); PG8_BAR; PG8_SCHED;
            PG8_LDB(B0, 1, 0); PG8_LDB(B1, 1, 1); PG8_SCHED; PG8_LDA(At, 1, 0); PG8_STAGE_A(PG8_SA(0, 1), a2, 1, v2);
            PG8_WAIT_V(8); PG8_WAIT_L(0); PG8_BAR; PG8_MMA(0, 0, At, B0); PG8_MMA(0, 1, At, B1); PG8_BAR; PG8_SCHED;
            PG8_LDA(At, 1, 1); PG8_STAGE(PG8_SB(1, 0), b3, voffB); PG8_STAGE(PG8_SB(1, 1), b3 + hstep, voffB); PG8_STAGE_A(PG8_SA(1, 0), a3, 0, v2);
            PG8_WAIT_V(8); PG8_WAIT_L(0); PG8_BAR; PG8_MMA(1, 0, At, B0); PG8_MMA(1, 1, At, B1); PG8_BAR; PG8_SCHED;
        }
        if constexpr (ALIGN_EPI) { if (wr == 0) PG8_BAR; }
        { int pm_ = cur.pm, pn_ = cur.pn, fr_ = fr, fq_ = fq;
          asm volatile("" : "+s"(pm_), "+s"(pn_), "+v"(fr_), "+v"(fq_));
          E(acc, pm_, pn_, wr, wc, fr_, fq_); }
        if (!has_next) break;
#pragma unroll
        for (int a = 0; a < 2; ++a)
#pragma unroll
            for (int b = 0; b < 2; ++b)
#pragma unroll
                for (int m = 0; m < 4; ++m)
#pragma unroll
                    for (int n = 0; n < 2; ++n) acc[a][b][m][n] = (f32x4){0.f, 0.f, 0.f, 0.f};
        cur = nxt; cA = nA; cB = nB; ++ui;
        if constexpr (GATHER) {
#pragma unroll
            for (int h = 0; h < 2; ++h)
#pragma unroll
                for (int i = 0; i < 2; ++i) vc[h][i] = vn[h][i]; }
        if constexpr (ALIGN_EPI) { if (wr == 1) PG8_BAR; }
    }
    PG8_WAIT_V(0);
    if constexpr (!ALIGN_EPI) { if (wr == 0) PG8_BAR; }
    PG8_BAR;
#undef PG8_SA
#undef PG8_SB
#undef PG8_STAGE
#undef PG8_STAGE_A
#undef PG8_LDA
#undef PG8_LDB
#undef PG8_MMA
#undef PG8_WAIT_V
#undef PG8_WAIT_L
#undef PG8_BAR
#undef PG8_SCHED
}
}
template <bool FP8 = false, class Epi, class Sched>
__device__ __forceinline__ void gemm_fast(unsigned char* lds, const bf16_t* A, const bf16_t* Bt, int K, const Sched& S, const Epi& E) {
    pg8::gemm_phase<Epi, Sched, true, Sched::GATHER, FP8>(lds, A, Bt, K, S, E);
    __syncthreads();
}

typedef f32x4 AccT[2][2][4][2];
#define EPI_ROW(ai, m) (pm * 256 + (ai) * 128 + wr * 64 + (m) * 16 + fr)
__device__ __forceinline__ void unpack8(const u32x4 w, f32x4& lo, f32x4& hi) {
    lo = (f32x4){bf2f(w.x & 0xffffu), __uint_as_float(w.x & 0xffff0000u), bf2f(w.y & 0xffffu), __uint_as_float(w.y & 0xffff0000u)};
    hi = (f32x4){bf2f(w.z & 0xffffu), __uint_as_float(w.z & 0xffff0000u), bf2f(w.w & 0xffffu), __uint_as_float(w.w & 0xffff0000u)};
}
__device__ __forceinline__ u32x4 pack8(const f32x4 v0, const f32x4 v1) { u32x4 w; w.x = pk2(v0.x, v0.y); w.y = pk2(v0.z, v0.w); w.z = pk2(v1.x, v1.y); w.w = pk2(v1.z, v1.w); return w; }
__device__ __forceinline__ float dot8(const f32x4 a, const f32x4 b) { return ((a.x * a.x + a.y * a.y) + (a.z * a.z + a.w * a.w)) + ((b.x * b.x + b.y * b.y) + (b.z * b.z + b.w * b.w)); }
__device__ __forceinline__ void epi_rstd(const float* ssq, const int* rowmap, int pm, int wr, int fr, int fq, float (&rs)[2][4]) {
    f32x4 p[2][4];
#pragma unroll
    for (int ai = 0; ai < 2; ++ai)
#pragma unroll
        for (int m = 0; m < 4; ++m) { int row = EPI_ROW(ai, m); if (rowmap) row = rowmap[row]; p[ai][m] = *(const f32x4*)((const char*)ssq + ((unsigned)row * 16u + 4u * (unsigned)fq) * 4u); }
#pragma unroll
    for (int ai = 0; ai < 2; ++ai)
#pragma unroll
        for (int m = 0; m < 4; ++m) { float t = (p[ai][m].x + p[ai][m].y) + (p[ai][m].z + p[ai][m].w); t += __shfl_xor(t, 16); t += __shfl_xor(t, 32); rs[ai][m] = __builtin_amdgcn_rsqf(t * (1.f / 1024.f) + EPS); }
}
__device__ __forceinline__ void epi_ssq(float* ssq, int row, int slot, float s_, int fq) { s_ += __shfl_xor(s_, 16); s_ += __shfl_xor(s_, 32); if (fq == 0) *(float*)((char*)ssq + ((unsigned)row * 16u + (unsigned)slot) * 4u) = s_; }

struct EpiZ { static constexpr bool PERM = true; bf16_t* z; const float* bin; const float* ssq;
    __device__ __forceinline__ void operator()(const AccT& acc, int pm, int pn, int wr, int wc, int fr, int fq) const {
        const int c0 = pn * 256 + wc * 32 + 8 * fq; f32x4 bv[2][2]; float rs[2][4];
#pragma unroll
        for (int bj = 0; bj < 2; ++bj)
#pragma unroll
            for (int n = 0; n < 2; ++n) { const int cc = c0 + bj * 128 + n * 4; bv[bj][n] = *(const f32x4*)(bin + (cc < 2048 ? cc : cc + 8)); }
        epi_rstd(ssq, nullptr, pm, wr, fr, fq, rs);
#pragma unroll
        for (int ai = 0; ai < 2; ++ai)
#pragma unroll
            for (int m = 0; m < 4; ++m) { bf16_t* rp = z + (size_t)EPI_ROW(ai, m) * ZW + c0; const float r = rs[ai][m];
#pragma unroll
                for (int bj = 0; bj < 2; ++bj) *(u32x4*)(rp + bj * 128) = pack8(acc[ai][bj][m][0] * r + bv[bj][0], acc[ai][bj][m][1] * r + bv[bj][1]); } } };
template <bool XB> struct EpiHres { static constexpr bool PERM = true; const float* xb; bf16_t* hb; float* ssq;
    __device__ __forceinline__ void operator()(const AccT& acc, int pm, int pn, int wr, int wc, int fr, int fq) const {
        const int c0 = pn * 256 + wc * 32 + 8 * fq;
#pragma unroll
        for (int ai = 0; ai < 2; ++ai) {
            f32x4 lx[4][2][2]; u32x4 lh[4][2];
#pragma unroll
            for (int m = 0; m < 4; ++m)
#pragma unroll
                for (int bj = 0; bj < 2; ++bj) { const size_t o = (size_t)EPI_ROW(ai, m) * D + c0 + bj * 128;
                    if (XB) { lx[m][bj][0] = *(const f32x4*)(xb + o); lx[m][bj][1] = *(const f32x4*)(xb + o + 4); } else lh[m][bj] = *(const u32x4*)(hb + o); }
#pragma unroll
            for (int m = 0; m < 4; ++m) { float s_ = 0.f; const int row = EPI_ROW(ai, m);
#pragma unroll
                for (int bj = 0; bj < 2; ++bj) { f32x4 b0, b1; if (XB) { b0 = lx[m][bj][0]; b1 = lx[m][bj][1]; } else unpack8(lh[m][bj], b0, b1);
                    const f32x4 v0 = b0 + acc[ai][bj][m][0], v1 = b1 + acc[ai][bj][m][1]; s_ += dot8(v0, v1);
                    *(u32x4*)(hb + (size_t)row * D + c0 + bj * 128) = pack8(v0, v1); }
                epi_ssq(ssq, row, pn * 4 + wc, s_, fq); }
        } } };
struct EpiSwiglu { static constexpr bool PERM = true; bf16_t* hid; const float* ssq; const int* rowmap;
    __device__ __forceinline__ void operator()(const AccT& acc, int pm, int pn, int wr, int wc, int fr, int fq) const {
        const int c0 = pn * 128 + wc * 32 + 8 * fq; float rs[2][4];
        epi_rstd(ssq, rowmap, pm, wr, fr, fq, rs);
#pragma unroll
        for (int ai = 0; ai < 2; ++ai)
#pragma unroll
            for (int m = 0; m < 4; ++m) { u32x4 w; const float r = rs[ai][m];
#pragma unroll
                for (int n = 0; n < 2; ++n) { const f32x4 g = acc[ai][0][m][n] * r, u = acc[ai][1][m][n] * r;
                    w[2 * n] = pk2(siluf_(g.x) * u.x, siluf_(g.y) * u.y); w[2 * n + 1] = pk2(siluf_(g.z) * u.z, siluf_(g.w) * u.w); }
                *(u32x4*)(hid + (size_t)EPI_ROW(ai, m) * DFF + c0) = w; } } };
struct EpiSwiglu8 { static constexpr bool PERM = true; unsigned char* hid8; float sc;
    __device__ __forceinline__ void operator()(const AccT& acc, int pm, int pn, int wr, int wc, int fr, int fq) const {
        const int c0 = pn * 128 + wc * 32 + 8 * fq;
#pragma unroll
        for (int ai = 0; ai < 2; ++ai)
#pragma unroll
            for (int m = 0; m < 4; ++m) { u32x2 w;
#pragma unroll
                for (int n = 0; n < 2; ++n) { const f32x4 g = acc[ai][0][m][n] * sc, u = acc[ai][1][m][n] * sc;
                    w[n] = pk4_fp8(siluf_(g.x) * u.x, siluf_(g.y) * u.y, siluf_(g.z) * u.z, siluf_(g.w) * u.w); }
                *(u32x2*)(hid8 + (size_t)EPI_ROW(ai, m) * DFF + c0) = w; } } };
struct EpiMoeDown { static constexpr bool PERM = true; bf16_t* hb; bf16_t* y1; const int* row_tok; const int* row_slot; const float* row_gate; float sc;
    __device__ __forceinline__ void operator()(const AccT& acc, int pm, int pn, int wr, int wc, int fr, int fq) const {
        const int c0 = pn * 256 + wc * 32 + 8 * fq;
        int tok[2][4], slot[2][4]; float gt[2][4];
#pragma unroll
        for (int ai = 0; ai < 2; ++ai)
#pragma unroll
            for (int m = 0; m < 4; ++m) { const int row = EPI_ROW(ai, m); tok[ai][m] = row_tok[row]; slot[ai][m] = row_slot[row]; gt[ai][m] = row_gate[row] * sc; }
#pragma unroll
        for (int ai = 0; ai < 2; ++ai) {
            u32x4 lh[4][2];
#pragma unroll
            for (int m = 0; m < 4; ++m) { const bool rmw = tok[ai][m] < M && slot[ai][m] == 0;
#pragma unroll
                for (int bj = 0; bj < 2; ++bj) lh[m][bj] = rmw ? *(const u32x4*)(hb + (size_t)tok[ai][m] * D + c0 + bj * 128) : (u32x4){0u, 0u, 0u, 0u}; }
#pragma unroll
            for (int m = 0; m < 4; ++m) { if (tok[ai][m] >= M) continue; const size_t o = (size_t)tok[ai][m] * D + c0; const float g = gt[ai][m];
                if (slot[ai][m] == 0) {
#pragma unroll
                    for (int bj = 0; bj < 2; ++bj) { f32x4 b0, b1; unpack8(lh[m][bj], b0, b1); *(u32x4*)(hb + o + bj * 128) = pack8(b0 + g * acc[ai][bj][m][0], b1 + g * acc[ai][bj][m][1]); }
                } else {
#pragma unroll
                    for (int bj = 0; bj < 2; ++bj) *(u32x4*)(y1 + o + bj * 128) = pack8(g * acc[ai][bj][m][0], g * acc[ai][bj][m][1]);
                } }
        } } };
struct EpiStoreBf16 { static constexpr bool PERM = true; bf16_t* out;
    __device__ __forceinline__ void operator()(const AccT& acc, int pm, int pn, int wr, int wc, int fr, int fq) const {
        const int c0 = pn * 256 + wc * 32 + 8 * fq;
#pragma unroll
        for (int ai = 0; ai < 2; ++ai)
#pragma unroll
            for (int m = 0; m < 4; ++m)
#pragma unroll
                for (int bj = 0; bj < 2; ++bj) *(u32x4*)(out + (size_t)EPI_ROW(ai, m) * D + c0 + bj * 128) = pack8(acc[ai][bj][m][0], acc[ai][bj][m][1]); } };
struct EpiPle { static constexpr bool PERM = true; const bf16_t* hin; bf16_t* hb; const bf16_t* pp; float* ssq; const float* ssq_in;
    __device__ __forceinline__ void operator()(const AccT& acc, int pm, int pn, int wr, int wc, int fr, int fq) const {
        const int c0 = pn * 256 + wc * 32 + 8 * fq; float rs[2][4];
        epi_rstd(ssq_in, nullptr, pm, wr, fr, fq, rs);
        u32x4 sg[2][4][2];
#pragma unroll
        for (int ai = 0; ai < 2; ++ai)
#pragma unroll
            for (int m = 0; m < 4; ++m)
#pragma unroll
                for (int bj = 0; bj < 2; ++bj) { f32x4 a0 = acc[ai][bj][m][0] * rs[ai][m], a1 = acc[ai][bj][m][1] * rs[ai][m];
#pragma unroll
                    for (int q = 0; q < 4; ++q) { a0[q] = sigmoidf_(a0[q]); a1[q] = sigmoidf_(a1[q]); }
                    sg[ai][m][bj] = pack8(a0, a1); }
        asm volatile("" ::: "memory");
#pragma unroll
        for (int ai = 0; ai < 2; ++ai) {
            u32x4 lh[4][2], lp[4][2];
#pragma unroll
            for (int m = 0; m < 4; ++m)
#pragma unroll
                for (int bj = 0; bj < 2; ++bj) { const unsigned ob = ((unsigned)EPI_ROW(ai, m) * D + c0 + bj * 128) * 2u;
                    lh[m][bj] = *(const u32x4*)((const char*)hin + ob); lp[m][bj] = *(const u32x4*)((const char*)pp + ob); }
#pragma unroll
            for (int m = 0; m < 4; ++m) { float s_ = 0.f; const int row = EPI_ROW(ai, m);
#pragma unroll
                for (int bj = 0; bj < 2; ++bj) { f32x4 h0, h1, p0, p1, g0, g1; unpack8(lh[m][bj], h0, h1); unpack8(lp[m][bj], p0, p1); unpack8(sg[ai][m][bj], g0, g1);
                    h0 += g0 * p0; h1 += g1 * p1; s_ += dot8(h0, h1);
                    *(u32x4*)((char*)hb + ((unsigned)row * D + c0 + bj * 128) * 2u) = pack8(h0, h1); }
                epi_ssq(ssq, row, pn * 4 + wc, s_, fq); }
        } } };

__device__ __forceinline__ float conv4(const bf16_t* zc, int row, int s, const float* w  , int wstride, float b) {
    float acc = b;
#pragma unroll
    for (int j = 0; j < 4; ++j) { const int ds = 3 - j; if (s - ds >= 0) acc += w[j * wstride] * bf2f(zc[(ptrdiff_t)(row - ds) * ZW]); }
    return acc;
}
__device__ __forceinline__ void chunk_gates(float* sc, const float* gates, int row0, int h, int lane) {
    const float ip = gates[(size_t)(row0 + lane) * 8 + h], fp = gates[(size_t)(row0 + lane) * 8 + 4 + h];
    float b = logsigmoidf_(fp);
#pragma unroll
    for (int o = 1; o < 64; o <<= 1) { const float n = __shfl_up(b, o); if (lane >= o) b += n; }
    sc[lane] = b; sc[64 + lane] = ip;
}
__device__ __forceinline__ void chunk_gates_r(float* sc, float ip, float fp, int lane) {
    float b = logsigmoidf_(fp);
#pragma unroll
    for (int o = 1; o < 64; o <<= 1) { const float n = __shfl_up(b, o); if (lane >= o) b += n; }
    sc[lane] = b; sc[64 + lane] = ip;
}
__device__ __forceinline__ void mlstm_local(const Args& a, unsigned char* lds, int l, int item) {
    const int b = item >> 8, c = (item >> 2) & 63, h = item & 3, row0 = b * SEQ + c * CH, tid = otid(), lane = tid & 63;
    float* Kt = (float*)lds;
    float* Vt = Kt + 64 * 128;
    float* sc = Vt + 64 * 128;
    const bf16_t* z = (const bf16_t*)(a.ws + WS_Z);
    const float* gates = (const float*)(a.ws + WS_SMALL + SM_GATES);
    if (tid < 64) {
        chunk_gates(sc, gates, row0, h, lane);
        const float bl = __shfl(sc[lane], 63), al = bl - sc[lane] + sc[64 + lane];
        const float amax = wave_max(al);
        sc[128 + lane] = __expf(al - amax);
        if (lane == 0) { ((float*)(a.ws + WS_SMALL + SM_BL))[item] = bl; ((float*)(a.ws + WS_SMALL + SM_AMAX))[item] = amax; }
    }
    const float* wc = a.in[I_WCQK] + (size_t)l * 4 * 1024; const float* bc = a.in[I_BCQK] + (size_t)l * 1024;
    for (int i = tid; i < 64 * 128; i += NT) {
        const int ll = i >> 7, d = i & 127, ch = ZK + h * DH + d;
        Kt[i] = siluf_(conv4(z + ch, row0 + ll, c * CH + ll, wc + ch, 1024, bc[ch]));
        Vt[i] = bf2f(z[(size_t)(row0 + ll) * ZW + ZV + h * DH + d]);
    }
    __syncthreads();
    const int d = tid & 127, eg = tid >> 7;
    float acc[33];
#pragma unroll
    for (int i = 0; i < 33; ++i) acc[i] = 0.f;
    for (int ll = 0; ll < 64; ++ll) {
        const float kd = Kt[ll * 128 + d] * sc[128 + ll];
#pragma unroll
        for (int i = 0; i < 32; ++i) acc[i] += Vt[ll * 128 + eg + 4 * i] * kd;
        acc[32] += kd;
    }
    float* ct = (float*)(a.ws + WS_CT) + (size_t)item * EROWS * 128;
#pragma unroll
    for (int i = 0; i < 32; ++i) ct[(eg + 4 * i) * 128 + d] = acc[i];
    if (eg == 0) ct[128 * 128 + d] = acc[32];
    __syncthreads();
}
__device__ __forceinline__ void mlstm_scan(const Args& a, int G) {
    const float* BL = (const float*)(a.ws + WS_SMALL + SM_BL); const float* AM = (const float*)(a.ws + WS_SMALL + SM_AMAX);
    float* MP = (float*)(a.ws + WS_SMALL + SM_MPREV);
    const int tid = otid();
    for (int w = blockIdx.x; w < 16 * 16; w += G) {
        const int bh = w >> 4, sl = w & 15, b = bh >> 2, h = bh & 3;
        unsigned* p = (unsigned*)(a.ws + WS_CT) + (size_t)((b * NC) * NH + h) * 8192 + sl * 512 + tid;
        float s0 = 0.f, s1 = 0.f, m = 0.f;
#pragma unroll 1
        for (int c0 = 0; c0 < NC; c0 += 16) {
            unsigned x[16];
#pragma unroll
            for (int j = 0; j < 16; ++j) x[j] = p[(size_t)(c0 + j) * (NH * 8192)];
#pragma unroll
            for (int j = 0; j < 16; ++j) {
                const int item = (b * NC + c0 + j) * NH + h;
                const float bl = BL[item], am = AM[item];
                const float mn = fmaxf(bl + m, am), dec = __expf(bl + m - mn), scl = __expf(am - mn);
                p[(size_t)(c0 + j) * (NH * 8192)] = pk2(s0, s1);
                if (sl == 0 && tid == 0) MP[item] = m;
                s0 = dec * s0 + scl * bf2f(x[j] & 0xffffu); s1 = dec * s1 + scl * __uint_as_float(x[j] & 0xffff0000u); m = mn;
            }
        }
        if (sl == 1 && tid < 128) {
            float* q = (float*)(a.ws + WS_DN) + (size_t)((b * NC) * NH + h) * 128 + tid;
            float sn = 0.f; m = 0.f;
#pragma unroll 1
            for (int c0 = 0; c0 < NC; c0 += 16) {
                float x[16];
#pragma unroll
                for (int j = 0; j < 16; ++j) x[j] = q[(size_t)(c0 + j) * (NH * 128)];
#pragma unroll
                for (int j = 0; j < 16; ++j) {
                    const int item = (b * NC + c0 + j) * NH + h;
                    const float bl = BL[item], am = AM[item];
                    const float mn = fmaxf(bl + m, am), dec = __expf(bl + m - mn), scl = __expf(am - mn);
                    q[(size_t)(c0 + j) * (NH * 128)] = sn;
                    sn = dec * sn + scl * x[j]; m = mn;
                }
            }
        }
    }
}
__device__ __forceinline__ void mlstm_out(const Args& a, unsigned char* lds, int l, int item) {
    const int b = item >> 8, c = (item >> 2) & 63, h = item & 3, row0 = b * SEQ + c * CH, tid = otid(), lane = tid & 63, wave = tid >> 6;
    float* Q = (float*)lds;
    float* Kt = Q + 64 * 128;
    float* Vt = Kt + 64 * 128;
    float* Sm = Vt + 64 * 128;
    float* sc = Sm + 64 * 64;
    const bf16_t* z = (const bf16_t*)(a.ws + WS_Z);
    const float* gates = (const float*)(a.ws + WS_SMALL + SM_GATES);
    const float mprev = ((const float*)(a.ws + WS_SMALL + SM_MPREV))[item];
    if (tid < 64) {
        chunk_gates(sc, gates, row0, h, lane);
        float g = sc[64 + lane] - sc[lane];
#pragma unroll
        for (int o = 1; o < 64; o <<= 1) { const float n = __shfl_up(g, o); if (lane >= o) g = fmaxf(g, n); }
        const float mrow = sc[lane] + fmaxf(mprev, g);
        sc[128 + lane] = mrow; sc[192 + lane] = __expf(sc[lane] + mprev - mrow);
    }
    const float* wc = a.in[I_WCQK] + (size_t)l * 4 * 1024; const float* bc = a.in[I_BCQK] + (size_t)l * 1024;
    for (int i = tid; i < 64 * 128; i += NT) {
        const int ll = i >> 7, d = i & 127, chq = ZQ + h * DH + d, chk = ZK + h * DH + d;
        Q[i] = siluf_(conv4(z + chq, row0 + ll, c * CH + ll, wc + chq, 1024, bc[chq])) * 0.08838834764831845f;
        Kt[i] = siluf_(conv4(z + chk, row0 + ll, c * CH + ll, wc + chk, 1024, bc[chk]));
        Vt[i] = bf2f(z[(size_t)(row0 + ll) * ZW + ZV + h * DH + d]);
    }
    __syncthreads();
    for (int i = tid; i < 64 * 64; i += NT) {
        const int ll = i >> 6, mm = i & 63; float s = 0.f;
        if (mm <= ll) {
            for (int d = 0; d < 128; ++d) s += Q[ll * 128 + d] * Kt[mm * 128 + d];
            s *= __expf(sc[ll] - sc[mm] + sc[64 + mm] - sc[128 + ll]);
        }
        Sm[i] = s;
    }
    __syncthreads();
    const float* ct = (const float*)(a.ws + WS_CT) + (size_t)item * EROWS * 128;
    if (tid < 64) {
        float di = 0.f, dn = 0.f;
        for (int mm = 0; mm < 64; ++mm) di += Sm[tid * 64 + mm];
        for (int d = 0; d < 128; ++d) dn += Q[tid * 128 + d] * ct[128 * 128 + d];
        const float den = di + sc[192 + tid] * dn;
        sc[256 + tid] = fmaxf(fabsf(den), __expf(-sc[128 + tid]));
    }
    const int e = tid & 127, lg = tid >> 7;
    float acc[16], acc2[16];
#pragma unroll
    for (int i = 0; i < 16; ++i) { acc[i] = 0.f; acc2[i] = 0.f; }
    for (int mm = 0; mm < 64; ++mm) { const float vv = Vt[mm * 128 + e];
#pragma unroll
        for (int i = 0; i < 16; ++i) acc[i] += Sm[(lg * 16 + i) * 64 + mm] * vv; }
    for (int d = 0; d < 128; ++d) { const float cv = ct[e * 128 + d];
#pragma unroll
        for (int i = 0; i < 16; ++i) acc2[i] += Q[(lg * 16 + i) * 128 + d] * cv; }
    __syncthreads();
#pragma unroll
    for (int i = 0; i < 16; ++i) { const int ll = lg * 16 + i;
        const float hv = (acc[i] + sc[192 + ll] * acc2[i]) / sc[256 + ll];
        const float o = sigmoidf_(bf2f(z[(size_t)(row0 + ll) * ZW + ZO + h * DH + e]));
        Kt[ll * 128 + e] = hv * o; }
    __syncthreads();
    const float* gm = a.in[I_GMH] + (size_t)l * DM + h * DH;
    bf16_t* mix = (bf16_t*)(a.ws + WS_MIX);
    for (int ll = wave * 8; ll < wave * 8 + 8; ++ll) {
        const float x0 = Kt[ll * 128 + 2 * lane], x1 = Kt[ll * 128 + 2 * lane + 1];
        const float rs = rsqrtf(wave_sum(x0 * x0 + x1 * x1) * (1.f / 128.f) + EPS);
        *(unsigned*)(mix + (size_t)(row0 + ll) * D + h * DH + 2 * lane) = pk2(x0 * rs * gm[2 * lane], x1 * rs * gm[2 * lane + 1]);
    }
    __syncthreads();
}


typedef short bf16x8 __attribute__((ext_vector_type(8)));
__device__ __forceinline__ f32x4 mfma16(bf16x8 a, bf16x8 b, f32x4 c) { return __builtin_amdgcn_mfma_f32_16x16x32_bf16(a, b, c, 0, 0, 0); }

__device__ __forceinline__ void conv_load11(const bf16_t* zc, int row0, int l0, bool first_chunk, unsigned (&x)[11]) {
#pragma unroll
    for (int j = 0; j < 11; ++j) { const int ll = l0 - 3 + j; x[j] = (first_chunk && ll < 0) ? 0u : *(const unsigned*)(zc + (ptrdiff_t)(row0 + ll) * ZW); }
}
struct ConvW { float w[4][2]; float b[2]; };
__device__ __forceinline__ void conv_loadw(const float* wc, const float* bc, int col, ConvW& cw) {
#pragma unroll
    for (int j = 0; j < 4; ++j) { cw.w[j][0] = wc[j * 1024 + col]; cw.w[j][1] = wc[j * 1024 + col + 1]; }
    cw.b[0] = bc[col]; cw.b[1] = bc[col + 1];
}
__device__ __forceinline__ void conv_apply(const unsigned (&x)[11], const ConvW& cw, float (&out)[8][2]) {
#pragma unroll
    for (int i = 0; i < 8; ++i) { float a0 = cw.b[0], a1 = cw.b[1];
#pragma unroll
        for (int j = 0; j < 4; ++j) { a0 += cw.w[j][0] * bf2f(x[i + j] & 0xffffu); a1 += cw.w[j][1] * __uint_as_float(x[i + j] & 0xffff0000u); }
        out[i][0] = a0; out[i][1] = a1; }
}
struct MlRegs { unsigned xk[11], v[8]; ConvW cw; float gi, gf; };
__device__ __forceinline__ void ml_load(const Args& a, int l, int item, MlRegs& R) {
    const int b = item >> 8, c = (item >> 2) & 63, h = item & 3, row0 = b * SEQ + c * CH, tid = otid(), lane = tid & 63, wave = tid >> 6;
    const bf16_t* z = (const bf16_t*)(a.ws + WS_Z);
    const float* gates = (const float*)(a.ws + WS_SMALL + SM_GATES);
    const int cp = lane, lg = wave, colk = ZK + h * DH + 2 * cp, colv = ZV + h * DH + 2 * cp;
    conv_load11(z + colk, row0, 8 * lg, c == 0, R.xk);
#pragma unroll
    for (int i = 0; i < 8; ++i) R.v[i] = *(const unsigned*)(z + (size_t)(row0 + 8 * lg + i) * ZW + colv);
    conv_loadw(a.in[I_WCQK] + (size_t)l * 4 * 1024, a.in[I_BCQK] + (size_t)l * 1024, colk, R.cw);
    R.gi = gates[(size_t)(row0 + lane) * 8 + h]; R.gf = gates[(size_t)(row0 + lane) * 8 + 4 + h];
}
__device__ __forceinline__ void ml_compute(const Args& a, unsigned char* lds, int l, int item, MlRegs& R) {
    const int tid = otid(), lane = tid & 63, wave = tid >> 6, fr = lane & 15, fq = lane >> 4;
    unsigned char* KT = lds; unsigned char* VT = lds + 18432; float* RED = (float*)(lds + 36864); float* sc = (float*)(lds + 40960);
    const int cp = lane, lg = wave;
    unsigned (&xk)[11] = R.xk; unsigned (&v)[8] = R.v; ConvW& cw = R.cw;
    if (tid < 64) {
        chunk_gates_r(sc, R.gi, R.gf, lane);
        {
            float g = sc[64 + lane] - sc[lane];
#pragma unroll
            for (int o = 1; o < 64; o <<= 1) { const float n = __shfl_up(g, o); if (lane >= o) g = fmaxf(g, n); }
            float* scal = (float*)(a.ws + WS_SCAL) + (size_t)item * 128; scal[lane] = sc[lane]; scal[64 + lane] = g; }
        const float bl = __shfl(sc[lane], 63), al = bl - sc[lane] + sc[64 + lane];
        const float amax = wave_max(al);
        sc[128 + lane] = __expf(al - amax);
        if (lane == 0) { ((float*)(a.ws + WS_SMALL + SM_BL))[item] = bl; ((float*)(a.ws + WS_SMALL + SM_AMAX))[item] = amax; }
    }
    LDS_BARRIER();
    {
        float kk[8][2];
        conv_apply(xk, cw, kk);
        float n0 = 0.f, n1 = 0.f;
#pragma unroll
        for (int i = 0; i < 8; ++i) { const float wl = sc[128 + 8 * lg + i]; kk[i][0] = siluf_(kk[i][0]) * wl; kk[i][1] = siluf_(kk[i][1]) * wl; n0 += kk[i][0]; n1 += kk[i][1]; }
        u32x4 p0, p1;
#pragma unroll
        for (int i = 0; i < 4; ++i) { p0[i] = pk2(kk[2 * i][0], kk[2 * i + 1][0]); p1[i] = pk2(kk[2 * i][1], kk[2 * i + 1][1]); }
        *(u32x4*)(KT + (2 * cp) * 144 + lg * 16) = p0; *(u32x4*)(KT + (2 * cp + 1) * 144 + lg * 16) = p1;
        RED[lg * 128 + 2 * cp] = n0; RED[lg * 128 + 2 * cp + 1] = n1;
#pragma unroll
        for (int i = 0; i < 4; ++i) { p0[i] = (v[2 * i] & 0xffffu) | (v[2 * i + 1] << 16); p1[i] = (v[2 * i] >> 16) | (v[2 * i + 1] & 0xffff0000u); }
        *(u32x4*)(VT + (2 * cp) * 144 + lg * 16) = p0; *(u32x4*)(VT + (2 * cp + 1) * 144 + lg * 16) = p1;
    }
    LDS_BARRIER();
    bf16_t* ct = (bf16_t*)(a.ws + WS_CT) + (size_t)item * 128 * 128;
    {
        const int et0 = 2 * (wave & 3), dt0 = 4 * (wave >> 2);
        bf16x8 Vf[2][2], Kf[4][2];
#pragma unroll
        for (int i = 0; i < 2; ++i)
#pragma unroll
            for (int ks = 0; ks < 2; ++ks) Vf[i][ks] = *(const bf16x8*)(VT + ((et0 + i) * 16 + fr) * 144 + (ks * 32 + 8 * fq) * 2);
#pragma unroll
        for (int j = 0; j < 4; ++j)
#pragma unroll
            for (int ks = 0; ks < 2; ++ks) Kf[j][ks] = *(const bf16x8*)(KT + ((dt0 + j) * 16 + fr) * 144 + (ks * 32 + 8 * fq) * 2);
#pragma unroll
        for (int i = 0; i < 2; ++i)
#pragma unroll
            for (int j = 0; j < 4; ++j) {
                f32x4 acc = {0.f, 0.f, 0.f, 0.f};
                acc = mfma16(Kf[j][0], Vf[i][0], acc); acc = mfma16(Kf[j][1], Vf[i][1], acc);
                u32x2 w; w.x = pk2(acc[0], acc[1]); w.y = pk2(acc[2], acc[3]);
                *(u32x2*)(ct + ((et0 + i) * 16 + fr) * 128 + (dt0 + j) * 16 + 4 * fq) = w;
            }
    }
    if (tid < 128) { float s_ = 0.f;
#pragma unroll
        for (int g = 0; g < 8; ++g) s_ += RED[g * 128 + tid];
        ((float*)(a.ws + WS_DN))[(size_t)item * 128 + tid] = s_; }
    LDS_BARRIER();
}
struct MoRegs { unsigned xq[11], xk[11], v[8]; u32x4 og[2]; float gi, gb, gg, mprev; };
__device__ __forceinline__ void mo_load(const Args& a, int l, int item, MoRegs& R) {
    const int b = item >> 8, c = (item >> 2) & 63, h = item & 3, row0 = b * SEQ + c * CH, tid = otid(), lane = tid & 63, wave = tid >> 6;
    const bf16_t* z = (const bf16_t*)(a.ws + WS_Z);
    const float* gates = (const float*)(a.ws + WS_SMALL + SM_GATES);
    const int cp = lane, lg = wave, colq = ZQ + h * DH + 2 * cp, colk = ZK + h * DH + 2 * cp, colv = ZV + h * DH + 2 * cp;
    conv_load11(z + colq, row0, 8 * lg, c == 0, R.xq);
    conv_load11(z + colk, row0, 8 * lg, c == 0, R.xk);
#pragma unroll
    for (int i = 0; i < 8; ++i) R.v[i] = *(const unsigned*)(z + (size_t)(row0 + 8 * lg + i) * ZW + colv);
#pragma unroll
    for (int j = 0; j < 2; ++j) { const int pc = tid + j * NT; R.og[j] = *(const u32x4*)(z + (size_t)(row0 + (pc >> 4)) * ZW + ZO + h * DH + (pc & 15) * 8); }
    R.gi = gates[(size_t)(row0 + lane) * 8 + h];
    { const float* scal = (const float*)(a.ws + WS_SCAL) + (size_t)item * 128; R.gb = scal[lane]; R.gg = scal[64 + lane]; }
    R.mprev = ((const float*)(a.ws + WS_SMALL + SM_MPREV))[item];
}
__device__ __forceinline__ void mo_compute(const Args& a, unsigned char* lds, int l, int item, MoRegs& R, ConvW& cwq, ConvW& cwk, int& hw) {
    const int b = item >> 8, c = (item >> 2) & 63, h = item & 3, row0 = b * SEQ + c * CH, tid = otid(), lane = tid & 63, wave = tid >> 6, fr = lane & 15, fq = lane >> 4;
    unsigned char* QN = lds; unsigned char* KN = lds + 17408; unsigned char* VT = lds + 34816; unsigned char* SP = lds + 53248;
    float* sc = (float*)(lds + 62464);
    float* HM = (float*)lds;
    const int cp = lane, lg = wave;
    unsigned (&xq)[11] = R.xq; unsigned (&xk)[11] = R.xk; unsigned (&v)[8] = R.v;
    bf16x8 Cf[4]; f32x4 dnv[4];
    { const bf16_t* ct = (const bf16_t*)(a.ws + WS_CT) + (size_t)item * 128 * 128; const float* dn = (const float*)(a.ws + WS_DN) + (size_t)item * 128;
#pragma unroll
      for (int ks = 0; ks < 4; ++ks) Cf[ks] = *(const bf16x8*)(ct + (wave * 16 + fr) * 128 + ks * 32 + 8 * fq);
#pragma unroll
      for (int j = 0; j < 4; ++j) dnv[j] = *(const f32x4*)(dn + (tid & 7) * 16 + 4 * j); }
    f32x4 gmv[2][2];
#pragma unroll
    for (int j = 0; j < 2; ++j) { const float* gp = a.in[I_GMH] + (size_t)l * DM + h * DH + ((tid + j * NT) & 15) * 8; gmv[j][0] = *(const f32x4*)gp; gmv[j][1] = *(const f32x4*)(gp + 4); }
    if (hw != h) { const float* wc = a.in[I_WCQK] + (size_t)l * 4 * 1024; const float* bc = a.in[I_BCQK] + (size_t)l * 1024;
        conv_loadw(wc, bc, ZQ + h * DH + 2 * cp, cwq); conv_loadw(wc, bc, ZK + h * DH + 2 * cp, cwk); hw = h; }
    if (tid < 64) {
        const float mprev = R.mprev, mrow = R.gb + fmaxf(mprev, R.gg);
        sc[lane] = R.gb; sc[64 + lane] = R.gi; sc[128 + lane] = mrow; sc[192 + lane] = __expf(R.gb + mprev - mrow);
    }
    {
        float qq[8][2];
        conv_apply(xq, cwq, qq);
#pragma unroll
        for (int i = 0; i < 8; ++i) *(unsigned*)(QN + (8 * lg + i) * 272 + cp * 4) = pk2(siluf_(qq[i][0]) * 0.08838834764831845f, siluf_(qq[i][1]) * 0.08838834764831845f);
        conv_apply(xk, cwk, qq);
#pragma unroll
        for (int i = 0; i < 8; ++i) *(unsigned*)(KN + (8 * lg + i) * 272 + cp * 4) = pk2(siluf_(qq[i][0]), siluf_(qq[i][1]));
        u32x4 p0, p1;
#pragma unroll
        for (int i = 0; i < 4; ++i) { p0[i] = (v[2 * i] & 0xffffu) | (v[2 * i + 1] << 16); p1[i] = (v[2 * i] >> 16) | (v[2 * i + 1] & 0xffff0000u); }
        *(u32x4*)(VT + (2 * cp) * 144 + lg * 16) = p0; *(u32x4*)(VT + (2 * cp + 1) * 144 + lg * 16) = p1;
    }
    LDS_BARRIER();
    {
        const int ll = tid >> 3, part = tid & 7; float s_ = 0.f;
#pragma unroll
        for (int j = 0; j < 4; ++j) { const u32x2 qv = *(const u32x2*)(QN + ll * 272 + (part * 16 + 4 * j) * 2);
            s_ += bf2f(qv.x & 0xffffu) * dnv[j].x + __uint_as_float(qv.x & 0xffff0000u) * dnv[j].y + bf2f(qv.y & 0xffffu) * dnv[j].z + __uint_as_float(qv.y & 0xffff0000u) * dnv[j].w; }
        s_ = sum8(s_);
        if (part == 0) sc[384 + ll] = s_;
    }
    {
        const int lt = wave & 3; const int ll = lt * 16 + fr; const float bl_ = sc[ll], mr = sc[128 + ll]; float dsum = 0.f;
#pragma unroll
        for (int mi = 0; mi < 2; ++mi) {
            const int mt = 2 * (wave >> 2) + mi; u32x2 pk = {0u, 0u};
            if (mt <= lt) {
                f32x4 acc = {0.f, 0.f, 0.f, 0.f};
#pragma unroll
                for (int ks = 0; ks < 4; ++ks) { const bf16x8 A = *(const bf16x8*)(KN + (mt * 16 + fr) * 272 + (ks * 32 + 8 * fq) * 2), B = *(const bf16x8*)(QN + (lt * 16 + fr) * 272 + (ks * 32 + 8 * fq) * 2);
                    acc = mfma16(A, B, acc); }
                float sv[4];
#pragma unroll
                for (int r = 0; r < 4; ++r) { const int mm = mt * 16 + 4 * fq + r; const float wgt = (mm <= ll) ? __expf(bl_ - sc[mm] + sc[64 + mm] - mr) : 0.f; sv[r] = acc[r] * wgt; dsum += sv[r]; }
                pk.x = pk2(sv[0], sv[1]); pk.y = pk2(sv[2], sv[3]);
            }
            *(u32x2*)(SP + ll * 144 + (mt * 16 + 4 * fq) * 2) = pk;
        }
        dsum += __shfl_xor(dsum, 16); dsum += __shfl_xor(dsum, 32);
        if (fq == 0) sc[256 + (wave >> 2) * 64 + ll] = dsum;
    }
    LDS_BARRIER();
    if (tid < 64) { const float den = sc[256 + tid] + sc[320 + tid] + sc[192 + tid] * sc[384 + tid]; sc[448 + tid] = fmaxf(fabsf(den), __expf(-sc[128 + tid])); }
    f32x4 acc1[4], acc2[4];
    {
        bf16x8 Vf[2];
#pragma unroll
        for (int ks = 0; ks < 2; ++ks) Vf[ks] = *(const bf16x8*)(VT + (wave * 16 + fr) * 144 + (ks * 32 + 8 * fq) * 2);
#pragma unroll
        for (int lt = 0; lt < 4; ++lt) {
            acc1[lt] = (f32x4){0.f, 0.f, 0.f, 0.f}; acc2[lt] = (f32x4){0.f, 0.f, 0.f, 0.f};
#pragma unroll
            for (int ks = 0; ks < 2; ++ks) acc1[lt] = mfma16(*(const bf16x8*)(SP + (lt * 16 + fr) * 144 + (ks * 32 + 8 * fq) * 2), Vf[ks], acc1[lt]);
#pragma unroll
            for (int ks = 0; ks < 4; ++ks) acc2[lt] = mfma16(*(const bf16x8*)(QN + (lt * 16 + fr) * 272 + (ks * 32 + 8 * fq) * 2), Cf[ks], acc2[lt]);
        }
    }
    LDS_BARRIER();
#pragma unroll
    for (int lt = 0; lt < 4; ++lt)
#pragma unroll
        for (int r = 0; r < 4; ++r) { const int ll = lt * 16 + 4 * fq + r;
            HM[ll * 132 + wave * 16 + fr] = (acc1[lt][r] + sc[192 + ll] * acc2[lt][r]) * frcp(sc[448 + ll]); }
    LDS_BARRIER();
    {
        bf16_t* mix = (bf16_t*)(a.ws + WS_MIX);
#pragma unroll
        for (int j = 0; j < 2; ++j) { const int pc = tid + j * NT, ll = pc >> 4, q16 = pc & 15;
            const f32x4 h0 = *(const f32x4*)(HM + ll * 132 + q16 * 8), h1 = *(const f32x4*)(HM + ll * 132 + q16 * 8 + 4);
            f32x4 o0, o1; unpack8(R.og[j], o0, o1);
            f32x4 g0, g1;
#pragma unroll
            for (int q = 0; q < 4; ++q) { g0[q] = h0[q] * sigmoidf_(o0[q]); g1[q] = h1[q] * sigmoidf_(o1[q]); }
            const float rs = __builtin_amdgcn_rsqf(sum16(dot8(g0, g1)) * (1.f / 128.f) + EPS);
            *(u32x4*)(mix + (size_t)(row0 + ll) * D + h * DH + q16 * 8) = pack8(g0 * rs * gmv[j][0], g1 * rs * gmv[j][1]); }
    }
    LDS_BARRIER();
}

template <int MODE>
__device__ __forceinline__ void rglru_item(const Args& a, unsigned char* lds, int l, int item) {
    const int b = item >> 6, c = item & 63, row0 = b * SEQ + c * CH, ch = otid(), lane = ch & 63, nb = ch >> 6;
    float* xs = (float*)lds + nb * 64 * 64;
    const bf16_t* z = (const bf16_t*)(a.ws + WS_Z);
    const float* wcr = a.in[I_WCR] + (size_t)l * 4 * DR; const float bcr = a.in[I_BCR][l * DR + ch];
    const float w0 = wcr[ch], w1 = wcr[DR + ch], w2 = wcr[2 * DR + ch], w3 = wcr[3 * DR + ch];
    const bf16_t* zc = z + ZXR + ch;
    float xm3 = 0.f, xm2 = 0.f, xm1 = 0.f;
    { const int s0 = c * CH; if (s0 >= 3) { xm3 = bf2f(zc[(size_t)(row0 - 3) * ZW]); xm2 = bf2f(zc[(size_t)(row0 - 2) * ZW]); xm1 = bf2f(zc[(size_t)(row0 - 1) * ZW]); } }
#pragma unroll 4
    for (int t = 0; t < 64; ++t) { const float x0 = bf2f(zc[(size_t)(row0 + t) * ZW]);
        xs[t * 64 + lane] = bcr + w0 * xm3 + w1 * xm2 + w2 * xm1 + w3 * x0; xm3 = xm2; xm2 = xm1; xm1 = x0; }
    unsigned wa[32], wx[32];
    const float* wra = a.in[I_WRA] + ((size_t)(l * NBR + nb) * 64) * 64 + lane; const float* wri = a.in[I_WRI] + ((size_t)(l * NBR + nb) * 64) * 64 + lane;
#pragma unroll
    for (int d = 0; d < 32; ++d) { wa[d] = pk2(wra[(2 * d) * 64], wra[(2 * d + 1) * 64]); wx[d] = pk2(wri[(2 * d) * 64], wri[(2 * d + 1) * 64]); }
    const float ba = a.in[I_BRA][l * DR + ch], bx = a.in[I_BRI][l * DR + ch];
    const float lam = a.in[I_LAM][l * DR + ch];
    const float sp = fmaxf(-lam, 0.f) + log1pf(__expf(-fabsf(lam)));
    float hst = 0.f, ap = 1.f;
    if (MODE == 1) hst = ((const float*)(a.ws + WS_SMALL + SM_RGP))[(size_t)item * DR + ch];
    const float gr = a.in[I_GR][l * DR + ch];
    bf16_t* mix = (bf16_t*)(a.ws + WS_MIX);
    __syncthreads();
#pragma unroll 1
    for (int t = 0; t < 64; ++t) {
        float ra = ba, ia = bx;
#pragma unroll
        for (int d4 = 0; d4 < 16; ++d4) { const f32x4 xv = *(const f32x4*)(xs + t * 64 + 4 * d4);
#pragma unroll
            for (int q = 0; q < 2; ++q) { const unsigned pa = wa[2 * d4 + q], px = wx[2 * d4 + q];
                ra += xv[2 * q] * __uint_as_float(pa << 16) + xv[2 * q + 1] * __uint_as_float(pa & 0xffff0000u);
                ia += xv[2 * q] * __uint_as_float(px << 16) + xv[2 * q + 1] * __uint_as_float(px & 0xffff0000u); } }
        const float xo = xs[t * 64 + lane];
        const float r = sigmoidf_(ra), ig = sigmoidf_(ia), la = -8.f * r * sp, av = __expf(la);
        const float uu = sqrtf(-expm1f(2.f * la)) * (ig * xo);
        hst = av * hst + uu; ap *= av;
        if (MODE == 1) {
            const float y = bf2f(z[(size_t)(row0 + t) * ZW + ZYR + ch]);
            const float o = hst * gelu_tanh(y);
            const float rs = rsqrtf(wave_sum(o * o) * (1.f / 64.f) + EPS);
            mix[(size_t)(row0 + t) * D + DM + ch] = (bf16_t)f2bf(o * rs * gr);
        }
    }
    if (MODE == 0) { ((float*)(a.ws + WS_SMALL + SM_RGA))[(size_t)item * DR + ch] = ap; ((float*)(a.ws + WS_SMALL + SM_RGH))[(size_t)item * DR + ch] = hst; }
    __syncthreads();
}

template <int MODE>
__device__ __forceinline__ void rglru_fast(const Args& a, unsigned char* lds, int l, int item) {
    const int b = item >> 6, c = item & 63, row0 = b * SEQ + c * CH, ch = otid(), lane = ch & 63, nb = ch >> 6, fr = lane & 15, fq = lane >> 4;
    unsigned char* XA = lds + nb * 9216;
    float* GS = (float*)(lds + 73728 + nb * 8448);
    const bf16_t* z = (const bf16_t*)(a.ws + WS_Z);
    unsigned ypk[32];
    {
        const float* wcr = a.in[I_WCR] + (size_t)l * 4 * DR; const float bcr = a.in[I_BCR][l * DR + ch];
        const float w0 = wcr[ch], w1 = wcr[DR + ch], w2 = wcr[2 * DR + ch], w3 = wcr[3 * DR + ch];
        const bf16_t* zc = z + ZXR + ch;
        bf16_t xin[67];
#pragma unroll
        for (int t = 0; t < 67; ++t) xin[t] = (c == 0 && t < 3) ? (bf16_t)0 : zc[(ptrdiff_t)(row0 + t - 3) * ZW];
        if (MODE == 1) {
            bf16_t yb[64];
#pragma unroll
            for (int t = 0; t < 64; ++t) yb[t] = z[(size_t)(row0 + t) * ZW + ZYR + ch];
#pragma unroll
            for (int t = 0; t < 32; ++t) ypk[t] = (unsigned)yb[2 * t] | ((unsigned)yb[2 * t + 1] << 16);
        }
#pragma unroll
        for (int t = 0; t < 64; ++t)
            *(bf16_t*)(XA + t * 144 + lane * 2) = (bf16_t)f2bf(bcr + w0 * bf2f(xin[t]) + w1 * bf2f(xin[t + 1]) + w2 * bf2f(xin[t + 2]) + w3 * bf2f(xin[t + 3]));
    }
    bf16x8 Bf[8][2];
    { const bf16_t* wt = (const bf16_t*)(a.ws + WS_SMALL + SM_RGW) + (size_t)((l * NBR + nb) * 2) * 64 * 64;
#pragma unroll
        for (int ct = 0; ct < 8; ++ct)
#pragma unroll
            for (int ks = 0; ks < 2; ++ks) Bf[ct][ks] = *(const bf16x8*)(wt + (size_t)((ct >> 2) * 64 + (ct & 3) * 16 + fr) * 64 + ks * 32 + 8 * fq); }
    const float ba = a.in[I_BRA][l * DR + ch], bx = a.in[I_BRI][l * DR + ch];
    const float lam = a.in[I_LAM][l * DR + ch];
    const float sp8 = -8.f * (fmaxf(-lam, 0.f) + log1pf(__expf(-fabsf(lam))));
    float hst = 0.f, ap = 1.f;
    if (MODE == 1) hst = ((const float*)(a.ws + WS_SMALL + SM_RGP))[(size_t)item * DR + ch];
    const float gr = a.in[I_GR][l * DR + ch];
    bf16_t* mix = (bf16_t*)(a.ws + WS_MIX);
    WAVE_LDS_SYNC();
#pragma unroll
    for (int rt = 0; rt < 4; ++rt) {
        bf16x8 Af[2];
#pragma unroll
        for (int ks = 0; ks < 2; ++ks) Af[ks] = *(const bf16x8*)(XA + (rt * 16 + fr) * 144 + (ks * 32 + 8 * fq) * 2);
#pragma unroll
        for (int ct = 0; ct < 8; ++ct) {
            f32x4 acc = {0.f, 0.f, 0.f, 0.f};
            acc = mfma16(Af[0], Bf[ct][0], acc); acc = mfma16(Af[1], Bf[ct][1], acc);
#pragma unroll
            for (int r = 0; r < 4; ++r) GS[(4 * fq + r) * 132 + (ct >> 2) * 64 + (ct & 3) * 16 + fr] = acc[r];
        }
        WAVE_LDS_SYNC();
        {
            float ra[16], ia[16], xo[16], ov_[16];
#pragma unroll
            for (int tt = 0; tt < 16; ++tt) { ra[tt] = GS[tt * 132 + lane]; ia[tt] = GS[tt * 132 + 64 + lane]; xo[tt] = bf2f(*(const bf16_t*)(XA + (rt * 16 + tt) * 144 + lane * 2)); }
#pragma unroll
            for (int tt = 0; tt < 16; ++tt) {
                const float r = sigmoidf_(ra[tt] + ba), ig = sigmoidf_(ia[tt] + bx), la = sp8 * r, av = __expf(la);
                const float uu = __builtin_amdgcn_sqrtf(fmaxf(fmaf(-av, av, 1.f), 0.f)) * (ig * xo[tt]);
                hst = av * hst + uu; ap *= av;
                ov_[tt] = hst;
            }
            if (MODE == 1) {
#pragma unroll
                for (int tt = 0; tt < 16; ++tt) *(bf16_t*)(XA + (rt * 16 + tt) * 144 + lane * 2) = (bf16_t)f2bf(ov_[tt] * gelu_tanh((tt & 1) ? __uint_as_float(ypk[rt * 8 + (tt >> 1)] & 0xffff0000u) : bf2f(ypk[rt * 8 + (tt >> 1)] & 0xffffu)));
            }
        }
        WAVE_LDS_SYNC();
    }
    if (MODE == 1) {
        float ss = 0.f;
#pragma unroll
        for (int j = 0; j < 8; ++j) { const u32x4 v = *(const u32x4*)(XA + lane * 144 + j * 16);
#pragma unroll
            for (int q = 0; q < 4; ++q) { const float lo = bf2f(v[q] & 0xffffu), hi = __uint_as_float(v[q] & 0xffff0000u); ss += lo * lo + hi * hi; } }
        const float rs = rsqrtf(ss * (1.f / 64.f) + EPS) ;
#pragma unroll
        for (int t0 = 0; t0 < 64; t0 += 16) { float ovv[16];
#pragma unroll
            for (int tt = 0; tt < 16; ++tt) ovv[tt] = bf2f(*(const bf16_t*)(XA + (t0 + tt) * 144 + lane * 2));
#pragma unroll
            for (int tt = 0; tt < 16; ++tt) { const float rst = __int_as_float(__builtin_amdgcn_readlane(__float_as_int(rs), t0 + tt));
                *(bf16_t*)(XA + (t0 + tt) * 144 + lane * 2) = (bf16_t)f2bf(ovv[tt] * rst * gr); } }
        WAVE_LDS_SYNC();
#pragma unroll
        for (int j = 0; j < 8; ++j) { const int t = j * 8 + (lane >> 3), q16 = lane & 7;
            *(u32x4*)(mix + (size_t)(row0 + t) * D + DM + nb * 64 + q16 * 8) = *(const u32x4*)(XA + t * 144 + q16 * 16); }
    }
    if (MODE == 0) { ((float*)(a.ws + WS_SMALL + SM_RGA))[(size_t)item * DR + ch] = ap; ((float*)(a.ws + WS_SMALL + SM_RGH))[(size_t)item * DR + ch] = hst; }
    LDS_BARRIER();
}
__device__ __forceinline__ void rglru_scan(const Args& a, int G) {
    const int tid = otid();
    for (int i = blockIdx.x * 8 + (tid & 7); i < NBATCH * DR && tid < 8; i += G * 8) {
        const int b = i / DR, ch = i % DR;
        const float* A_ = (const float*)(a.ws + WS_SMALL + SM_RGA) + (size_t)(b * NC) * DR + ch; const float* H_ = (const float*)(a.ws + WS_SMALL + SM_RGH) + (size_t)(b * NC) * DR + ch;
        float* P_ = (float*)(a.ws + WS_SMALL + SM_RGP) + (size_t)(b * NC) * DR + ch;
        float hs = 0.f;
#pragma unroll 1
        for (int c0 = 0; c0 < NC; c0 += 16) {
            float av[16], hv[16];
#pragma unroll
            for (int j = 0; j < 16; ++j) { av[j] = A_[(c0 + j) * DR]; hv[j] = H_[(c0 + j) * DR]; }
#pragma unroll
            for (int j = 0; j < 16; ++j) { P_[(c0 + j) * DR] = hs; hs = av[j] * hs + hv[j]; }
        }
    }
}

__device__ __forceinline__ void phase_route(const Args& a, unsigned char* lds) {
    unsigned* wtot = (unsigned*)lds;
    int* pre = (int*)(lds + 256);
    int* tot = pre + 8;
    int* ce = tot + 16;
    unsigned* pref = (unsigned*)(lds + 2048);
    const int tid = otid(), lane = tid & 63, wave = tid >> 6, G = gridDim.x;
    const unsigned char* tok_p = (const unsigned char*)(a.ws + WS_SMALL + SM_TOKP); const float* tok_g = (const float*)(a.ws + WS_SMALL + SM_TOKG);
    int* row_tok = (int*)(a.ws + WS_SMALL + SM_ROWTOK); float* row_gate = (float*)(a.ws + WS_SMALL + SM_ROWGATE); int* tile_e = (int*)(a.ws + WS_SMALL + SM_TILEE);
    if (tid < 256) {
        unsigned long long hh = 0ull;
#pragma unroll
        for (int j = 0; j < 4; ++j) { const u32x4 v = ((const u32x4*)(tok_p + tid * 64))[j];
#pragma unroll
            for (int q = 0; q < 4; ++q)
#pragma unroll
                for (int bb = 0; bb < 4; ++bb) { const unsigned by = (v[q] >> (8 * bb)) & 0xffu; hh += (1ull << (8 * (by & 15u))) + (1ull << (8 * (by >> 4))); } }
        unsigned w[4];
#pragma unroll
        for (int i = 0; i < 4; ++i) { const unsigned two = (unsigned)(hh >> (16 * i)) & 0xffffu; w[i] = (two & 0xffu) | ((two >> 8) << 16); }
        unsigned inc[4];
#pragma unroll
        for (int i = 0; i < 4; ++i) { unsigned x = w[i];
#pragma unroll
            for (int o = 1; o < 64; o <<= 1) { const unsigned n = __shfl_up(x, o); if (lane >= o) x += n; }
            inc[i] = x; }
        if (lane == 63) {
#pragma unroll
            for (int i = 0; i < 4; ++i) wtot[wave * 4 + i] = inc[i]; }
        __builtin_amdgcn_s_waitcnt(0);
        __builtin_amdgcn_s_barrier();
#pragma unroll
        for (int i = 0; i < 4; ++i) { unsigned base = 0u;
            for (int ww = 0; ww < wave; ++ww) base += wtot[ww * 4 + i];
            pref[tid * 4 + i] = base + inc[i] - w[i];
            if (tid == 255) { const unsigned t2 = base + inc[i]; tot[2 * i] = (int)(t2 & 0xffffu); tot[2 * i + 1] = (int)(t2 >> 16); } }
    } else {
        __builtin_amdgcn_s_barrier();
    }
    __syncthreads();
    if (tid == 0) { int s_ = 0; for (int e = 0; e < 8; ++e) { tot[8 + e] = s_; s_ += (tot[e] + 255) & ~255; }
        if (blockIdx.x == 0) { int t = 0; for (int e = 0; e < 8; ++e) { const int n = (tot[e] + 255) >> 8; for (int j = 0; j < n; ++j) tile_e[t++] = e; tile_e[256 + e] = t; } tile_e[255] = t; } }
    __syncthreads();
    for (int ck = blockIdx.x; ck < 256; ck += G) {
        if (tid < 128) { const unsigned by = tok_p[ck * 64 + (tid >> 1)]; ce[tid] = (tid & 1) ? (int)(by >> 4) : (int)(by & 15u); }
        __syncthreads();
        if (tid < 128) { const int e = ce[tid];
            int rank = 0, w0cnt = 0;
#pragma unroll
            for (int q = 0; q < 8; ++q) { const unsigned long long mk = __ballot(e == q); if (e == q) rank = __popcll(mk & ((1ull << lane) - 1ull)); if (wave == 0 && lane == 0) ce[128 + q] = __popcll(mk); }
            __builtin_amdgcn_s_waitcnt(0);
            asm volatile("s_barrier" ::: "memory");
            if (wave == 1) rank += ce[128 + e];
            (void)w0cnt;
            const unsigned pw = pref[ck * 4 + (e >> 1)]; const int pr = (int)((e & 1) ? (pw >> 16) : (pw & 0xffffu));
            const int dest = tot[8 + e] + pr + rank;
            row_tok[dest] = ck * 64 + (tid >> 1); row_gate[dest] = tok_g[ck * 128 + tid]; ((int*)(a.ws + WS_SMALL + SM_ROWSLOT))[dest] = tid & 1; }
        else { asm volatile("s_barrier" ::: "memory"); }
        __syncthreads();
    }
}

#ifndef GEMM
#define GEMM gemm_fast
#endif
__global__ void __launch_bounds__(NT, 2) mk_fwd(Args a0) {
    extern __shared__ __attribute__((aligned(16))) unsigned char lds[];
    const int G = gridDim.x, bid = blockIdx.x, ph_lo = a0.ph_lo, ph_hi = a0.ph_hi;
    volatile LAS unsigned* xst = (volatile LAS unsigned*)(lds + LDS_BYTES - 64);
    if (threadIdx.x < 2) xst[threadIdx.x] = 0u;
    __syncthreads();
    const XcdBarrier xb = xcd_barrier_post((unsigned*)(a0.ws + WS_SMALL + SM_BAR), xst);
    int ph = 0;
#ifndef PROBE_CAT
#define PROBE_CAT 0
#define PROBE_N 1
#endif
#define PHASE_BEGIN(cat) if (ph >= ph_lo && ph < ph_hi) { for (int rep_ = 0; rep_ < ((cat) == PROBE_CAT ? PROBE_N : 1); ++rep_) { const bool lastrep = (rep_ + 1 == ((cat) == PROBE_CAT ? PROBE_N : 1)); (void)lastrep; const Args& a = *(const Args*)okarg(); unsigned char* const ws = a.ws; \
    bf16_t* const hn = (bf16_t*)(ws + WS_HN); bf16_t* const z = (bf16_t*)(ws + WS_Z); bf16_t* const mix = (bf16_t*)(ws + WS_MIX); bf16_t* const hid = (bf16_t*)(ws + WS_HID); \
    float* const gates = (float*)(ws + WS_SMALL + SM_GATES); int* const tok_e = (int*)(ws + WS_SMALL + SM_TOKP); float* const tok_g = (float*)(ws + WS_SMALL + SM_TOKG); \
    const int* const row_tok = (const int*)(ws + WS_SMALL + SM_ROWTOK); const float* const row_gate = (const float*)(ws + WS_SMALL + SM_ROWGATE); const int* const tile_e = (const int*)(ws + WS_SMALL + SM_TILEE); \
    (void)hn; (void)z; (void)mix; (void)hid; (void)gates; (void)tok_e; (void)tok_g; (void)row_tok; (void)row_gate; (void)tile_e;
#define PHASE_END(dosync) } for (int rep_ = 0; rep_ < (PROBE_CAT == 6 ? PROBE_N : 1); ++rep_) if ((dosync) && ph + 1 < ph_hi) { xcd_barrier(xb); } } ++ph;

    PHASE_BEGIN(1) phase_prologue(a, lds); __syncthreads();
        phase_rowpass<0, 1, 1, false>(lds, a.in[I_X], hn, nullptr, a.in[I_GMIX], (float*)(ws + WS_SSQ), a.in[I_WIN] + 2048, DIN, a.in[I_BIN] + 2048, gates, nullptr, nullptr, nullptr); PHASE_END(true)
    { constexpr int l = 0;
#define LAYER_PTRS bf16_t* const hb = (bf16_t*)(ws + (l ? WS_H1 : WS_HN)); bf16_t* const hbo = (bf16_t*)(ws + (l ? WS_HN : WS_H1)); float* const ssq = (float*)(ws + WS_SSQ + l * SSQ_STRIDE); float* const ssqo = (float*)(ws + WS_SSQ + (1 - l) * SSQ_STRIDE); (void)hb; (void)hbo; (void)ssq; (void)ssqo;
        PHASE_BEGIN(3) LAYER_PTRS { if (l == 1) phase_rowpass<1, 1, 0, false>(lds, nullptr, hb, nullptr, a.in[I_GMIX] + l * D, nullptr, a.in[I_WIN] + (size_t)l * D * DIN + 2048, DIN, a.in[I_BIN] + l * DIN + 2048, gates, nullptr, nullptr, nullptr);
            GridOrder S{M / 256, ZW / 256, G, bid}; EpiZ E{z, a.in[I_BIN] + l * DIN, ssq};
            GEMM(lds, hb, (const bf16_t*)(ws + (l ? WS_W_IN1 : WS_W_IN0)), D, S, E); } PHASE_END(true)
        PHASE_BEGIN(4) LAYER_PTRS { MlRegs cur, nxt; int it = bid; if (it < 1024) ml_load(a, l, it, cur); nxt = cur;
            for (; it < 1024; it += G) { if (it + G < 1024) ml_load(a, l, it + G, nxt); ml_compute(a, lds, l, it, cur); cur = nxt; }
            for (; it < 1280; it += G) rglru_fast<0>(a, lds, l, it - 1024); } PHASE_END(true)
        PHASE_BEGIN(0) LAYER_PTRS mlstm_scan(a, G); rglru_scan(a, G); PHASE_END(true)
        PHASE_BEGIN(5) LAYER_PTRS { MoRegs cur, nxt; ConvW cwq, cwk; int hw = -1; int it = bid; if (it < 1024) mo_load(a, l, it, cur); nxt = cur;
            for (; it < 1024; it += G) { if (it + G < 1024) mo_load(a, l, it + G, nxt); mo_compute(a, lds, l, it, cur, cwq, cwk, hw); cur = nxt; }
            for (; it < 1280; it += G) rglru_fast<1>(a, lds, l, it - 1024); } PHASE_END(true)
        PHASE_BEGIN(0) LAYER_PTRS { GridOrder S{M / 256, D / 256, G, bid}; EpiHres<l == 0> E{l == 0 ? a.in[I_X] : nullptr, hb, ssq};
            GEMM(lds, mix, (const bf16_t*)(ws + (l ? WS_W_OUT1 : WS_W_OUT0)), D, S, E); } PHASE_END(true)
        if (l == 0) {
            PHASE_BEGIN(3) LAYER_PTRS { GridOrder S{M / 256, 2 * DFF / 256, G, bid}; EpiSwiglu E{hid, ssq, nullptr};
                GEMM(lds, hb, (const bf16_t*)(ws + WS_W_FFGU), D, S, E);
                { constexpr int nun = (M / 256) * (2 * DFF / 256); const int first = nun % G;
                  TailOrder S2{M / 256, D / 256, G, bid, first}; EpiStoreBf16 E2{(bf16_t*)(ws + WS_PP0)};
                  GEMM(lds, (const bf16_t*)(ws + WS_PB0), (const bf16_t*)(ws + WS_W_PP0), DPLE, S2, E2); } } PHASE_END(true)
            PHASE_BEGIN(0) LAYER_PTRS { GridOrder S{M / 256, D / 256, G, bid}; EpiHres<false> E{nullptr, hb, ssq};
                GEMM(lds, hid, (const bf16_t*)(ws + WS_W_FFD), DFF, S, E); } PHASE_END(true)
        } else {
            PHASE_BEGIN(2) LAYER_PTRS phase_rowpass<1, 2, 0, false>(lds, nullptr, hb, nullptr, a.in[I_GFFN] + l * D, nullptr, a.in[I_WROUTER], 8, nullptr, nullptr, (unsigned char*)tok_e, tok_g, nullptr, ws + WS_HN8); PHASE_END(true)
            PHASE_BEGIN(12) LAYER_PTRS phase_route(a, lds); PHASE_END(true)
            PHASE_BEGIN(3) LAYER_PTRS { MoeOrder<true> S{tile_e[255], 2 * DFF / 256, G, bid, row_tok, (size_t)5632 * D}; S.init(tile_e); EpiSwiglu8 E{ws + WS_HID, 1.f / 32.f};
                gemm_fast<true>(lds, (const bf16_t*)(ws + WS_HN8), (const bf16_t*)(ws + WS_W_EGU), D, S, E); } PHASE_END(true)
            PHASE_BEGIN(0) LAYER_PTRS { MoeOrder<false> S{tile_e[255], D / 256, G, bid, nullptr, (size_t)D * DFF}; S.init(tile_e); EpiMoeDown E{hb, (bf16_t*)a.out, row_tok, (const int*)(ws + WS_SMALL + SM_ROWSLOT), row_gate, 1.f / 32.f};
                gemm_fast<true>(lds, (const bf16_t*)(ws + WS_HID), (const bf16_t*)(ws + WS_W_ED), DFF, S, E);
                { const int nun = tile_e[255] * (D / 256); const int first = nun > 2 * G ? nun - 2 * G : 0;
                  TailOrder S2{M / 256, D / 256, G, bid, first < G ? first : 0}; EpiStoreBf16 E2{(bf16_t*)a.out + (size_t)M * D};
                  GEMM(lds, (const bf16_t*)(ws + WS_PB1), (const bf16_t*)(ws + WS_W_PP1), DPLE, S2, E2); } } PHASE_END(true)
            PHASE_BEGIN(0) LAYER_PTRS phase_rowpass<1, 0, 1, true>(lds, nullptr, hb, (const bf16_t*)a.out, nullptr, ssq, nullptr, 0, nullptr, nullptr, nullptr, nullptr, nullptr); PHASE_END(true)
        }
        PHASE_BEGIN(10) LAYER_PTRS { GridOrder S{M / 256, D / 256, G, bid};
            EpiPle E{hb, hbo, l == 0 ? (const bf16_t*)(ws + WS_PP0) : (const bf16_t*)a.out + (size_t)M * D, ssqo, ssq}; GEMM(lds, hb, (const bf16_t*)(ws + WS_W_PG) + (size_t)l * D * D, D, S, E);
            if (l == 0 && bid == 0) { for (int i = otid(); i < D / 2; i += NT) ((unsigned*)(ws + WS_H1 + (size_t)M * D * 2))[i] = 0u; } } PHASE_END(true)
    }
    { constexpr int l = 1;
        PHASE_BEGIN(3) LAYER_PTRS { if (l == 1) phase_rowpass<1, 1, 0, false>(lds, nullptr, hb, nullptr, a.in[I_GMIX] + l * D, nullptr, a.in[I_WIN] + (size_t)l * D * DIN + 2048, DIN, a.in[I_BIN] + l * DIN + 2048, gates, nullptr, nullptr, nullptr);
            GridOrder S{M / 256, ZW / 256, G, bid}; EpiZ E{z, a.in[I_BIN] + l * DIN, ssq};
            GEMM(lds, hb, (const bf16_t*)(ws + (l ? WS_W_IN1 : WS_W_IN0)), D, S, E); } PHASE_END(true)
        PHASE_BEGIN(4) LAYER_PTRS { MlRegs cur, nxt; int it = bid; if (it < 1024) ml_load(a, l, it, cur); nxt = cur;
            for (; it < 1024; it += G) { if (it + G < 1024) ml_load(a, l, it + G, nxt); ml_compute(a, lds, l, it, cur); cur = nxt; }
            for (; it < 1280; it += G) rglru_fast<0>(a, lds, l, it - 1024); } PHASE_END(true)
        PHASE_BEGIN(0) LAYER_PTRS mlstm_scan(a, G); rglru_scan(a, G); PHASE_END(true)
        PHASE_BEGIN(5) LAYER_PTRS { MoRegs cur, nxt; ConvW cwq, cwk; int hw = -1; int it = bid; if (it < 1024) mo_load(a, l, it, cur); nxt = cur;
            for (; it < 1024; it += G) { if (it + G < 1024) mo_load(a, l, it + G, nxt); mo_compute(a, lds, l, it, cur, cwq, cwk, hw); cur = nxt; }
            for (; it < 1280; it += G) rglru_fast<1>(a, lds, l, it - 1024); } PHASE_END(true)
        PHASE_BEGIN(0) LAYER_PTRS { GridOrder S{M / 256, D / 256, G, bid}; EpiHres<l == 0> E{l == 0 ? a.in[I_X] : nullptr, hb, ssq};
            GEMM(lds, mix, (const bf16_t*)(ws + (l ? WS_W_OUT1 : WS_W_OUT0)), D, S, E); } PHASE_END(true)
        if (l == 0) {
            PHASE_BEGIN(3) LAYER_PTRS { GridOrder S{M / 256, 2 * DFF / 256, G, bid}; EpiSwiglu E{hid, ssq, nullptr};
                GEMM(lds, hb, (const bf16_t*)(ws + WS_W_FFGU), D, S, E);
                { constexpr int nun = (M / 256) * (2 * DFF / 256); const int first = nun % G;
                  TailOrder S2{M / 256, D / 256, G, bid, first}; EpiStoreBf16 E2{(bf16_t*)(ws + WS_PP0)};
                  GEMM(lds, (const bf16_t*)(ws + WS_PB0), (const bf16_t*)(ws + WS_W_PP0), DPLE, S2, E2); } } PHASE_END(true)
            PHASE_BEGIN(0) LAYER_PTRS { GridOrder S{M / 256, D / 256, G, bid}; EpiHres<false> E{nullptr, hb, ssq};
                GEMM(lds, hid, (const bf16_t*)(ws + WS_W_FFD), DFF, S, E); } PHASE_END(true)
        } else {
            PHASE_BEGIN(2) LAYER_PTRS phase_rowpass<1, 2, 0, false>(lds, nullptr, hb, nullptr, a.in[I_GFFN] + l * D, nullptr, a.in[I_WROUTER], 8, nullptr, nullptr, (unsigned char*)tok_e, tok_g, nullptr, ws + WS_HN8); PHASE_END(true)
            PHASE_BEGIN(12) LAYER_PTRS phase_route(a, lds); PHASE_END(true)
            PHASE_BEGIN(3) LAYER_PTRS { MoeOrder<true> S{tile_e[255], 2 * DFF / 256, G, bid, row_tok, (size_t)5632 * D}; S.init(tile_e); EpiSwiglu8 E{ws + WS_HID, 1.f / 32.f};
                gemm_fast<true>(lds, (const bf16_t*)(ws + WS_HN8), (const bf16_t*)(ws + WS_W_EGU), D, S, E); } PHASE_END(true)
            PHASE_BEGIN(0) LAYER_PTRS { MoeOrder<false> S{tile_e[255], D / 256, G, bid, nullptr, (size_t)D * DFF}; S.init(tile_e); EpiMoeDown E{hb, (bf16_t*)a.out, row_tok, (const int*)(ws + WS_SMALL + SM_ROWSLOT), row_gate, 1.f / 32.f};
                gemm_fast<true>(lds, (const bf16_t*)(ws + WS_HID), (const bf16_t*)(ws + WS_W_ED), DFF, S, E);
                { const int nun = tile_e[255] * (D / 256); const int first = nun > 2 * G ? nun - 2 * G : 0;
                  TailOrder S2{M / 256, D / 256, G, bid, first < G ? first : 0}; EpiStoreBf16 E2{(bf16_t*)a.out + (size_t)M * D};
                  GEMM(lds, (const bf16_t*)(ws + WS_PB1), (const bf16_t*)(ws + WS_W_PP1), DPLE, S2, E2); } } PHASE_END(true)
            PHASE_BEGIN(0) LAYER_PTRS phase_rowpass<1, 0, 1, true>(lds, nullptr, hb, (const bf16_t*)a.out, nullptr, ssq, nullptr, 0, nullptr, nullptr, nullptr, nullptr, nullptr); PHASE_END(true)
        }
        PHASE_BEGIN(10) LAYER_PTRS { GridOrder S{M / 256, D / 256, G, bid};
            EpiPle E{hb, hbo, l == 0 ? (const bf16_t*)(ws + WS_PP0) : (const bf16_t*)a.out + (size_t)M * D, ssqo, ssq}; GEMM(lds, hb, (const bf16_t*)(ws + WS_W_PG) + (size_t)l * D * D, D, S, E);
            if (l == 0 && bid == 0) { for (int i = otid(); i < D / 2; i += NT) ((unsigned*)(ws + WS_H1 + (size_t)M * D * 2))[i] = 0u; } } PHASE_END(true)
    }
    PHASE_BEGIN(0) phase_rowpass<1, 0, 2, false>(lds, nullptr, hn, nullptr, a.in[I_GFINAL], nullptr, nullptr, 0, nullptr, nullptr, nullptr, nullptr, a.out); PHASE_END(false)
}

extern "C" void kernel_launch(void* const* d_in, const int* in_sizes, int n_in, void* d_out, int out_size,
                              void* d_ws, size_t ws_size, hipStream_t stream) {
    static int grid = 0;
    if (grid == 0) {
        if (n_in != 29 || out_size != M * D || ws_size < WS_END) { fprintf(stderr, "kernel_launch: unexpected problem (n_in %d out %d ws %zu)\n", n_in, out_size, ws_size); grid = -1; return; }
        int dev = 0, cus = 0, per_cu = 0;
        (void)hipGetDevice(&dev);
        (void)hipDeviceGetAttribute(&cus, hipDeviceAttributeMultiprocessorCount, dev);
        (void)hipFuncSetAttribute((const void*)mk_fwd, hipFuncAttributeMaxDynamicSharedMemorySize, LDS_BYTES);
        (void)hipOccupancyMaxActiveBlocksPerMultiprocessor(&per_cu, (const void*)mk_fwd, NT, LDS_BYTES);
        if (per_cu < 1) { fprintf(stderr, "kernel_launch: occupancy query says %d blocks per CU\n", per_cu); per_cu = 1; }
        grid = cus;
    }
    if (grid < 0) return;
    Args a{};
    for (int i = 0; i < 29; ++i) a.in[i] = (const float*)d_in[i];
    a.out = (float*)d_out; a.ws = (unsigned char*)d_ws; a.ph_lo = 0; a.ph_hi = 1000;
    (void)hipMemsetAsync((unsigned char*)d_ws + WS_SMALL + SM_BAR, 0, 16 * 1024, stream);
    void* args[] = {&a};
    hipError_t e = hipLaunchCooperativeKernel((void*)mk_fwd, dim3(grid), dim3(NT), args, LDS_BYTES, stream);
    if (e != hipSuccess) fprintf(stderr, "cooperative launch failed: %s (grid %d)\n", hipGetErrorString(e), grid);
}
```

```cpp
#include <hip/hip_runtime.h>
#include <hip/hip_cooperative_groups.h>
#include <cstdio>
#include <cstdint>
namespace cg = cooperative_groups;

constexpr int NT = 512;
constexpr int D = 1024, NBATCH = 4, SEQ = 4096, M = NBATCH * SEQ;
constexpr int CH = 64, NC = SEQ / CH, NH = 4, DH = 128, DM = 512, DR = 512, NBR = 8, DBR = 64;
constexpr int DIN = 3080, ZW = 3072, DFF = 2816, NE = 8, DPLE = 256;
constexpr int PMAX = 2 * M + NE * 256, NTILE_MAX = PMAX / 256;
constexpr int EROWS = 129;
constexpr float EPS = 1e-6f;
constexpr int ZQ = 0, ZK = 512, ZV = 1024, ZO = 1536, ZXR = 2048, ZYR = 2560;

constexpr size_t MiB = 1u << 20;
constexpr size_t WS_SMALL = 0;
constexpr size_t WS_W_IN0 = 4 * MiB;
constexpr size_t WS_W_OUT0 = 10 * MiB;
constexpr size_t WS_W_FFGU = 12 * MiB;
constexpr size_t WS_W_FFD = 23 * MiB;
constexpr size_t WS_PB0 = WS_W_FFD + 5632 * 1024;
constexpr size_t WS_W_PP0 = WS_PB0 + 8 * MiB;
constexpr size_t WS_H1 = 4 * MiB;
constexpr size_t WS_W_IN1 = 37 * MiB;
constexpr size_t WS_W_OUT1 = 43 * MiB;
constexpr size_t WS_W_PG = 45 * MiB;
constexpr size_t WS_W_PP1 = 49 * MiB;
constexpr size_t WS_W_EGU = WS_W_PP1 + MiB / 2;
constexpr size_t WS_W_ED = WS_W_EGU + 88 * MiB;
constexpr size_t WS_HN8 = WS_W_EGU + 44 * MiB;
constexpr size_t WS_PB1 = WS_W_ED + 44 * MiB;
constexpr size_t WS_HN = WS_PB1 + 8 * MiB;
static_assert(WS_H1 + (size_t)(M + 1) * D * 2 <= WS_W_IN1 && WS_W_PP0 + 1024 * 256 * 2 <= WS_W_IN1, "map");
constexpr size_t WS_RF = 222 * MiB;
constexpr size_t WS_Z = WS_RF;
constexpr size_t WS_CT = WS_Z + 96 * MiB;
constexpr size_t WS_DN = WS_CT + 32 * MiB;
constexpr size_t WS_MIX = WS_CT + 72 * MiB;
constexpr size_t WS_HID = WS_RF;
constexpr size_t WS_PP0 = WS_RF + 130 * MiB;
constexpr size_t WS_SSQ = WS_RF + 201 * MiB;
constexpr size_t SSQ_STRIDE = (size_t)(M + 16) * 64;
constexpr size_t WS_SCAL = WS_RF + 204 * MiB;
constexpr size_t WS_END = 435 * MiB;
static_assert(WS_MIX + (size_t)M * D * 2 <= WS_SSQ && WS_HID + (size_t)PMAX * DFF * 2 <= WS_SSQ && WS_SSQ + 2 * SSQ_STRIDE <= WS_END, "map");
static_assert(WS_HN + (size_t)(M + 1) * D * 2 <= WS_RF, "map");
static_assert(WS_MIX + (size_t)M * D * 2 <= WS_END, "map");
static_assert(WS_HID + (size_t)PMAX * DFF * 2 <= WS_END, "map");
static_assert(WS_DN + 1024 * 128 * 4 <= WS_PP0 && WS_PP0 + (size_t)M * D * 2 <= WS_MIX && WS_HID + (size_t)M * DFF * 2 <= WS_PP0, "map");
constexpr size_t SM_GATES = 0;
constexpr size_t SM_TOKE = 512 * 1024;
constexpr size_t SM_TOKG = SM_TOKE + 128 * 1024;
constexpr size_t SM_ROWTOK = SM_TOKG + 128 * 1024;
constexpr size_t SM_ROWGATE = SM_ROWTOK + 160 * 1024;
constexpr size_t SM_TILEE = SM_ROWGATE + 160 * 1024;
constexpr size_t SM_ROWSLOT = SM_TILEE + 4 * 1024;
constexpr size_t SM_TOKP = SM_ROWSLOT + 160 * 1024;
constexpr size_t SM_BL = SM_TOKP + 16 * 1024;
constexpr size_t SM_AMAX = SM_BL + 4 * 1024;
constexpr size_t SM_MPREV = SM_AMAX + 4 * 1024;
constexpr size_t SM_RGA = 2 * MiB;
constexpr size_t SM_RGH = SM_RGA + 512 * 1024;
constexpr size_t SM_RGP = SM_RGH + 512 * 1024;
constexpr size_t SM_BAR = SM_RGP + 512 * 1024;
constexpr size_t SM_RGW = SM_BAR + 16 * 1024;
static_assert(SM_MPREV + 4096 <= SM_RGA && SM_RGW + 256 * 1024 <= 4 * MiB, "small map");

constexpr int LDS_BYTES = 147456;

typedef unsigned short bf16_t;
typedef float f32x4 __attribute__((ext_vector_type(4)));
typedef unsigned u32x4 __attribute__((ext_vector_type(4)));
typedef unsigned u32x2 __attribute__((ext_vector_type(2)));

__device__ __forceinline__ float bf2f(unsigned v) { return __uint_as_float(v << 16); }
__device__ __forceinline__ unsigned pk2(float lo, float hi);
__device__ __forceinline__ unsigned f2bf(float f) { return pk2(f, 0.f) & 0xffffu; }
typedef float f32x2_t __attribute__((ext_vector_type(2))); typedef __bf16 bf16x2_t __attribute__((ext_vector_type(2)));
__device__ __forceinline__ unsigned pk2(float lo, float hi) { f32x2_t v = {lo, hi}; bf16x2_t b = __builtin_convertvector(v, bf16x2_t); return __builtin_bit_cast(unsigned, b); }
__device__ __forceinline__ unsigned pk4_fp8(float a, float b, float c, float d) { int w = __builtin_amdgcn_cvt_pk_fp8_f32(a, b, 0, false); w = __builtin_amdgcn_cvt_pk_fp8_f32(c, d, w, true); return (unsigned)w; }
__device__ __forceinline__ float frcp(float x) { return __builtin_amdgcn_rcpf(x); }
__device__ __forceinline__ float sigmoidf_(float x) { return frcp(1.f + __expf(-x)); }
__device__ __forceinline__ float siluf_(float x) { return x * frcp(1.f + __expf(-x)); }
__device__ __forceinline__ float logsigmoidf_(float x) { return fminf(x, 0.f) - log1pf(__expf(-fabsf(x))); }
__device__ __forceinline__ float gelu_tanh(float y) { const float u2 = 1.5957691216057308f * (y + 0.044715f * y * y * y); return y * frcp(1.f + __expf(-u2)); }
__device__ __forceinline__ float wave_sum(float v) {
#pragma unroll
    for (int o = 1; o < 64; o <<= 1) v += __shfl_xor(v, o);
    return v;
}
__device__ __forceinline__ float wave_max(float v) {
#pragma unroll
    for (int o = 1; o < 64; o <<= 1) v = fmaxf(v, __shfl_xor(v, o));
    return v;
}

__device__ __forceinline__ float dpp_f(float v, const int ctrl_sel) {
    const int x = __float_as_int(v); int r;
    if (ctrl_sel == 0) r = __builtin_amdgcn_update_dpp(x, x, 0xB1, 0xF, 0xF, false);
    else if (ctrl_sel == 1) r = __builtin_amdgcn_update_dpp(x, x, 0x4E, 0xF, 0xF, false);
    else if (ctrl_sel == 2) r = __builtin_amdgcn_update_dpp(x, x, 0x141, 0xF, 0xF, false);
    else r = __builtin_amdgcn_update_dpp(x, x, 0x140, 0xF, 0xF, false);
    return __int_as_float(r);
}
__device__ __forceinline__ float sum4(float v) { v += dpp_f(v, 0); v += dpp_f(v, 1); return v; }
__device__ __forceinline__ float sum8(float v) { v = sum4(v); v += dpp_f(v, 2); return v; }
__device__ __forceinline__ float sum16(float v) { v = sum8(v); v += dpp_f(v, 3); return v; }
#define WAVE_LDS_SYNC() asm volatile("s_waitcnt lgkmcnt(0)" ::: "memory")
#define LDS_BARRIER() do { asm volatile("s_waitcnt lgkmcnt(0)" ::: "memory"); __builtin_amdgcn_s_barrier(); asm volatile("" ::: "memory"); } while (0)
__device__ __forceinline__ int otid() { int t = threadIdx.x; asm volatile("" : "+v"(t)); return t; }
__device__ __forceinline__ int oint(int v) { asm volatile("" : "+s"(v)); return v; }
__device__ __forceinline__ const void* okarg() { auto p = __builtin_amdgcn_kernarg_segment_ptr(); asm volatile("" : "+s"(p)); return (const void*)p; }

struct Args { const float* in[29]; float* out; unsigned char* ws; int ph_lo, ph_hi; };
enum { I_X = 0, I_P, I_GMIX, I_WIN, I_BIN, I_WCQK, I_BCQK, I_GMH, I_WCR, I_BCR, I_WRA, I_BRA, I_WRI, I_BRI, I_LAM, I_GR, I_WOUT, I_GFFN,
       I_WFG, I_WFU, I_WFD, I_WROUTER, I_WEG, I_WEU, I_WED, I_GPLE, I_WPG, I_WPP, I_GFINAL };


#define XB_TMO      128
#define XB_XCNT(j)  (256  + 64 * (j))
#define XB_XSUB(j)  (1280 + 64 * (j))
#define XB_XGEN(j)  (2304 + 64 * (j))
#define XB_TOP      3328
#define XB_TOPGEN   3392
#define XCD_BAR_WORDS 3456
#define XB_SPIN_CAP (1u << 18)
#define LAS __attribute__((address_space(3)))
__device__ __forceinline__ unsigned xb_ld(unsigned* p)              { return __hip_atomic_load(p, __ATOMIC_RELAXED, __HIP_MEMORY_SCOPE_AGENT); }
__device__ __forceinline__ unsigned xb_add(unsigned* p, unsigned v) { return __hip_atomic_fetch_add(p, v, __ATOMIC_RELAXED, __HIP_MEMORY_SCOPE_AGENT); }
__device__ __forceinline__ unsigned xb_xcc_id() { return (unsigned)__builtin_amdgcn_s_getreg((3 << 11) | 20) & 0xFu; }
#define XB_SPIN(cond, bar) do { unsigned _sp = 0; while (cond) { __builtin_amdgcn_s_sleep(1); \
    if ((++_sp & 255u) == 0u) { if (xb_ld(&(bar)[XB_TMO])) break; if (_sp > XB_SPIN_CAP) { atomicAdd(&(bar)[XB_TMO], 1u); break; } } } } while (0)
struct XcdBarrier { unsigned* bar; unsigned x; volatile LAS unsigned* st; };
__device__ __forceinline__ XcdBarrier xcd_barrier_post(unsigned* bar, volatile LAS unsigned* st) {
    XcdBarrier b; b.bar = bar; b.x = xb_xcc_id(); b.st = st;
    if (threadIdx.x == 0) (void)xb_add(&bar[XB_XCNT(b.x)], 1u);
    return b;
}
__device__ __forceinline__ void xcd_barrier_complete(unsigned* bar, unsigned x, unsigned& nloc, unsigned& nx) {
    const unsigned G = gridDim.x * gridDim.y * gridDim.z;
    unsigned sum, cnt, mine, sp = 0u;
    for (;;) {
        sum = 0u; cnt = 0u; mine = 0u;
#pragma unroll
        for (unsigned j = 0; j < 16; ++j) { const unsigned c = xb_ld(&bar[XB_XCNT(j)]); sum += c; cnt += (c > 0u) ? 1u : 0u; mine = (j == x) ? c : mine; }
        if (sum == G) break;
        __builtin_amdgcn_s_sleep(1);
        if ((++sp & 255u) == 0u) { if (xb_ld(&bar[XB_TMO])) break; if (sp > XB_SPIN_CAP) { atomicAdd(&bar[XB_TMO], 1u); break; } }
    }
    nloc = mine > 0u ? mine : 1u; nx = cnt > 0u ? cnt : 1u;
}
__device__ __forceinline__ void xcd_barrier(const XcdBarrier& b) {
    asm volatile("s_waitcnt vmcnt(0)" ::: "memory");
    __syncthreads();
    if (threadIdx.x == 0) {
        unsigned* bar = b.bar;
        __builtin_amdgcn_s_waitcnt(0);
        unsigned nloc = b.st[0], nx = b.st[1];
        if (nloc == 0u) { xcd_barrier_complete(bar, b.x, nloc, nx); b.st[0] = nloc; b.st[1] = nx; }
        const unsigned old = xb_add(&bar[XB_XSUB(b.x)], 1u);
        const unsigned gen = old / nloc;
        if (old + 1u == (gen + 1u) * nloc) {
            __builtin_amdgcn_fence(__ATOMIC_RELEASE, "agent");
            asm volatile("s_waitcnt vmcnt(0)" ::: "memory");
            const unsigned og = xb_add(&bar[XB_TOP], 1u);
            const unsigned tg = og / nx;
            if (og + 1u == (tg + 1u) * nx) xb_add(&bar[XB_TOPGEN], 1u);
            else XB_SPIN(xb_ld(&bar[XB_TOPGEN]) == tg, bar);
            __builtin_amdgcn_fence(__ATOMIC_ACQUIRE, "agent");
            xb_add(&bar[XB_XGEN(b.x)], 1u);
            asm volatile("s_waitcnt vmcnt(0)" ::: "memory");
        } else {
            XB_SPIN(xb_ld(&bar[XB_XGEN(b.x)]) == gen, bar);
            __builtin_amdgcn_fence(__ATOMIC_ACQUIRE, "agent");
            asm volatile("s_waitcnt vmcnt(0)" ::: "memory");
        }
    }
    __syncthreads();
}

struct CvtJob { const float* src; bf16_t* dst; int ld, k0, c0, K, n0; const float* gain; int fp8; };
__device__ __forceinline__ void cvt_plain_job(CvtJob& o, const float* src, int K, int N, bf16_t* dst, int tile, const float* gain) {
    const int nt = N / 64, kb = tile / nt, nb = tile % nt; o.src = src; o.dst = dst; o.ld = N; o.k0 = kb * 64; o.c0 = nb * 64; o.K = K; o.n0 = nb * 64; o.gain = gain; o.fp8 = 0;
}
__device__ __forceinline__ void cvt_gu_job(CvtJob& o, const float* g, const float* u, bf16_t* dst, int tile, const float* gain) {
    const int nt = 5632 / 64, kb = tile / nt, nb = tile % nt, n0 = nb * 64, tt = n0 >> 8, half = (n0 >> 7) & 1, w = n0 & 127;
    o.src = half ? u : g; o.dst = dst; o.ld = DFF; o.k0 = kb * 64; o.c0 = tt * 128 + w; o.K = 1024; o.n0 = n0; o.gain = gain; o.fp8 = 0;
}
__device__ __forceinline__ void cvt_job(const Args& a, int it, CvtJob& o) {
    unsigned char* ws = a.ws;
    constexpr int T_IN = 16 * 48, T_OUT = 16 * 16, T_GU = 16 * 88, T_FD = 44 * 16, T_PG = 256, T_PP = 4 * 16;
    int r = it;
    if (r < 2 * T_IN) { const int l = r / T_IN, tile = r % T_IN; const int nt = ZW / 64, kb = tile / nt, nb = tile % nt, n0 = nb * 64;
        o.src = a.in[I_WIN] + (size_t)l * D * DIN; o.dst = (bf16_t*)(ws + (l ? WS_W_IN1 : WS_W_IN0)); o.ld = DIN; o.k0 = kb * 64; o.c0 = n0 < 2048 ? n0 : n0 + 8; o.K = D; o.n0 = n0; o.gain = a.in[I_GMIX] + l * D; o.fp8 = 0; return; }
    r -= 2 * T_IN;
    if (r < 2 * T_OUT) { const int l = r / T_OUT; cvt_plain_job(o, a.in[I_WOUT] + (size_t)l * D * D, D, D, (bf16_t*)(ws + (l ? WS_W_OUT1 : WS_W_OUT0)), r % T_OUT, nullptr); return; }
    r -= 2 * T_OUT;
    if (r < T_GU) { cvt_gu_job(o, a.in[I_WFG], a.in[I_WFU], (bf16_t*)(ws + WS_W_FFGU), r, a.in[I_GFFN]); return; }
    r -= T_GU;
    if (r < T_FD) { cvt_plain_job(o, a.in[I_WFD], DFF, D, (bf16_t*)(ws + WS_W_FFD), r, nullptr); return; }
    r -= T_FD;
    if (r < 2 * T_PG) { const int l = r / T_PG; cvt_plain_job(o, a.in[I_WPG] + (size_t)l * D * D, D, D, (bf16_t*)(ws + WS_W_PG) + (size_t)l * D * D, r % T_PG, a.in[I_GPLE] + l * D); return; }
    r -= 2 * T_PG;
    if (r < 2 * T_PP) { const int l = r / T_PP; cvt_plain_job(o, a.in[I_WPP] + (size_t)l * DPLE * D, DPLE, D, (bf16_t*)(ws + (l ? WS_W_PP1 : WS_W_PP0)), r % T_PP, nullptr); return; }
    r -= 2 * T_PP;
    if (r < 8 * T_GU) { const int e = r / T_GU; cvt_gu_job(o, a.in[I_WEG] + (size_t)e * D * DFF, a.in[I_WEU] + (size_t)e * D * DFF, (bf16_t*)(ws + WS_W_EGU + (size_t)e * 5632 * D), r % T_GU, nullptr); o.fp8 = 1; return; }
    r -= 8 * T_GU;
    { const int e = r / T_FD; cvt_plain_job(o, a.in[I_WED] + (size_t)e * DFF * D, DFF, D, (bf16_t*)(ws + WS_W_ED + (size_t)e * D * DFF), r % T_FD, nullptr); o.fp8 = 1; }
}
__device__ __forceinline__ void phase_prologue(const Args& a, unsigned char* lds) {
    unsigned char* ws = a.ws;
    const int G = gridDim.x, t = otid();
    constexpr int T_IN = 16 * 48, T_OUT = 16 * 16, T_GU = 16 * 88, T_FD = 44 * 16, T_PG = 256, T_PP = 4 * 16;
    constexpr int NT_ALL = 2 * T_IN + 2 * T_OUT + T_GU + T_FD + 2 * T_PG + 2 * T_PP + 8 * T_GU + 8 * T_FD;
    constexpr int NB = 4;
    const int kk0 = t >> 4, cc = (t & 15) * 4, n = t >> 3, kg = t & 7;
    float4 v[NB][2], vn[NB][2];
    int it0 = blockIdx.x * NB;
    if (it0 < NT_ALL) {
#pragma unroll
        for (int b = 0; b < NB; ++b) { const int it = it0 + b < NT_ALL ? it0 + b : NT_ALL - 1; CvtJob jq; cvt_job(a, it, jq);
#pragma unroll
            for (int j = 0; j < 2; ++j) v[b][j] = *(const float4*)(jq.src + (size_t)(jq.k0 + kk0 + 32 * j) * jq.ld + jq.c0 + cc); }
    }
    for (; it0 < NT_ALL; it0 += G * NB) {
        const int itn = it0 + G * NB;
        if (itn < NT_ALL) {
#pragma unroll
            for (int b = 0; b < NB; ++b) { const int it = itn + b < NT_ALL ? itn + b : NT_ALL - 1; CvtJob jq; cvt_job(a, it, jq);
#pragma unroll
                for (int j = 0; j < 2; ++j) vn[b][j] = *(const float4*)(jq.src + (size_t)(jq.k0 + kk0 + 32 * j) * jq.ld + jq.c0 + cc); }
        }
#pragma unroll
        for (int b = 0; b < NB; ++b) { float* tl = (float*)lds + b * (64 * 65); const int it = it0 + b < NT_ALL ? it0 + b : NT_ALL - 1; CvtJob jq; cvt_job(a, it, jq);
#pragma unroll
            for (int j = 0; j < 2; ++j) { float4 w = v[b][j];
                if (jq.gain) { const float gk = jq.gain[jq.k0 + kk0 + 32 * j]; w.x *= gk; w.y *= gk; w.z *= gk; w.w *= gk; }
                float* p = tl + (kk0 + 32 * j) * 65 + cc; p[0] = w.x; p[1] = w.y; p[2] = w.z; p[3] = w.w; } }
        LDS_BARRIER();
#pragma unroll
        for (int b = 0; b < NB; ++b) { if (it0 + b >= NT_ALL) break; const float* s_ = (const float*)lds + b * (64 * 65) + (8 * kg) * 65 + n; CvtJob jq; cvt_job(a, it0 + b, jq);
            if (jq.fp8) { u32x2 o; o.x = pk4_fp8(32.f * s_[0], 32.f * s_[65], 32.f * s_[130], 32.f * s_[195]); o.y = pk4_fp8(32.f * s_[260], 32.f * s_[325], 32.f * s_[390], 32.f * s_[455]);
                *(u32x2*)((unsigned char*)jq.dst + (size_t)(jq.n0 + n) * jq.K + jq.k0 + 8 * kg) = o; }
            else { u32x4 o; o.x = pk2(s_[0], s_[65]); o.y = pk2(s_[130], s_[195]); o.z = pk2(s_[260], s_[325]); o.w = pk2(s_[390], s_[455]);
                *(u32x4*)(jq.dst + (size_t)(jq.n0 + n) * jq.K + jq.k0 + 8 * kg) = o; } }
        LDS_BARRIER();
#pragma unroll
        for (int b = 0; b < NB; ++b) { v[b][0] = vn[b][0]; v[b][1] = vn[b][1]; }
    }
    const size_t np4 = (size_t)M * DPLE / 4;
    for (size_t i = (size_t)blockIdx.x * NT + otid(); i < 2 * np4; i += (size_t)G * NT) {
        const float4 v = ((const float4*)a.in[I_P])[i]; u32x2 o; o.x = pk2(v.x, v.y); o.y = pk2(v.z, v.w);
        if (i < np4) ((u32x2*)(ws + WS_PB0))[i] = o; else ((u32x2*)(ws + WS_PB1))[i - np4] = o; }
    for (int i = blockIdx.x * NT + otid(); i < 2 * 8 * 2 * 64 * 64; i += G * NT) {
        const int d = i & 63, e = (i >> 6) & 63, g = (i >> 12) & 1, ln = i >> 13;
        ((bf16_t*)(ws + WS_SMALL + SM_RGW))[i] = (bf16_t)f2bf((g ? a.in[I_WRI] : a.in[I_WRA])[((size_t)ln * 64 + d) * 64 + e]);
    }
    if (blockIdx.x == 0) { for (int i = otid(); i < D / 4; i += NT) ((unsigned*)(ws + WS_HN8 + (size_t)M * D))[i] = 0u; for (int i = otid(); i < D / 2; i += NT) ((unsigned*)(ws + WS_HN + (size_t)M * D * 2))[i] = 0u; if (otid() < 32) ((float*)(ws + WS_SSQ + (otid() >> 4) * SSQ_STRIDE))[(size_t)M * 16 + (otid() & 15)] = 0.f; }
    for (int i = blockIdx.x * NT + otid(); i < PMAX; i += G * NT) { ((int*)(ws + WS_SMALL + SM_ROWTOK))[i] = M; ((float*)(ws + WS_SMALL + SM_ROWGATE))[i] = 0.f; }
}

template <int IN, bool ADDY> struct RawRow {
    f32x4 x[IN == 0 ? 4 : 1]; u32x2 h[IN == 1 ? 4 : 1]; u32x2 y[ADDY ? 4 : 1];
    __device__ __forceinline__ void load(const float* xin, const bf16_t* hb, const bf16_t* y1, int r, int lane) {
#pragma unroll
        for (int j = 0; j < 4; ++j) {
            if (IN == 0) x[j] = ((const f32x4*)(xin + (size_t)r * D) + lane)[64 * j]; else h[j] = ((const u32x2*)(hb + (size_t)r * D) + lane)[64 * j];
            if (ADDY) y[j] = ((const u32x2*)(y1 + (size_t)r * D) + lane)[64 * j]; }
    }
    __device__ __forceinline__ void copy_from(const RawRow& o) {
#pragma unroll
        for (int j = 0; j < 4; ++j) { if (IN == 0) x[j] = o.x[j]; else h[j] = o.h[j]; if (ADDY) y[j] = o.y[j]; }
    }
};
template <int IN, int AUX, int WR, bool ADDY>
__device__ __forceinline__ void phase_rowpass(unsigned char* lds, const float* xin, bf16_t* hb, const bf16_t* y1, const float* g, float* ssq,
                                              const float* auxW, int auxld, const float* auxB, float* gates, unsigned char* tok_p, float* tok_g, float* fout, unsigned char* h8 = nullptr) {
    float* wl = (float*)lds;
    const int tid = otid(), lane = tid & 63, wave = tid >> 6;
    if (AUX) {
        for (int i = tid; i < D * 8; i += NT) wl[i] = auxW[(size_t)(i >> 3) * auxld + (i & 7)];
        __syncthreads();
    }
    f32x4 gv[4];
    if (AUX || WR == 2) {
#pragma unroll
        for (int j = 0; j < 4; ++j) gv[j] = *(const f32x4*)(g + 4 * lane + 256 * j);
    }
    RawRow<1, ADDY> cur, nxt;
    const int rstep = gridDim.x * 8; int row = blockIdx.x * 8 + wave;
    if (IN == 1) { if (row < M) cur.load(xin, hb, y1, row, lane); nxt.copy_from(cur); }
    for (; row < M; row += rstep) {
        if (IN == 1) { if (row + rstep < M) nxt.load(xin, hb, y1, row + rstep, lane); }
        f32x4 v[4]; float ss = 0.f;
#pragma unroll
        for (int j = 0; j < 4; ++j) {
            if (IN == 0) v[j] = ((const f32x4*)(xin + (size_t)row * D) + lane)[64 * j];
            else { const u32x2 w = cur.h[j]; v[j] = (f32x4){bf2f(w.x & 0xffffu), __uint_as_float(w.x & 0xffff0000u), bf2f(w.y & 0xffffu), __uint_as_float(w.y & 0xffff0000u)}; }
            if (ADDY) { const u32x2 y = cur.y[j];
                v[j].x += bf2f(y.x & 0xffffu); v[j].y += __uint_as_float(y.x & 0xffff0000u); v[j].z += bf2f(y.y & 0xffffu); v[j].w += __uint_as_float(y.y & 0xffff0000u); }
            ss += (v[j].x * v[j].x + v[j].y * v[j].y) + (v[j].z * v[j].z + v[j].w * v[j].w); }
        if (IN == 1) cur.copy_from(nxt);
        float tot; { const int ri = __float_as_int(sum16(ss)); tot = (__int_as_float(__builtin_amdgcn_readlane(ri, 0)) + __int_as_float(__builtin_amdgcn_readlane(ri, 16))) + (__int_as_float(__builtin_amdgcn_readlane(ri, 32)) + __int_as_float(__builtin_amdgcn_readlane(ri, 48))); }
        const float rstd = __builtin_amdgcn_rsqf(tot * (1.f / D) + EPS);
        if (WR == 1) {
            u32x2* o = (u32x2*)(hb + (size_t)row * D) + lane;
#pragma unroll
            for (int j = 0; j < 4; ++j) { u32x2 w; w.x = pk2(v[j].x, v[j].y); w.y = pk2(v[j].z, v[j].w); o[64 * j] = w; }
            if (lane < 16) ssq[(size_t)row * 16 + lane] = lane == 0 ? tot : 0.f;
        }
        if (AUX || WR == 2) {
#pragma unroll
            for (int j = 0; j < 4; ++j) v[j] = v[j] * rstd * gv[j];
        }
        if (AUX == 2 && h8) {
#pragma unroll
            for (int j = 0; j < 4; ++j) ((unsigned*)(h8 + (size_t)row * D) + lane)[64 * j] = pk4_fp8(v[j].x, v[j].y, v[j].z, v[j].w);
        }
        if (WR == 2) {
            f32x4* o = (f32x4*)(fout + (size_t)row * D) + lane;
#pragma unroll
            for (int j = 0; j < 4; ++j) o[64 * j] = v[j];
        }
        if (AUX) {
            float acc[8];
#pragma unroll
            for (int c = 0; c < 8; ++c) acc[c] = 0.f;
#pragma unroll
            for (int j = 0; j < 4; ++j)
#pragma unroll
                for (int q = 0; q < 4; ++q) {
                    const int k = 4 * lane + 256 * j + q; const float xv = v[j][q];
                    const f32x4 w0 = *(const f32x4*)(wl + k * 8), w1 = *(const f32x4*)(wl + k * 8 + 4);
                    acc[0] += xv * w0.x; acc[1] += xv * w0.y; acc[2] += xv * w0.z; acc[3] += xv * w0.w;
                    acc[4] += xv * w1.x; acc[5] += xv * w1.y; acc[6] += xv * w1.z; acc[7] += xv * w1.w;
                }
#pragma unroll
            for (int c = 0; c < 8; ++c) { const float r16 = sum16(acc[c]); const int ri = __float_as_int(r16);
                acc[c] = (__int_as_float(__builtin_amdgcn_readlane(ri, 0)) + __int_as_float(__builtin_amdgcn_readlane(ri, 16))) + (__int_as_float(__builtin_amdgcn_readlane(ri, 32)) + __int_as_float(__builtin_amdgcn_readlane(ri, 48))); }
            if (AUX == 1) {
                if (lane < 8) { float s_ = acc[0];
#pragma unroll
                    for (int c = 1; c < 8; ++c) s_ = (lane == c) ? acc[c] : s_;
                    gates[(size_t)row * 8 + lane] = s_ + auxB[lane]; }
            } else {
                if (lane == 0) {
                    int e1 = 0; float v1 = acc[0];
#pragma unroll
                    for (int c = 1; c < 8; ++c) if (acc[c] > v1) { v1 = acc[c]; e1 = c; }
                    int e2 = -1; float v2 = -INFINITY;
#pragma unroll
                    for (int c = 0; c < 8; ++c) if (c != e1 && acc[c] > v2) { v2 = acc[c]; e2 = c; }
                    const float p2 = __expf(v2 - v1), inv = 1.f / (1.f + p2);
                    tok_p[row] = (unsigned char)(e1 | (e2 << 4)); tok_g[row * 2] = inv; tok_g[row * 2 + 1] = p2 * inv;
                }
            }
        }
    }
    __syncthreads();
}

struct Unit { int pm, pn; const int* rows; size_t bofs; };
struct GridOrder {
    static constexpr bool GATHER = false;
    int nM, nN, G, c;
    __device__ __forceinline__ bool next(int i, Unit& u) const {
        const int L0_ = i * G + c, nwg = nM * nN; if (L0_ >= nwg) return false;
        const int q_ = nwg / 8, r_ = nwg % 8, xcd = L0_ % 8, off = L0_ / 8; const int L = (xcd < r_ ? xcd * (q_ + 1) : r_ * (q_ + 1) + (xcd - r_) * q_) + off;
        const int grp = L / (8 * nN), fm = grp * 8, gsz = (nM - fm) < 8 ? (nM - fm) : 8, w = L % (8 * nN);
        u.pm = fm + w % gsz; u.pn = w / gsz; u.rows = nullptr; u.bofs = 0; return true;
    }
};
struct TailOrder {
    static constexpr bool GATHER = false;
    int nM, nN, G, c, first;
    __device__ __forceinline__ bool next(int i, Unit& u) const {
        if (c < first) return false; const int L = i * (G - first) + (c - first); if (L >= nM * nN) return false;
        u.pm = L / nN; u.pn = L % nN; u.rows = nullptr; u.bofs = 0; return true;
    }
};
template <bool GATHER_> struct MoeOrder {
    static constexpr bool GATHER = GATHER_;
    int nM, nN, G, c; const int* rows; size_t estride; int te[8];
    __device__ __forceinline__ void init(const int* tile_e) {
#pragma unroll
        for (int e = 0; e < 8; ++e) te[e] = __builtin_amdgcn_readfirstlane(tile_e[256 + e]);
    }
    __device__ __forceinline__ bool next(int i, Unit& u) const {
        const int L0_ = i * G + c, nwg = nM * nN; if (L0_ >= nwg) return false;
        const int q_ = nwg / 8, r_ = nwg % 8, xcd = L0_ % 8, off = L0_ / 8; const int L = (xcd < r_ ? xcd * (q_ + 1) : r_ * (q_ + 1) + (xcd - r_) * q_) + off;
        const int grp = L / (8 * nN), fm = grp * 8, gsz = (nM - fm) < 8 ? (nM - fm) : 8, w = L % (8 * nN);
        u.pm = fm + w % gsz; u.pn = w / gsz; u.rows = rows; int e = 0;
#pragma unroll
        for (int q = 0; q < 7; ++q) e += (u.pm >= te[q]) ? 1 : 0;
        u.bofs = (size_t)e * estride; return true;
    }
};


namespace pg8 {
#define PG8_LAS __attribute__((address_space(3)))
typedef short bf16x8 __attribute__((ext_vector_type(8)));
constexpr int BM = 256, BK = 64, HALF = 128, HTB = HALF * BK * 2, STAGE_BYTES = 8 * HTB;
__device__ __forceinline__ int lds_byte(int r, int c) { const int st = (r >> 4) * 2 + (c >> 5), rr = r & 15, cc = c & 31, ob = rr * 64 + cc * 2; return st * 1024 + (ob ^ (((ob >> 9) & 1) << 5)); }
__device__ __forceinline__ void stage_rc(int b, int& R, int& C) { const int st = b / 1024, sb = b % 1024, swz = sb ^ (((sb >> 9) & 1) << 5); R = (st >> 1) * 16 + swz / 64; C = (st & 1) * 32 + (swz % 64) / 2; }

typedef int i32x8 __attribute__((ext_vector_type(8))); typedef int i32x4 __attribute__((ext_vector_type(4)));
__device__ __forceinline__ i32x8 cat8(bf16x8 lo, bf16x8 hi) { return __builtin_shufflevector(__builtin_bit_cast(i32x4, lo), __builtin_bit_cast(i32x4, hi), 0, 1, 2, 3, 4, 5, 6, 7); }
__device__ __forceinline__ int perm32(int rho) { const int n = rho >> 4, i = rho & 15; return 8 * (i >> 2) + 4 * n + (i & 3); }
__device__ __forceinline__ void unit_voff(const Unit& u, const int (&R)[2], const int (&C)[2], int KB  , unsigned (&vo)[2][2]) {
#pragma unroll
    for (int h = 0; h < 2; ++h)
#pragma unroll
        for (int i = 0; i < 2; ++i) { int row = u.pm * BM + h * HALF + R[i]; if (u.rows) row = u.rows[row]; vo[h][i] = (unsigned)row * (unsigned)KB + (unsigned)C[i] * 2u; }
}

template <class Epi, class Sched, bool ALIGN_EPI, bool GATHER, bool FP8 = false>
__device__ __forceinline__ void gemm_phase(unsigned char* lds_, const bf16_t* A_, const bf16_t* Bt_, const int K_, const Sched& S, const Epi& E) {
    PG8_LAS unsigned char* lds = (PG8_LAS unsigned char*)lds_;
    const int K = oint(K_);
    const int tid = otid(), wid = __builtin_amdgcn_readfirstlane(tid >> 6), lane = tid & 63, wr = wid >> 2, wc = wid & 3, fr = lane & 15, fq = lane >> 4;
    const int KB = FP8 ? K : 2 * K;
    const int nt = KB / (BK * 2);
    int R[2], C[2]; unsigned voffA[2], voffB[2];
#pragma unroll
    for (int i = 0; i < 2; ++i) { stage_rc(tid * 16 + i * 8192, R[i], C[i]); voffA[i] = (unsigned)(R[i] * KB + C[i] * 2);
        const int Rb = Epi::PERM ? ((R[i] & ~31) + perm32(R[i] & 31)) : R[i]; voffB[i] = (unsigned)(Rb * KB + C[i] * 2); }
    const size_t kstep = (size_t)(BK * 2);
    const size_t hstep = (size_t)HALF * KB;
    const size_t tstep = 2 * hstep;
    const unsigned ldsw = (unsigned)wid * 1024u;
    const int pc0 = FP8 ? 32 * (fq >> 1) + 16 * (fq & 1) : fq * 8; constexpr int KOFF = FP8 ? 16 : 1024;
    const int aoff = lds_byte(wr * 64 + fr, pc0), boff = lds_byte(wc * 32 + fr, pc0);
#define PG8_SA(b, h) (((b) * 2 + (h)) * HTB)
#define PG8_SB(b, h) ((4 + (b) * 2 + (h)) * HTB)
#define PG8_STAGE(bufoff, gbase, voff) do { _Pragma("unroll") for (int _i = 0; _i < 2; ++_i) \
        __builtin_amdgcn_global_load_lds((const unsigned*)((const char*)(gbase) + (voff)[_i]), (PG8_LAS unsigned*)(lds + (bufoff) + ldsw + _i * 8192), 16, 0, 0); } while (0)
#define PG8_STAGE_A(bufoff, base, h, VO) do { if constexpr (GATHER) { PG8_STAGE(bufoff, base, (VO)[h]); } else { PG8_STAGE(bufoff, (base) + (h) * hstep, voffA); } } while (0)
#define PG8_LDA(dst, b, h) do { _Pragma("unroll") for (int m = 0; m < 4; ++m) _Pragma("unroll") for (int k = 0; k < 2; ++k) dst[m][k] = *(const PG8_LAS bf16x8*)(lds + PG8_SA(b, h) + aoff + m * 2048 + k * KOFF); } while (0)
#define PG8_LDB(dst, b, h) do { _Pragma("unroll") for (int n = 0; n < 2; ++n) _Pragma("unroll") for (int k = 0; k < 2; ++k) dst[n][k] = *(const PG8_LAS bf16x8*)(lds + PG8_SB(b, h) + boff + n * 2048 + k * KOFF); } while (0)
#define PG8_MMA(ai, bj, At, Bt) do { __builtin_amdgcn_s_setprio(1); _Pragma("unroll") for (int m = 0; m < 4; ++m) _Pragma("unroll") for (int n = 0; n < 2; ++n) { \
        if constexpr (FP8) { const i32x8 b8_ = cat8(Bt[n][0], Bt[n][1]), a8_ = cat8(At[m][0], At[m][1]); \
            asm volatile("v_mfma_scale_f32_16x16x128_f8f6f4 %0, %1, %2, %0, %3, %3 op_sel_hi:[0,0,0]" : "+v"(acc[ai][bj][m][n]) : "v"(b8_), "v"(a8_), "v"(scale1)); } \
        else { _Pragma("unroll") for (int k = 0; k < 2; ++k) acc[ai][bj][m][n] = __builtin_amdgcn_mfma_f32_16x16x32_bf16(Bt[n][k], At[m][k], acc[ai][bj][m][n], 0, 0, 0); } } __builtin_amdgcn_s_setprio(0); } while (0)
#define PG8_WAIT_V(n) asm volatile("s_waitcnt vmcnt(" #n ")" ::: "memory")
#define PG8_WAIT_L(n) asm volatile("s_waitcnt lgkmcnt(" #n ")" ::: "memory")
#define PG8_BAR __builtin_amdgcn_s_barrier()
#define PG8_SCHED __builtin_amdgcn_sched_barrier(0)
    const int scale1 = 0x7f7f7f7f;
    Unit cur, nxt; int ui = 0;
    if (!S.next(0, cur)) return;
    f32x4 acc[2][2][4][2];
#pragma unroll
    for (int a = 0; a < 2; ++a)
#pragma unroll
        for (int b = 0; b < 2; ++b)
#pragma unroll
            for (int m = 0; m < 4; ++m)
#pragma unroll
                for (int n = 0; n < 2; ++n) acc[a][b][m][n] = (f32x4){0.f, 0.f, 0.f, 0.f};
    bf16x8 At[4][2], B0[2][2], B1[2][2];
    unsigned vc[2][2], vn[2][2];
    if constexpr (GATHER) unit_voff(cur, R, C, KB, vc);
    const char* cA = GATHER ? (const char*)A_ : (const char*)A_ + (size_t)cur.pm * tstep;
    const char* cB = (const char*)Bt_ + cur.bofs * (FP8 ? 1 : 2) + (size_t)cur.pn * tstep;
    PG8_STAGE(PG8_SB(0, 0), cB, voffB); PG8_STAGE(PG8_SB(0, 1), cB + hstep, voffB); PG8_STAGE_A(PG8_SA(0, 0), cA, 0, vc); PG8_STAGE_A(PG8_SA(0, 1), cA, 1, vc);
    if (wr == 1) PG8_BAR;
    PG8_WAIT_V(2); PG8_BAR;
    PG8_STAGE(PG8_SB(1, 0), cB + kstep, voffB); PG8_STAGE_A(PG8_SA(1, 0), cA + kstep, 0, vc); PG8_STAGE(PG8_SB(1, 1), cB + hstep + kstep, voffB);
    PG8_WAIT_V(6); PG8_BAR;
    for (;;) {
        const bool has_next = S.next(ui + 1, nxt);
        const char* nA = cA; const char* nB = cB;
        if (has_next) { nB = (const char*)Bt_ + nxt.bofs * (FP8 ? 1 : 2) + (size_t)nxt.pn * tstep; if constexpr (!GATHER) nA = (const char*)A_ + (size_t)nxt.pm * tstep; }
        int rn[2][2];
        if constexpr (GATHER) {
#pragma unroll
            for (int h = 0; h < 2; ++h)
#pragma unroll
                for (int i = 0; i < 2; ++i) rn[h][i] = cur.rows[(has_next ? nxt.pm : cur.pm) * BM + h * HALF + R[i]]; }
        for (int t = 0; t < nt; t += 2) {
            const bool last = (t == nt - 2);
            if constexpr (GATHER) { if (last) {
#pragma unroll
                for (int h = 0; h < 2; ++h)
#pragma unroll
                    for (int i = 0; i < 2; ++i) { int r_ = rn[h][i]; asm volatile("" : "+v"(r_));
                        vn[h][i] = (unsigned)r_ * (unsigned)KB + (unsigned)C[i] * 2u; } } }
            const char* a1 = cA + (size_t)(t + 1) * kstep;
            const char* a2 = last ? nA : cA + (size_t)(t + 2) * kstep; const char* b2 = last ? nB : cB + (size_t)(t + 2) * kstep;
            const char* a3 = a2 + kstep; const char* b3 = b2 + kstep;
            unsigned v2[2][2];
            if constexpr (GATHER) {
#pragma unroll
                for (int h = 0; h < 2; ++h)
#pragma unroll
                    for (int i = 0; i < 2; ++i) v2[h][i] = last ? vn[h][i] : vc[h][i]; }
            PG8_LDB(B0, 0, 0); PG8_LDB(B1, 0, 1); PG8_SCHED; PG8_LDA(At, 0, 0); PG8_STAGE_A(PG8_SA(1, 1), a1, 1, vc);
            PG8_WAIT_V(8); PG8_WAIT_L(0); PG8_BAR; PG8_MMA(0, 0, At, B0); PG8_MMA(0, 1, At, B1); PG8_BAR; PG8_SCHED;
            PG8_LDA(At, 0, 1); PG8_STAGE(PG8_SB(0, 0), b2, voffB); PG8_STAGE(PG8_SB(0, 1), b2 + hstep, voffB); PG8_STAGE_A(PG8_SA(0, 0), a2, 0, v2);
            PG8_WAIT_V(8); PG8_WAIT_L(0); PG8_BAR; PG8_MMA(1, 0, At, B0); PG8_MMA(1, 1, At, B1); PG8_BAR; PG8_SCHED;
            PG8_LDB(B0, 1, 0); PG8_LDB(B1, 1, 1); PG8_SCHED; PG8_LDA(At, 1, 0); PG8_STAGE_A(PG8_SA(0, 1), a2, 1, v2);
            PG8_WAIT_V(8); PG8_WAIT_L(0); PG8_BAR; PG8_MMA(0, 0, At, B0); PG8_MMA(0, 1, At, B1); PG8_BAR; PG8_SCHED;
            PG8_LDA(At, 1, 1); PG8_STAGE(PG8_SB(1, 0), b3, voffB); PG8_STAGE(PG8_SB(1, 1), b3 + hstep, voffB); PG8_STAGE_A(PG8_SA(1, 0), a3, 0, v2);
            PG8_WAIT_V(8); PG8_WAIT_L(0); PG8_BAR; PG8_MMA(1, 0, At, B0); PG8_MMA(1, 1, At, B1); PG8_BAR; PG8_SCHED;
        }
        if constexpr (ALIGN_EPI) { if (wr == 0) PG8_BAR; }
        { int pm_ = cur.pm, pn_ = cur.pn, fr_ = fr, fq_ = fq;
          asm volatile("" : "+s"(pm_), "+s"(pn_), "+v"(fr_), "+v"(fq_));
          E(acc, pm_, pn_, wr, wc, fr_, fq_); }
        if (!has_next) break;
#pragma unroll
        for (int a = 0; a < 2; ++a)
#pragma unroll
            for (int b = 0; b < 2; ++b)
#pragma unroll
                for (int m = 0; m < 4; ++m)
#pragma unroll
                    for (int n = 0; n < 2; ++n) acc[a][b][m][n] = (f32x4){0.f, 0.f, 0.f, 0.f};
        cur = nxt; cA = nA; cB = nB; ++ui;
        if constexpr (GATHER) {
#pragma unroll
            for (int h = 0; h < 2; ++h)
#pragma unroll
                for (int i = 0; i < 2; ++i) vc[h][i] = vn[h][i]; }
        if constexpr (ALIGN_EPI) { if (wr == 1) PG8_BAR; }
    }
    PG8_WAIT_V(0);
    if constexpr (!ALIGN_EPI) { if (wr == 0) PG8_BAR; }
    PG8_BAR;
#undef PG8_SA
#undef PG8_SB
#undef PG8_STAGE
#undef PG8_STAGE_A
#undef PG8_LDA
#undef PG8_LDB
#undef PG8_MMA
#undef PG8_WAIT_V
#undef PG8_WAIT_L
#undef PG8_BAR
#undef PG8_SCHED
}
}
template <bool FP8 = false, class Epi, class Sched>
__device__ __forceinline__ void gemm_fast(unsigned char* lds, const bf16_t* A, const bf16_t* Bt, int K, const Sched& S, const Epi& E) {
    pg8::gemm_phase<Epi, Sched, true, Sched::GATHER, FP8>(lds, A, Bt, K, S, E);
    __syncthreads();
}

typedef f32x4 AccT[2][2][4][2];
#define EPI_ROW(ai, m) (pm * 256 + (ai) * 128 + wr * 64 + (m) * 16 + fr)
__device__ __forceinline__ void unpack8(const u32x4 w, f32x4& lo, f32x4& hi) {
    lo = (f32x4){bf2f(w.x & 0xffffu), __uint_as_float(w.x & 0xffff0000u), bf2f(w.y & 0xffffu), __uint_as_float(w.y & 0xffff0000u)};
    hi = (f32x4){bf2f(w.z & 0xffffu), __uint_as_float(w.z & 0xffff0000u), bf2f(w.w & 0xffffu), __uint_as_float(w.w & 0xffff0000u)};
}
__device__ __forceinline__ u32x4 pack8(const f32x4 v0, const f32x4 v1) { u32x4 w; w.x = pk2(v0.x, v0.y); w.y = pk2(v0.z, v0.w); w.z = pk2(v1.x, v1.y); w.w = pk2(v1.z, v1.w); return w; }
__device__ __forceinline__ float dot8(const f32x4 a, const f32x4 b) { return ((a.x * a.x + a.y * a.y) + (a.z * a.z + a.w * a.w)) + ((b.x * b.x + b.y * b.y) + (b.z * b.z + b.w * b.w)); }
__device__ __forceinline__ void epi_rstd(const float* ssq, const int* rowmap, int pm, int wr, int fr, int fq, float (&rs)[2][4]) {
    f32x4 p[2][4];
#pragma unroll
    for (int ai = 0; ai < 2; ++ai)
#pragma unroll
        for (int m = 0; m < 4; ++m) { int row = EPI_ROW(ai, m); if (rowmap) row = rowmap[row]; p[ai][m] = *(const f32x4*)((const char*)ssq + ((unsigned)row * 16u + 4u * (unsigned)fq) * 4u); }
#pragma unroll
    for (int ai = 0; ai < 2; ++ai)
#pragma unroll
        for (int m = 0; m < 4; ++m) { float t = (p[ai][m].x + p[ai][m].y) + (p[ai][m].z + p[ai][m].w); t += __shfl_xor(t, 16); t += __shfl_xor(t, 32); rs[ai][m] = __builtin_amdgcn_rsqf(t * (1.f / 1024.f) + EPS); }
}
__device__ __forceinline__ void epi_ssq(float* ssq, int row, int slot, float s_, int fq) { s_ += __shfl_xor(s_, 16); s_ += __shfl_xor(s_, 32); if (fq == 0) *(float*)((char*)ssq + ((unsigned)row * 16u + (unsigned)slot) * 4u) = s_; }

struct EpiZ { static constexpr bool PERM = true; bf16_t* z; const float* bin; const float* ssq;
    __device__ __forceinline__ void operator()(const AccT& acc, int pm, int pn, int wr, int wc, int fr, int fq) const {
        const int c0 = pn * 256 + wc * 32 + 8 * fq; f32x4 bv[2][2]; float rs[2][4];
#pragma unroll
        for (int bj = 0; bj < 2; ++bj)
#pragma unroll
            for (int n = 0; n < 2; ++n) { const int cc = c0 + bj * 128 + n * 4; bv[bj][n] = *(const f32x4*)(bin + (cc < 2048 ? cc : cc + 8)); }
        epi_rstd(ssq, nullptr, pm, wr, fr, fq, rs);
#pragma unroll
        for (int ai = 0; ai < 2; ++ai)
#pragma unroll
            for (int m = 0; m < 4; ++m) { bf16_t* rp = z + (size_t)EPI_ROW(ai, m) * ZW + c0; const float r = rs[ai][m];
#pragma unroll
                for (int bj = 0; bj < 2; ++bj) *(u32x4*)(rp + bj * 128) = pack8(acc[ai][bj][m][0] * r + bv[bj][0], acc[ai][bj][m][1] * r + bv[bj][1]); } } };
template <bool XB> struct EpiHres { static constexpr bool PERM = true; const float* xb; bf16_t* hb; float* ssq;
    __device__ __forceinline__ void operator()(const AccT& acc, int pm, int pn, int wr, int wc, int fr, int fq) const {
        const int c0 = pn * 256 + wc * 32 + 8 * fq;
#pragma unroll
        for (int ai = 0; ai < 2; ++ai) {
            f32x4 lx[4][2][2]; u32x4 lh[4][2];
#pragma unroll
            for (int m = 0; m < 4; ++m)
#pragma unroll
                for (int bj = 0; bj < 2; ++bj) { const size_t o = (size_t)EPI_ROW(ai, m) * D + c0 + bj * 128;
                    if (XB) { lx[m][bj][0] = *(const f32x4*)(xb + o); lx[m][bj][1] = *(const f32x4*)(xb + o + 4); } else lh[m][bj] = *(const u32x4*)(hb + o); }
#pragma unroll
            for (int m = 0; m < 4; ++m) { float s_ = 0.f; const int row = EPI_ROW(ai, m);
#pragma unroll
                for (int bj = 0; bj < 2; ++bj) { f32x4 b0, b1; if (XB) { b0 = lx[m][bj][0]; b1 = lx[m][bj][1]; } else unpack8(lh[m][bj], b0, b1);
                    const f32x4 v0 = b0 + acc[ai][bj][m][0], v1 = b1 + acc[ai][bj][m][1]; s_ += dot8(v0, v1);
                    *(u32x4*)(hb + (size_t)row * D + c0 + bj * 128) = pack8(v0, v1); }
                epi_ssq(ssq, row, pn * 4 + wc, s_, fq); }
        } } };
struct EpiSwiglu { static constexpr bool PERM = true; bf16_t* hid; const float* ssq; const int* rowmap;
    __device__ __forceinline__ void operator()(const AccT& acc, int pm, int pn, int wr, int wc, int fr, int fq) const {
        const int c0 = pn * 128 + wc * 32 + 8 * fq; float rs[2][4];
        epi_rstd(ssq, rowmap, pm, wr, fr, fq, rs);
#pragma unroll
        for (int ai = 0; ai < 2; ++ai)
#pragma unroll
            for (int m = 0; m < 4; ++m) { u32x4 w; const float r = rs[ai][m];
#pragma unroll
                for (int n = 0; n < 2; ++n) { const f32x4 g = acc[ai][0][m][n] * r, u = acc[ai][1][m][n] * r;
                    w[2 * n] = pk2(siluf_(g.x) * u.x, siluf_(g.y) * u.y); w[2 * n + 1] = pk2(siluf_(g.z) * u.z, siluf_(g.w) * u.w); }
                *(u32x4*)(hid + (size_t)EPI_ROW(ai, m) * DFF + c0) = w; } } };
struct EpiSwiglu8 { static constexpr bool PERM = true; unsigned char* hid8; float sc;
    __device__ __forceinline__ void operator()(const AccT& acc, int pm, int pn, int wr, int wc, int fr, int fq) const {
        const int c0 = pn * 128 + wc * 32 + 8 * fq;
#pragma unroll
        for (int ai = 0; ai < 2; ++ai)
#pragma unroll
            for (int m = 0; m < 4; ++m) { u32x2 w;
#pragma unroll
                for (int n = 0; n < 2; ++n) { const f32x4 g = acc[ai][0][m][n] * sc, u = acc[ai][1][m][n] * sc;
                    w[n] = pk4_fp8(siluf_(g.x) * u.x, siluf_(g.y) * u.y, siluf_(g.z) * u.z, siluf_(g.w) * u.w); }
                *(u32x2*)(hid8 + (size_t)EPI_ROW(ai, m) * DFF + c0) = w; } } };
struct EpiMoeDown { static constexpr bool PERM = true; bf16_t* hb; bf16_t* y1; const int* row_tok; const int* row_slot; const float* row_gate; float sc;
    __device__ __forceinline__ void operator()(const AccT& acc, int pm, int pn, int wr, int wc, int fr, int fq) const {
        const int c0 = pn * 256 + wc * 32 + 8 * fq;
        int tok[2][4], slot[2][4]; float gt[2][4];
#pragma unroll
        for (int ai = 0; ai < 2; ++ai)
#pragma unroll
            for (int m = 0; m < 4; ++m) { const int row = EPI_ROW(ai, m); tok[ai][m] = row_tok[row]; slot[ai][m] = row_slot[row]; gt[ai][m] = row_gate[row] * sc; }
#pragma unroll
        for (int ai = 0; ai < 2; ++ai) {
            u32x4 lh[4][2];
#pragma unroll
            for (int m = 0; m < 4; ++m) { const bool rmw = tok[ai][m] < M && slot[ai][m] == 0;
#pragma unroll
                for (int bj = 0; bj < 2; ++bj) lh[m][bj] = rmw ? *(const u32x4*)(hb + (size_t)tok[ai][m] * D + c0 + bj * 128) : (u32x4){0u, 0u, 0u, 0u}; }
#pragma unroll
            for (int m = 0; m < 4; ++m) { if (tok[ai][m] >= M) continue; const size_t o = (size_t)tok[ai][m] * D + c0; const float g = gt[ai][m];
                if (slot[ai][m] == 0) {
#pragma unroll
                    for (int bj = 0; bj < 2; ++bj) { f32x4 b0, b1; unpack8(lh[m][bj], b0, b1); *(u32x4*)(hb + o + bj * 128) = pack8(b0 + g * acc[ai][bj][m][0], b1 + g * acc[ai][bj][m][1]); }
                } else {
#pragma unroll
                    for (int bj = 0; bj < 2; ++bj) *(u32x4*)(y1 + o + bj * 128) = pack8(g * acc[ai][bj][m][0], g * acc[ai][bj][m][1]);
                } }
        } } };
struct EpiStoreBf16 { static constexpr bool PERM = true; bf16_t* out;
    __device__ __forceinline__ void operator()(const AccT& acc, int pm, int pn, int wr, int wc, int fr, int fq) const {
        const int c0 = pn * 256 + wc * 32 + 8 * fq;
#pragma unroll
        for (int ai = 0; ai < 2; ++ai)
#pragma unroll
            for (int m = 0; m < 4; ++m)
#pragma unroll
                for (int bj = 0; bj < 2; ++bj) *(u32x4*)(out + (size_t)EPI_ROW(ai, m) * D + c0 + bj * 128) = pack8(acc[ai][bj][m][0], acc[ai][bj][m][1]); } };
struct EpiPle { static constexpr bool PERM = true; const bf16_t* hin; bf16_t* hb; const bf16_t* pp; float* ssq; const float* ssq_in;
    __device__ __forceinline__ void operator()(const AccT& acc, int pm, int pn, int wr, int wc, int fr, int fq) const {
        const int c0 = pn * 256 + wc * 32 + 8 * fq; float rs[2][4];
        epi_rstd(ssq_in, nullptr, pm, wr, fr, fq, rs);
        u32x4 sg[2][4][2];
#pragma unroll
        for (int ai = 0; ai < 2; ++ai)
#pragma unroll
            for (int m = 0; m < 4; ++m)
#pragma unroll
                for (int bj = 0; bj < 2; ++bj) { f32x4 a0 = acc[ai][bj][m][0] * rs[ai][m], a1 = acc[ai][bj][m][1] * rs[ai][m];
#pragma unroll
                    for (int q = 0; q < 4; ++q) { a0[q] = sigmoidf_(a0[q]); a1[q] = sigmoidf_(a1[q]); }
                    sg[ai][m][bj] = pack8(a0, a1); }
        asm volatile("" ::: "memory");
#pragma unroll
        for (int ai = 0; ai < 2; ++ai) {
            u32x4 lh[4][2], lp[4][2];
#pragma unroll
            for (int m = 0; m < 4; ++m)
#pragma unroll
                for (int bj = 0; bj < 2; ++bj) { const unsigned ob = ((unsigned)EPI_ROW(ai, m) * D + c0 + bj * 128) * 2u;
                    lh[m][bj] = *(const u32x4*)((const char*)hin + ob); lp[m][bj] = *(const u32x4*)((const char*)pp + ob); }
#pragma unroll
            for (int m = 0; m < 4; ++m) { float s_ = 0.f; const int row = EPI_ROW(ai, m);
#pragma unroll
                for (int bj = 0; bj < 2; ++bj) { f32x4 h0, h1, p0, p1, g0, g1; unpack8(lh[m][bj], h0, h1); unpack8(lp[m][bj], p0, p1); unpack8(sg[ai][m][bj], g0, g1);
                    h0 += g0 * p0; h1 += g1 * p1; s_ += dot8(h0, h1);
                    *(u32x4*)((char*)hb + ((unsigned)row * D + c0 + bj * 128) * 2u) = pack8(h0, h1); }
                epi_ssq(ssq, row, pn * 4 + wc, s_, fq); }
        } } };

__device__ __forceinline__ float conv4(const bf16_t* zc, int row, int s, const float* w  , int wstride, float b) {
    float acc = b;
#pragma unroll
    for (int j = 0; j < 4; ++j) { const int ds = 3 - j; if (s - ds >= 0) acc += w[j * wstride] * bf2f(zc[(ptrdiff_t)(row - ds) * ZW]); }
    return acc;
}
__device__ __forceinline__ void chunk_gates(float* sc, const float* gates, int row0, int h, int lane) {
    const float ip = gates[(size_t)(row0 + lane) * 8 + h], fp = gates[(size_t)(row0 + lane) * 8 + 4 + h];
    float b = logsigmoidf_(fp);
#pragma unroll
    for (int o = 1; o < 64; o <<= 1) { const float n = __shfl_up(b, o); if (lane >= o) b += n; }
    sc[lane] = b; sc[64 + lane] = ip;
}
__device__ __forceinline__ void chunk_gates_r(float* sc, float ip, float fp, int lane) {
    float b = logsigmoidf_(fp);
#pragma unroll
    for (int o = 1; o < 64; o <<= 1) { const float n = __shfl_up(b, o); if (lane >= o) b += n; }
    sc[lane] = b; sc[64 + lane] = ip;
}
__device__ __forceinline__ void mlstm_local(const Args& a, unsigned char* lds, int l, int item) {
    const int b = item >> 8, c = (item >> 2) & 63, h = item & 3, row0 = b * SEQ + c * CH, tid = otid(), lane = tid & 63;
    float* Kt = (float*)lds;
    float* Vt = Kt + 64 * 128;
    float* sc = Vt + 64 * 128;
    const bf16_t* z = (const bf16_t*)(a.ws + WS_Z);
    const float* gates = (const float*)(a.ws + WS_SMALL + SM_GATES);
    if (tid < 64) {
        chunk_gates(sc, gates, row0, h, lane);
        const float bl = __shfl(sc[lane], 63), al = bl - sc[lane] + sc[64 + lane];
        const float amax = wave_max(al);
        sc[128 + lane] = __expf(al - amax);
        if (lane == 0) { ((float*)(a.ws + WS_SMALL + SM_BL))[item] = bl; ((float*)(a.ws + WS_SMALL + SM_AMAX))[item] = amax; }
    }
    const float* wc = a.in[I_WCQK] + (size_t)l * 4 * 1024; const float* bc = a.in[I_BCQK] + (size_t)l * 1024;
    for (int i = tid; i < 64 * 128; i += NT) {
        const int ll = i >> 7, d = i & 127, ch = ZK + h * DH + d;
        Kt[i] = siluf_(conv4(z + ch, row0 + ll, c * CH + ll, wc + ch, 1024, bc[ch]));
        Vt[i] = bf2f(z[(size_t)(row0 + ll) * ZW + ZV + h * DH + d]);
    }
    __syncthreads();
    const int d = tid & 127, eg = tid >> 7;
    float acc[33];
#pragma unroll
    for (int i = 0; i < 33; ++i) acc[i] = 0.f;
    for (int ll = 0; ll < 64; ++ll) {
        const float kd = Kt[ll * 128 + d] * sc[128 + ll];
#pragma unroll
        for (int i = 0; i < 32; ++i) acc[i] += Vt[ll * 128 + eg + 4 * i] * kd;
        acc[32] += kd;
    }
    float* ct = (float*)(a.ws + WS_CT) + (size_t)item * EROWS * 128;
#pragma unroll
    for (int i = 0; i < 32; ++i) ct[(eg + 4 * i) * 128 + d] = acc[i];
    if (eg == 0) ct[128 * 128 + d] = acc[32];
    __syncthreads();
}
__device__ __forceinline__ void mlstm_scan(const Args& a, int G) {
    const float* BL = (const float*)(a.ws + WS_SMALL + SM_BL); const float* AM = (const float*)(a.ws + WS_SMALL + SM_AMAX);
    float* MP = (float*)(a.ws + WS_SMALL + SM_MPREV);
    const int tid = otid();
    for (int w = blockIdx.x; w < 16 * 16; w += G) {
        const int bh = w >> 4, sl = w & 15, b = bh >> 2, h = bh & 3;
        unsigned* p = (unsigned*)(a.ws + WS_CT) + (size_t)((b * NC) * NH + h) * 8192 + sl * 512 + tid;
        float s0 = 0.f, s1 = 0.f, m = 0.f;
#pragma unroll 1
        for (int c0 = 0; c0 < NC; c0 += 16) {
            unsigned x[16];
#pragma unroll
            for (int j = 0; j < 16; ++j) x[j] = p[(size_t)(c0 + j) * (NH * 8192)];
#pragma unroll
            for (int j = 0; j < 16; ++j) {
                const int item = (b * NC + c0 + j) * NH + h;
                const float bl = BL[item], am = AM[item];
                const float mn = fmaxf(bl + m, am), dec = __expf(bl + m - mn), scl = __expf(am - mn);
                p[(size_t)(c0 + j) * (NH * 8192)] = pk2(s0, s1);
                if (sl == 0 && tid == 0) MP[item] = m;
                s0 = dec * s0 + scl * bf2f(x[j] & 0xffffu); s1 = dec * s1 + scl * __uint_as_float(x[j] & 0xffff0000u); m = mn;
            }
        }
        if (sl == 1 && tid < 128) {
            float* q = (float*)(a.ws + WS_DN) + (size_t)((b * NC) * NH + h) * 128 + tid;
            float sn = 0.f; m = 0.f;
#pragma unroll 1
            for (int c0 = 0; c0 < NC; c0 += 16) {
                float x[16];
#pragma unroll
                for (int j = 0; j < 16; ++j) x[j] = q[(size_t)(c0 + j) * (NH * 128)];
#pragma unroll
                for (int j = 0; j < 16; ++j) {
                    const int item = (b * NC + c0 + j) * NH + h;
                    const float bl = BL[item], am = AM[item];
                    const float mn = fmaxf(bl + m, am), dec = __expf(bl + m - mn), scl = __expf(am - mn);
                    q[(size_t)(c0 + j) * (NH * 128)] = sn;
                    sn = dec * sn + scl * x[j]; m = mn;
                }
            }
        }
    }
}
__device__ __forceinline__ void mlstm_out(const Args& a, unsigned char* lds, int l, int item) {
    const int b = item >> 8, c = (item >> 2) & 63, h = item & 3, row0 = b * SEQ + c * CH, tid = otid(), lane = tid & 63, wave = tid >> 6;
    float* Q = (float*)lds;
    float* Kt = Q + 64 * 128;
    float* Vt = Kt + 64 * 128;
    float* Sm = Vt + 64 * 128;
    float* sc = Sm + 64 * 64;
    const bf16_t* z = (const bf16_t*)(a.ws + WS_Z);
    const float* gates = (const float*)(a.ws + WS_SMALL + SM_GATES);
    const float mprev = ((const float*)(a.ws + WS_SMALL + SM_MPREV))[item];
    if (tid < 64) {
        chunk_gates(sc, gates, row0, h, lane);
        float g = sc[64 + lane] - sc[lane];
#pragma unroll
        for (int o = 1; o < 64; o <<= 1) { const float n = __shfl_up(g, o); if (lane >= o) g = fmaxf(g, n); }
        const float mrow = sc[lane] + fmaxf(mprev, g);
        sc[128 + lane] = mrow; sc[192 + lane] = __expf(sc[lane] + mprev - mrow);
    }
    const float* wc = a.in[I_WCQK] + (size_t)l * 4 * 1024; const float* bc = a.in[I_BCQK] + (size_t)l * 1024;
    for (int i = tid; i < 64 * 128; i += NT) {
        const int ll = i >> 7, d = i & 127, chq = ZQ + h * DH + d, chk = ZK + h * DH + d;
        Q[i] = siluf_(conv4(z + chq, row0 + ll, c * CH + ll, wc + chq, 1024, bc[chq])) * 0.08838834764831845f;
        Kt[i] = siluf_(conv4(z + chk, row0 + ll, c * CH + ll, wc + chk, 1024, bc[chk]));
        Vt[i] = bf2f(z[(size_t)(row0 + ll) * ZW + ZV + h * DH + d]);
    }
    __syncthreads();
    for (int i = tid; i < 64 * 64; i += NT) {
        const int ll = i >> 6, mm = i & 63; float s = 0.f;
        if (mm <= ll) {
            for (int d = 0; d < 128; ++d) s += Q[ll * 128 + d] * Kt[mm * 128 + d];
            s *= __expf(sc[ll] - sc[mm] + sc[64 + mm] - sc[128 + ll]);
        }
        Sm[i] = s;
    }
    __syncthreads();
    const float* ct = (const float*)(a.ws + WS_CT) + (size_t)item * EROWS * 128;
    if (tid < 64) {
        float di = 0.f, dn = 0.f;
        for (int mm = 0; mm < 64; ++mm) di += Sm[tid * 64 + mm];
        for (int d = 0; d < 128; ++d) dn += Q[tid * 128 + d] * ct[128 * 128 + d];
        const float den = di + sc[192 + tid] * dn;
        sc[256 + tid] = fmaxf(fabsf(den), __expf(-sc[128 + tid]));
    }
    const int e = tid & 127, lg = tid >> 7;
    float acc[16], acc2[16];
#pragma unroll
    for (int i = 0; i < 16; ++i) { acc[i] = 0.f; acc2[i] = 0.f; }
    for (int mm = 0; mm < 64; ++mm) { const float vv = Vt[mm * 128 + e];
#pragma unroll
        for (int i = 0; i < 16; ++i) acc[i] += Sm[(lg * 16 + i) * 64 + mm] * vv; }
    for (int d = 0; d < 128; ++d) { const float cv = ct[e * 128 + d];
#pragma unroll
        for (int i = 0; i < 16; ++i) acc2[i] += Q[(lg * 16 + i) * 128 + d] * cv; }
    __syncthreads();
#pragma unroll
    for (int i = 0; i < 16; ++i) { const int ll = lg * 16 + i;
        const float hv = (acc[i] + sc[192 + ll] * acc2[i]) / sc[256 + ll];
        const float o = sigmoidf_(bf2f(z[(size_t)(row0 + ll) * ZW + ZO + h * DH + e]));
        Kt[ll * 128 + e] = hv * o; }
    __syncthreads();
    const float* gm = a.in[I_GMH] + (size_t)l * DM + h * DH;
    bf16_t* mix = (bf16_t*)(a.ws + WS_MIX);
    for (int ll = wave * 8; ll < wave * 8 + 8; ++ll) {
        const float x0 = Kt[ll * 128 + 2 * lane], x1 = Kt[ll * 128 + 2 * lane + 1];
        const float rs = rsqrtf(wave_sum(x0 * x0 + x1 * x1) * (1.f / 128.f) + EPS);
        *(unsigned*)(mix + (size_t)(row0 + ll) * D + h * DH + 2 * lane) = pk2(x0 * rs * gm[2 * lane], x1 * rs * gm[2 * lane + 1]);
    }
    __syncthreads();
}


typedef short bf16x8 __attribute__((ext_vector_type(8)));
__device__ __forceinline__ f32x4 mfma16(bf16x8 a, bf16x8 b, f32x4 c) { return __builtin_amdgcn_mfma_f32_16x16x32_bf16(a, b, c, 0, 0, 0); }

template <int IN, int AUX>
__device__ __forceinline__ void phase_rowpass_mm(unsigned char* lds, const float* xin, bf16_t* hb, const float* g, float* ssq, const float* auxW, int auxld, const float* auxB,
                                                 float* gates, unsigned char* tok_p, float* tok_g, unsigned char* h8) {
    constexpr int WLD = 1032;
    bf16_t* wl = (bf16_t*)lds; float* gl = (float*)(lds + 8 * WLD * 2);
    const int tid = otid(), lane = tid & 63, wave = tid >> 6;
    for (int i = tid; i < D * 8; i += NT) { const int k = i >> 3, c = i & 7; wl[c * WLD + k] = (bf16_t)f2bf(g[k] * auxW[(size_t)k * auxld + c]); }
    if (AUX == 2) for (int i = tid; i < D; i += NT) gl[i] = g[i];
    __syncthreads();
    const int n = lane & 15, kq = lane >> 4;
    const bf16_t* wrow = wl + (n & 7) * WLD + 8 * kq;
    if (wave < 4) for (int task = blockIdx.x + gridDim.x * wave; task < M / 16; task += gridDim.x * 4) {
        const int row = task * 16 + n;
        f32x4 accL = {0.f, 0.f, 0.f, 0.f}, accS = {0.f, 0.f, 0.f, 0.f};
        u32x4 xr[32];
        if (IN == 1) {
            const u32x4* src = (const u32x4*)(hb + (size_t)row * D + 8 * kq);
#pragma unroll
            for (int s = 0; s < 32; ++s) xr[s] = src[4 * s];
            asm volatile("" ::: "memory");
#pragma unroll
            for (int s = 0; s < 32; ++s) { const bf16x8 xf = __builtin_bit_cast(bf16x8, xr[s]); const bf16x8 wf = *(const bf16x8*)(wrow + 32 * s);
                accL = mfma16(wf, xf, accL); accS = mfma16(xf, xf, accS); }
        } else {
            const f32x4* src = (const f32x4*)(xin + (size_t)row * D + 8 * kq); u32x4* dst = (u32x4*)(hb + (size_t)row * D + 8 * kq);
#pragma unroll
            for (int hf = 0; hf < 2; ++hf) { f32x4 xf32[32]; asm volatile("" ::: "memory");
#pragma unroll
                for (int s = 0; s < 16; ++s) { xf32[2 * s] = src[8 * (16 * hf + s)]; xf32[2 * s + 1] = src[8 * (16 * hf + s) + 1]; }
                asm volatile("" ::: "memory");
#pragma unroll
                for (int s = 0; s < 16; ++s) { const f32x4 a_ = xf32[2 * s], b_ = xf32[2 * s + 1];
                    u32x4 p; p.x = pk2(a_.x, a_.y); p.y = pk2(a_.z, a_.w); p.z = pk2(b_.x, b_.y); p.w = pk2(b_.z, b_.w); dst[4 * (16 * hf + s)] = p;
                    const bf16x8 xf = __builtin_bit_cast(bf16x8, p); const bf16x8 wf = *(const bf16x8*)(wrow + 32 * (16 * hf + s));
                    accL = mfma16(wf, xf, accL); accS = mfma16(xf, xf, accS); } }
        }
        float dv = accS[0]; dv = (n & 3) == 1 ? accS[1] : dv; dv = (n & 3) == 2 ? accS[2] : dv; dv = (n & 3) == 3 ? accS[3] : dv;
        const float tot = __shfl(dv, n + 16 * (n >> 2));
        const float rstd = __builtin_amdgcn_rsqf(tot * (1.f / D) + EPS);
        if (IN == 0) { f32x4 o = {kq == 0 ? tot : 0.f, 0.f, 0.f, 0.f}; *(f32x4*)(ssq + (size_t)row * 16 + 4 * kq) = o; }
        if (AUX == 1) {
            if (kq < 2) { const f32x4 b_ = *(const f32x4*)(auxB + 4 * kq); *(f32x4*)(gates + (size_t)row * 8 + 4 * kq) = accL * rstd + b_; }
        } else {
            const f32x4 lg = accL * rstd;
            float o4[4];
#pragma unroll
            for (int r = 0; r < 4; ++r) o4[r] = __shfl(lg[r], lane + 16);
            if (kq == 0) {
                float acc[8] = {lg[0], lg[1], lg[2], lg[3], o4[0], o4[1], o4[2], o4[3]};
                int e1 = 0; float v1 = acc[0];
#pragma unroll
                for (int c = 1; c < 8; ++c) if (acc[c] > v1) { v1 = acc[c]; e1 = c; }
                int e2 = -1; float v2 = -INFINITY;
#pragma unroll
                for (int c = 0; c < 8; ++c) if (c != e1 && acc[c] > v2) { v2 = acc[c]; e2 = c; }
                const float p2 = __expf(v2 - v1), inv = 1.f / (1.f + p2);
                tok_p[row] = (unsigned char)(e1 | (e2 << 4)); tok_g[row * 2] = inv; tok_g[row * 2 + 1] = p2 * inv;
            }
            if (h8) {
                u32x2* dst = (u32x2*)(h8 + (size_t)row * D + 8 * kq);
#pragma unroll
                for (int s = 0; s < 32; ++s) { if ((s & 3) == 0) asm volatile("" ::: "memory"); const u32x4 w = xr[s]; const f32x4 g0 = *(const f32x4*)(gl + 32 * s + 8 * kq), g1 = *(const f32x4*)(gl + 32 * s + 8 * kq + 4);
                    u32x2 o; o.x = pk4_fp8(bf2f(w.x & 0xffffu) * rstd * g0.x, __uint_as_float(w.x & 0xffff0000u) * rstd * g0.y, bf2f(w.y & 0xffffu) * rstd * g0.z, __uint_as_float(w.y & 0xffff0000u) * rstd * g0.w);
                    o.y = pk4_fp8(bf2f(w.z & 0xffffu) * rstd * g1.x, __uint_as_float(w.z & 0xffff0000u) * rstd * g1.y, bf2f(w.w & 0xffffu) * rstd * g1.z, __uint_as_float(w.w & 0xffff0000u) * rstd * g1.w);
                    dst[4 * s] = o; }
            }
        }
    }
    __syncthreads();
}

__device__ __forceinline__ void conv_load11(const bf16_t* zc, int row0, int l0, bool first_chunk, unsigned (&x)[11]) {
#pragma unroll
    for (int j = 0; j < 11; ++j) { const int ll = l0 - 3 + j; x[j] = (first_chunk && ll < 0) ? 0u : *(const unsigned*)(zc + (ptrdiff_t)(row0 + ll) * ZW); }
}
struct ConvW { float w[4][2]; float b[2]; };
__device__ __forceinline__ void conv_loadw(const float* wc, const float* bc, int col, ConvW& cw) {
#pragma unroll
    for (int j = 0; j < 4; ++j) { cw.w[j][0] = wc[j * 1024 + col]; cw.w[j][1] = wc[j * 1024 + col + 1]; }
    cw.b[0] = bc[col]; cw.b[1] = bc[col + 1];
}
__device__ __forceinline__ void conv_apply(const unsigned (&x)[11], const ConvW& cw, float (&out)[8][2]) {
#pragma unroll
    for (int i = 0; i < 8; ++i) { float a0 = cw.b[0], a1 = cw.b[1];
#pragma unroll
        for (int j = 0; j < 4; ++j) { a0 += cw.w[j][0] * bf2f(x[i + j] & 0xffffu); a1 += cw.w[j][1] * __uint_as_float(x[i + j] & 0xffff0000u); }
        out[i][0] = a0; out[i][1] = a1; }
}
struct MlRegs { unsigned xk[11], v[8]; ConvW cw; float gi, gf; };
__device__ __forceinline__ void ml_load(const Args& a, int l, int item, MlRegs& R) {
    const int b = item >> 8, c = (item >> 2) & 63, h = item & 3, row0 = b * SEQ + c * CH, tid = otid(), lane = tid & 63, wave = tid >> 6;
    const bf16_t* z = (const bf16_t*)(a.ws + WS_Z);
    const float* gates = (const float*)(a.ws + WS_SMALL + SM_GATES);
    const int cp = lane, lg = wave, colk = ZK + h * DH + 2 * cp, colv = ZV + h * DH + 2 * cp;
    conv_load11(z + colk, row0, 8 * lg, c == 0, R.xk);
#pragma unroll
    for (int i = 0; i < 8; ++i) R.v[i] = *(const unsigned*)(z + (size_t)(row0 + 8 * lg + i) * ZW + colv);
    conv_loadw(a.in[I_WCQK] + (size_t)l * 4 * 1024, a.in[I_BCQK] + (size_t)l * 1024, colk, R.cw);
    R.gi = gates[(size_t)(row0 + lane) * 8 + h]; R.gf = gates[(size_t)(row0 + lane) * 8 + 4 + h];
}
__device__ __forceinline__ void ml_compute(const Args& a, unsigned char* lds, int l, int item, MlRegs& R) {
    const int tid = otid(), lane = tid & 63, wave = tid >> 6, fr = lane & 15, fq = lane >> 4;
    unsigned char* KT = lds; unsigned char* VT = lds + 18432; float* RED = (float*)(lds + 36864); float* sc = (float*)(lds + 40960);
    const int cp = lane, lg = wave;
    unsigned (&xk)[11] = R.xk; unsigned (&v)[8] = R.v; ConvW& cw = R.cw;
    if (tid < 64) {
        chunk_gates_r(sc, R.gi, R.gf, lane);
        {
            float g = sc[64 + lane] - sc[lane];
#pragma unroll
            for (int o = 1; o < 64; o <<= 1) { const float n = __shfl_up(g, o); if (lane >= o) g = fmaxf(g, n); }
            float* scal = (float*)(a.ws + WS_SCAL) + (size_t)item * 128; scal[lane] = sc[lane]; scal[64 + lane] = g; }
        const float bl = __shfl(sc[lane], 63), al = bl - sc[lane] + sc[64 + lane];
        const float amax = wave_max(al);
        sc[128 + lane] = __expf(al - amax);
        if (lane == 0) { ((float*)(a.ws + WS_SMALL + SM_BL))[item] = bl; ((float*)(a.ws + WS_SMALL + SM_AMAX))[item] = amax; }
    }
    LDS_BARRIER();
    {
        float kk[8][2];
        conv_apply(xk, cw, kk);
        float n0 = 0.f, n1 = 0.f;
#pragma unroll
        for (int i = 0; i < 8; ++i) { const float wl = sc[128 + 8 * lg + i]; kk[i][0] = siluf_(kk[i][0]) * wl; kk[i][1] = siluf_(kk[i][1]) * wl; n0 += kk[i][0]; n1 += kk[i][1]; }
        u32x4 p0, p1;
#pragma unroll
        for (int i = 0; i < 4; ++i) { p0[i] = pk2(kk[2 * i][0], kk[2 * i + 1][0]); p1[i] = pk2(kk[2 * i][1], kk[2 * i + 1][1]); }
        *(u32x4*)(KT + (2 * cp) * 144 + lg * 16) = p0; *(u32x4*)(KT + (2 * cp + 1) * 144 + lg * 16) = p1;
        RED[lg * 128 + 2 * cp] = n0; RED[lg * 128 + 2 * cp + 1] = n1;
#pragma unroll
        for (int i = 0; i < 4; ++i) { p0[i] = (v[2 * i] & 0xffffu) | (v[2 * i + 1] << 16); p1[i] = (v[2 * i] >> 16) | (v[2 * i + 1] & 0xffff0000u); }
        *(u32x4*)(VT + (2 * cp) * 144 + lg * 16) = p0; *(u32x4*)(VT + (2 * cp + 1) * 144 + lg * 16) = p1;
    }
    LDS_BARRIER();
    bf16_t* ct = (bf16_t*)(a.ws + WS_CT) + (size_t)item * 128 * 128;
    {
        const int et0 = 2 * (wave & 3), dt0 = 4 * (wave >> 2);
        bf16x8 Vf[2][2], Kf[4][2];
#pragma unroll
        for (int i = 0; i < 2; ++i)
#pragma unroll
            for (int ks = 0; ks < 2; ++ks) Vf[i][ks] = *(const bf16x8*)(VT + ((et0 + i) * 16 + fr) * 144 + (ks * 32 + 8 * fq) * 2);
#pragma unroll
        for (int j = 0; j < 4; ++j)
#pragma unroll
            for (int ks = 0; ks < 2; ++ks) Kf[j][ks] = *(const bf16x8*)(KT + ((dt0 + j) * 16 + fr) * 144 + (ks * 32 + 8 * fq) * 2);
#pragma unroll
        for (int i = 0; i < 2; ++i)
#pragma unroll
            for (int j = 0; j < 4; ++j) {
                f32x4 acc = {0.f, 0.f, 0.f, 0.f};
                acc = mfma16(Kf[j][0], Vf[i][0], acc); acc = mfma16(Kf[j][1], Vf[i][1], acc);
                u32x2 w; w.x = pk2(acc[0], acc[1]); w.y = pk2(acc[2], acc[3]);
                *(u32x2*)(ct + ((et0 + i) * 16 + fr) * 128 + (dt0 + j) * 16 + 4 * fq) = w;
            }
    }
    if (tid < 128) { float s_ = 0.f;
#pragma unroll
        for (int g = 0; g < 8; ++g) s_ += RED[g * 128 + tid];
        ((float*)(a.ws + WS_DN))[(size_t)item * 128 + tid] = s_; }
    LDS_BARRIER();
}
struct MoRegs { unsigned xq[11], xk[11], v[8]; u32x4 og[2]; float gi, gb, gg, mprev; };
__device__ __forceinline__ void mo_load(const Args& a, int l, int item, MoRegs& R) {
    const int b = item >> 8, c = (item >> 2) & 63, h = item & 3, row0 = b * SEQ + c * CH, tid = otid(), lane = tid & 63, wave = tid >> 6;
    const bf16_t* z = (const bf16_t*)(a.ws + WS_Z);
    const float* gates = (const float*)(a.ws + WS_SMALL + SM_GATES);
    const int cp = lane, lg = wave, colq = ZQ + h * DH + 2 * cp, colk = ZK + h * DH + 2 * cp, colv = ZV + h * DH + 2 * cp;
    conv_load11(z + colq, row0, 8 * lg, c == 0, R.xq);
    conv_load11(z + colk, row0, 8 * lg, c == 0, R.xk);
#pragma unroll
    for (int i = 0; i < 8; ++i) R.v[i] = *(const unsigned*)(z + (size_t)(row0 + 8 * lg + i) * ZW + colv);
#pragma unroll
    for (int j = 0; j < 2; ++j) { const int pc = tid + j * NT; R.og[j] = *(const u32x4*)(z + (size_t)(row0 + (pc >> 4)) * ZW + ZO + h * DH + (pc & 15) * 8); }
    R.gi = gates[(size_t)(row0 + lane) * 8 + h];
    { const float* scal = (const float*)(a.ws + WS_SCAL) + (size_t)item * 128; R.gb = scal[lane]; R.gg = scal[64 + lane]; }
    R.mprev = ((const float*)(a.ws + WS_SMALL + SM_MPREV))[item];
}
__device__ __forceinline__ void mo_compute(const Args& a, unsigned char* lds, int l, int item, MoRegs& R, ConvW& cwq, ConvW& cwk, int& hw) {
    const int b = item >> 8, c = (item >> 2) & 63, h = item & 3, row0 = b * SEQ + c * CH, tid = otid(), lane = tid & 63, wave = tid >> 6, fr = lane & 15, fq = lane >> 4;
    unsigned char* QN = lds; unsigned char* KN = lds + 17408; unsigned char* VT = lds + 34816; unsigned char* SP = lds + 53248;
    float* sc = (float*)(lds + 62464);
    float* HM = (float*)lds;
    const int cp = lane, lg = wave;
    unsigned (&xq)[11] = R.xq; unsigned (&xk)[11] = R.xk; unsigned (&v)[8] = R.v;
    bf16x8 Cf[4]; f32x4 dnv[4];
    { const bf16_t* ct = (const bf16_t*)(a.ws + WS_CT) + (size_t)item * 128 * 128; const float* dn = (const float*)(a.ws + WS_DN) + (size_t)item * 128;
#pragma unroll
      for (int ks = 0; ks < 4; ++ks) Cf[ks] = *(const bf16x8*)(ct + (wave * 16 + fr) * 128 + ks * 32 + 8 * fq);
#pragma unroll
      for (int j = 0; j < 4; ++j) dnv[j] = *(const f32x4*)(dn + (tid & 7) * 16 + 4 * j); }
    f32x4 gmv[2][2];
#pragma unroll
    for (int j = 0; j < 2; ++j) { const float* gp = a.in[I_GMH] + (size_t)l * DM + h * DH + ((tid + j * NT) & 15) * 8; gmv[j][0] = *(const f32x4*)gp; gmv[j][1] = *(const f32x4*)(gp + 4); }
    if (hw != h) { const float* wc = a.in[I_WCQK] + (size_t)l * 4 * 1024; const float* bc = a.in[I_BCQK] + (size_t)l * 1024;
        conv_loadw(wc, bc, ZQ + h * DH + 2 * cp, cwq); conv_loadw(wc, bc, ZK + h * DH + 2 * cp, cwk); hw = h; }
    if (tid < 64) {
        const float mprev = R.mprev, mrow = R.gb + fmaxf(mprev, R.gg);
        sc[lane] = R.gb; sc[64 + lane] = R.gi; sc[128 + lane] = mrow; sc[192 + lane] = __expf(R.gb + mprev - mrow);
    }
    {
        float qq[8][2];
        conv_apply(xq, cwq, qq);
#pragma unroll
        for (int i = 0; i < 8; ++i) *(unsigned*)(QN + (8 * lg + i) * 272 + cp * 4) = pk2(siluf_(qq[i][0]) * 0.08838834764831845f, siluf_(qq[i][1]) * 0.08838834764831845f);
        conv_apply(xk, cwk, qq);
#pragma unroll
        for (int i = 0; i < 8; ++i) *(unsigned*)(KN + (8 * lg + i) * 272 + cp * 4) = pk2(siluf_(qq[i][0]), siluf_(qq[i][1]));
        u32x4 p0, p1;
#pragma unroll
        for (int i = 0; i < 4; ++i) { p0[i] = (v[2 * i] & 0xffffu) | (v[2 * i + 1] << 16); p1[i] = (v[2 * i] >> 16) | (v[2 * i + 1] & 0xffff0000u); }
        *(u32x4*)(VT + (2 * cp) * 144 + lg * 16) = p0; *(u32x4*)(VT + (2 * cp + 1) * 144 + lg * 16) = p1;
    }
    LDS_BARRIER();
    {
        const int ll = tid >> 3, part = tid & 7; float s_ = 0.f;
#pragma unroll
        for (int j = 0; j < 4; ++j) { const u32x2 qv = *(const u32x2*)(QN + ll * 272 + (part * 16 + 4 * j) * 2);
            s_ += bf2f(qv.x & 0xffffu) * dnv[j].x + __uint_as_float(qv.x & 0xffff0000u) * dnv[j].y + bf2f(qv.y & 0xffffu) * dnv[j].z + __uint_as_float(qv.y & 0xffff0000u) * dnv[j].w; }
        s_ = sum8(s_);
        if (part == 0) sc[384 + ll] = s_;
    }
    {
        const int lt = wave & 3; const int ll = lt * 16 + fr; const float bl_ = sc[ll], mr = sc[128 + ll]; float dsum = 0.f;
#pragma unroll
        for (int mi = 0; mi < 2; ++mi) {
            const int mt = 2 * (wave >> 2) + mi; u32x2 pk = {0u, 0u};
            if (mt <= lt) {
                f32x4 acc = {0.f, 0.f, 0.f, 0.f};
#pragma unroll
                for (int ks = 0; ks < 4; ++ks) { const bf16x8 A = *(const bf16x8*)(KN + (mt * 16 + fr) * 272 + (ks * 32 + 8 * fq) * 2), B = *(const bf16x8*)(QN + (lt * 16 + fr) * 272 + (ks * 32 + 8 * fq) * 2);
                    acc = mfma16(A, B, acc); }
                float sv[4];
#pragma unroll
                for (int r = 0; r < 4; ++r) { const int mm = mt * 16 + 4 * fq + r; const float wgt = (mm <= ll) ? __expf(bl_ - sc[mm] + sc[64 + mm] - mr) : 0.f; sv[r] = acc[r] * wgt; dsum += sv[r]; }
                pk.x = pk2(sv[0], sv[1]); pk.y = pk2(sv[2], sv[3]);
            }
            *(u32x2*)(SP + ll * 144 + (mt * 16 + 4 * fq) * 2) = pk;
        }
        dsum += __shfl_xor(dsum, 16); dsum += __shfl_xor(dsum, 32);
        if (fq == 0) sc[256 + (wave >> 2) * 64 + ll] = dsum;
    }
    LDS_BARRIER();
    if (tid < 64) { const float den = sc[256 + tid] + sc[320 + tid] + sc[192 + tid] * sc[384 + tid]; sc[448 + tid] = fmaxf(fabsf(den), __expf(-sc[128 + tid])); }
    f32x4 acc1[4], acc2[4];
    {
        bf16x8 Vf[2];
#pragma unroll
        for (int ks = 0; ks < 2; ++ks) Vf[ks] = *(const bf16x8*)(VT + (wave * 16 + fr) * 144 + (ks * 32 + 8 * fq) * 2);
#pragma unroll
        for (int lt = 0; lt < 4; ++lt) {
            acc1[lt] = (f32x4){0.f, 0.f, 0.f, 0.f}; acc2[lt] = (f32x4){0.f, 0.f, 0.f, 0.f};
#pragma unroll
            for (int ks = 0; ks < 2; ++ks) acc1[lt] = mfma16(*(const bf16x8*)(SP + (lt * 16 + fr) * 144 + (ks * 32 + 8 * fq) * 2), Vf[ks], acc1[lt]);
#pragma unroll
            for (int ks = 0; ks < 4; ++ks) acc2[lt] = mfma16(*(const bf16x8*)(QN + (lt * 16 + fr) * 272 + (ks * 32 + 8 * fq) * 2), Cf[ks], acc2[lt]);
        }
    }
    LDS_BARRIER();
#pragma unroll
    for (int lt = 0; lt < 4; ++lt)
#pragma unroll
        for (int r = 0; r < 4; ++r) { const int ll = lt * 16 + 4 * fq + r;
            HM[ll * 132 + wave * 16 + fr] = (acc1[lt][r] + sc[192 + ll] * acc2[lt][r]) * frcp(sc[448 + ll]); }
    LDS_BARRIER();
    {
        bf16_t* mix = (bf16_t*)(a.ws + WS_MIX);
#pragma unroll
        for (int j = 0; j < 2; ++j) { const int pc = tid + j * NT, ll = pc >> 4, q16 = pc & 15;
            const f32x4 h0 = *(const f32x4*)(HM + ll * 132 + q16 * 8), h1 = *(const f32x4*)(HM + ll * 132 + q16 * 8 + 4);
            f32x4 o0, o1; unpack8(R.og[j], o0, o1);
            f32x4 g0, g1;
#pragma unroll
            for (int q = 0; q < 4; ++q) { g0[q] = h0[q] * sigmoidf_(o0[q]); g1[q] = h1[q] * sigmoidf_(o1[q]); }
            const float rs = __builtin_amdgcn_rsqf(sum16(dot8(g0, g1)) * (1.f / 128.f) + EPS);
            *(u32x4*)(mix + (size_t)(row0 + ll) * D + h * DH + q16 * 8) = pack8(g0 * rs * gmv[j][0], g1 * rs * gmv[j][1]); }
    }
    LDS_BARRIER();
}

template <int MODE>
__device__ __forceinline__ void rglru_item(const Args& a, unsigned char* lds, int l, int item) {
    const int b = item >> 6, c = item & 63, row0 = b * SEQ + c * CH, ch = otid(), lane = ch & 63, nb = ch >> 6;
    float* xs = (float*)lds + nb * 64 * 64;
    const bf16_t* z = (const bf16_t*)(a.ws + WS_Z);
    const float* wcr = a.in[I_WCR] + (size_t)l * 4 * DR; const float bcr = a.in[I_BCR][l * DR + ch];
    const float w0 = wcr[ch], w1 = wcr[DR + ch], w2 = wcr[2 * DR + ch], w3 = wcr[3 * DR + ch];
    const bf16_t* zc = z + ZXR + ch;
    float xm3 = 0.f, xm2 = 0.f, xm1 = 0.f;
    { const int s0 = c * CH; if (s0 >= 3) { xm3 = bf2f(zc[(size_t)(row0 - 3) * ZW]); xm2 = bf2f(zc[(size_t)(row0 - 2) * ZW]); xm1 = bf2f(zc[(size_t)(row0 - 1) * ZW]); } }
#pragma unroll 4
    for (int t = 0; t < 64; ++t) { const float x0 = bf2f(zc[(size_t)(row0 + t) * ZW]);
        xs[t * 64 + lane] = bcr + w0 * xm3 + w1 * xm2 + w2 * xm1 + w3 * x0; xm3 = xm2; xm2 = xm1; xm1 = x0; }
    unsigned wa[32], wx[32];
    const float* wra = a.in[I_WRA] + ((size_t)(l * NBR + nb) * 64) * 64 + lane; const float* wri = a.in[I_WRI] + ((size_t)(l * NBR + nb) * 64) * 64 + lane;
#pragma unroll
    for (int d = 0; d < 32; ++d) { wa[d] = pk2(wra[(2 * d) * 64], wra[(2 * d + 1) * 64]); wx[d] = pk2(wri[(2 * d) * 64], wri[(2 * d + 1) * 64]); }
    const float ba = a.in[I_BRA][l * DR + ch], bx = a.in[I_BRI][l * DR + ch];
    const float lam = a.in[I_LAM][l * DR + ch];
    const float sp = fmaxf(-lam, 0.f) + log1pf(__expf(-fabsf(lam)));
    float hst = 0.f, ap = 1.f;
    if (MODE == 1) hst = ((const float*)(a.ws + WS_SMALL + SM_RGP))[(size_t)item * DR + ch];
    const float gr = a.in[I_GR][l * DR + ch];
    bf16_t* mix = (bf16_t*)(a.ws + WS_MIX);
    __syncthreads();
#pragma unroll 1
    for (int t = 0; t < 64; ++t) {
        float ra = ba, ia = bx;
#pragma unroll
        for (int d4 = 0; d4 < 16; ++d4) { const f32x4 xv = *(const f32x4*)(xs + t * 64 + 4 * d4);
#pragma unroll
            for (int q = 0; q < 2; ++q) { const unsigned pa = wa[2 * d4 + q], px = wx[2 * d4 + q];
                ra += xv[2 * q] * __uint_as_float(pa << 16) + xv[2 * q + 1] * __uint_as_float(pa & 0xffff0000u);
                ia += xv[2 * q] * __uint_as_float(px << 16) + xv[2 * q + 1] * __uint_as_float(px & 0xffff0000u); } }
        const float xo = xs[t * 64 + lane];
        const float r = sigmoidf_(ra), ig = sigmoidf_(ia), la = -8.f * r * sp, av = __expf(la);
        const float uu = sqrtf(-expm1f(2.f * la)) * (ig * xo);
        hst = av * hst + uu; ap *= av;
        if (MODE == 1) {
            const float y = bf2f(z[(size_t)(row0 + t) * ZW + ZYR + ch]);
            const float o = hst * gelu_tanh(y);
            const float rs = rsqrtf(wave_sum(o * o) * (1.f / 64.f) + EPS);
            mix[(size_t)(row0 + t) * D + DM + ch] = (bf16_t)f2bf(o * rs * gr);
        }
    }
    if (MODE == 0) { ((float*)(a.ws + WS_SMALL + SM_RGA))[(size_t)item * DR + ch] = ap; ((float*)(a.ws + WS_SMALL + SM_RGH))[(size_t)item * DR + ch] = hst; }
    __syncthreads();
}

template <int MODE>
__device__ __forceinline__ void rglru_fast(const Args& a, unsigned char* lds, int l, int item) {
    const int b = item >> 6, c = item & 63, row0 = b * SEQ + c * CH, ch = otid(), lane = ch & 63, nb = ch >> 6, fr = lane & 15, fq = lane >> 4;
    unsigned char* XA = lds + nb * 9216;
    float* GS = (float*)(lds + 73728 + nb * 8448);
    const bf16_t* z = (const bf16_t*)(a.ws + WS_Z);
    unsigned ypk[32];
    {
        const float* wcr = a.in[I_WCR] + (size_t)l * 4 * DR; const float bcr = a.in[I_BCR][l * DR + ch];
        const float w0 = wcr[ch], w1 = wcr[DR + ch], w2 = wcr[2 * DR + ch], w3 = wcr[3 * DR + ch];
        const bf16_t* zc = z + ZXR + ch;
        bf16_t xin[67];
#pragma unroll
        for (int t = 0; t < 67; ++t) xin[t] = (c == 0 && t < 3) ? (bf16_t)0 : zc[(ptrdiff_t)(row0 + t - 3) * ZW];
        if (MODE == 1) {
            bf16_t yb[64];
#pragma unroll
            for (int t = 0; t < 64; ++t) yb[t] = z[(size_t)(row0 + t) * ZW + ZYR + ch];
#pragma unroll
            for (int t = 0; t < 32; ++t) ypk[t] = (unsigned)yb[2 * t] | ((unsigned)yb[2 * t + 1] << 16);
        }
#pragma unroll
        for (int t = 0; t < 64; ++t)
            *(bf16_t*)(XA + t * 144 + lane * 2) = (bf16_t)f2bf(bcr + w0 * bf2f(xin[t]) + w1 * bf2f(xin[t + 1]) + w2 * bf2f(xin[t + 2]) + w3 * bf2f(xin[t + 3]));
    }
    bf16x8 Bf[8][2];
    { const bf16_t* wt = (const bf16_t*)(a.ws + WS_SMALL + SM_RGW) + (size_t)((l * NBR + nb) * 2) * 64 * 64;
#pragma unroll
        for (int ct = 0; ct < 8; ++ct)
#pragma unroll
            for (int ks = 0; ks < 2; ++ks) Bf[ct][ks] = *(const bf16x8*)(wt + (size_t)((ct >> 2) * 64 + (ct & 3) * 16 + fr) * 64 + ks * 32 + 8 * fq); }
    const float ba = a.in[I_BRA][l * DR + ch], bx = a.in[I_BRI][l * DR + ch];
    const float lam = a.in[I_LAM][l * DR + ch];
    const float sp8 = -8.f * (fmaxf(-lam, 0.f) + log1pf(__expf(-fabsf(lam))));
    float hst = 0.f, ap = 1.f;
    if (MODE == 1) hst = ((const float*)(a.ws + WS_SMALL + SM_RGP))[(size_t)item * DR + ch];
    const float gr = a.in[I_GR][l * DR + ch];
    bf16_t* mix = (bf16_t*)(a.ws + WS_MIX);
    WAVE_LDS_SYNC();
#pragma unroll
    for (int rt = 0; rt < 4; ++rt) {
        bf16x8 Af[2];
#pragma unroll
        for (int ks = 0; ks < 2; ++ks) Af[ks] = *(const bf16x8*)(XA + (rt * 16 + fr) * 144 + (ks * 32 + 8 * fq) * 2);
#pragma unroll
        for (int ct = 0; ct < 8; ++ct) {
            f32x4 acc = {0.f, 0.f, 0.f, 0.f};
            acc = mfma16(Af[0], Bf[ct][0], acc); acc = mfma16(Af[1], Bf[ct][1], acc);
#pragma unroll
            for (int r = 0; r < 4; ++r) GS[(4 * fq + r) * 132 + (ct >> 2) * 64 + (ct & 3) * 16 + fr] = acc[r];
        }
        WAVE_LDS_SYNC();
        {
            float ra[16], ia[16], xo[16], ov_[16];
#pragma unroll
            for (int tt = 0; tt < 16; ++tt) { ra[tt] = GS[tt * 132 + lane]; ia[tt] = GS[tt * 132 + 64 + lane]; xo[tt] = bf2f(*(const bf16_t*)(XA + (rt * 16 + tt) * 144 + lane * 2)); }
#pragma unroll
            for (int tt = 0; tt < 16; ++tt) {
                const float r = sigmoidf_(ra[tt] + ba), ig = sigmoidf_(ia[tt] + bx), la = sp8 * r, av = __expf(la);
                const float uu = __builtin_amdgcn_sqrtf(fmaxf(fmaf(-av, av, 1.f), 0.f)) * (ig * xo[tt]);
                hst = av * hst + uu; ap *= av;
                ov_[tt] = hst;
            }
            if (MODE == 1) {
#pragma unroll
                for (int tt = 0; tt < 16; ++tt) *(bf16_t*)(XA + (rt * 16 + tt) * 144 + lane * 2) = (bf16_t)f2bf(ov_[tt] * gelu_tanh((tt & 1) ? __uint_as_float(ypk[rt * 8 + (tt >> 1)] & 0xffff0000u) : bf2f(ypk[rt * 8 + (tt >> 1)] & 0xffffu)));
            }
        }
        WAVE_LDS_SYNC();
    }
    if (MODE == 1) {
        float ss = 0.f;
#pragma unroll
        for (int j = 0; j < 8; ++j) { const u32x4 v = *(const u32x4*)(XA + lane * 144 + j * 16);
#pragma unroll
            for (int q = 0; q < 4; ++q) { const float lo = bf2f(v[q] & 0xffffu), hi = __uint_as_float(v[q] & 0xffff0000u); ss += lo * lo + hi * hi; } }
        const float rs = rsqrtf(ss * (1.f / 64.f) + EPS) ;
#pragma unroll
        for (int t0 = 0; t0 < 64; t0 += 16) { float ovv[16];
#pragma unroll
            for (int tt = 0; tt < 16; ++tt) ovv[tt] = bf2f(*(const bf16_t*)(XA + (t0 + tt) * 144 + lane * 2));
#pragma unroll
            for (int tt = 0; tt < 16; ++tt) { const float rst = __int_as_float(__builtin_amdgcn_readlane(__float_as_int(rs), t0 + tt));
                *(bf16_t*)(XA + (t0 + tt) * 144 + lane * 2) = (bf16_t)f2bf(ovv[tt] * rst * gr); } }
        WAVE_LDS_SYNC();
#pragma unroll
        for (int j = 0; j < 8; ++j) { const int t = j * 8 + (lane >> 3), q16 = lane & 7;
            *(u32x4*)(mix + (size_t)(row0 + t) * D + DM + nb * 64 + q16 * 8) = *(const u32x4*)(XA + t * 144 + q16 * 16); }
    }
    if (MODE == 0) { ((float*)(a.ws + WS_SMALL + SM_RGA))[(size_t)item * DR + ch] = ap; ((float*)(a.ws + WS_SMALL + SM_RGH))[(size_t)item * DR + ch] = hst; }
    LDS_BARRIER();
}
__device__ __forceinline__ void rglru_scan(const Args& a, int G) {
    const int tid = otid();
    for (int i = blockIdx.x * 8 + (tid & 7); i < NBATCH * DR && tid < 8; i += G * 8) {
        const int b = i / DR, ch = i % DR;
        const float* A_ = (const float*)(a.ws + WS_SMALL + SM_RGA) + (size_t)(b * NC) * DR + ch; const float* H_ = (const float*)(a.ws + WS_SMALL + SM_RGH) + (size_t)(b * NC) * DR + ch;
        float* P_ = (float*)(a.ws + WS_SMALL + SM_RGP) + (size_t)(b * NC) * DR + ch;
        float hs = 0.f;
#pragma unroll 1
        for (int c0 = 0; c0 < NC; c0 += 16) {
            float av[16], hv[16];
#pragma unroll
            for (int j = 0; j < 16; ++j) { av[j] = A_[(c0 + j) * DR]; hv[j] = H_[(c0 + j) * DR]; }
#pragma unroll
            for (int j = 0; j < 16; ++j) { P_[(c0 + j) * DR] = hs; hs = av[j] * hs + hv[j]; }
        }
    }
}

__device__ __forceinline__ void phase_route(const Args& a, unsigned char* lds) {
    unsigned* wtot = (unsigned*)lds;
    int* pre = (int*)(lds + 256);
    int* tot = pre + 8;
    int* ce = tot + 16;
    unsigned* pref = (unsigned*)(lds + 2048);
    const int tid = otid(), lane = tid & 63, wave = tid >> 6, G = gridDim.x;
    const unsigned char* tok_p = (const unsigned char*)(a.ws + WS_SMALL + SM_TOKP); const float* tok_g = (const float*)(a.ws + WS_SMALL + SM_TOKG);
    int* row_tok = (int*)(a.ws + WS_SMALL + SM_ROWTOK); float* row_gate = (float*)(a.ws + WS_SMALL + SM_ROWGATE); int* tile_e = (int*)(a.ws + WS_SMALL + SM_TILEE);
    if (tid < 256) {
        unsigned long long hh = 0ull;
#pragma unroll
        for (int j = 0; j < 4; ++j) { const u32x4 v = ((const u32x4*)(tok_p + tid * 64))[j];
#pragma unroll
            for (int q = 0; q < 4; ++q)
#pragma unroll
                for (int bb = 0; bb < 4; ++bb) { const unsigned by = (v[q] >> (8 * bb)) & 0xffu; hh += (1ull << (8 * (by & 15u))) + (1ull << (8 * (by >> 4))); } }
        unsigned w[4];
#pragma unroll
        for (int i = 0; i < 4; ++i) { const unsigned two = (unsigned)(hh >> (16 * i)) & 0xffffu; w[i] = (two & 0xffu) | ((two >> 8) << 16); }
        unsigned inc[4];
#pragma unroll
        for (int i = 0; i < 4; ++i) { unsigned x = w[i];
#pragma unroll
            for (int o = 1; o < 64; o <<= 1) { const unsigned n = __shfl_up(x, o); if (lane >= o) x += n; }
            inc[i] = x; }
        if (lane == 63) {
#pragma unroll
            for (int i = 0; i < 4; ++i) wtot[wave * 4 + i] = inc[i]; }
        __builtin_amdgcn_s_waitcnt(0);
        __builtin_amdgcn_s_barrier();
#pragma unroll
        for (int i = 0; i < 4; ++i) { unsigned base = 0u;
            for (int ww = 0; ww < wave; ++ww) base += wtot[ww * 4 + i];
            pref[tid * 4 + i] = base + inc[i] - w[i];
            if (tid == 255) { const unsigned t2 = base + inc[i]; tot[2 * i] = (int)(t2 & 0xffffu); tot[2 * i + 1] = (int)(t2 >> 16); } }
    } else {
        __builtin_amdgcn_s_barrier();
    }
    __syncthreads();
    if (tid == 0) { int s_ = 0; for (int e = 0; e < 8; ++e) { tot[8 + e] = s_; s_ += (tot[e] + 255) & ~255; }
        if (blockIdx.x == 0) { int t = 0; for (int e = 0; e < 8; ++e) { const int n = (tot[e] + 255) >> 8; for (int j = 0; j < n; ++j) tile_e[t++] = e; tile_e[256 + e] = t; } tile_e[255] = t; } }
    __syncthreads();
    for (int ck = blockIdx.x; ck < 256; ck += G) {
        if (tid < 128) { const unsigned by = tok_p[ck * 64 + (tid >> 1)]; ce[tid] = (tid & 1) ? (int)(by >> 4) : (int)(by & 15u); }
        __syncthreads();
        if (tid < 128) { const int e = ce[tid];
            int rank = 0, w0cnt = 0;
#pragma unroll
            for (int q = 0; q < 8; ++q) { const unsigned long long mk = __ballot(e == q); if (e == q) rank = __popcll(mk & ((1ull << lane) - 1ull)); if (wave == 0 && lane == 0) ce[128 + q] = __popcll(mk); }
            __builtin_amdgcn_s_waitcnt(0);
            asm volatile("s_barrier" ::: "memory");
            if (wave == 1) rank += ce[128 + e];
            (void)w0cnt;
            const unsigned pw = pref[ck * 4 + (e >> 1)]; const int pr = (int)((e & 1) ? (pw >> 16) : (pw & 0xffffu));
            const int dest = tot[8 + e] + pr + rank;
            row_tok[dest] = ck * 64 + (tid >> 1); row_gate[dest] = tok_g[ck * 128 + tid]; ((int*)(a.ws + WS_SMALL + SM_ROWSLOT))[dest] = tid & 1; }
        else { asm volatile("s_barrier" ::: "memory"); }
        __syncthreads();
    }
}

#ifndef GEMM
#define GEMM gemm_fast
#endif
__global__ void __launch_bounds__(NT, 2) mk_fwd(Args a0) {
    extern __shared__ __attribute__((aligned(16))) unsigned char lds[];
    const int G = gridDim.x, bid = blockIdx.x, ph_lo = a0.ph_lo, ph_hi = a0.ph_hi;
    volatile LAS unsigned* xst = (volatile LAS unsigned*)(lds + LDS_BYTES - 64);
    if (threadIdx.x < 2) xst[threadIdx.x] = 0u;
    __syncthreads();
    const XcdBarrier xb = xcd_barrier_post((unsigned*)(a0.ws + WS_SMALL + SM_BAR), xst);
    int ph = 0;
#ifndef PROBE_CAT
#define PROBE_CAT 0
#define PROBE_N 1
#endif
#define PHASE_BEGIN(cat) if (ph >= ph_lo && ph < ph_hi) { for (int rep_ = 0; rep_ < ((cat) == PROBE_CAT ? PROBE_N : 1); ++rep_) { const bool lastrep = (rep_ + 1 == ((cat) == PROBE_CAT ? PROBE_N : 1)); (void)lastrep; const Args& a = *(const Args*)okarg(); unsigned char* const ws = a.ws; \
    bf16_t* const hn = (bf16_t*)(ws + WS_HN); bf16_t* const z = (bf16_t*)(ws + WS_Z); bf16_t* const mix = (bf16_t*)(ws + WS_MIX); bf16_t* const hid = (bf16_t*)(ws + WS_HID); \
    float* const gates = (float*)(ws + WS_SMALL + SM_GATES); int* const tok_e = (int*)(ws + WS_SMALL + SM_TOKP); float* const tok_g = (float*)(ws + WS_SMALL + SM_TOKG); \
    const int* const row_tok = (const int*)(ws + WS_SMALL + SM_ROWTOK); const float* const row_gate = (const float*)(ws + WS_SMALL + SM_ROWGATE); const int* const tile_e = (const int*)(ws + WS_SMALL + SM_TILEE); \
    (void)hn; (void)z; (void)mix; (void)hid; (void)gates; (void)tok_e; (void)tok_g; (void)row_tok; (void)row_gate; (void)tile_e;
#define PHASE_END(dosync) } for (int rep_ = 0; rep_ < (PROBE_CAT == 6 ? PROBE_N : 1); ++rep_) if ((dosync) && ph + 1 < ph_hi) { xcd_barrier(xb); } } ++ph;

    PHASE_BEGIN(1) phase_prologue(a, lds); __syncthreads();
        phase_rowpass_mm<0, 1>(lds, a.in[I_X], hn, a.in[I_GMIX], (float*)(ws + WS_SSQ), a.in[I_WIN] + 2048, DIN, a.in[I_BIN] + 2048, gates, nullptr, nullptr, nullptr); PHASE_END(true)
    { constexpr int l = 0;
#define LAYER_PTRS bf16_t* const hb = (bf16_t*)(ws + (l ? WS_H1 : WS_HN)); bf16_t* const hbo = (bf16_t*)(ws + (l ? WS_HN : WS_H1)); float* const ssq = (float*)(ws + WS_SSQ + l * SSQ_STRIDE); float* const ssqo = (float*)(ws + WS_SSQ + (1 - l) * SSQ_STRIDE); (void)hb; (void)hbo; (void)ssq; (void)ssqo;
        PHASE_BEGIN(3) LAYER_PTRS { if (l == 1) phase_rowpass_mm<1, 1>(lds, nullptr, hb, a.in[I_GMIX] + l * D, nullptr, a.in[I_WIN] + (size_t)l * D * DIN + 2048, DIN, a.in[I_BIN] + l * DIN + 2048, gates, nullptr, nullptr, nullptr);
            GridOrder S{M / 256, ZW / 256, G, bid}; EpiZ E{z, a.in[I_BIN] + l * DIN, ssq};
            GEMM(lds, hb, (const bf16_t*)(ws + (l ? WS_W_IN1 : WS_W_IN0)), D, S, E); } PHASE_END(true)
        PHASE_BEGIN(4) LAYER_PTRS { MlRegs cur, nxt; int it = bid; if (it < 1024) ml_load(a, l, it, cur); nxt = cur;
            for (; it < 1024; it += G) { if (it + G < 1024) ml_load(a, l, it + G, nxt); ml_compute(a, lds, l, it, cur); cur = nxt; }
            for (; it < 1280; it += G) rglru_fast<0>(a, lds, l, it - 1024); } PHASE_END(true)
        PHASE_BEGIN(0) LAYER_PTRS mlstm_scan(a, G); rglru_scan(a, G); PHASE_END(true)
        PHASE_BEGIN(5) LAYER_PTRS { MoRegs cur, nxt; ConvW cwq, cwk; int hw = -1; int it = bid; if (it < 1024) mo_load(a, l, it, cur); nxt = cur;
            for (; it < 1024; it += G) { if (it + G < 1024) mo_load(a, l, it + G, nxt); mo_compute(a, lds, l, it, cur, cwq, cwk, hw); cur = nxt; }
            for (; it < 1280; it += G) rglru_fast<1>(a, lds, l, it - 1024); } PHASE_END(true)
        PHASE_BEGIN(0) LAYER_PTRS { GridOrder S{M / 256, D / 256, G, bid}; EpiHres<l == 0> E{l == 0 ? a.in[I_X] : nullptr, hb, ssq};
            GEMM(lds, mix, (const bf16_t*)(ws + (l ? WS_W_OUT1 : WS_W_OUT0)), D, S, E); } PHASE_END(true)
        if (l == 0) {
            PHASE_BEGIN(3) LAYER_PTRS { GridOrder S{M / 256, 2 * DFF / 256, G, bid}; EpiSwiglu E{hid, ssq, nullptr};
                GEMM(lds, hb, (const bf16_t*)(ws + WS_W_FFGU), D, S, E);
                { constexpr int nun = (M / 256) * (2 * DFF / 256); const int first = nun % G;
                  TailOrder S2{M / 256, D / 256, G, bid, first}; EpiStoreBf16 E2{(bf16_t*)(ws + WS_PP0)};
                  GEMM(lds, (const bf16_t*)(ws + WS_PB0), (const bf16_t*)(ws + WS_W_PP0), DPLE, S2, E2); } } PHASE_END(true)
            PHASE_BEGIN(0) LAYER_PTRS { GridOrder S{M / 256, D / 256, G, bid}; EpiHres<false> E{nullptr, hb, ssq};
                GEMM(lds, hid, (const bf16_t*)(ws + WS_W_FFD), DFF, S, E); } PHASE_END(true)
        } else {
            PHASE_BEGIN(2) LAYER_PTRS phase_rowpass_mm<1, 2>(lds, nullptr, hb, a.in[I_GFFN] + l * D, nullptr, a.in[I_WROUTER], 8, nullptr, nullptr, (unsigned char*)tok_e, tok_g, ws + WS_HN8); PHASE_END(true)
            PHASE_BEGIN(12) LAYER_PTRS phase_route(a, lds); PHASE_END(true)
            PHASE_BEGIN(3) LAYER_PTRS { MoeOrder<true> S{tile_e[255], 2 * DFF / 256, G, bid, row_tok, (size_t)5632 * D}; S.init(tile_e); EpiSwiglu8 E{ws + WS_HID, 1.f / 32.f};
                gemm_fast<true>(lds, (const bf16_t*)(ws + WS_HN8), (const bf16_t*)(ws + WS_W_EGU), D, S, E); } PHASE_END(true)
            PHASE_BEGIN(0) LAYER_PTRS { MoeOrder<false> S{tile_e[255], D / 256, G, bid, nullptr, (size_t)D * DFF}; S.init(tile_e); EpiMoeDown E{hb, (bf16_t*)a.out, row_tok, (const int*)(ws + WS_SMALL + SM_ROWSLOT), row_gate, 1.f / 32.f};
                gemm_fast<true>(lds, (const bf16_t*)(ws + WS_HID), (const bf16_t*)(ws + WS_W_ED), DFF, S, E);
                { const int nun = tile_e[255] * (D / 256); const int first = nun > 2 * G ? nun - 2 * G : 0;
                  TailOrder S2{M / 256, D / 256, G, bid, first < G ? first : 0}; EpiStoreBf16 E2{(bf16_t*)a.out + (size_t)M * D};
                  GEMM(lds, (const bf16_t*)(ws + WS_PB1), (const bf16_t*)(ws + WS_W_PP1), DPLE, S2, E2); } } PHASE_END(true)
            PHASE_BEGIN(0) LAYER_PTRS phase_rowpass<1, 0, 1, true>(lds, nullptr, hb, (const bf16_t*)a.out, nullptr, ssq, nullptr, 0, nullptr, nullptr, nullptr, nullptr, nullptr); PHASE_END(true)
        }
        PHASE_BEGIN(10) LAYER_PTRS { GridOrder S{M / 256, D / 256, G, bid};
            EpiPle E{hb, hbo, l == 0 ? (const bf16_t*)(ws + WS_PP0) : (const bf16_t*)a.out + (size_t)M * D, ssqo, ssq}; GEMM(lds, hb, (const bf16_t*)(ws + WS_W_PG) + (size_t)l * D * D, D, S, E);
            if (l == 0 && bid == 0) { for (int i = otid(); i < D / 2; i += NT) ((unsigned*)(ws + WS_H1 + (size_t)M * D * 2))[i] = 0u; } } PHASE_END(true)
    }
    { constexpr int l = 1;
        PHASE_BEGIN(3) LAYER_PTRS { if (l == 1) phase_rowpass_mm<1, 1>(lds, nullptr, hb, a.in[I_GMIX] + l * D, nullptr, a.in[I_WIN] + (size_t)l * D * DIN + 2048, DIN, a.in[I_BIN] + l * DIN + 2048, gates, nullptr, nullptr, nullptr);
            GridOrder S{M / 256, ZW / 256, G, bid}; EpiZ E{z, a.in[I_BIN] + l * DIN, ssq};
            GEMM(lds, hb, (const bf16_t*)(ws + (l ? WS_W_IN1 : WS_W_IN0)), D, S, E); } PHASE_END(true)
        PHASE_BEGIN(4) LAYER_PTRS { MlRegs cur, nxt; int it = bid; if (it < 1024) ml_load(a, l, it, cur); nxt = cur;
            for (; it < 1024; it += G) { if (it + G < 1024) ml_load(a, l, it + G, nxt); ml_compute(a, lds, l, it, cur); cur = nxt; }
            for (; it < 1280; it += G) rglru_fast<0>(a, lds, l, it - 1024); } PHASE_END(true)
        PHASE_BEGIN(0) LAYER_PTRS mlstm_scan(a, G); rglru_scan(a, G); PHASE_END(true)
        PHASE_BEGIN(5) LAYER_PTRS { MoRegs cur, nxt; ConvW cwq, cwk; int hw = -1; int it = bid; if (it < 1024) mo_load(a, l, it, cur); nxt = cur;
            for (; it < 1024; it += G) { if (it + G < 1024) mo_load(a, l, it + G, nxt); mo_compute(a, lds, l, it, cur, cwq, cwk, hw); cur = nxt; }
            for (; it < 1280; it += G) rglru_fast<1>(a, lds, l, it - 1024); } PHASE_END(true)
        PHASE_BEGIN(0) LAYER_PTRS { GridOrder S{M / 256, D / 256, G, bid}; EpiHres<l == 0> E{l == 0 ? a.in[I_X] : nullptr, hb, ssq};
            GEMM(lds, mix, (const bf16_t*)(ws + (l ? WS_W_OUT1 : WS_W_OUT0)), D, S, E); } PHASE_END(true)
        if (l == 0) {
            PHASE_BEGIN(3) LAYER_PTRS { GridOrder S{M / 256, 2 * DFF / 256, G, bid}; EpiSwiglu E{hid, ssq, nullptr};
                GEMM(lds, hb, (const bf16_t*)(ws + WS_W_FFGU), D, S, E);
                { constexpr int nun = (M / 256) * (2 * DFF / 256); const int first = nun % G;
                  TailOrder S2{M / 256, D / 256, G, bid, first}; EpiStoreBf16 E2{(bf16_t*)(ws + WS_PP0)};
                  GEMM(lds, (const bf16_t*)(ws + WS_PB0), (const bf16_t*)(ws + WS_W_PP0), DPLE, S2, E2); } } PHASE_END(true)
            PHASE_BEGIN(0) LAYER_PTRS { GridOrder S{M / 256, D / 256, G, bid}; EpiHres<false> E{nullptr, hb, ssq};
                GEMM(lds, hid, (const bf16_t*)(ws + WS_W_FFD), DFF, S, E); } PHASE_END(true)
        } else {
            PHASE_BEGIN(2) LAYER_PTRS phase_rowpass_mm<1, 2>(lds, nullptr, hb, a.in[I_GFFN] + l * D, nullptr, a.in[I_WROUTER], 8, nullptr, nullptr, (unsigned char*)tok_e, tok_g, ws + WS_HN8); PHASE_END(true)
            PHASE_BEGIN(12) LAYER_PTRS phase_route(a, lds); PHASE_END(true)
            PHASE_BEGIN(3) LAYER_PTRS { MoeOrder<true> S{tile_e[255], 2 * DFF / 256, G, bid, row_tok, (size_t)5632 * D}; S.init(tile_e); EpiSwiglu8 E{ws + WS_HID, 1.f / 32.f};
                gemm_fast<true>(lds, (const bf16_t*)(ws + WS_HN8), (const bf16_t*)(ws + WS_W_EGU), D, S, E); } PHASE_END(true)
            PHASE_BEGIN(0) LAYER_PTRS { MoeOrder<false> S{tile_e[255], D / 256, G, bid, nullptr, (size_t)D * DFF}; S.init(tile_e); EpiMoeDown E{hb, (bf16_t*)a.out, row_tok, (const int*)(ws + WS_SMALL + SM_ROWSLOT), row_gate, 1.f / 32.f};
                gemm_fast<true>(lds, (const bf16_t*)(ws + WS_HID), (const bf16_t*)(ws + WS_W_ED), DFF, S, E);
                { const int nun = tile_e[255] * (D / 256); const int first = nun > 2 * G ? nun - 2 * G : 0;
                  TailOrder S2{M / 256, D / 256, G, bid, first < G ? first : 0}; EpiStoreBf16 E2{(bf16_t*)a.out + (size_t)M * D};
                  GEMM(lds, (const bf16_t*)(ws + WS_PB1), (const bf16_t*)(ws + WS_W_PP1), DPLE, S2, E2); } } PHASE_END(true)
            PHASE_BEGIN(0) LAYER_PTRS phase_rowpass<1, 0, 1, true>(lds, nullptr, hb, (const bf16_t*)a.out, nullptr, ssq, nullptr, 0, nullptr, nullptr, nullptr, nullptr, nullptr); PHASE_END(true)
        }
        PHASE_BEGIN(10) LAYER_PTRS { GridOrder S{M / 256, D / 256, G, bid};
            EpiPle E{hb, hbo, l == 0 ? (const bf16_t*)(ws + WS_PP0) : (const bf16_t*)a.out + (size_t)M * D, ssqo, ssq}; GEMM(lds, hb, (const bf16_t*)(ws + WS_W_PG) + (size_t)l * D * D, D, S, E);
            if (l == 0 && bid == 0) { for (int i = otid(); i < D / 2; i += NT) ((unsigned*)(ws + WS_H1 + (size_t)M * D * 2))[i] = 0u; } } PHASE_END(true)
    }
    PHASE_BEGIN(0) phase_rowpass<1, 0, 2, false>(lds, nullptr, hn, nullptr, a.in[I_GFINAL], nullptr, nullptr, 0, nullptr, nullptr, nullptr, nullptr, a.out); PHASE_END(false)
}

extern "C" void kernel_launch(void* const* d_in, const int* in_sizes, int n_in, void* d_out, int out_size,
                              void* d_ws, size_t ws_size, hipStream_t stream) {
    static int grid = 0;
    if (grid == 0) {
        if (n_in != 29 || out_size != M * D || ws_size < WS_END) { fprintf(stderr, "kernel_launch: unexpected problem (n_in %d out %d ws %zu)\n", n_in, out_size, ws_size); grid = -1; return; }
        int dev = 0, cus = 0, per_cu = 0;
        (void)hipGetDevice(&dev);
        (void)hipDeviceGetAttribute(&cus, hipDeviceAttributeMultiprocessorCount, dev);
        (void)hipFuncSetAttribute((const void*)mk_fwd, hipFuncAttributeMaxDynamicSharedMemorySize, LDS_BYTES);
        (void)hipOccupancyMaxActiveBlocksPerMultiprocessor(&per_cu, (const void*)mk_fwd, NT, LDS_BYTES);
        if (per_cu < 1) { fprintf(stderr, "kernel_launch: occupancy query says %d blocks per CU\n", per_cu); per_cu = 1; }
        grid = cus;
    }
    if (grid < 0) return;
    Args a{};
    for (int i = 0; i < 29; ++i) a.in[i] = (const float*)d_in[i];
    a.out = (float*)d_out; a.ws = (unsigned char*)d_ws; a.ph_lo = 0; a.ph_hi = 1000;
    (void)hipMemsetAsync((unsigned char*)d_ws + WS_SMALL + SM_BAR, 0, 16 * 1024, stream);
    void* args[] = {&a};
    hipError_t e = hipLaunchCooperativeKernel((void*)mk_fwd, dim3(grid), dim3(NT), args, LDS_BYTES, stream);
    if (e != hipSuccess) fprintf(stderr, "cooperative launch failed: %s (grid %d)\n", hipGetErrorString(e), grid);
}
```

```cpp
#include <hip/hip_runtime.h>
#include <hip/hip_cooperative_groups.h>
#include <cstdio>
#include <cstdint>
namespace cg = cooperative_groups;

constexpr int NT = 512;
constexpr int D = 1024, NBATCH = 4, SEQ = 4096, M = NBATCH * SEQ;
constexpr int CH = 64, NC = SEQ / CH, NH = 4, DH = 128, DM = 512, DR = 512, NBR = 8, DBR = 64;
constexpr int DIN = 3080, ZW = 3072, DFF = 2816, NE = 8, DPLE = 256;
constexpr int PMAX = 2 * M + NE * 256, NTILE_MAX = PMAX / 256;
constexpr int EROWS = 129;
constexpr float EPS = 1e-6f;
constexpr int ZQ = 0, ZK = 512, ZV = 1024, ZO = 1536, ZXR = 2048, ZYR = 2560;

constexpr size_t MiB = 1u << 20;
constexpr size_t WS_SMALL = 0;
constexpr size_t WS_W_IN0 = 4 * MiB;
constexpr size_t WS_W_OUT0 = 10 * MiB;
constexpr size_t WS_W_FFGU = 12 * MiB;
constexpr size_t WS_W_FFD = 23 * MiB;
constexpr size_t WS_PB0 = WS_W_FFD + 5632 * 1024;
constexpr size_t WS_W_PP0 = WS_PB0 + 8 * MiB;
constexpr size_t WS_H1 = 4 * MiB;
constexpr size_t WS_W_IN1 = 37 * MiB;
constexpr size_t WS_W_OUT1 = 43 * MiB;
constexpr size_t WS_W_PG = 45 * MiB;
constexpr size_t WS_W_PP1 = 49 * MiB;
constexpr size_t WS_W_EGU = WS_W_PP1 + MiB / 2;
constexpr size_t WS_W_ED = WS_W_EGU + 88 * MiB;
constexpr size_t WS_HN8 = WS_W_EGU + 44 * MiB;
constexpr size_t WS_PB1 = WS_W_ED + 44 * MiB;
constexpr size_t WS_HN = WS_PB1 + 8 * MiB;
static_assert(WS_H1 + (size_t)(M + 1) * D * 2 <= WS_W_IN1 && WS_W_PP0 + 1024 * 256 * 2 <= WS_W_IN1, "map");
constexpr size_t WS_RF = 222 * MiB;
constexpr size_t WS_Z = WS_RF;
constexpr size_t WS_CT = WS_Z + 96 * MiB;
constexpr size_t WS_DN = WS_CT + 32 * MiB;
constexpr size_t WS_MIX = WS_CT + 72 * MiB;
constexpr size_t WS_HID = WS_RF;
constexpr size_t WS_PP0 = WS_RF + 130 * MiB;
constexpr size_t WS_SSQ = WS_RF + 201 * MiB;
constexpr size_t SSQ_STRIDE = (size_t)(M + 16) * 64;
constexpr size_t WS_SCAL = WS_RF + 204 * MiB;
constexpr size_t WS_END = 435 * MiB;
static_assert(WS_MIX + (size_t)M * D * 2 <= WS_SSQ && WS_HID + (size_t)PMAX * DFF * 2 <= WS_SSQ && WS_SSQ + 2 * SSQ_STRIDE <= WS_END, "map");
static_assert(WS_HN + (size_t)(M + 1) * D * 2 <= WS_RF, "map");
static_assert(WS_MIX + (size_t)M * D * 2 <= WS_END, "map");
static_assert(WS_HID + (size_t)PMAX * DFF * 2 <= WS_END, "map");
static_assert(WS_DN + 1024 * 128 * 4 <= WS_PP0 && WS_PP0 + (size_t)M * D * 2 <= WS_MIX && WS_HID + (size_t)M * DFF * 2 <= WS_PP0, "map");
constexpr size_t SM_GATES = 0;
constexpr size_t SM_TOKE = 512 * 1024;
constexpr size_t SM_TOKG = SM_TOKE + 128 * 1024;
constexpr size_t SM_ROWTOK = SM_TOKG + 128 * 1024;
constexpr size_t SM_ROWGATE = SM_ROWTOK + 160 * 1024;
constexpr size_t SM_TILEE = SM_ROWGATE + 160 * 1024;
constexpr size_t SM_ROWSLOT = SM_TILEE + 4 * 1024;
constexpr size_t SM_TOKP = SM_ROWSLOT + 160 * 1024;
constexpr size_t SM_BL = SM_TOKP + 16 * 1024;
constexpr size_t SM_AMAX = SM_BL + 4 * 1024;
constexpr size_t SM_MPREV = SM_AMAX + 4 * 1024;
constexpr size_t SM_RGA = 2 * MiB;
constexpr size_t SM_RGH = SM_RGA + 512 * 1024;
constexpr size_t SM_RGP = SM_RGH + 512 * 1024;
constexpr size_t SM_BAR = SM_RGP + 512 * 1024;
constexpr size_t SM_RGW = SM_BAR + 16 * 1024;
static_assert(SM_MPREV + 4096 <= SM_RGA && SM_RGW + 256 * 1024 <= 4 * MiB, "small map");

constexpr int LDS_BYTES = 147456;

typedef unsigned short bf16_t;
typedef float f32x4 __attribute__((ext_vector_type(4)));
typedef unsigned u32x4 __attribute__((ext_vector_type(4)));
typedef unsigned u32x2 __attribute__((ext_vector_type(2)));

__device__ __forceinline__ float bf2f(unsigned v) { return __uint_as_float(v << 16); }
__device__ __forceinline__ unsigned pk2(float lo, float hi);
__device__ __forceinline__ unsigned f2bf(float f) { return pk2(f, 0.f) & 0xffffu; }
typedef float f32x2_t __attribute__((ext_vector_type(2))); typedef __bf16 bf16x2_t __attribute__((ext_vector_type(2)));
__device__ __forceinline__ unsigned pk2(float lo, float hi) { f32x2_t v = {lo, hi}; bf16x2_t b = __builtin_convertvector(v, bf16x2_t); return __builtin_bit_cast(unsigned, b); }
__device__ __forceinline__ unsigned pk4_fp8(float a, float b, float c, float d) { int w = __builtin_amdgcn_cvt_pk_fp8_f32(a, b, 0, false); w = __builtin_amdgcn_cvt_pk_fp8_f32(c, d, w, true); return (unsigned)w; }
__device__ __forceinline__ float frcp(float x) { return __builtin_amdgcn_rcpf(x); }
__device__ __forceinline__ float sigmoidf_(float x) { return frcp(1.f + __expf(-x)); }
__device__ __forceinline__ float siluf_(float x) { return x * frcp(1.f + __expf(-x)); }
__device__ __forceinline__ float logsigmoidf_(float x) { return fminf(x, 0.f) - log1pf(__expf(-fabsf(x))); }
__device__ __forceinline__ float gelu_tanh(float y) { const float u2 = 1.5957691216057308f * (y + 0.044715f * y * y * y); return y * frcp(1.f + __expf(-u2)); }
__device__ __forceinline__ float wave_sum(float v) {
#pragma unroll
    for (int o = 1; o < 64; o <<= 1) v += __shfl_xor(v, o);
    return v;
}
__device__ __forceinline__ float wave_max(float v) {
#pragma unroll
    for (int o = 1; o < 64; o <<= 1) v = fmaxf(v, __shfl_xor(v, o));
    return v;
}

__device__ __forceinline__ float dpp_f(float v, const int ctrl_sel) {
    const int x = __float_as_int(v); int r;
    if (ctrl_sel == 0) r = __builtin_amdgcn_update_dpp(x, x, 0xB1, 0xF, 0xF, false);
    else if (ctrl_sel == 1) r = __builtin_amdgcn_update_dpp(x, x, 0x4E, 0xF, 0xF, false);
    else if (ctrl_sel == 2) r = __builtin_amdgcn_update_dpp(x, x, 0x141, 0xF, 0xF, false);
    else r = __builtin_amdgcn_update_dpp(x, x, 0x140, 0xF, 0xF, false);
    return __int_as_float(r);
}
__device__ __forceinline__ float sum4(float v) { v += dpp_f(v, 0); v += dpp_f(v, 1); return v; }
__device__ __forceinline__ float sum8(float v) { v = sum4(v); v += dpp_f(v, 2); return v; }
__device__ __forceinline__ float sum16(float v) { v = sum8(v); v += dpp_f(v, 3); return v; }
#define WAVE_LDS_SYNC() asm volatile("s_waitcnt lgkmcnt(0)" ::: "memory")
#define LDS_BARRIER() do { asm volatile("s_waitcnt lgkmcnt(0)" ::: "memory"); __builtin_amdgcn_s_barrier(); asm volatile("" ::: "memory"); } while (0)
__device__ __forceinline__ int otid() { int t = threadIdx.x; asm volatile("" : "+v"(t)); return t; }
__device__ __forceinline__ int oint(int v) { asm volatile("" : "+s"(v)); return v; }
__device__ __forceinline__ const void* okarg() { auto p = __builtin_amdgcn_kernarg_segment_ptr(); asm volatile("" : "+s"(p)); return (const void*)p; }

struct Args { const float* in[29]; float* out; unsigned char* ws; int ph_lo, ph_hi; };
enum { I_X = 0, I_P, I_GMIX, I_WIN, I_BIN, I_WCQK, I_BCQK, I_GMH, I_WCR, I_BCR, I_WRA, I_BRA, I_WRI, I_BRI, I_LAM, I_GR, I_WOUT, I_GFFN,
       I_WFG, I_WFU, I_WFD, I_WROUTER, I_WEG, I_WEU, I_WED, I_GPLE, I_WPG, I_WPP, I_GFINAL };


#define XB_TMO      128
#define XB_XCNT(j)  (256  + 64 * (j))
#define XB_XSUB(j)  (1280 + 64 * (j))
#define XB_XGEN(j)  (2304 + 64 * (j))
#define XB_TOP      3328
#define XB_TOPGEN   3392
#define XCD_BAR_WORDS 3456
#define XB_SPIN_CAP (1u << 18)
#define LAS __attribute__((address_space(3)))
__device__ __forceinline__ unsigned xb_ld(unsigned* p)              { return __hip_atomic_load(p, __ATOMIC_RELAXED, __HIP_MEMORY_SCOPE_AGENT); }
__device__ __forceinline__ unsigned xb_add(unsigned* p, unsigned v) { return __hip_atomic_fetch_add(p, v, __ATOMIC_RELAXED, __HIP_MEMORY_SCOPE_AGENT); }
__device__ __forceinline__ unsigned xb_xcc_id() { return (unsigned)__builtin_amdgcn_s_getreg((3 << 11) | 20) & 0xFu; }
#define XB_SPIN(cond, bar) do { unsigned _sp = 0; while (cond) { __builtin_amdgcn_s_sleep(1); \
    if ((++_sp & 255u) == 0u) { if (xb_ld(&(bar)[XB_TMO])) break; if (_sp > XB_SPIN_CAP) { atomicAdd(&(bar)[XB_TMO], 1u); break; } } } } while (0)
struct XcdBarrier { unsigned* bar; unsigned x; volatile LAS unsigned* st; };
__device__ __forceinline__ XcdBarrier xcd_barrier_post(unsigned* bar, volatile LAS unsigned* st) {
    XcdBarrier b; b.bar = bar; b.x = xb_xcc_id(); b.st = st;
    if (threadIdx.x == 0) (void)xb_add(&bar[XB_XCNT(b.x)], 1u);
    return b;
}
__device__ __forceinline__ void xcd_barrier_complete(unsigned* bar, unsigned x, unsigned& nloc, unsigned& nx) {
    const unsigned G = gridDim.x * gridDim.y * gridDim.z;
    unsigned sum, cnt, mine, sp = 0u;
    for (;;) {
        sum = 0u; cnt = 0u; mine = 0u;
#pragma unroll
        for (unsigned j = 0; j < 16; ++j) { const unsigned c = xb_ld(&bar[XB_XCNT(j)]); sum += c; cnt += (c > 0u) ? 1u : 0u; mine = (j == x) ? c : mine; }
        if (sum == G) break;
        __builtin_amdgcn_s_sleep(1);
        if ((++sp & 255u) == 0u) { if (xb_ld(&bar[XB_TMO])) break; if (sp > XB_SPIN_CAP) { atomicAdd(&bar[XB_TMO], 1u); break; } }
    }
    nloc = mine > 0u ? mine : 1u; nx = cnt > 0u ? cnt : 1u;
}
__device__ __forceinline__ void xcd_barrier(const XcdBarrier& b) {
    asm volatile("s_waitcnt vmcnt(0)" ::: "memory");
    __syncthreads();
    if (threadIdx.x == 0) {
        unsigned* bar = b.bar;
        __builtin_amdgcn_s_waitcnt(0);
        unsigned nloc = b.st[0], nx = b.st[1];
        if (nloc == 0u) { xcd_barrier_complete(bar, b.x, nloc, nx); b.st[0] = nloc; b.st[1] = nx; }
        const unsigned old = xb_add(&bar[XB_XSUB(b.x)], 1u);
        const unsigned gen = old / nloc;
        if (old + 1u == (gen + 1u) * nloc) {
            __builtin_amdgcn_fence(__ATOMIC_RELEASE, "agent");
            asm volatile("s_waitcnt vmcnt(0)" ::: "memory");
            const unsigned og = xb_add(&bar[XB_TOP], 1u);
            const unsigned tg = og / nx;
            if (og + 1u == (tg + 1u) * nx) xb_add(&bar[XB_TOPGEN], 1u);
            else XB_SPIN(xb_ld(&bar[XB_TOPGEN]) == tg, bar);
            __builtin_amdgcn_fence(__ATOMIC_ACQUIRE, "agent");
            xb_add(&bar[XB_XGEN(b.x)], 1u);
            asm volatile("s_waitcnt vmcnt(0)" ::: "memory");
        } else {
            XB_SPIN(xb_ld(&bar[XB_XGEN(b.x)]) == gen, bar);
            __builtin_amdgcn_fence(__ATOMIC_ACQUIRE, "agent");
            asm volatile("s_waitcnt vmcnt(0)" ::: "memory");
        }
    }
    __syncthreads();
}

struct CvtJob { const float* src; bf16_t* dst; int ld, k0, c0, K, n0; const float* gain; int fp8; };
__device__ __forceinline__ void cvt_plain_job(CvtJob& o, const float* src, int K, int N, bf16_t* dst, int tile, const float* gain) {
    const int nt = N / 64, kb = tile / nt, nb = tile % nt; o.src = src; o.dst = dst; o.ld = N; o.k0 = kb * 64; o.c0 = nb * 64; o.K = K; o.n0 = nb * 64; o.gain = gain; o.fp8 = 0;
}
__device__ __forceinline__ void cvt_gu_job(CvtJob& o, const float* g, const float* u, bf16_t* dst, int tile, const float* gain) {
    const int nt = 5632 / 64, kb = tile / nt, nb = tile % nt, n0 = nb * 64, tt = n0 >> 8, half = (n0 >> 7) & 1, w = n0 & 127;
    o.src = half ? u : g; o.dst = dst; o.ld = DFF; o.k0 = kb * 64; o.c0 = tt * 128 + w; o.K = 1024; o.n0 = n0; o.gain = gain; o.fp8 = 0;
}
__device__ __forceinline__ void cvt_job(const Args& a, int it, CvtJob& o) {
    unsigned char* ws = a.ws;
    constexpr int T_IN = 16 * 48, T_OUT = 16 * 16, T_GU = 16 * 88, T_FD = 44 * 16, T_PG = 256, T_PP = 4 * 16;
    int r = it;
    if (r < 2 * T_IN) { const int l = r / T_IN, tile = r % T_IN; const int nt = ZW / 64, kb = tile / nt, nb = tile % nt, n0 = nb * 64;
        o.src = a.in[I_WIN] + (size_t)l * D * DIN; o.dst = (bf16_t*)(ws + (l ? WS_W_IN1 : WS_W_IN0)); o.ld = DIN; o.k0 = kb * 64; o.c0 = n0 < 2048 ? n0 : n0 + 8; o.K = D; o.n0 = n0; o.gain = a.in[I_GMIX] + l * D; o.fp8 = 0; return; }
    r -= 2 * T_IN;
    if (r < 2 * T_OUT) { const int l = r / T_OUT; cvt_plain_job(o, a.in[I_WOUT] + (size_t)l * D * D, D, D, (bf16_t*)(ws + (l ? WS_W_OUT1 : WS_W_OUT0)), r % T_OUT, nullptr); return; }
    r -= 2 * T_OUT;
    if (r < T_GU) { cvt_gu_job(o, a.in[I_WFG], a.in[I_WFU], (bf16_t*)(ws + WS_W_FFGU), r, a.in[I_GFFN]); return; }
    r -= T_GU;
    if (r < T_FD) { cvt_plain_job(o, a.in[I_WFD], DFF, D, (bf16_t*)(ws + WS_W_FFD), r, nullptr); return; }
    r -= T_FD;
    if (r < 2 * T_PG) { const int l = r / T_PG; cvt_plain_job(o, a.in[I_WPG] + (size_t)l * D * D, D, D, (bf16_t*)(ws + WS_W_PG) + (size_t)l * D * D, r % T_PG, a.in[I_GPLE] + l * D); return; }
    r -= 2 * T_PG;
    if (r < 2 * T_PP) { const int l = r / T_PP; cvt_plain_job(o, a.in[I_WPP] + (size_t)l * DPLE * D, DPLE, D, (bf16_t*)(ws + (l ? WS_W_PP1 : WS_W_PP0)), r % T_PP, nullptr); return; }
    r -= 2 * T_PP;
    if (r < 8 * T_GU) { const int e = r / T_GU; cvt_gu_job(o, a.in[I_WEG] + (size_t)e * D * DFF, a.in[I_WEU] + (size_t)e * D * DFF, (bf16_t*)(ws + WS_W_EGU + (size_t)e * 5632 * D), r % T_GU, nullptr); o.fp8 = 1; return; }
    r -= 8 * T_GU;
    { const int e = r / T_FD; cvt_plain_job(o, a.in[I_WED] + (size_t)e * DFF * D, DFF, D, (bf16_t*)(ws + WS_W_ED + (size_t)e * D * DFF), r % T_FD, nullptr); o.fp8 = 1; }
}
__device__ __forceinline__ void phase_prologue(const Args& a, unsigned char* lds) {
    unsigned char* ws = a.ws;
    const int G = gridDim.x, t = otid();
    constexpr int T_IN = 16 * 48, T_OUT = 16 * 16, T_GU = 16 * 88, T_FD = 44 * 16, T_PG = 256, T_PP = 4 * 16;
    constexpr int NT_ALL = 2 * T_IN + 2 * T_OUT + T_GU + T_FD + 2 * T_PG + 2 * T_PP + 8 * T_GU + 8 * T_FD;
    constexpr int NB = 4;
    const int kk0 = t >> 4, cc = (t & 15) * 4, n = t >> 3, kg = t & 7;
    float4 v[NB][2], vn[NB][2];
    int it0 = blockIdx.x * NB;
    if (it0 < NT_ALL) {
#pragma unroll
        for (int b = 0; b < NB; ++b) { const int it = it0 + b < NT_ALL ? it0 + b : NT_ALL - 1; CvtJob jq; cvt_job(a, it, jq);
#pragma unroll
            for (int j = 0; j < 2; ++j) v[b][j] = *(const float4*)(jq.src + (size_t)(jq.k0 + kk0 + 32 * j) * jq.ld + jq.c0 + cc); }
    }
    for (; it0 < NT_ALL; it0 += G * NB) {
        const int itn = it0 + G * NB;
        if (itn < NT_ALL) {
#pragma unroll
            for (int b = 0; b < NB; ++b) { const int it = itn + b < NT_ALL ? itn + b : NT_ALL - 1; CvtJob jq; cvt_job(a, it, jq);
#pragma unroll
                for (int j = 0; j < 2; ++j) vn[b][j] = *(const float4*)(jq.src + (size_t)(jq.k0 + kk0 + 32 * j) * jq.ld + jq.c0 + cc); }
        }
#pragma unroll
        for (int b = 0; b < NB; ++b) { float* tl = (float*)lds + b * (64 * 65); const int it = it0 + b < NT_ALL ? it0 + b : NT_ALL - 1; CvtJob jq; cvt_job(a, it, jq);
#pragma unroll
            for (int j = 0; j < 2; ++j) { float4 w = v[b][j];
                if (jq.gain) { const float gk = jq.gain[jq.k0 + kk0 + 32 * j]; w.x *= gk; w.y *= gk; w.z *= gk; w.w *= gk; }
                float* p = tl + (kk0 + 32 * j) * 65 + cc; p[0] = w.x; p[1] = w.y; p[2] = w.z; p[3] = w.w; } }
        LDS_BARRIER();
#pragma unroll
        for (int b = 0; b < NB; ++b) { if (it0 + b >= NT_ALL) break; const float* s_ = (const float*)lds + b * (64 * 65) + (8 * kg) * 65 + n; CvtJob jq; cvt_job(a, it0 + b, jq);
            if (jq.fp8) { u32x2 o; o.x = pk4_fp8(32.f * s_[0], 32.f * s_[65], 32.f * s_[130], 32.f * s_[195]); o.y = pk4_fp8(32.f * s_[260], 32.f * s_[325], 32.f * s_[390], 32.f * s_[455]);
                *(u32x2*)((unsigned char*)jq.dst + (size_t)(jq.n0 + n) * jq.K + jq.k0 + 8 * kg) = o; }
            else { u32x4 o; o.x = pk2(s_[0], s_[65]); o.y = pk2(s_[130], s_[195]); o.z = pk2(s_[260], s_[325]); o.w = pk2(s_[390], s_[455]);
                *(u32x4*)(jq.dst + (size_t)(jq.n0 + n) * jq.K + jq.k0 + 8 * kg) = o; } }
        LDS_BARRIER();
#pragma unroll
        for (int b = 0; b < NB; ++b) { v[b][0] = vn[b][0]; v[b][1] = vn[b][1]; }
    }
    const size_t np4 = (size_t)M * DPLE / 4;
    for (size_t i = (size_t)blockIdx.x * NT + otid(); i < 2 * np4; i += (size_t)G * NT) {
        const float4 v = ((const float4*)a.in[I_P])[i]; u32x2 o; o.x = pk2(v.x, v.y); o.y = pk2(v.z, v.w);
        if (i < np4) ((u32x2*)(ws + WS_PB0))[i] = o; else ((u32x2*)(ws + WS_PB1))[i - np4] = o; }
    for (int i = blockIdx.x * NT + otid(); i < 2 * 8 * 2 * 64 * 64; i += G * NT) {
        const int d = i & 63, e = (i >> 6) & 63, g = (i >> 12) & 1, ln = i >> 13;
        ((bf16_t*)(ws + WS_SMALL + SM_RGW))[i] = (bf16_t)f2bf((g ? a.in[I_WRI] : a.in[I_WRA])[((size_t)ln * 64 + d) * 64 + e]);
    }
    if (blockIdx.x == 0) { for (int i = otid(); i < D / 4; i += NT) ((unsigned*)(ws + WS_HN8 + (size_t)M * D))[i] = 0u; for (int i = otid(); i < D / 2; i += NT) ((unsigned*)(ws + WS_HN + (size_t)M * D * 2))[i] = 0u; if (otid() < 32) ((float*)(ws + WS_SSQ + (otid() >> 4) * SSQ_STRIDE))[(size_t)M * 16 + (otid() & 15)] = 0.f; }
    for (int i = blockIdx.x * NT + otid(); i < PMAX; i += G * NT) { ((int*)(ws + WS_SMALL + SM_ROWTOK))[i] = M; ((float*)(ws + WS_SMALL + SM_ROWGATE))[i] = 0.f; }
}

template <int IN, bool ADDY> struct RawRow {
    f32x4 x[IN == 0 ? 4 : 1]; u32x2 h[IN == 1 ? 4 : 1]; u32x2 y[ADDY ? 4 : 1];
    __device__ __forceinline__ void load(const float* xin, const bf16_t* hb, const bf16_t* y1, int r, int lane) {
#pragma unroll
        for (int j = 0; j < 4; ++j) {
            if (IN == 0) x[j] = ((const f32x4*)(xin + (size_t)r * D) + lane)[64 * j]; else h[j] = ((const u32x2*)(hb + (size_t)r * D) + lane)[64 * j];
            if (ADDY) y[j] = ((const u32x2*)(y1 + (size_t)r * D) + lane)[64 * j]; }
    }
    __device__ __forceinline__ void copy_from(const RawRow& o) {
#pragma unroll
        for (int j = 0; j < 4; ++j) { if (IN == 0) x[j] = o.x[j]; else h[j] = o.h[j]; if (ADDY) y[j] = o.y[j]; }
    }
};
template <int IN, int AUX, int WR, bool ADDY>
__device__ __forceinline__ void phase_rowpass(unsigned char* lds, const float* xin, bf16_t* hb, const bf16_t* y1, const float* g, float* ssq,
                                              const float* auxW, int auxld, const float* auxB, float* gates, unsigned char* tok_p, float* tok_g, float* fout, unsigned char* h8 = nullptr) {
    float* wl = (float*)lds;
    const int tid = otid(), lane = tid & 63, wave = tid >> 6;
    if (AUX) {
        for (int i = tid; i < D * 8; i += NT) wl[i] = auxW[(size_t)(i >> 3) * auxld + (i & 7)];
        __syncthreads();
    }
    f32x4 gv[4];
    if (AUX || WR == 2) {
#pragma unroll
        for (int j = 0; j < 4; ++j) gv[j] = *(const f32x4*)(g + 4 * lane + 256 * j);
    }
    RawRow<1, ADDY> cur, nxt;
    const int rstep = gridDim.x * 8; int row = blockIdx.x * 8 + wave;
    if (IN == 1) { if (row < M) cur.load(xin, hb, y1, row, lane); nxt.copy_from(cur); }
    for (; row < M; row += rstep) {
        if (IN == 1) { if (row + rstep < M) nxt.load(xin, hb, y1, row + rstep, lane); }
        f32x4 v[4]; float ss = 0.f;
#pragma unroll
        for (int j = 0; j < 4; ++j) {
            if (IN == 0) v[j] = ((const f32x4*)(xin + (size_t)row * D) + lane)[64 * j];
            else { const u32x2 w = cur.h[j]; v[j] = (f32x4){bf2f(w.x & 0xffffu), __uint_as_float(w.x & 0xffff0000u), bf2f(w.y & 0xffffu), __uint_as_float(w.y & 0xffff0000u)}; }
            if (ADDY) { const u32x2 y = cur.y[j];
                v[j].x += bf2f(y.x & 0xffffu); v[j].y += __uint_as_float(y.x & 0xffff0000u); v[j].z += bf2f(y.y & 0xffffu); v[j].w += __uint_as_float(y.y & 0xffff0000u); }
            ss += (v[j].x * v[j].x + v[j].y * v[j].y) + (v[j].z * v[j].z + v[j].w * v[j].w); }
        if (IN == 1) cur.copy_from(nxt);
        float tot; { const int ri = __float_as_int(sum16(ss)); tot = (__int_as_float(__builtin_amdgcn_readlane(ri, 0)) + __int_as_float(__builtin_amdgcn_readlane(ri, 16))) + (__int_as_float(__builtin_amdgcn_readlane(ri, 32)) + __int_as_float(__builtin_amdgcn_readlane(ri, 48))); }
        const float rstd = __builtin_amdgcn_rsqf(tot * (1.f / D) + EPS);
        if (WR == 1) {
            u32x2* o = (u32x2*)(hb + (size_t)row * D) + lane;
#pragma unroll
            for (int j = 0; j < 4; ++j) { u32x2 w; w.x = pk2(v[j].x, v[j].y); w.y = pk2(v[j].z, v[j].w); o[64 * j] = w; }
            if (lane < 16) ssq[(size_t)row * 16 + lane] = lane == 0 ? tot : 0.f;
        }
        if (AUX || WR == 2) {
#pragma unroll
            for (int j = 0; j < 4; ++j) v[j] = v[j] * rstd * gv[j];
        }
        if (AUX == 2 && h8) {
#pragma unroll
            for (int j = 0; j < 4; ++j) ((unsigned*)(h8 + (size_t)row * D) + lane)[64 * j] = pk4_fp8(v[j].x, v[j].y, v[j].z, v[j].w);
        }
        if (WR == 2) {
            f32x4* o = (f32x4*)(fout + (size_t)row * D) + lane;
#pragma unroll
            for (int j = 0; j < 4; ++j) o[64 * j] = v[j];
        }
        if (AUX) {
            float acc[8];
#pragma unroll
            for (int c = 0; c < 8; ++c) acc[c] = 0.f;
#pragma unroll
            for (int j = 0; j < 4; ++j)
#pragma unroll
                for (int q = 0; q < 4; ++q) {
                    const int k = 4 * lane + 256 * j + q; const float xv = v[j][q];
                    const f32x4 w0 = *(const f32x4*)(wl + k * 8), w1 = *(const f32x4*)(wl + k * 8 + 4);
                    acc[0] += xv * w0.x; acc[1] += xv * w0.y; acc[2] += xv * w0.z; acc[3] += xv * w0.w;
                    acc[4] += xv * w1.x; acc[5] += xv * w1.y; acc[6] += xv * w1.z; acc[7] += xv * w1.w;
                }
#pragma unroll
            for (int c = 0; c < 8; ++c) { const float r16 = sum16(acc[c]); const int ri = __float_as_int(r16);
                acc[c] = (__int_as_float(__builtin_amdgcn_readlane(ri, 0)) + __int_as_float(__builtin_amdgcn_readlane(ri, 16))) + (__int_as_float(__builtin_amdgcn_readlane(ri, 32)) + __int_as_float(__builtin_amdgcn_readlane(ri, 48))); }
            if (AUX == 1) {
                if (lane < 8) { float s_ = acc[0];
#pragma unroll
                    for (int c = 1; c < 8; ++c) s_ = (lane == c) ? acc[c] : s_;
                    gates[(size_t)row * 8 + lane] = s_ + auxB[lane]; }
            } else {
                if (lane == 0) {
                    int e1 = 0; float v1 = acc[0];
#pragma unroll
                    for (int c = 1; c < 8; ++c) if (acc[c] > v1) { v1 = acc[c]; e1 = c; }
                    int e2 = -1; float v2 = -INFINITY;
#pragma unroll
                    for (int c = 0; c < 8; ++c) if (c != e1 && acc[c] > v2) { v2 = acc[c]; e2 = c; }
                    const float p2 = __expf(v2 - v1), inv = 1.f / (1.f + p2);
                    tok_p[row] = (unsigned char)(e1 | (e2 << 4)); tok_g[row * 2] = inv; tok_g[row * 2 + 1] = p2 * inv;
                }
            }
        }
    }
    __syncthreads();
}

struct Unit { int pm, pn; const int* rows; size_t bofs; };
struct GridOrder {
    static constexpr bool GATHER = false;
    int nM, nN, G, c;
    __device__ __forceinline__ bool next(int i, Unit& u) const {
        const int L0_ = i * G + c, nwg = nM * nN; if (L0_ >= nwg) return false;
        const int q_ = nwg / 8, r_ = nwg % 8, xcd = L0_ % 8, off = L0_ / 8; const int L = (xcd < r_ ? xcd * (q_ + 1) : r_ * (q_ + 1) + (xcd - r_) * q_) + off;
        const int grp = L / (8 * nN), fm = grp * 8, gsz = (nM - fm) < 8 ? (nM - fm) : 8, w = L % (8 * nN);
        u.pm = fm + w % gsz; u.pn = w / gsz; u.rows = nullptr; u.bofs = 0; return true;
    }
};
struct TailOrder {
    static constexpr bool GATHER = false;
    int nM, nN, G, c, first;
    __device__ __forceinline__ bool next(int i, Unit& u) const {
        if (c < first) return false; const int L = i * (G - first) + (c - first); if (L >= nM * nN) return false;
        u.pm = L / nN; u.pn = L % nN; u.rows = nullptr; u.bofs = 0; return true;
    }
};
template <bool GATHER_> struct MoeOrder {
    static constexpr bool GATHER = GATHER_;
    int nM, nN, G, c; const int* rows; size_t estride; int te[8];
    __device__ __forceinline__ void init(const int* tile_e) {
#pragma unroll
        for (int e = 0; e < 8; ++e) te[e] = __builtin_amdgcn_readfirstlane(tile_e[256 + e]);
    }
    __device__ __forceinline__ bool next(int i, Unit& u) const {
        const int L0_ = i * G + c, nwg = nM * nN; if (L0_ >= nwg) return false;
        const int q_ = nwg / 8, r_ = nwg % 8, xcd = L0_ % 8, off = L0_ / 8; const int L = (xcd < r_ ? xcd * (q_ + 1) : r_ * (q_ + 1) + (xcd - r_) * q_) + off;
        const int grp = L / (8 * nN), fm = grp * 8, gsz = (nM - fm) < 8 ? (nM - fm) : 8, w = L % (8 * nN);
        u.pm = fm + w % gsz; u.pn = w / gsz; u.rows = rows; int e = 0;
#pragma unroll
        for (int q = 0; q < 7; ++q) e += (u.pm >= te[q]) ? 1 : 0;
        u.bofs = (size_t)e * estride; return true;
    }
};


namespace pg8 {
#define PG8_LAS __attribute__((address_space(3)))
typedef short bf16x8 __attribute__((ext_vector_type(8)));
constexpr int BM = 256, BK = 64, HALF = 128, HTB = HALF * BK * 2, STAGE_BYTES = 8 * HTB;
__device__ __forceinline__ int lds_byte(int r, int c) { const int st = (r >> 4) * 2 + (c >> 5), rr = r & 15, cc = c & 31, ob = rr * 64 + cc * 2; return st * 1024 + (ob ^ (((ob >> 9) & 1) << 5)); }
__device__ __forceinline__ void stage_rc(int b, int& R, int& C) { const int st = b / 1024, sb = b % 1024, swz = sb ^ (((sb >> 9) & 1) << 5); R = (st >> 1) * 16 + swz / 64; C = (st & 1) * 32 + (swz % 64) / 2; }

typedef int i32x8 __attribute__((ext_vector_type(8))); typedef int i32x4 __attribute__((ext_vector_type(4)));
__device__ __forceinline__ i32x8 cat8(bf16x8 lo, bf16x8 hi) { return __builtin_shufflevector(__builtin_bit_cast(i32x4, lo), __builtin_bit_cast(i32x4, hi), 0, 1, 2, 3, 4, 5, 6, 7); }
__device__ __forceinline__ int perm32(int rho) { const int n = rho >> 4, i = rho & 15; return 8 * (i >> 2) + 4 * n + (i & 3); }
__device__ __forceinline__ void unit_voff(const Unit& u, const int (&R)[2], const int (&C)[2], int KB  , unsigned (&vo)[2][2]) {
#pragma unroll
    for (int h = 0; h < 2; ++h)
#pragma unroll
        for (int i = 0; i < 2; ++i) { int row = u.pm * BM + h * HALF + R[i]; if (u.rows) row = u.rows[row]; vo[h][i] = (unsigned)row * (unsigned)KB + (unsigned)C[i] * 2u; }
}

template <class Epi, class Sched, bool ALIGN_EPI, bool GATHER, bool FP8 = false>
__device__ __forceinline__ void gemm_phase(unsigned char* lds_, const bf16_t* A_, const bf16_t* Bt_, const int K_, const Sched& S, const Epi& E) {
    PG8_LAS unsigned char* lds = (PG8_LAS unsigned char*)lds_;
    const int K = oint(K_);
    const int tid = otid(), wid = __builtin_amdgcn_readfirstlane(tid >> 6), lane = tid & 63, wr = wid >> 2, wc = wid & 3, fr = lane & 15, fq = lane >> 4;
    const int KB = FP8 ? K : 2 * K;
    const int nt = KB / (BK * 2);
    int R[2], C[2]; unsigned voffA[2], voffB[2];
#pragma unroll
    for (int i = 0; i < 2; ++i) { stage_rc(tid * 16 + i * 8192, R[i], C[i]); voffA[i] = (unsigned)(R[i] * KB + C[i] * 2);
        const int Rb = Epi::PERM ? ((R[i] & ~31) + perm32(R[i] & 31)) : R[i]; voffB[i] = (unsigned)(Rb * KB + C[i] * 2); }
    const size_t kstep = (size_t)(BK * 2);
    const size_t hstep = (size_t)HALF * KB;
    const size_t tstep = 2 * hstep;
    const unsigned ldsw = (unsigned)wid * 1024u;
    const int pc0 = FP8 ? 32 * (fq >> 1) + 16 * (fq & 1) : fq * 8; constexpr int KOFF = FP8 ? 16 : 1024;
    const int aoff = lds_byte(wr * 64 + fr, pc0), boff = lds_byte(wc * 32 + fr, pc0);
#define PG8_SA(b, h) (((b) * 2 + (h)) * HTB)
#define PG8_SB(b, h) ((4 + (b) * 2 + (h)) * HTB)
#define PG8_STAGE(bufoff, gbase, voff) do { _Pragma("unroll") for (int _i = 0; _i < 2; ++_i) \
        __builtin_amdgcn_global_load_lds((const unsigned*)((const char*)(gbase) + (voff)[_i]), (PG8_LAS unsigned*)(lds + (bufoff) + ldsw + _i * 8192), 16, 0, 0); } while (0)
#define PG8_STAGE_A(bufoff, base, h, VO) do { if constexpr (GATHER) { PG8_STAGE(bufoff, base, (VO)[h]); } else { PG8_STAGE(bufoff, (base) + (h) * hstep, voffA); } } while (0)
#define PG8_LDA(dst, b, h) do { _Pragma("unroll") for (int m = 0; m < 4; ++m) _Pragma("unroll") for (int k = 0; k < 2; ++k) dst[m][k] = *(const PG8_LAS bf16x8*)(lds + PG8_SA(b, h) + aoff + m * 2048 + k * KOFF); } while (0)
#define PG8_LDB(dst, b, h) do { _Pragma("unroll") for (int n = 0; n < 2; ++n) _Pragma("unroll") for (int k = 0; k < 2; ++k) dst[n][k] = *(const PG8_LAS bf16x8*)(lds + PG8_SB(b, h) + boff + n * 2048 + k * KOFF); } while (0)
#define PG8_MMA(ai, bj, At, Bt) do { __builtin_amdgcn_s_setprio(1); _Pragma("unroll") for (int m = 0; m < 4; ++m) _Pragma("unroll") for (int n = 0; n < 2; ++n) { \
        if constexpr (FP8) { const i32x8 b8_ = cat8(Bt[n][0], Bt[n][1]), a8_ = cat8(At[m][0], At[m][1]); \
            asm volatile("v_mfma_scale_f32_16x16x128_f8f6f4 %0, %1, %2, %0, %3, %3 op_sel_hi:[0,0,0]" : "+v"(acc[ai][bj][m][n]) : "v"(b8_), "v"(a8_), "v"(scale1)); } \
        else { _Pragma("unroll") for (int k = 0; k < 2; ++k) acc[ai][bj][m][n] = __builtin_amdgcn_mfma_f32_16x16x32_bf16(Bt[n][k], At[m][k], acc[ai][bj][m][n], 0, 0, 0); } } __builtin_amdgcn_s_setprio(0); } while (0)
#define PG8_WAIT_V(n) asm volatile("s_waitcnt vmcnt(" #n ")" ::: "memory")
#define PG8_WAIT_L(n) asm volatile("s_waitcnt lgkmcnt(" #n ")" ::: "memory")
#define PG8_BAR __builtin_amdgcn_s_barrier()
#define PG8_SCHED __builtin_amdgcn_sched_barrier(0)
    const int scale1 = 0x7f7f7f7f;
    Unit cur, nxt; int ui = 0;
    if (!S.next(0, cur)) return;
    f32x4 acc[2][2][4][2];
#pragma unroll
    for (int a = 0; a < 2; ++a)
#pragma unroll
        for (int b = 0; b < 2; ++b)
#pragma unroll
            for (int m = 0; m < 4; ++m)
#pragma unroll
                for (int n = 0; n < 2; ++n) acc[a][b][m][n] = (f32x4){0.f, 0.f, 0.f, 0.f};
    bf16x8 At[4][2], B0[2][2], B1[2][2];
    unsigned vc[2][2], vn[2][2];
    if constexpr (GATHER) unit_voff(cur, R, C, KB, vc);
    const char* cA = GATHER ? (const char*)A_ : (const char*)A_ + (size_t)cur.pm * tstep;
    const char* cB = (const char*)Bt_ + cur.bofs * (FP8 ? 1 : 2) + (size_t)cur.pn * tstep;
    PG8_STAGE(PG8_SB(0, 0), cB, voffB); PG8_STAGE(PG8_SB(0, 1), cB + hstep, voffB); PG8_STAGE_A(PG8_SA(0, 0), cA, 0, vc); PG8_STAGE_A(PG8_SA(0, 1), cA, 1, vc);
    if (wr == 1) PG8_BAR;
    PG8_WAIT_V(2); PG8_BAR;
    PG8_STAGE(PG8_SB(1, 0), cB + kstep, voffB); PG8_STAGE_A(PG8_SA(1, 0), cA + kstep, 0, vc); PG8_STAGE(PG8_SB(1, 1), cB + hstep + kstep, voffB);
    PG8_WAIT_V(6); PG8_BAR;
    for (;;) {
        const bool has_next = S.next(ui + 1, nxt);
        const char* nA = cA; const char* nB = cB;
        if (has_next) { nB = (const char*)Bt_ + nxt.bofs * (FP8 ? 1 : 2) + (size_t)nxt.pn * tstep; if constexpr (!GATHER) nA = (const char*)A_ + (size_t)nxt.pm * tstep; }
        int rn[2][2];
        if constexpr (GATHER) {
#pragma unroll
            for (int h = 0; h < 2; ++h)
#pragma unroll
                for (int i = 0; i < 2; ++i) rn[h][i] = cur.rows[(has_next ? nxt.pm : cur.pm) * BM + h * HALF + R[i]]; }
        for (int t = 0; t < nt; t += 2) {
            const bool last = (t == nt - 2);
            if constexpr (GATHER) { if (last) {
#pragma unroll
                for (int h = 0; h < 2; ++h)
#pragma unroll
                    for (int i = 0; i < 2; ++i) { int r_ = rn[h][i]; asm volatile("" : "+v"(r_));
                        vn[h][i] = (unsigned)r_ * (unsigned)KB + (unsigned)C[i] * 2u; } } }
            const char* a1 = cA + (size_t)(t + 1) * kstep;
            const char* a2 = last ? nA : cA + (size_t)(t + 2) * kstep; const char* b2 = last ? nB : cB + (size_t)(t + 2) * kstep;
            const char* a3 = a2 + kstep; const char* b3 = b2 + kstep;
            unsigned v2[2][2];
            if constexpr (GATHER) {
#pragma unroll
                for (int h = 0; h < 2; ++h)
#pragma unroll
                    for (int i = 0; i < 2; ++i) v2[h][i] = last ? vn[h][i] : vc[h][i]; }
            PG8_LDB(B0, 0, 0); PG8_LDB(B1, 0, 1); PG8_SCHED; PG8_LDA(At, 0, 0); PG8_STAGE_A(PG8_SA(1, 1), a1, 1, vc);
            PG8_WAIT_V(8); PG8_WAIT_L(0); PG8_BAR; PG8_MMA(0, 0, At, B0); PG8_MMA(0, 1, At, B1); PG8_BAR; PG8_SCHED;
            PG8_LDA(At, 0, 1); PG8_STAGE(PG8_SB(0, 0), b2, voffB); PG8_STAGE(PG8_SB(0, 1), b2 + hstep, voffB); PG8_STAGE_A(PG8_SA(0, 0), a2, 0, v2);
            PG8_WAIT_V(8); PG8_WAIT_L(0); PG8_BAR; PG8_MMA(1, 0, At, B0); PG8_MMA(1, 1, At, B1); PG8_BAR; PG8_SCHED;
            PG8_LDB(B0, 1, 0); PG8_LDB(B1, 1, 1); PG8_SCHED; PG8_LDA(At, 1, 0); PG8_STAGE_A(PG8_SA(0, 1), a2, 1, v2);
            PG8_WAIT_V(8); PG8_WAIT_L(0); PG8_BAR; PG8_MMA(0, 0, At, B0); PG8_MMA(0, 1, At, B1); PG8_BAR; PG8_SCHED;
            PG8_LDA(At, 1, 1); PG8_STAGE(PG8_SB(1, 0), b3, voffB); PG8_STAGE(PG8_SB(1, 1), b3 + hstep, voffB); PG8_STAGE_A(PG8_SA(1, 0), a3, 0, v2);
            PG8_WAIT_V(8); PG8_WAIT_L(0); PG8_BAR; PG8_MMA(1, 0, At, B0); PG8_MMA(1, 1, At, B1); PG8_BAR; PG8_SCHED;
        }
        if constexpr (ALIGN_EPI) { if (wr == 0) PG8_BAR; }
        { int pm_ = cur.pm, pn_ = cur.pn, fr_ = fr, fq_ = fq;
          asm volatile("" : "+s"(pm_), "+s"(pn_), "+v"(fr_), "+v"(fq_));
          E(acc, pm_, pn_, wr, wc, fr_, fq_); }
        if (!has_next) break;
#pragma unroll
        for (int a = 0; a < 2; ++a)
#pragma unroll
            for (int b = 0; b < 2; ++b)
#pragma unroll
                for (int m = 0; m < 4; ++m)
#pragma unroll
                    for (int n = 0; n < 2; ++n) acc[a][b][m][n] = (f32x4){0.f, 0.f, 0.f, 0.f};
        cur = nxt; cA = nA; cB = nB; ++ui;
        if constexpr (GATHER) {
#pragma unroll
            for (int h = 0; h < 2; ++h)
#pragma unroll
                for (int i = 0; i < 2; ++i) vc[h][i] = vn[h][i]; }
        if constexpr (ALIGN_EPI) { if (wr == 1) PG8_BAR; }
    }
    PG8_WAIT_V(0);
    if constexpr (!ALIGN_EPI) { if (wr == 0) PG8_BAR; }
    PG8_BAR;
#undef PG8_SA
#undef PG8_SB
#undef PG8_STAGE
#undef PG8_STAGE_A
#undef PG8_LDA
#undef PG8_LDB
#undef PG8_MMA
#undef PG8_WAIT_V
#undef PG8_WAIT_L
#undef PG8_BAR
#undef PG8_SCHED
}
}
template <bool FP8 = false, class Epi, class Sched>
__device__ __forceinline__ void gemm_fast(unsigned char* lds, const bf16_t* A, const bf16_t* Bt, int K, const Sched& S, const Epi& E) {
    pg8::gemm_phase<Epi, Sched, true, Sched::GATHER, FP8>(lds, A, Bt, K, S, E);
    __syncthreads();
}

typedef f32x4 AccT[2][2][4][2];
#define EPI_ROW(ai, m) (pm * 256 + (ai) * 128 + wr * 64 + (m) * 16 + fr)
__device__ __forceinline__ void unpack8(const u32x4 w, f32x4& lo, f32x4& hi) {
    lo = (f32x4){bf2f(w.x & 0xffffu), __uint_as_float(w.x & 0xffff0000u), bf2f(w.y & 0xffffu), __uint_as_float(w.y & 0xffff0000u)};
    hi = (f32x4){bf2f(w.z & 0xffffu), __uint_as_float(w.z & 0xffff0000u), bf2f(w.w & 0xffffu), __uint_as_float(w.w & 0xffff0000u)};
}
__device__ __forceinline__ u32x4 pack8(const f32x4 v0, const f32x4 v1) { u32x4 w; w.x = pk2(v0.x, v0.y); w.y = pk2(v0.z, v0.w); w.z = pk2(v1.x, v1.y); w.w = pk2(v1.z, v1.w); return w; }
__device__ __forceinline__ float dot8(const f32x4 a, const f32x4 b) { return ((a.x * a.x + a.y * a.y) + (a.z * a.z + a.w * a.w)) + ((b.x * b.x + b.y * b.y) + (b.z * b.z + b.w * b.w)); }
__device__ __forceinline__ void epi_rstd(const float* ssq, const int* rowmap, int pm, int wr, int fr, int fq, float (&rs)[2][4]) {
    f32x4 p[2][4];
#pragma unroll
    for (int ai = 0; ai < 2; ++ai)
#pragma unroll
        for (int m = 0; m < 4; ++m) { int row = EPI_ROW(ai, m); if (rowmap) row = rowmap[row]; p[ai][m] = *(const f32x4*)((const char*)ssq + ((unsigned)row * 16u + 4u * (unsigned)fq) * 4u); }
#pragma unroll
    for (int ai = 0; ai < 2; ++ai)
#pragma unroll
        for (int m = 0; m < 4; ++m) { float t = (p[ai][m].x + p[ai][m].y) + (p[ai][m].z + p[ai][m].w); t += __shfl_xor(t, 16); t += __shfl_xor(t, 32); rs[ai][m] = __builtin_amdgcn_rsqf(t * (1.f / 1024.f) + EPS); }
}
__device__ __forceinline__ void epi_ssq(float* ssq, int row, int slot, float s_, int fq) { s_ += __shfl_xor(s_, 16); s_ += __shfl_xor(s_, 32); if (fq == 0) *(float*)((char*)ssq + ((unsigned)row * 16u + (unsigned)slot) * 4u) = s_; }

struct EpiZ { static constexpr bool PERM = true; bf16_t* z; const float* bin; const float* ssq;
    __device__ __forceinline__ void operator()(const AccT& acc, int pm, int pn, int wr, int wc, int fr, int fq) const {
        const int c0 = pn * 256 + wc * 32 + 8 * fq; f32x4 bv[2][2]; float rs[2][4];
#pragma unroll
        for (int bj = 0; bj < 2; ++bj)
#pragma unroll
            for (int n = 0; n < 2; ++n) { const int cc = c0 + bj * 128 + n * 4; bv[bj][n] = *(const f32x4*)(bin + (cc < 2048 ? cc : cc + 8)); }
        epi_rstd(ssq, nullptr, pm, wr, fr, fq, rs);
#pragma unroll
        for (int ai = 0; ai < 2; ++ai)
#pragma unroll
            for (int m = 0; m < 4; ++m) { bf16_t* rp = z + (size_t)EPI_ROW(ai, m) * ZW + c0; const float r = rs[ai][m];
#pragma unroll
                for (int bj = 0; bj < 2; ++bj) *(u32x4*)(rp + bj * 128) = pack8(acc[ai][bj][m][0] * r + bv[bj][0], acc[ai][bj][m][1] * r + bv[bj][1]); } } };
template <bool XB> struct EpiHres { static constexpr bool PERM = true; const float* xb; bf16_t* hb; float* ssq;
    __device__ __forceinline__ void operator()(const AccT& acc, int pm, int pn, int wr, int wc, int fr, int fq) const {
        const int c0 = pn * 256 + wc * 32 + 8 * fq;
#pragma unroll
        for (int ai = 0; ai < 2; ++ai) {
            f32x4 lx[4][2][2]; u32x4 lh[4][2];
#pragma unroll
            for (int m = 0; m < 4; ++m)
#pragma unroll
                for (int bj = 0; bj < 2; ++bj) { const size_t o = (size_t)EPI_ROW(ai, m) * D + c0 + bj * 128;
                    if (XB) { lx[m][bj][0] = *(const f32x4*)(xb + o); lx[m][bj][1] = *(const f32x4*)(xb + o + 4); } else lh[m][bj] = *(const u32x4*)(hb + o); }
#pragma unroll
            for (int m = 0; m < 4; ++m) { float s_ = 0.f; const int row = EPI_ROW(ai, m);
#pragma unroll
                for (int bj = 0; bj < 2; ++bj) { f32x4 b0, b1; if (XB) { b0 = lx[m][bj][0]; b1 = lx[m][bj][1]; } else unpack8(lh[m][bj], b0, b1);
                    const f32x4 v0 = b0 + acc[ai][bj][m][0], v1 = b1 + acc[ai][bj][m][1]; s_ += dot8(v0, v1);
                    *(u32x4*)(hb + (size_t)row * D + c0 + bj * 128) = pack8(v0, v1); }
                epi_ssq(ssq, row, pn * 4 + wc, s_, fq); }
        } } };
struct EpiSwiglu { static constexpr bool PERM = true; bf16_t* hid; const float* ssq; const int* rowmap;
    __device__ __forceinline__ void operator()(const AccT& acc, int pm, int pn, int wr, int wc, int fr, int fq) const {
        const int c0 = pn * 128 + wc * 32 + 8 * fq; float rs[2][4];
        epi_rstd(ssq, rowmap, pm, wr, fr, fq, rs);
#pragma unroll
        for (int ai = 0; ai < 2; ++ai)
#pragma unroll
            for (int m = 0; m < 4; ++m) { u32x4 w; const float r = rs[ai][m];
#pragma unroll
                for (int n = 0; n < 2; ++n) { const f32x4 g = acc[ai][0][m][n] * r, u = acc[ai][1][m][n] * r;
                    w[2 * n] = pk2(siluf_(g.x) * u.x, siluf_(g.y) * u.y); w[2 * n + 1] = pk2(siluf_(g.z) * u.z, siluf_(g.w) * u.w); }
                *(u32x4*)(hid + (size_t)EPI_ROW(ai, m) * DFF + c0) = w; } } };
struct EpiSwiglu8 { static constexpr bool PERM = true; unsigned char* hid8; float sc;
    __device__ __forceinline__ void operator()(const AccT& acc, int pm, int pn, int wr, int wc, int fr, int fq) const {
        const int c0 = pn * 128 + wc * 32 + 8 * fq;
#pragma unroll
        for (int ai = 0; ai < 2; ++ai)
#pragma unroll
            for (int m = 0; m < 4; ++m) { u32x2 w;
#pragma unroll
                for (int n = 0; n < 2; ++n) { const f32x4 g = acc[ai][0][m][n] * sc, u = acc[ai][1][m][n] * sc;
                    w[n] = pk4_fp8(siluf_(g.x) * u.x, siluf_(g.y) * u.y, siluf_(g.z) * u.z, siluf_(g.w) * u.w); }
                *(u32x2*)(hid8 + (size_t)EPI_ROW(ai, m) * DFF + c0) = w; } } };
struct EpiMoeDown { static constexpr bool PERM = true; bf16_t* hb; bf16_t* y1; const int* row_tok; const int* row_slot; const float* row_gate; float sc;
    __device__ __forceinline__ void operator()(const AccT& acc, int pm, int pn, int wr, int wc, int fr, int fq) const {
        const int c0 = pn * 256 + wc * 32 + 8 * fq;
        int tok[2][4], slot[2][4]; float gt[2][4];
#pragma unroll
        for (int ai = 0; ai < 2; ++ai)
#pragma unroll
            for (int m = 0; m < 4; ++m) { const int row = EPI_ROW(ai, m); tok[ai][m] = row_tok[row]; slot[ai][m] = row_slot[row]; gt[ai][m] = row_gate[row] * sc; }
#pragma unroll
        for (int ai = 0; ai < 2; ++ai) {
            u32x4 lh[4][2];
#pragma unroll
            for (int m = 0; m < 4; ++m) { const bool rmw = tok[ai][m] < M && slot[ai][m] == 0;
#pragma unroll
                for (int bj = 0; bj < 2; ++bj) lh[m][bj] = rmw ? *(const u32x4*)(hb + (size_t)tok[ai][m] * D + c0 + bj * 128) : (u32x4){0u, 0u, 0u, 0u}; }
#pragma unroll
            for (int m = 0; m < 4; ++m) { if (tok[ai][m] >= M) continue; const size_t o = (size_t)tok[ai][m] * D + c0; const float g = gt[ai][m];
                if (slot[ai][m] == 0) {
#pragma unroll
                    for (int bj = 0; bj < 2; ++bj) { f32x4 b0, b1; unpack8(lh[m][bj], b0, b1); *(u32x4*)(hb + o + bj * 128) = pack8(b0 + g * acc[ai][bj][m][0], b1 + g * acc[ai][bj][m][1]); }
                } else {
#pragma unroll
                    for (int bj = 0; bj < 2; ++bj) *(u32x4*)(y1 + o + bj * 128) = pack8(g * acc[ai][bj][m][0], g * acc[ai][bj][m][1]);
                } }
        } } };
struct EpiStoreBf16 { static constexpr bool PERM = true; bf16_t* out;
    __device__ __forceinline__ void operator()(const AccT& acc, int pm, int pn, int wr, int wc, int fr, int fq) const {
        const int c0 = pn * 256 + wc * 32 + 8 * fq;
#pragma unroll
        for (int ai = 0; ai < 2; ++ai)
#pragma unroll
            for (int m = 0; m < 4; ++m)
#pragma unroll
                for (int bj = 0; bj < 2; ++bj) *(u32x4*)(out + (size_t)EPI_ROW(ai, m) * D + c0 + bj * 128) = pack8(acc[ai][bj][m][0], acc[ai][bj][m][1]); } };
struct EpiPle { static constexpr bool PERM = true; const bf16_t* hin; bf16_t* hb; const bf16_t* pp; float* ssq; const float* ssq_in;
    __device__ __forceinline__ void operator()(const AccT& acc, int pm, int pn, int wr, int wc, int fr, int fq) const {
        const int c0 = pn * 256 + wc * 32 + 8 * fq; float rs[2][4];
        epi_rstd(ssq_in, nullptr, pm, wr, fr, fq, rs);
        u32x4 sg[2][4][2];
#pragma unroll
        for (int ai = 0; ai < 2; ++ai)
#pragma unroll
            for (int m = 0; m < 4; ++m)
#pragma unroll
                for (int bj = 0; bj < 2; ++bj) { f32x4 a0 = acc[ai][bj][m][0] * rs[ai][m], a1 = acc[ai][bj][m][1] * rs[ai][m];
#pragma unroll
                    for (int q = 0; q < 4; ++q) { a0[q] = sigmoidf_(a0[q]); a1[q] = sigmoidf_(a1[q]); }
                    sg[ai][m][bj] = pack8(a0, a1); }
        asm volatile("" ::: "memory");
#pragma unroll
        for (int ai = 0; ai < 2; ++ai) {
            u32x4 lh[4][2], lp[4][2];
#pragma unroll
            for (int m = 0; m < 4; ++m)
#pragma unroll
                for (int bj = 0; bj < 2; ++bj) { const unsigned ob = ((unsigned)EPI_ROW(ai, m) * D + c0 + bj * 128) * 2u;
                    lh[m][bj] = *(const u32x4*)((const char*)hin + ob); lp[m][bj] = *(const u32x4*)((const char*)pp + ob); }
#pragma unroll
            for (int m = 0; m < 4; ++m) { float s_ = 0.f; const int row = EPI_ROW(ai, m);
#pragma unroll
                for (int bj = 0; bj < 2; ++bj) { f32x4 h0, h1, p0, p1, g0, g1; unpack8(lh[m][bj], h0, h1); unpack8(lp[m][bj], p0, p1); unpack8(sg[ai][m][bj], g0, g1);
                    h0 += g0 * p0; h1 += g1 * p1; s_ += dot8(h0, h1);
                    *(u32x4*)((char*)hb + ((unsigned)row * D + c0 + bj * 128) * 2u) = pack8(h0, h1); }
                epi_ssq(ssq, row, pn * 4 + wc, s_, fq); }
        } } };

__device__ __forceinline__ float conv4(const bf16_t* zc, int row, int s, const float* w  , int wstride, float b) {
    float acc = b;
#pragma unroll
    for (int j = 0; j < 4; ++j) { const int ds = 3 - j; if (s - ds >= 0) acc += w[j * wstride] * bf2f(zc[(ptrdiff_t)(row - ds) * ZW]); }
    return acc;
}
__device__ __forceinline__ void chunk_gates(float* sc, const float* gates, int row0, int h, int lane) {
    const float ip = gates[(size_t)(row0 + lane) * 8 + h], fp = gates[(size_t)(row0 + lane) * 8 + 4 + h];
    float b = logsigmoidf_(fp);
#pragma unroll
    for (int o = 1; o < 64; o <<= 1) { const float n = __shfl_up(b, o); if (lane >= o) b += n; }
    sc[lane] = b; sc[64 + lane] = ip;
}
__device__ __forceinline__ void chunk_gates_r(float* sc, float ip, float fp, int lane) {
    float b = logsigmoidf_(fp);
#pragma unroll
    for (int o = 1; o < 64; o <<= 1) { const float n = __shfl_up(b, o); if (lane >= o) b += n; }
    sc[lane] = b; sc[64 + lane] = ip;
}
__device__ __forceinline__ void mlstm_local(const Args& a, unsigned char* lds, int l, int item) {
    const int b = item >> 8, c = (item >> 2) & 63, h = item & 3, row0 = b * SEQ + c * CH, tid = otid(), lane = tid & 63;
    float* Kt = (float*)lds;
    float* Vt = Kt + 64 * 128;
    float* sc = Vt + 64 * 128;
    const bf16_t* z = (const bf16_t*)(a.ws + WS_Z);
    const float* gates = (const float*)(a.ws + WS_SMALL + SM_GATES);
    if (tid < 64) {
        chunk_gates(sc, gates, row0, h, lane);
        const float bl = __shfl(sc[lane], 63), al = bl - sc[lane] + sc[64 + lane];
        const float amax = wave_max(al);
        sc[128 + lane] = __expf(al - amax);
        if (lane == 0) { ((float*)(a.ws + WS_SMALL + SM_BL))[item] = bl; ((float*)(a.ws + WS_SMALL + SM_AMAX))[item] = amax; }
    }
    const float* wc = a.in[I_WCQK] + (size_t)l * 4 * 1024; const float* bc = a.in[I_BCQK] + (size_t)l * 1024;
    for (int i = tid; i < 64 * 128; i += NT) {
        const int ll = i >> 7, d = i & 127, ch = ZK + h * DH + d;
        Kt[i] = siluf_(conv4(z + ch, row0 + ll, c * CH + ll, wc + ch, 1024, bc[ch]));
        Vt[i] = bf2f(z[(size_t)(row0 + ll) * ZW + ZV + h * DH + d]);
    }
    __syncthreads();
    const int d = tid & 127, eg = tid >> 7;
    float acc[33];
#pragma unroll
    for (int i = 0; i < 33; ++i) acc[i] = 0.f;
    for (int ll = 0; ll < 64; ++ll) {
        const float kd = Kt[ll * 128 + d] * sc[128 + ll];
#pragma unroll
        for (int i = 0; i < 32; ++i) acc[i] += Vt[ll * 128 + eg + 4 * i] * kd;
        acc[32] += kd;
    }
    float* ct = (float*)(a.ws + WS_CT) + (size_t)item * EROWS * 128;
#pragma unroll
    for (int i = 0; i < 32; ++i) ct[(eg + 4 * i) * 128 + d] = acc[i];
    if (eg == 0) ct[128 * 128 + d] = acc[32];
    __syncthreads();
}
__device__ __forceinline__ void mlstm_scan(const Args& a, int G) {
    const float* BL = (const float*)(a.ws + WS_SMALL + SM_BL); const float* AM = (const float*)(a.ws + WS_SMALL + SM_AMAX);
    float* MP = (float*)(a.ws + WS_SMALL + SM_MPREV);
    const int tid = otid();
    for (int w = blockIdx.x; w < 16 * 16; w += G) {
        const int bh = w >> 4, sl = w & 15, b = bh >> 2, h = bh & 3;
        unsigned* p = (unsigned*)(a.ws + WS_CT) + (size_t)((b * NC) * NH + h) * 8192 + sl * 512 + tid;
        float s0 = 0.f, s1 = 0.f, m = 0.f;
#pragma unroll 1
        for (int c0 = 0; c0 < NC; c0 += 16) {
            unsigned x[16];
#pragma unroll
            for (int j = 0; j < 16; ++j) x[j] = p[(size_t)(c0 + j) * (NH * 8192)];
#pragma unroll
            for (int j = 0; j < 16; ++j) {
                const int item = (b * NC + c0 + j) * NH + h;
                const float bl = BL[item], am = AM[item];
                const float mn = fmaxf(bl + m, am), dec = __expf(bl + m - mn), scl = __expf(am - mn);
                p[(size_t)(c0 + j) * (NH * 8192)] = pk2(s0, s1);
                if (sl == 0 && tid == 0) MP[item] = m;
                s0 = dec * s0 + scl * bf2f(x[j] & 0xffffu); s1 = dec * s1 + scl * __uint_as_float(x[j] & 0xffff0000u); m = mn;
            }
        }
        if (sl == 1 && tid < 128) {
            float* q = (float*)(a.ws + WS_DN) + (size_t)((b * NC) * NH + h) * 128 + tid;
            float sn = 0.f; m = 0.f;
#pragma unroll 1
            for (int c0 = 0; c0 < NC; c0 += 16) {
                float x[16];
#pragma unroll
                for (int j = 0; j < 16; ++j) x[j] = q[(size_t)(c0 + j) * (NH * 128)];
#pragma unroll
                for (int j = 0; j < 16; ++j) {
                    const int item = (b * NC + c0 + j) * NH + h;
                    const float bl = BL[item], am = AM[item];
                    const float mn = fmaxf(bl + m, am), dec = __expf(bl + m - mn), scl = __expf(am - mn);
                    q[(size_t)(c0 + j) * (NH * 128)] = sn;
                    sn = dec * sn + scl * x[j]; m = mn;
                }
            }
        }
    }
}
__device__ __forceinline__ void mlstm_out(const Args& a, unsigned char* lds, int l, int item) {
    const int b = item >> 8, c = (item >> 2) & 63, h = item & 3, row0 = b * SEQ + c * CH, tid = otid(), lane = tid & 63, wave = tid >> 6;
    float* Q = (float*)lds;
    float* Kt = Q + 64 * 128;
    float* Vt = Kt + 64 * 128;
    float* Sm = Vt + 64 * 128;
    float* sc = Sm + 64 * 64;
    const bf16_t* z = (const bf16_t*)(a.ws + WS_Z);
    const float* gates = (const float*)(a.ws + WS_SMALL + SM_GATES);
    const float mprev = ((const float*)(a.ws + WS_SMALL + SM_MPREV))[item];
    if (tid < 64) {
        chunk_gates(sc, gates, row0, h, lane);
        float g = sc[64 + lane] - sc[lane];
#pragma unroll
        for (int o = 1; o < 64; o <<= 1) { const float n = __shfl_up(g, o); if (lane >= o) g = fmaxf(g, n); }
        const float mrow = sc[lane] + fmaxf(mprev, g);
        sc[128 + lane] = mrow; sc[192 + lane] = __expf(sc[lane] + mprev - mrow);
    }
    const float* wc = a.in[I_WCQK] + (size_t)l * 4 * 1024; const float* bc = a.in[I_BCQK] + (size_t)l * 1024;
    for (int i = tid; i < 64 * 128; i += NT) {
        const int ll = i >> 7, d = i & 127, chq = ZQ + h * DH + d, chk = ZK + h * DH + d;
        Q[i] = siluf_(conv4(z + chq, row0 + ll, c * CH + ll, wc + chq, 1024, bc[chq])) * 0.08838834764831845f;
        Kt[i] = siluf_(conv4(z + chk, row0 + ll, c * CH + ll, wc + chk, 1024, bc[chk]));
        Vt[i] = bf2f(z[(size_t)(row0 + ll) * ZW + ZV + h * DH + d]);
    }
    __syncthreads();
    for (int i = tid; i < 64 * 64; i += NT) {
        const int ll = i >> 6, mm = i & 63; float s = 0.f;
        if (mm <= ll) {
            for (int d = 0; d < 128; ++d) s += Q[ll * 128 + d] * Kt[mm * 128 + d];
            s *= __expf(sc[ll] - sc[mm] + sc[64 + mm] - sc[128 + ll]);
        }
        Sm[i] = s;
    }
    __syncthreads();
    const float* ct = (const float*)(a.ws + WS_CT) + (size_t)item * EROWS * 128;
    if (tid < 64) {
        float di = 0.f, dn = 0.f;
        for (int mm = 0; mm < 64; ++mm) di += Sm[tid * 64 + mm];
        for (int d = 0; d < 128; ++d) dn += Q[tid * 128 + d] * ct[128 * 128 + d];
        const float den = di + sc[192 + tid] * dn;
        sc[256 + tid] = fmaxf(fabsf(den), __expf(-sc[128 + tid]));
    }
    const int e = tid & 127, lg = tid >> 7;
    float acc[16], acc2[16];
#pragma unroll
    for (int i = 0; i < 16; ++i) { acc[i] = 0.f; acc2[i] = 0.f; }
    for (int mm = 0; mm < 64; ++mm) { const float vv = Vt[mm * 128 + e];
#pragma unroll
        for (int i = 0; i < 16; ++i) acc[i] += Sm[(lg * 16 + i) * 64 + mm] * vv; }
    for (int d = 0; d < 128; ++d) { const float cv = ct[e * 128 + d];
#pragma unroll
        for (int i = 0; i < 16; ++i) acc2[i] += Q[(lg * 16 + i) * 128 + d] * cv; }
    __syncthreads();
#pragma unroll
    for (int i = 0; i < 16; ++i) { const int ll = lg * 16 + i;
        const float hv = (acc[i] + sc[192 + ll] * acc2[i]) / sc[256 + ll];
        const float o = sigmoidf_(bf2f(z[(size_t)(row0 + ll) * ZW + ZO + h * DH + e]));
        Kt[ll * 128 + e] = hv * o; }
    __syncthreads();
    const float* gm = a.in[I_GMH] + (size_t)l * DM + h * DH;
    bf16_t* mix = (bf16_t*)(a.ws + WS_MIX);
    for (int ll = wave * 8; ll < wave * 8 + 8; ++ll) {
        const float x0 = Kt[ll * 128 + 2 * lane], x1 = Kt[ll * 128 + 2 * lane + 1];
        const float rs = rsqrtf(wave_sum(x0 * x0 + x1 * x1) * (1.f / 128.f) + EPS);
        *(unsigned*)(mix + (size_t)(row0 + ll) * D + h * DH + 2 * lane) = pk2(x0 * rs * gm[2 * lane], x1 * rs * gm[2 * lane + 1]);
    }
    __syncthreads();
}


typedef short bf16x8 __attribute__((ext_vector_type(8)));
__device__ __forceinline__ f32x4 mfma16(bf16x8 a, bf16x8 b, f32x4 c) { return __builtin_amdgcn_mfma_f32_16x16x32_bf16(a, b, c, 0, 0, 0); }

template <int IN, int AUX>
__device__ __forceinline__ void phase_rowpass_mm(unsigned char* lds, const float* xin, bf16_t* hb, const float* g, float* ssq, const float* auxW, int auxld, const float* auxB,
                                                 float* gates, unsigned char* tok_p, float* tok_g, unsigned char* h8) {
    constexpr int WLD = 1032;
    bf16_t* wl = (bf16_t*)lds; float* gl = (float*)(lds + 8 * WLD * 2);
    const int tid = otid(), lane = tid & 63, wave = tid >> 6;
    for (int i = tid; i < D * 8; i += NT) { const int k = i >> 3, c = i & 7; wl[c * WLD + k] = (bf16_t)f2bf(g[k] * auxW[(size_t)k * auxld + c]); }
    if (AUX == 2) for (int i = tid; i < D; i += NT) gl[i] = g[i];
    __syncthreads();
    const int n = lane & 15, kq = lane >> 4;
    const bf16_t* wrow = wl + (n & 7) * WLD + 8 * kq;
    if (wave < 4) for (int task = blockIdx.x + gridDim.x * wave; task < M / 16; task += gridDim.x * 4) {
        const int row = task * 16 + n;
        f32x4 accL = {0.f, 0.f, 0.f, 0.f}, accS = {0.f, 0.f, 0.f, 0.f};
        u32x4 xr[32];
        if (IN == 1) {
            const u32x4* src = (const u32x4*)(hb + (size_t)row * D + 8 * kq);
#pragma unroll
            for (int s = 0; s < 32; ++s) xr[s] = src[4 * s];
            asm volatile("" ::: "memory");
#pragma unroll
            for (int s = 0; s < 32; ++s) { const bf16x8 xf = __builtin_bit_cast(bf16x8, xr[s]); const bf16x8 wf = *(const bf16x8*)(wrow + 32 * s);
                accL = mfma16(wf, xf, accL); accS = mfma16(xf, xf, accS); }
        } else {
            const f32x4* src = (const f32x4*)(xin + (size_t)row * D + 8 * kq); u32x4* dst = (u32x4*)(hb + (size_t)row * D + 8 * kq);
#pragma unroll
            for (int hf = 0; hf < 2; ++hf) { f32x4 xf32[32]; asm volatile("" ::: "memory");
#pragma unroll
                for (int s = 0; s < 16; ++s) { xf32[2 * s] = src[8 * (16 * hf + s)]; xf32[2 * s + 1] = src[8 * (16 * hf + s) + 1]; }
                asm volatile("" ::: "memory");
#pragma unroll
                for (int s = 0; s < 16; ++s) { const f32x4 a_ = xf32[2 * s], b_ = xf32[2 * s + 1];
                    u32x4 p; p.x = pk2(a_.x, a_.y); p.y = pk2(a_.z, a_.w); p.z = pk2(b_.x, b_.y); p.w = pk2(b_.z, b_.w); dst[4 * (16 * hf + s)] = p;
                    const bf16x8 xf = __builtin_bit_cast(bf16x8, p); const bf16x8 wf = *(const bf16x8*)(wrow + 32 * (16 * hf + s));
                    accL = mfma16(wf, xf, accL); accS = mfma16(xf, xf, accS); } }
        }
        float dv = accS[0]; dv = (n & 3) == 1 ? accS[1] : dv; dv = (n & 3) == 2 ? accS[2] : dv; dv = (n & 3) == 3 ? accS[3] : dv;
        const float tot = __shfl(dv, n + 16 * (n >> 2));
        const float rstd = __builtin_amdgcn_rsqf(tot * (1.f / D) + EPS);
        if (IN == 0) { f32x4 o = {kq == 0 ? tot : 0.f, 0.f, 0.f, 0.f}; *(f32x4*)(ssq + (size_t)row * 16 + 4 * kq) = o; }
        if (AUX == 1) {
            if (kq < 2) { const f32x4 b_ = *(const f32x4*)(auxB + 4 * kq); *(f32x4*)(gates + (size_t)row * 8 + 4 * kq) = accL * rstd + b_; }
        } else {
            const f32x4 lg = accL * rstd;
            float o4[4];
#pragma unroll
            for (int r = 0; r < 4; ++r) o4[r] = __shfl(lg[r], lane + 16);
            if (kq == 0) {
                float acc[8] = {lg[0], lg[1], lg[2], lg[3], o4[0], o4[1], o4[2], o4[3]};
                int e1 = 0; float v1 = acc[0];
#pragma unroll
                for (int c = 1; c < 8; ++c) if (acc[c] > v1) { v1 = acc[c]; e1 = c; }
                int e2 = -1; float v2 = -INFINITY;
#pragma unroll
                for (int c = 0; c < 8; ++c) if (c != e1 && acc[c] > v2) { v2 = acc[c]; e2 = c; }
                const float p2 = __expf(v2 - v1), inv = 1.f / (1.f + p2);
                tok_p[row] = (unsigned char)(e1 | (e2 << 4)); tok_g[row * 2] = inv; tok_g[row * 2 + 1] = p2 * inv;
            }
            if (h8) {
                u32x2* dst = (u32x2*)(h8 + (size_t)row * D + 8 * kq);
#pragma unroll
                for (int s = 0; s < 32; ++s) { if ((s & 3) == 0) asm volatile("" ::: "memory"); const u32x4 w = xr[s]; const f32x4 g0 = *(const f32x4*)(gl + 32 * s + 8 * kq), g1 = *(const f32x4*)(gl + 32 * s + 8 * kq + 4);
                    u32x2 o; o.x = pk4_fp8(bf2f(w.x & 0xffffu) * rstd * g0.x, __uint_as_float(w.x & 0xffff0000u) * rstd * g0.y, bf2f(w.y & 0xffffu) * rstd * g0.z, __uint_as_float(w.y & 0xffff0000u) * rstd * g0.w);
                    o.y = pk4_fp8(bf2f(w.z & 0xffffu) * rstd * g1.x, __uint_as_float(w.z & 0xffff0000u) * rstd * g1.y, bf2f(w.w & 0xffffu) * rstd * g1.z, __uint_as_float(w.w & 0xffff0000u) * rstd * g1.w);
                    dst[4 * s] = o; }
            }
        }
    }
    __syncthreads();
}

__device__ __forceinline__ void conv_load11(const bf16_t* zc, int row0, int l0, bool first_chunk, unsigned (&x)[11]) {
#pragma unroll
    for (int j = 0; j < 11; ++j) { const int ll = l0 - 3 + j; x[j] = (first_chunk && ll < 0) ? 0u : *(const unsigned*)(zc + (ptrdiff_t)(row0 + ll) * ZW); }
}
struct ConvW { float w[4][2]; float b[2]; };
__device__ __forceinline__ void conv_loadw(const float* wc, const float* bc, int col, ConvW& cw) {
#pragma unroll
    for (int j = 0; j < 4; ++j) { cw.w[j][0] = wc[j * 1024 + col]; cw.w[j][1] = wc[j * 1024 + col + 1]; }
    cw.b[0] = bc[col]; cw.b[1] = bc[col + 1];
}
__device__ __forceinline__ void conv_apply(const unsigned (&x)[11], const ConvW& cw, float (&out)[8][2]) {
#pragma unroll
    for (int i = 0; i < 8; ++i) { float a0 = cw.b[0], a1 = cw.b[1];
#pragma unroll
        for (int j = 0; j < 4; ++j) { a0 += cw.w[j][0] * bf2f(x[i + j] & 0xffffu); a1 += cw.w[j][1] * __uint_as_float(x[i + j] & 0xffff0000u); }
        out[i][0] = a0; out[i][1] = a1; }
}
struct MlRegs { unsigned xk[11], v[8]; ConvW cw; float gi, gf; };
__device__ __forceinline__ void ml_load(const Args& a, int l, int item, MlRegs& R) {
    const int b = item >> 8, c = (item >> 2) & 63, h = item & 3, row0 = b * SEQ + c * CH, tid = otid(), lane = tid & 63, wave = tid >> 6;
    const bf16_t* z = (const bf16_t*)(a.ws + WS_Z);
    const float* gates = (const float*)(a.ws + WS_SMALL + SM_GATES);
    const int cp = lane, lg = wave, colk = ZK + h * DH + 2 * cp, colv = ZV + h * DH + 2 * cp;
    conv_load11(z + colk, row0, 8 * lg, c == 0, R.xk);
#pragma unroll
    for (int i = 0; i < 8; ++i) R.v[i] = *(const unsigned*)(z + (size_t)(row0 + 8 * lg + i) * ZW + colv);
    conv_loadw(a.in[I_WCQK] + (size_t)l * 4 * 1024, a.in[I_BCQK] + (size_t)l * 1024, colk, R.cw);
    R.gi = gates[(size_t)(row0 + lane) * 8 + h]; R.gf = gates[(size_t)(row0 + lane) * 8 + 4 + h];
}
__device__ __forceinline__ void ml_compute(const Args& a, unsigned char* lds, int l, int item, MlRegs& R) {
    const int tid = otid(), lane = tid & 63, wave = tid >> 6, fr = lane & 15, fq = lane >> 4;
    unsigned char* KT = lds; unsigned char* VT = lds + 18432; float* RED = (float*)(lds + 36864); float* sc = (float*)(lds + 40960);
    const int cp = lane, lg = wave;
    unsigned (&xk)[11] = R.xk; unsigned (&v)[8] = R.v; ConvW& cw = R.cw;
    if (tid < 64) {
        chunk_gates_r(sc, R.gi, R.gf, lane);
        {
            float g = sc[64 + lane] - sc[lane];
#pragma unroll
            for (int o = 1; o < 64; o <<= 1) { const float n = __shfl_up(g, o); if (lane >= o) g = fmaxf(g, n); }
            float* scal = (float*)(a.ws + WS_SCAL) + (size_t)item * 128; scal[lane] = sc[lane]; scal[64 + lane] = g; }
        const float bl = __shfl(sc[lane], 63), al = bl - sc[lane] + sc[64 + lane];
        const float amax = wave_max(al);
        sc[128 + lane] = __expf(al - amax);
        if (lane == 0) { ((float*)(a.ws + WS_SMALL + SM_BL))[item] = bl; ((float*)(a.ws + WS_SMALL + SM_AMAX))[item] = amax; }
    }
    LDS_BARRIER();
    {
        float kk[8][2];
        conv_apply(xk, cw, kk);
        float n0 = 0.f, n1 = 0.f;
#pragma unroll
        for (int i = 0; i < 8; ++i) { const float wl = sc[128 + 8 * lg + i]; kk[i][0] = siluf_(kk[i][0]) * wl; kk[i][1] = siluf_(kk[i][1]) * wl; n0 += kk[i][0]; n1 += kk[i][1]; }
        u32x4 p0, p1;
#pragma unroll
        for (int i = 0; i < 4; ++i) { p0[i] = pk2(kk[2 * i][0], kk[2 * i + 1][0]); p1[i] = pk2(kk[2 * i][1], kk[2 * i + 1][1]); }
        *(u32x4*)(KT + (2 * cp) * 144 + lg * 16) = p0; *(u32x4*)(KT + (2 * cp + 1) * 144 + lg * 16) = p1;
        RED[lg * 128 + 2 * cp] = n0; RED[lg * 128 + 2 * cp + 1] = n1;
#pragma unroll
        for (int i = 0; i < 4; ++i) { p0[i] = (v[2 * i] & 0xffffu) | (v[2 * i + 1] << 16); p1[i] = (v[2 * i] >> 16) | (v[2 * i + 1] & 0xffff0000u); }
        *(u32x4*)(VT + (2 * cp) * 144 + lg * 16) = p0; *(u32x4*)(VT + (2 * cp + 1) * 144 + lg * 16) = p1;
    }
    LDS_BARRIER();
    bf16_t* ct = (bf16_t*)(a.ws + WS_CT) + (size_t)item * 128 * 128;
    {
        const int et0 = 2 * (wave & 3), dt0 = 4 * (wave >> 2);
        bf16x8 Vf[2][2], Kf[4][2];
#pragma unroll
        for (int i = 0; i < 2; ++i)
#pragma unroll
            for (int ks = 0; ks < 2; ++ks) Vf[i][ks] = *(const bf16x8*)(VT + ((et0 + i) * 16 + fr) * 144 + (ks * 32 + 8 * fq) * 2);
#pragma unroll
        for (int j = 0; j < 4; ++j)
#pragma unroll
            for (int ks = 0; ks < 2; ++ks) Kf[j][ks] = *(const bf16x8*)(KT + ((dt0 + j) * 16 + fr) * 144 + (ks * 32 + 8 * fq) * 2);
#pragma unroll
        for (int i = 0; i < 2; ++i)
#pragma unroll
            for (int j = 0; j < 4; ++j) {
                f32x4 acc = {0.f, 0.f, 0.f, 0.f};
                acc = mfma16(Kf[j][0], Vf[i][0], acc); acc = mfma16(Kf[j][1], Vf[i][1], acc);
                u32x2 w; w.x = pk2(acc[0], acc[1]); w.y = pk2(acc[2], acc[3]);
                *(u32x2*)(ct + ((et0 + i) * 16 + fr) * 128 + (dt0 + j) * 16 + 4 * fq) = w;
            }
    }
    if (tid < 128) { float s_ = 0.f;
#pragma unroll
        for (int g = 0; g < 8; ++g) s_ += RED[g * 128 + tid];
        ((float*)(a.ws + WS_DN))[(size_t)item * 128 + tid] = s_; }
    LDS_BARRIER();
}
struct MoRegs { unsigned xq[11], xk[11], v[8]; u32x4 og[2]; float gi, gb, gg, mprev; };
__device__ __forceinline__ void mo_load(const Args& a, int l, int item, MoRegs& R) {
    const int b = item >> 8, c = (item >> 2) & 63, h = item & 3, row0 = b * SEQ + c * CH, tid = otid(), lane = tid & 63, wave = tid >> 6;
    const bf16_t* z = (const bf16_t*)(a.ws + WS_Z);
    const float* gates = (const float*)(a.ws + WS_SMALL + SM_GATES);
    const int cp = lane, lg = wave, colq = ZQ + h * DH + 2 * cp, colk = ZK + h * DH + 2 * cp, colv = ZV + h * DH + 2 * cp;
    conv_load11(z + colq, row0, 8 * lg, c == 0, R.xq);
    conv_load11(z + colk, row0, 8 * lg, c == 0, R.xk);
#pragma unroll
    for (int i = 0; i < 8; ++i) R.v[i] = *(const unsigned*)(z + (size_t)(row0 + 8 * lg + i) * ZW + colv);
#pragma unroll
    for (int j = 0; j < 2; ++j) { const int pc = tid + j * NT; R.og[j] = *(const u32x4*)(z + (size_t)(row0 + (pc >> 4)) * ZW + ZO + h * DH + (pc & 15) * 8); }
    R.gi = gates[(size_t)(row0 + lane) * 8 + h];
    { const float* scal = (const float*)(a.ws + WS_SCAL) + (size_t)item * 128; R.gb = scal[lane]; R.gg = scal[64 + lane]; }
    R.mprev = ((const float*)(a.ws + WS_SMALL + SM_MPREV))[item];
}
__device__ __forceinline__ void mo_compute(const Args& a, unsigned char* lds, int l, int item, MoRegs& R, ConvW& cwq, ConvW& cwk, int& hw) {
    const int b = item >> 8, c = (item >> 2) & 63, h = item & 3, row0 = b * SEQ + c * CH, tid = otid(), lane = tid & 63, wave = tid >> 6, fr = lane & 15, fq = lane >> 4;
    unsigned char* QN = lds; unsigned char* KN = lds + 17408; unsigned char* VT = lds + 34816; unsigned char* SP = lds + 53248;
    float* sc = (float*)(lds + 62464);
    float* HM = (float*)lds;
    const int cp = lane, lg = wave;
    unsigned (&xq)[11] = R.xq; unsigned (&xk)[11] = R.xk; unsigned (&v)[8] = R.v;
    bf16x8 Cf[4]; f32x4 dnv[4];
    { const bf16_t* ct = (const bf16_t*)(a.ws + WS_CT) + (size_t)item * 128 * 128; const float* dn = (const float*)(a.ws + WS_DN) + (size_t)item * 128;
#pragma unroll
      for (int ks = 0; ks < 4; ++ks) Cf[ks] = *(const bf16x8*)(ct + (wave * 16 + fr) * 128 + ks * 32 + 8 * fq);
#pragma unroll
      for (int j = 0; j < 4; ++j) dnv[j] = *(const f32x4*)(dn + (tid & 7) * 16 + 4 * j); }
    f32x4 gmv[2][2];
#pragma unroll
    for (int j = 0; j < 2; ++j) { const float* gp = a.in[I_GMH] + (size_t)l * DM + h * DH + ((tid + j * NT) & 15) * 8; gmv[j][0] = *(const f32x4*)gp; gmv[j][1] = *(const f32x4*)(gp + 4); }
    if (hw != h) { const float* wc = a.in[I_WCQK] + (size_t)l * 4 * 1024; const float* bc = a.in[I_BCQK] + (size_t)l * 1024;
        conv_loadw(wc, bc, ZQ + h * DH + 2 * cp, cwq); conv_loadw(wc, bc, ZK + h * DH + 2 * cp, cwk); hw = h; }
    if (tid < 64) {
        const float mprev = R.mprev, mrow = R.gb + fmaxf(mprev, R.gg);
        sc[lane] = R.gb; sc[64 + lane] = R.gi; sc[128 + lane] = mrow; sc[192 + lane] = __expf(R.gb + mprev - mrow);
    }
    {
        float qq[8][2];
        conv_apply(xq, cwq, qq);
#pragma unroll
        for (int i = 0; i < 8; ++i) *(unsigned*)(QN + (8 * lg + i) * 272 + cp * 4) = pk2(siluf_(qq[i][0]) * 0.08838834764831845f, siluf_(qq[i][1]) * 0.08838834764831845f);
        conv_apply(xk, cwk, qq);
#pragma unroll
        for (int i = 0; i < 8; ++i) *(unsigned*)(KN + (8 * lg + i) * 272 + cp * 4) = pk2(siluf_(qq[i][0]), siluf_(qq[i][1]));
        u32x4 p0, p1;
#pragma unroll
        for (int i = 0; i < 4; ++i) { p0[i] = (v[2 * i] & 0xffffu) | (v[2 * i + 1] << 16); p1[i] = (v[2 * i] >> 16) | (v[2 * i + 1] & 0xffff0000u); }
        *(u32x4*)(VT + (2 * cp) * 144 + lg * 16) = p0; *(u32x4*)(VT + (2 * cp + 1) * 144 + lg * 16) = p1;
    }
    LDS_BARRIER();
    {
        const int ll = tid >> 3, part = tid & 7; float s_ = 0.f;
#pragma unroll
        for (int j = 0; j < 4; ++j) { const u32x2 qv = *(const u32x2*)(QN + ll * 272 + (part * 16 + 4 * j) * 2);
            s_ += bf2f(qv.x & 0xffffu) * dnv[j].x + __uint_as_float(qv.x & 0xffff0000u) * dnv[j].y + bf2f(qv.y & 0xffffu) * dnv[j].z + __uint_as_float(qv.y & 0xffff0000u) * dnv[j].w; }
        s_ = sum8(s_);
        if (part == 0) sc[384 + ll] = s_;
    }
    {
        const int lt = wave & 3; const int ll = lt * 16 + fr; const float bl_ = sc[ll], mr = sc[128 + ll]; float dsum = 0.f;
#pragma unroll
        for (int mi = 0; mi < 2; ++mi) {
            const int mt = 2 * (wave >> 2) + mi; u32x2 pk = {0u, 0u};
            if (mt <= lt) {
                f32x4 acc = {0.f, 0.f, 0.f, 0.f};
#pragma unroll
                for (int ks = 0; ks < 4; ++ks) { const bf16x8 A = *(const bf16x8*)(KN + (mt * 16 + fr) * 272 + (ks * 32 + 8 * fq) * 2), B = *(const bf16x8*)(QN + (lt * 16 + fr) * 272 + (ks * 32 + 8 * fq) * 2);
                    acc = mfma16(A, B, acc); }
                float sv[4];
#pragma unroll
                for (int r = 0; r < 4; ++r) { const int mm = mt * 16 + 4 * fq + r; const float wgt = (mm <= ll) ? __expf(bl_ - sc[mm] + sc[64 + mm] - mr) : 0.f; sv[r] = acc[r] * wgt; dsum += sv[r]; }
                pk.x = pk2(sv[0], sv[1]); pk.y = pk2(sv[2], sv[3]);
            }
            *(u32x2*)(SP + ll * 144 + (mt * 16 + 4 * fq) * 2) = pk;
        }
        dsum += __shfl_xor(dsum, 16); dsum += __shfl_xor(dsum, 32);
        if (fq == 0) sc[256 + (wave >> 2) * 64 + ll] = dsum;
    }
    LDS_BARRIER();
    if (tid < 64) { const float den = sc[256 + tid] + sc[320 + tid] + sc[192 + tid] * sc[384 + tid]; sc[448 + tid] = fmaxf(fabsf(den), __expf(-sc[128 + tid])); }
    f32x4 acc1[4], acc2[4];
    {
        bf16x8 Vf[2];
#pragma unroll
        for (int ks = 0; ks < 2; ++ks) Vf[ks] = *(const bf16x8*)(VT + (wave * 16 + fr) * 144 + (ks * 32 + 8 * fq) * 2);
#pragma unroll
        for (int lt = 0; lt < 4; ++lt) {
            acc1[lt] = (f32x4){0.f, 0.f, 0.f, 0.f}; acc2[lt] = (f32x4){0.f, 0.f, 0.f, 0.f};
#pragma unroll
            for (int ks = 0; ks < 2; ++ks) acc1[lt] = mfma16(*(const bf16x8*)(SP + (lt * 16 + fr) * 144 + (ks * 32 + 8 * fq) * 2), Vf[ks], acc1[lt]);
#pragma unroll
            for (int ks = 0; ks < 4; ++ks) acc2[lt] = mfma16(*(const bf16x8*)(QN + (lt * 16 + fr) * 272 + (ks * 32 + 8 * fq) * 2), Cf[ks], acc2[lt]);
        }
    }
    LDS_BARRIER();
#pragma unroll
    for (int lt = 0; lt < 4; ++lt)
#pragma unroll
        for (int r = 0; r < 4; ++r) { const int ll = lt * 16 + 4 * fq + r;
            HM[ll * 132 + wave * 16 + fr] = (acc1[lt][r] + sc[192 + ll] * acc2[lt][r]) * frcp(sc[448 + ll]); }
    LDS_BARRIER();
    {
        bf16_t* mix = (bf16_t*)(a.ws + WS_MIX);
#pragma unroll
        for (int j = 0; j < 2; ++j) { const int pc = tid + j * NT, ll = pc >> 4, q16 = pc & 15;
            const f32x4 h0 = *(const f32x4*)(HM + ll * 132 + q16 * 8), h1 = *(const f32x4*)(HM + ll * 132 + q16 * 8 + 4);
            f32x4 o0, o1; unpack8(R.og[j], o0, o1);
            f32x4 g0, g1;
#pragma unroll
            for (int q = 0; q < 4; ++q) { g0[q] = h0[q] * sigmoidf_(o0[q]); g1[q] = h1[q] * sigmoidf_(o1[q]); }
            const float rs = __builtin_amdgcn_rsqf(sum16(dot8(g0, g1)) * (1.f / 128.f) + EPS);
            *(u32x4*)(mix + (size_t)(row0 + ll) * D + h * DH + q16 * 8) = pack8(g0 * rs * gmv[j][0], g1 * rs * gmv[j][1]); }
    }
    LDS_BARRIER();
}

template <int MODE>
__device__ __forceinline__ void rglru_item(const Args& a, unsigned char* lds, int l, int item) {
    const int b = item >> 6, c = item & 63, row0 = b * SEQ + c * CH, ch = otid(), lane = ch & 63, nb = ch >> 6;
    float* xs = (float*)lds + nb * 64 * 64;
    const bf16_t* z = (const bf16_t*)(a.ws + WS_Z);
    const float* wcr = a.in[I_WCR] + (size_t)l * 4 * DR; const float bcr = a.in[I_BCR][l * DR + ch];
    const float w0 = wcr[ch], w1 = wcr[DR + ch], w2 = wcr[2 * DR + ch], w3 = wcr[3 * DR + ch];
    const bf16_t* zc = z + ZXR + ch;
    float xm3 = 0.f, xm2 = 0.f, xm1 = 0.f;
    { const int s0 = c * CH; if (s0 >= 3) { xm3 = bf2f(zc[(size_t)(row0 - 3) * ZW]); xm2 = bf2f(zc[(size_t)(row0 - 2) * ZW]); xm1 = bf2f(zc[(size_t)(row0 - 1) * ZW]); } }
#pragma unroll 4
    for (int t = 0; t < 64; ++t) { const float x0 = bf2f(zc[(size_t)(row0 + t) * ZW]);
        xs[t * 64 + lane] = bcr + w0 * xm3 + w1 * xm2 + w2 * xm1 + w3 * x0; xm3 = xm2; xm2 = xm1; xm1 = x0; }
    unsigned wa[32], wx[32];
    const float* wra = a.in[I_WRA] + ((size_t)(l * NBR + nb) * 64) * 64 + lane; const float* wri = a.in[I_WRI] + ((size_t)(l * NBR + nb) * 64) * 64 + lane;
#pragma unroll
    for (int d = 0; d < 32; ++d) { wa[d] = pk2(wra[(2 * d) * 64], wra[(2 * d + 1) * 64]); wx[d] = pk2(wri[(2 * d) * 64], wri[(2 * d + 1) * 64]); }
    const float ba = a.in[I_BRA][l * DR + ch], bx = a.in[I_BRI][l * DR + ch];
    const float lam = a.in[I_LAM][l * DR + ch];
    const float sp = fmaxf(-lam, 0.f) + log1pf(__expf(-fabsf(lam)));
    float hst = 0.f, ap = 1.f;
    if (MODE == 1) hst = ((const float*)(a.ws + WS_SMALL + SM_RGP))[(size_t)item * DR + ch];
    const float gr = a.in[I_GR][l * DR + ch];
    bf16_t* mix = (bf16_t*)(a.ws + WS_MIX);
    __syncthreads();
#pragma unroll 1
    for (int t = 0; t < 64; ++t) {
        float ra = ba, ia = bx;
#pragma unroll
        for (int d4 = 0; d4 < 16; ++d4) { const f32x4 xv = *(const f32x4*)(xs + t * 64 + 4 * d4);
#pragma unroll
            for (int q = 0; q < 2; ++q) { const unsigned pa = wa[2 * d4 + q], px = wx[2 * d4 + q];
                ra += xv[2 * q] * __uint_as_float(pa << 16) + xv[2 * q + 1] * __uint_as_float(pa & 0xffff0000u);
                ia += xv[2 * q] * __uint_as_float(px << 16) + xv[2 * q + 1] * __uint_as_float(px & 0xffff0000u); } }
        const float xo = xs[t * 64 + lane];
        const float r = sigmoidf_(ra), ig = sigmoidf_(ia), la = -8.f * r * sp, av = __expf(la);
        const float uu = sqrtf(-expm1f(2.f * la)) * (ig * xo);
        hst = av * hst + uu; ap *= av;
        if (MODE == 1) {
            const float y = bf2f(z[(size_t)(row0 + t) * ZW + ZYR + ch]);
            const float o = hst * gelu_tanh(y);
            const float rs = rsqrtf(wave_sum(o * o) * (1.f / 64.f) + EPS);
            mix[(size_t)(row0 + t) * D + DM + ch] = (bf16_t)f2bf(o * rs * gr);
        }
    }
    if (MODE == 0) { ((float*)(a.ws + WS_SMALL + SM_RGA))[(size_t)item * DR + ch] = ap; ((float*)(a.ws + WS_SMALL + SM_RGH))[(size_t)item * DR + ch] = hst; }
    __syncthreads();
}

template <int MODE>
__device__ __forceinline__ void rglru_fast(const Args& a, unsigned char* lds, int l, int item) {
    const int b = item >> 6, c = item & 63, row0 = b * SEQ + c * CH, ch = otid(), lane = ch & 63, nb = ch >> 6, fr = lane & 15, fq = lane >> 4;
    unsigned char* XA = lds + nb * 9216;
    float* GS = (float*)(lds + 73728 + nb * 8448);
    const bf16_t* z = (const bf16_t*)(a.ws + WS_Z);
    unsigned ypk[32];
    {
        const float* wcr = a.in[I_WCR] + (size_t)l * 4 * DR; const float bcr = a.in[I_BCR][l * DR + ch];
        const float w0 = wcr[ch], w1 = wcr[DR + ch], w2 = wcr[2 * DR + ch], w3 = wcr[3 * DR + ch];
        const bf16_t* zc = z + ZXR + ch;
        bf16_t xin[67];
#pragma unroll
        for (int t = 0; t < 67; ++t) xin[t] = (c == 0 && t < 3) ? (bf16_t)0 : zc[(ptrdiff_t)(row0 + t - 3) * ZW];
        if (MODE == 1) {
            bf16_t yb[64];
#pragma unroll
            for (int t = 0; t < 64; ++t) yb[t] = z[(size_t)(row0 + t) * ZW + ZYR + ch];
#pragma unroll
            for (int t = 0; t < 32; ++t) ypk[t] = (unsigned)yb[2 * t] | ((unsigned)yb[2 * t + 1] << 16);
        }
#pragma unroll
        for (int t = 0; t < 64; ++t)
            *(bf16_t*)(XA + t * 144 + lane * 2) = (bf16_t)f2bf(bcr + w0 * bf2f(xin[t]) + w1 * bf2f(xin[t + 1]) + w2 * bf2f(xin[t + 2]) + w3 * bf2f(xin[t + 3]));
    }
    bf16x8 Bf[8][2];
    { const bf16_t* wt = (const bf16_t*)(a.ws + WS_SMALL + SM_RGW) + (size_t)((l * NBR + nb) * 2) * 64 * 64;
#pragma unroll
        for (int ct = 0; ct < 8; ++ct)
#pragma unroll
            for (int ks = 0; ks < 2; ++ks) Bf[ct][ks] = *(const bf16x8*)(wt + (size_t)((ct >> 2) * 64 + (ct & 3) * 16 + fr) * 64 + ks * 32 + 8 * fq); }
    const float ba = a.in[I_BRA][l * DR + ch], bx = a.in[I_BRI][l * DR + ch];
    const float lam = a.in[I_LAM][l * DR + ch];
    const float sp8 = -8.f * (fmaxf(-lam, 0.f) + log1pf(__expf(-fabsf(lam))));
    float hst = 0.f, ap = 1.f;
    if (MODE == 1) hst = ((const float*)(a.ws + WS_SMALL + SM_RGP))[(size_t)item * DR + ch];
    const float gr = a.in[I_GR][l * DR + ch];
    bf16_t* mix = (bf16_t*)(a.ws + WS_MIX);
    WAVE_LDS_SYNC();
#pragma unroll
    for (int rt = 0; rt < 4; ++rt) {
        bf16x8 Af[2];
#pragma unroll
        for (int ks = 0; ks < 2; ++ks) Af[ks] = *(const bf16x8*)(XA + (rt * 16 + fr) * 144 + (ks * 32 + 8 * fq) * 2);
#pragma unroll
        for (int ct = 0; ct < 8; ++ct) {
            f32x4 acc = {0.f, 0.f, 0.f, 0.f};
            acc = mfma16(Af[0], Bf[ct][0], acc); acc = mfma16(Af[1], Bf[ct][1], acc);
#pragma unroll
            for (int r = 0; r < 4; ++r) GS[(4 * fq + r) * 132 + (ct >> 2) * 64 + (ct & 3) * 16 + fr] = acc[r];
        }
        WAVE_LDS_SYNC();
        {
            float ra[16], ia[16], xo[16], ov_[16], apv_[16];
#pragma unroll
            for (int tt = 0; tt < 16; ++tt) { ra[tt] = GS[tt * 132 + lane]; ia[tt] = GS[tt * 132 + 64 + lane]; xo[tt] = bf2f(*(const bf16_t*)(XA + (rt * 16 + tt) * 144 + lane * 2)); }
#pragma unroll
            for (int tt = 0; tt < 16; ++tt) {
                const float r = sigmoidf_(ra[tt] + ba), ig = sigmoidf_(ia[tt] + bx), la = sp8 * r, av = __expf(la);
                const float uu = __builtin_amdgcn_sqrtf(fmaxf(fmaf(-av, av, 1.f), 0.f)) * (ig * xo[tt]);
                hst = av * hst + uu; ap *= av;
                ov_[tt] = hst; apv_[tt] = ap;
            }
            if (MODE == 0) {
                unsigned char* GB = (unsigned char*)GS;
#pragma unroll
                for (int tt = 0; tt < 16; ++tt) { *(bf16_t*)(GB + tt * 128 + lane * 2) = (bf16_t)f2bf(ov_[tt]); *(bf16_t*)(GB + 2048 + tt * 128 + lane * 2) = (bf16_t)f2bf(apv_[tt]); }
                WAVE_LDS_SYNC();
                bf16_t* hlp = (bf16_t*)a.out; bf16_t* ppp = hlp + (size_t)M * DR;
#pragma unroll
                for (int j = 0; j < 2; ++j) { const int p = lane + 64 * j; const size_t off = (size_t)(row0 + rt * 16 + (p >> 3)) * DR + nb * 64 + (p & 7) * 8;
                    *(u32x4*)(hlp + off) = *(const u32x4*)(GB + p * 16); *(u32x4*)(ppp + off) = *(const u32x4*)(GB + 2048 + p * 16); }
            }
            if (MODE == 1) {
#pragma unroll
                for (int tt = 0; tt < 16; ++tt) *(bf16_t*)(XA + (rt * 16 + tt) * 144 + lane * 2) = (bf16_t)f2bf(ov_[tt] * gelu_tanh((tt & 1) ? __uint_as_float(ypk[rt * 8 + (tt >> 1)] & 0xffff0000u) : bf2f(ypk[rt * 8 + (tt >> 1)] & 0xffffu)));
            }
        }
        WAVE_LDS_SYNC();
    }
    if (MODE == 1) {
        float ss = 0.f;
#pragma unroll
        for (int j = 0; j < 8; ++j) { const u32x4 v = *(const u32x4*)(XA + lane * 144 + j * 16);
#pragma unroll
            for (int q = 0; q < 4; ++q) { const float lo = bf2f(v[q] & 0xffffu), hi = __uint_as_float(v[q] & 0xffff0000u); ss += lo * lo + hi * hi; } }
        const float rs = rsqrtf(ss * (1.f / 64.f) + EPS) ;
#pragma unroll
        for (int t0 = 0; t0 < 64; t0 += 16) { float ovv[16];
#pragma unroll
            for (int tt = 0; tt < 16; ++tt) ovv[tt] = bf2f(*(const bf16_t*)(XA + (t0 + tt) * 144 + lane * 2));
#pragma unroll
            for (int tt = 0; tt < 16; ++tt) { const float rst = __int_as_float(__builtin_amdgcn_readlane(__float_as_int(rs), t0 + tt));
                *(bf16_t*)(XA + (t0 + tt) * 144 + lane * 2) = (bf16_t)f2bf(ovv[tt] * rst * gr); } }
        WAVE_LDS_SYNC();
#pragma unroll
        for (int j = 0; j < 8; ++j) { const int t = j * 8 + (lane >> 3), q16 = lane & 7;
            *(u32x4*)(mix + (size_t)(row0 + t) * D + DM + nb * 64 + q16 * 8) = *(const u32x4*)(XA + t * 144 + q16 * 16); }
    }
    if (MODE == 0) { ((float*)(a.ws + WS_SMALL + SM_RGA))[(size_t)item * DR + ch] = ap; ((float*)(a.ws + WS_SMALL + SM_RGH))[(size_t)item * DR + ch] = hst; }
    LDS_BARRIER();
}
__device__ __forceinline__ void rglru_out(const Args& a, int l, int item) {
    const int b = item >> 6, c = item & 63, row0 = b * SEQ + c * CH, tid = otid(), lane = tid & 63, nb = tid >> 6, ch0 = nb * 64 + (lane & 7) * 8, t0 = lane >> 3;
    const bf16_t* z = (const bf16_t*)(a.ws + WS_Z);
    const bf16_t* hlp = (const bf16_t*)a.out; const bf16_t* ppp = hlp + (size_t)M * DR;
    bf16_t* mix = (bf16_t*)(a.ws + WS_MIX);
    u32x4 hv[8], pv[8], yv[8];
#pragma unroll
    for (int j = 0; j < 8; ++j) { const size_t r = (size_t)(row0 + j * 8 + t0);
        hv[j] = *(const u32x4*)(hlp + r * DR + ch0); pv[j] = *(const u32x4*)(ppp + r * DR + ch0); yv[j] = *(const u32x4*)(z + r * ZW + ZYR + ch0); }
    const float* cp = (const float*)(a.ws + WS_SMALL + SM_RGP) + (size_t)item * DR + ch0; const f32x4 c0 = *(const f32x4*)cp, c1 = *(const f32x4*)(cp + 4);
    const float* gp = a.in[I_GR] + l * DR + ch0; const f32x4 g0 = *(const f32x4*)gp, g1 = *(const f32x4*)(gp + 4);
#pragma unroll
    for (int j = 0; j < 8; ++j) {
        f32x4 h0, h1, p0, p1, y0, y1; unpack8(hv[j], h0, h1); unpack8(pv[j], p0, p1); unpack8(yv[j], y0, y1);
        f32x4 o0, o1;
#pragma unroll
        for (int q = 0; q < 4; ++q) { o0[q] = (h0[q] + p0[q] * c0[q]) * gelu_tanh(y0[q]); o1[q] = (h1[q] + p1[q] * c1[q]) * gelu_tanh(y1[q]); }
        const float rs = __builtin_amdgcn_rsqf(sum8(dot8(o0, o1)) * (1.f / 64.f) + EPS);
        *(u32x4*)(mix + (size_t)(row0 + j * 8 + t0) * D + DM + ch0) = pack8(o0 * rs * g0, o1 * rs * g1);
    }
}
__device__ __forceinline__ void rglru_scan(const Args& a, int G) {
    const int tid = otid();
    for (int i = blockIdx.x * 8 + (tid & 7); i < NBATCH * DR && tid < 8; i += G * 8) {
        const int b = i / DR, ch = i % DR;
        const float* A_ = (const float*)(a.ws + WS_SMALL + SM_RGA) + (size_t)(b * NC) * DR + ch; const float* H_ = (const float*)(a.ws + WS_SMALL + SM_RGH) + (size_t)(b * NC) * DR + ch;
        float* P_ = (float*)(a.ws + WS_SMALL + SM_RGP) + (size_t)(b * NC) * DR + ch;
        float hs = 0.f;
#pragma unroll 1
        for (int c0 = 0; c0 < NC; c0 += 16) {
            float av[16], hv[16];
#pragma unroll
            for (int j = 0; j < 16; ++j) { av[j] = A_[(c0 + j) * DR]; hv[j] = H_[(c0 + j) * DR]; }
#pragma unroll
            for (int j = 0; j < 16; ++j) { P_[(c0 + j) * DR] = hs; hs = av[j] * hs + hv[j]; }
        }
    }
}

__device__ __forceinline__ void phase_route(const Args& a, unsigned char* lds) {
    unsigned* wtot = (unsigned*)lds;
    int* pre = (int*)(lds + 256);
    int* tot = pre + 8;
    int* ce = tot + 16;
    unsigned* pref = (unsigned*)(lds + 2048);
    const int tid = otid(), lane = tid & 63, wave = tid >> 6, G = gridDim.x;
    const unsigned char* tok_p = (const unsigned char*)(a.ws + WS_SMALL + SM_TOKP); const float* tok_g = (const float*)(a.ws + WS_SMALL + SM_TOKG);
    int* row_tok = (int*)(a.ws + WS_SMALL + SM_ROWTOK); float* row_gate = (float*)(a.ws + WS_SMALL + SM_ROWGATE); int* tile_e = (int*)(a.ws + WS_SMALL + SM_TILEE);
    if (tid < 256) {
        unsigned long long hh = 0ull;
#pragma unroll
        for (int j = 0; j < 4; ++j) { const u32x4 v = ((const u32x4*)(tok_p + tid * 64))[j];
#pragma unroll
            for (int q = 0; q < 4; ++q)
#pragma unroll
                for (int bb = 0; bb < 4; ++bb) { const unsigned by = (v[q] >> (8 * bb)) & 0xffu; hh += (1ull << (8 * (by & 15u))) + (1ull << (8 * (by >> 4))); } }
        unsigned w[4];
#pragma unroll
        for (int i = 0; i < 4; ++i) { const unsigned two = (unsigned)(hh >> (16 * i)) & 0xffffu; w[i] = (two & 0xffu) | ((two >> 8) << 16); }
        unsigned inc[4];
#pragma unroll
        for (int i = 0; i < 4; ++i) { unsigned x = w[i];
#pragma unroll
            for (int o = 1; o < 64; o <<= 1) { const unsigned n = __shfl_up(x, o); if (lane >= o) x += n; }
            inc[i] = x; }
        if (lane == 63) {
#pragma unroll
            for (int i = 0; i < 4; ++i) wtot[wave * 4 + i] = inc[i]; }
        __builtin_amdgcn_s_waitcnt(0);
        __builtin_amdgcn_s_barrier();
#pragma unroll
        for (int i = 0; i < 4; ++i) { unsigned base = 0u;
            for (int ww = 0; ww < wave; ++ww) base += wtot[ww * 4 + i];
            pref[tid * 4 + i] = base + inc[i] - w[i];
            if (tid == 255) { const unsigned t2 = base + inc[i]; tot[2 * i] = (int)(t2 & 0xffffu); tot[2 * i + 1] = (int)(t2 >> 16); } }
    } else {
        __builtin_amdgcn_s_barrier();
    }
    __syncthreads();
    if (tid == 0) { int s_ = 0; for (int e = 0; e < 8; ++e) { tot[8 + e] = s_; s_ += (tot[e] + 255) & ~255; }
        if (blockIdx.x == 0) { int t = 0; for (int e = 0; e < 8; ++e) { const int n = (tot[e] + 255) >> 8; for (int j = 0; j < n; ++j) tile_e[t++] = e; tile_e[256 + e] = t; } tile_e[255] = t; } }
    __syncthreads();
    for (int ck = blockIdx.x; ck < 256; ck += G) {
        if (tid < 128) { const unsigned by = tok_p[ck * 64 + (tid >> 1)]; ce[tid] = (tid & 1) ? (int)(by >> 4) : (int)(by & 15u); }
        __syncthreads();
        if (tid < 128) { const int e = ce[tid];
            int rank = 0, w0cnt = 0;
#pragma unroll
            for (int q = 0; q < 8; ++q) { const unsigned long long mk = __ballot(e == q); if (e == q) rank = __popcll(mk & ((1ull << lane) - 1ull)); if (wave == 0 && lane == 0) ce[128 + q] = __popcll(mk); }
            __builtin_amdgcn_s_waitcnt(0);
            asm volatile("s_barrier" ::: "memory");
            if (wave == 1) rank += ce[128 + e];
            (void)w0cnt;
            const unsigned pw = pref[ck * 4 + (e >> 1)]; const int pr = (int)((e & 1) ? (pw >> 16) : (pw & 0xffffu));
            const int dest = tot[8 + e] + pr + rank;
            row_tok[dest] = ck * 64 + (tid >> 1); row_gate[dest] = tok_g[ck * 128 + tid]; ((int*)(a.ws + WS_SMALL + SM_ROWSLOT))[dest] = tid & 1; }
        else { asm volatile("s_barrier" ::: "memory"); }
        __syncthreads();
    }
}

#ifndef GEMM
#define GEMM gemm_fast
#endif
__global__ void __launch_bounds__(NT, 2) mk_fwd(Args a0) {
    extern __shared__ __attribute__((aligned(16))) unsigned char lds[];
    const int G = gridDim.x, bid = blockIdx.x, ph_lo = a0.ph_lo, ph_hi = a0.ph_hi;
    volatile LAS unsigned* xst = (volatile LAS unsigned*)(lds + LDS_BYTES - 64);
    if (threadIdx.x < 2) xst[threadIdx.x] = 0u;
    __syncthreads();
    const XcdBarrier xb = xcd_barrier_post((unsigned*)(a0.ws + WS_SMALL + SM_BAR), xst);
    int ph = 0;
#ifndef PROBE_CAT
#define PROBE_CAT 0
#define PROBE_N 1
#endif
#define PHASE_BEGIN(cat) if (ph >= ph_lo && ph < ph_hi) { for (int rep_ = 0; rep_ < ((cat) == PROBE_CAT ? PROBE_N : 1); ++rep_) { const bool lastrep = (rep_ + 1 == ((cat) == PROBE_CAT ? PROBE_N : 1)); (void)lastrep; const Args& a = *(const Args*)okarg(); unsigned char* const ws = a.ws; \
    bf16_t* const hn = (bf16_t*)(ws + WS_HN); bf16_t* const z = (bf16_t*)(ws + WS_Z); bf16_t* const mix = (bf16_t*)(ws + WS_MIX); bf16_t* const hid = (bf16_t*)(ws + WS_HID); \
    float* const gates = (float*)(ws + WS_SMALL + SM_GATES); int* const tok_e = (int*)(ws + WS_SMALL + SM_TOKP); float* const tok_g = (float*)(ws + WS_SMALL + SM_TOKG); \
    const int* const row_tok = (const int*)(ws + WS_SMALL + SM_ROWTOK); const float* const row_gate = (const float*)(ws + WS_SMALL + SM_ROWGATE); const int* const tile_e = (const int*)(ws + WS_SMALL + SM_TILEE); \
    (void)hn; (void)z; (void)mix; (void)hid; (void)gates; (void)tok_e; (void)tok_g; (void)row_tok; (void)row_gate; (void)tile_e;
#define PHASE_END(dosync) } for (int rep_ = 0; rep_ < (PROBE_CAT == 6 ? PROBE_N : 1); ++rep_) if ((dosync) && ph + 1 < ph_hi) { xcd_barrier(xb); } } ++ph;

    PHASE_BEGIN(1) phase_prologue(a, lds); __syncthreads();
        phase_rowpass_mm<0, 1>(lds, a.in[I_X], hn, a.in[I_GMIX], (float*)(ws + WS_SSQ), a.in[I_WIN] + 2048, DIN, a.in[I_BIN] + 2048, gates, nullptr, nullptr, nullptr); PHASE_END(true)
    { constexpr int l = 0;
#define LAYER_PTRS bf16_t* const hb = (bf16_t*)(ws + (l ? WS_H1 : WS_HN)); bf16_t* const hbo = (bf16_t*)(ws + (l ? WS_HN : WS_H1)); float* const ssq = (float*)(ws + WS_SSQ + l * SSQ_STRIDE); float* const ssqo = (float*)(ws + WS_SSQ + (1 - l) * SSQ_STRIDE); (void)hb; (void)hbo; (void)ssq; (void)ssqo;
        PHASE_BEGIN(3) LAYER_PTRS { if (l == 1) phase_rowpass_mm<1, 1>(lds, nullptr, hb, a.in[I_GMIX] + l * D, nullptr, a.in[I_WIN] + (size_t)l * D * DIN + 2048, DIN, a.in[I_BIN] + l * DIN + 2048, gates, nullptr, nullptr, nullptr);
            GridOrder S{M / 256, ZW / 256, G, bid}; EpiZ E{z, a.in[I_BIN] + l * DIN, ssq};
            GEMM(lds, hb, (const bf16_t*)(ws + (l ? WS_W_IN1 : WS_W_IN0)), D, S, E); } PHASE_END(true)
        PHASE_BEGIN(4) LAYER_PTRS { MlRegs cur, nxt; int it = bid; if (it < 1024) ml_load(a, l, it, cur); nxt = cur;
            for (; it < 1024; it += G) { if (it + G < 1024) ml_load(a, l, it + G, nxt); ml_compute(a, lds, l, it, cur); cur = nxt; }
            for (; it < 1280; it += G) rglru_fast<0>(a, lds, l, it - 1024); } PHASE_END(true)
        PHASE_BEGIN(0) LAYER_PTRS mlstm_scan(a, G); rglru_scan(a, G); PHASE_END(true)
        PHASE_BEGIN(5) LAYER_PTRS { MoRegs cur, nxt; ConvW cwq, cwk; int hw = -1; int it = bid; if (it < 1024) mo_load(a, l, it, cur); nxt = cur;
            for (; it < 1024; it += G) { if (it + G < 1024) mo_load(a, l, it + G, nxt); mo_compute(a, lds, l, it, cur, cwq, cwk, hw); cur = nxt; }
            for (; it < 1280; it += G) rglru_out(a, l, it - 1024); } PHASE_END(true)
        PHASE_BEGIN(0) LAYER_PTRS { GridOrder S{M / 256, D / 256, G, bid}; EpiHres<l == 0> E{l == 0 ? a.in[I_X] : nullptr, hb, ssq};
            GEMM(lds, mix, (const bf16_t*)(ws + (l ? WS_W_OUT1 : WS_W_OUT0)), D, S, E); } PHASE_END(true)
        if (l == 0) {
            PHASE_BEGIN(3) LAYER_PTRS { GridOrder S{M / 256, 2 * DFF / 256, G, bid}; EpiSwiglu E{hid, ssq, nullptr};
                GEMM(lds, hb, (const bf16_t*)(ws + WS_W_FFGU), D, S, E);
                { constexpr int nun = (M / 256) * (2 * DFF / 256); const int first = nun % G;
                  TailOrder S2{M / 256, D / 256, G, bid, first}; EpiStoreBf16 E2{(bf16_t*)(ws + WS_PP0)};
                  GEMM(lds, (const bf16_t*)(ws + WS_PB0), (const bf16_t*)(ws + WS_W_PP0), DPLE, S2, E2); } } PHASE_END(true)
            PHASE_BEGIN(0) LAYER_PTRS { GridOrder S{M / 256, D / 256, G, bid}; EpiHres<false> E{nullptr, hb, ssq};
                GEMM(lds, hid, (const bf16_t*)(ws + WS_W_FFD), DFF, S, E); } PHASE_END(true)
        } else {
            PHASE_BEGIN(2) LAYER_PTRS phase_rowpass_mm<1, 2>(lds, nullptr, hb, a.in[I_GFFN] + l * D, nullptr, a.in[I_WROUTER], 8, nullptr, nullptr, (unsigned char*)tok_e, tok_g, ws + WS_HN8); PHASE_END(true)
            PHASE_BEGIN(12) LAYER_PTRS phase_route(a, lds); PHASE_END(true)
            PHASE_BEGIN(3) LAYER_PTRS { MoeOrder<true> S{tile_e[255], 2 * DFF / 256, G, bid, row_tok, (size_t)5632 * D}; S.init(tile_e); EpiSwiglu8 E{ws + WS_HID, 1.f / 32.f};
                gemm_fast<true>(lds, (const bf16_t*)(ws + WS_HN8), (const bf16_t*)(ws + WS_W_EGU), D, S, E); } PHASE_END(true)
            PHASE_BEGIN(0) LAYER_PTRS { MoeOrder<false> S{tile_e[255], D / 256, G, bid, nullptr, (size_t)D * DFF}; S.init(tile_e); EpiMoeDown E{hb, (bf16_t*)a.out, row_tok, (const int*)(ws + WS_SMALL + SM_ROWSLOT), row_gate, 1.f / 32.f};
                gemm_fast<true>(lds, (const bf16_t*)(ws + WS_HID), (const bf16_t*)(ws + WS_W_ED), DFF, S, E);
                { const int nun = tile_e[255] * (D / 256); const int first = nun > 2 * G ? nun - 2 * G : 0;
                  TailOrder S2{M / 256, D / 256, G, bid, first < G ? first : 0}; EpiStoreBf16 E2{(bf16_t*)a.out + (size_t)M * D};
                  GEMM(lds, (const bf16_t*)(ws + WS_PB1), (const bf16_t*)(ws + WS_W_PP1), DPLE, S2, E2); } } PHASE_END(true)
            PHASE_BEGIN(0) LAYER_PTRS phase_rowpass<1, 0, 1, true>(lds, nullptr, hb, (const bf16_t*)a.out, nullptr, ssq, nullptr, 0, nullptr, nullptr, nullptr, nullptr, nullptr); PHASE_END(true)
        }
        PHASE_BEGIN(10) LAYER_PTRS { GridOrder S{M / 256, D / 256, G, bid};
            EpiPle E{hb, hbo, l == 0 ? (const bf16_t*)(ws + WS_PP0) : (const bf16_t*)a.out + (size_t)M * D, ssqo, ssq}; GEMM(lds, hb, (const bf16_t*)(ws + WS_W_PG) + (size_t)l * D * D, D, S, E);
            if (l == 0 && bid == 0) { for (int i = otid(); i < D / 2; i += NT) ((unsigned*)(ws + WS_H1 + (size_t)M * D * 2))[i] = 0u; } } PHASE_END(true)
    }
    { constexpr int l = 1;
        PHASE_BEGIN(3) LAYER_PTRS { if (l == 1) phase_rowpass_mm<1, 1>(lds, nullptr, hb, a.in[I_GMIX] + l * D, nullptr, a.in[I_WIN] + (size_t)l * D * DIN + 2048, DIN, a.in[I_BIN] + l * DIN + 2048, gates, nullptr, nullptr, nullptr);
            GridOrder S{M / 256, ZW / 256, G, bid}; EpiZ E{z, a.in[I_BIN] + l * DIN, ssq};
            GEMM(lds, hb, (const bf16_t*)(ws + (l ? WS_W_IN1 : WS_W_IN0)), D, S, E); } PHASE_END(true)
        PHASE_BEGIN(4) LAYER_PTRS { MlRegs cur, nxt; int it = bid; if (it < 1024) ml_load(a, l, it, cur); nxt = cur;
            for (; it < 1024; it += G) { if (it + G < 1024) ml_load(a, l, it + G, nxt); ml_compute(a, lds, l, it, cur); cur = nxt; }
            for (; it < 1280; it += G) rglru_fast<0>(a, lds, l, it - 1024); } PHASE_END(true)
        PHASE_BEGIN(0) LAYER_PTRS mlstm_scan(a, G); rglru_scan(a, G); PHASE_END(true)
        PHASE_BEGIN(5) LAYER_PTRS { MoRegs cur, nxt; ConvW cwq, cwk; int hw = -1; int it = bid; if (it < 1024) mo_load(a, l, it, cur); nxt = cur;
            for (; it < 1024; it += G) { if (it + G < 1024) mo_load(a, l, it + G, nxt); mo_compute(a, lds, l, it, cur, cwq, cwk, hw); cur = nxt; }
            for (; it < 1280; it += G) rglru_out(a, l, it - 1024); } PHASE_END(true)
        PHASE_BEGIN(0) LAYER_PTRS { GridOrder S{M / 256, D / 256, G, bid}; EpiHres<l == 0> E{l == 0 ? a.in[I_X] : nullptr, hb, ssq};
            GEMM(lds, mix, (const bf16_t*)(ws + (l ? WS_W_OUT1 : WS_W_OUT0)), D, S, E); } PHASE_END(true)
        if (l == 0) {
            PHASE_BEGIN(3) LAYER_PTRS { GridOrder S{M / 256, 2 * DFF / 256, G, bid}; EpiSwiglu E{hid, ssq, nullptr};
                GEMM(lds, hb, (const bf16_t*)(ws + WS_W_FFGU), D, S, E);
                { constexpr int nun = (M / 256) * (2 * DFF / 256); const int first = nun % G;
                  TailOrder S2{M / 256, D / 256, G, bid, first}; EpiStoreBf16 E2{(bf16_t*)(ws + WS_PP0)};
                  GEMM(lds, (const bf16_t*)(ws + WS_PB0), (const bf16_t*)(ws + WS_W_PP0), DPLE, S2, E2); } } PHASE_END(true)
            PHASE_BEGIN(0) LAYER_PTRS { GridOrder S{M / 256, D / 256, G, bid}; EpiHres<false> E{nullptr, hb, ssq};
                GEMM(lds, hid, (const bf16_t*)(ws + WS_W_FFD), DFF, S, E); } PHASE_END(true)
        } else {
            PHASE_BEGIN(2) LAYER_PTRS phase_rowpass_mm<1, 2>(lds, nullptr, hb, a.in[I_GFFN] + l * D, nullptr, a.in[I_WROUTER], 8, nullptr, nullptr, (unsigned char*)tok_e, tok_g, ws + WS_HN8); PHASE_END(true)
            PHASE_BEGIN(12) LAYER_PTRS phase_route(a, lds); PHASE_END(true)
            PHASE_BEGIN(3) LAYER_PTRS { MoeOrder<true> S{tile_e[255], 2 * DFF / 256, G, bid, row_tok, (size_t)5632 * D}; S.init(tile_e); EpiSwiglu8 E{ws + WS_HID, 1.f / 32.f};
                gemm_fast<true>(lds, (const bf16_t*)(ws + WS_HN8), (const bf16_t*)(ws + WS_W_EGU), D, S, E); } PHASE_END(true)
            PHASE_BEGIN(0) LAYER_PTRS { MoeOrder<false> S{tile_e[255], D / 256, G, bid, nullptr, (size_t)D * DFF}; S.init(tile_e); EpiMoeDown E{hb, (bf16_t*)a.out, row_tok, (const int*)(ws + WS_SMALL + SM_ROWSLOT), row_gate, 1.f / 32.f};
                gemm_fast<true>(lds, (const bf16_t*)(ws + WS_HID), (const bf16_t*)(ws + WS_W_ED), DFF, S, E);
                { const int nun = tile_e[255] * (D / 256); const int first = nun > 2 * G ? nun - 2 * G : 0;
                  TailOrder S2{M / 256, D / 256, G, bid, first < G ? first : 0}; EpiStoreBf16 E2{(bf16_t*)a.out + (size_t)M * D};
                  GEMM(lds, (const bf16_t*)(ws + WS_PB1), (const bf16_t*)(ws + WS_W_PP1), DPLE, S2, E2); } } PHASE_END(true)
            PHASE_BEGIN(0) LAYER_PTRS phase_rowpass<1, 0, 1, true>(lds, nullptr, hb, (const bf16_t*)a.out, nullptr, ssq, nullptr, 0, nullptr, nullptr, nullptr, nullptr, nullptr); PHASE_END(true)
        }
        PHASE_BEGIN(10) LAYER_PTRS { GridOrder S{M / 256, D / 256, G, bid};
            EpiPle E{hb, hbo, l == 0 ? (const bf16_t*)(ws + WS_PP0) : (const bf16_t*)a.out + (size_t)M * D, ssqo, ssq}; GEMM(lds, hb, (const bf16_t*)(ws + WS_W_PG) + (size_t)l * D * D, D, S, E);
            if (l == 0 && bid == 0) { for (int i = otid(); i < D / 2; i += NT) ((unsigned*)(ws + WS_H1 + (size_t)M * D * 2))[i] = 0u; } } PHASE_END(true)
    }
    PHASE_BEGIN(0) phase_rowpass<1, 0, 2, false>(lds, nullptr, hn, nullptr, a.in[I_GFINAL], nullptr, nullptr, 0, nullptr, nullptr, nullptr, nullptr, a.out); PHASE_END(false)
}

extern "C" void kernel_launch(void* const* d_in, const int* in_sizes, int n_in, void* d_out, int out_size,
                              void* d_ws, size_t ws_size, hipStream_t stream) {
    static int grid = 0;
    if (grid == 0) {
        if (n_in != 29 || out_size != M * D || ws_size < WS_END) { fprintf(stderr, "kernel_launch: unexpected problem (n_in %d out %d ws %zu)\n", n_in, out_size, ws_size); grid = -1; return; }
        int dev = 0, cus = 0, per_cu = 0;
        (void)hipGetDevice(&dev);
        (void)hipDeviceGetAttribute(&cus, hipDeviceAttributeMultiprocessorCount, dev);
        (void)hipFuncSetAttribute((const void*)mk_fwd, hipFuncAttributeMaxDynamicSharedMemorySize, LDS_BYTES);
        (void)hipOccupancyMaxActiveBlocksPerMultiprocessor(&per_cu, (const void*)mk_fwd, NT, LDS_BYTES);
        if (per_cu < 1) { fprintf(stderr, "kernel_launch: occupancy query says %d blocks per CU\n", per_cu); per_cu = 1; }
        grid = cus;
    }
    if (grid < 0) return;
    Args a{};
    for (int i = 0; i < 29; ++i) a.in[i] = (const float*)d_in[i];
    a.out = (float*)d_out; a.ws = (unsigned char*)d_ws; a.ph_lo = 0; a.ph_hi = 1000;
    (void)hipMemsetAsync((unsigned char*)d_ws + WS_SMALL + SM_BAR, 0, 16 * 1024, stream);
    void* args[] = {&a};
    hipError_t e = hipLaunchCooperativeKernel((void*)mk_fwd, dim3(grid), dim3(NT), args, LDS_BYTES, stream);
    if (e != hipSuccess) fprintf(stderr, "cooperative launch failed: %s (grid %d)\n", hipGetErrorString(e), grid);
}
```

```cpp
#include <hip/hip_runtime.h>
#include <hip/hip_cooperative_groups.h>
#include <cstdio>
#include <cstdint>
namespace cg = cooperative_groups;

constexpr int NT = 512;
constexpr int D = 1024, NBATCH = 4, SEQ = 4096, M = NBATCH * SEQ;
constexpr int CH = 64, NC = SEQ / CH, NH = 4, DH = 128, DM = 512, DR = 512, NBR = 8, DBR = 64;
constexpr int DIN = 3080, ZW = 3072, DFF = 2816, NE = 8, DPLE = 256;
constexpr int PMAX = 2 * M + NE * 256, NTILE_MAX = PMAX / 256;
constexpr int EROWS = 129;
constexpr float EPS = 1e-6f;
constexpr int ZQ = 0, ZK = 512, ZV = 1024, ZO = 1536, ZXR = 2048, ZYR = 2560;

constexpr size_t MiB = 1u << 20;
constexpr size_t WS_SMALL = 0;
constexpr size_t WS_W_IN0 = 4 * MiB;
constexpr size_t WS_W_OUT0 = 10 * MiB;
constexpr size_t WS_W_FFGU = 12 * MiB;
constexpr size_t WS_W_FFD = 23 * MiB;
constexpr size_t WS_PB0 = WS_W_FFD + 5632 * 1024;
constexpr size_t WS_W_PP0 = WS_PB0 + 8 * MiB;
constexpr size_t WS_H1 = 4 * MiB;
constexpr size_t WS_W_IN1 = 37 * MiB;
constexpr size_t WS_W_OUT1 = 43 * MiB;
constexpr size_t WS_W_PG = 45 * MiB;
constexpr size_t WS_W_PP1 = 49 * MiB;
constexpr size_t WS_W_EGU = WS_W_PP1 + MiB / 2;
constexpr size_t WS_W_ED = WS_W_EGU + 88 * MiB;
constexpr size_t WS_HN8 = WS_W_EGU + 44 * MiB;
constexpr size_t WS_PB1 = WS_W_ED + 44 * MiB;
constexpr size_t WS_HN = WS_PB1 + 8 * MiB;
static_assert(WS_H1 + (size_t)(M + 1) * D * 2 <= WS_W_IN1 && WS_W_PP0 + 1024 * 256 * 2 <= WS_W_IN1, "map");
constexpr size_t WS_RF = 222 * MiB;
constexpr size_t WS_Z = WS_RF;
constexpr size_t WS_CT = WS_Z + 96 * MiB;
constexpr size_t WS_DN = WS_CT + 32 * MiB;
constexpr size_t WS_MIX = WS_CT + 72 * MiB;
constexpr size_t WS_HID = WS_RF;
constexpr size_t WS_PP0 = WS_RF + 130 * MiB;
constexpr size_t WS_SSQ = WS_RF + 201 * MiB;
constexpr size_t SSQ_STRIDE = (size_t)(M + 16) * 64;
constexpr size_t WS_SCAL = WS_RF + 204 * MiB;
constexpr size_t WS_END = 435 * MiB;
static_assert(WS_MIX + (size_t)M * D * 2 <= WS_SSQ && WS_HID + (size_t)PMAX * DFF * 2 <= WS_SSQ && WS_SSQ + 2 * SSQ_STRIDE <= WS_END, "map");
static_assert(WS_HN + (size_t)(M + 1) * D * 2 <= WS_RF, "map");
static_assert(WS_MIX + (size_t)M * D * 2 <= WS_END, "map");
static_assert(WS_HID + (size_t)PMAX * DFF * 2 <= WS_END, "map");
static_assert(WS_DN + 1024 * 128 * 4 <= WS_PP0 && WS_PP0 + (size_t)M * D * 2 <= WS_MIX && WS_HID + (size_t)M * DFF * 2 <= WS_PP0, "map");
constexpr size_t SM_GATES = 0;
constexpr size_t SM_TOKE = 512 * 1024;
constexpr size_t SM_TOKG = SM_TOKE + 128 * 1024;
constexpr size_t SM_ROWTOK = SM_TOKG + 128 * 1024;
constexpr size_t SM_ROWGATE = SM_ROWTOK + 160 * 1024;
constexpr size_t SM_TILEE = SM_ROWGATE + 160 * 1024;
constexpr size_t SM_ROWSLOT = SM_TILEE + 4 * 1024;
constexpr size_t SM_TOKP = SM_ROWSLOT + 160 * 1024;
constexpr size_t SM_BL = SM_TOKP + 16 * 1024;
constexpr size_t SM_AMAX = SM_BL + 4 * 1024;
constexpr size_t SM_MPREV = SM_AMAX + 4 * 1024;
constexpr size_t SM_RGA = 2 * MiB;
constexpr size_t SM_RGH = SM_RGA + 512 * 1024;
constexpr size_t SM_RGP = SM_RGH + 512 * 1024;
constexpr size_t SM_BAR = SM_RGP + 512 * 1024;
constexpr size_t SM_RGW = SM_BAR + 16 * 1024;
static_assert(SM_MPREV + 4096 <= SM_RGA && SM_RGW + 256 * 1024 <= 4 * MiB, "small map");

constexpr int LDS_BYTES = 147456;

typedef unsigned short bf16_t;
typedef float f32x4 __attribute__((ext_vector_type(4)));
typedef unsigned u32x4 __attribute__((ext_vector_type(4)));
typedef unsigned u32x2 __attribute__((ext_vector_type(2)));

__device__ __forceinline__ float bf2f(unsigned v) { return __uint_as_float(v << 16); }
__device__ __forceinline__ unsigned pk2(float lo, float hi);
__device__ __forceinline__ unsigned f2bf(float f) { return pk2(f, 0.f) & 0xffffu; }
typedef float f32x2_t __attribute__((ext_vector_type(2))); typedef __bf16 bf16x2_t __attribute__((ext_vector_type(2)));
__device__ __forceinline__ unsigned pk2(float lo, float hi) { f32x2_t v = {lo, hi}; bf16x2_t b = __builtin_convertvector(v, bf16x2_t); return __builtin_bit_cast(unsigned, b); }
__device__ __forceinline__ unsigned pk4_fp8(float a, float b, float c, float d) { int w = __builtin_amdgcn_cvt_pk_fp8_f32(a, b, 0, false); w = __builtin_amdgcn_cvt_pk_fp8_f32(c, d, w, true); return (unsigned)w; }
__device__ __forceinline__ float frcp(float x) { return __builtin_amdgcn_rcpf(x); }
__device__ __forceinline__ float sigmoidf_(float x) { return frcp(1.f + __expf(-x)); }
__device__ __forceinline__ float siluf_(float x) { return x * frcp(1.f + __expf(-x)); }
__device__ __forceinline__ float logsigmoidf_(float x) { return fminf(x, 0.f) - log1pf(__expf(-fabsf(x))); }
__device__ __forceinline__ float gelu_tanh(float y) { const float u2 = 1.5957691216057308f * (y + 0.044715f * y * y * y); return y * frcp(1.f + __expf(-u2)); }
__device__ __forceinline__ float wave_sum(float v) {
#pragma unroll
    for (int o = 1; o < 64; o <<= 1) v += __shfl_xor(v, o);
    return v;
}
__device__ __forceinline__ float wave_max(float v) {
#pragma unroll
    for (int o = 1; o < 64; o <<= 1) v = fmaxf(v, __shfl_xor(v, o));
    return v;
}

__device__ __forceinline__ float dpp_f(float v, const int ctrl_sel) {
    const int x = __float_as_int(v); int r;
    if (ctrl_sel == 0) r = __builtin_amdgcn_update_dpp(x, x, 0xB1, 0xF, 0xF, false);
    else if (ctrl_sel == 1) r = __builtin_amdgcn_update_dpp(x, x, 0x4E, 0xF, 0xF, false);
    else if (ctrl_sel == 2) r = __builtin_amdgcn_update_dpp(x, x, 0x141, 0xF, 0xF, false);
    else r = __builtin_amdgcn_update_dpp(x, x, 0x140, 0xF, 0xF, false);
    return __int_as_float(r);
}
__device__ __forceinline__ float sum4(float v) { v += dpp_f(v, 0); v += dpp_f(v, 1); return v; }
__device__ __forceinline__ float sum8(float v) { v = sum4(v); v += dpp_f(v, 2); return v; }
__device__ __forceinline__ float sum16(float v) { v = sum8(v); v += dpp_f(v, 3); return v; }
#define WAVE_LDS_SYNC() asm volatile("s_waitcnt lgkmcnt(0)" ::: "memory")
#define LDS_BARRIER() do { asm volatile("s_waitcnt lgkmcnt(0)" ::: "memory"); __builtin_amdgcn_s_barrier(); asm volatile("" ::: "memory"); } while (0)
__device__ __forceinline__ int otid() { int t = threadIdx.x; asm volatile("" : "+v"(t)); return t; }
__device__ __forceinline__ int oint(int v) { asm volatile("" : "+s"(v)); return v; }
__device__ __forceinline__ const void* okarg() { auto p = __builtin_amdgcn_kernarg_segment_ptr(); asm volatile("" : "+s"(p)); return (const void*)p; }

struct Args { const float* in[29]; float* out; unsigned char* ws; int ph_lo, ph_hi; };
enum { I_X = 0, I_P, I_GMIX, I_WIN, I_BIN, I_WCQK, I_BCQK, I_GMH, I_WCR, I_BCR, I_WRA, I_BRA, I_WRI, I_BRI, I_LAM, I_GR, I_WOUT, I_GFFN,
       I_WFG, I_WFU, I_WFD, I_WROUTER, I_WEG, I_WEU, I_WED, I_GPLE, I_WPG, I_WPP, I_GFINAL };


#define XB_TMO      128
#define XB_XCNT(j)  (256  + 64 * (j))
#define XB_XSUB(j)  (1280 + 64 * (j))
#define XB_XGEN(j)  (2304 + 64 * (j))
#define XB_TOP      3328
#define XB_TOPGEN   3392
#define XCD_BAR_WORDS 3456
#define XB_SPIN_CAP (1u << 18)
#define LAS __attribute__((address_space(3)))
__device__ __forceinline__ unsigned xb_ld(unsigned* p)              { return __hip_atomic_load(p, __ATOMIC_RELAXED, __HIP_MEMORY_SCOPE_AGENT); }
__device__ __forceinline__ unsigned xb_add(unsigned* p, unsigned v) { return __hip_atomic_fetch_add(p, v, __ATOMIC_RELAXED, __HIP_MEMORY_SCOPE_AGENT); }
__device__ __forceinline__ unsigned xb_xcc_id() { return (unsigned)__builtin_amdgcn_s_getreg((3 << 11) | 20) & 0xFu; }
#define XB_SPIN(cond, bar) do { unsigned _sp = 0; while (cond) { __builtin_amdgcn_s_sleep(1); \
    if ((++_sp & 255u) == 0u) { if (xb_ld(&(bar)[XB_TMO])) break; if (_sp > XB_SPIN_CAP) { atomicAdd(&(bar)[XB_TMO], 1u); break; } } } } while (0)
struct XcdBarrier { unsigned* bar; unsigned x; volatile LAS unsigned* st; };
__device__ __forceinline__ XcdBarrier xcd_barrier_post(unsigned* bar, volatile LAS unsigned* st) {
    XcdBarrier b; b.bar = bar; b.x = xb_xcc_id(); b.st = st;
    if (threadIdx.x == 0) (void)xb_add(&bar[XB_XCNT(b.x)], 1u);
    return b;
}
__device__ __forceinline__ void xcd_barrier_complete(unsigned* bar, unsigned x, unsigned& nloc, unsigned& nx) {
    const unsigned G = gridDim.x * gridDim.y * gridDim.z;
    unsigned sum, cnt, mine, sp = 0u;
    for (;;) {
        sum = 0u; cnt = 0u; mine = 0u;
#pragma unroll
        for (unsigned j = 0; j < 16; ++j) { const unsigned c = xb_ld(&bar[XB_XCNT(j)]); sum += c; cnt += (c > 0u) ? 1u : 0u; mine = (j == x) ? c : mine; }
        if (sum == G) break;
        __builtin_amdgcn_s_sleep(1);
        if ((++sp & 255u) == 0u) { if (xb_ld(&bar[XB_TMO])) break; if (sp > XB_SPIN_CAP) { atomicAdd(&bar[XB_TMO], 1u); break; } }
    }
    nloc = mine > 0u ? mine : 1u; nx = cnt > 0u ? cnt : 1u;
}
__device__ __forceinline__ void xcd_barrier(const XcdBarrier& b) {
    asm volatile("s_waitcnt vmcnt(0)" ::: "memory");
    __syncthreads();
    if (threadIdx.x == 0) {
        unsigned* bar = b.bar;
        __builtin_amdgcn_s_waitcnt(0);
        unsigned nloc = b.st[0], nx = b.st[1];
        if (nloc == 0u) { xcd_barrier_complete(bar, b.x, nloc, nx); b.st[0] = nloc; b.st[1] = nx; }
        const unsigned old = xb_add(&bar[XB_XSUB(b.x)], 1u);
        const unsigned gen = old / nloc;
        if (old + 1u == (gen + 1u) * nloc) {
            __builtin_amdgcn_fence(__ATOMIC_RELEASE, "agent");
            asm volatile("s_waitcnt vmcnt(0)" ::: "memory");
            const unsigned og = xb_add(&bar[XB_TOP], 1u);
            const unsigned tg = og / nx;
            if (og + 1u == (tg + 1u) * nx) xb_add(&bar[XB_TOPGEN], 1u);
            else XB_SPIN(xb_ld(&bar[XB_TOPGEN]) == tg, bar);
            __builtin_amdgcn_fence(__ATOMIC_ACQUIRE, "agent");
            xb_add(&bar[XB_XGEN(b.x)], 1u);
            asm volatile("s_waitcnt vmcnt(0)" ::: "memory");
        } else {
            XB_SPIN(xb_ld(&bar[XB_XGEN(b.x)]) == gen, bar);
            __builtin_amdgcn_fence(__ATOMIC_ACQUIRE, "agent");
            asm volatile("s_waitcnt vmcnt(0)" ::: "memory");
        }
    }
    __syncthreads();
}

struct CvtJob { const float* src; bf16_t* dst; int ld, k0, c0, K, n0; const float* gain; int fp8; };
__device__ __forceinline__ void cvt_plain_job(CvtJob& o, const float* src, int K, int N, bf16_t* dst, int tile, const float* gain) {
    const int nt = N / 64, kb = tile / nt, nb = tile % nt; o.src = src; o.dst = dst; o.ld = N; o.k0 = kb * 64; o.c0 = nb * 64; o.K = K; o.n0 = nb * 64; o.gain = gain; o.fp8 = 0;
}
__device__ __forceinline__ void cvt_gu_job(CvtJob& o, const float* g, const float* u, bf16_t* dst, int tile, const float* gain) {
    const int nt = 5632 / 64, kb = tile / nt, nb = tile % nt, n0 = nb * 64, tt = n0 >> 8, half = (n0 >> 7) & 1, w = n0 & 127;
    o.src = half ? u : g; o.dst = dst; o.ld = DFF; o.k0 = kb * 64; o.c0 = tt * 128 + w; o.K = 1024; o.n0 = n0; o.gain = gain; o.fp8 = 0;
}
__device__ __forceinline__ void cvt_job(const Args& a, int it, CvtJob& o) {
    unsigned char* ws = a.ws;
    constexpr int T_IN = 16 * 48, T_OUT = 16 * 16, T_GU = 16 * 88, T_FD = 44 * 16, T_PG = 256, T_PP = 4 * 16;
    int r = it;
    if (r < 2 * T_IN) { const int l = r / T_IN, tile = r % T_IN; const int nt = ZW / 64, kb = tile / nt, nb = tile % nt, n0 = nb * 64;
        o.src = a.in[I_WIN] + (size_t)l * D * DIN; o.dst = (bf16_t*)(ws + (l ? WS_W_IN1 : WS_W_IN0)); o.ld = DIN; o.k0 = kb * 64; o.c0 = n0 < 2048 ? n0 : n0 + 8; o.K = D; o.n0 = n0; o.gain = a.in[I_GMIX] + l * D; o.fp8 = 0; return; }
    r -= 2 * T_IN;
    if (r < 2 * T_OUT) { const int l = r / T_OUT; cvt_plain_job(o, a.in[I_WOUT] + (size_t)l * D * D, D, D, (bf16_t*)(ws + (l ? WS_W_OUT1 : WS_W_OUT0)), r % T_OUT, nullptr); return; }
    r -= 2 * T_OUT;
    if (r < T_GU) { cvt_gu_job(o, a.in[I_WFG], a.in[I_WFU], (bf16_t*)(ws + WS_W_FFGU), r, a.in[I_GFFN]); return; }
    r -= T_GU;
    if (r < T_FD) { cvt_plain_job(o, a.in[I_WFD], DFF, D, (bf16_t*)(ws + WS_W_FFD), r, nullptr); return; }
    r -= T_FD;
    if (r < 2 * T_PG) { const int l = r / T_PG; cvt_plain_job(o, a.in[I_WPG] + (size_t)l * D * D, D, D, (bf16_t*)(ws + WS_W_PG) + (size_t)l * D * D, r % T_PG, a.in[I_GPLE] + l * D); return; }
    r -= 2 * T_PG;
    if (r < 2 * T_PP) { const int l = r / T_PP; cvt_plain_job(o, a.in[I_WPP] + (size_t)l * DPLE * D, DPLE, D, (bf16_t*)(ws + (l ? WS_W_PP1 : WS_W_PP0)), r % T_PP, nullptr); return; }
    r -= 2 * T_PP;
    if (r < 8 * T_GU) { const int e = r / T_GU; cvt_gu_job(o, a.in[I_WEG] + (size_t)e * D * DFF, a.in[I_WEU] + (size_t)e * D * DFF, (bf16_t*)(ws + WS_W_EGU + (size_t)e * 5632 * D), r % T_GU, nullptr); o.fp8 = 1; return; }
    r -= 8 * T_GU;
    { const int e = r / T_FD; cvt_plain_job(o, a.in[I_WED] + (size_t)e * DFF * D, DFF, D, (bf16_t*)(ws + WS_W_ED + (size_t)e * D * DFF), r % T_FD, nullptr); o.fp8 = 1; }
}
__device__ __forceinline__ void phase_prologue(const Args& a, unsigned char* lds) {
    unsigned char* ws = a.ws;
    const int G = gridDim.x, t = otid();
    constexpr int T_IN = 16 * 48, T_OUT = 16 * 16, T_GU = 16 * 88, T_FD = 44 * 16, T_PG = 256, T_PP = 4 * 16;
    constexpr int NT_ALL = 2 * T_IN + 2 * T_OUT + T_GU + T_FD + 2 * T_PG + 2 * T_PP + 8 * T_GU + 8 * T_FD;
    constexpr int NB = 4;
    const int kk0 = t >> 4, cc = (t & 15) * 4, n = t >> 3, kg = t & 7;
    float4 v[NB][2], vn[NB][2];
    int it0 = blockIdx.x * NB;
    if (it0 < NT_ALL) {
#pragma unroll
        for (int b = 0; b < NB; ++b) { const int it = it0 + b < NT_ALL ? it0 + b : NT_ALL - 1; CvtJob jq; cvt_job(a, it, jq);
#pragma unroll
            for (int j = 0; j < 2; ++j) v[b][j] = *(const float4*)(jq.src + (size_t)(jq.k0 + kk0 + 32 * j) * jq.ld + jq.c0 + cc); }
    }
    for (; it0 < NT_ALL; it0 += G * NB) {
        const int itn = it0 + G * NB;
        if (itn < NT_ALL) {
#pragma unroll
            for (int b = 0; b < NB; ++b) { const int it = itn + b < NT_ALL ? itn + b : NT_ALL - 1; CvtJob jq; cvt_job(a, it, jq);
#pragma unroll
                for (int j = 0; j < 2; ++j) vn[b][j] = *(const float4*)(jq.src + (size_t)(jq.k0 + kk0 + 32 * j) * jq.ld + jq.c0 + cc); }
        }
#pragma unroll
        for (int b = 0; b < NB; ++b) { float* tl = (float*)lds + b * (64 * 65); const int it = it0 + b < NT_ALL ? it0 + b : NT_ALL - 1; CvtJob jq; cvt_job(a, it, jq);
#pragma unroll
            for (int j = 0; j < 2; ++j) { float4 w = v[b][j];
                if (jq.gain) { const float gk = jq.gain[jq.k0 + kk0 + 32 * j]; w.x *= gk; w.y *= gk; w.z *= gk; w.w *= gk; }
                float* p = tl + (kk0 + 32 * j) * 65 + cc; p[0] = w.x; p[1] = w.y; p[2] = w.z; p[3] = w.w; } }
        LDS_BARRIER();
#pragma unroll
        for (int b = 0; b < NB; ++b) { if (it0 + b >= NT_ALL) break; const float* s_ = (const float*)lds + b * (64 * 65) + (8 * kg) * 65 + n; CvtJob jq; cvt_job(a, it0 + b, jq);
            if (jq.fp8) { u32x2 o; o.x = pk4_fp8(32.f * s_[0], 32.f * s_[65], 32.f * s_[130], 32.f * s_[195]); o.y = pk4_fp8(32.f * s_[260], 32.f * s_[325], 32.f * s_[390], 32.f * s_[455]);
                *(u32x2*)((unsigned char*)jq.dst + (size_t)(jq.n0 + n) * jq.K + jq.k0 + 8 * kg) = o; }
            else { u32x4 o; o.x = pk2(s_[0], s_[65]); o.y = pk2(s_[130], s_[195]); o.z = pk2(s_[260], s_[325]); o.w = pk2(s_[390], s_[455]);
                *(u32x4*)(jq.dst + (size_t)(jq.n0 + n) * jq.K + jq.k0 + 8 * kg) = o; } }
        LDS_BARRIER();
#pragma unroll
        for (int b = 0; b < NB; ++b) { v[b][0] = vn[b][0]; v[b][1] = vn[b][1]; }
    }
    const size_t np4 = (size_t)M * DPLE / 4;
    for (size_t i = (size_t)blockIdx.x * NT + otid(); i < 2 * np4; i += (size_t)G * NT) {
        const float4 v = ((const float4*)a.in[I_P])[i]; u32x2 o; o.x = pk2(v.x, v.y); o.y = pk2(v.z, v.w);
        if (i < np4) ((u32x2*)(ws + WS_PB0))[i] = o; else ((u32x2*)(ws + WS_PB1))[i - np4] = o; }
    for (int i = blockIdx.x * NT + otid(); i < 2 * 8 * 2 * 64 * 64; i += G * NT) {
        const int d = i & 63, e = (i >> 6) & 63, g = (i >> 12) & 1, ln = i >> 13;
        ((bf16_t*)(ws + WS_SMALL + SM_RGW))[i] = (bf16_t)f2bf((g ? a.in[I_WRI] : a.in[I_WRA])[((size_t)ln * 64 + d) * 64 + e]);
    }
    if (blockIdx.x == 0) { for (int i = otid(); i < D / 4; i += NT) ((unsigned*)(ws + WS_HN8 + (size_t)M * D))[i] = 0u; for (int i = otid(); i < D / 2; i += NT) ((unsigned*)(ws + WS_HN + (size_t)M * D * 2))[i] = 0u; if (otid() < 32) ((float*)(ws + WS_SSQ + (otid() >> 4) * SSQ_STRIDE))[(size_t)M * 16 + (otid() & 15)] = 0.f; }
    for (int i = blockIdx.x * NT + otid(); i < PMAX; i += G * NT) { ((int*)(ws + WS_SMALL + SM_ROWTOK))[i] = M; ((float*)(ws + WS_SMALL + SM_ROWGATE))[i] = 0.f; }
}

template <int IN, bool ADDY> struct RawRow {
    f32x4 x[IN == 0 ? 4 : 1]; u32x2 h[IN == 1 ? 4 : 1]; u32x2 y[ADDY ? 4 : 1];
    __device__ __forceinline__ void load(const float* xin, const bf16_t* hb, const bf16_t* y1, int r, int lane) {
#pragma unroll
        for (int j = 0; j < 4; ++j) {
            if (IN == 0) x[j] = ((const f32x4*)(xin + (size_t)r * D) + lane)[64 * j]; else h[j] = ((const u32x2*)(hb + (size_t)r * D) + lane)[64 * j];
            if (ADDY) y[j] = ((const u32x2*)(y1 + (size_t)r * D) + lane)[64 * j]; }
    }
    __device__ __forceinline__ void copy_from(const RawRow& o) {
#pragma unroll
        for (int j = 0; j < 4; ++j) { if (IN == 0) x[j] = o.x[j]; else h[j] = o.h[j]; if (ADDY) y[j] = o.y[j]; }
    }
};
template <int IN, int AUX, int WR, bool ADDY>
__device__ __forceinline__ void phase_rowpass(unsigned char* lds, const float* xin, bf16_t* hb, const bf16_t* y1, const float* g, float* ssq,
                                              const float* auxW, int auxld, const float* auxB, float* gates, unsigned char* tok_p, float* tok_g, float* fout, unsigned char* h8 = nullptr) {
    float* wl = (float*)lds;
    const int tid = otid(), lane = tid & 63, wave = tid >> 6;
    if (AUX) {
        for (int i = tid; i < D * 8; i += NT) wl[i] = auxW[(size_t)(i >> 3) * auxld + (i & 7)];
        __syncthreads();
    }
    f32x4 gv[4];
    if (AUX || WR == 2) {
#pragma unroll
        for (int j = 0; j < 4; ++j) gv[j] = *(const f32x4*)(g + 4 * lane + 256 * j);
    }
    RawRow<1, ADDY> cur, nxt;
    const int rstep = gridDim.x * 8; int row = blockIdx.x * 8 + wave;
    if (IN == 1) { if (row < M) cur.load(xin, hb, y1, row, lane); nxt.copy_from(cur); }
    for (; row < M; row += rstep) {
        if (IN == 1) { if (row + rstep < M) nxt.load(xin, hb, y1, row + rstep, lane); }
        f32x4 v[4]; float ss = 0.f;
#pragma unroll
        for (int j = 0; j < 4; ++j) {
            if (IN == 0) v[j] = ((const f32x4*)(xin + (size_t)row * D) + lane)[64 * j];
            else { const u32x2 w = cur.h[j]; v[j] = (f32x4){bf2f(w.x & 0xffffu), __uint_as_float(w.x & 0xffff0000u), bf2f(w.y & 0xffffu), __uint_as_float(w.y & 0xffff0000u)}; }
            if (ADDY) { const u32x2 y = cur.y[j];
                v[j].x += bf2f(y.x & 0xffffu); v[j].y += __uint_as_float(y.x & 0xffff0000u); v[j].z += bf2f(y.y & 0xffffu); v[j].w += __uint_as_float(y.y & 0xffff0000u); }
            ss += (v[j].x * v[j].x + v[j].y * v[j].y) + (v[j].z * v[j].z + v[j].w * v[j].w); }
        if (IN == 1) cur.copy_from(nxt);
        float tot; { const int ri = __float_as_int(sum16(ss)); tot = (__int_as_float(__builtin_amdgcn_readlane(ri, 0)) + __int_as_float(__builtin_amdgcn_readlane(ri, 16))) + (__int_as_float(__builtin_amdgcn_readlane(ri, 32)) + __int_as_float(__builtin_amdgcn_readlane(ri, 48))); }
        const float rstd = __builtin_amdgcn_rsqf(tot * (1.f / D) + EPS);
        if (WR == 1) {
            u32x2* o = (u32x2*)(hb + (size_t)row * D) + lane;
#pragma unroll
            for (int j = 0; j < 4; ++j) { u32x2 w; w.x = pk2(v[j].x, v[j].y); w.y = pk2(v[j].z, v[j].w); o[64 * j] = w; }
            if (lane < 16) ssq[(size_t)row * 16 + lane] = lane == 0 ? tot : 0.f;
        }
        if (AUX || WR == 2) {
#pragma unroll
            for (int j = 0; j < 4; ++j) v[j] = v[j] * rstd * gv[j];
        }
        if (AUX == 2 && h8) {
#pragma unroll
            for (int j = 0; j < 4; ++j) ((unsigned*)(h8 + (size_t)row * D) + lane)[64 * j] = pk4_fp8(v[j].x, v[j].y, v[j].z, v[j].w);
        }
        if (WR == 2) {
            f32x4* o = (f32x4*)(fout + (size_t)row * D) + lane;
#pragma unroll
            for (int j = 0; j < 4; ++j) o[64 * j] = v[j];
        }
        if (AUX) {
            float acc[8];
#pragma unroll
            for (int c = 0; c < 8; ++c) acc[c] = 0.f;
#pragma unroll
            for (int j = 0; j < 4; ++j)
#pragma unroll
                for (int q = 0; q < 4; ++q) {
                    const int k = 4 * lane + 256 * j + q; const float xv = v[j][q];
                    const f32x4 w0 = *(const f32x4*)(wl + k * 8), w1 = *(const f32x4*)(wl + k * 8 + 4);
                    acc[0] += xv * w0.x; acc[1] += xv * w0.y; acc[2] += xv * w0.z; acc[3] += xv * w0.w;
                    acc[4] += xv * w1.x; acc[5] += xv * w1.y; acc[6] += xv * w1.z; acc[7] += xv * w1.w;
                }
#pragma unroll
            for (int c = 0; c < 8; ++c) { const float r16 = sum16(acc[c]); const int ri = __float_as_int(r16);
                acc[c] = (__int_as_float(__builtin_amdgcn_readlane(ri, 0)) + __int_as_float(__builtin_amdgcn_readlane(ri, 16))) + (__int_as_float(__builtin_amdgcn_readlane(ri, 32)) + __int_as_float(__builtin_amdgcn_readlane(ri, 48))); }
            if (AUX == 1) {
                if (lane < 8) { float s_ = acc[0];
#pragma unroll
                    for (int c = 1; c < 8; ++c) s_ = (lane == c) ? acc[c] : s_;
                    gates[(size_t)row * 8 + lane] = s_ + auxB[lane]; }
            } else {
                if (lane == 0) {
                    int e1 = 0; float v1 = acc[0];
#pragma unroll
                    for (int c = 1; c < 8; ++c) if (acc[c] > v1) { v1 = acc[c]; e1 = c; }
                    int e2 = -1; float v2 = -INFINITY;
#pragma unroll
                    for (int c = 0; c < 8; ++c) if (c != e1 && acc[c] > v2) { v2 = acc[c]; e2 = c; }
                    const float p2 = __expf(v2 - v1), inv = 1.f / (1.f + p2);
                    tok_p[row] = (unsigned char)(e1 | (e2 << 4)); tok_g[row * 2] = inv; tok_g[row * 2 + 1] = p2 * inv;
                }
            }
        }
    }
    __syncthreads();
}

struct Unit { int pm, pn; const int* rows; size_t bofs; };
struct GridOrder {
    static constexpr bool GATHER = false;
    int nM, nN, G, c;
    __device__ __forceinline__ bool next(int i, Unit& u) const {
        const int L0_ = i * G + c, nwg = nM * nN; if (L0_ >= nwg) return false;
        const int q_ = nwg / 8, r_ = nwg % 8, xcd = L0_ % 8, off = L0_ / 8; const int L = (xcd < r_ ? xcd * (q_ + 1) : r_ * (q_ + 1) + (xcd - r_) * q_) + off;
        const int grp = L / (8 * nN), fm = grp * 8, gsz = (nM - fm) < 8 ? (nM - fm) : 8, w = L % (8 * nN);
        u.pm = fm + w % gsz; u.pn = w / gsz; u.rows = nullptr; u.bofs = 0; return true;
    }
};
struct TailOrder {
    static constexpr bool GATHER = false;
    int nM, nN, G, c, first;
    __device__ __forceinline__ bool next(int i, Unit& u) const {
        if (c < first) return false; const int L = i * (G - first) + (c - first); if (L >= nM * nN) return false;
        u.pm = L / nN; u.pn = L % nN; u.rows = nullptr; u.bofs = 0; return true;
    }
};
template <bool GATHER_> struct MoeOrder {
    static constexpr bool GATHER = GATHER_;
    int nM, nN, G, c; const int* rows; size_t estride; int te[8];
    __device__ __forceinline__ void init(const int* tile_e) {
#pragma unroll
        for (int e = 0; e < 8; ++e) te[e] = __builtin_amdgcn_readfirstlane(tile_e[256 + e]);
    }
    __device__ __forceinline__ bool next(int i, Unit& u) const {
        const int L0_ = i * G + c, nwg = nM * nN; if (L0_ >= nwg) return false;
        const int q_ = nwg / 8, r_ = nwg % 8, xcd = L0_ % 8, off = L0_ / 8; const int L = (xcd < r_ ? xcd * (q_ + 1) : r_ * (q_ + 1) + (xcd - r_) * q_) + off;
        const int grp = L / (8 * nN), fm = grp * 8, gsz = (nM - fm) < 8 ? (nM - fm) : 8, w = L % (8 * nN);
        u.pm = fm + w % gsz; u.pn = w / gsz; u.rows = rows; int e = 0;
#pragma unroll
        for (int q = 0; q < 7; ++q) e += (u.pm >= te[q]) ? 1 : 0;
        u.bofs = (size_t)e * estride; return true;
    }
};


namespace pg8 {
#define PG8_LAS __attribute__((address_space(3)))
typedef short bf16x8 __attribute__((ext_vector_type(8)));
constexpr int BM = 256, BK = 64, HALF = 128, HTB = HALF * BK * 2, STAGE_BYTES = 8 * HTB;
__device__ __forceinline__ int lds_byte(int r, int c) { const int st = (r >> 4) * 2 + (c >> 5), rr = r & 15, cc = c & 31, ob = rr * 64 + cc * 2; return st * 1024 + (ob ^ (((ob >> 9) & 1) << 5)); }
__device__ __forceinline__ void stage_rc(int b, int& R, int& C) { const int st = b / 1024, sb = b % 1024, swz = sb ^ (((sb >> 9) & 1) << 5); R = (st >> 1) * 16 + swz / 64; C = (st & 1) * 32 + (swz % 64) / 2; }

typedef int i32x8 __attribute__((ext_vector_type(8))); typedef int i32x4 __attribute__((ext_vector_type(4)));
__device__ __forceinline__ i32x8 cat8(bf16x8 lo, bf16x8 hi) { return __builtin_shufflevector(__builtin_bit_cast(i32x4, lo), __builtin_bit_cast(i32x4, hi), 0, 1, 2, 3, 4, 5, 6, 7); }
__device__ __forceinline__ int perm32(int rho) { const int n = rho >> 4, i = rho & 15; return 8 * (i >> 2) + 4 * n + (i & 3); }
__device__ __forceinline__ void unit_voff(const Unit& u, const int (&R)[2], const int (&C)[2], int KB  , unsigned (&vo)[2][2]) {
#pragma unroll
    for (int h = 0; h < 2; ++h)
#pragma unroll
        for (int i = 0; i < 2; ++i) { int row = u.pm * BM + h * HALF + R[i]; if (u.rows) row = u.rows[row]; vo[h][i] = (unsigned)row * (unsigned)KB + (unsigned)C[i] * 2u; }
}

template <class Epi, class Sched, bool ALIGN_EPI, bool GATHER, bool FP8 = false>
__device__ __forceinline__ void gemm_phase(unsigned char* lds_, const bf16_t* A_, const bf16_t* Bt_, const int K_, const Sched& S, const Epi& E) {
    PG8_LAS unsigned char* lds = (PG8_LAS unsigned char*)lds_;
    const int K = oint(K_);
    const int tid = otid(), wid = __builtin_amdgcn_readfirstlane(tid >> 6), lane = tid & 63, wr = wid >> 2, wc = wid & 3, fr = lane & 15, fq = lane >> 4;
    const int KB = FP8 ? K : 2 * K;
    const int nt = KB / (BK * 2);
    int R[2], C[2]; unsigned voffA[2], voffB[2];
#pragma unroll
    for (int i = 0; i < 2; ++i) { stage_rc(tid * 16 + i * 8192, R[i], C[i]); voffA[i] = (unsigned)(R[i] * KB + C[i] * 2);
        const int Rb = Epi::PERM ? ((R[i] & ~31) + perm32(R[i] & 31)) : R[i]; voffB[i] = (unsigned)(Rb * KB + C[i] * 2); }
    const size_t kstep = (size_t)(BK * 2);
    const size_t hstep = (size_t)HALF * KB;
    const size_t tstep = 2 * hstep;
    const unsigned ldsw = (unsigned)wid * 1024u;
    const int pc0 = FP8 ? 32 * (fq >> 1) + 16 * (fq & 1) : fq * 8; constexpr int KOFF = FP8 ? 16 : 1024;
    const int aoff = lds_byte(wr * 64 + fr, pc0), boff = lds_byte(wc * 32 + fr, pc0);
#define PG8_SA(b, h) (((b) * 2 + (h)) * HTB)
#define PG8_SB(b, h) ((4 + (b) * 2 + (h)) * HTB)
#define PG8_STAGE(bufoff, gbase, voff) do { _Pragma("unroll") for (int _i = 0; _i < 2; ++_i) \
        __builtin_amdgcn_global_load_lds((const unsigned*)((const char*)(gbase) + (voff)[_i]), (PG8_LAS unsigned*)(lds + (bufoff) + ldsw + _i * 8192), 16, 0, 0); } while (0)
#define PG8_STAGE_A(bufoff, base, h, VO) do { if constexpr (GATHER) { PG8_STAGE(bufoff, base, (VO)[h]); } else { PG8_STAGE(bufoff, (base) + (h) * hstep, voffA); } } while (0)
#define PG8_LDA(dst, b, h) do { _Pragma("unroll") for (int m = 0; m < 4; ++m) _Pragma("unroll") for (int k = 0; k < 2; ++k) dst[m][k] = *(const PG8_LAS bf16x8*)(lds + PG8_SA(b, h) + aoff + m * 2048 + k * KOFF); } while (0)
#define PG8_LDB(dst, b, h) do { _Pragma("unroll") for (int n = 0; n < 2; ++n) _Pragma("unroll") for (int k = 0; k < 2; ++k) dst[n][k] = *(const PG8_LAS bf16x8*)(lds + PG8_SB(b, h) + boff + n * 2048 + k * KOFF); } while (0)
#define PG8_MMA(ai, bj, At, Bt) do { __builtin_amdgcn_s_setprio(1); _Pragma("unroll") for (int m = 0; m < 4; ++m) _Pragma("unroll") for (int n = 0; n < 2; ++n) { \
        if constexpr (FP8) { const i32x8 b8_ = cat8(Bt[n][0], Bt[n][1]), a8_ = cat8(At[m][0], At[m][1]); \
            asm volatile("v_mfma_scale_f32_16x16x128_f8f6f4 %0, %1, %2, %0, %3, %3 op_sel_hi:[0,0,0]" : "+v"(acc[ai][bj][m][n]) : "v"(b8_), "v"(a8_), "v"(scale1)); } \
        else { _Pragma("unroll") for (int k = 0; k < 2; ++k) acc[ai][bj][m][n] = __builtin_amdgcn_mfma_f32_16x16x32_bf16(Bt[n][k], At[m][k], acc[ai][bj][m][n], 0, 0, 0); } } __builtin_amdgcn_s_setprio(0); } while (0)
#define PG8_WAIT_V(n) asm volatile("s_waitcnt vmcnt(" #n ")" ::: "memory")
#define PG8_WAIT_L(n) asm volatile("s_waitcnt lgkmcnt(" #n ")" ::: "memory")
#define PG8_BAR __builtin_amdgcn_s_barrier()
#define PG8_SCHED __builtin_amdgcn_sched_barrier(0)
    const int scale1 = 0x7f7f7f7f;
    Unit cur, nxt; int ui = 0;
    if (!S.next(0, cur)) return;
    f32x4 acc[2][2][4][2];
#pragma unroll
    for (int a = 0; a < 2; ++a)
#pragma unroll
        for (int b = 0; b < 2; ++b)
#pragma unroll
            for (int m = 0; m < 4; ++m)
#pragma unroll
                for (int n = 0; n < 2; ++n) acc[a][b][m][n] = (f32x4){0.f, 0.f, 0.f, 0.f};
    bf16x8 At[4][2], B0[2][2], B1[2][2];
    unsigned vc[2][2], vn[2][2];
    if constexpr (GATHER) unit_voff(cur, R, C, KB, vc);
    const char* cA = GATHER ? (const char*)A_ : (const char*)A_ + (size_t)cur.pm * tstep;
    const char* cB = (const char*)Bt_ + cur.bofs * (FP8 ? 1 : 2) + (size_t)cur.pn * tstep;
    PG8_STAGE(PG8_SB(0, 0), cB, voffB); PG8_STAGE(PG8_SB(0, 1), cB + hstep, voffB); PG8_STAGE_A(PG8_SA(0, 0), cA, 0, vc); PG8_STAGE_A(PG8_SA(0, 1), cA, 1, vc);
    if (wr == 1) PG8_BAR;
    PG8_WAIT_V(2); PG8_BAR;
    PG8_STAGE(PG8_SB(1, 0), cB + kstep, voffB); PG8_STAGE_A(PG8_SA(1, 0), cA + kstep, 0, vc); PG8_STAGE(PG8_SB(1, 1), cB + hstep + kstep, voffB);
    PG8_WAIT_V(6); PG8_BAR;
    for (;;) {
        const bool has_next = S.next(ui + 1, nxt);
        const char* nA = cA; const char* nB = cB;
        if (has_next) { nB = (const char*)Bt_ + nxt.bofs * (FP8 ? 1 : 2) + (size_t)nxt.pn * tstep; if constexpr (!GATHER) nA = (const char*)A_ + (size_t)nxt.pm * tstep; }
        int rn[2][2];
        if constexpr (GATHER) {
#pragma unroll
            for (int h = 0; h < 2; ++h)
#pragma unroll
                for (int i = 0; i < 2; ++i) rn[h][i] = cur.rows[(has_next ? nxt.pm : cur.pm) * BM + h * HALF + R[i]]; }
        for (int t = 0; t < nt; t += 2) {
            const bool last = (t == nt - 2);
            if constexpr (GATHER) { if (last) {
#pragma unroll
                for (int h = 0; h < 2; ++h)
#pragma unroll
                    for (int i = 0; i < 2; ++i) { int r_ = rn[h][i]; asm volatile("" : "+v"(r_));
                        vn[h][i] = (unsigned)r_ * (unsigned)KB + (unsigned)C[i] * 2u; } } }
            const char* a1 = cA + (size_t)(t + 1) * kstep;
            const char* a2 = last ? nA : cA + (size_t)(t + 2) * kstep; const char* b2 = last ? nB : cB + (size_t)(t + 2) * kstep;
            const char* a3 = a2 + kstep; const char* b3 = b2 + kstep;
            unsigned v2[2][2];
            if constexpr (GATHER) {
#pragma unroll
                for (int h = 0; h < 2; ++h)
#pragma unroll
                    for (int i = 0; i < 2; ++i) v2[h][i] = last ? vn[h][i] : vc[h][i]; }
            PG8_LDB(B0, 0, 0); PG8_LDB(B1, 0, 1); PG8_SCHED; PG8_LDA(At, 0, 0); PG8_STAGE_A(PG8_SA(1, 1), a1, 1, vc);
            PG8_WAIT_V(8); PG8_WAIT_L(0); PG8_BAR; PG8_MMA(0, 0, At, B0); PG8_MMA(0, 1, At, B1); PG8_BAR; PG8_SCHED;
            PG8_LDA(At, 0, 1); PG8_STAGE(PG8_SB(0, 0), b2, voffB); PG8_STAGE(PG8_SB(0, 1), b2 + hstep, voffB); PG8_STAGE_A(PG8_SA(0, 0), a2, 0, v2);
            PG8_WAIT_V(8); PG8_WAIT_L(0); PG8_BAR; PG8_MMA(1, 0, At, B0); PG8_MMA(1, 1, At, B1); PG8_BAR; PG8_SCHED;
            PG8_LDB(B0, 1, 0); PG8_LDB(B1, 1, 1); PG8_SCHED; PG8_LDA(At, 1, 0); PG8_STAGE_A(PG8_SA(0, 1), a2, 1, v2);
            PG8_WAIT_V(8); PG8_WAIT_L(0); PG8_BAR; PG8_MMA(0, 0, At, B0); PG8_MMA(0, 1, At, B1); PG8_BAR; PG8_SCHED;
            PG8_LDA(At, 1, 1); PG8_STAGE(PG8_SB(1, 0), b3, voffB); PG8_STAGE(PG8_SB(1, 1), b3 + hstep, voffB); PG8_STAGE_A(PG8_SA(1, 0), a3, 0, v2);
            PG8_WAIT_V(8); PG8_WAIT_L(0); PG8_BAR; PG8_MMA(1, 0, At, B0); PG8_MMA(1, 1, At, B1); PG8_BAR; PG8_SCHED;
        }
        if constexpr (ALIGN_EPI) { if (wr == 0) PG8_BAR; }
        { int pm_ = cur.pm, pn_ = cur.pn, fr_ = fr, fq_ = fq;
          asm volatile("" : "+s"(pm_), "+s"(pn_), "+v"(fr_), "+v"(fq_));
          E(acc, pm_, pn_, wr, wc, fr_, fq_); }
        if (!has_next) break;
#pragma unroll
        for (int a = 0; a < 2; ++a)
#pragma unroll
            for (int b = 0; b < 2; ++b)
#pragma unroll
                for (int m = 0; m < 4; ++m)
#pragma unroll
                    for (int n = 0; n < 2; ++n) acc[a][b][m][n] = (f32x4){0.f, 0.f, 0.f, 0.f};
        cur = nxt; cA = nA; cB = nB; ++ui;
        if constexpr (GATHER) {
#pragma unroll
            for (int h = 0; h < 2; ++h)
#pragma unroll
                for (int i = 0; i < 2; ++i) vc[h][i] = vn[h][i]; }
        if constexpr (ALIGN_EPI) { if (wr == 1) PG8_BAR; }
    }
    PG8_WAIT_V(0);
    if constexpr (!ALIGN_EPI) { if (wr == 0) PG8_BAR; }
    PG8_BAR;
#undef PG8_SA
#undef PG8_SB
#undef PG8_STAGE
#undef PG8_STAGE_A
#undef PG8_LDA
#undef PG8_LDB
#undef PG8_MMA
#undef PG8_WAIT_V
#undef PG8_WAIT_L
#undef PG8_BAR
#undef PG8_SCHED
}
}
template <bool FP8 = false, class Epi, class Sched>
__device__ __forceinline__ void gemm_fast(unsigned char* lds, const bf16_t* A, const bf16_t* Bt, int K, const Sched& S, const Epi& E) {
    pg8::gemm_phase<Epi, Sched, true, Sched::GATHER, FP8>(lds, A, Bt, K, S, E);
    __syncthreads();
}

typedef f32x4 AccT[2][2][4][2];
#define EPI_ROW(ai, m) (pm * 256 + (ai) * 128 + wr * 64 + (m) * 16 + fr)
__device__ __forceinline__ void unpack8(const u32x4 w, f32x4& lo, f32x4& hi) {
    lo = (f32x4){bf2f(w.x & 0xffffu), __uint_as_float(w.x & 0xffff0000u), bf2f(w.y & 0xffffu), __uint_as_float(w.y & 0xffff0000u)};
    hi = (f32x4){bf2f(w.z & 0xffffu), __uint_as_float(w.z & 0xffff0000u), bf2f(w.w & 0xffffu), __uint_as_float(w.w & 0xffff0000u)};
}
__device__ __forceinline__ u32x4 pack8(const f32x4 v0, const f32x4 v1) { u32x4 w; w.x = pk2(v0.x, v0.y); w.y = pk2(v0.z, v0.w); w.z = pk2(v1.x, v1.y); w.w = pk2(v1.z, v1.w); return w; }
__device__ __forceinline__ float dot8(const f32x4 a, const f32x4 b) { return ((a.x * a.x + a.y * a.y) + (a.z * a.z + a.w * a.w)) + ((b.x * b.x + b.y * b.y) + (b.z * b.z + b.w * b.w)); }
__device__ __forceinline__ void epi_rstd(const float* ssq, const int* rowmap, int pm, int wr, int fr, int fq, float (&rs)[2][4]) {
    f32x4 p[2][4];
#pragma unroll
    for (int ai = 0; ai < 2; ++ai)
#pragma unroll
        for (int m = 0; m < 4; ++m) { int row = EPI_ROW(ai, m); if (rowmap) row = rowmap[row]; p[ai][m] = *(const f32x4*)((const char*)ssq + ((unsigned)row * 16u + 4u * (unsigned)fq) * 4u); }
#pragma unroll
    for (int ai = 0; ai < 2; ++ai)
#pragma unroll
        for (int m = 0; m < 4; ++m) { float t = (p[ai][m].x + p[ai][m].y) + (p[ai][m].z + p[ai][m].w); t += __shfl_xor(t, 16); t += __shfl_xor(t, 32); rs[ai][m] = __builtin_amdgcn_rsqf(t * (1.f / 1024.f) + EPS); }
}
__device__ __forceinline__ void epi_ssq(float* ssq, int row, int slot, float s_, int fq) { s_ += __shfl_xor(s_, 16); s_ += __shfl_xor(s_, 32); if (fq == 0) *(float*)((char*)ssq + ((unsigned)row * 16u + (unsigned)slot) * 4u) = s_; }

struct EpiZ { static constexpr bool PERM = true; bf16_t* z; const float* bin; const float* ssq;
    __device__ __forceinline__ void operator()(const AccT& acc, int pm, int pn, int wr, int wc, int fr, int fq) const {
        const int c0 = pn * 256 + wc * 32 + 8 * fq; f32x4 bv[2][2]; float rs[2][4];
#pragma unroll
        for (int bj = 0; bj < 2; ++bj)
#pragma unroll
            for (int n = 0; n < 2; ++n) { const int cc = c0 + bj * 128 + n * 4; bv[bj][n] = *(const f32x4*)(bin + (cc < 2048 ? cc : cc + 8)); }
        epi_rstd(ssq, nullptr, pm, wr, fr, fq, rs);
#pragma unroll
        for (int ai = 0; ai < 2; ++ai)
#pragma unroll
            for (int m = 0; m < 4; ++m) { bf16_t* rp = z + (size_t)EPI_ROW(ai, m) * ZW + c0; const float r = rs[ai][m];
#pragma unroll
                for (int bj = 0; bj < 2; ++bj) *(u32x4*)(rp + bj * 128) = pack8(acc[ai][bj][m][0] * r + bv[bj][0], acc[ai][bj][m][1] * r + bv[bj][1]); } } };
template <bool XB> struct EpiHres { static constexpr bool PERM = true; const float* xb; bf16_t* hb; float* ssq;
    __device__ __forceinline__ void operator()(const AccT& acc, int pm, int pn, int wr, int wc, int fr, int fq) const {
        const int c0 = pn * 256 + wc * 32 + 8 * fq;
#pragma unroll
        for (int ai = 0; ai < 2; ++ai) {
            f32x4 lx[4][2][2]; u32x4 lh[4][2];
#pragma unroll
            for (int m = 0; m < 4; ++m)
#pragma unroll
                for (int bj = 0; bj < 2; ++bj) { const size_t o = (size_t)EPI_ROW(ai, m) * D + c0 + bj * 128;
                    if (XB) { lx[m][bj][0] = *(const f32x4*)(xb + o); lx[m][bj][1] = *(const f32x4*)(xb + o + 4); } else lh[m][bj] = *(const u32x4*)(hb + o); }
#pragma unroll
            for (int m = 0; m < 4; ++m) { float s_ = 0.f; const int row = EPI_ROW(ai, m);
#pragma unroll
                for (int bj = 0; bj < 2; ++bj) { f32x4 b0, b1; if (XB) { b0 = lx[m][bj][0]; b1 = lx[m][bj][1]; } else unpack8(lh[m][bj], b0, b1);
                    const f32x4 v0 = b0 + acc[ai][bj][m][0], v1 = b1 + acc[ai][bj][m][1]; s_ += dot8(v0, v1);
                    *(u32x4*)(hb + (size_t)row * D + c0 + bj * 128) = pack8(v0, v1); }
                epi_ssq(ssq, row, pn * 4 + wc, s_, fq); }
        } } };
struct EpiSwiglu { static constexpr bool PERM = true; bf16_t* hid; const float* ssq; const int* rowmap;
    __device__ __forceinline__ void operator()(const AccT& acc, int pm, int pn, int wr, int wc, int fr, int fq) const {
        const int c0 = pn * 128 + wc * 32 + 8 * fq; float rs[2][4];
        epi_rstd(ssq, rowmap, pm, wr, fr, fq, rs);
#pragma unroll
        for (int ai = 0; ai < 2; ++ai)
#pragma unroll
            for (int m = 0; m < 4; ++m) { u32x4 w; const float r = rs[ai][m];
#pragma unroll
                for (int n = 0; n < 2; ++n) { const f32x4 g = acc[ai][0][m][n] * r, u = acc[ai][1][m][n] * r;
                    w[2 * n] = pk2(siluf_(g.x) * u.x, siluf_(g.y) * u.y); w[2 * n + 1] = pk2(siluf_(g.z) * u.z, siluf_(g.w) * u.w); }
                *(u32x4*)(hid + (size_t)EPI_ROW(ai, m) * DFF + c0) = w; } } };
struct EpiSwiglu8 { static constexpr bool PERM = true; unsigned char* hid8; float sc;
    __device__ __forceinline__ void operator()(const AccT& acc, int pm, int pn, int wr, int wc, int fr, int fq) const {
        const int c0 = pn * 128 + wc * 32 + 8 * fq;
#pragma unroll
        for (int ai = 0; ai < 2; ++ai)
#pragma unroll
            for (int m = 0; m < 4; ++m) { u32x2 w;
#pragma unroll
                for (int n = 0; n < 2; ++n) { const f32x4 g = acc[ai][0][m][n] * sc, u = acc[ai][1][m][n] * sc;
                    w[n] = pk4_fp8(siluf_(g.x) * u.x, siluf_(g.y) * u.y, siluf_(g.z) * u.z, siluf_(g.w) * u.w); }
                *(u32x2*)(hid8 + (size_t)EPI_ROW(ai, m) * DFF + c0) = w; } } };
struct EpiMoeDown { static constexpr bool PERM = true; bf16_t* hb; bf16_t* y1; const int* row_tok; const int* row_slot; const float* row_gate; float sc;
    __device__ __forceinline__ void operator()(const AccT& acc, int pm, int pn, int wr, int wc, int fr, int fq) const {
        const int c0 = pn * 256 + wc * 32 + 8 * fq;
        int tok[2][4], slot[2][4]; float gt[2][4];
#pragma unroll
        for (int ai = 0; ai < 2; ++ai)
#pragma unroll
            for (int m = 0; m < 4; ++m) { const int row = EPI_ROW(ai, m); tok[ai][m] = row_tok[row]; slot[ai][m] = row_slot[row]; gt[ai][m] = row_gate[row] * sc; }
#pragma unroll
        for (int ai = 0; ai < 2; ++ai) {
            u32x4 lh[4][2];
#pragma unroll
            for (int m = 0; m < 4; ++m) { const bool rmw = tok[ai][m] < M && slot[ai][m] == 0;
#pragma unroll
                for (int bj = 0; bj < 2; ++bj) lh[m][bj] = rmw ? *(const u32x4*)(hb + (size_t)tok[ai][m] * D + c0 + bj * 128) : (u32x4){0u, 0u, 0u, 0u}; }
#pragma unroll
            for (int m = 0; m < 4; ++m) { if (tok[ai][m] >= M) continue; const size_t o = (size_t)tok[ai][m] * D + c0; const float g = gt[ai][m];
                if (slot[ai][m] == 0) {
#pragma unroll
                    for (int bj = 0; bj < 2; ++bj) { f32x4 b0, b1; unpack8(lh[m][bj], b0, b1); *(u32x4*)(hb + o + bj * 128) = pack8(b0 + g * acc[ai][bj][m][0], b1 + g * acc[ai][bj][m][1]); }
                } else {
#pragma unroll
                    for (int bj = 0; bj < 2; ++bj) *(u32x4*)(y1 + o + bj * 128) = pack8(g * acc[ai][bj][m][0], g * acc[ai][bj][m][1]);
                } }
        } } };
struct EpiStoreBf16 { static constexpr bool PERM = true; bf16_t* out;
    __device__ __forceinline__ void operator()(const AccT& acc, int pm, int pn, int wr, int wc, int fr, int fq) const {
        const int c0 = pn * 256 + wc * 32 + 8 * fq;
#pragma unroll
        for (int ai = 0; ai < 2; ++ai)
#pragma unroll
            for (int m = 0; m < 4; ++m)
#pragma unroll
                for (int bj = 0; bj < 2; ++bj) *(u32x4*)(out + (size_t)EPI_ROW(ai, m) * D + c0 + bj * 128) = pack8(acc[ai][bj][m][0], acc[ai][bj][m][1]); } };
struct EpiPle { static constexpr bool PERM = true; const bf16_t* hin; bf16_t* hb; const bf16_t* pp; float* ssq; const float* ssq_in;
    __device__ __forceinline__ void operator()(const AccT& acc, int pm, int pn, int wr, int wc, int fr, int fq) const {
        const int c0 = pn * 256 + wc * 32 + 8 * fq; float rs[2][4];
        epi_rstd(ssq_in, nullptr, pm, wr, fr, fq, rs);
        u32x4 sg[2][4][2];
#pragma unroll
        for (int ai = 0; ai < 2; ++ai)
#pragma unroll
            for (int m = 0; m < 4; ++m)
#pragma unroll
                for (int bj = 0; bj < 2; ++bj) { f32x4 a0 = acc[ai][bj][m][0] * rs[ai][m], a1 = acc[ai][bj][m][1] * rs[ai][m];
#pragma unroll
                    for (int q = 0; q < 4; ++q) { a0[q] = sigmoidf_(a0[q]); a1[q] = sigmoidf_(a1[q]); }
                    sg[ai][m][bj] = pack8(a0, a1); }
        asm volatile("" ::: "memory");
#pragma unroll
        for (int ai = 0; ai < 2; ++ai) {
            u32x4 lh[4][2], lp[4][2];
#pragma unroll
            for (int m = 0; m < 4; ++m)
#pragma unroll
                for (int bj = 0; bj < 2; ++bj) { const unsigned ob = ((unsigned)EPI_ROW(ai, m) * D + c0 + bj * 128) * 2u;
                    lh[m][bj] = *(const u32x4*)((const char*)hin + ob); lp[m][bj] = *(const u32x4*)((const char*)pp + ob); }
#pragma unroll
            for (int m = 0; m < 4; ++m) { float s_ = 0.f; const int row = EPI_ROW(ai, m);
#pragma unroll
                for (int bj = 0; bj < 2; ++bj) { f32x4 h0, h1, p0, p1, g0, g1; unpack8(lh[m][bj], h0, h1); unpack8(lp[m][bj], p0, p1); unpack8(sg[ai][m][bj], g0, g1);
                    h0 += g0 * p0; h1 += g1 * p1; s_ += dot8(h0, h1);
                    *(u32x4*)((char*)hb + ((unsigned)row * D + c0 + bj * 128) * 2u) = pack8(h0, h1); }
                epi_ssq(ssq, row, pn * 4 + wc, s_, fq); }
        } } };

__device__ __forceinline__ float conv4(const bf16_t* zc, int row, int s, const float* w  , int wstride, float b) {
    float acc = b;
#pragma unroll
    for (int j = 0; j < 4; ++j) { const int ds = 3 - j; if (s - ds >= 0) acc += w[j * wstride] * bf2f(zc[(ptrdiff_t)(row - ds) * ZW]); }
    return acc;
}
__device__ __forceinline__ void chunk_gates(float* sc, const float* gates, int row0, int h, int lane) {
    const float ip = gates[(size_t)(row0 + lane) * 8 + h], fp = gates[(size_t)(row0 + lane) * 8 + 4 + h];
    float b = logsigmoidf_(fp);
#pragma unroll
    for (int o = 1; o < 64; o <<= 1) { const float n = __shfl_up(b, o); if (lane >= o) b += n; }
    sc[lane] = b; sc[64 + lane] = ip;
}
__device__ __forceinline__ void chunk_gates_r(float* sc, float ip, float fp, int lane) {
    float b = logsigmoidf_(fp);
#pragma unroll
    for (int o = 1; o < 64; o <<= 1) { const float n = __shfl_up(b, o); if (lane >= o) b += n; }
    sc[lane] = b; sc[64 + lane] = ip;
}
__device__ __forceinline__ void mlstm_local(const Args& a, unsigned char* lds, int l, int item) {
    const int b = item >> 8, c = (item >> 2) & 63, h = item & 3, row0 = b * SEQ + c * CH, tid = otid(), lane = tid & 63;
    float* Kt = (float*)lds;
    float* Vt = Kt + 64 * 128;
    float* sc = Vt + 64 * 128;
    const bf16_t* z = (const bf16_t*)(a.ws + WS_Z);
    const float* gates = (const float*)(a.ws + WS_SMALL + SM_GATES);
    if (tid < 64) {
        chunk_gates(sc, gates, row0, h, lane);
        const float bl = __shfl(sc[lane], 63), al = bl - sc[lane] + sc[64 + lane];
        const float amax = wave_max(al);
        sc[128 + lane] = __expf(al - amax);
        if (lane == 0) { ((float*)(a.ws + WS_SMALL + SM_BL))[item] = bl; ((float*)(a.ws + WS_SMALL + SM_AMAX))[item] = amax; }
    }
    const float* wc = a.in[I_WCQK] + (size_t)l * 4 * 1024; const float* bc = a.in[I_BCQK] + (size_t)l * 1024;
    for (int i = tid; i < 64 * 128; i += NT) {
        const int ll = i >> 7, d = i & 127, ch = ZK + h * DH + d;
        Kt[i] = siluf_(conv4(z + ch, row0 + ll, c * CH + ll, wc + ch, 1024, bc[ch]));
        Vt[i] = bf2f(z[(size_t)(row0 + ll) * ZW + ZV + h * DH + d]);
    }
    __syncthreads();
    const int d = tid & 127, eg = tid >> 7;
    float acc[33];
#pragma unroll
    for (int i = 0; i < 33; ++i) acc[i] = 0.f;
    for (int ll = 0; ll < 64; ++ll) {
        const float kd = Kt[ll * 128 + d] * sc[128 + ll];
#pragma unroll
        for (int i = 0; i < 32; ++i) acc[i] += Vt[ll * 128 + eg + 4 * i] * kd;
        acc[32] += kd;
    }
    float* ct = (float*)(a.ws + WS_CT) + (size_t)item * EROWS * 128;
#pragma unroll
    for (int i = 0; i < 32; ++i) ct[(eg + 4 * i) * 128 + d] = acc[i];
    if (eg == 0) ct[128 * 128 + d] = acc[32];
    __syncthreads();
}
__device__ __forceinline__ void mlstm_scan(const Args& a, int G) {
    const float* BL = (const float*)(a.ws + WS_SMALL + SM_BL); const float* AM = (const float*)(a.ws + WS_SMALL + SM_AMAX);
    float* MP = (float*)(a.ws + WS_SMALL + SM_MPREV);
    const int tid = otid();
    for (int w = blockIdx.x; w < 16 * 16; w += G) {
        const int bh = w >> 4, sl = w & 15, b = bh >> 2, h = bh & 3;
        unsigned* p = (unsigned*)(a.ws + WS_CT) + (size_t)((b * NC) * NH + h) * 8192 + sl * 512 + tid;
        const bool dn = (sl == 1 && tid < 128);
        float* q = (float*)(a.ws + WS_DN) + (size_t)((b * NC) * NH + h) * 128 + (dn ? tid : 0);
        float s0 = 0.f, s1 = 0.f, sn = 0.f, m = 0.f;
        unsigned x[16], xn[16]; float y[16], yn[16];
#pragma unroll
        for (int j = 0; j < 16; ++j) { x[j] = p[(size_t)j * (NH * 8192)]; y[j] = q[(size_t)j * (NH * 128)]; }
#pragma unroll 1
        for (int c0 = 0; c0 < NC; c0 += 16) {
            const int cn = (c0 + 16 < NC) ? c0 + 16 : c0;
#pragma unroll
            for (int j = 0; j < 16; ++j) { xn[j] = p[(size_t)(cn + j) * (NH * 8192)]; yn[j] = q[(size_t)(cn + j) * (NH * 128)]; }
#pragma unroll
            for (int j = 0; j < 16; ++j) {
                const int item = (b * NC + c0 + j) * NH + h;
                const float bl = BL[item], am = AM[item];
                const float mn = fmaxf(bl + m, am), dec = __expf(bl + m - mn), scl = __expf(am - mn);
                p[(size_t)(c0 + j) * (NH * 8192)] = pk2(s0, s1);
                if (dn) q[(size_t)(c0 + j) * (NH * 128)] = sn;
                if (sl == 0 && tid == 0) MP[item] = m;
                s0 = dec * s0 + scl * bf2f(x[j] & 0xffffu); s1 = dec * s1 + scl * __uint_as_float(x[j] & 0xffff0000u); sn = dec * sn + scl * y[j]; m = mn;
            }
#pragma unroll
            for (int j = 0; j < 16; ++j) { x[j] = xn[j]; y[j] = yn[j]; }
        }
    }
}
__device__ __forceinline__ void mlstm_out(const Args& a, unsigned char* lds, int l, int item) {
    const int b = item >> 8, c = (item >> 2) & 63, h = item & 3, row0 = b * SEQ + c * CH, tid = otid(), lane = tid & 63, wave = tid >> 6;
    float* Q = (float*)lds;
    float* Kt = Q + 64 * 128;
    float* Vt = Kt + 64 * 128;
    float* Sm = Vt + 64 * 128;
    float* sc = Sm + 64 * 64;
    const bf16_t* z = (const bf16_t*)(a.ws + WS_Z);
    const float* gates = (const float*)(a.ws + WS_SMALL + SM_GATES);
    const float mprev = ((const float*)(a.ws + WS_SMALL + SM_MPREV))[item];
    if (tid < 64) {
        chunk_gates(sc, gates, row0, h, lane);
        float g = sc[64 + lane] - sc[lane];
#pragma unroll
        for (int o = 1; o < 64; o <<= 1) { const float n = __shfl_up(g, o); if (lane >= o) g = fmaxf(g, n); }
        const float mrow = sc[lane] + fmaxf(mprev, g);
        sc[128 + lane] = mrow; sc[192 + lane] = __expf(sc[lane] + mprev - mrow);
    }
    const float* wc = a.in[I_WCQK] + (size_t)l * 4 * 1024; const float* bc = a.in[I_BCQK] + (size_t)l * 1024;
    for (int i = tid; i < 64 * 128; i += NT) {
        const int ll = i >> 7, d = i & 127, chq = ZQ + h * DH + d, chk = ZK + h * DH + d;
        Q[i] = siluf_(conv4(z + chq, row0 + ll, c * CH + ll, wc + chq, 1024, bc[chq])) * 0.08838834764831845f;
        Kt[i] = siluf_(conv4(z + chk, row0 + ll, c * CH + ll, wc + chk, 1024, bc[chk]));
        Vt[i] = bf2f(z[(size_t)(row0 + ll) * ZW + ZV + h * DH + d]);
    }
    __syncthreads();
    for (int i = tid; i < 64 * 64; i += NT) {
        const int ll = i >> 6, mm = i & 63; float s = 0.f;
        if (mm <= ll) {
            for (int d = 0; d < 128; ++d) s += Q[ll * 128 + d] * Kt[mm * 128 + d];
            s *= __expf(sc[ll] - sc[mm] + sc[64 + mm] - sc[128 + ll]);
        }
        Sm[i] = s;
    }
    __syncthreads();
    const float* ct = (const float*)(a.ws + WS_CT) + (size_t)item * EROWS * 128;
    if (tid < 64) {
        float di = 0.f, dn = 0.f;
        for (int mm = 0; mm < 64; ++mm) di += Sm[tid * 64 + mm];
        for (int d = 0; d < 128; ++d) dn += Q[tid * 128 + d] * ct[128 * 128 + d];
        const float den = di + sc[192 + tid] * dn;
        sc[256 + tid] = fmaxf(fabsf(den), __expf(-sc[128 + tid]));
    }
    const int e = tid & 127, lg = tid >> 7;
    float acc[16], acc2[16];
#pragma unroll
    for (int i = 0; i < 16; ++i) { acc[i] = 0.f; acc2[i] = 0.f; }
    for (int mm = 0; mm < 64; ++mm) { const float vv = Vt[mm * 128 + e];
#pragma unroll
        for (int i = 0; i < 16; ++i) acc[i] += Sm[(lg * 16 + i) * 64 + mm] * vv; }
    for (int d = 0; d < 128; ++d) { const float cv = ct[e * 128 + d];
#pragma unroll
        for (int i = 0; i < 16; ++i) acc2[i] += Q[(lg * 16 + i) * 128 + d] * cv; }
    __syncthreads();
#pragma unroll
    for (int i = 0; i < 16; ++i) { const int ll = lg * 16 + i;
        const float hv = (acc[i] + sc[192 + ll] * acc2[i]) / sc[256 + ll];
        const float o = sigmoidf_(bf2f(z[(size_t)(row0 + ll) * ZW + ZO + h * DH + e]));
        Kt[ll * 128 + e] = hv * o; }
    __syncthreads();
    const float* gm = a.in[I_GMH] + (size_t)l * DM + h * DH;
    bf16_t* mix = (bf16_t*)(a.ws + WS_MIX);
    for (int ll = wave * 8; ll < wave * 8 + 8; ++ll) {
        const float x0 = Kt[ll * 128 + 2 * lane], x1 = Kt[ll * 128 + 2 * lane + 1];
        const float rs = rsqrtf(wave_sum(x0 * x0 + x1 * x1) * (1.f / 128.f) + EPS);
        *(unsigned*)(mix + (size_t)(row0 + ll) * D + h * DH + 2 * lane) = pk2(x0 * rs * gm[2 * lane], x1 * rs * gm[2 * lane + 1]);
    }
    __syncthreads();
}


typedef short bf16x8 __attribute__((ext_vector_type(8)));
__device__ __forceinline__ f32x4 mfma16(bf16x8 a, bf16x8 b, f32x4 c) { return __builtin_amdgcn_mfma_f32_16x16x32_bf16(a, b, c, 0, 0, 0); }

template <int IN, int AUX>
__device__ __forceinline__ void phase_rowpass_mm(unsigned char* lds, const float* xin, bf16_t* hb, const float* g, float* ssq, const float* auxW, int auxld, const float* auxB,
                                                 float* gates, unsigned char* tok_p, float* tok_g, unsigned char* h8) {
    constexpr int WLD = 1032;
    bf16_t* wl = (bf16_t*)lds; float* gl = (float*)(lds + 8 * WLD * 2);
    const int tid = otid(), lane = tid & 63, wave = tid >> 6;
    for (int i = tid; i < D * 8; i += NT) { const int k = i >> 3, c = i & 7; wl[c * WLD + k] = (bf16_t)f2bf(g[k] * auxW[(size_t)k * auxld + c]); }
    if (AUX == 2) for (int i = tid; i < D; i += NT) gl[i] = g[i];
    __syncthreads();
    const int n = lane & 15, kq = lane >> 4;
    const bf16_t* wrow = wl + (n & 7) * WLD + 8 * kq;
    if (wave < 4) for (int task = blockIdx.x + gridDim.x * wave; task < M / 16; task += gridDim.x * 4) {
        const int row = task * 16 + n;
        f32x4 accL = {0.f, 0.f, 0.f, 0.f}, accS = {0.f, 0.f, 0.f, 0.f};
        u32x4 xr[32];
        if (IN == 1) {
            const u32x4* src = (const u32x4*)(hb + (size_t)row * D + 8 * kq);
#pragma unroll
            for (int s = 0; s < 32; ++s) xr[s] = src[4 * s];
            asm volatile("" ::: "memory");
#pragma unroll
            for (int s = 0; s < 32; ++s) { const bf16x8 xf = __builtin_bit_cast(bf16x8, xr[s]); const bf16x8 wf = *(const bf16x8*)(wrow + 32 * s);
                accL = mfma16(wf, xf, accL); accS = mfma16(xf, xf, accS); }
        } else {
            const f32x4* src = (const f32x4*)(xin + (size_t)row * D + 8 * kq); u32x4* dst = (u32x4*)(hb + (size_t)row * D + 8 * kq);
#pragma unroll
            for (int hf = 0; hf < 2; ++hf) { f32x4 xf32[32]; asm volatile("" ::: "memory");
#pragma unroll
                for (int s = 0; s < 16; ++s) { xf32[2 * s] = src[8 * (16 * hf + s)]; xf32[2 * s + 1] = src[8 * (16 * hf + s) + 1]; }
                asm volatile("" ::: "memory");
#pragma unroll
                for (int s = 0; s < 16; ++s) { const f32x4 a_ = xf32[2 * s], b_ = xf32[2 * s + 1];
                    u32x4 p; p.x = pk2(a_.x, a_.y); p.y = pk2(a_.z, a_.w); p.z = pk2(b_.x, b_.y); p.w = pk2(b_.z, b_.w); dst[4 * (16 * hf + s)] = p;
                    const bf16x8 xf = __builtin_bit_cast(bf16x8, p); const bf16x8 wf = *(const bf16x8*)(wrow + 32 * (16 * hf + s));
                    accL = mfma16(wf, xf, accL); accS = mfma16(xf, xf, accS); } }
        }
        float dv = accS[0]; dv = (n & 3) == 1 ? accS[1] : dv; dv = (n & 3) == 2 ? accS[2] : dv; dv = (n & 3) == 3 ? accS[3] : dv;
        const float tot = __shfl(dv, n + 16 * (n >> 2));
        const float rstd = __builtin_amdgcn_rsqf(tot * (1.f / D) + EPS);
        if (IN == 0) { f32x4 o = {kq == 0 ? tot : 0.f, 0.f, 0.f, 0.f}; *(f32x4*)(ssq + (size_t)row * 16 + 4 * kq) = o; }
        if (AUX == 1) {
            if (kq < 2) { const f32x4 b_ = *(const f32x4*)(auxB + 4 * kq); *(f32x4*)(gates + (size_t)row * 8 + 4 * kq) = accL * rstd + b_; }
        } else {
            const f32x4 lg = accL * rstd;
            float o4[4];
#pragma unroll
            for (int r = 0; r < 4; ++r) o4[r] = __shfl(lg[r], lane + 16);
            if (kq == 0) {
                float acc[8] = {lg[0], lg[1], lg[2], lg[3], o4[0], o4[1], o4[2], o4[3]};
                int e1 = 0; float v1 = acc[0];
#pragma unroll
                for (int c = 1; c < 8; ++c) if (acc[c] > v1) { v1 = acc[c]; e1 = c; }
                int e2 = -1; float v2 = -INFINITY;
#pragma unroll
                for (int c = 0; c < 8; ++c) if (c != e1 && acc[c] > v2) { v2 = acc[c]; e2 = c; }
                const float p2 = __expf(v2 - v1), inv = 1.f / (1.f + p2);
                tok_p[row] = (unsigned char)(e1 | (e2 << 4)); tok_g[row * 2] = inv; tok_g[row * 2 + 1] = p2 * inv;
            }
            if (h8) {
                u32x2* dst = (u32x2*)(h8 + (size_t)row * D + 8 * kq);
#pragma unroll
                for (int s = 0; s < 32; ++s) { if ((s & 3) == 0) asm volatile("" ::: "memory"); const u32x4 w = xr[s]; const f32x4 g0 = *(const f32x4*)(gl + 32 * s + 8 * kq), g1 = *(const f32x4*)(gl + 32 * s + 8 * kq + 4);
                    u32x2 o; o.x = pk4_fp8(bf2f(w.x & 0xffffu) * rstd * g0.x, __uint_as_float(w.x & 0xffff0000u) * rstd * g0.y, bf2f(w.y & 0xffffu) * rstd * g0.z, __uint_as_float(w.y & 0xffff0000u) * rstd * g0.w);
                    o.y = pk4_fp8(bf2f(w.z & 0xffffu) * rstd * g1.x, __uint_as_float(w.z & 0xffff0000u) * rstd * g1.y, bf2f(w.w & 0xffffu) * rstd * g1.z, __uint_as_float(w.w & 0xffff0000u) * rstd * g1.w);
                    dst[4 * s] = o; }
            }
        }
    }
    __syncthreads();
}

__device__ __forceinline__ void conv_load11(const bf16_t* zc, int row0, int l0, bool first_chunk, unsigned (&x)[11]) {
#pragma unroll
    for (int j = 0; j < 11; ++j) { const int ll = l0 - 3 + j; x[j] = (first_chunk && ll < 0) ? 0u : *(const unsigned*)(zc + (ptrdiff_t)(row0 + ll) * ZW); }
}
struct ConvW { float w[4][2]; float b[2]; };
__device__ __forceinline__ void conv_loadw(const float* wc, const float* bc, int col, ConvW& cw) {
#pragma unroll
    for (int j = 0; j < 4; ++j) { cw.w[j][0] = wc[j * 1024 + col]; cw.w[j][1] = wc[j * 1024 + col + 1]; }
    cw.b[0] = bc[col]; cw.b[1] = bc[col + 1];
}
__device__ __forceinline__ void conv_apply(const unsigned (&x)[11], const ConvW& cw, float (&out)[8][2]) {
#pragma unroll
    for (int i = 0; i < 8; ++i) { float a0 = cw.b[0], a1 = cw.b[1];
#pragma unroll
        for (int j = 0; j < 4; ++j) { a0 += cw.w[j][0] * bf2f(x[i + j] & 0xffffu); a1 += cw.w[j][1] * __uint_as_float(x[i + j] & 0xffff0000u); }
        out[i][0] = a0; out[i][1] = a1; }
}
struct MlRegs { unsigned xk[11], v[8]; ConvW cw; float gi, gf; };
__device__ __forceinline__ void ml_load(const Args& a, int l, int item, MlRegs& R) {
    const int b = item >> 8, c = (item >> 2) & 63, h = item & 3, row0 = b * SEQ + c * CH, tid = otid(), lane = tid & 63, wave = tid >> 6;
    const bf16_t* z = (const bf16_t*)(a.ws + WS_Z);
    const float* gates = (const float*)(a.ws + WS_SMALL + SM_GATES);
    const int cp = lane, lg = wave, colk = ZK + h * DH + 2 * cp, colv = ZV + h * DH + 2 * cp;
    conv_load11(z + colk, row0, 8 * lg, c == 0, R.xk);
#pragma unroll
    for (int i = 0; i < 8; ++i) R.v[i] = *(const unsigned*)(z + (size_t)(row0 + 8 * lg + i) * ZW + colv);
    conv_loadw(a.in[I_WCQK] + (size_t)l * 4 * 1024, a.in[I_BCQK] + (size_t)l * 1024, colk, R.cw);
    R.gi = gates[(size_t)(row0 + lane) * 8 + h]; R.gf = gates[(size_t)(row0 + lane) * 8 + 4 + h];
}
__device__ __forceinline__ void ml_compute(const Args& a, unsigned char* lds, int l, int item, MlRegs& R) {
    const int tid = otid(), lane = tid & 63, wave = tid >> 6, fr = lane & 15, fq = lane >> 4;
    unsigned char* KT = lds; unsigned char* VT = lds + 18432; float* RED = (float*)(lds + 36864); float* sc = (float*)(lds + 40960);
    const int cp = lane, lg = wave;
    unsigned (&xk)[11] = R.xk; unsigned (&v)[8] = R.v; ConvW& cw = R.cw;
    if (tid < 64) {
        chunk_gates_r(sc, R.gi, R.gf, lane);
        {
            float g = sc[64 + lane] - sc[lane];
#pragma unroll
            for (int o = 1; o < 64; o <<= 1) { const float n = __shfl_up(g, o); if (lane >= o) g = fmaxf(g, n); }
            float* scal = (float*)(a.ws + WS_SCAL) + (size_t)item * 128; scal[lane] = sc[lane]; scal[64 + lane] = g; }
        const float bl = __shfl(sc[lane], 63), al = bl - sc[lane] + sc[64 + lane];
        const float amax = wave_max(al);
        sc[128 + lane] = __expf(al - amax);
        if (lane == 0) { ((float*)(a.ws + WS_SMALL + SM_BL))[item] = bl; ((float*)(a.ws + WS_SMALL + SM_AMAX))[item] = amax; }
    }
    LDS_BARRIER();
    {
        float kk[8][2];
        conv_apply(xk, cw, kk);
        float n0 = 0.f, n1 = 0.f;
#pragma unroll
        for (int i = 0; i < 8; ++i) { const float wl = sc[128 + 8 * lg + i]; kk[i][0] = siluf_(kk[i][0]) * wl; kk[i][1] = siluf_(kk[i][1]) * wl; n0 += kk[i][0]; n1 += kk[i][1]; }
        u32x4 p0, p1;
#pragma unroll
        for (int i = 0; i < 4; ++i) { p0[i] = pk2(kk[2 * i][0], kk[2 * i + 1][0]); p1[i] = pk2(kk[2 * i][1], kk[2 * i + 1][1]); }
        *(u32x4*)(KT + (2 * cp) * 144 + lg * 16) = p0; *(u32x4*)(KT + (2 * cp + 1) * 144 + lg * 16) = p1;
        RED[lg * 128 + 2 * cp] = n0; RED[lg * 128 + 2 * cp + 1] = n1;
#pragma unroll
        for (int i = 0; i < 4; ++i) { p0[i] = (v[2 * i] & 0xffffu) | (v[2 * i + 1] << 16); p1[i] = (v[2 * i] >> 16) | (v[2 * i + 1] & 0xffff0000u); }
        *(u32x4*)(VT + (2 * cp) * 144 + lg * 16) = p0; *(u32x4*)(VT + (2 * cp + 1) * 144 + lg * 16) = p1;
    }
    LDS_BARRIER();
    bf16_t* ct = (bf16_t*)(a.ws + WS_CT) + (size_t)item * 128 * 128;
    {
        const int et0 = 2 * (wave & 3), dt0 = 4 * (wave >> 2);
        bf16x8 Vf[2][2], Kf[4][2];
#pragma unroll
        for (int i = 0; i < 2; ++i)
#pragma unroll
            for (int ks = 0; ks < 2; ++ks) Vf[i][ks] = *(const bf16x8*)(VT + ((et0 + i) * 16 + fr) * 144 + (ks * 32 + 8 * fq) * 2);
#pragma unroll
        for (int j = 0; j < 4; ++j)
#pragma unroll
            for (int ks = 0; ks < 2; ++ks) Kf[j][ks] = *(const bf16x8*)(KT + ((dt0 + j) * 16 + fr) * 144 + (ks * 32 + 8 * fq) * 2);
#pragma unroll
        for (int i = 0; i < 2; ++i)
#pragma unroll
            for (int j = 0; j < 4; ++j) {
                f32x4 acc = {0.f, 0.f, 0.f, 0.f};
                acc = mfma16(Kf[j][0], Vf[i][0], acc); acc = mfma16(Kf[j][1], Vf[i][1], acc);
                u32x2 w; w.x = pk2(acc[0], acc[1]); w.y = pk2(acc[2], acc[3]);
                *(u32x2*)(ct + ((et0 + i) * 16 + fr) * 128 + (dt0 + j) * 16 + 4 * fq) = w;
            }
    }
    if (tid < 128) { float s_ = 0.f;
#pragma unroll
        for (int g = 0; g < 8; ++g) s_ += RED[g * 128 + tid];
        ((float*)(a.ws + WS_DN))[(size_t)item * 128 + tid] = s_; }
    LDS_BARRIER();
}
struct MoRegs { unsigned xq[11], xk[11], v[8]; u32x4 og[2]; float gi, gb, gg, mprev; };
__device__ __forceinline__ void mo_load(const Args& a, int l, int item, MoRegs& R) {
    const int b = item >> 8, c = (item >> 2) & 63, h = item & 3, row0 = b * SEQ + c * CH, tid = otid(), lane = tid & 63, wave = tid >> 6;
    const bf16_t* z = (const bf16_t*)(a.ws + WS_Z);
    const float* gates = (const float*)(a.ws + WS_SMALL + SM_GATES);
    const int cp = lane, lg = wave, colq = ZQ + h * DH + 2 * cp, colk = ZK + h * DH + 2 * cp, colv = ZV + h * DH + 2 * cp;
    conv_load11(z + colq, row0, 8 * lg, c == 0, R.xq);
    conv_load11(z + colk, row0, 8 * lg, c == 0, R.xk);
#pragma unroll
    for (int i = 0; i < 8; ++i) R.v[i] = *(const unsigned*)(z + (size_t)(row0 + 8 * lg + i) * ZW + colv);
#pragma unroll
    for (int j = 0; j < 2; ++j) { const int pc = tid + j * NT; R.og[j] = *(const u32x4*)(z + (size_t)(row0 + (pc >> 4)) * ZW + ZO + h * DH + (pc & 15) * 8); }
    R.gi = gates[(size_t)(row0 + lane) * 8 + h];
    { const float* scal = (const float*)(a.ws + WS_SCAL) + (size_t)item * 128; R.gb = scal[lane]; R.gg = scal[64 + lane]; }
    R.mprev = ((const float*)(a.ws + WS_SMALL + SM_MPREV))[item];
}
__device__ __forceinline__ void mo_compute(const Args& a, unsigned char* lds, int l, int item, MoRegs& R, ConvW& cwq, ConvW& cwk, int& hw) {
    const int b = item >> 8, c = (item >> 2) & 63, h = item & 3, row0 = b * SEQ + c * CH, tid = otid(), lane = tid & 63, wave = tid >> 6, fr = lane & 15, fq = lane >> 4;
    unsigned char* QN = lds; unsigned char* KN = lds + 17408; unsigned char* VT = lds + 34816; unsigned char* SP = lds + 53248;
    float* sc = (float*)(lds + 62464);
    float* HM = (float*)lds;
    const int cp = lane, lg = wave;
    unsigned (&xq)[11] = R.xq; unsigned (&xk)[11] = R.xk; unsigned (&v)[8] = R.v;
    bf16x8 Cf[4]; f32x4 dnv[4];
    { const bf16_t* ct = (const bf16_t*)(a.ws + WS_CT) + (size_t)item * 128 * 128; const float* dn = (const float*)(a.ws + WS_DN) + (size_t)item * 128;
#pragma unroll
      for (int ks = 0; ks < 4; ++ks) Cf[ks] = *(const bf16x8*)(ct + (wave * 16 + fr) * 128 + ks * 32 + 8 * fq);
#pragma unroll
      for (int j = 0; j < 4; ++j) dnv[j] = *(const f32x4*)(dn + (tid & 7) * 16 + 4 * j); }
    f32x4 gmv[2][2];
#pragma unroll
    for (int j = 0; j < 2; ++j) { const float* gp = a.in[I_GMH] + (size_t)l * DM + h * DH + ((tid + j * NT) & 15) * 8; gmv[j][0] = *(const f32x4*)gp; gmv[j][1] = *(const f32x4*)(gp + 4); }
    if (hw != h) { const float* wc = a.in[I_WCQK] + (size_t)l * 4 * 1024; const float* bc = a.in[I_BCQK] + (size_t)l * 1024;
        conv_loadw(wc, bc, ZQ + h * DH + 2 * cp, cwq); conv_loadw(wc, bc, ZK + h * DH + 2 * cp, cwk); hw = h; }
    if (tid < 64) {
        const float mprev = R.mprev, mrow = R.gb + fmaxf(mprev, R.gg);
        sc[lane] = R.gb; sc[64 + lane] = R.gi; sc[128 + lane] = mrow; sc[192 + lane] = __expf(R.gb + mprev - mrow);
    }
    {
        float qq[8][2];
        conv_apply(xq, cwq, qq);
#pragma unroll
        for (int i = 0; i < 8; ++i) *(unsigned*)(QN + (8 * lg + i) * 272 + cp * 4) = pk2(siluf_(qq[i][0]) * 0.08838834764831845f, siluf_(qq[i][1]) * 0.08838834764831845f);
        conv_apply(xk, cwk, qq);
#pragma unroll
        for (int i = 0; i < 8; ++i) *(unsigned*)(KN + (8 * lg + i) * 272 + cp * 4) = pk2(siluf_(qq[i][0]), siluf_(qq[i][1]));
        u32x4 p0, p1;
#pragma unroll
        for (int i = 0; i < 4; ++i) { p0[i] = (v[2 * i] & 0xffffu) | (v[2 * i + 1] << 16); p1[i] = (v[2 * i] >> 16) | (v[2 * i + 1] & 0xffff0000u); }
        *(u32x4*)(VT + (2 * cp) * 144 + lg * 16) = p0; *(u32x4*)(VT + (2 * cp + 1) * 144 + lg * 16) = p1;
    }
    LDS_BARRIER();
    {
        const int ll = tid >> 3, part = tid & 7; float s_ = 0.f;
#pragma unroll
        for (int j = 0; j < 4; ++j) { const u32x2 qv = *(const u32x2*)(QN + ll * 272 + (part * 16 + 4 * j) * 2);
            s_ += bf2f(qv.x & 0xffffu) * dnv[j].x + __uint_as_float(qv.x & 0xffff0000u) * dnv[j].y + bf2f(qv.y & 0xffffu) * dnv[j].z + __uint_as_float(qv.y & 0xffff0000u) * dnv[j].w; }
        s_ = sum8(s_);
        if (part == 0) sc[384 + ll] = s_;
    }
    {
        const int lt = wave & 3; const int ll = lt * 16 + fr; const float bl_ = sc[ll], mr = sc[128 + ll]; float dsum = 0.f;
#pragma unroll
        for (int mi = 0; mi < 2; ++mi) {
            const int mt = 2 * (wave >> 2) + mi; u32x2 pk = {0u, 0u};
            if (mt <= lt) {
                f32x4 acc = {0.f, 0.f, 0.f, 0.f};
#pragma unroll
                for (int ks = 0; ks < 4; ++ks) { const bf16x8 A = *(const bf16x8*)(KN + (mt * 16 + fr) * 272 + (ks * 32 + 8 * fq) * 2), B = *(const bf16x8*)(QN + (lt * 16 + fr) * 272 + (ks * 32 + 8 * fq) * 2);
                    acc = mfma16(A, B, acc); }
                float sv[4];
#pragma unroll
                for (int r = 0; r < 4; ++r) { const int mm = mt * 16 + 4 * fq + r; const float wgt = (mm <= ll) ? __expf(bl_ - sc[mm] + sc[64 + mm] - mr) : 0.f; sv[r] = acc[r] * wgt; dsum += sv[r]; }
                pk.x = pk2(sv[0], sv[1]); pk.y = pk2(sv[2], sv[3]);
            }
            *(u32x2*)(SP + ll * 144 + (mt * 16 + 4 * fq) * 2) = pk;
        }
        dsum += __shfl_xor(dsum, 16); dsum += __shfl_xor(dsum, 32);
        if (fq == 0) sc[256 + (wave >> 2) * 64 + ll] = dsum;
    }
    LDS_BARRIER();
    if (tid < 64) { const float den = sc[256 + tid] + sc[320 + tid] + sc[192 + tid] * sc[384 + tid]; sc[448 + tid] = fmaxf(fabsf(den), __expf(-sc[128 + tid])); }
    f32x4 acc1[4], acc2[4];
    {
        bf16x8 Vf[2];
#pragma unroll
        for (int ks = 0; ks < 2; ++ks) Vf[ks] = *(const bf16x8*)(VT + (wave * 16 + fr) * 144 + (ks * 32 + 8 * fq) * 2);
#pragma unroll
        for (int lt = 0; lt < 4; ++lt) {
            acc1[lt] = (f32x4){0.f, 0.f, 0.f, 0.f}; acc2[lt] = (f32x4){0.f, 0.f, 0.f, 0.f};
#pragma unroll
            for (int ks = 0; ks < 2; ++ks) acc1[lt] = mfma16(*(const bf16x8*)(SP + (lt * 16 + fr) * 144 + (ks * 32 + 8 * fq) * 2), Vf[ks], acc1[lt]);
#pragma unroll
            for (int ks = 0; ks < 4; ++ks) acc2[lt] = mfma16(*(const bf16x8*)(QN + (lt * 16 + fr) * 272 + (ks * 32 + 8 * fq) * 2), Cf[ks], acc2[lt]);
        }
    }
    LDS_BARRIER();
#pragma unroll
    for (int lt = 0; lt < 4; ++lt)
#pragma unroll
        for (int r = 0; r < 4; ++r) { const int ll = lt * 16 + 4 * fq + r;
            HM[ll * 132 + wave * 16 + fr] = (acc1[lt][r] + sc[192 + ll] * acc2[lt][r]) * frcp(sc[448 + ll]); }
    LDS_BARRIER();
    {
        bf16_t* mix = (bf16_t*)(a.ws + WS_MIX);
#pragma unroll
        for (int j = 0; j < 2; ++j) { const int pc = tid + j * NT, ll = pc >> 4, q16 = pc & 15;
            const f32x4 h0 = *(const f32x4*)(HM + ll * 132 + q16 * 8), h1 = *(const f32x4*)(HM + ll * 132 + q16 * 8 + 4);
            f32x4 o0, o1; unpack8(R.og[j], o0, o1);
            f32x4 g0, g1;
#pragma unroll
            for (int q = 0; q < 4; ++q) { g0[q] = h0[q] * sigmoidf_(o0[q]); g1[q] = h1[q] * sigmoidf_(o1[q]); }
            const float rs = __builtin_amdgcn_rsqf(sum16(dot8(g0, g1)) * (1.f / 128.f) + EPS);
            *(u32x4*)(mix + (size_t)(row0 + ll) * D + h * DH + q16 * 8) = pack8(g0 * rs * gmv[j][0], g1 * rs * gmv[j][1]); }
    }
    LDS_BARRIER();
}

template <int MODE>
__device__ __forceinline__ void rglru_item(const Args& a, unsigned char* lds, int l, int item) {
    const int b = item >> 6, c = item & 63, row0 = b * SEQ + c * CH, ch = otid(), lane = ch & 63, nb = ch >> 6;
    float* xs = (float*)lds + nb * 64 * 64;
    const bf16_t* z = (const bf16_t*)(a.ws + WS_Z);
    const float* wcr = a.in[I_WCR] + (size_t)l * 4 * DR; const float bcr = a.in[I_BCR][l * DR + ch];
    const float w0 = wcr[ch], w1 = wcr[DR + ch], w2 = wcr[2 * DR + ch], w3 = wcr[3 * DR + ch];
    const bf16_t* zc = z + ZXR + ch;
    float xm3 = 0.f, xm2 = 0.f, xm1 = 0.f;
    { const int s0 = c * CH; if (s0 >= 3) { xm3 = bf2f(zc[(size_t)(row0 - 3) * ZW]); xm2 = bf2f(zc[(size_t)(row0 - 2) * ZW]); xm1 = bf2f(zc[(size_t)(row0 - 1) * ZW]); } }
#pragma unroll 4
    for (int t = 0; t < 64; ++t) { const float x0 = bf2f(zc[(size_t)(row0 + t) * ZW]);
        xs[t * 64 + lane] = bcr + w0 * xm3 + w1 * xm2 + w2 * xm1 + w3 * x0; xm3 = xm2; xm2 = xm1; xm1 = x0; }
    unsigned wa[32], wx[32];
    const float* wra = a.in[I_WRA] + ((size_t)(l * NBR + nb) * 64) * 64 + lane; const float* wri = a.in[I_WRI] + ((size_t)(l * NBR + nb) * 64) * 64 + lane;
#pragma unroll
    for (int d = 0; d < 32; ++d) { wa[d] = pk2(wra[(2 * d) * 64], wra[(2 * d + 1) * 64]); wx[d] = pk2(wri[(2 * d) * 64], wri[(2 * d + 1) * 64]); }
    const float ba = a.in[I_BRA][l * DR + ch], bx = a.in[I_BRI][l * DR + ch];
    const float lam = a.in[I_LAM][l * DR + ch];
    const float sp = fmaxf(-lam, 0.f) + log1pf(__expf(-fabsf(lam)));
    float hst = 0.f, ap = 1.f;
    if (MODE == 1) hst = ((const float*)(a.ws + WS_SMALL + SM_RGP))[(size_t)item * DR + ch];
    const float gr = a.in[I_GR][l * DR + ch];
    bf16_t* mix = (bf16_t*)(a.ws + WS_MIX);
    __syncthreads();
#pragma unroll 1
    for (int t = 0; t < 64; ++t) {
        float ra = ba, ia = bx;
#pragma unroll
        for (int d4 = 0; d4 < 16; ++d4) { const f32x4 xv = *(const f32x4*)(xs + t * 64 + 4 * d4);
#pragma unroll
            for (int q = 0; q < 2; ++q) { const unsigned pa = wa[2 * d4 + q], px = wx[2 * d4 + q];
                ra += xv[2 * q] * __uint_as_float(pa << 16) + xv[2 * q + 1] * __uint_as_float(pa & 0xffff0000u);
                ia += xv[2 * q] * __uint_as_float(px << 16) + xv[2 * q + 1] * __uint_as_float(px & 0xffff0000u); } }
        const float xo = xs[t * 64 + lane];
        const float r = sigmoidf_(ra), ig = sigmoidf_(ia), la = -8.f * r * sp, av = __expf(la);
        const float uu = sqrtf(-expm1f(2.f * la)) * (ig * xo);
        hst = av * hst + uu; ap *= av;
        if (MODE == 1) {
            const float y = bf2f(z[(size_t)(row0 + t) * ZW + ZYR + ch]);
            const float o = hst * gelu_tanh(y);
            const float rs = rsqrtf(wave_sum(o * o) * (1.f / 64.f) + EPS);
            mix[(size_t)(row0 + t) * D + DM + ch] = (bf16_t)f2bf(o * rs * gr);
        }
    }
    if (MODE == 0) { ((float*)(a.ws + WS_SMALL + SM_RGA))[(size_t)item * DR + ch] = ap; ((float*)(a.ws + WS_SMALL + SM_RGH))[(size_t)item * DR + ch] = hst; }
    __syncthreads();
}

template <int MODE>
__device__ __forceinline__ void rglru_fast(const Args& a, unsigned char* lds, int l, int item) {
    const int b = item >> 6, c = item & 63, row0 = b * SEQ + c * CH, ch = otid(), lane = ch & 63, nb = ch >> 6, fr = lane & 15, fq = lane >> 4;
    unsigned char* XA = lds + nb * 9216;
    float* GS = (float*)(lds + 73728 + nb * 8448);
    const bf16_t* z = (const bf16_t*)(a.ws + WS_Z);
    unsigned ypk[32];
    {
        const float* wcr = a.in[I_WCR] + (size_t)l * 4 * DR; const float bcr = a.in[I_BCR][l * DR + ch];
        const float w0 = wcr[ch], w1 = wcr[DR + ch], w2 = wcr[2 * DR + ch], w3 = wcr[3 * DR + ch];
        const bf16_t* zc = z + ZXR + ch;
        bf16_t xin[67];
#pragma unroll
        for (int t = 0; t < 67; ++t) xin[t] = (c == 0 && t < 3) ? (bf16_t)0 : zc[(ptrdiff_t)(row0 + t - 3) * ZW];
        if (MODE == 1) {
            bf16_t yb[64];
#pragma unroll
            for (int t = 0; t < 64; ++t) yb[t] = z[(size_t)(row0 + t) * ZW + ZYR + ch];
#pragma unroll
            for (int t = 0; t < 32; ++t) ypk[t] = (unsigned)yb[2 * t] | ((unsigned)yb[2 * t + 1] << 16);
        }
#pragma unroll
        for (int t = 0; t < 64; ++t)
            *(bf16_t*)(XA + t * 144 + lane * 2) = (bf16_t)f2bf(bcr + w0 * bf2f(xin[t]) + w1 * bf2f(xin[t + 1]) + w2 * bf2f(xin[t + 2]) + w3 * bf2f(xin[t + 3]));
    }
    bf16x8 Bf[8][2];
    { const bf16_t* wt = (const bf16_t*)(a.ws + WS_SMALL + SM_RGW) + (size_t)((l * NBR + nb) * 2) * 64 * 64;
#pragma unroll
        for (int ct = 0; ct < 8; ++ct)
#pragma unroll
            for (int ks = 0; ks < 2; ++ks) Bf[ct][ks] = *(const bf16x8*)(wt + (size_t)((ct >> 2) * 64 + (ct & 3) * 16 + fr) * 64 + ks * 32 + 8 * fq); }
    const float ba = a.in[I_BRA][l * DR + ch], bx = a.in[I_BRI][l * DR + ch];
    const float lam = a.in[I_LAM][l * DR + ch];
    const float sp8 = -8.f * (fmaxf(-lam, 0.f) + log1pf(__expf(-fabsf(lam))));
    float hst = 0.f, ap = 1.f;
    if (MODE == 1) hst = ((const float*)(a.ws + WS_SMALL + SM_RGP))[(size_t)item * DR + ch];
    const float gr = a.in[I_GR][l * DR + ch];
    bf16_t* mix = (bf16_t*)(a.ws + WS_MIX);
    WAVE_LDS_SYNC();
#pragma unroll
    for (int rt = 0; rt < 4; ++rt) {
        bf16x8 Af[2];
#pragma unroll
        for (int ks = 0; ks < 2; ++ks) Af[ks] = *(const bf16x8*)(XA + (rt * 16 + fr) * 144 + (ks * 32 + 8 * fq) * 2);
#pragma unroll
        for (int ct = 0; ct < 8; ++ct) {
            f32x4 acc = {0.f, 0.f, 0.f, 0.f};
            acc = mfma16(Af[0], Bf[ct][0], acc); acc = mfma16(Af[1], Bf[ct][1], acc);
#pragma unroll
            for (int r = 0; r < 4; ++r) GS[(4 * fq + r) * 132 + (ct >> 2) * 64 + (ct & 3) * 16 + fr] = acc[r];
        }
        WAVE_LDS_SYNC();
        {
            float ra[16], ia[16], xo[16], ov_[16], apv_[16];
#pragma unroll
            for (int tt = 0; tt < 16; ++tt) { ra[tt] = GS[tt * 132 + lane]; ia[tt] = GS[tt * 132 + 64 + lane]; xo[tt] = bf2f(*(const bf16_t*)(XA + (rt * 16 + tt) * 144 + lane * 2)); }
#pragma unroll
            for (int tt = 0; tt < 16; ++tt) {
                const float r = sigmoidf_(ra[tt] + ba), ig = sigmoidf_(ia[tt] + bx), la = sp8 * r, av = __expf(la);
                const float uu = __builtin_amdgcn_sqrtf(fmaxf(fmaf(-av, av, 1.f), 0.f)) * (ig * xo[tt]);
                hst = av * hst + uu; ap *= av;
                ov_[tt] = hst; apv_[tt] = ap;
            }
            if (MODE == 0) {
                unsigned char* GB = (unsigned char*)GS;
#pragma unroll
                for (int tt = 0; tt < 16; ++tt) { *(bf16_t*)(GB + tt * 128 + lane * 2) = (bf16_t)f2bf(ov_[tt]); *(bf16_t*)(GB + 2048 + tt * 128 + lane * 2) = (bf16_t)f2bf(apv_[tt]); }
                WAVE_LDS_SYNC();
                bf16_t* hlp = (bf16_t*)a.out; bf16_t* ppp = hlp + (size_t)M * DR;
#pragma unroll
                for (int j = 0; j < 2; ++j) { const int p = lane + 64 * j; const size_t off = (size_t)(row0 + rt * 16 + (p >> 3)) * DR + nb * 64 + (p & 7) * 8;
                    *(u32x4*)(hlp + off) = *(const u32x4*)(GB + p * 16); *(u32x4*)(ppp + off) = *(const u32x4*)(GB + 2048 + p * 16); }
            }
            if (MODE == 1) {
#pragma unroll
                for (int tt = 0; tt < 16; ++tt) *(bf16_t*)(XA + (rt * 16 + tt) * 144 + lane * 2) = (bf16_t)f2bf(ov_[tt] * gelu_tanh((tt & 1) ? __uint_as_float(ypk[rt * 8 + (tt >> 1)] & 0xffff0000u) : bf2f(ypk[rt * 8 + (tt >> 1)] & 0xffffu)));
            }
        }
        WAVE_LDS_SYNC();
    }
    if (MODE == 1) {
        float ss = 0.f;
#pragma unroll
        for (int j = 0; j < 8; ++j) { const u32x4 v = *(const u32x4*)(XA + lane * 144 + j * 16);
#pragma unroll
            for (int q = 0; q < 4; ++q) { const float lo = bf2f(v[q] & 0xffffu), hi = __uint_as_float(v[q] & 0xffff0000u); ss += lo * lo + hi * hi; } }
        const float rs = rsqrtf(ss * (1.f / 64.f) + EPS) ;
#pragma unroll
        for (int t0 = 0; t0 < 64; t0 += 16) { float ovv[16];
#pragma unroll
            for (int tt = 0; tt < 16; ++tt) ovv[tt] = bf2f(*(const bf16_t*)(XA + (t0 + tt) * 144 + lane * 2));
#pragma unroll
            for (int tt = 0; tt < 16; ++tt) { const float rst = __int_as_float(__builtin_amdgcn_readlane(__float_as_int(rs), t0 + tt));
                *(bf16_t*)(XA + (t0 + tt) * 144 + lane * 2) = (bf16_t)f2bf(ovv[tt] * rst * gr); } }
        WAVE_LDS_SYNC();
#pragma unroll
        for (int j = 0; j < 8; ++j) { const int t = j * 8 + (lane >> 3), q16 = lane & 7;
            *(u32x4*)(mix + (size_t)(row0 + t) * D + DM + nb * 64 + q16 * 8) = *(const u32x4*)(XA + t * 144 + q16 * 16); }
    }
    if (MODE == 0) { ((float*)(a.ws + WS_SMALL + SM_RGA))[(size_t)item * DR + ch] = ap; ((float*)(a.ws + WS_SMALL + SM_RGH))[(size_t)item * DR + ch] = hst; }
    LDS_BARRIER();
}
__device__ __forceinline__ void rglru_out(const Args& a, int l, int item) {
    const int b = item >> 6, c = item & 63, row0 = b * SEQ + c * CH, tid = otid(), lane = tid & 63, nb = tid >> 6, ch0 = nb * 64 + (lane & 7) * 8, t0 = lane >> 3;
    const bf16_t* z = (const bf16_t*)(a.ws + WS_Z);
    const bf16_t* hlp = (const bf16_t*)a.out; const bf16_t* ppp = hlp + (size_t)M * DR;
    bf16_t* mix = (bf16_t*)(a.ws + WS_MIX);
    u32x4 hv[8], pv[8], yv[8];
#pragma unroll
    for (int j = 0; j < 8; ++j) { const size_t r = (size_t)(row0 + j * 8 + t0);
        hv[j] = *(const u32x4*)(hlp + r * DR + ch0); pv[j] = *(const u32x4*)(ppp + r * DR + ch0); yv[j] = *(const u32x4*)(z + r * ZW + ZYR + ch0); }
    const float* cp = (const float*)(a.ws + WS_SMALL + SM_RGP) + (size_t)item * DR + ch0; const f32x4 c0 = *(const f32x4*)cp, c1 = *(const f32x4*)(cp + 4);
    const float* gp = a.in[I_GR] + l * DR + ch0; const f32x4 g0 = *(const f32x4*)gp, g1 = *(const f32x4*)(gp + 4);
#pragma unroll
    for (int j = 0; j < 8; ++j) {
        f32x4 h0, h1, p0, p1, y0, y1; unpack8(hv[j], h0, h1); unpack8(pv[j], p0, p1); unpack8(yv[j], y0, y1);
        f32x4 o0, o1;
#pragma unroll
        for (int q = 0; q < 4; ++q) { o0[q] = (h0[q] + p0[q] * c0[q]) * gelu_tanh(y0[q]); o1[q] = (h1[q] + p1[q] * c1[q]) * gelu_tanh(y1[q]); }
        const float rs = __builtin_amdgcn_rsqf(sum8(dot8(o0, o1)) * (1.f / 64.f) + EPS);
        *(u32x4*)(mix + (size_t)(row0 + j * 8 + t0) * D + DM + ch0) = pack8(o0 * rs * g0, o1 * rs * g1);
    }
}
__device__ __forceinline__ void rglru_scan(const Args& a, int G) {
    const int tid = otid(), lane = tid & 63, wave = tid >> 6;
    for (int i = blockIdx.x * 8 + wave; i < NBATCH * DR; i += G * 8) {
        const int b = i / DR, ch = i % DR; const size_t o = (size_t)(b * NC + lane) * DR + ch;
        float A = ((const float*)(a.ws + WS_SMALL + SM_RGA))[o], H = ((const float*)(a.ws + WS_SMALL + SM_RGH))[o];
#pragma unroll
        for (int d = 1; d < 64; d <<= 1) { const float Ap = __shfl_up(A, d), Hp = __shfl_up(H, d); if (lane >= d) { H = A * Hp + H; A = A * Ap; } }
        const float pin = __shfl_up(H, 1);
        ((float*)(a.ws + WS_SMALL + SM_RGP))[o] = lane == 0 ? 0.f : pin;
    }
}

__device__ __forceinline__ void phase_route(const Args& a, unsigned char* lds) {
    unsigned* wtot = (unsigned*)lds;
    int* pre = (int*)(lds + 256);
    int* tot = pre + 8;
    int* ce = tot + 16;
    unsigned* pref = (unsigned*)(lds + 2048);
    const int tid = otid(), lane = tid & 63, wave = tid >> 6, G = gridDim.x;
    const unsigned char* tok_p = (const unsigned char*)(a.ws + WS_SMALL + SM_TOKP); const float* tok_g = (const float*)(a.ws + WS_SMALL + SM_TOKG);
    int* row_tok = (int*)(a.ws + WS_SMALL + SM_ROWTOK); float* row_gate = (float*)(a.ws + WS_SMALL + SM_ROWGATE); int* tile_e = (int*)(a.ws + WS_SMALL + SM_TILEE);
    if (tid < 256) {
        unsigned long long hh = 0ull;
#pragma unroll
        for (int j = 0; j < 4; ++j) { const u32x4 v = ((const u32x4*)(tok_p + tid * 64))[j];
#pragma unroll
            for (int q = 0; q < 4; ++q)
#pragma unroll
                for (int bb = 0; bb < 4; ++bb) { const unsigned by = (v[q] >> (8 * bb)) & 0xffu; hh += (1ull << (8 * (by & 15u))) + (1ull << (8 * (by >> 4))); } }
        unsigned w[4];
#pragma unroll
        for (int i = 0; i < 4; ++i) { const unsigned two = (unsigned)(hh >> (16 * i)) & 0xffffu; w[i] = (two & 0xffu) | ((two >> 8) << 16); }
        unsigned inc[4];
#pragma unroll
        for (int i = 0; i < 4; ++i) { unsigned x = w[i];
#pragma unroll
            for (int o = 1; o < 64; o <<= 1) { const unsigned n = __shfl_up(x, o); if (lane >= o) x += n; }
            inc[i] = x; }
        if (lane == 63) {
#pragma unroll
            for (int i = 0; i < 4; ++i) wtot[wave * 4 + i] = inc[i]; }
        __builtin_amdgcn_s_waitcnt(0);
        __builtin_amdgcn_s_barrier();
#pragma unroll
        for (int i = 0; i < 4; ++i) { unsigned base = 0u;
            for (int ww = 0; ww < wave; ++ww) base += wtot[ww * 4 + i];
            pref[tid * 4 + i] = base + inc[i] - w[i];
            if (tid == 255) { const unsigned t2 = base + inc[i]; tot[2 * i] = (int)(t2 & 0xffffu); tot[2 * i + 1] = (int)(t2 >> 16); } }
    } else {
        __builtin_amdgcn_s_barrier();
    }
    __syncthreads();
    if (tid == 0) { int s_ = 0; for (int e = 0; e < 8; ++e) { tot[8 + e] = s_; s_ += (tot[e] + 255) & ~255; }
        if (blockIdx.x == 0) { int t = 0; for (int e = 0; e < 8; ++e) { const int n = (tot[e] + 255) >> 8; for (int j = 0; j < n; ++j) tile_e[t++] = e; tile_e[256 + e] = t; } tile_e[255] = t; } }
    __syncthreads();
    for (int ck = blockIdx.x; ck < 256; ck += G) {
        if (tid < 128) { const unsigned by = tok_p[ck * 64 + (tid >> 1)]; ce[tid] = (tid & 1) ? (int)(by >> 4) : (int)(by & 15u); }
        __syncthreads();
        if (tid < 128) { const int e = ce[tid];
            int rank = 0, w0cnt = 0;
#pragma unroll
            for (int q = 0; q < 8; ++q) { const unsigned long long mk = __ballot(e == q); if (e == q) rank = __popcll(mk & ((1ull << lane) - 1ull)); if (wave == 0 && lane == 0) ce[128 + q] = __popcll(mk); }
            __builtin_amdgcn_s_waitcnt(0);
            asm volatile("s_barrier" ::: "memory");
            if (wave == 1) rank += ce[128 + e];
            (void)w0cnt;
            const unsigned pw = pref[ck * 4 + (e >> 1)]; const int pr = (int)((e & 1) ? (pw >> 16) : (pw & 0xffffu));
            const int dest = tot[8 + e] + pr + rank;
            row_tok[dest] = ck * 64 + (tid >> 1); row_gate[dest] = tok_g[ck * 128 + tid]; ((int*)(a.ws + WS_SMALL + SM_ROWSLOT))[dest] = tid & 1; }
        else { asm volatile("s_barrier" ::: "memory"); }
        __syncthreads();
    }
}

#ifndef GEMM
#define GEMM gemm_fast
#endif
__global__ void __launch_bounds__(NT, 2) mk_fwd(Args a0) {
    extern __shared__ __attribute__((aligned(16))) unsigned char lds[];
    const int G = gridDim.x, bid = blockIdx.x, ph_lo = a0.ph_lo, ph_hi = a0.ph_hi;
    volatile LAS unsigned* xst = (volatile LAS unsigned*)(lds + LDS_BYTES - 64);
    if (threadIdx.x < 2) xst[threadIdx.x] = 0u;
    __syncthreads();
    const XcdBarrier xb = xcd_barrier_post((unsigned*)(a0.ws + WS_SMALL + SM_BAR), xst);
    int ph = 0;
#ifndef PROBE_CAT
#define PROBE_CAT 0
#define PROBE_N 1
#endif
#define PHASE_BEGIN(cat) if (ph >= ph_lo && ph < ph_hi) { for (int rep_ = 0; rep_ < ((cat) == PROBE_CAT ? PROBE_N : 1); ++rep_) { const bool lastrep = (rep_ + 1 == ((cat) == PROBE_CAT ? PROBE_N : 1)); (void)lastrep; const Args& a = *(const Args*)okarg(); unsigned char* const ws = a.ws; \
    bf16_t* const hn = (bf16_t*)(ws + WS_HN); bf16_t* const z = (bf16_t*)(ws + WS_Z); bf16_t* const mix = (bf16_t*)(ws + WS_MIX); bf16_t* const hid = (bf16_t*)(ws + WS_HID); \
    float* const gates = (float*)(ws + WS_SMALL + SM_GATES); int* const tok_e = (int*)(ws + WS_SMALL + SM_TOKP); float* const tok_g = (float*)(ws + WS_SMALL + SM_TOKG); \
    const int* const row_tok = (const int*)(ws + WS_SMALL + SM_ROWTOK); const float* const row_gate = (const float*)(ws + WS_SMALL + SM_ROWGATE); const int* const tile_e = (const int*)(ws + WS_SMALL + SM_TILEE); \
    (void)hn; (void)z; (void)mix; (void)hid; (void)gates; (void)tok_e; (void)tok_g; (void)row_tok; (void)row_gate; (void)tile_e;
#define PHASE_END(dosync) } for (int rep_ = 0; rep_ < (PROBE_CAT == 6 ? PROBE_N : 1); ++rep_) if ((dosync) && ph + 1 < ph_hi) { xcd_barrier(xb); } } ++ph;

    PHASE_BEGIN(1) phase_prologue(a, lds); __syncthreads();
        phase_rowpass_mm<0, 1>(lds, a.in[I_X], hn, a.in[I_GMIX], (float*)(ws + WS_SSQ), a.in[I_WIN] + 2048, DIN, a.in[I_BIN] + 2048, gates, nullptr, nullptr, nullptr); PHASE_END(true)
    { constexpr int l = 0;
#define LAYER_PTRS bf16_t* const hb = (bf16_t*)(ws + (l ? WS_H1 : WS_HN)); bf16_t* const hbo = (bf16_t*)(ws + (l ? WS_HN : WS_H1)); float* const ssq = (float*)(ws + WS_SSQ + l * SSQ_STRIDE); float* const ssqo = (float*)(ws + WS_SSQ + (1 - l) * SSQ_STRIDE); (void)hb; (void)hbo; (void)ssq; (void)ssqo;
        PHASE_BEGIN(3) LAYER_PTRS { if (l == 1) phase_rowpass_mm<1, 1>(lds, nullptr, hb, a.in[I_GMIX] + l * D, nullptr, a.in[I_WIN] + (size_t)l * D * DIN + 2048, DIN, a.in[I_BIN] + l * DIN + 2048, gates, nullptr, nullptr, nullptr);
            GridOrder S{M / 256, ZW / 256, G, bid}; EpiZ E{z, a.in[I_BIN] + l * DIN, ssq};
            GEMM(lds, hb, (const bf16_t*)(ws + (l ? WS_W_IN1 : WS_W_IN0)), D, S, E); } PHASE_END(true)
        PHASE_BEGIN(4) LAYER_PTRS { MlRegs cur, nxt; int it = bid; if (it < 1024) ml_load(a, l, it, cur); nxt = cur;
            for (; it < 1024; it += G) { if (it + G < 1024) ml_load(a, l, it + G, nxt); ml_compute(a, lds, l, it, cur); cur = nxt; }
            for (; it < 1280; it += G) rglru_fast<0>(a, lds, l, it - 1024); } PHASE_END(true)
        PHASE_BEGIN(0) LAYER_PTRS mlstm_scan(a, G); rglru_scan(a, G); PHASE_END(true)
        PHASE_BEGIN(5) LAYER_PTRS { MoRegs cur, nxt; ConvW cwq, cwk; int hw = -1; int it = bid; if (it < 1024) mo_load(a, l, it, cur); nxt = cur;
            for (; it < 1024; it += G) { if (it + G < 1024) mo_load(a, l, it + G, nxt); mo_compute(a, lds, l, it, cur, cwq, cwk, hw); cur = nxt; }
            for (; it < 1280; it += G) rglru_out(a, l, it - 1024); } PHASE_END(true)
        PHASE_BEGIN(0) LAYER_PTRS { GridOrder S{M / 256, D / 256, G, bid}; EpiHres<l == 0> E{l == 0 ? a.in[I_X] : nullptr, hb, ssq};
            GEMM(lds, mix, (const bf16_t*)(ws + (l ? WS_W_OUT1 : WS_W_OUT0)), D, S, E); } PHASE_END(true)
        if (l == 0) {
            PHASE_BEGIN(3) LAYER_PTRS { GridOrder S{M / 256, 2 * DFF / 256, G, bid}; EpiSwiglu E{hid, ssq, nullptr};
                GEMM(lds, hb, (const bf16_t*)(ws + WS_W_FFGU), D, S, E);
                { constexpr int nun = (M / 256) * (2 * DFF / 256); const int first = nun % G;
                  TailOrder S2{M / 256, D / 256, G, bid, first}; EpiStoreBf16 E2{(bf16_t*)(ws + WS_PP0)};
                  GEMM(lds, (const bf16_t*)(ws + WS_PB0), (const bf16_t*)(ws + WS_W_PP0), DPLE, S2, E2); } } PHASE_END(true)
            PHASE_BEGIN(0) LAYER_PTRS { GridOrder S{M / 256, D / 256, G, bid}; EpiHres<false> E{nullptr, hb, ssq};
                GEMM(lds, hid, (const bf16_t*)(ws + WS_W_FFD), DFF, S, E); } PHASE_END(true)
        } else {
            PHASE_BEGIN(2) LAYER_PTRS phase_rowpass_mm<1, 2>(lds, nullptr, hb, a.in[I_GFFN] + l * D, nullptr, a.in[I_WROUTER], 8, nullptr, nullptr, (unsigned char*)tok_e, tok_g, ws + WS_HN8); PHASE_END(true)
            PHASE_BEGIN(12) LAYER_PTRS phase_route(a, lds); PHASE_END(true)
            PHASE_BEGIN(3) LAYER_PTRS { MoeOrder<true> S{tile_e[255], 2 * DFF / 256, G, bid, row_tok, (size_t)5632 * D}; S.init(tile_e); EpiSwiglu8 E{ws + WS_HID, 1.f / 32.f};
                gemm_fast<true>(lds, (const bf16_t*)(ws + WS_HN8), (const bf16_t*)(ws + WS_W_EGU), D, S, E); } PHASE_END(true)
            PHASE_BEGIN(0) LAYER_PTRS { MoeOrder<false> S{tile_e[255], D / 256, G, bid, nullptr, (size_t)D * DFF}; S.init(tile_e); EpiMoeDown E{hb, (bf16_t*)a.out, row_tok, (const int*)(ws + WS_SMALL + SM_ROWSLOT), row_gate, 1.f / 32.f};
                gemm_fast<true>(lds, (const bf16_t*)(ws + WS_HID), (const bf16_t*)(ws + WS_W_ED), DFF, S, E);
                { const int nun = tile_e[255] * (D / 256); const int first = nun > 2 * G ? nun - 2 * G : 0;
                  TailOrder S2{M / 256, D / 256, G, bid, first < G ? first : 0}; EpiStoreBf16 E2{(bf16_t*)a.out + (size_t)M * D};
                  GEMM(lds, (const bf16_t*)(ws + WS_PB1), (const bf16_t*)(ws + WS_W_PP1), DPLE, S2, E2); } } PHASE_END(true)
            PHASE_BEGIN(0) LAYER_PTRS phase_rowpass<1, 0, 1, true>(lds, nullptr, hb, (const bf16_t*)a.out, nullptr, ssq, nullptr, 0, nullptr, nullptr, nullptr, nullptr, nullptr); PHASE_END(true)
        }
        PHASE_BEGIN(10) LAYER_PTRS { GridOrder S{M / 256, D / 256, G, bid};
            EpiPle E{hb, hbo, l == 0 ? (const bf16_t*)(ws + WS_PP0) : (const bf16_t*)a.out + (size_t)M * D, ssqo, ssq}; GEMM(lds, hb, (const bf16_t*)(ws + WS_W_PG) + (size_t)l * D * D, D, S, E);
            if (l == 0 && bid == 0) { for (int i = otid(); i < D / 2; i += NT) ((unsigned*)(ws + WS_H1 + (size_t)M * D * 2))[i] = 0u; } } PHASE_END(true)
    }
    { constexpr int l = 1;
        PHASE_BEGIN(3) LAYER_PTRS { if (l == 1) phase_rowpass_mm<1, 1>(lds, nullptr, hb, a.in[I_GMIX] + l * D, nullptr, a.in[I_WIN] + (size_t)l * D * DIN + 2048, DIN, a.in[I_BIN] + l * DIN + 2048, gates, nullptr, nullptr, nullptr);
            GridOrder S{M / 256, ZW / 256, G, bid}; EpiZ E{z, a.in[I_BIN] + l * DIN, ssq};
            GEMM(lds, hb, (const bf16_t*)(ws + (l ? WS_W_IN1 : WS_W_IN0)), D, S, E); } PHASE_END(true)
        PHASE_BEGIN(4) LAYER_PTRS { MlRegs cur, nxt; int it = bid; if (it < 1024) ml_load(a, l, it, cur); nxt = cur;
            for (; it < 1024; it += G) { if (it + G < 1024) ml_load(a, l, it + G, nxt); ml_compute(a, lds, l, it, cur); cur = nxt; }
            for (; it < 1280; it += G) rglru_fast<0>(a, lds, l, it - 1024); } PHASE_END(true)
        PHASE_BEGIN(0) LAYER_PTRS mlstm_scan(a, G); rglru_scan(a, G); PHASE_END(true)
        PHASE_BEGIN(5) LAYER_PTRS { MoRegs cur, nxt; ConvW cwq, cwk; int hw = -1; int it = bid; if (it < 1024) mo_load(a, l, it, cur); nxt = cur;
            for (; it < 1024; it += G) { if (it + G < 1024) mo_load(a, l, it + G, nxt); mo_compute(a, lds, l, it, cur, cwq, cwk, hw); cur = nxt; }
            for (; it < 1280; it += G) rglru_out(a, l, it - 1024); } PHASE_END(true)
        PHASE_BEGIN(0) LAYER_PTRS { GridOrder S{M / 256, D / 256, G, bid}; EpiHres<l == 0> E{l == 0 ? a.in[I_X] : nullptr, hb, ssq};
            GEMM(lds, mix, (const bf16_t*)(ws + (l ? WS_W_OUT1 : WS_W_OUT0)), D, S, E); } PHASE_END(true)
        if (l == 0) {
            PHASE_BEGIN(3) LAYER_PTRS { GridOrder S{M / 256, 2 * DFF / 256, G, bid}; EpiSwiglu E{hid, ssq, nullptr};
                GEMM(lds, hb, (const bf16_t*)(ws + WS_W_FFGU), D, S, E);
                { constexpr int nun = (M / 256) * (2 * DFF / 256); const int first = nun % G;
                  TailOrder S2{M / 256, D / 256, G, bid, first}; EpiStoreBf16 E2{(bf16_t*)(ws + WS_PP0)};
                  GEMM(lds, (const bf16_t*)(ws + WS_PB0), (const bf16_t*)(ws + WS_W_PP0), DPLE, S2, E2); } } PHASE_END(true)
            PHASE_BEGIN(0) LAYER_PTRS { GridOrder S{M / 256, D / 256, G, bid}; EpiHres<false> E{nullptr, hb, ssq};
                GEMM(lds, hid, (const bf16_t*)(ws + WS_W_FFD), DFF, S, E); } PHASE_END(true)
        } else {
            PHASE_BEGIN(2) LAYER_PTRS phase_rowpass_mm<1, 2>(lds, nullptr, hb, a.in[I_GFFN] + l * D, nullptr, a.in[I_WROUTER], 8, nullptr, nullptr, (unsigned char*)tok_e, tok_g, ws + WS_HN8); PHASE_END(true)
            PHASE_BEGIN(12) LAYER_PTRS phase_route(a, lds); PHASE_END(true)
            PHASE_BEGIN(3) LAYER_PTRS { MoeOrder<true> S{tile_e[255], 2 * DFF / 256, G, bid, row_tok, (size_t)5632 * D}; S.init(tile_e); EpiSwiglu8 E{ws + WS_HID, 1.f / 32.f};
                gemm_fast<true>(lds, (const bf16_t*)(ws + WS_HN8), (const bf16_t*)(ws + WS_W_EGU), D, S, E); } PHASE_END(true)
            PHASE_BEGIN(0) LAYER_PTRS { MoeOrder<false> S{tile_e[255], D / 256, G, bid, nullptr, (size_t)D * DFF}; S.init(tile_e); EpiMoeDown E{hb, (bf16_t*)a.out, row_tok, (const int*)(ws + WS_SMALL + SM_ROWSLOT), row_gate, 1.f / 32.f};
                gemm_fast<true>(lds, (const bf16_t*)(ws + WS_HID), (const bf16_t*)(ws + WS_W_ED), DFF, S, E);
                { const int nun = tile_e[255] * (D / 256); const int first = nun > 2 * G ? nun - 2 * G : 0;
                  TailOrder S2{M / 256, D / 256, G, bid, first < G ? first : 0}; EpiStoreBf16 E2{(bf16_t*)a.out + (size_t)M * D};
                  GEMM(lds, (const bf16_t*)(ws + WS_PB1), (const bf16_t*)(ws + WS_W_PP1), DPLE, S2, E2); } } PHASE_END(true)
            PHASE_BEGIN(0) LAYER_PTRS phase_rowpass<1, 0, 1, true>(lds, nullptr, hb, (const bf16_t*)a.out, nullptr, ssq, nullptr, 0, nullptr, nullptr, nullptr, nullptr, nullptr); PHASE_END(true)
        }
        PHASE_BEGIN(10) LAYER_PTRS { GridOrder S{M / 256, D / 256, G, bid};
            EpiPle E{hb, hbo, l == 0 ? (const bf16_t*)(ws + WS_PP0) : (const bf16_t*)a.out + (size_t)M * D, ssqo, ssq}; GEMM(lds, hb, (const bf16_t*)(ws + WS_W_PG) + (size_t)l * D * D, D, S, E);
            if (l == 0 && bid == 0) { for (int i = otid(); i < D / 2; i += NT) ((unsigned*)(ws + WS_H1 + (size_t)M * D * 2))[i] = 0u; } } PHASE_END(true)
    }
    PHASE_BEGIN(0) phase_rowpass<1, 0, 2, false>(lds, nullptr, hn, nullptr, a.in[I_GFINAL], nullptr, nullptr, 0, nullptr, nullptr, nullptr, nullptr, a.out); PHASE_END(false)
}

extern "C" void kernel_launch(void* const* d_in, const int* in_sizes, int n_in, void* d_out, int out_size,
                              void* d_ws, size_t ws_size, hipStream_t stream) {
    static int grid = 0;
    if (grid == 0) {
        if (n_in != 29 || out_size != M * D || ws_size < WS_END) { fprintf(stderr, "kernel_launch: unexpected problem (n_in %d out %d ws %zu)\n", n_in, out_size, ws_size); grid = -1; return; }
        int dev = 0, cus = 0, per_cu = 0;
        (void)hipGetDevice(&dev);
        (void)hipDeviceGetAttribute(&cus, hipDeviceAttributeMultiprocessorCount, dev);
        (void)hipFuncSetAttribute((const void*)mk_fwd, hipFuncAttributeMaxDynamicSharedMemorySize, LDS_BYTES);
        (void)hipOccupancyMaxActiveBlocksPerMultiprocessor(&per_cu, (const void*)mk_fwd, NT, LDS_BYTES);
        if (per_cu < 1) { fprintf(stderr, "kernel_launch: occupancy query says %d blocks per CU\n", per_cu); per_cu = 1; }
        grid = cus;
    }
    if (grid < 0) return;
    Args a{};
    for (int i = 0; i < 29; ++i) a.in[i] = (const float*)d_in[i];
    a.out = (float*)d_out; a.ws = (unsigned char*)d_ws; a.ph_lo = 0; a.ph_hi = 1000;
    (void)hipMemsetAsync((unsigned char*)d_ws + WS_SMALL + SM_BAR, 0, 16 * 1024, stream);
    void* args[] = {&a};
    hipError_t e = hipLaunchCooperativeKernel((void*)mk_fwd, dim3(grid), dim3(NT), args, LDS_BYTES, stream);
    if (e != hipSuccess) fprintf(stderr, "cooperative launch failed: %s (grid %d)\n", hipGetErrorString(e), grid);
}
```

```cpp
#include <hip/hip_runtime.h>
#include <hip/hip_cooperative_groups.h>
#include <cstdio>
#include <cstdint>
namespace cg = cooperative_groups;

constexpr int NT = 512;
constexpr int D = 1024, NBATCH = 4, SEQ = 4096, M = NBATCH * SEQ;
constexpr int CH = 64, NC = SEQ / CH, NH = 4, DH = 128, DM = 512, DR = 512, NBR = 8, DBR = 64;
constexpr int DIN = 3080, ZW = 3072, DFF = 2816, NE = 8, DPLE = 256;
constexpr int PMAX = 2 * M + NE * 256, NTILE_MAX = PMAX / 256;
constexpr int EROWS = 129;
constexpr float EPS = 1e-6f;
constexpr int ZQ = 0, ZK = 512, ZV = 1024, ZO = 1536, ZXR = 2048, ZYR = 2560;

constexpr size_t MiB = 1u << 20;
constexpr size_t WS_SMALL = 0;
constexpr size_t WS_W_IN0 = 4 * MiB;
constexpr size_t WS_W_OUT0 = 10 * MiB;
constexpr size_t WS_W_FFGU = 12 * MiB;
constexpr size_t WS_W_FFD = 23 * MiB;
constexpr size_t WS_PB0 = WS_W_FFD + 5632 * 1024;
constexpr size_t WS_W_PP0 = WS_PB0 + 8 * MiB;
constexpr size_t WS_H1 = 4 * MiB;
constexpr size_t WS_W_IN1 = 37 * MiB;
constexpr size_t WS_W_OUT1 = 43 * MiB;
constexpr size_t WS_W_PG = 45 * MiB;
constexpr size_t WS_W_PP1 = 49 * MiB;
constexpr size_t WS_W_EGU = WS_W_PP1 + MiB / 2;
constexpr size_t WS_W_ED = WS_W_EGU + 88 * MiB;
constexpr size_t WS_HN8 = WS_W_EGU + 44 * MiB;
constexpr size_t WS_PB1 = WS_W_ED + 44 * MiB;
constexpr size_t WS_HN = WS_PB1 + 8 * MiB;
static_assert(WS_H1 + (size_t)(M + 1) * D * 2 <= WS_W_IN1 && WS_W_PP0 + 1024 * 256 * 2 <= WS_W_IN1, "map");
constexpr size_t WS_RF = 222 * MiB;
constexpr size_t WS_Z = WS_RF;
constexpr size_t WS_CT = WS_Z + 96 * MiB;
constexpr size_t WS_DN = WS_CT + 32 * MiB;
constexpr size_t WS_MIX = WS_CT + 72 * MiB;
constexpr size_t WS_HID = WS_RF;
constexpr size_t WS_PP0 = WS_RF + 130 * MiB;
constexpr size_t WS_SSQ = WS_RF + 201 * MiB;
constexpr size_t SSQ_STRIDE = (size_t)(M + 16) * 64;
constexpr size_t WS_SCAL = WS_RF + 204 * MiB;
constexpr size_t WS_END = 435 * MiB;
static_assert(WS_MIX + (size_t)M * D * 2 <= WS_SSQ && WS_HID + (size_t)PMAX * DFF * 2 <= WS_SSQ && WS_SSQ + 2 * SSQ_STRIDE <= WS_END, "map");
static_assert(WS_HN + (size_t)(M + 1) * D * 2 <= WS_RF, "map");
static_assert(WS_MIX + (size_t)M * D * 2 <= WS_END, "map");
static_assert(WS_HID + (size_t)PMAX * DFF * 2 <= WS_END, "map");
static_assert(WS_DN + 1024 * 128 * 4 <= WS_PP0 && WS_PP0 + (size_t)M * D * 2 <= WS_MIX && WS_HID + (size_t)M * DFF * 2 <= WS_PP0, "map");
constexpr size_t SM_GATES = 0;
constexpr size_t SM_TOKE = 512 * 1024;
constexpr size_t SM_TOKG = SM_TOKE + 128 * 1024;
constexpr size_t SM_ROWTOK = SM_TOKG + 128 * 1024;
constexpr size_t SM_ROWGATE = SM_ROWTOK + 160 * 1024;
constexpr size_t SM_TILEE = SM_ROWGATE + 160 * 1024;
constexpr size_t SM_ROWSLOT = SM_TILEE + 4 * 1024;
constexpr size_t SM_TOKP = SM_ROWSLOT + 160 * 1024;
constexpr size_t SM_BL = SM_TOKP + 16 * 1024;
constexpr size_t SM_AMAX = SM_BL + 4 * 1024;
constexpr size_t SM_MPREV = SM_AMAX + 4 * 1024;
constexpr size_t SM_RGA = 2 * MiB;
constexpr size_t SM_RGH = SM_RGA + 512 * 1024;
constexpr size_t SM_RGP = SM_RGH + 512 * 1024;
constexpr size_t SM_BAR = SM_RGP + 512 * 1024;
constexpr size_t SM_RGW = SM_BAR + 16 * 1024;
static_assert(SM_MPREV + 4096 <= SM_RGA && SM_RGW + 256 * 1024 <= 4 * MiB, "small map");

constexpr int LDS_BYTES = 147456;

typedef unsigned short bf16_t;
typedef float f32x4 __attribute__((ext_vector_type(4)));
typedef unsigned u32x4 __attribute__((ext_vector_type(4)));
typedef unsigned u32x2 __attribute__((ext_vector_type(2)));

__device__ __forceinline__ float bf2f(unsigned v) { return __uint_as_float(v << 16); }
__device__ __forceinline__ unsigned pk2(float lo, float hi);
__device__ __forceinline__ unsigned f2bf(float f) { return pk2(f, 0.f) & 0xffffu; }
typedef float f32x2_t __attribute__((ext_vector_type(2))); typedef __bf16 bf16x2_t __attribute__((ext_vector_type(2)));
__device__ __forceinline__ unsigned pk2(float lo, float hi) { f32x2_t v = {lo, hi}; bf16x2_t b = __builtin_convertvector(v, bf16x2_t); return __builtin_bit_cast(unsigned, b); }
__device__ __forceinline__ unsigned pk4_fp8(float a, float b, float c, float d) { int w = __builtin_amdgcn_cvt_pk_fp8_f32(a, b, 0, false); w = __builtin_amdgcn_cvt_pk_fp8_f32(c, d, w, true); return (unsigned)w; }
__device__ __forceinline__ float frcp(float x) { return __builtin_amdgcn_rcpf(x); }
__device__ __forceinline__ float sigmoidf_(float x) { return frcp(1.f + __expf(-x)); }
__device__ __forceinline__ float siluf_(float x) { return x * frcp(1.f + __expf(-x)); }
__device__ __forceinline__ float logsigmoidf_(float x) { return fminf(x, 0.f) - log1pf(__expf(-fabsf(x))); }
__device__ __forceinline__ float gelu_tanh(float y) { const float u2 = 1.5957691216057308f * (y + 0.044715f * y * y * y); return y * frcp(1.f + __expf(-u2)); }
__device__ __forceinline__ float wave_sum(float v) {
#pragma unroll
    for (int o = 1; o < 64; o <<= 1) v += __shfl_xor(v, o);
    return v;
}
__device__ __forceinline__ float wave_max(float v) {
#pragma unroll
    for (int o = 1; o < 64; o <<= 1) v = fmaxf(v, __shfl_xor(v, o));
    return v;
}

__device__ __forceinline__ float dpp_f(float v, const int ctrl_sel) {
    const int x = __float_as_int(v); int r;
    if (ctrl_sel == 0) r = __builtin_amdgcn_update_dpp(x, x, 0xB1, 0xF, 0xF, false);
    else if (ctrl_sel == 1) r = __builtin_amdgcn_update_dpp(x, x, 0x4E, 0xF, 0xF, false);
    else if (ctrl_sel == 2) r = __builtin_amdgcn_update_dpp(x, x, 0x141, 0xF, 0xF, false);
    else r = __builtin_amdgcn_update_dpp(x, x, 0x140, 0xF, 0xF, false);
    return __int_as_float(r);
}
__device__ __forceinline__ float sum4(float v) { v += dpp_f(v, 0); v += dpp_f(v, 1); return v; }
__device__ __forceinline__ float sum8(float v) { v = sum4(v); v += dpp_f(v, 2); return v; }
__device__ __forceinline__ float sum16(float v) { v = sum8(v); v += dpp_f(v, 3); return v; }
#define WAVE_LDS_SYNC() asm volatile("s_waitcnt lgkmcnt(0)" ::: "memory")
#define LDS_BARRIER() do { asm volatile("s_waitcnt lgkmcnt(0)" ::: "memory"); __builtin_amdgcn_s_barrier(); asm volatile("" ::: "memory"); } while (0)
__device__ __forceinline__ int otid() { int t = threadIdx.x; asm volatile("" : "+v"(t)); return t; }
__device__ __forceinline__ int oint(int v) { asm volatile("" : "+s"(v)); return v; }
__device__ __forceinline__ const void* okarg() { auto p = __builtin_amdgcn_kernarg_segment_ptr(); asm volatile("" : "+s"(p)); return (const void*)p; }

struct Args { const float* in[29]; float* out; unsigned char* ws; int ph_lo, ph_hi; };
enum { I_X = 0, I_P, I_GMIX, I_WIN, I_BIN, I_WCQK, I_BCQK, I_GMH, I_WCR, I_BCR, I_WRA, I_BRA, I_WRI, I_BRI, I_LAM, I_GR, I_WOUT, I_GFFN,
       I_WFG, I_WFU, I_WFD, I_WROUTER, I_WEG, I_WEU, I_WED, I_GPLE, I_WPG, I_WPP, I_GFINAL };


#define XB_TMO      128
#define XB_XCNT(j)  (256  + 64 * (j))
#define XB_XSUB(j)  (1280 + 64 * (j))
#define XB_XGEN(j)  (2304 + 64 * (j))
#define XB_TOP      3328
#define XB_TOPGEN   3392
#define XCD_BAR_WORDS 3456
#define XB_SPIN_CAP (1u << 18)
#define LAS __attribute__((address_space(3)))
__device__ __forceinline__ unsigned xb_ld(unsigned* p)              { return __hip_atomic_load(p, __ATOMIC_RELAXED, __HIP_MEMORY_SCOPE_AGENT); }
__device__ __forceinline__ unsigned xb_add(unsigned* p, unsigned v) { return __hip_atomic_fetch_add(p, v, __ATOMIC_RELAXED, __HIP_MEMORY_SCOPE_AGENT); }
__device__ __forceinline__ unsigned xb_xcc_id() { return (unsigned)__builtin_amdgcn_s_getreg((3 << 11) | 20) & 0xFu; }
#define XB_SPIN(cond, bar) do { unsigned _sp = 0; while (cond) { __builtin_amdgcn_s_sleep(1); \
    if ((++_sp & 255u) == 0u) { if (xb_ld(&(bar)[XB_TMO])) break; if (_sp > XB_SPIN_CAP) { atomicAdd(&(bar)[XB_TMO], 1u); break; } } } } while (0)
struct XcdBarrier { unsigned* bar; unsigned x; volatile LAS unsigned* st; };
__device__ __forceinline__ XcdBarrier xcd_barrier_post(unsigned* bar, volatile LAS unsigned* st) {
    XcdBarrier b; b.bar = bar; b.x = xb_xcc_id(); b.st = st;
    if (threadIdx.x == 0) (void)xb_add(&bar[XB_XCNT(b.x)], 1u);
    return b;
}
__device__ __forceinline__ void xcd_barrier_complete(unsigned* bar, unsigned x, unsigned& nloc, unsigned& nx) {
    const unsigned G = gridDim.x * gridDim.y * gridDim.z;
    unsigned sum, cnt, mine, sp = 0u;
    for (;;) {
        sum = 0u; cnt = 0u; mine = 0u;
#pragma unroll
        for (unsigned j = 0; j < 16; ++j) { const unsigned c = xb_ld(&bar[XB_XCNT(j)]); sum += c; cnt += (c > 0u) ? 1u : 0u; mine = (j == x) ? c : mine; }
        if (sum == G) break;
        __builtin_amdgcn_s_sleep(1);
        if ((++sp & 255u) == 0u) { if (xb_ld(&bar[XB_TMO])) break; if (sp > XB_SPIN_CAP) { atomicAdd(&bar[XB_TMO], 1u); break; } }
    }
    nloc = mine > 0u ? mine : 1u; nx = cnt > 0u ? cnt : 1u;
}
__device__ __forceinline__ void xcd_barrier(const XcdBarrier& b) {
    asm volatile("s_waitcnt vmcnt(0)" ::: "memory");
    __syncthreads();
    if (threadIdx.x == 0) {
        unsigned* bar = b.bar;
        __builtin_amdgcn_s_waitcnt(0);
        unsigned nloc = b.st[0], nx = b.st[1];
        if (nloc == 0u) { xcd_barrier_complete(bar, b.x, nloc, nx); b.st[0] = nloc; b.st[1] = nx; }
        const unsigned old = xb_add(&bar[XB_XSUB(b.x)], 1u);
        const unsigned gen = old / nloc;
        if (old + 1u == (gen + 1u) * nloc) {
            __builtin_amdgcn_fence(__ATOMIC_RELEASE, "agent");
            asm volatile("s_waitcnt vmcnt(0)" ::: "memory");
            const unsigned og = xb_add(&bar[XB_TOP], 1u);
            const unsigned tg = og / nx;
            if (og + 1u == (tg + 1u) * nx) xb_add(&bar[XB_TOPGEN], 1u);
            else XB_SPIN(xb_ld(&bar[XB_TOPGEN]) == tg, bar);
            __builtin_amdgcn_fence(__ATOMIC_ACQUIRE, "agent");
            xb_add(&bar[XB_XGEN(b.x)], 1u);
            asm volatile("s_waitcnt vmcnt(0)" ::: "memory");
        } else {
            XB_SPIN(xb_ld(&bar[XB_XGEN(b.x)]) == gen, bar);
            __builtin_amdgcn_fence(__ATOMIC_ACQUIRE, "agent");
            asm volatile("s_waitcnt vmcnt(0)" ::: "memory");
        }
    }
    __syncthreads();
}

struct CvtJob { const float* src; bf16_t* dst; int ld, k0, c0, K, n0; const float* gain; int fp8; };
__device__ __forceinline__ void cvt_plain_job(CvtJob& o, const float* src, int K, int N, bf16_t* dst, int tile, const float* gain) {
    const int nt = N / 64, kb = tile / nt, nb = tile % nt; o.src = src; o.dst = dst; o.ld = N; o.k0 = kb * 64; o.c0 = nb * 64; o.K = K; o.n0 = nb * 64; o.gain = gain; o.fp8 = 0;
}
__device__ __forceinline__ void cvt_gu_job(CvtJob& o, const float* g, const float* u, bf16_t* dst, int tile, const float* gain) {
    const int nt = 5632 / 64, kb = tile / nt, nb = tile % nt, n0 = nb * 64, tt = n0 >> 8, half = (n0 >> 7) & 1, w = n0 & 127;
    o.src = half ? u : g; o.dst = dst; o.ld = DFF; o.k0 = kb * 64; o.c0 = tt * 128 + w; o.K = 1024; o.n0 = n0; o.gain = gain; o.fp8 = 0;
}
__device__ __forceinline__ int cvt_tile2x2(int tile, int nt) { const int grp = tile >> 2, sub = tile & 3, gpr = nt >> 1; return ((grp / gpr) * 2 + (sub >> 1)) * nt + (grp % gpr) * 2 + (sub & 1); }
__device__ __forceinline__ void cvt_job(const Args& a, int it, CvtJob& o) {
    unsigned char* ws = a.ws;
    constexpr int T_IN = 16 * 48, T_OUT = 16 * 16, T_GU = 16 * 88, T_FD = 44 * 16, T_PG = 256, T_PP = 4 * 16;
    int r = it;
    if (r < 2 * T_IN) { const int l = r / T_IN, tile = r % T_IN; const int nt = ZW / 64, kb = tile / nt, nb = tile % nt, n0 = nb * 64;
        o.src = a.in[I_WIN] + (size_t)l * D * DIN; o.dst = (bf16_t*)(ws + (l ? WS_W_IN1 : WS_W_IN0)); o.ld = DIN; o.k0 = kb * 64; o.c0 = n0 < 2048 ? n0 : n0 + 8; o.K = D; o.n0 = n0; o.gain = a.in[I_GMIX] + l * D; o.fp8 = 0; return; }
    r -= 2 * T_IN;
    if (r < 2 * T_OUT) { const int l = r / T_OUT; cvt_plain_job(o, a.in[I_WOUT] + (size_t)l * D * D, D, D, (bf16_t*)(ws + (l ? WS_W_OUT1 : WS_W_OUT0)), r % T_OUT, nullptr); return; }
    r -= 2 * T_OUT;
    if (r < T_GU) { cvt_gu_job(o, a.in[I_WFG], a.in[I_WFU], (bf16_t*)(ws + WS_W_FFGU), r, a.in[I_GFFN]); return; }
    r -= T_GU;
    if (r < T_FD) { cvt_plain_job(o, a.in[I_WFD], DFF, D, (bf16_t*)(ws + WS_W_FFD), r, nullptr); return; }
    r -= T_FD;
    if (r < 2 * T_PG) { const int l = r / T_PG; cvt_plain_job(o, a.in[I_WPG] + (size_t)l * D * D, D, D, (bf16_t*)(ws + WS_W_PG) + (size_t)l * D * D, r % T_PG, a.in[I_GPLE] + l * D); return; }
    r -= 2 * T_PG;
    if (r < 2 * T_PP) { const int l = r / T_PP; cvt_plain_job(o, a.in[I_WPP] + (size_t)l * DPLE * D, DPLE, D, (bf16_t*)(ws + (l ? WS_W_PP1 : WS_W_PP0)), r % T_PP, nullptr); return; }
    r -= 2 * T_PP;
    if (r < 8 * T_GU) { const int e = r / T_GU; cvt_gu_job(o, a.in[I_WEG] + (size_t)e * D * DFF, a.in[I_WEU] + (size_t)e * D * DFF, (bf16_t*)(ws + WS_W_EGU + (size_t)e * 5632 * D), cvt_tile2x2(r % T_GU, 5632 / 64), nullptr); o.fp8 = 1; return; }
    r -= 8 * T_GU;
    { const int e = r / T_FD; cvt_plain_job(o, a.in[I_WED] + (size_t)e * DFF * D, DFF, D, (bf16_t*)(ws + WS_W_ED + (size_t)e * D * DFF), cvt_tile2x2(r % T_FD, D / 64), nullptr); o.fp8 = 1; }
}
__device__ __forceinline__ void phase_prologue(const Args& a, unsigned char* lds) {
    unsigned char* ws = a.ws;
    const int G = gridDim.x, t = otid();
    constexpr int T_IN = 16 * 48, T_OUT = 16 * 16, T_GU = 16 * 88, T_FD = 44 * 16, T_PG = 256, T_PP = 4 * 16;
    constexpr int NT_ALL = 2 * T_IN + 2 * T_OUT + T_GU + T_FD + 2 * T_PG + 2 * T_PP + 8 * T_GU + 8 * T_FD;
    constexpr int NB = 4;
    const int kk0 = t >> 4, cc = (t & 15) * 4, n = t >> 3, kg = t & 7;
    float4 v[NB][2], vn[NB][2];
    int it0 = blockIdx.x * NB;
    if (it0 < NT_ALL) {
#pragma unroll
        for (int b = 0; b < NB; ++b) { const int it = it0 + b < NT_ALL ? it0 + b : NT_ALL - 1; CvtJob jq; cvt_job(a, it, jq);
#pragma unroll
            for (int j = 0; j < 2; ++j) v[b][j] = *(const float4*)(jq.src + (size_t)(jq.k0 + kk0 + 32 * j) * jq.ld + jq.c0 + cc); }
    }
    for (; it0 < NT_ALL; it0 += G * NB) {
        const int itn = it0 + G * NB;
        if (itn < NT_ALL) {
#pragma unroll
            for (int b = 0; b < NB; ++b) { const int it = itn + b < NT_ALL ? itn + b : NT_ALL - 1; CvtJob jq; cvt_job(a, it, jq);
#pragma unroll
                for (int j = 0; j < 2; ++j) vn[b][j] = *(const float4*)(jq.src + (size_t)(jq.k0 + kk0 + 32 * j) * jq.ld + jq.c0 + cc); }
        }
#pragma unroll
        for (int b = 0; b < NB; ++b) { float* tl = (float*)lds + b * (64 * 65); const int it = it0 + b < NT_ALL ? it0 + b : NT_ALL - 1; CvtJob jq; cvt_job(a, it, jq);
#pragma unroll
            for (int j = 0; j < 2; ++j) { float4 w = v[b][j];
                if (jq.gain) { const float gk = jq.gain[jq.k0 + kk0 + 32 * j]; w.x *= gk; w.y *= gk; w.z *= gk; w.w *= gk; }
                float* p = tl + (kk0 + 32 * j) * 65 + cc; p[0] = w.x; p[1] = w.y; p[2] = w.z; p[3] = w.w; } }
        LDS_BARRIER();
#pragma unroll
        for (int b = 0; b < NB; ++b) { if (it0 + b >= NT_ALL) break; const float* s_ = (const float*)lds + b * (64 * 65) + (8 * kg) * 65 + n; CvtJob jq; cvt_job(a, it0 + b, jq);
            if (jq.fp8) { u32x2 o; o.x = pk4_fp8(32.f * s_[0], 32.f * s_[65], 32.f * s_[130], 32.f * s_[195]); o.y = pk4_fp8(32.f * s_[260], 32.f * s_[325], 32.f * s_[390], 32.f * s_[455]);
                *(u32x2*)((unsigned char*)jq.dst + (size_t)(jq.n0 + n) * jq.K + jq.k0 + 8 * kg) = o; }
            else { u32x4 o; o.x = pk2(s_[0], s_[65]); o.y = pk2(s_[130], s_[195]); o.z = pk2(s_[260], s_[325]); o.w = pk2(s_[390], s_[455]);
                *(u32x4*)(jq.dst + (size_t)(jq.n0 + n) * jq.K + jq.k0 + 8 * kg) = o; } }
        LDS_BARRIER();
#pragma unroll
        for (int b = 0; b < NB; ++b) { v[b][0] = vn[b][0]; v[b][1] = vn[b][1]; }
    }
    const size_t np4 = (size_t)M * DPLE / 4;
    for (size_t i = (size_t)blockIdx.x * NT + otid(); i < 2 * np4; i += (size_t)G * NT) {
        const float4 v = ((const float4*)a.in[I_P])[i]; u32x2 o; o.x = pk2(v.x, v.y); o.y = pk2(v.z, v.w);
        if (i < np4) ((u32x2*)(ws + WS_PB0))[i] = o; else ((u32x2*)(ws + WS_PB1))[i - np4] = o; }
    for (int i = blockIdx.x * NT + otid(); i < 2 * 8 * 2 * 64 * 64; i += G * NT) {
        const int d = i & 63, e = (i >> 6) & 63, g = (i >> 12) & 1, ln = i >> 13;
        ((bf16_t*)(ws + WS_SMALL + SM_RGW))[i] = (bf16_t)f2bf((g ? a.in[I_WRI] : a.in[I_WRA])[((size_t)ln * 64 + d) * 64 + e]);
    }
    if (blockIdx.x == 0) { for (int i = otid(); i < D / 4; i += NT) ((unsigned*)(ws + WS_HN8 + (size_t)M * D))[i] = 0u; for (int i = otid(); i < D / 2; i += NT) ((unsigned*)(ws + WS_HN + (size_t)M * D * 2))[i] = 0u; if (otid() < 32) ((float*)(ws + WS_SSQ + (otid() >> 4) * SSQ_STRIDE))[(size_t)M * 16 + (otid() & 15)] = 0.f; }
    for (int i = blockIdx.x * NT + otid(); i < PMAX; i += G * NT) { ((int*)(ws + WS_SMALL + SM_ROWTOK))[i] = M; ((float*)(ws + WS_SMALL + SM_ROWGATE))[i] = 0.f; }
}

template <int IN, bool ADDY> struct RawRow {
    f32x4 x[IN == 0 ? 4 : 1]; u32x2 h[IN == 1 ? 4 : 1]; u32x2 y[ADDY ? 4 : 1];
    __device__ __forceinline__ void load(const float* xin, const bf16_t* hb, const bf16_t* y1, int r, int lane) {
#pragma unroll
        for (int j = 0; j < 4; ++j) {
            if (IN == 0) x[j] = ((const f32x4*)(xin + (size_t)r * D) + lane)[64 * j]; else h[j] = ((const u32x2*)(hb + (size_t)r * D) + lane)[64 * j];
            if (ADDY) y[j] = ((const u32x2*)(y1 + (size_t)r * D) + lane)[64 * j]; }
    }
    __device__ __forceinline__ void copy_from(const RawRow& o) {
#pragma unroll
        for (int j = 0; j < 4; ++j) { if (IN == 0) x[j] = o.x[j]; else h[j] = o.h[j]; if (ADDY) y[j] = o.y[j]; }
    }
};
template <int IN, int AUX, int WR, bool ADDY>
__device__ __forceinline__ void phase_rowpass(unsigned char* lds, const float* xin, bf16_t* hb, const bf16_t* y1, const float* g, float* ssq,
                                              const float* auxW, int auxld, const float* auxB, float* gates, unsigned char* tok_p, float* tok_g, float* fout, unsigned char* h8 = nullptr) {
    float* wl = (float*)lds;
    const int tid = otid(), lane = tid & 63, wave = tid >> 6;
    if (AUX) {
        for (int i = tid; i < D * 8; i += NT) wl[i] = auxW[(size_t)(i >> 3) * auxld + (i & 7)];
        __syncthreads();
    }
    f32x4 gv[4];
    if (AUX || WR == 2) {
#pragma unroll
        for (int j = 0; j < 4; ++j) gv[j] = *(const f32x4*)(g + 4 * lane + 256 * j);
    }
    RawRow<1, ADDY> cur, nxt;
    const int rstep = gridDim.x * 8; int row = blockIdx.x * 8 + wave;
    if (IN == 1) { if (row < M) cur.load(xin, hb, y1, row, lane); nxt.copy_from(cur); }
    for (; row < M; row += rstep) {
        if (IN == 1) { if (row + rstep < M) nxt.load(xin, hb, y1, row + rstep, lane); }
        f32x4 v[4]; float ss = 0.f;
#pragma unroll
        for (int j = 0; j < 4; ++j) {
            if (IN == 0) v[j] = ((const f32x4*)(xin + (size_t)row * D) + lane)[64 * j];
            else { const u32x2 w = cur.h[j]; v[j] = (f32x4){bf2f(w.x & 0xffffu), __uint_as_float(w.x & 0xffff0000u), bf2f(w.y & 0xffffu), __uint_as_float(w.y & 0xffff0000u)}; }
            if (ADDY) { const u32x2 y = cur.y[j];
                v[j].x += bf2f(y.x & 0xffffu); v[j].y += __uint_as_float(y.x & 0xffff0000u); v[j].z += bf2f(y.y & 0xffffu); v[j].w += __uint_as_float(y.y & 0xffff0000u); }
            ss += (v[j].x * v[j].x + v[j].y * v[j].y) + (v[j].z * v[j].z + v[j].w * v[j].w); }
        if (IN == 1) cur.copy_from(nxt);
        float tot; { const int ri = __float_as_int(sum16(ss)); tot = (__int_as_float(__builtin_amdgcn_readlane(ri, 0)) + __int_as_float(__builtin_amdgcn_readlane(ri, 16))) + (__int_as_float(__builtin_amdgcn_readlane(ri, 32)) + __int_as_float(__builtin_amdgcn_readlane(ri, 48))); }
        const float rstd = __builtin_amdgcn_rsqf(tot * (1.f / D) + EPS);
        if (WR == 1) {
            u32x2* o = (u32x2*)(hb + (size_t)row * D) + lane;
#pragma unroll
            for (int j = 0; j < 4; ++j) { u32x2 w; w.x = pk2(v[j].x, v[j].y); w.y = pk2(v[j].z, v[j].w); o[64 * j] = w; }
            if (lane < 16) ssq[(size_t)row * 16 + lane] = lane == 0 ? tot : 0.f;
        }
        if (AUX || WR == 2) {
#pragma unroll
            for (int j = 0; j < 4; ++j) v[j] = v[j] * rstd * gv[j];
        }
        if (AUX == 2 && h8) {
#pragma unroll
            for (int j = 0; j < 4; ++j) ((unsigned*)(h8 + (size_t)row * D) + lane)[64 * j] = pk4_fp8(v[j].x, v[j].y, v[j].z, v[j].w);
        }
        if (WR == 2) {
            f32x4* o = (f32x4*)(fout + (size_t)row * D) + lane;
#pragma unroll
            for (int j = 0; j < 4; ++j) o[64 * j] = v[j];
        }
        if (AUX) {
            float acc[8];
#pragma unroll
            for (int c = 0; c < 8; ++c) acc[c] = 0.f;
#pragma unroll
            for (int j = 0; j < 4; ++j)
#pragma unroll
                for (int q = 0; q < 4; ++q) {
                    const int k = 4 * lane + 256 * j + q; const float xv = v[j][q];
                    const f32x4 w0 = *(const f32x4*)(wl + k * 8), w1 = *(const f32x4*)(wl + k * 8 + 4);
                    acc[0] += xv * w0.x; acc[1] += xv * w0.y; acc[2] += xv * w0.z; acc[3] += xv * w0.w;
                    acc[4] += xv * w1.x; acc[5] += xv * w1.y; acc[6] += xv * w1.z; acc[7] += xv * w1.w;
                }
#pragma unroll
            for (int c = 0; c < 8; ++c) { const float r16 = sum16(acc[c]); const int ri = __float_as_int(r16);
                acc[c] = (__int_as_float(__builtin_amdgcn_readlane(ri, 0)) + __int_as_float(__builtin_amdgcn_readlane(ri, 16))) + (__int_as_float(__builtin_amdgcn_readlane(ri, 32)) + __int_as_float(__builtin_amdgcn_readlane(ri, 48))); }
            if (AUX == 1) {
                if (lane < 8) { float s_ = acc[0];
#pragma unroll
                    for (int c = 1; c < 8; ++c) s_ = (lane == c) ? acc[c] : s_;
                    gates[(size_t)row * 8 + lane] = s_ + auxB[lane]; }
            } else {
                if (lane == 0) {
                    int e1 = 0; float v1 = acc[0];
#pragma unroll
                    for (int c = 1; c < 8; ++c) if (acc[c] > v1) { v1 = acc[c]; e1 = c; }
                    int e2 = -1; float v2 = -INFINITY;
#pragma unroll
                    for (int c = 0; c < 8; ++c) if (c != e1 && acc[c] > v2) { v2 = acc[c]; e2 = c; }
                    const float p2 = __expf(v2 - v1), inv = 1.f / (1.f + p2);
                    tok_p[row] = (unsigned char)(e1 | (e2 << 4)); tok_g[row * 2] = inv; tok_g[row * 2 + 1] = p2 * inv;
                }
            }
        }
    }
    __syncthreads();
}

struct Unit { int pm, pn; const int* rows; size_t bofs; };
struct GridOrder {
    static constexpr bool GATHER = false;
    int nM, nN, G, c;
    __device__ __forceinline__ bool next(int i, Unit& u) const {
        const int L0_ = i * G + c, nwg = nM * nN; if (L0_ >= nwg) return false;
        const int q_ = nwg / 8, r_ = nwg % 8, xcd = L0_ % 8, off = L0_ / 8; const int L = (xcd < r_ ? xcd * (q_ + 1) : r_ * (q_ + 1) + (xcd - r_) * q_) + off;
        const int grp = L / (8 * nN), fm = grp * 8, gsz = (nM - fm) < 8 ? (nM - fm) : 8, w = L % (8 * nN);
        u.pm = fm + w % gsz; u.pn = w / gsz; u.rows = nullptr; u.bofs = 0; return true;
    }
};
struct TailOrder {
    static constexpr bool GATHER = false;
    int nM, nN, G, c, first;
    __device__ __forceinline__ bool next(int i, Unit& u) const {
        if (c < first) return false; const int L = i * (G - first) + (c - first); if (L >= nM * nN) return false;
        u.pm = L / nN; u.pn = L % nN; u.rows = nullptr; u.bofs = 0; return true;
    }
};
template <bool GATHER_> struct MoeOrder {
    static constexpr bool GATHER = GATHER_;
    int nM, nN, G, c; const int* rows; size_t estride; int te[8];
    __device__ __forceinline__ void init(const int* tile_e) {
#pragma unroll
        for (int e = 0; e < 8; ++e) te[e] = __builtin_amdgcn_readfirstlane(tile_e[256 + e]);
    }
    __device__ __forceinline__ bool next(int i, Unit& u) const {
        const int L0_ = i * G + c, nwg = nM * nN; if (L0_ >= nwg) return false;
        const int q_ = nwg / 8, r_ = nwg % 8, xcd = L0_ % 8, off = L0_ / 8; const int L = (xcd < r_ ? xcd * (q_ + 1) : r_ * (q_ + 1) + (xcd - r_) * q_) + off;
        const int grp = L / (8 * nN), fm = grp * 8, gsz = (nM - fm) < 8 ? (nM - fm) : 8, w = L % (8 * nN);
        u.pm = fm + w % gsz; u.pn = w / gsz; u.rows = rows; int e = 0;
#pragma unroll
        for (int q = 0; q < 7; ++q) e += (u.pm >= te[q]) ? 1 : 0;
        u.bofs = (size_t)e * estride; return true;
    }
};


namespace pg8 {
#define PG8_LAS __attribute__((address_space(3)))
typedef short bf16x8 __attribute__((ext_vector_type(8)));
constexpr int BM = 256, BK = 64, HALF = 128, HTB = HALF * BK * 2, STAGE_BYTES = 8 * HTB;
__device__ __forceinline__ int lds_byte(int r, int c) { const int st = (r >> 4) * 2 + (c >> 5), rr = r & 15, cc = c & 31, ob = rr * 64 + cc * 2; return st * 1024 + (ob ^ (((ob >> 9) & 1) << 5)); }
__device__ __forceinline__ void stage_rc(int b, int& R, int& C) { const int st = b / 1024, sb = b % 1024, swz = sb ^ (((sb >> 9) & 1) << 5); R = (st >> 1) * 16 + swz / 64; C = (st & 1) * 32 + (swz % 64) / 2; }

typedef int i32x8 __attribute__((ext_vector_type(8))); typedef int i32x4 __attribute__((ext_vector_type(4)));
__device__ __forceinline__ i32x8 cat8(bf16x8 lo, bf16x8 hi) { return __builtin_shufflevector(__builtin_bit_cast(i32x4, lo), __builtin_bit_cast(i32x4, hi), 0, 1, 2, 3, 4, 5, 6, 7); }
__device__ __forceinline__ int perm32(int rho) { const int n = rho >> 4, i = rho & 15; return 8 * (i >> 2) + 4 * n + (i & 3); }
__device__ __forceinline__ void unit_voff(const Unit& u, const int (&R)[2], const int (&C)[2], int KB  , unsigned (&vo)[2][2]) {
#pragma unroll
    for (int h = 0; h < 2; ++h)
#pragma unroll
        for (int i = 0; i < 2; ++i) { int row = u.pm * BM + h * HALF + R[i]; if (u.rows) row = u.rows[row]; vo[h][i] = (unsigned)row * (unsigned)KB + (unsigned)C[i] * 2u; }
}

template <class Epi, class Sched, bool ALIGN_EPI, bool GATHER, bool FP8 = false>
__device__ __forceinline__ void gemm_phase(unsigned char* lds_, const bf16_t* A_, const bf16_t* Bt_, const int K_, const Sched& S, const Epi& E) {
    PG8_LAS unsigned char* lds = (PG8_LAS unsigned char*)lds_;
    const int K = oint(K_);
    const int tid = otid(), wid = __builtin_amdgcn_readfirstlane(tid >> 6), lane = tid & 63, wr = wid >> 2, wc = wid & 3, fr = lane & 15, fq = lane >> 4;
    const int KB = FP8 ? K : 2 * K;
    const int nt = KB / (BK * 2);
    int R[2], C[2]; unsigned voffA[2], voffB[2];
#pragma unroll
    for (int i = 0; i < 2; ++i) { stage_rc(tid * 16 + i * 8192, R[i], C[i]); voffA[i] = (unsigned)(R[i] * KB + C[i] * 2);
        const int Rb = Epi::PERM ? ((R[i] & ~31) + perm32(R[i] & 31)) : R[i]; voffB[i] = (unsigned)(Rb * KB + C[i] * 2); }
    const size_t kstep = (size_t)(BK * 2);
    const size_t hstep = (size_t)HALF * KB;
    const size_t tstep = 2 * hstep;
    const unsigned ldsw = (unsigned)wid * 1024u;
    const int pc0 = FP8 ? 32 * (fq >> 1) + 16 * (fq & 1) : fq * 8; constexpr int KOFF = FP8 ? 16 : 1024;
    const int aoff = lds_byte(wr * 64 + fr, pc0), boff = lds_byte(wc * 32 + fr, pc0);
#define PG8_SA(b, h) (((b) * 2 + (h)) * HTB)
#define PG8_SB(b, h) ((4 + (b) * 2 + (h)) * HTB)
#define PG8_STAGE(bufoff, gbase, voff) do { _Pragma("unroll") for (int _i = 0; _i < 2; ++_i) \
        __builtin_amdgcn_global_load_lds((const unsigned*)((const char*)(gbase) + (voff)[_i]), (PG8_LAS unsigned*)(lds + (bufoff) + ldsw + _i * 8192), 16, 0, 0); } while (0)
#define PG8_STAGE_A(bufoff, base, h, VO) do { if constexpr (GATHER) { PG8_STAGE(bufoff, base, (VO)[h]); } else { PG8_STAGE(bufoff, (base) + (h) * hstep, voffA); } } while (0)
#define PG8_LDA(dst, b, h) do { _Pragma("unroll") for (int m = 0; m < 4; ++m) _Pragma("unroll") for (int k = 0; k < 2; ++k) dst[m][k] = *(const PG8_LAS bf16x8*)(lds + PG8_SA(b, h) + aoff + m * 2048 + k * KOFF); } while (0)
#define PG8_LDB(dst, b, h) do { _Pragma("unroll") for (int n = 0; n < 2; ++n) _Pragma("unroll") for (int k = 0; k < 2; ++k) dst[n][k] = *(const PG8_LAS bf16x8*)(lds + PG8_SB(b, h) + boff + n * 2048 + k * KOFF); } while (0)
#define PG8_MMA(ai, bj, At, Bt) do { __builtin_amdgcn_s_setprio(1); _Pragma("unroll") for (int m = 0; m < 4; ++m) _Pragma("unroll") for (int n = 0; n < 2; ++n) { \
        if constexpr (FP8) { const i32x8 b8_ = cat8(Bt[n][0], Bt[n][1]), a8_ = cat8(At[m][0], At[m][1]); \
            asm volatile("v_mfma_scale_f32_16x16x128_f8f6f4 %0, %1, %2, %0, %3, %3 op_sel_hi:[0,0,0]" : "+v"(acc[ai][bj][m][n]) : "v"(b8_), "v"(a8_), "v"(scale1)); } \
        else { _Pragma("unroll") for (int k = 0; k < 2; ++k) acc[ai][bj][m][n] = __builtin_amdgcn_mfma_f32_16x16x32_bf16(Bt[n][k], At[m][k], acc[ai][bj][m][n], 0, 0, 0); } } __builtin_amdgcn_s_setprio(0); } while (0)
#define PG8_WAIT_V(n) asm volatile("s_waitcnt vmcnt(" #n ")" ::: "memory")
#define PG8_WAIT_L(n) asm volatile("s_waitcnt lgkmcnt(" #n ")" ::: "memory")
#define PG8_BAR __builtin_amdgcn_s_barrier()
#define PG8_SCHED __builtin_amdgcn_sched_barrier(0)
    const int scale1 = 0x7f7f7f7f;
    Unit cur, nxt; int ui = 0;
    if (!S.next(0, cur)) return;
    f32x4 acc[2][2][4][2];
#pragma unroll
    for (int a = 0; a < 2; ++a)
#pragma unroll
        for (int b = 0; b < 2; ++b)
#pragma unroll
            for (int m = 0; m < 4; ++m)
#pragma unroll
                for (int n = 0; n < 2; ++n) acc[a][b][m][n] = (f32x4){0.f, 0.f, 0.f, 0.f};
    bf16x8 At[4][2], B0[2][2], B1[2][2];
    unsigned vc[2][2], vn[2][2];
    if constexpr (GATHER) unit_voff(cur, R, C, KB, vc);
    const char* cA = GATHER ? (const char*)A_ : (const char*)A_ + (size_t)cur.pm * tstep;
    const char* cB = (const char*)Bt_ + cur.bofs * (FP8 ? 1 : 2) + (size_t)cur.pn * tstep;
    PG8_STAGE(PG8_SB(0, 0), cB, voffB); PG8_STAGE(PG8_SB(0, 1), cB + hstep, voffB); PG8_STAGE_A(PG8_SA(0, 0), cA, 0, vc); PG8_STAGE_A(PG8_SA(0, 1), cA, 1, vc);
    if (wr == 1) PG8_BAR;
    PG8_WAIT_V(2); PG8_BAR;
    PG8_STAGE(PG8_SB(1, 0), cB + kstep, voffB); PG8_STAGE_A(PG8_SA(1, 0), cA + kstep, 0, vc); PG8_STAGE(PG8_SB(1, 1), cB + hstep + kstep, voffB);
    PG8_WAIT_V(6); PG8_BAR;
    for (;;) {
        const bool has_next = S.next(ui + 1, nxt);
        const char* nA = cA; const char* nB = cB;
        if (has_next) { nB = (const char*)Bt_ + nxt.bofs * (FP8 ? 1 : 2) + (size_t)nxt.pn * tstep; if constexpr (!GATHER) nA = (const char*)A_ + (size_t)nxt.pm * tstep; }
        int rn[2][2];
        if constexpr (GATHER) {
#pragma unroll
            for (int h = 0; h < 2; ++h)
#pragma unroll
                for (int i = 0; i < 2; ++i) rn[h][i] = cur.rows[(has_next ? nxt.pm : cur.pm) * BM + h * HALF + R[i]]; }
        for (int t = 0; t < nt; t += 2) {
            const bool last = (t == nt - 2);
            if constexpr (GATHER) { if (last) {
#pragma unroll
                for (int h = 0; h < 2; ++h)
#pragma unroll
                    for (int i = 0; i < 2; ++i) { int r_ = rn[h][i]; asm volatile("" : "+v"(r_));
                        vn[h][i] = (unsigned)r_ * (unsigned)KB + (unsigned)C[i] * 2u; } } }
            const char* a1 = cA + (size_t)(t + 1) * kstep;
            const char* a2 = last ? nA : cA + (size_t)(t + 2) * kstep; const char* b2 = last ? nB : cB + (size_t)(t + 2) * kstep;
            const char* a3 = a2 + kstep; const char* b3 = b2 + kstep;
            unsigned v2[2][2];
            if constexpr (GATHER) {
#pragma unroll
                for (int h = 0; h < 2; ++h)
#pragma unroll
                    for (int i = 0; i < 2; ++i) v2[h][i] = last ? vn[h][i] : vc[h][i]; }
            PG8_LDB(B0, 0, 0); PG8_LDB(B1, 0, 1); PG8_SCHED; PG8_LDA(At, 0, 0); PG8_STAGE_A(PG8_SA(1, 1), a1, 1, vc);
            PG8_WAIT_V(8); PG8_WAIT_L(0); PG8_BAR; PG8_MMA(0, 0, At, B0); PG8_MMA(0, 1, At, B1); PG8_BAR; PG8_SCHED;
            PG8_LDA(At, 0, 1); PG8_STAGE(PG8_SB(0, 0), b2, voffB); PG8_STAGE(PG8_SB(0, 1), b2 + hstep, voffB); PG8_STAGE_A(PG8_SA(0, 0), a2, 0, v2);
            PG8_WAIT_V(8); PG8_WAIT_L(0); PG8_BAR; PG8_MMA(1, 0, At, B0); PG8_MMA(1, 1, At, B1); PG8_BAR; PG8_SCHED;
            PG8_LDB(B0, 1, 0); PG8_LDB(B1, 1, 1); PG8_SCHED; PG8_LDA(At, 1, 0); PG8_STAGE_A(PG8_SA(0, 1), a2, 1, v2);
            PG8_WAIT_V(8); PG8_WAIT_L(0); PG8_BAR; PG8_MMA(0, 0, At, B0); PG8_MMA(0, 1, At, B1); PG8_BAR; PG8_SCHED;
            PG8_LDA(At, 1, 1); PG8_STAGE(PG8_SB(1, 0), b3, voffB); PG8_STAGE(PG8_SB(1, 1), b3 + hstep, voffB); PG8_STAGE_A(PG8_SA(1, 0), a3, 0, v2);
            PG8_WAIT_V(8); PG8_WAIT_L(0); PG8_BAR; PG8_MMA(1, 0, At, B0); PG8_MMA(1, 1, At, B1); PG8_BAR; PG8_SCHED;
        }
        if constexpr (ALIGN_EPI) { if (wr == 0) PG8_BAR; }
        { int pm_ = cur.pm, pn_ = cur.pn, fr_ = fr, fq_ = fq;
          asm volatile("" : "+s"(pm_), "+s"(pn_), "+v"(fr_), "+v"(fq_));
          E(acc, pm_, pn_, wr, wc, fr_, fq_); }
        if (!has_next) break;
#pragma unroll
        for (int a = 0; a < 2; ++a)
#pragma unroll
            for (int b = 0; b < 2; ++b)
#pragma unroll
                for (int m = 0; m < 4; ++m)
#pragma unroll
                    for (int n = 0; n < 2; ++n) acc[a][b][m][n] = (f32x4){0.f, 0.f, 0.f, 0.f};
        cur = nxt; cA = nA; cB = nB; ++ui;
        if constexpr (GATHER) {
#pragma unroll
            for (int h = 0; h < 2; ++h)
#pragma unroll
                for (int i = 0; i < 2; ++i) vc[h][i] = vn[h][i]; }
        if constexpr (ALIGN_EPI) { if (wr == 1) PG8_BAR; }
    }
    PG8_WAIT_V(0);
    if constexpr (!ALIGN_EPI) { if (wr == 0) PG8_BAR; }
    PG8_BAR;
#undef PG8_SA
#undef PG8_SB
#undef PG8_STAGE
#undef PG8_STAGE_A
#undef PG8_LDA
#undef PG8_LDB
#undef PG8_MMA
#undef PG8_WAIT_V
#undef PG8_WAIT_L
#undef PG8_BAR
#undef PG8_SCHED
}
}
template <bool FP8 = false, class Epi, class Sched>
__device__ __forceinline__ void gemm_fast(unsigned char* lds, const bf16_t* A, const bf16_t* Bt, int K, const Sched& S, const Epi& E) {
    pg8::gemm_phase<Epi, Sched, true, Sched::GATHER, FP8>(lds, A, Bt, K, S, E);
    __syncthreads();
}

typedef f32x4 AccT[2][2][4][2];
#define EPI_ROW(ai, m) (pm * 256 + (ai) * 128 + wr * 64 + (m) * 16 + fr)
__device__ __forceinline__ void unpack8(const u32x4 w, f32x4& lo, f32x4& hi) {
    lo = (f32x4){bf2f(w.x & 0xffffu), __uint_as_float(w.x & 0xffff0000u), bf2f(w.y & 0xffffu), __uint_as_float(w.y & 0xffff0000u)};
    hi = (f32x4){bf2f(w.z & 0xffffu), __uint_as_float(w.z & 0xffff0000u), bf2f(w.w & 0xffffu), __uint_as_float(w.w & 0xffff0000u)};
}
__device__ __forceinline__ u32x4 pack8(const f32x4 v0, const f32x4 v1) { u32x4 w; w.x = pk2(v0.x, v0.y); w.y = pk2(v0.z, v0.w); w.z = pk2(v1.x, v1.y); w.w = pk2(v1.z, v1.w); return w; }
__device__ __forceinline__ float dot8(const f32x4 a, const f32x4 b) { return ((a.x * a.x + a.y * a.y) + (a.z * a.z + a.w * a.w)) + ((b.x * b.x + b.y * b.y) + (b.z * b.z + b.w * b.w)); }
__device__ __forceinline__ void epi_rstd(const float* ssq, const int* rowmap, int pm, int wr, int fr, int fq, float (&rs)[2][4]) {
    f32x4 p[2][4];
#pragma unroll
    for (int ai = 0; ai < 2; ++ai)
#pragma unroll
        for (int m = 0; m < 4; ++m) { int row = EPI_ROW(ai, m); if (rowmap) row = rowmap[row]; p[ai][m] = *(const f32x4*)((const char*)ssq + ((unsigned)row * 16u + 4u * (unsigned)fq) * 4u); }
#pragma unroll
    for (int ai = 0; ai < 2; ++ai)
#pragma unroll
        for (int m = 0; m < 4; ++m) { float t = (p[ai][m].x + p[ai][m].y) + (p[ai][m].z + p[ai][m].w); t += __shfl_xor(t, 16); t += __shfl_xor(t, 32); rs[ai][m] = __builtin_amdgcn_rsqf(t * (1.f / 1024.f) + EPS); }
}
__device__ __forceinline__ void epi_ssq(float* ssq, int row, int slot, float s_, int fq) { s_ += __shfl_xor(s_, 16); s_ += __shfl_xor(s_, 32); if (fq == 0) *(float*)((char*)ssq + ((unsigned)row * 16u + (unsigned)slot) * 4u) = s_; }

struct EpiZ { static constexpr bool PERM = true; bf16_t* z; const float* bin; const float* ssq;
    __device__ __forceinline__ void operator()(const AccT& acc, int pm, int pn, int wr, int wc, int fr, int fq) const {
        const int c0 = pn * 256 + wc * 32 + 8 * fq; f32x4 bv[2][2]; float rs[2][4];
#pragma unroll
        for (int bj = 0; bj < 2; ++bj)
#pragma unroll
            for (int n = 0; n < 2; ++n) { const int cc = c0 + bj * 128 + n * 4; bv[bj][n] = *(const f32x4*)(bin + (cc < 2048 ? cc : cc + 8)); }
        epi_rstd(ssq, nullptr, pm, wr, fr, fq, rs);
#pragma unroll
        for (int ai = 0; ai < 2; ++ai)
#pragma unroll
            for (int m = 0; m < 4; ++m) { bf16_t* rp = z + (size_t)EPI_ROW(ai, m) * ZW + c0; const float r = rs[ai][m];
#pragma unroll
                for (int bj = 0; bj < 2; ++bj) *(u32x4*)(rp + bj * 128) = pack8(acc[ai][bj][m][0] * r + bv[bj][0], acc[ai][bj][m][1] * r + bv[bj][1]); } } };
template <bool XB> struct EpiHres { static constexpr bool PERM = true; const float* xb; bf16_t* hb; float* ssq;
    __device__ __forceinline__ void operator()(const AccT& acc, int pm, int pn, int wr, int wc, int fr, int fq) const {
        const int c0 = pn * 256 + wc * 32 + 8 * fq;
#pragma unroll
        for (int ai = 0; ai < 2; ++ai) {
            f32x4 lx[4][2][2]; u32x4 lh[4][2];
#pragma unroll
            for (int m = 0; m < 4; ++m)
#pragma unroll
                for (int bj = 0; bj < 2; ++bj) { const size_t o = (size_t)EPI_ROW(ai, m) * D + c0 + bj * 128;
                    if (XB) { lx[m][bj][0] = *(const f32x4*)(xb + o); lx[m][bj][1] = *(const f32x4*)(xb + o + 4); } else lh[m][bj] = *(const u32x4*)(hb + o); }
#pragma unroll
            for (int m = 0; m < 4; ++m) { float s_ = 0.f; const int row = EPI_ROW(ai, m);
#pragma unroll
                for (int bj = 0; bj < 2; ++bj) { f32x4 b0, b1; if (XB) { b0 = lx[m][bj][0]; b1 = lx[m][bj][1]; } else unpack8(lh[m][bj], b0, b1);
                    const f32x4 v0 = b0 + acc[ai][bj][m][0], v1 = b1 + acc[ai][bj][m][1]; s_ += dot8(v0, v1);
                    *(u32x4*)(hb + (size_t)row * D + c0 + bj * 128) = pack8(v0, v1); }
                epi_ssq(ssq, row, pn * 4 + wc, s_, fq); }
        } } };
struct EpiSwiglu { static constexpr bool PERM = true; bf16_t* hid; const float* ssq; const int* rowmap;
    __device__ __forceinline__ void operator()(const AccT& acc, int pm, int pn, int wr, int wc, int fr, int fq) const {
        const int c0 = pn * 128 + wc * 32 + 8 * fq; float rs[2][4];
        epi_rstd(ssq, rowmap, pm, wr, fr, fq, rs);
#pragma unroll
        for (int ai = 0; ai < 2; ++ai)
#pragma unroll
            for (int m = 0; m < 4; ++m) { u32x4 w; const float r = rs[ai][m];
#pragma unroll
                for (int n = 0; n < 2; ++n) { const f32x4 g = acc[ai][0][m][n] * r, u = acc[ai][1][m][n] * r;
                    w[2 * n] = pk2(siluf_(g.x) * u.x, siluf_(g.y) * u.y); w[2 * n + 1] = pk2(siluf_(g.z) * u.z, siluf_(g.w) * u.w); }
                *(u32x4*)(hid + (size_t)EPI_ROW(ai, m) * DFF + c0) = w; } } };
struct EpiSwiglu8 { static constexpr bool PERM = true; unsigned char* hid8; float sc;
    __device__ __forceinline__ void operator()(const AccT& acc, int pm, int pn, int wr, int wc, int fr, int fq) const {
        const int c0 = pn * 128 + wc * 32 + 8 * fq;
#pragma unroll
        for (int ai = 0; ai < 2; ++ai)
#pragma unroll
            for (int m = 0; m < 4; ++m) { u32x2 w;
#pragma unroll
                for (int n = 0; n < 2; ++n) { const f32x4 g = acc[ai][0][m][n] * sc, u = acc[ai][1][m][n] * sc;
                    w[n] = pk4_fp8(siluf_(g.x) * u.x, siluf_(g.y) * u.y, siluf_(g.z) * u.z, siluf_(g.w) * u.w); }
                *(u32x2*)(hid8 + (size_t)EPI_ROW(ai, m) * DFF + c0) = w; } } };
struct EpiMoeDown { static constexpr bool PERM = true; bf16_t* hb; bf16_t* y1; const int* row_tok; const int* row_slot; const float* row_gate; float sc;
    __device__ __forceinline__ void operator()(const AccT& acc, int pm, int pn, int wr, int wc, int fr, int fq) const {
        const int c0 = pn * 256 + wc * 32 + 8 * fq;
        int tok[2][4], slot[2][4]; float gt[2][4];
#pragma unroll
        for (int ai = 0; ai < 2; ++ai)
#pragma unroll
            for (int m = 0; m < 4; ++m) { const int row = EPI_ROW(ai, m); tok[ai][m] = row_tok[row]; slot[ai][m] = row_slot[row]; gt[ai][m] = row_gate[row] * sc; }
#pragma unroll
        for (int ai = 0; ai < 2; ++ai) {
            u32x4 lh[4][2];
#pragma unroll
            for (int m = 0; m < 4; ++m) { const bool rmw = tok[ai][m] < M && slot[ai][m] == 0;
#pragma unroll
                for (int bj = 0; bj < 2; ++bj) lh[m][bj] = rmw ? *(const u32x4*)(hb + (size_t)tok[ai][m] * D + c0 + bj * 128) : (u32x4){0u, 0u, 0u, 0u}; }
#pragma unroll
            for (int m = 0; m < 4; ++m) { if (tok[ai][m] >= M) continue; const size_t o = (size_t)tok[ai][m] * D + c0; const float g = gt[ai][m];
                if (slot[ai][m] == 0) {
#pragma unroll
                    for (int bj = 0; bj < 2; ++bj) { f32x4 b0, b1; unpack8(lh[m][bj], b0, b1); *(u32x4*)(hb + o + bj * 128) = pack8(b0 + g * acc[ai][bj][m][0], b1 + g * acc[ai][bj][m][1]); }
                } else {
#pragma unroll
                    for (int bj = 0; bj < 2; ++bj) *(u32x4*)(y1 + o + bj * 128) = pack8(g * acc[ai][bj][m][0], g * acc[ai][bj][m][1]);
                } }
        } } };
struct EpiStoreBf16 { static constexpr bool PERM = true; bf16_t* out;
    __device__ __forceinline__ void operator()(const AccT& acc, int pm, int pn, int wr, int wc, int fr, int fq) const {
        const int c0 = pn * 256 + wc * 32 + 8 * fq;
#pragma unroll
        for (int ai = 0; ai < 2; ++ai)
#pragma unroll
            for (int m = 0; m < 4; ++m)
#pragma unroll
                for (int bj = 0; bj < 2; ++bj) *(u32x4*)(out + (size_t)EPI_ROW(ai, m) * D + c0 + bj * 128) = pack8(acc[ai][bj][m][0], acc[ai][bj][m][1]); } };
struct EpiPle { static constexpr bool PERM = true; const bf16_t* hin; bf16_t* hb; const bf16_t* pp; float* ssq; const float* ssq_in;
    __device__ __forceinline__ void operator()(const AccT& acc, int pm, int pn, int wr, int wc, int fr, int fq) const {
        const int c0 = pn * 256 + wc * 32 + 8 * fq; float rs[2][4];
        epi_rstd(ssq_in, nullptr, pm, wr, fr, fq, rs);
        u32x4 sg[2][4][2];
#pragma unroll
        for (int ai = 0; ai < 2; ++ai)
#pragma unroll
            for (int m = 0; m < 4; ++m)
#pragma unroll
                for (int bj = 0; bj < 2; ++bj) { f32x4 a0 = acc[ai][bj][m][0] * rs[ai][m], a1 = acc[ai][bj][m][1] * rs[ai][m];
#pragma unroll
                    for (int q = 0; q < 4; ++q) { a0[q] = sigmoidf_(a0[q]); a1[q] = sigmoidf_(a1[q]); }
                    sg[ai][m][bj] = pack8(a0, a1); }
        asm volatile("" ::: "memory");
#pragma unroll
        for (int ai = 0; ai < 2; ++ai) {
            u32x4 lh[4][2], lp[4][2];
#pragma unroll
            for (int m = 0; m < 4; ++m)
#pragma unroll
                for (int bj = 0; bj < 2; ++bj) { const unsigned ob = ((unsigned)EPI_ROW(ai, m) * D + c0 + bj * 128) * 2u;
                    lh[m][bj] = *(const u32x4*)((const char*)hin + ob); lp[m][bj] = *(const u32x4*)((const char*)pp + ob); }
#pragma unroll
            for (int m = 0; m < 4; ++m) { float s_ = 0.f; const int row = EPI_ROW(ai, m);
#pragma unroll
                for (int bj = 0; bj < 2; ++bj) { f32x4 h0, h1, p0, p1, g0, g1; unpack8(lh[m][bj], h0, h1); unpack8(lp[m][bj], p0, p1); unpack8(sg[ai][m][bj], g0, g1);
                    h0 += g0 * p0; h1 += g1 * p1; s_ += dot8(h0, h1);
                    *(u32x4*)((char*)hb + ((unsigned)row * D + c0 + bj * 128) * 2u) = pack8(h0, h1); }
                epi_ssq(ssq, row, pn * 4 + wc, s_, fq); }
        } } };

__device__ __forceinline__ float conv4(const bf16_t* zc, int row, int s, const float* w  , int wstride, float b) {
    float acc = b;
#pragma unroll
    for (int j = 0; j < 4; ++j) { const int ds = 3 - j; if (s - ds >= 0) acc += w[j * wstride] * bf2f(zc[(ptrdiff_t)(row - ds) * ZW]); }
    return acc;
}
__device__ __forceinline__ void chunk_gates(float* sc, const float* gates, int row0, int h, int lane) {
    const float ip = gates[(size_t)(row0 + lane) * 8 + h], fp = gates[(size_t)(row0 + lane) * 8 + 4 + h];
    float b = logsigmoidf_(fp);
#pragma unroll
    for (int o = 1; o < 64; o <<= 1) { const float n = __shfl_up(b, o); if (lane >= o) b += n; }
    sc[lane] = b; sc[64 + lane] = ip;
}
__device__ __forceinline__ void chunk_gates_r(float* sc, float ip, float fp, int lane) {
    float b = logsigmoidf_(fp);
#pragma unroll
    for (int o = 1; o < 64; o <<= 1) { const float n = __shfl_up(b, o); if (lane >= o) b += n; }
    sc[lane] = b; sc[64 + lane] = ip;
}
__device__ __forceinline__ void mlstm_local(const Args& a, unsigned char* lds, int l, int item) {
    const int b = item >> 8, c = (item >> 2) & 63, h = item & 3, row0 = b * SEQ + c * CH, tid = otid(), lane = tid & 63;
    float* Kt = (float*)lds;
    float* Vt = Kt + 64 * 128;
    float* sc = Vt + 64 * 128;
    const bf16_t* z = (const bf16_t*)(a.ws + WS_Z);
    const float* gates = (const float*)(a.ws + WS_SMALL + SM_GATES);
    if (tid < 64) {
        chunk_gates(sc, gates, row0, h, lane);
        const float bl = __shfl(sc[lane], 63), al = bl - sc[lane] + sc[64 + lane];
        const float amax = wave_max(al);
        sc[128 + lane] = __expf(al - amax);
        if (lane == 0) { ((float*)(a.ws + WS_SMALL + SM_BL))[item] = bl; ((float*)(a.ws + WS_SMALL + SM_AMAX))[item] = amax; }
    }
    const float* wc = a.in[I_WCQK] + (size_t)l * 4 * 1024; const float* bc = a.in[I_BCQK] + (size_t)l * 1024;
    for (int i = tid; i < 64 * 128; i += NT) {
        const int ll = i >> 7, d = i & 127, ch = ZK + h * DH + d;
        Kt[i] = siluf_(conv4(z + ch, row0 + ll, c * CH + ll, wc + ch, 1024, bc[ch]));
        Vt[i] = bf2f(z[(size_t)(row0 + ll) * ZW + ZV + h * DH + d]);
    }
    __syncthreads();
    const int d = tid & 127, eg = tid >> 7;
    float acc[33];
#pragma unroll
    for (int i = 0; i < 33; ++i) acc[i] = 0.f;
    for (int ll = 0; ll < 64; ++ll) {
        const float kd = Kt[ll * 128 + d] * sc[128 + ll];
#pragma unroll
        for (int i = 0; i < 32; ++i) acc[i] += Vt[ll * 128 + eg + 4 * i] * kd;
        acc[32] += kd;
    }
    float* ct = (float*)(a.ws + WS_CT) + (size_t)item * EROWS * 128;
#pragma unroll
    for (int i = 0; i < 32; ++i) ct[(eg + 4 * i) * 128 + d] = acc[i];
    if (eg == 0) ct[128 * 128 + d] = acc[32];
    __syncthreads();
}
__device__ __forceinline__ void mlstm_scan(const Args& a, int G) {
    const float* BL = (const float*)(a.ws + WS_SMALL + SM_BL); const float* AM = (const float*)(a.ws + WS_SMALL + SM_AMAX);
    float* MP = (float*)(a.ws + WS_SMALL + SM_MPREV);
    const int tid = otid();
    for (int w = blockIdx.x; w < 16 * 16; w += G) {
        const int bh = w >> 4, sl = w & 15, b = bh >> 2, h = bh & 3;
        unsigned* p = (unsigned*)(a.ws + WS_CT) + (size_t)((b * NC) * NH + h) * 8192 + sl * 512 + tid;
        const bool dn = (sl == 1 && tid < 128);
        float* q = (float*)(a.ws + WS_DN) + (size_t)((b * NC) * NH + h) * 128 + (dn ? tid : 0);
        float s0 = 0.f, s1 = 0.f, sn = 0.f, m = 0.f;
        unsigned x[16], xn[16]; float y[16], yn[16];
#pragma unroll
        for (int j = 0; j < 16; ++j) { x[j] = p[(size_t)j * (NH * 8192)]; y[j] = q[(size_t)j * (NH * 128)]; }
#pragma unroll 1
        for (int c0 = 0; c0 < NC; c0 += 16) {
            const int cn = (c0 + 16 < NC) ? c0 + 16 : c0;
#pragma unroll
            for (int j = 0; j < 16; ++j) { xn[j] = p[(size_t)(cn + j) * (NH * 8192)]; yn[j] = q[(size_t)(cn + j) * (NH * 128)]; }
#pragma unroll
            for (int j = 0; j < 16; ++j) {
                const int item = (b * NC + c0 + j) * NH + h;
                const float bl = BL[item], am = AM[item];
                const float mn = fmaxf(bl + m, am), dec = __expf(bl + m - mn), scl = __expf(am - mn);
                p[(size_t)(c0 + j) * (NH * 8192)] = pk2(s0, s1);
                if (dn) q[(size_t)(c0 + j) * (NH * 128)] = sn;
                if (sl == 0 && tid == 0) MP[item] = m;
                s0 = dec * s0 + scl * bf2f(x[j] & 0xffffu); s1 = dec * s1 + scl * __uint_as_float(x[j] & 0xffff0000u); sn = dec * sn + scl * y[j]; m = mn;
            }
#pragma unroll
            for (int j = 0; j < 16; ++j) { x[j] = xn[j]; y[j] = yn[j]; }
        }
    }
}
__device__ __forceinline__ void mlstm_out(const Args& a, unsigned char* lds, int l, int item) {
    const int b = item >> 8, c = (item >> 2) & 63, h = item & 3, row0 = b * SEQ + c * CH, tid = otid(), lane = tid & 63, wave = tid >> 6;
    float* Q = (float*)lds;
    float* Kt = Q + 64 * 128;
    float* Vt = Kt + 64 * 128;
    float* Sm = Vt + 64 * 128;
    float* sc = Sm + 64 * 64;
    const bf16_t* z = (const bf16_t*)(a.ws + WS_Z);
    const float* gates = (const float*)(a.ws + WS_SMALL + SM_GATES);
    const float mprev = ((const float*)(a.ws + WS_SMALL + SM_MPREV))[item];
    if (tid < 64) {
        chunk_gates(sc, gates, row0, h, lane);
        float g = sc[64 + lane] - sc[lane];
#pragma unroll
        for (int o = 1; o < 64; o <<= 1) { const float n = __shfl_up(g, o); if (lane >= o) g = fmaxf(g, n); }
        const float mrow = sc[lane] + fmaxf(mprev, g);
        sc[128 + lane] = mrow; sc[192 + lane] = __expf(sc[lane] + mprev - mrow);
    }
    const float* wc = a.in[I_WCQK] + (size_t)l * 4 * 1024; const float* bc = a.in[I_BCQK] + (size_t)l * 1024;
    for (int i = tid; i < 64 * 128; i += NT) {
        const int ll = i >> 7, d = i & 127, chq = ZQ + h * DH + d, chk = ZK + h * DH + d;
        Q[i] = siluf_(conv4(z + chq, row0 + ll, c * CH + ll, wc + chq, 1024, bc[chq])) * 0.08838834764831845f;
        Kt[i] = siluf_(conv4(z + chk, row0 + ll, c * CH + ll, wc + chk, 1024, bc[chk]));
        Vt[i] = bf2f(z[(size_t)(row0 + ll) * ZW + ZV + h * DH + d]);
    }
    __syncthreads();
    for (int i = tid; i < 64 * 64; i += NT) {
        const int ll = i >> 6, mm = i & 63; float s = 0.f;
        if (mm <= ll) {
            for (int d = 0; d < 128; ++d) s += Q[ll * 128 + d] * Kt[mm * 128 + d];
            s *= __expf(sc[ll] - sc[mm] + sc[64 + mm] - sc[128 + ll]);
        }
        Sm[i] = s;
    }
    __syncthreads();
    const float* ct = (const float*)(a.ws + WS_CT) + (size_t)item * EROWS * 128;
    if (tid < 64) {
        float di = 0.f, dn = 0.f;
        for (int mm = 0; mm < 64; ++mm) di += Sm[tid * 64 + mm];
        for (int d = 0; d < 128; ++d) dn += Q[tid * 128 + d] * ct[128 * 128 + d];
        const float den = di + sc[192 + tid] * dn;
        sc[256 + tid] = fmaxf(fabsf(den), __expf(-sc[128 + tid]));
    }
    const int e = tid & 127, lg = tid >> 7;
    float acc[16], acc2[16];
#pragma unroll
    for (int i = 0; i < 16; ++i) { acc[i] = 0.f; acc2[i] = 0.f; }
    for (int mm = 0; mm < 64; ++mm) { const float vv = Vt[mm * 128 + e];
#pragma unroll
        for (int i = 0; i < 16; ++i) acc[i] += Sm[(lg * 16 + i) * 64 + mm] * vv; }
    for (int d = 0; d < 128; ++d) { const float cv = ct[e * 128 + d];
#pragma unroll
        for (int i = 0; i < 16; ++i) acc2[i] += Q[(lg * 16 + i) * 128 + d] * cv; }
    __syncthreads();
#pragma unroll
    for (int i = 0; i < 16; ++i) { const int ll = lg * 16 + i;
        const float hv = (acc[i] + sc[192 + ll] * acc2[i]) / sc[256 + ll];
        const float o = sigmoidf_(bf2f(z[(size_t)(row0 + ll) * ZW + ZO + h * DH + e]));
        Kt[ll * 128 + e] = hv * o; }
    __syncthreads();
    const float* gm = a.in[I_GMH] + (size_t)l * DM + h * DH;
    bf16_t* mix = (bf16_t*)(a.ws + WS_MIX);
    for (int ll = wave * 8; ll < wave * 8 + 8; ++ll) {
        const float x0 = Kt[ll * 128 + 2 * lane], x1 = Kt[ll * 128 + 2 * lane + 1];
        const float rs = rsqrtf(wave_sum(x0 * x0 + x1 * x1) * (1.f / 128.f) + EPS);
        *(unsigned*)(mix + (size_t)(row0 + ll) * D + h * DH + 2 * lane) = pk2(x0 * rs * gm[2 * lane], x1 * rs * gm[2 * lane + 1]);
    }
    __syncthreads();
}


typedef short bf16x8 __attribute__((ext_vector_type(8)));
__device__ __forceinline__ f32x4 mfma16(bf16x8 a, bf16x8 b, f32x4 c) { return __builtin_amdgcn_mfma_f32_16x16x32_bf16(a, b, c, 0, 0, 0); }

template <int IN, int AUX>
__device__ __forceinline__ void phase_rowpass_mm(unsigned char* lds, const float* xin, bf16_t* hb, const float* g, float* ssq, const float* auxW, int auxld, const float* auxB,
                                                 float* gates, unsigned char* tok_p, float* tok_g, unsigned char* h8) {
    constexpr int WLD = 1032;
    bf16_t* wl = (bf16_t*)lds; float* gl = (float*)(lds + 8 * WLD * 2);
    const int tid = otid(), lane = tid & 63, wave = tid >> 6;
    for (int i = tid; i < D * 8; i += NT) { const int k = i >> 3, c = i & 7; wl[c * WLD + k] = (bf16_t)f2bf(g[k] * auxW[(size_t)k * auxld + c]); }
    if (AUX == 2) for (int i = tid; i < D; i += NT) gl[i] = g[i];
    __syncthreads();
    const int n = lane & 15, kq = lane >> 4;
    const bf16_t* wrow = wl + (n & 7) * WLD + 8 * kq;
    if (wave < 4) for (int task = blockIdx.x + gridDim.x * wave; task < M / 16; task += gridDim.x * 4) {
        const int row = task * 16 + n;
        f32x4 accL = {0.f, 0.f, 0.f, 0.f}, accS = {0.f, 0.f, 0.f, 0.f};
        u32x4 xr[32];
        if (IN == 1) {
            const u32x4* src = (const u32x4*)(hb + (size_t)row * D + 8 * kq);
#pragma unroll
            for (int s = 0; s < 32; ++s) xr[s] = src[4 * s];
            asm volatile("" ::: "memory");
#pragma unroll
            for (int s = 0; s < 32; ++s) { const bf16x8 xf = __builtin_bit_cast(bf16x8, xr[s]); const bf16x8 wf = *(const bf16x8*)(wrow + 32 * s);
                accL = mfma16(wf, xf, accL); accS = mfma16(xf, xf, accS); }
        } else {
            const f32x4* src = (const f32x4*)(xin + (size_t)row * D + 8 * kq); u32x4* dst = (u32x4*)(hb + (size_t)row * D + 8 * kq);
#pragma unroll
            for (int hf = 0; hf < 2; ++hf) { f32x4 xf32[32]; asm volatile("" ::: "memory");
#pragma unroll
                for (int s = 0; s < 16; ++s) { xf32[2 * s] = src[8 * (16 * hf + s)]; xf32[2 * s + 1] = src[8 * (16 * hf + s) + 1]; }
                asm volatile("" ::: "memory");
#pragma unroll
                for (int s = 0; s < 16; ++s) { const f32x4 a_ = xf32[2 * s], b_ = xf32[2 * s + 1];
                    u32x4 p; p.x = pk2(a_.x, a_.y); p.y = pk2(a_.z, a_.w); p.z = pk2(b_.x, b_.y); p.w = pk2(b_.z, b_.w); dst[4 * (16 * hf + s)] = p;
                    const bf16x8 xf = __builtin_bit_cast(bf16x8, p); const bf16x8 wf = *(const bf16x8*)(wrow + 32 * (16 * hf + s));
                    accL = mfma16(wf, xf, accL); accS = mfma16(xf, xf, accS); } }
        }
        float dv = accS[0]; dv = (n & 3) == 1 ? accS[1] : dv; dv = (n & 3) == 2 ? accS[2] : dv; dv = (n & 3) == 3 ? accS[3] : dv;
        const float tot = __shfl(dv, n + 16 * (n >> 2));
        const float rstd = __builtin_amdgcn_rsqf(tot * (1.f / D) + EPS);
        if (IN == 0) { f32x4 o = {kq == 0 ? tot : 0.f, 0.f, 0.f, 0.f}; *(f32x4*)(ssq + (size_t)row * 16 + 4 * kq) = o; }
        if (AUX == 1) {
            if (kq < 2) { const f32x4 b_ = *(const f32x4*)(auxB + 4 * kq); *(f32x4*)(gates + (size_t)row * 8 + 4 * kq) = accL * rstd + b_; }
        } else {
            const f32x4 lg = accL * rstd;
            float o4[4];
#pragma unroll
            for (int r = 0; r < 4; ++r) o4[r] = __shfl(lg[r], lane + 16);
            if (kq == 0) {
                float acc[8] = {lg[0], lg[1], lg[2], lg[3], o4[0], o4[1], o4[2], o4[3]};
                int e1 = 0; float v1 = acc[0];
#pragma unroll
                for (int c = 1; c < 8; ++c) if (acc[c] > v1) { v1 = acc[c]; e1 = c; }
                int e2 = -1; float v2 = -INFINITY;
#pragma unroll
                for (int c = 0; c < 8; ++c) if (c != e1 && acc[c] > v2) { v2 = acc[c]; e2 = c; }
                const float p2 = __expf(v2 - v1), inv = 1.f / (1.f + p2);
                tok_p[row] = (unsigned char)(e1 | (e2 << 4)); tok_g[row * 2] = inv; tok_g[row * 2 + 1] = p2 * inv;
            }
            if (h8) {
                u32x2* dst = (u32x2*)(h8 + (size_t)row * D + 8 * kq);
#pragma unroll
                for (int s = 0; s < 32; ++s) { if ((s & 3) == 0) asm volatile("" ::: "memory"); const u32x4 w = xr[s]; const f32x4 g0 = *(const f32x4*)(gl + 32 * s + 8 * kq), g1 = *(const f32x4*)(gl + 32 * s + 8 * kq + 4);
                    u32x2 o; o.x = pk4_fp8(bf2f(w.x & 0xffffu) * rstd * g0.x, __uint_as_float(w.x & 0xffff0000u) * rstd * g0.y, bf2f(w.y & 0xffffu) * rstd * g0.z, __uint_as_float(w.y & 0xffff0000u) * rstd * g0.w);
                    o.y = pk4_fp8(bf2f(w.z & 0xffffu) * rstd * g1.x, __uint_as_float(w.z & 0xffff0000u) * rstd * g1.y, bf2f(w.w & 0xffffu) * rstd * g1.z, __uint_as_float(w.w & 0xffff0000u) * rstd * g1.w);
                    dst[4 * s] = o; }
            }
        }
    }
    __syncthreads();
}

__device__ __forceinline__ void conv_load11(const bf16_t* zc, int row0, int l0, bool first_chunk, unsigned (&x)[11]) {
#pragma unroll
    for (int j = 0; j < 11; ++j) { const int ll = l0 - 3 + j; x[j] = (first_chunk && ll < 0) ? 0u : *(const unsigned*)(zc + (ptrdiff_t)(row0 + ll) * ZW); }
}
struct ConvW { float w[4][2]; float b[2]; };
__device__ __forceinline__ void conv_loadw(const float* wc, const float* bc, int col, ConvW& cw) {
#pragma unroll
    for (int j = 0; j < 4; ++j) { cw.w[j][0] = wc[j * 1024 + col]; cw.w[j][1] = wc[j * 1024 + col + 1]; }
    cw.b[0] = bc[col]; cw.b[1] = bc[col + 1];
}
__device__ __forceinline__ void conv_apply(const unsigned (&x)[11], const ConvW& cw, float (&out)[8][2]) {
#pragma unroll
    for (int i = 0; i < 8; ++i) { float a0 = cw.b[0], a1 = cw.b[1];
#pragma unroll
        for (int j = 0; j < 4; ++j) { a0 += cw.w[j][0] * bf2f(x[i + j] & 0xffffu); a1 += cw.w[j][1] * __uint_as_float(x[i + j] & 0xffff0000u); }
        out[i][0] = a0; out[i][1] = a1; }
}
struct MlRegs { unsigned xk[11], v[8]; ConvW cw; float gi, gf; };
__device__ __forceinline__ void ml_load(const Args& a, int l, int item, MlRegs& R) {
    const int b = item >> 8, c = (item >> 2) & 63, h = item & 3, row0 = b * SEQ + c * CH, tid = otid(), lane = tid & 63, wave = tid >> 6;
    const bf16_t* z = (const bf16_t*)(a.ws + WS_Z);
    const float* gates = (const float*)(a.ws + WS_SMALL + SM_GATES);
    const int cp = lane, lg = wave, colk = ZK + h * DH + 2 * cp, colv = ZV + h * DH + 2 * cp;
    conv_load11(z + colk, row0, 8 * lg, c == 0, R.xk);
#pragma unroll
    for (int i = 0; i < 8; ++i) R.v[i] = *(const unsigned*)(z + (size_t)(row0 + 8 * lg + i) * ZW + colv);
    conv_loadw(a.in[I_WCQK] + (size_t)l * 4 * 1024, a.in[I_BCQK] + (size_t)l * 1024, colk, R.cw);
    R.gi = gates[(size_t)(row0 + lane) * 8 + h]; R.gf = gates[(size_t)(row0 + lane) * 8 + 4 + h];
}
__device__ __forceinline__ void ml_compute(const Args& a, unsigned char* lds, int l, int item, MlRegs& R) {
    const int tid = otid(), lane = tid & 63, wave = tid >> 6, fr = lane & 15, fq = lane >> 4;
    unsigned char* KT = lds; unsigned char* VT = lds + 18432; float* RED = (float*)(lds + 36864); float* sc = (float*)(lds + 40960);
    const int cp = lane, lg = wave;
    unsigned (&xk)[11] = R.xk; unsigned (&v)[8] = R.v; ConvW& cw = R.cw;
    if (tid < 64) {
        chunk_gates_r(sc, R.gi, R.gf, lane);
        {
            float g = sc[64 + lane] - sc[lane];
#pragma unroll
            for (int o = 1; o < 64; o <<= 1) { const float n = __shfl_up(g, o); if (lane >= o) g = fmaxf(g, n); }
            float* scal = (float*)(a.ws + WS_SCAL) + (size_t)item * 128; scal[lane] = sc[lane]; scal[64 + lane] = g; }
        const float bl = __shfl(sc[lane], 63), al = bl - sc[lane] + sc[64 + lane];
        const float amax = wave_max(al);
        sc[128 + lane] = __expf(al - amax);
        if (lane == 0) { ((float*)(a.ws + WS_SMALL + SM_BL))[item] = bl; ((float*)(a.ws + WS_SMALL + SM_AMAX))[item] = amax; }
    }
    LDS_BARRIER();
    {
        float kk[8][2];
        conv_apply(xk, cw, kk);
        float n0 = 0.f, n1 = 0.f;
#pragma unroll
        for (int i = 0; i < 8; ++i) { const float wl = sc[128 + 8 * lg + i]; kk[i][0] = siluf_(kk[i][0]) * wl; kk[i][1] = siluf_(kk[i][1]) * wl; n0 += kk[i][0]; n1 += kk[i][1]; }
        u32x4 p0, p1;
#pragma unroll
        for (int i = 0; i < 4; ++i) { p0[i] = pk2(kk[2 * i][0], kk[2 * i + 1][0]); p1[i] = pk2(kk[2 * i][1], kk[2 * i + 1][1]); }
        *(u32x4*)(KT + (2 * cp) * 144 + lg * 16) = p0; *(u32x4*)(KT + (2 * cp + 1) * 144 + lg * 16) = p1;
        RED[lg * 128 + 2 * cp] = n0; RED[lg * 128 + 2 * cp + 1] = n1;
#pragma unroll
        for (int i = 0; i < 4; ++i) { p0[i] = (v[2 * i] & 0xffffu) | (v[2 * i + 1] << 16); p1[i] = (v[2 * i] >> 16) | (v[2 * i + 1] & 0xffff0000u); }
        *(u32x4*)(VT + (2 * cp) * 144 + lg * 16) = p0; *(u32x4*)(VT + (2 * cp + 1) * 144 + lg * 16) = p1;
    }
    LDS_BARRIER();
    bf16_t* ct = (bf16_t*)(a.ws + WS_CT) + (size_t)item * 128 * 128;
    {
        const int et0 = 2 * (wave & 3), dt0 = 4 * (wave >> 2);
        bf16x8 Vf[2][2], Kf[4][2];
#pragma unroll
        for (int i = 0; i < 2; ++i)
#pragma unroll
            for (int ks = 0; ks < 2; ++ks) Vf[i][ks] = *(const bf16x8*)(VT + ((et0 + i) * 16 + fr) * 144 + (ks * 32 + 8 * fq) * 2);
#pragma unroll
        for (int j = 0; j < 4; ++j)
#pragma unroll
            for (int ks = 0; ks < 2; ++ks) Kf[j][ks] = *(const bf16x8*)(KT + ((dt0 + j) * 16 + fr) * 144 + (ks * 32 + 8 * fq) * 2);
#pragma unroll
        for (int i = 0; i < 2; ++i)
#pragma unroll
            for (int j = 0; j < 4; ++j) {
                f32x4 acc = {0.f, 0.f, 0.f, 0.f};
                acc = mfma16(Kf[j][0], Vf[i][0], acc); acc = mfma16(Kf[j][1], Vf[i][1], acc);
                u32x2 w; w.x = pk2(acc[0], acc[1]); w.y = pk2(acc[2], acc[3]);
                *(u32x2*)(ct + ((et0 + i) * 16 + fr) * 128 + (dt0 + j) * 16 + 4 * fq) = w;
            }
    }
    if (tid < 128) { float s_ = 0.f;
#pragma unroll
        for (int g = 0; g < 8; ++g) s_ += RED[g * 128 + tid];
        ((float*)(a.ws + WS_DN))[(size_t)item * 128 + tid] = s_; }
    LDS_BARRIER();
}
struct MoRegs { unsigned xq[11], xk[11], v[8]; u32x4 og[2]; float gi, gb, gg, mprev; };
__device__ __forceinline__ void mo_load(const Args& a, int l, int item, MoRegs& R) {
    const int b = item >> 8, c = (item >> 2) & 63, h = item & 3, row0 = b * SEQ + c * CH, tid = otid(), lane = tid & 63, wave = tid >> 6;
    const bf16_t* z = (const bf16_t*)(a.ws + WS_Z);
    const float* gates = (const float*)(a.ws + WS_SMALL + SM_GATES);
    const int cp = lane, lg = wave, colq = ZQ + h * DH + 2 * cp, colk = ZK + h * DH + 2 * cp, colv = ZV + h * DH + 2 * cp;
    conv_load11(z + colq, row0, 8 * lg, c == 0, R.xq);
    conv_load11(z + colk, row0, 8 * lg, c == 0, R.xk);
#pragma unroll
    for (int i = 0; i < 8; ++i) R.v[i] = *(const unsigned*)(z + (size_t)(row0 + 8 * lg + i) * ZW + colv);
#pragma unroll
    for (int j = 0; j < 2; ++j) { const int pc = tid + j * NT; R.og[j] = *(const u32x4*)(z + (size_t)(row0 + (pc >> 4)) * ZW + ZO + h * DH + (pc & 15) * 8); }
    R.gi = gates[(size_t)(row0 + lane) * 8 + h];
    { const float* scal = (const float*)(a.ws + WS_SCAL) + (size_t)item * 128; R.gb = scal[lane]; R.gg = scal[64 + lane]; }
    R.mprev = ((const float*)(a.ws + WS_SMALL + SM_MPREV))[item];
}
__device__ __forceinline__ void mo_compute(const Args& a, unsigned char* lds, int l, int item, MoRegs& R, ConvW& cwq, ConvW& cwk, int& hw) {
    const int b = item >> 8, c = (item >> 2) & 63, h = item & 3, row0 = b * SEQ + c * CH, tid = otid(), lane = tid & 63, wave = tid >> 6, fr = lane & 15, fq = lane >> 4;
    unsigned char* QN = lds; unsigned char* KN = lds + 17408; unsigned char* VT = lds + 34816; unsigned char* SP = lds + 53248;
    float* sc = (float*)(lds + 62464);
    float* HM = (float*)lds;
    const int cp = lane, lg = wave;
    unsigned (&xq)[11] = R.xq; unsigned (&xk)[11] = R.xk; unsigned (&v)[8] = R.v;
    bf16x8 Cf[4]; f32x4 dnv[4];
    { const bf16_t* ct = (const bf16_t*)(a.ws + WS_CT) + (size_t)item * 128 * 128; const float* dn = (const float*)(a.ws + WS_DN) + (size_t)item * 128;
#pragma unroll
      for (int ks = 0; ks < 4; ++ks) Cf[ks] = *(const bf16x8*)(ct + (wave * 16 + fr) * 128 + ks * 32 + 8 * fq);
#pragma unroll
      for (int j = 0; j < 4; ++j) dnv[j] = *(const f32x4*)(dn + (tid & 7) * 16 + 4 * j); }
    f32x4 gmv[2][2];
#pragma unroll
    for (int j = 0; j < 2; ++j) { const float* gp = a.in[I_GMH] + (size_t)l * DM + h * DH + ((tid + j * NT) & 15) * 8; gmv[j][0] = *(const f32x4*)gp; gmv[j][1] = *(const f32x4*)(gp + 4); }
    if (hw != h) { const float* wc = a.in[I_WCQK] + (size_t)l * 4 * 1024; const float* bc = a.in[I_BCQK] + (size_t)l * 1024;
        conv_loadw(wc, bc, ZQ + h * DH + 2 * cp, cwq); conv_loadw(wc, bc, ZK + h * DH + 2 * cp, cwk); hw = h; }
    if (tid < 64) {
        const float mprev = R.mprev, mrow = R.gb + fmaxf(mprev, R.gg);
        sc[lane] = R.gb; sc[64 + lane] = R.gi; sc[128 + lane] = mrow; sc[192 + lane] = __expf(R.gb + mprev - mrow);
    }
    {
        float qq[8][2];
        conv_apply(xq, cwq, qq);
#pragma unroll
        for (int i = 0; i < 8; ++i) *(unsigned*)(QN + (8 * lg + i) * 272 + cp * 4) = pk2(siluf_(qq[i][0]) * 0.08838834764831845f, siluf_(qq[i][1]) * 0.08838834764831845f);
        conv_apply(xk, cwk, qq);
#pragma unroll
        for (int i = 0; i < 8; ++i) *(unsigned*)(KN + (8 * lg + i) * 272 + cp * 4) = pk2(siluf_(qq[i][0]), siluf_(qq[i][1]));
        u32x4 p0, p1;
#pragma unroll
        for (int i = 0; i < 4; ++i) { p0[i] = (v[2 * i] & 0xffffu) | (v[2 * i + 1] << 16); p1[i] = (v[2 * i] >> 16) | (v[2 * i + 1] & 0xffff0000u); }
        *(u32x4*)(VT + (2 * cp) * 144 + lg * 16) = p0; *(u32x4*)(VT + (2 * cp + 1) * 144 + lg * 16) = p1;
    }
    LDS_BARRIER();
    {
        const int ll = tid >> 3, part = tid & 7; float s_ = 0.f;
#pragma unroll
        for (int j = 0; j < 4; ++j) { const u32x2 qv = *(const u32x2*)(QN + ll * 272 + (part * 16 + 4 * j) * 2);
            s_ += bf2f(qv.x & 0xffffu) * dnv[j].x + __uint_as_float(qv.x & 0xffff0000u) * dnv[j].y + bf2f(qv.y & 0xffffu) * dnv[j].z + __uint_as_float(qv.y & 0xffff0000u) * dnv[j].w; }
        s_ = sum8(s_);
        if (part == 0) sc[384 + ll] = s_;
    }
    {
        const int lt = wave & 3; const int ll = lt * 16 + fr; const float bl_ = sc[ll], mr = sc[128 + ll]; float dsum = 0.f;
#pragma unroll
        for (int mi = 0; mi < 2; ++mi) {
            const int mt = 2 * (wave >> 2) + mi; u32x2 pk = {0u, 0u};
            if (mt <= lt) {
                f32x4 acc = {0.f, 0.f, 0.f, 0.f};
#pragma unroll
                for (int ks = 0; ks < 4; ++ks) { const bf16x8 A = *(const bf16x8*)(KN + (mt * 16 + fr) * 272 + (ks * 32 + 8 * fq) * 2), B = *(const bf16x8*)(QN + (lt * 16 + fr) * 272 + (ks * 32 + 8 * fq) * 2);
                    acc = mfma16(A, B, acc); }
                float sv[4];
#pragma unroll
                for (int r = 0; r < 4; ++r) { const int mm = mt * 16 + 4 * fq + r; const float wgt = (mm <= ll) ? __expf(bl_ - sc[mm] + sc[64 + mm] - mr) : 0.f; sv[r] = acc[r] * wgt; dsum += sv[r]; }
                pk.x = pk2(sv[0], sv[1]); pk.y = pk2(sv[2], sv[3]);
            }
            *(u32x2*)(SP + ll * 144 + (mt * 16 + 4 * fq) * 2) = pk;
        }
        dsum += __shfl_xor(dsum, 16); dsum += __shfl_xor(dsum, 32);
        if (fq == 0) sc[256 + (wave >> 2) * 64 + ll] = dsum;
    }
    LDS_BARRIER();
    if (tid < 64) { const float den = sc[256 + tid] + sc[320 + tid] + sc[192 + tid] * sc[384 + tid]; sc[448 + tid] = fmaxf(fabsf(den), __expf(-sc[128 + tid])); }
    f32x4 acc1[4], acc2[4];
    {
        bf16x8 Vf[2];
#pragma unroll
        for (int ks = 0; ks < 2; ++ks) Vf[ks] = *(const bf16x8*)(VT + (wave * 16 + fr) * 144 + (ks * 32 + 8 * fq) * 2);
#pragma unroll
        for (int lt = 0; lt < 4; ++lt) {
            acc1[lt] = (f32x4){0.f, 0.f, 0.f, 0.f}; acc2[lt] = (f32x4){0.f, 0.f, 0.f, 0.f};
#pragma unroll
            for (int ks = 0; ks < 2; ++ks) acc1[lt] = mfma16(*(const bf16x8*)(SP + (lt * 16 + fr) * 144 + (ks * 32 + 8 * fq) * 2), Vf[ks], acc1[lt]);
#pragma unroll
            for (int ks = 0; ks < 4; ++ks) acc2[lt] = mfma16(*(const bf16x8*)(QN + (lt * 16 + fr) * 272 + (ks * 32 + 8 * fq) * 2), Cf[ks], acc2[lt]);
        }
    }
    LDS_BARRIER();
#pragma unroll
    for (int lt = 0; lt < 4; ++lt)
#pragma unroll
        for (int r = 0; r < 4; ++r) { const int ll = lt * 16 + 4 * fq + r;
            HM[ll * 132 + wave * 16 + fr] = (acc1[lt][r] + sc[192 + ll] * acc2[lt][r]) * frcp(sc[448 + ll]); }
    LDS_BARRIER();
    {
        bf16_t* mix = (bf16_t*)(a.ws + WS_MIX);
#pragma unroll
        for (int j = 0; j < 2; ++j) { const int pc = tid + j * NT, ll = pc >> 4, q16 = pc & 15;
            const f32x4 h0 = *(const f32x4*)(HM + ll * 132 + q16 * 8), h1 = *(const f32x4*)(HM + ll * 132 + q16 * 8 + 4);
            f32x4 o0, o1; unpack8(R.og[j], o0, o1);
            f32x4 g0, g1;
#pragma unroll
            for (int q = 0; q < 4; ++q) { g0[q] = h0[q] * sigmoidf_(o0[q]); g1[q] = h1[q] * sigmoidf_(o1[q]); }
            const float rs = __builtin_amdgcn_rsqf(sum16(dot8(g0, g1)) * (1.f / 128.f) + EPS);
            *(u32x4*)(mix + (size_t)(row0 + ll) * D + h * DH + q16 * 8) = pack8(g0 * rs * gmv[j][0], g1 * rs * gmv[j][1]); }
    }
    LDS_BARRIER();
}

template <int MODE>
__device__ __forceinline__ void rglru_item(const Args& a, unsigned char* lds, int l, int item) {
    const int b = item >> 6, c = item & 63, row0 = b * SEQ + c * CH, ch = otid(), lane = ch & 63, nb = ch >> 6;
    float* xs = (float*)lds + nb * 64 * 64;
    const bf16_t* z = (const bf16_t*)(a.ws + WS_Z);
    const float* wcr = a.in[I_WCR] + (size_t)l * 4 * DR; const float bcr = a.in[I_BCR][l * DR + ch];
    const float w0 = wcr[ch], w1 = wcr[DR + ch], w2 = wcr[2 * DR + ch], w3 = wcr[3 * DR + ch];
    const bf16_t* zc = z + ZXR + ch;
    float xm3 = 0.f, xm2 = 0.f, xm1 = 0.f;
    { const int s0 = c * CH; if (s0 >= 3) { xm3 = bf2f(zc[(size_t)(row0 - 3) * ZW]); xm2 = bf2f(zc[(size_t)(row0 - 2) * ZW]); xm1 = bf2f(zc[(size_t)(row0 - 1) * ZW]); } }
#pragma unroll 4
    for (int t = 0; t < 64; ++t) { const float x0 = bf2f(zc[(size_t)(row0 + t) * ZW]);
        xs[t * 64 + lane] = bcr + w0 * xm3 + w1 * xm2 + w2 * xm1 + w3 * x0; xm3 = xm2; xm2 = xm1; xm1 = x0; }
    unsigned wa[32], wx[32];
    const float* wra = a.in[I_WRA] + ((size_t)(l * NBR + nb) * 64) * 64 + lane; const float* wri = a.in[I_WRI] + ((size_t)(l * NBR + nb) * 64) * 64 + lane;
#pragma unroll
    for (int d = 0; d < 32; ++d) { wa[d] = pk2(wra[(2 * d) * 64], wra[(2 * d + 1) * 64]); wx[d] = pk2(wri[(2 * d) * 64], wri[(2 * d + 1) * 64]); }
    const float ba = a.in[I_BRA][l * DR + ch], bx = a.in[I_BRI][l * DR + ch];
    const float lam = a.in[I_LAM][l * DR + ch];
    const float sp = fmaxf(-lam, 0.f) + log1pf(__expf(-fabsf(lam)));
    float hst = 0.f, ap = 1.f;
    if (MODE == 1) hst = ((const float*)(a.ws + WS_SMALL + SM_RGP))[(size_t)item * DR + ch];
    const float gr = a.in[I_GR][l * DR + ch];
    bf16_t* mix = (bf16_t*)(a.ws + WS_MIX);
    __syncthreads();
#pragma unroll 1
    for (int t = 0; t < 64; ++t) {
        float ra = ba, ia = bx;
#pragma unroll
        for (int d4 = 0; d4 < 16; ++d4) { const f32x4 xv = *(const f32x4*)(xs + t * 64 + 4 * d4);
#pragma unroll
            for (int q = 0; q < 2; ++q) { const unsigned pa = wa[2 * d4 + q], px = wx[2 * d4 + q];
                ra += xv[2 * q] * __uint_as_float(pa << 16) + xv[2 * q + 1] * __uint_as_float(pa & 0xffff0000u);
                ia += xv[2 * q] * __uint_as_float(px << 16) + xv[2 * q + 1] * __uint_as_float(px & 0xffff0000u); } }
        const float xo = xs[t * 64 + lane];
        const float r = sigmoidf_(ra), ig = sigmoidf_(ia), la = -8.f * r * sp, av = __expf(la);
        const float uu = sqrtf(-expm1f(2.f * la)) * (ig * xo);
        hst = av * hst + uu; ap *= av;
        if (MODE == 1) {
            const float y = bf2f(z[(size_t)(row0 + t) * ZW + ZYR + ch]);
            const float o = hst * gelu_tanh(y);
            const float rs = rsqrtf(wave_sum(o * o) * (1.f / 64.f) + EPS);
            mix[(size_t)(row0 + t) * D + DM + ch] = (bf16_t)f2bf(o * rs * gr);
        }
    }
    if (MODE == 0) { ((float*)(a.ws + WS_SMALL + SM_RGA))[(size_t)item * DR + ch] = ap; ((float*)(a.ws + WS_SMALL + SM_RGH))[(size_t)item * DR + ch] = hst; }
    __syncthreads();
}

template <int MODE>
__device__ __forceinline__ void rglru_fast(const Args& a, unsigned char* lds, int l, int item) {
    const int b = item >> 6, c = item & 63, row0 = b * SEQ + c * CH, ch = otid(), lane = ch & 63, nb = ch >> 6, fr = lane & 15, fq = lane >> 4;
    unsigned char* XA = lds + nb * 9216;
    float* GS = (float*)(lds + 73728 + nb * 8448);
    const bf16_t* z = (const bf16_t*)(a.ws + WS_Z);
    unsigned ypk[32];
    {
        const float* wcr = a.in[I_WCR] + (size_t)l * 4 * DR; const float bcr = a.in[I_BCR][l * DR + ch];
        const float w0 = wcr[ch], w1 = wcr[DR + ch], w2 = wcr[2 * DR + ch], w3 = wcr[3 * DR + ch];
        const bf16_t* zc = z + ZXR + ch;
        bf16_t xin[67];
#pragma unroll
        for (int t = 0; t < 67; ++t) xin[t] = (c == 0 && t < 3) ? (bf16_t)0 : zc[(ptrdiff_t)(row0 + t - 3) * ZW];
        if (MODE == 1) {
            bf16_t yb[64];
#pragma unroll
            for (int t = 0; t < 64; ++t) yb[t] = z[(size_t)(row0 + t) * ZW + ZYR + ch];
#pragma unroll
            for (int t = 0; t < 32; ++t) ypk[t] = (unsigned)yb[2 * t] | ((unsigned)yb[2 * t + 1] << 16);
        }
#pragma unroll
        for (int t = 0; t < 64; ++t)
            *(bf16_t*)(XA + t * 144 + lane * 2) = (bf16_t)f2bf(bcr + w0 * bf2f(xin[t]) + w1 * bf2f(xin[t + 1]) + w2 * bf2f(xin[t + 2]) + w3 * bf2f(xin[t + 3]));
    }
    bf16x8 Bf[8][2];
    { const bf16_t* wt = (const bf16_t*)(a.ws + WS_SMALL + SM_RGW) + (size_t)((l * NBR + nb) * 2) * 64 * 64;
#pragma unroll
        for (int ct = 0; ct < 8; ++ct)
#pragma unroll
            for (int ks = 0; ks < 2; ++ks) Bf[ct][ks] = *(const bf16x8*)(wt + (size_t)((ct >> 2) * 64 + (ct & 3) * 16 + fr) * 64 + ks * 32 + 8 * fq); }
    const float ba = a.in[I_BRA][l * DR + ch], bx = a.in[I_BRI][l * DR + ch];
    const float lam = a.in[I_LAM][l * DR + ch];
    const float sp8 = -8.f * (fmaxf(-lam, 0.f) + log1pf(__expf(-fabsf(lam))));
    float hst = 0.f, ap = 1.f;
    if (MODE == 1) hst = ((const float*)(a.ws + WS_SMALL + SM_RGP))[(size_t)item * DR + ch];
    const float gr = a.in[I_GR][l * DR + ch];
    bf16_t* mix = (bf16_t*)(a.ws + WS_MIX);
    WAVE_LDS_SYNC();
#pragma unroll
    for (int rt = 0; rt < 4; ++rt) {
        bf16x8 Af[2];
#pragma unroll
        for (int ks = 0; ks < 2; ++ks) Af[ks] = *(const bf16x8*)(XA + (rt * 16 + fr) * 144 + (ks * 32 + 8 * fq) * 2);
#pragma unroll
        for (int ct = 0; ct < 8; ++ct) {
            f32x4 acc = {0.f, 0.f, 0.f, 0.f};
            acc = mfma16(Af[0], Bf[ct][0], acc); acc = mfma16(Af[1], Bf[ct][1], acc);
#pragma unroll
            for (int r = 0; r < 4; ++r) GS[(4 * fq + r) * 132 + (ct >> 2) * 64 + (ct & 3) * 16 + fr] = acc[r];
        }
        WAVE_LDS_SYNC();
        {
            float ra[16], ia[16], xo[16], ov_[16], apv_[16];
#pragma unroll
            for (int tt = 0; tt < 16; ++tt) { ra[tt] = GS[tt * 132 + lane]; ia[tt] = GS[tt * 132 + 64 + lane]; xo[tt] = bf2f(*(const bf16_t*)(XA + (rt * 16 + tt) * 144 + lane * 2)); }
#pragma unroll
            for (int tt = 0; tt < 16; ++tt) {
                const float r = sigmoidf_(ra[tt] + ba), ig = sigmoidf_(ia[tt] + bx), la = sp8 * r, av = __expf(la);
                const float uu = __builtin_amdgcn_sqrtf(fmaxf(fmaf(-av, av, 1.f), 0.f)) * (ig * xo[tt]);
                hst = av * hst + uu; ap *= av;
                ov_[tt] = hst; apv_[tt] = ap;
            }
            if (MODE == 0) {
                unsigned char* GB = (unsigned char*)GS;
#pragma unroll
                for (int tt = 0; tt < 16; ++tt) { *(bf16_t*)(GB + tt * 128 + lane * 2) = (bf16_t)f2bf(ov_[tt]); *(bf16_t*)(GB + 2048 + tt * 128 + lane * 2) = (bf16_t)f2bf(apv_[tt]); }
                WAVE_LDS_SYNC();
                bf16_t* hlp = (bf16_t*)a.out; bf16_t* ppp = hlp + (size_t)M * DR;
#pragma unroll
                for (int j = 0; j < 2; ++j) { const int p = lane + 64 * j; const size_t off = (size_t)(row0 + rt * 16 + (p >> 3)) * DR + nb * 64 + (p & 7) * 8;
                    *(u32x4*)(hlp + off) = *(const u32x4*)(GB + p * 16); *(u32x4*)(ppp + off) = *(const u32x4*)(GB + 2048 + p * 16); }
            }
            if (MODE == 1) {
#pragma unroll
                for (int tt = 0; tt < 16; ++tt) *(bf16_t*)(XA + (rt * 16 + tt) * 144 + lane * 2) = (bf16_t)f2bf(ov_[tt] * gelu_tanh((tt & 1) ? __uint_as_float(ypk[rt * 8 + (tt >> 1)] & 0xffff0000u) : bf2f(ypk[rt * 8 + (tt >> 1)] & 0xffffu)));
            }
        }
        WAVE_LDS_SYNC();
    }
    if (MODE == 1) {
        float ss = 0.f;
#pragma unroll
        for (int j = 0; j < 8; ++j) { const u32x4 v = *(const u32x4*)(XA + lane * 144 + j * 16);
#pragma unroll
            for (int q = 0; q < 4; ++q) { const float lo = bf2f(v[q] & 0xffffu), hi = __uint_as_float(v[q] & 0xffff0000u); ss += lo * lo + hi * hi; } }
        const float rs = rsqrtf(ss * (1.f / 64.f) + EPS) ;
#pragma unroll
        for (int t0 = 0; t0 < 64; t0 += 16) { float ovv[16];
#pragma unroll
            for (int tt = 0; tt < 16; ++tt) ovv[tt] = bf2f(*(const bf16_t*)(XA + (t0 + tt) * 144 + lane * 2));
#pragma unroll
            for (int tt = 0; tt < 16; ++tt) { const float rst = __int_as_float(__builtin_amdgcn_readlane(__float_as_int(rs), t0 + tt));
                *(bf16_t*)(XA + (t0 + tt) * 144 + lane * 2) = (bf16_t)f2bf(ovv[tt] * rst * gr); } }
        WAVE_LDS_SYNC();
#pragma unroll
        for (int j = 0; j < 8; ++j) { const int t = j * 8 + (lane >> 3), q16 = lane & 7;
            *(u32x4*)(mix + (size_t)(row0 + t) * D + DM + nb * 64 + q16 * 8) = *(const u32x4*)(XA + t * 144 + q16 * 16); }
    }
    if (MODE == 0) { ((float*)(a.ws + WS_SMALL + SM_RGA))[(size_t)item * DR + ch] = ap; ((float*)(a.ws + WS_SMALL + SM_RGH))[(size_t)item * DR + ch] = hst; }
    LDS_BARRIER();
}
__device__ __forceinline__ void rglru_out(const Args& a, int l, int item) {
    const int b = item >> 6, c = item & 63, row0 = b * SEQ + c * CH, tid = otid(), lane = tid & 63, nb = tid >> 6, ch0 = nb * 64 + (lane & 7) * 8, t0 = lane >> 3;
    const bf16_t* z = (const bf16_t*)(a.ws + WS_Z);
    const bf16_t* hlp = (const bf16_t*)a.out; const bf16_t* ppp = hlp + (size_t)M * DR;
    bf16_t* mix = (bf16_t*)(a.ws + WS_MIX);
    u32x4 hv[8], pv[8], yv[8];
#pragma unroll
    for (int j = 0; j < 8; ++j) { const size_t r = (size_t)(row0 + j * 8 + t0);
        hv[j] = *(const u32x4*)(hlp + r * DR + ch0); pv[j] = *(const u32x4*)(ppp + r * DR + ch0); yv[j] = *(const u32x4*)(z + r * ZW + ZYR + ch0); }
    const float* cp = (const float*)(a.ws + WS_SMALL + SM_RGP) + (size_t)item * DR + ch0; const f32x4 c0 = *(const f32x4*)cp, c1 = *(const f32x4*)(cp + 4);
    const float* gp = a.in[I_GR] + l * DR + ch0; const f32x4 g0 = *(const f32x4*)gp, g1 = *(const f32x4*)(gp + 4);
#pragma unroll
    for (int j = 0; j < 8; ++j) {
        f32x4 h0, h1, p0, p1, y0, y1; unpack8(hv[j], h0, h1); unpack8(pv[j], p0, p1); unpack8(yv[j], y0, y1);
        f32x4 o0, o1;
#pragma unroll
        for (int q = 0; q < 4; ++q) { o0[q] = (h0[q] + p0[q] * c0[q]) * gelu_tanh(y0[q]); o1[q] = (h1[q] + p1[q] * c1[q]) * gelu_tanh(y1[q]); }
        const float rs = __builtin_amdgcn_rsqf(sum8(dot8(o0, o1)) * (1.f / 64.f) + EPS);
        *(u32x4*)(mix + (size_t)(row0 + j * 8 + t0) * D + DM + ch0) = pack8(o0 * rs * g0, o1 * rs * g1);
    }
}
__device__ __forceinline__ void rglru_scan(const Args& a, int G) {
    const int tid = otid(), lane = tid & 63, wave = tid >> 6;
    for (int i = blockIdx.x * 8 + wave; i < NBATCH * DR; i += G * 8) {
        const int b = i / DR, ch = i % DR; const size_t o = (size_t)(b * NC + lane) * DR + ch;
        float A = ((const float*)(a.ws + WS_SMALL + SM_RGA))[o], H = ((const float*)(a.ws + WS_SMALL + SM_RGH))[o];
#pragma unroll
        for (int d = 1; d < 64; d <<= 1) { const float Ap = __shfl_up(A, d), Hp = __shfl_up(H, d); if (lane >= d) { H = A * Hp + H; A = A * Ap; } }
        const float pin = __shfl_up(H, 1);
        ((float*)(a.ws + WS_SMALL + SM_RGP))[o] = lane == 0 ? 0.f : pin;
    }
}

__device__ __forceinline__ void phase_route(const Args& a, unsigned char* lds) {
    unsigned* wtot = (unsigned*)lds;
    int* pre = (int*)(lds + 256);
    int* tot = pre + 8;
    int* ce = tot + 16;
    unsigned* pref = (unsigned*)(lds + 2048);
    const int tid = otid(), lane = tid & 63, wave = tid >> 6, G = gridDim.x;
    const unsigned char* tok_p = (const unsigned char*)(a.ws + WS_SMALL + SM_TOKP); const float* tok_g = (const float*)(a.ws + WS_SMALL + SM_TOKG);
    int* row_tok = (int*)(a.ws + WS_SMALL + SM_ROWTOK); float* row_gate = (float*)(a.ws + WS_SMALL + SM_ROWGATE); int* tile_e = (int*)(a.ws + WS_SMALL + SM_TILEE);
    if (tid < 256) {
        unsigned long long hh = 0ull;
#pragma unroll
        for (int j = 0; j < 4; ++j) { const u32x4 v = ((const u32x4*)(tok_p + tid * 64))[j];
#pragma unroll
            for (int q = 0; q < 4; ++q)
#pragma unroll
                for (int bb = 0; bb < 4; ++bb) { const unsigned by = (v[q] >> (8 * bb)) & 0xffu; hh += (1ull << (8 * (by & 15u))) + (1ull << (8 * (by >> 4))); } }
        unsigned w[4];
#pragma unroll
        for (int i = 0; i < 4; ++i) { const unsigned two = (unsigned)(hh >> (16 * i)) & 0xffffu; w[i] = (two & 0xffu) | ((two >> 8) << 16); }
        unsigned inc[4];
#pragma unroll
        for (int i = 0; i < 4; ++i) { unsigned x = w[i];
#pragma unroll
            for (int o = 1; o < 64; o <<= 1) { const unsigned n = __shfl_up(x, o); if (lane >= o) x += n; }
            inc[i] = x; }
        if (lane == 63) {
#pragma unroll
            for (int i = 0; i < 4; ++i) wtot[wave * 4 + i] = inc[i]; }
        __builtin_amdgcn_s_waitcnt(0);
        __builtin_amdgcn_s_barrier();
#pragma unroll
        for (int i = 0; i < 4; ++i) { unsigned base = 0u;
            for (int ww = 0; ww < wave; ++ww) base += wtot[ww * 4 + i];
            pref[tid * 4 + i] = base + inc[i] - w[i];
            if (tid == 255) { const unsigned t2 = base + inc[i]; tot[2 * i] = (int)(t2 & 0xffffu); tot[2 * i + 1] = (int)(t2 >> 16); } }
    } else {
        __builtin_amdgcn_s_barrier();
    }
    __syncthreads();
    if (tid == 0) { int s_ = 0; for (int e = 0; e < 8; ++e) { tot[8 + e] = s_; s_ += (tot[e] + 255) & ~255; }
        if (blockIdx.x == 0) { int t = 0; for (int e = 0; e < 8; ++e) { const int n = (tot[e] + 255) >> 8; for (int j = 0; j < n; ++j) tile_e[t++] = e; tile_e[256 + e] = t; } tile_e[255] = t; } }
    __syncthreads();
    for (int ck = blockIdx.x; ck < 256; ck += G) {
        if (tid < 128) { const unsigned by = tok_p[ck * 64 + (tid >> 1)]; ce[tid] = (tid & 1) ? (int)(by >> 4) : (int)(by & 15u); }
        __syncthreads();
        if (tid < 128) { const int e = ce[tid];
            int rank = 0, w0cnt = 0;
#pragma unroll
            for (int q = 0; q < 8; ++q) { const unsigned long long mk = __ballot(e == q); if (e == q) rank = __popcll(mk & ((1ull << lane) - 1ull)); if (wave == 0 && lane == 0) ce[128 + q] = __popcll(mk); }
            __builtin_amdgcn_s_waitcnt(0);
            asm volatile("s_barrier" ::: "memory");
            if (wave == 1) rank += ce[128 + e];
            (void)w0cnt;
            const unsigned pw = pref[ck * 4 + (e >> 1)]; const int pr = (int)((e & 1) ? (pw >> 16) : (pw & 0xffffu));
            const int dest = tot[8 + e] + pr + rank;
            row_tok[dest] = ck * 64 + (tid >> 1); row_gate[dest] = tok_g[ck * 128 + tid]; ((int*)(a.ws + WS_SMALL + SM_ROWSLOT))[dest] = tid & 1; }
        else { asm volatile("s_barrier" ::: "memory"); }
        __syncthreads();
    }
}

#ifndef GEMM
#define GEMM gemm_fast
#endif
__global__ void __launch_bounds__(NT, 2) mk_fwd(Args a0) {
    extern __shared__ __attribute__((aligned(16))) unsigned char lds[];
    const int G = gridDim.x, bid = blockIdx.x, ph_lo = a0.ph_lo, ph_hi = a0.ph_hi;
    volatile LAS unsigned* xst = (volatile LAS unsigned*)(lds + LDS_BYTES - 64);
    if (threadIdx.x < 2) xst[threadIdx.x] = 0u;
    __syncthreads();
    const XcdBarrier xb = xcd_barrier_post((unsigned*)(a0.ws + WS_SMALL + SM_BAR), xst);
    int ph = 0;
#ifndef PROBE_CAT
#define PROBE_CAT 0
#define PROBE_N 1
#endif
#define PHASE_BEGIN(cat) if (ph >= ph_lo && ph < ph_hi) { for (int rep_ = 0; rep_ < ((cat) == PROBE_CAT ? PROBE_N : 1); ++rep_) { const bool lastrep = (rep_ + 1 == ((cat) == PROBE_CAT ? PROBE_N : 1)); (void)lastrep; const Args& a = *(const Args*)okarg(); unsigned char* const ws = a.ws; \
    bf16_t* const hn = (bf16_t*)(ws + WS_HN); bf16_t* const z = (bf16_t*)(ws + WS_Z); bf16_t* const mix = (bf16_t*)(ws + WS_MIX); bf16_t* const hid = (bf16_t*)(ws + WS_HID); \
    float* const gates = (float*)(ws + WS_SMALL + SM_GATES); int* const tok_e = (int*)(ws + WS_SMALL + SM_TOKP); float* const tok_g = (float*)(ws + WS_SMALL + SM_TOKG); \
    const int* const row_tok = (const int*)(ws + WS_SMALL + SM_ROWTOK); const float* const row_gate = (const float*)(ws + WS_SMALL + SM_ROWGATE); const int* const tile_e = (const int*)(ws + WS_SMALL + SM_TILEE); \
    (void)hn; (void)z; (void)mix; (void)hid; (void)gates; (void)tok_e; (void)tok_g; (void)row_tok; (void)row_gate; (void)tile_e;
#define PHASE_END(dosync) } for (int rep_ = 0; rep_ < (PROBE_CAT == 6 ? PROBE_N : 1); ++rep_) if ((dosync) && ph + 1 < ph_hi) { xcd_barrier(xb); } } ++ph;

    PHASE_BEGIN(1) phase_prologue(a, lds); __syncthreads();
        phase_rowpass_mm<0, 1>(lds, a.in[I_X], hn, a.in[I_GMIX], (float*)(ws + WS_SSQ), a.in[I_WIN] + 2048, DIN, a.in[I_BIN] + 2048, gates, nullptr, nullptr, nullptr); PHASE_END(true)
    { constexpr int l = 0;
#define LAYER_PTRS bf16_t* const hb = (bf16_t*)(ws + (l ? WS_H1 : WS_HN)); bf16_t* const hbo = (bf16_t*)(ws + (l ? WS_HN : WS_H1)); float* const ssq = (float*)(ws + WS_SSQ + l * SSQ_STRIDE); float* const ssqo = (float*)(ws + WS_SSQ + (1 - l) * SSQ_STRIDE); (void)hb; (void)hbo; (void)ssq; (void)ssqo;
        PHASE_BEGIN(3) LAYER_PTRS { if (l == 1) phase_rowpass_mm<1, 1>(lds, nullptr, hb, a.in[I_GMIX] + l * D, nullptr, a.in[I_WIN] + (size_t)l * D * DIN + 2048, DIN, a.in[I_BIN] + l * DIN + 2048, gates, nullptr, nullptr, nullptr);
            GridOrder S{M / 256, ZW / 256, G, bid}; EpiZ E{z, a.in[I_BIN] + l * DIN, ssq};
            GEMM(lds, hb, (const bf16_t*)(ws + (l ? WS_W_IN1 : WS_W_IN0)), D, S, E); } PHASE_END(true)
        PHASE_BEGIN(4) LAYER_PTRS { MlRegs cur, nxt; int it = bid; if (it < 1024) ml_load(a, l, it, cur); nxt = cur;
            for (; it < 1024; it += G) { if (it + G < 1024) ml_load(a, l, it + G, nxt); ml_compute(a, lds, l, it, cur); cur = nxt; }
            for (; it < 1280; it += G) rglru_fast<0>(a, lds, l, it - 1024); } PHASE_END(true)
        PHASE_BEGIN(0) LAYER_PTRS mlstm_scan(a, G); rglru_scan(a, G); PHASE_END(true)
        PHASE_BEGIN(5) LAYER_PTRS { MoRegs cur, nxt; ConvW cwq, cwk; int hw = -1; int it = bid; if (it < 1024) mo_load(a, l, it, cur); nxt = cur;
            for (; it < 1024; it += G) { if (it + G < 1024) mo_load(a, l, it + G, nxt); mo_compute(a, lds, l, it, cur, cwq, cwk, hw); cur = nxt; }
            for (; it < 1280; it += G) rglru_out(a, l, it - 1024); } PHASE_END(true)
        PHASE_BEGIN(0) LAYER_PTRS { GridOrder S{M / 256, D / 256, G, bid}; EpiHres<l == 0> E{l == 0 ? a.in[I_X] : nullptr, hb, ssq};
            GEMM(lds, mix, (const bf16_t*)(ws + (l ? WS_W_OUT1 : WS_W_OUT0)), D, S, E); } PHASE_END(true)
        if (l == 0) {
            PHASE_BEGIN(3) LAYER_PTRS { GridOrder S{M / 256, 2 * DFF / 256, G, bid}; EpiSwiglu E{hid, ssq, nullptr};
                GEMM(lds, hb, (const bf16_t*)(ws + WS_W_FFGU), D, S, E);
                { constexpr int nun = (M / 256) * (2 * DFF / 256); const int first = nun % G;
                  TailOrder S2{M / 256, D / 256, G, bid, first}; EpiStoreBf16 E2{(bf16_t*)(ws + WS_PP0)};
                  GEMM(lds, (const bf16_t*)(ws + WS_PB0), (const bf16_t*)(ws + WS_W_PP0), DPLE, S2, E2); } } PHASE_END(true)
            PHASE_BEGIN(0) LAYER_PTRS { GridOrder S{M / 256, D / 256, G, bid}; EpiHres<false> E{nullptr, hb, ssq};
                GEMM(lds, hid, (const bf16_t*)(ws + WS_W_FFD), DFF, S, E); } PHASE_END(true)
        } else {
            PHASE_BEGIN(2) LAYER_PTRS phase_rowpass_mm<1, 2>(lds, nullptr, hb, a.in[I_GFFN] + l * D, nullptr, a.in[I_WROUTER], 8, nullptr, nullptr, (unsigned char*)tok_e, tok_g, ws + WS_HN8); PHASE_END(true)
            PHASE_BEGIN(12) LAYER_PTRS phase_route(a, lds); PHASE_END(true)
            PHASE_BEGIN(3) LAYER_PTRS { MoeOrder<true> S{tile_e[255], 2 * DFF / 256, G, bid, row_tok, (size_t)5632 * D}; S.init(tile_e); EpiSwiglu8 E{ws + WS_HID, 1.f / 32.f};
                gemm_fast<true>(lds, (const bf16_t*)(ws + WS_HN8), (const bf16_t*)(ws + WS_W_EGU), D, S, E); } PHASE_END(true)
            PHASE_BEGIN(0) LAYER_PTRS { MoeOrder<false> S{tile_e[255], D / 256, G, bid, nullptr, (size_t)D * DFF}; S.init(tile_e); EpiMoeDown E{hb, (bf16_t*)a.out, row_tok, (const int*)(ws + WS_SMALL + SM_ROWSLOT), row_gate, 1.f / 32.f};
                gemm_fast<true>(lds, (const bf16_t*)(ws + WS_HID), (const bf16_t*)(ws + WS_W_ED), DFF, S, E);
                { const int nun = tile_e[255] * (D / 256); const int first = nun > 2 * G ? nun - 2 * G : 0;
                  TailOrder S2{M / 256, D / 256, G, bid, first < G ? first : 0}; EpiStoreBf16 E2{(bf16_t*)a.out + (size_t)M * D};
                  GEMM(lds, (const bf16_t*)(ws + WS_PB1), (const bf16_t*)(ws + WS_W_PP1), DPLE, S2, E2); } } PHASE_END(true)
            PHASE_BEGIN(0) LAYER_PTRS phase_rowpass<1, 0, 1, true>(lds, nullptr, hb, (const bf16_t*)a.out, nullptr, ssq, nullptr, 0, nullptr, nullptr, nullptr, nullptr, nullptr); PHASE_END(true)
        }
        PHASE_BEGIN(10) LAYER_PTRS { GridOrder S{M / 256, D / 256, G, bid};
            EpiPle E{hb, hbo, l == 0 ? (const bf16_t*)(ws + WS_PP0) : (const bf16_t*)a.out + (size_t)M * D, ssqo, ssq}; GEMM(lds, hb, (const bf16_t*)(ws + WS_W_PG) + (size_t)l * D * D, D, S, E);
            if (l == 0 && bid == 0) { for (int i = otid(); i < D / 2; i += NT) ((unsigned*)(ws + WS_H1 + (size_t)M * D * 2))[i] = 0u; } } PHASE_END(true)
    }
    { constexpr int l = 1;
        PHASE_BEGIN(3) LAYER_PTRS { if (l == 1) phase_rowpass_mm<1, 1>(lds, nullptr, hb, a.in[I_GMIX] + l * D, nullptr, a.in[I_WIN] + (size_t)l * D * DIN + 2048, DIN, a.in[I_BIN] + l * DIN + 2048, gates, nullptr, nullptr, nullptr);
            GridOrder S{M / 256, ZW / 256, G, bid}; EpiZ E{z, a.in[I_BIN] + l * DIN, ssq};
            GEMM(lds, hb, (const bf16_t*)(ws + (l ? WS_W_IN1 : WS_W_IN0)), D, S, E); } PHASE_END(true)
        PHASE_BEGIN(4) LAYER_PTRS { MlRegs cur, nxt; int it = bid; if (it < 1024) ml_load(a, l, it, cur); nxt = cur;
            for (; it < 1024; it += G) { if (it + G < 1024) ml_load(a, l, it + G, nxt); ml_compute(a, lds, l, it, cur); cur = nxt; }
            for (; it < 1280; it += G) rglru_fast<0>(a, lds, l, it - 1024); } PHASE_END(true)
        PHASE_BEGIN(0) LAYER_PTRS mlstm_scan(a, G); rglru_scan(a, G); PHASE_END(true)
        PHASE_BEGIN(5) LAYER_PTRS { MoRegs cur, nxt; ConvW cwq, cwk; int hw = -1; int it = bid; if (it < 1024) mo_load(a, l, it, cur); nxt = cur;
            for (; it < 1024; it += G) { if (it + G < 1024) mo_load(a, l, it + G, nxt); mo_compute(a, lds, l, it, cur, cwq, cwk, hw); cur = nxt; }
            for (; it < 1280; it += G) rglru_out(a, l, it - 1024); } PHASE_END(true)
        PHASE_BEGIN(0) LAYER_PTRS { GridOrder S{M / 256, D / 256, G, bid}; EpiHres<l == 0> E{l == 0 ? a.in[I_X] : nullptr, hb, ssq};
            GEMM(lds, mix, (const bf16_t*)(ws + (l ? WS_W_OUT1 : WS_W_OUT0)), D, S, E); } PHASE_END(true)
        if (l == 0) {
            PHASE_BEGIN(3) LAYER_PTRS { GridOrder S{M / 256, 2 * DFF / 256, G, bid}; EpiSwiglu E{hid, ssq, nullptr};
                GEMM(lds, hb, (const bf16_t*)(ws + WS_W_FFGU), D, S, E);
                { constexpr int nun = (M / 256) * (2 * DFF / 256); const int first = nun % G;
                  TailOrder S2{M / 256, D / 256, G, bid, first}; EpiStoreBf16 E2{(bf16_t*)(ws + WS_PP0)};
                  GEMM(lds, (const bf16_t*)(ws + WS_PB0), (const bf16_t*)(ws + WS_W_PP0), DPLE, S2, E2); } } PHASE_END(true)
            PHASE_BEGIN(0) LAYER_PTRS { GridOrder S{M / 256, D / 256, G, bid}; EpiHres<false> E{nullptr, hb, ssq};
                GEMM(lds, hid, (const bf16_t*)(ws + WS_W_FFD), DFF, S, E); } PHASE_END(true)
        } else {
            PHASE_BEGIN(2) LAYER_PTRS phase_rowpass_mm<1, 2>(lds, nullptr, hb, a.in[I_GFFN] + l * D, nullptr, a.in[I_WROUTER], 8, nullptr, nullptr, (unsigned char*)tok_e, tok_g, ws + WS_HN8); PHASE_END(true)
            PHASE_BEGIN(12) LAYER_PTRS phase_route(a, lds); PHASE_END(true)
            PHASE_BEGIN(3) LAYER_PTRS { MoeOrder<true> S{tile_e[255], 2 * DFF / 256, G, bid, row_tok, (size_t)5632 * D}; S.init(tile_e); EpiSwiglu8 E{ws + WS_HID, 1.f / 32.f};
                gemm_fast<true>(lds, (const bf16_t*)(ws + WS_HN8), (const bf16_t*)(ws + WS_W_EGU), D, S, E); } PHASE_END(true)
            PHASE_BEGIN(0) LAYER_PTRS { MoeOrder<false> S{tile_e[255], D / 256, G, bid, nullptr, (size_t)D * DFF}; S.init(tile_e); EpiMoeDown E{hb, (bf16_t*)a.out, row_tok, (const int*)(ws + WS_SMALL + SM_ROWSLOT), row_gate, 1.f / 32.f};
                gemm_fast<true>(lds, (const bf16_t*)(ws + WS_HID), (const bf16_t*)(ws + WS_W_ED), DFF, S, E);
                { const int nun = tile_e[255] * (D / 256); const int first = nun > 2 * G ? nun - 2 * G : 0;
                  TailOrder S2{M / 256, D / 256, G, bid, first < G ? first : 0}; EpiStoreBf16 E2{(bf16_t*)a.out + (size_t)M * D};
                  GEMM(lds, (const bf16_t*)(ws + WS_PB1), (const bf16_t*)(ws + WS_W_PP1), DPLE, S2, E2); } } PHASE_END(true)
            PHASE_BEGIN(0) LAYER_PTRS phase_rowpass<1, 0, 1, true>(lds, nullptr, hb, (const bf16_t*)a.out, nullptr, ssq, nullptr, 0, nullptr, nullptr, nullptr, nullptr, nullptr); PHASE_END(true)
        }
        PHASE_BEGIN(10) LAYER_PTRS { GridOrder S{M / 256, D / 256, G, bid};
            EpiPle E{hb, hbo, l == 0 ? (const bf16_t*)(ws + WS_PP0) : (const bf16_t*)a.out + (size_t)M * D, ssqo, ssq}; GEMM(lds, hb, (const bf16_t*)(ws + WS_W_PG) + (size_t)l * D * D, D, S, E);
            if (l == 0 && bid == 0) { for (int i = otid(); i < D / 2; i += NT) ((unsigned*)(ws + WS_H1 + (size_t)M * D * 2))[i] = 0u; } } PHASE_END(true)
    }
    PHASE_BEGIN(0) phase_rowpass<1, 0, 2, false>(lds, nullptr, hn, nullptr, a.in[I_GFINAL], nullptr, nullptr, 0, nullptr, nullptr, nullptr, nullptr, a.out); PHASE_END(false)
}

extern "C" void kernel_launch(void* const* d_in, const int* in_sizes, int n_in, void* d_out, int out_size,
                              void* d_ws, size_t ws_size, hipStream_t stream) {
    static int grid = 0;
    if (grid == 0) {
        if (n_in != 29 || out_size != M * D || ws_size < WS_END) { fprintf(stderr, "kernel_launch: unexpected problem (n_in %d out %d ws %zu)\n", n_in, out_size, ws_size); grid = -1; return; }
        int dev = 0, cus = 0, per_cu = 0;
        (void)hipGetDevice(&dev);
        (void)hipDeviceGetAttribute(&cus, hipDeviceAttributeMultiprocessorCount, dev);
        (void)hipFuncSetAttribute((const void*)mk_fwd, hipFuncAttributeMaxDynamicSharedMemorySize, LDS_BYTES);
        (void)hipOccupancyMaxActiveBlocksPerMultiprocessor(&per_cu, (const void*)mk_fwd, NT, LDS_BYTES);
        if (per_cu < 1) { fprintf(stderr, "kernel_launch: occupancy query says %d blocks per CU\n", per_cu); per_cu = 1; }
        grid = cus;
    }
    if (grid < 0) return;
    Args a{};
    for (int i = 0; i < 29; ++i) a.in[i] = (const float*)d_in[i];
    a.out = (float*)d_out; a.ws = (unsigned char*)d_ws; a.ph_lo = 0; a.ph_hi = 1000;
    (void)hipMemsetAsync((unsigned char*)d_ws + WS_SMALL + SM_BAR, 0, 16 * 1024, stream);
    void* args[] = {&a};
    hipError_t e = hipLaunchCooperativeKernel((void*)mk_fwd, dim3(grid), dim3(NT), args, LDS_BYTES, stream);
    if (e != hipSuccess) fprintf(stderr, "cooperative launch failed: %s (grid %d)\n", hipGetErrorString(e), grid);
}
```

```cpp
#include <hip/hip_runtime.h>
#include <hip/hip_cooperative_groups.h>
#include <cstdio>
#include <cstdint>
namespace cg = cooperative_groups;

constexpr int NT = 512;
constexpr int D = 1024, NBATCH = 4, SEQ = 4096, M = NBATCH * SEQ;
constexpr int CH = 64, NC = SEQ / CH, NH = 4, DH = 128, DM = 512, DR = 512, NBR = 8, DBR = 64;
constexpr int DIN = 3080, ZW = 3072, DFF = 2816, NE = 8, DPLE = 256;
constexpr int PMAX = 2 * M + NE * 256, NTILE_MAX = PMAX / 256;
constexpr int EROWS = 129;
constexpr float EPS = 1e-6f;
constexpr int ZQ = 0, ZK = 512, ZV = 1024, ZO = 1536, ZXR = 2048, ZYR = 2560;

constexpr size_t MiB = 1u << 20;
constexpr size_t WS_SMALL = 0;
constexpr size_t WS_W_IN0 = 4 * MiB;
constexpr size_t WS_W_OUT0 = 10 * MiB;
constexpr size_t WS_W_FFGU = 12 * MiB;
constexpr size_t WS_W_FFD = 23 * MiB;
constexpr size_t WS_PB0 = WS_W_FFD + 5632 * 1024;
constexpr size_t WS_W_PP0 = WS_PB0 + 8 * MiB;
constexpr size_t WS_H1 = 4 * MiB;
constexpr size_t WS_W_IN1 = 37 * MiB;
constexpr size_t WS_W_OUT1 = 43 * MiB;
constexpr size_t WS_W_PG = 45 * MiB;
constexpr size_t WS_W_PP1 = 49 * MiB;
constexpr size_t WS_W_EGU = WS_W_PP1 + MiB / 2;
constexpr size_t WS_W_ED = WS_W_EGU + 88 * MiB;
constexpr size_t WS_HN8 = WS_W_EGU + 44 * MiB;
constexpr size_t WS_PB1 = WS_W_ED + 44 * MiB;
constexpr size_t WS_HN = WS_PB1 + 8 * MiB;
static_assert(WS_H1 + (size_t)(M + 1) * D * 2 <= WS_W_IN1 && WS_W_PP0 + 1024 * 256 * 2 <= WS_W_IN1, "map");
constexpr size_t WS_RF = 222 * MiB;
constexpr size_t WS_Z = WS_RF;
constexpr size_t WS_CT = WS_Z + 96 * MiB;
constexpr size_t WS_DN = WS_CT + 32 * MiB;
constexpr size_t WS_MIX = WS_CT + 72 * MiB;
constexpr size_t WS_HID = WS_RF;
constexpr size_t WS_PP0 = WS_RF + 130 * MiB;
constexpr size_t WS_SSQ = WS_RF + 201 * MiB;
constexpr size_t SSQ_STRIDE = (size_t)(M + 16) * 64;
constexpr size_t WS_SCAL = WS_RF + 204 * MiB;
constexpr size_t WS_END = 435 * MiB;
static_assert(WS_MIX + (size_t)M * D * 2 <= WS_SSQ && WS_HID + (size_t)PMAX * DFF * 2 <= WS_SSQ && WS_SSQ + 2 * SSQ_STRIDE <= WS_END, "map");
static_assert(WS_HN + (size_t)(M + 1) * D * 2 <= WS_RF, "map");
static_assert(WS_MIX + (size_t)M * D * 2 <= WS_END, "map");
static_assert(WS_HID + (size_t)PMAX * DFF * 2 <= WS_END, "map");
static_assert(WS_DN + 1024 * 128 * 4 <= WS_PP0 && WS_PP0 + (size_t)M * D * 2 <= WS_MIX && WS_HID + (size_t)M * DFF * 2 <= WS_PP0, "map");
constexpr size_t SM_GATES = 0;
constexpr size_t SM_TOKE = 512 * 1024;
constexpr size_t SM_TOKG = SM_TOKE + 128 * 1024;
constexpr size_t SM_ROWTOK = SM_TOKG + 128 * 1024;
constexpr size_t SM_ROWGATE = SM_ROWTOK + 160 * 1024;
constexpr size_t SM_TILEE = SM_ROWGATE + 160 * 1024;
constexpr size_t SM_ROWSLOT = SM_TILEE + 4 * 1024;
constexpr size_t SM_TOKP = SM_ROWSLOT + 160 * 1024;
constexpr size_t SM_BL = SM_TOKP + 16 * 1024;
constexpr size_t SM_AMAX = SM_BL + 4 * 1024;
constexpr size_t SM_MPREV = SM_AMAX + 4 * 1024;
constexpr size_t SM_RGA = 2 * MiB;
constexpr size_t SM_RGH = SM_RGA + 512 * 1024;
constexpr size_t SM_RGP = SM_RGH + 512 * 1024;
constexpr size_t SM_BAR = SM_RGP + 512 * 1024;
constexpr size_t SM_RGW = SM_BAR + 16 * 1024;
static_assert(SM_MPREV + 4096 <= SM_RGA && SM_RGW + 256 * 1024 <= 4 * MiB, "small map");

constexpr int LDS_BYTES = 147456;

typedef unsigned short bf16_t;
typedef float f32x4 __attribute__((ext_vector_type(4)));
typedef unsigned u32x4 __attribute__((ext_vector_type(4)));
typedef unsigned u32x2 __attribute__((ext_vector_type(2)));

__device__ __forceinline__ float bf2f(unsigned v) { return __uint_as_float(v << 16); }
__device__ __forceinline__ unsigned pk2(float lo, float hi);
__device__ __forceinline__ unsigned f2bf(float f) { return pk2(f, 0.f) & 0xffffu; }
typedef float f32x2_t __attribute__((ext_vector_type(2))); typedef __bf16 bf16x2_t __attribute__((ext_vector_type(2)));
__device__ __forceinline__ unsigned pk2(float lo, float hi) { f32x2_t v = {lo, hi}; bf16x2_t b = __builtin_convertvector(v, bf16x2_t); return __builtin_bit_cast(unsigned, b); }
__device__ __forceinline__ unsigned pk4_fp8(float a, float b, float c, float d) { int w = __builtin_amdgcn_cvt_pk_fp8_f32(a, b, 0, false); w = __builtin_amdgcn_cvt_pk_fp8_f32(c, d, w, true); return (unsigned)w; }
__device__ __forceinline__ float frcp(float x) { return __builtin_amdgcn_rcpf(x); }
__device__ __forceinline__ float sigmoidf_(float x) { return frcp(1.f + __expf(-x)); }
__device__ __forceinline__ float siluf_(float x) { return x * frcp(1.f + __expf(-x)); }
__device__ __forceinline__ float logsigmoidf_(float x) { return fminf(x, 0.f) - log1pf(__expf(-fabsf(x))); }
__device__ __forceinline__ float gelu_tanh(float y) { const float u2 = 1.5957691216057308f * (y + 0.044715f * y * y * y); return y * frcp(1.f + __expf(-u2)); }
__device__ __forceinline__ float wave_sum(float v) {
#pragma unroll
    for (int o = 1; o < 64; o <<= 1) v += __shfl_xor(v, o);
    return v;
}
__device__ __forceinline__ float wave_max(float v) {
#pragma unroll
    for (int o = 1; o < 64; o <<= 1) v = fmaxf(v, __shfl_xor(v, o));
    return v;
}

__device__ __forceinline__ float dpp_f(float v, const int ctrl_sel) {
    const int x = __float_as_int(v); int r;
    if (ctrl_sel == 0) r = __builtin_amdgcn_update_dpp(x, x, 0xB1, 0xF, 0xF, false);
    else if (ctrl_sel == 1) r = __builtin_amdgcn_update_dpp(x, x, 0x4E, 0xF, 0xF, false);
    else if (ctrl_sel == 2) r = __builtin_amdgcn_update_dpp(x, x, 0x141, 0xF, 0xF, false);
    else r = __builtin_amdgcn_update_dpp(x, x, 0x140, 0xF, 0xF, false);
    return __int_as_float(r);
}
__device__ __forceinline__ float sum4(float v) { v += dpp_f(v, 0); v += dpp_f(v, 1); return v; }
__device__ __forceinline__ float sum8(float v) { v = sum4(v); v += dpp_f(v, 2); return v; }
__device__ __forceinline__ float sum16(float v) { v = sum8(v); v += dpp_f(v, 3); return v; }
#define WAVE_LDS_SYNC() asm volatile("s_waitcnt lgkmcnt(0)" ::: "memory")
#define LDS_BARRIER() do { asm volatile("s_waitcnt lgkmcnt(0)" ::: "memory"); __builtin_amdgcn_s_barrier(); asm volatile("" ::: "memory"); } while (0)
__device__ __forceinline__ int otid() { int t = threadIdx.x; asm volatile("" : "+v"(t)); return t; }
__device__ __forceinline__ int oint(int v) { asm volatile("" : "+s"(v)); return v; }
__device__ __forceinline__ const void* okarg() { auto p = __builtin_amdgcn_kernarg_segment_ptr(); asm volatile("" : "+s"(p)); return (const void*)p; }

struct Args { const float* in[29]; float* out; unsigned char* ws; int ph_lo, ph_hi; };
enum { I_X = 0, I_P, I_GMIX, I_WIN, I_BIN, I_WCQK, I_BCQK, I_GMH, I_WCR, I_BCR, I_WRA, I_BRA, I_WRI, I_BRI, I_LAM, I_GR, I_WOUT, I_GFFN,
       I_WFG, I_WFU, I_WFD, I_WROUTER, I_WEG, I_WEU, I_WED, I_GPLE, I_WPG, I_WPP, I_GFINAL };


#define XB_TMO      128
#define XB_XCNT(j)  (256  + 64 * (j))
#define XB_XSUB(j)  (1280 + 64 * (j))
#define XB_XGEN(j)  (2304 + 64 * (j))
#define XB_TOP      3328
#define XB_TOPGEN   3392
#define XCD_BAR_WORDS 3456
#define XB_SPIN_CAP (1u << 18)
#define LAS __attribute__((address_space(3)))
__device__ __forceinline__ unsigned xb_ld(unsigned* p)              { return __hip_atomic_load(p, __ATOMIC_RELAXED, __HIP_MEMORY_SCOPE_AGENT); }
__device__ __forceinline__ unsigned xb_add(unsigned* p, unsigned v) { return __hip_atomic_fetch_add(p, v, __ATOMIC_RELAXED, __HIP_MEMORY_SCOPE_AGENT); }
__device__ __forceinline__ unsigned xb_xcc_id() { return (unsigned)__builtin_amdgcn_s_getreg((3 << 11) | 20) & 0xFu; }
#define XB_SPIN(cond, bar) do { unsigned _sp = 0; while (cond) { __builtin_amdgcn_s_sleep(1); \
    if ((++_sp & 255u) == 0u) { if (xb_ld(&(bar)[XB_TMO])) break; if (_sp > XB_SPIN_CAP) { atomicAdd(&(bar)[XB_TMO], 1u); break; } } } } while (0)
struct XcdBarrier { unsigned* bar; unsigned x; volatile LAS unsigned* st; };
__device__ __forceinline__ XcdBarrier xcd_barrier_post(unsigned* bar, volatile LAS unsigned* st) {
    XcdBarrier b; b.bar = bar; b.x = xb_xcc_id(); b.st = st;
    if (threadIdx.x == 0) (void)xb_add(&bar[XB_XCNT(b.x)], 1u);
    return b;
}
__device__ __forceinline__ void xcd_barrier_complete(unsigned* bar, unsigned x, unsigned& nloc, unsigned& nx) {
    const unsigned G = gridDim.x * gridDim.y * gridDim.z;
    unsigned sum, cnt, mine, sp = 0u;
    for (;;) {
        sum = 0u; cnt = 0u; mine = 0u;
#pragma unroll
        for (unsigned j = 0; j < 16; ++j) { const unsigned c = xb_ld(&bar[XB_XCNT(j)]); sum += c; cnt += (c > 0u) ? 1u : 0u; mine = (j == x) ? c : mine; }
        if (sum == G) break;
        __builtin_amdgcn_s_sleep(1);
        if ((++sp & 255u) == 0u) { if (xb_ld(&bar[XB_TMO])) break; if (sp > XB_SPIN_CAP) { atomicAdd(&bar[XB_TMO], 1u); break; } }
    }
    nloc = mine > 0u ? mine : 1u; nx = cnt > 0u ? cnt : 1u;
}
__device__ __forceinline__ void xcd_barrier(const XcdBarrier& b) {
    asm volatile("s_waitcnt vmcnt(0)" ::: "memory");
    __syncthreads();
    if (threadIdx.x == 0) {
        unsigned* bar = b.bar;
        __builtin_amdgcn_s_waitcnt(0);
        unsigned nloc = b.st[0], nx = b.st[1];
        if (nloc == 0u) { xcd_barrier_complete(bar, b.x, nloc, nx); b.st[0] = nloc; b.st[1] = nx; }
        const unsigned old = xb_add(&bar[XB_XSUB(b.x)], 1u);
        const unsigned gen = old / nloc;
        if (old + 1u == (gen + 1u) * nloc) {
            __builtin_amdgcn_fence(__ATOMIC_RELEASE, "agent");
            asm volatile("s_waitcnt vmcnt(0)" ::: "memory");
            const unsigned og = xb_add(&bar[XB_TOP], 1u);
            const unsigned tg = og / nx;
            if (og + 1u == (tg + 1u) * nx) xb_add(&bar[XB_TOPGEN], 1u);
            else XB_SPIN(xb_ld(&bar[XB_TOPGEN]) == tg, bar);
            __builtin_amdgcn_fence(__ATOMIC_ACQUIRE, "agent");
            xb_add(&bar[XB_XGEN(b.x)], 1u);
            asm volatile("s_waitcnt vmcnt(0)" ::: "memory");
        } else {
            XB_SPIN(xb_ld(&bar[XB_XGEN(b.x)]) == gen, bar);
            __builtin_amdgcn_fence(__ATOMIC_ACQUIRE, "agent");
            asm volatile("s_waitcnt vmcnt(0)" ::: "memory");
        }
    }
    __syncthreads();
}

struct CvtJob { const float* src; bf16_t* dst; int ld, k0, c0, K, n0; const float* gain; int fp8; };
__device__ __forceinline__ void cvt_plain_job(CvtJob& o, const float* src, int K, int N, bf16_t* dst, int tile, const float* gain) {
    const int nt = N / 64, kb = tile / nt, nb = tile % nt; o.src = src; o.dst = dst; o.ld = N; o.k0 = kb * 64; o.c0 = nb * 64; o.K = K; o.n0 = nb * 64; o.gain = gain; o.fp8 = 0;
}
__device__ __forceinline__ void cvt_gu_job(CvtJob& o, const float* g, const float* u, bf16_t* dst, int tile, const float* gain) {
    const int nt = 5632 / 64, kb = tile / nt, nb = tile % nt, n0 = nb * 64, tt = n0 >> 8, half = (n0 >> 7) & 1, w = n0 & 127;
    o.src = half ? u : g; o.dst = dst; o.ld = DFF; o.k0 = kb * 64; o.c0 = tt * 128 + w; o.K = 1024; o.n0 = n0; o.gain = gain; o.fp8 = 0;
}
__device__ __forceinline__ int cvt_tile2x2(int tile, int nt) { const int grp = tile >> 2, sub = tile & 3, gpr = nt >> 1; return ((grp / gpr) * 2 + (sub >> 1)) * nt + (grp % gpr) * 2 + (sub & 1); }
__device__ __forceinline__ void cvt_job(const Args& a, int it, CvtJob& o) {
    unsigned char* ws = a.ws;
    constexpr int T_IN = 16 * 48, T_OUT = 16 * 16, T_GU = 16 * 88, T_FD = 44 * 16, T_PG = 256, T_PP = 4 * 16;
    int r = it;
    if (r < 2 * T_IN) { const int l = r / T_IN, tile = r % T_IN; const int nt = ZW / 64, kb = tile / nt, nb = tile % nt, n0 = nb * 64;
        o.src = a.in[I_WIN] + (size_t)l * D * DIN; o.dst = (bf16_t*)(ws + (l ? WS_W_IN1 : WS_W_IN0)); o.ld = DIN; o.k0 = kb * 64; o.c0 = n0 < 2048 ? n0 : n0 + 8; o.K = D; o.n0 = n0; o.gain = a.in[I_GMIX] + l * D; o.fp8 = 0; return; }
    r -= 2 * T_IN;
    if (r < 2 * T_OUT) { const int l = r / T_OUT; cvt_plain_job(o, a.in[I_WOUT] + (size_t)l * D * D, D, D, (bf16_t*)(ws + (l ? WS_W_OUT1 : WS_W_OUT0)), r % T_OUT, nullptr); return; }
    r -= 2 * T_OUT;
    if (r < T_GU) { cvt_gu_job(o, a.in[I_WFG], a.in[I_WFU], (bf16_t*)(ws + WS_W_FFGU), r, a.in[I_GFFN]); return; }
    r -= T_GU;
    if (r < T_FD) { cvt_plain_job(o, a.in[I_WFD], DFF, D, (bf16_t*)(ws + WS_W_FFD), r, nullptr); return; }
    r -= T_FD;
    if (r < 2 * T_PG) { const int l = r / T_PG; cvt_plain_job(o, a.in[I_WPG] + (size_t)l * D * D, D, D, (bf16_t*)(ws + WS_W_PG) + (size_t)l * D * D, r % T_PG, a.in[I_GPLE] + l * D); return; }
    r -= 2 * T_PG;
    if (r < 2 * T_PP) { const int l = r / T_PP; cvt_plain_job(o, a.in[I_WPP] + (size_t)l * DPLE * D, DPLE, D, (bf16_t*)(ws + (l ? WS_W_PP1 : WS_W_PP0)), r % T_PP, nullptr); return; }
    r -= 2 * T_PP;
    if (r < 8 * T_GU) { const int e = r / T_GU; cvt_gu_job(o, a.in[I_WEG] + (size_t)e * D * DFF, a.in[I_WEU] + (size_t)e * D * DFF, (bf16_t*)(ws + WS_W_EGU + (size_t)e * 5632 * D), cvt_tile2x2(r % T_GU, 5632 / 64), nullptr); o.fp8 = 1; return; }
    r -= 8 * T_GU;
    { const int e = r / T_FD; cvt_plain_job(o, a.in[I_WED] + (size_t)e * DFF * D, DFF, D, (bf16_t*)(ws + WS_W_ED + (size_t)e * D * DFF), cvt_tile2x2(r % T_FD, D / 64), nullptr); o.fp8 = 1; }
}
__device__ __forceinline__ void phase_prologue(const Args& a, unsigned char* lds) {
    unsigned char* ws = a.ws;
    const int G = gridDim.x, t = otid();
    constexpr int T_IN = 16 * 48, T_OUT = 16 * 16, T_GU = 16 * 88, T_FD = 44 * 16, T_PG = 256, T_PP = 4 * 16;
    constexpr int NT_ALL = 2 * T_IN + 2 * T_OUT + T_GU + T_FD + 2 * T_PG + 2 * T_PP + 8 * T_GU + 8 * T_FD;
    constexpr int NB = 4;
    const int kk0 = t >> 4, cc = (t & 15) * 4, n = t >> 3, kg = t & 7;
    float4 v[NB][2], vn[NB][2];
    int it0 = blockIdx.x * NB;
    if (it0 < NT_ALL) {
#pragma unroll
        for (int b = 0; b < NB; ++b) { const int it = it0 + b < NT_ALL ? it0 + b : NT_ALL - 1; CvtJob jq; cvt_job(a, it, jq);
#pragma unroll
            for (int j = 0; j < 2; ++j) v[b][j] = *(const float4*)(jq.src + (size_t)(jq.k0 + kk0 + 32 * j) * jq.ld + jq.c0 + cc); }
    }
    for (; it0 < NT_ALL; it0 += G * NB) {
        const int itn = it0 + G * NB;
        if (itn < NT_ALL) {
#pragma unroll
            for (int b = 0; b < NB; ++b) { const int it = itn + b < NT_ALL ? itn + b : NT_ALL - 1; CvtJob jq; cvt_job(a, it, jq);
#pragma unroll
                for (int j = 0; j < 2; ++j) vn[b][j] = *(const float4*)(jq.src + (size_t)(jq.k0 + kk0 + 32 * j) * jq.ld + jq.c0 + cc); }
        }
#pragma unroll
        for (int b = 0; b < NB; ++b) { float* tl = (float*)lds + b * (64 * 65); const int it = it0 + b < NT_ALL ? it0 + b : NT_ALL - 1; CvtJob jq; cvt_job(a, it, jq);
#pragma unroll
            for (int j = 0; j < 2; ++j) { float4 w = v[b][j];
                if (jq.gain) { const float gk = jq.gain[jq.k0 + kk0 + 32 * j]; w.x *= gk; w.y *= gk; w.z *= gk; w.w *= gk; }
                float* p = tl + (kk0 + 32 * j) * 65 + cc; p[0] = w.x; p[1] = w.y; p[2] = w.z; p[3] = w.w; } }
        LDS_BARRIER();
#pragma unroll
        for (int b = 0; b < NB; ++b) { if (it0 + b >= NT_ALL) break; const float* s_ = (const float*)lds + b * (64 * 65) + (8 * kg) * 65 + n; CvtJob jq; cvt_job(a, it0 + b, jq);
            if (jq.fp8) { u32x2 o; o.x = pk4_fp8(32.f * s_[0], 32.f * s_[65], 32.f * s_[130], 32.f * s_[195]); o.y = pk4_fp8(32.f * s_[260], 32.f * s_[325], 32.f * s_[390], 32.f * s_[455]);
                *(u32x2*)((unsigned char*)jq.dst + (size_t)(jq.n0 + n) * jq.K + jq.k0 + 8 * kg) = o; }
            else { u32x4 o; o.x = pk2(s_[0], s_[65]); o.y = pk2(s_[130], s_[195]); o.z = pk2(s_[260], s_[325]); o.w = pk2(s_[390], s_[455]);
                *(u32x4*)(jq.dst + (size_t)(jq.n0 + n) * jq.K + jq.k0 + 8 * kg) = o; } }
        LDS_BARRIER();
#pragma unroll
        for (int b = 0; b < NB; ++b) { v[b][0] = vn[b][0]; v[b][1] = vn[b][1]; }
    }
    const size_t np4 = (size_t)M * DPLE / 4;
    for (size_t i = (size_t)blockIdx.x * NT + otid(); i < 2 * np4; i += (size_t)G * NT) {
        const float4 v = ((const float4*)a.in[I_P])[i]; u32x2 o; o.x = pk2(v.x, v.y); o.y = pk2(v.z, v.w);
        if (i < np4) ((u32x2*)(ws + WS_PB0))[i] = o; else ((u32x2*)(ws + WS_PB1))[i - np4] = o; }
    for (int i = blockIdx.x * NT + otid(); i < 2 * 8 * 2 * 64 * 64; i += G * NT) {
        const int d = i & 63, e = (i >> 6) & 63, g = (i >> 12) & 1, ln = i >> 13;
        ((bf16_t*)(ws + WS_SMALL + SM_RGW))[i] = (bf16_t)f2bf((g ? a.in[I_WRI] : a.in[I_WRA])[((size_t)ln * 64 + d) * 64 + e]);
    }
    if (blockIdx.x == 0) { for (int i = otid(); i < D / 4; i += NT) ((unsigned*)(ws + WS_HN8 + (size_t)M * D))[i] = 0u; for (int i = otid(); i < D / 2; i += NT) ((unsigned*)(ws + WS_HN + (size_t)M * D * 2))[i] = 0u; if (otid() < 32) ((float*)(ws + WS_SSQ + (otid() >> 4) * SSQ_STRIDE))[(size_t)M * 16 + (otid() & 15)] = 0.f; }
    for (int i = blockIdx.x * NT + otid(); i < PMAX; i += G * NT) { ((int*)(ws + WS_SMALL + SM_ROWTOK))[i] = M; ((float*)(ws + WS_SMALL + SM_ROWGATE))[i] = 0.f; }
}

template <int IN, bool ADDY> struct RawRow {
    f32x4 x[IN == 0 ? 4 : 1]; u32x2 h[IN == 1 ? 4 : 1]; u32x2 y[ADDY ? 4 : 1];
    __device__ __forceinline__ void load(const float* xin, const bf16_t* hb, const bf16_t* y1, int r, int lane) {
#pragma unroll
        for (int j = 0; j < 4; ++j) {
            if (IN == 0) x[j] = ((const f32x4*)(xin + (size_t)r * D) + lane)[64 * j]; else h[j] = ((const u32x2*)(hb + (size_t)r * D) + lane)[64 * j];
            if (ADDY) y[j] = ((const u32x2*)(y1 + (size_t)r * D) + lane)[64 * j]; }
    }
    __device__ __forceinline__ void copy_from(const RawRow& o) {
#pragma unroll
        for (int j = 0; j < 4; ++j) { if (IN == 0) x[j] = o.x[j]; else h[j] = o.h[j]; if (ADDY) y[j] = o.y[j]; }
    }
};
template <int IN, int AUX, int WR, bool ADDY>
__device__ __forceinline__ void phase_rowpass(unsigned char* lds, const float* xin, bf16_t* hb, const bf16_t* y1, const float* g, float* ssq,
                                              const float* auxW, int auxld, const float* auxB, float* gates, unsigned char* tok_p, float* tok_g, float* fout, unsigned char* h8 = nullptr) {
    float* wl = (float*)lds;
    const int tid = otid(), lane = tid & 63, wave = tid >> 6;
    if (AUX) {
        for (int i = tid; i < D * 8; i += NT) wl[i] = auxW[(size_t)(i >> 3) * auxld + (i & 7)];
        __syncthreads();
    }
    f32x4 gv[4];
    if (AUX || WR == 2) {
#pragma unroll
        for (int j = 0; j < 4; ++j) gv[j] = *(const f32x4*)(g + 4 * lane + 256 * j);
    }
    RawRow<1, ADDY> cur, nxt;
    const int rstep = gridDim.x * 8; int row = blockIdx.x * 8 + wave;
    if (IN == 1) { if (row < M) cur.load(xin, hb, y1, row, lane); nxt.copy_from(cur); }
    for (; row < M; row += rstep) {
        if (IN == 1) { if (row + rstep < M) nxt.load(xin, hb, y1, row + rstep, lane); }
        f32x4 v[4]; float ss = 0.f;
#pragma unroll
        for (int j = 0; j < 4; ++j) {
            if (IN == 0) v[j] = ((const f32x4*)(xin + (size_t)row * D) + lane)[64 * j];
            else { const u32x2 w = cur.h[j]; v[j] = (f32x4){bf2f(w.x & 0xffffu), __uint_as_float(w.x & 0xffff0000u), bf2f(w.y & 0xffffu), __uint_as_float(w.y & 0xffff0000u)}; }
            if (ADDY) { const u32x2 y = cur.y[j];
                v[j].x += bf2f(y.x & 0xffffu); v[j].y += __uint_as_float(y.x & 0xffff0000u); v[j].z += bf2f(y.y & 0xffffu); v[j].w += __uint_as_float(y.y & 0xffff0000u); }
            ss += (v[j].x * v[j].x + v[j].y * v[j].y) + (v[j].z * v[j].z + v[j].w * v[j].w); }
        if (IN == 1) cur.copy_from(nxt);
        float tot; { const int ri = __float_as_int(sum16(ss)); tot = (__int_as_float(__builtin_amdgcn_readlane(ri, 0)) + __int_as_float(__builtin_amdgcn_readlane(ri, 16))) + (__int_as_float(__builtin_amdgcn_readlane(ri, 32)) + __int_as_float(__builtin_amdgcn_readlane(ri, 48))); }
        const float rstd = __builtin_amdgcn_rsqf(tot * (1.f / D) + EPS);
        if (WR == 1) {
            u32x2* o = (u32x2*)(hb + (size_t)row * D) + lane;
#pragma unroll
            for (int j = 0; j < 4; ++j) { u32x2 w; w.x = pk2(v[j].x, v[j].y); w.y = pk2(v[j].z, v[j].w); o[64 * j] = w; }
            if (lane < 16) ssq[(size_t)row * 16 + lane] = lane == 0 ? tot : 0.f;
        }
        if (AUX || WR == 2) {
#pragma unroll
            for (int j = 0; j < 4; ++j) v[j] = v[j] * rstd * gv[j];
        }
        if (AUX == 2 && h8) {
#pragma unroll
            for (int j = 0; j < 4; ++j) ((unsigned*)(h8 + (size_t)row * D) + lane)[64 * j] = pk4_fp8(v[j].x, v[j].y, v[j].z, v[j].w);
        }
        if (WR == 2) {
            f32x4* o = (f32x4*)(fout + (size_t)row * D) + lane;
#pragma unroll
            for (int j = 0; j < 4; ++j) o[64 * j] = v[j];
        }
        if (AUX) {
            float acc[8];
#pragma unroll
            for (int c = 0; c < 8; ++c) acc[c] = 0.f;
#pragma unroll
            for (int j = 0; j < 4; ++j)
#pragma unroll
                for (int q = 0; q < 4; ++q) {
                    const int k = 4 * lane + 256 * j + q; const float xv = v[j][q];
                    const f32x4 w0 = *(const f32x4*)(wl + k * 8), w1 = *(const f32x4*)(wl + k * 8 + 4);
                    acc[0] += xv * w0.x; acc[1] += xv * w0.y; acc[2] += xv * w0.z; acc[3] += xv * w0.w;
                    acc[4] += xv * w1.x; acc[5] += xv * w1.y; acc[6] += xv * w1.z; acc[7] += xv * w1.w;
                }
#pragma unroll
            for (int c = 0; c < 8; ++c) { const float r16 = sum16(acc[c]); const int ri = __float_as_int(r16);
                acc[c] = (__int_as_float(__builtin_amdgcn_readlane(ri, 0)) + __int_as_float(__builtin_amdgcn_readlane(ri, 16))) + (__int_as_float(__builtin_amdgcn_readlane(ri, 32)) + __int_as_float(__builtin_amdgcn_readlane(ri, 48))); }
            if (AUX == 1) {
                if (lane < 8) { float s_ = acc[0];
#pragma unroll
                    for (int c = 1; c < 8; ++c) s_ = (lane == c) ? acc[c] : s_;
                    gates[(size_t)row * 8 + lane] = s_ + auxB[lane]; }
            } else {
                if (lane == 0) {
                    int e1 = 0; float v1 = acc[0];
#pragma unroll
                    for (int c = 1; c < 8; ++c) if (acc[c] > v1) { v1 = acc[c]; e1 = c; }
                    int e2 = -1; float v2 = -INFINITY;
#pragma unroll
                    for (int c = 0; c < 8; ++c) if (c != e1 && acc[c] > v2) { v2 = acc[c]; e2 = c; }
                    const float p2 = __expf(v2 - v1), inv = 1.f / (1.f + p2);
                    tok_p[row] = (unsigned char)(e1 | (e2 << 4)); tok_g[row * 2] = inv; tok_g[row * 2 + 1] = p2 * inv;
                }
            }
        }
    }
    __syncthreads();
}

struct Unit { int pm, pn; const int* rows; size_t bofs; };
struct GridOrder {
    static constexpr bool GATHER = false;
    int nM, nN, G, c;
    __device__ __forceinline__ bool next(int i, Unit& u) const {
        const int L0_ = i * G + c, nwg = nM * nN; if (L0_ >= nwg) return false;
        const int q_ = nwg / 8, r_ = nwg % 8, xcd = L0_ % 8, off = L0_ / 8; const int L = (xcd < r_ ? xcd * (q_ + 1) : r_ * (q_ + 1) + (xcd - r_) * q_) + off;
        const int grp = L / (8 * nN), fm = grp * 8, gsz = (nM - fm) < 8 ? (nM - fm) : 8, w = L % (8 * nN);
        u.pm = fm + w % gsz; u.pn = w / gsz; u.rows = nullptr; u.bofs = 0; return true;
    }
};
struct TailOrder {
    static constexpr bool GATHER = false;
    int nM, nN, G, c, first;
    __device__ __forceinline__ bool next(int i, Unit& u) const {
        if (c < first) return false; const int L = i * (G - first) + (c - first); if (L >= nM * nN) return false;
        u.pm = L / nN; u.pn = L % nN; u.rows = nullptr; u.bofs = 0; return true;
    }
};
template <bool GATHER_> struct MoeOrder {
    static constexpr bool GATHER = GATHER_;
    int nM, nN, G, c; const int* rows; size_t estride; int te[8];
    __device__ __forceinline__ void init(const int* tile_e) {
#pragma unroll
        for (int e = 0; e < 8; ++e) te[e] = __builtin_amdgcn_readfirstlane(tile_e[256 + e]);
    }
    __device__ __forceinline__ bool next(int i, Unit& u) const {
        const int L0_ = i * G + c, nwg = nM * nN; if (L0_ >= nwg) return false;
        const int q_ = nwg / 8, r_ = nwg % 8, xcd = L0_ % 8, off = L0_ / 8; const int L = (xcd < r_ ? xcd * (q_ + 1) : r_ * (q_ + 1) + (xcd - r_) * q_) + off;
        const int grp = L / (8 * nN), fm = grp * 8, gsz = (nM - fm) < 8 ? (nM - fm) : 8, w = L % (8 * nN);
        u.pm = fm + w % gsz; u.pn = w / gsz; u.rows = rows; int e = 0;
#pragma unroll
        for (int q = 0; q < 7; ++q) e += (u.pm >= te[q]) ? 1 : 0;
        u.bofs = (size_t)e * estride; return true;
    }
};


namespace pg8 {
#define PG8_LAS __attribute__((address_space(3)))
typedef short bf16x8 __attribute__((ext_vector_type(8)));
constexpr int BM = 256, BK = 64, HALF = 128, HTB = HALF * BK * 2, STAGE_BYTES = 8 * HTB;
__device__ __forceinline__ int lds_byte(int r, int c) { const int st = (r >> 4) * 2 + (c >> 5), rr = r & 15, cc = c & 31, ob = rr * 64 + cc * 2; return st * 1024 + (ob ^ (((ob >> 9) & 1) << 5)); }
__device__ __forceinline__ void stage_rc(int b, int& R, int& C) { const int st = b / 1024, sb = b % 1024, swz = sb ^ (((sb >> 9) & 1) << 5); R = (st >> 1) * 16 + swz / 64; C = (st & 1) * 32 + (swz % 64) / 2; }

typedef int i32x8 __attribute__((ext_vector_type(8))); typedef int i32x4 __attribute__((ext_vector_type(4)));
__device__ __forceinline__ i32x8 cat8(bf16x8 lo, bf16x8 hi) { return __builtin_shufflevector(__builtin_bit_cast(i32x4, lo), __builtin_bit_cast(i32x4, hi), 0, 1, 2, 3, 4, 5, 6, 7); }
__device__ __forceinline__ int perm32(int rho) { const int n = rho >> 4, i = rho & 15; return 8 * (i >> 2) + 4 * n + (i & 3); }
__device__ __forceinline__ void unit_voff(const Unit& u, const int (&R)[2], const int (&C)[2], int KB  , unsigned (&vo)[2][2]) {
#pragma unroll
    for (int h = 0; h < 2; ++h)
#pragma unroll
        for (int i = 0; i < 2; ++i) { int row = u.pm * BM + h * HALF + R[i]; if (u.rows) row = u.rows[row]; vo[h][i] = (unsigned)row * (unsigned)KB + (unsigned)C[i] * 2u; }
}

template <class Epi, class Sched, bool ALIGN_EPI, bool GATHER, bool FP8 = false>
__device__ __forceinline__ void gemm_phase(unsigned char* lds_, const bf16_t* A_, const bf16_t* Bt_, const int K_, const Sched& S, const Epi& E) {
    PG8_LAS unsigned char* lds = (PG8_LAS unsigned char*)lds_;
    const int K = oint(K_);
    const int tid = otid(), wid = __builtin_amdgcn_readfirstlane(tid >> 6), lane = tid & 63, wr = wid >> 2, wc = wid & 3, fr = lane & 15, fq = lane >> 4;
    const int KB = FP8 ? K : 2 * K;
    const int nt = KB / (BK * 2);
    int R[2], C[2]; unsigned voffA[2], voffB[2];
#pragma unroll
    for (int i = 0; i < 2; ++i) { stage_rc(tid * 16 + i * 8192, R[i], C[i]); voffA[i] = (unsigned)(R[i] * KB + C[i] * 2);
        const int Rb = Epi::PERM ? ((R[i] & ~31) + perm32(R[i] & 31)) : R[i]; voffB[i] = (unsigned)(Rb * KB + C[i] * 2); }
    const size_t kstep = (size_t)(BK * 2);
    const size_t hstep = (size_t)HALF * KB;
    const size_t tstep = 2 * hstep;
    const unsigned ldsw = (unsigned)wid * 1024u;
    const int pc0 = FP8 ? 32 * (fq >> 1) + 16 * (fq & 1) : fq * 8; constexpr int KOFF = FP8 ? 16 : 1024;
    const int aoff = lds_byte(wr * 64 + fr, pc0), boff = lds_byte(wc * 32 + fr, pc0);
#define PG8_SA(b, h) (((b) * 2 + (h)) * HTB)
#define PG8_SB(b, h) ((4 + (b) * 2 + (h)) * HTB)
#define PG8_STAGE(bufoff, gbase, voff) do { _Pragma("unroll") for (int _i = 0; _i < 2; ++_i) \
        __builtin_amdgcn_global_load_lds((const unsigned*)((const char*)(gbase) + (voff)[_i]), (PG8_LAS unsigned*)(lds + (bufoff) + ldsw + _i * 8192), 16, 0, 0); } while (0)
#define PG8_STAGE_A(bufoff, base, h, VO) do { if constexpr (GATHER) { PG8_STAGE(bufoff, base, (VO)[h]); } else { PG8_STAGE(bufoff, (base) + (h) * hstep, voffA); } } while (0)
#define PG8_LDA(dst, b, h) do { _Pragma("unroll") for (int m = 0; m < 4; ++m) _Pragma("unroll") for (int k = 0; k < 2; ++k) dst[m][k] = *(const PG8_LAS bf16x8*)(lds + PG8_SA(b, h) + aoff + m * 2048 + k * KOFF); } while (0)
#define PG8_LDB(dst, b, h) do { _Pragma("unroll") for (int n = 0; n < 2; ++n) _Pragma("unroll") for (int k = 0; k < 2; ++k) dst[n][k] = *(const PG8_LAS bf16x8*)(lds + PG8_SB(b, h) + boff + n * 2048 + k * KOFF); } while (0)
#define PG8_MMA(ai, bj, At, Bt) do { __builtin_amdgcn_s_setprio(1); _Pragma("unroll") for (int m = 0; m < 4; ++m) _Pragma("unroll") for (int n = 0; n < 2; ++n) { \
        if constexpr (FP8) { const i32x8 b8_ = cat8(Bt[n][0], Bt[n][1]), a8_ = cat8(At[m][0], At[m][1]); \
            asm volatile("v_mfma_scale_f32_16x16x128_f8f6f4 %0, %1, %2, %0, %3, %3 op_sel_hi:[0,0,0]" : "+v"(acc[ai][bj][m][n]) : "v"(b8_), "v"(a8_), "v"(scale1)); } \
        else { _Pragma("unroll") for (int k = 0; k < 2; ++k) acc[ai][bj][m][n] = __builtin_amdgcn_mfma_f32_16x16x32_bf16(Bt[n][k], At[m][k], acc[ai][bj][m][n], 0, 0, 0); } } __builtin_amdgcn_s_setprio(0); } while (0)
#define PG8_WAIT_V(n) asm volatile("s_waitcnt vmcnt(" #n ")" ::: "memory")
#define PG8_WAIT_L(n) asm volatile("s_waitcnt lgkmcnt(" #n ")" ::: "memory")
#define PG8_BAR __builtin_amdgcn_s_barrier()
#define PG8_SCHED __builtin_amdgcn_sched_barrier(0)
    const int scale1 = 0x7f7f7f7f;
    Unit cur, nxt; int ui = 0;
    if (!S.next(0, cur)) return;
    f32x4 acc[2][2][4][2];
#pragma unroll
    for (int a = 0; a < 2; ++a)
#pragma unroll
        for (int b = 0; b < 2; ++b)
#pragma unroll
            for (int m = 0; m < 4; ++m)
#pragma unroll
                for (int n = 0; n < 2; ++n) acc[a][b][m][n] = (f32x4){0.f, 0.f, 0.f, 0.f};
    bf16x8 At[4][2], B0[2][2], B1[2][2];
    unsigned vc[2][2], vn[2][2];
    if constexpr (GATHER) unit_voff(cur, R, C, KB, vc);
    const char* cA = GATHER ? (const char*)A_ : (const char*)A_ + (size_t)cur.pm * tstep;
    const char* cB = (const char*)Bt_ + cur.bofs * (FP8 ? 1 : 2) + (size_t)cur.pn * tstep;
    PG8_STAGE(PG8_SB(0, 0), cB, voffB); PG8_STAGE(PG8_SB(0, 1), cB + hstep, voffB); PG8_STAGE_A(PG8_SA(0, 0), cA, 0, vc); PG8_STAGE_A(PG8_SA(0, 1), cA, 1, vc);
    if (wr == 1) PG8_BAR;
    PG8_WAIT_V(2); PG8_BAR;
    PG8_STAGE(PG8_SB(1, 0), cB + kstep, voffB); PG8_STAGE_A(PG8_SA(1, 0), cA + kstep, 0, vc); PG8_STAGE(PG8_SB(1, 1), cB + hstep + kstep, voffB);
    PG8_WAIT_V(6); PG8_BAR;
    for (;;) {
        const bool has_next = S.next(ui + 1, nxt);
        const char* nA = cA; const char* nB = cB;
        if (has_next) { nB = (const char*)Bt_ + nxt.bofs * (FP8 ? 1 : 2) + (size_t)nxt.pn * tstep; if constexpr (!GATHER) nA = (const char*)A_ + (size_t)nxt.pm * tstep; }
        int rn[2][2];
        if constexpr (GATHER) {
#pragma unroll
            for (int h = 0; h < 2; ++h)
#pragma unroll
                for (int i = 0; i < 2; ++i) rn[h][i] = cur.rows[(has_next ? nxt.pm : cur.pm) * BM + h * HALF + R[i]]; }
        for (int t = 0; t < nt; t += 2) {
            const bool last = (t == nt - 2);
            if constexpr (GATHER) { if (last) {
#pragma unroll
                for (int h = 0; h < 2; ++h)
#pragma unroll
                    for (int i = 0; i < 2; ++i) { int r_ = rn[h][i]; asm volatile("" : "+v"(r_));
                        vn[h][i] = (unsigned)r_ * (unsigned)KB + (unsigned)C[i] * 2u; } } }
            const char* a1 = cA + (size_t)(t + 1) * kstep;
            const char* a2 = last ? nA : cA + (size_t)(t + 2) * kstep; const char* b2 = last ? nB : cB + (size_t)(t + 2) * kstep;
            const char* a3 = a2 + kstep; const char* b3 = b2 + kstep;
            unsigned v2[2][2];
            if constexpr (GATHER) {
#pragma unroll
                for (int h = 0; h < 2; ++h)
#pragma unroll
                    for (int i = 0; i < 2; ++i) v2[h][i] = last ? vn[h][i] : vc[h][i]; }
            PG8_LDB(B0, 0, 0); PG8_LDB(B1, 0, 1); PG8_SCHED; PG8_LDA(At, 0, 0); PG8_STAGE_A(PG8_SA(1, 1), a1, 1, vc);
            PG8_WAIT_V(8); PG8_WAIT_L(0); PG8_BAR; PG8_MMA(0, 0, At, B0); PG8_MMA(0, 1, At, B1); PG8_BAR; PG8_SCHED;
            PG8_LDA(At, 0, 1); PG8_STAGE(PG8_SB(0, 0), b2, voffB); PG8_STAGE(PG8_SB(0, 1), b2 + hstep, voffB); PG8_STAGE_A(PG8_SA(0, 0), a2, 0, v2);
            PG8_WAIT_V(8); PG8_WAIT_L(0); PG8_BAR; PG8_MMA(1, 0, At, B0); PG8_MMA(1, 1, At, B1); PG8_BAR; PG8_SCHED;
            PG8_LDB(B0, 1, 0); PG8_LDB(B1, 1, 1); PG8_SCHED; PG8_LDA(At, 1, 0); PG8_STAGE_A(PG8_SA(0, 1), a2, 1, v2);
            PG8_WAIT_V(8); PG8_WAIT_L(0); PG8_BAR; PG8_MMA(0, 0, At, B0); PG8_MMA(0, 1, At, B1); PG8_BAR; PG8_SCHED;
            PG8_LDA(At, 1, 1); PG8_STAGE(PG8_SB(1, 0), b3, voffB); PG8_STAGE(PG8_SB(1, 1), b3 + hstep, voffB); PG8_STAGE_A(PG8_SA(1, 0), a3, 0, v2);
            PG8_WAIT_V(8); PG8_WAIT_L(0); PG8_BAR; PG8_MMA(1, 0, At, B0); PG8_MMA(1, 1, At, B1); PG8_BAR; PG8_SCHED;
        }
        if constexpr (ALIGN_EPI) { if (wr == 0) PG8_BAR; }
        { int pm_ = cur.pm, pn_ = cur.pn, fr_ = fr, fq_ = fq;
          asm volatile("" : "+s"(pm_), "+s"(pn_), "+v"(fr_), "+v"(fq_));
          E(acc, pm_, pn_, wr, wc, fr_, fq_); }
        if (!has_next) break;
#pragma unroll
        for (int a = 0; a < 2; ++a)
#pragma unroll
            for (int b = 0; b < 2; ++b)
#pragma unroll
                for (int m = 0; m < 4; ++m)
#pragma unroll
                    for (int n = 0; n < 2; ++n) acc[a][b][m][n] = (f32x4){0.f, 0.f, 0.f, 0.f};
        cur = nxt; cA = nA; cB = nB; ++ui;
        if constexpr (GATHER) {
#pragma unroll
            for (int h = 0; h < 2; ++h)
#pragma unroll
                for (int i = 0; i < 2; ++i) vc[h][i] = vn[h][i]; }
        if constexpr (ALIGN_EPI) { if (wr == 1) PG8_BAR; }
    }
    PG8_WAIT_V(0);
    if constexpr (!ALIGN_EPI) { if (wr == 0) PG8_BAR; }
    PG8_BAR;
#undef PG8_SA
#undef PG8_SB
#undef PG8_STAGE
#undef PG8_STAGE_A
#undef PG8_LDA
#undef PG8_LDB
#undef PG8_MMA
#undef PG8_WAIT_V
#undef PG8_WAIT_L
#undef PG8_BAR
#undef PG8_SCHED
}
}
template <bool FP8 = false, class Epi, class Sched>
__device__ __forceinline__ void gemm_fast(unsigned char* lds, const bf16_t* A, const bf16_t* Bt, int K, const Sched& S, const Epi& E) {
    pg8::gemm_phase<Epi, Sched, true, Sched::GATHER, FP8>(lds, A, Bt, K, S, E);
    __syncthreads();
}

typedef f32x4 AccT[2][2][4][2];
#define EPI_ROW(ai, m) (pm * 256 + (ai) * 128 + wr * 64 + (m) * 16 + fr)
__device__ __forceinline__ void unpack8(const u32x4 w, f32x4& lo, f32x4& hi) {
    lo = (f32x4){bf2f(w.x & 0xffffu), __uint_as_float(w.x & 0xffff0000u), bf2f(w.y & 0xffffu), __uint_as_float(w.y & 0xffff0000u)};
    hi = (f32x4){bf2f(w.z & 0xffffu), __uint_as_float(w.z & 0xffff0000u), bf2f(w.w & 0xffffu), __uint_as_float(w.w & 0xffff0000u)};
}
__device__ __forceinline__ u32x4 pack8(const f32x4 v0, const f32x4 v1) { u32x4 w; w.x = pk2(v0.x, v0.y); w.y = pk2(v0.z, v0.w); w.z = pk2(v1.x, v1.y); w.w = pk2(v1.z, v1.w); return w; }
__device__ __forceinline__ float dot8(const f32x4 a, const f32x4 b) { return ((a.x * a.x + a.y * a.y) + (a.z * a.z + a.w * a.w)) + ((b.x * b.x + b.y * b.y) + (b.z * b.z + b.w * b.w)); }
__device__ __forceinline__ void epi_rstd(const float* ssq, const int* rowmap, int pm, int wr, int fr, int fq, float (&rs)[2][4]) {
    f32x4 p[2][4];
#pragma unroll
    for (int ai = 0; ai < 2; ++ai)
#pragma unroll
        for (int m = 0; m < 4; ++m) { int row = EPI_ROW(ai, m); if (rowmap) row = rowmap[row]; p[ai][m] = *(const f32x4*)((const char*)ssq + ((unsigned)row * 16u + 4u * (unsigned)fq) * 4u); }
#pragma unroll
    for (int ai = 0; ai < 2; ++ai)
#pragma unroll
        for (int m = 0; m < 4; ++m) { float t = (p[ai][m].x + p[ai][m].y) + (p[ai][m].z + p[ai][m].w); t += __shfl_xor(t, 16); t += __shfl_xor(t, 32); rs[ai][m] = __builtin_amdgcn_rsqf(t * (1.f / 1024.f) + EPS); }
}
__device__ __forceinline__ void epi_ssq(float* ssq, int row, int slot, float s_, int fq) { s_ += __shfl_xor(s_, 16); s_ += __shfl_xor(s_, 32); if (fq == 0) *(float*)((char*)ssq + ((unsigned)row * 16u + (unsigned)slot) * 4u) = s_; }

struct EpiZ { static constexpr bool PERM = true; bf16_t* z; const float* bin; const float* ssq;
    __device__ __forceinline__ void operator()(const AccT& acc, int pm, int pn, int wr, int wc, int fr, int fq) const {
        const int c0 = pn * 256 + wc * 32 + 8 * fq; f32x4 bv[2][2]; float rs[2][4];
#pragma unroll
        for (int bj = 0; bj < 2; ++bj)
#pragma unroll
            for (int n = 0; n < 2; ++n) { const int cc = c0 + bj * 128 + n * 4; bv[bj][n] = *(const f32x4*)(bin + (cc < 2048 ? cc : cc + 8)); }
        epi_rstd(ssq, nullptr, pm, wr, fr, fq, rs);
#pragma unroll
        for (int ai = 0; ai < 2; ++ai)
#pragma unroll
            for (int m = 0; m < 4; ++m) { bf16_t* rp = z + (size_t)EPI_ROW(ai, m) * ZW + c0; const float r = rs[ai][m];
#pragma unroll
                for (int bj = 0; bj < 2; ++bj) *(u32x4*)(rp + bj * 128) = pack8(acc[ai][bj][m][0] * r + bv[bj][0], acc[ai][bj][m][1] * r + bv[bj][1]); } } };
template <bool XB> struct EpiHres { static constexpr bool PERM = true; const float* xb; bf16_t* hb; float* ssq;
    __device__ __forceinline__ void operator()(const AccT& acc, int pm, int pn, int wr, int wc, int fr, int fq) const {
        const int c0 = pn * 256 + wc * 32 + 8 * fq;
#pragma unroll
        for (int ai = 0; ai < 2; ++ai) {
            f32x4 lx[4][2][2]; u32x4 lh[4][2];
#pragma unroll
            for (int m = 0; m < 4; ++m)
#pragma unroll
                for (int bj = 0; bj < 2; ++bj) { const size_t o = (size_t)EPI_ROW(ai, m) * D + c0 + bj * 128;
                    if (XB) { lx[m][bj][0] = *(const f32x4*)(xb + o); lx[m][bj][1] = *(const f32x4*)(xb + o + 4); } else lh[m][bj] = *(const u32x4*)(hb + o); }
#pragma unroll
            for (int m = 0; m < 4; ++m) { float s_ = 0.f; const int row = EPI_ROW(ai, m);
#pragma unroll
                for (int bj = 0; bj < 2; ++bj) { f32x4 b0, b1; if (XB) { b0 = lx[m][bj][0]; b1 = lx[m][bj][1]; } else unpack8(lh[m][bj], b0, b1);
                    const f32x4 v0 = b0 + acc[ai][bj][m][0], v1 = b1 + acc[ai][bj][m][1]; s_ += dot8(v0, v1);
                    *(u32x4*)(hb + (size_t)row * D + c0 + bj * 128) = pack8(v0, v1); }
                epi_ssq(ssq, row, pn * 4 + wc, s_, fq); }
        } } };
struct EpiSwiglu { static constexpr bool PERM = true; bf16_t* hid; const float* ssq; const int* rowmap;
    __device__ __forceinline__ void operator()(const AccT& acc, int pm, int pn, int wr, int wc, int fr, int fq) const {
        const int c0 = pn * 128 + wc * 32 + 8 * fq; float rs[2][4];
        epi_rstd(ssq, rowmap, pm, wr, fr, fq, rs);
#pragma unroll
        for (int ai = 0; ai < 2; ++ai)
#pragma unroll
            for (int m = 0; m < 4; ++m) { u32x4 w; const float r = rs[ai][m];
#pragma unroll
                for (int n = 0; n < 2; ++n) { const f32x4 g = acc[ai][0][m][n] * r, u = acc[ai][1][m][n] * r;
                    w[2 * n] = pk2(siluf_(g.x) * u.x, siluf_(g.y) * u.y); w[2 * n + 1] = pk2(siluf_(g.z) * u.z, siluf_(g.w) * u.w); }
                *(u32x4*)(hid + (size_t)EPI_ROW(ai, m) * DFF + c0) = w; } } };
struct EpiSwiglu8 { static constexpr bool PERM = true; unsigned char* hid8; float sc;
    __device__ __forceinline__ void operator()(const AccT& acc, int pm, int pn, int wr, int wc, int fr, int fq) const {
        const int c0 = pn * 128 + wc * 32 + 8 * fq;
#pragma unroll
        for (int ai = 0; ai < 2; ++ai)
#pragma unroll
            for (int m = 0; m < 4; ++m) { u32x2 w;
#pragma unroll
                for (int n = 0; n < 2; ++n) { const f32x4 g = acc[ai][0][m][n] * sc, u = acc[ai][1][m][n] * sc;
                    w[n] = pk4_fp8(siluf_(g.x) * u.x, siluf_(g.y) * u.y, siluf_(g.z) * u.z, siluf_(g.w) * u.w); }
                *(u32x2*)(hid8 + (size_t)EPI_ROW(ai, m) * DFF + c0) = w; } } };
struct EpiMoeDown { static constexpr bool PERM = true; bf16_t* hb; bf16_t* y1; const int* row_tok; const int* row_slot; const float* row_gate; float sc;
    __device__ __forceinline__ void operator()(const AccT& acc, int pm, int pn, int wr, int wc, int fr, int fq) const {
        const int c0 = pn * 256 + wc * 32 + 8 * fq;
        int tok[2][4], slot[2][4]; float gt[2][4];
#pragma unroll
        for (int ai = 0; ai < 2; ++ai)
#pragma unroll
            for (int m = 0; m < 4; ++m) { const int row = EPI_ROW(ai, m); tok[ai][m] = row_tok[row]; slot[ai][m] = row_slot[row]; gt[ai][m] = row_gate[row] * sc; }
#pragma unroll
        for (int ai = 0; ai < 2; ++ai) {
            u32x4 lh[4][2];
#pragma unroll
            for (int m = 0; m < 4; ++m) { const bool rmw = tok[ai][m] < M && slot[ai][m] == 0;
#pragma unroll
                for (int bj = 0; bj < 2; ++bj) lh[m][bj] = rmw ? *(const u32x4*)(hb + (size_t)tok[ai][m] * D + c0 + bj * 128) : (u32x4){0u, 0u, 0u, 0u}; }
#pragma unroll
            for (int m = 0; m < 4; ++m) { if (tok[ai][m] >= M) continue; const size_t o = (size_t)tok[ai][m] * D + c0; const float g = gt[ai][m];
                if (slot[ai][m] == 0) {
#pragma unroll
                    for (int bj = 0; bj < 2; ++bj) { f32x4 b0, b1; unpack8(lh[m][bj], b0, b1); *(u32x4*)(hb + o + bj * 128) = pack8(b0 + g * acc[ai][bj][m][0], b1 + g * acc[ai][bj][m][1]); }
                } else {
#pragma unroll
                    for (int bj = 0; bj < 2; ++bj) *(u32x4*)(y1 + o + bj * 128) = pack8(g * acc[ai][bj][m][0], g * acc[ai][bj][m][1]);
                } }
        } } };
struct EpiStoreBf16 { static constexpr bool PERM = true; bf16_t* out;
    __device__ __forceinline__ void operator()(const AccT& acc, int pm, int pn, int wr, int wc, int fr, int fq) const {
        const int c0 = pn * 256 + wc * 32 + 8 * fq;
#pragma unroll
        for (int ai = 0; ai < 2; ++ai)
#pragma unroll
            for (int m = 0; m < 4; ++m)
#pragma unroll
                for (int bj = 0; bj < 2; ++bj) *(u32x4*)(out + (size_t)EPI_ROW(ai, m) * D + c0 + bj * 128) = pack8(acc[ai][bj][m][0], acc[ai][bj][m][1]); } };
struct EpiPle { static constexpr bool PERM = true; const bf16_t* hin; bf16_t* hb; const bf16_t* pp; float* ssq; const float* ssq_in;
    __device__ __forceinline__ void operator()(const AccT& acc, int pm, int pn, int wr, int wc, int fr, int fq) const {
        const int c0 = pn * 256 + wc * 32 + 8 * fq; float rs[2][4];
        epi_rstd(ssq_in, nullptr, pm, wr, fr, fq, rs);
        u32x4 sg[2][4][2];
#pragma unroll
        for (int ai = 0; ai < 2; ++ai)
#pragma unroll
            for (int m = 0; m < 4; ++m)
#pragma unroll
                for (int bj = 0; bj < 2; ++bj) { f32x4 a0 = acc[ai][bj][m][0] * rs[ai][m], a1 = acc[ai][bj][m][1] * rs[ai][m];
#pragma unroll
                    for (int q = 0; q < 4; ++q) { a0[q] = sigmoidf_(a0[q]); a1[q] = sigmoidf_(a1[q]); }
                    sg[ai][m][bj] = pack8(a0, a1); }
        asm volatile("" ::: "memory");
#pragma unroll
        for (int ai = 0; ai < 2; ++ai) {
            u32x4 lh[4][2], lp[4][2];
#pragma unroll
            for (int m = 0; m < 4; ++m)
#pragma unroll
                for (int bj = 0; bj < 2; ++bj) { const unsigned ob = ((unsigned)EPI_ROW(ai, m) * D + c0 + bj * 128) * 2u;
                    lh[m][bj] = *(const u32x4*)((const char*)hin + ob); lp[m][bj] = *(const u32x4*)((const char*)pp + ob); }
#pragma unroll
            for (int m = 0; m < 4; ++m) { float s_ = 0.f; const int row = EPI_ROW(ai, m);
#pragma unroll
                for (int bj = 0; bj < 2; ++bj) { f32x4 h0, h1, p0, p1, g0, g1; unpack8(lh[m][bj], h0, h1); unpack8(lp[m][bj], p0, p1); unpack8(sg[ai][m][bj], g0, g1);
                    h0 += g0 * p0; h1 += g1 * p1; s_ += dot8(h0, h1);
                    *(u32x4*)((char*)hb + ((unsigned)row * D + c0 + bj * 128) * 2u) = pack8(h0, h1); }
                epi_ssq(ssq, row, pn * 4 + wc, s_, fq); }
        } } };

__device__ __forceinline__ float conv4(const bf16_t* zc, int row, int s, const float* w  , int wstride, float b) {
    float acc = b;
#pragma unroll
    for (int j = 0; j < 4; ++j) { const int ds = 3 - j; if (s - ds >= 0) acc += w[j * wstride] * bf2f(zc[(ptrdiff_t)(row - ds) * ZW]); }
    return acc;
}
__device__ __forceinline__ void chunk_gates(float* sc, const float* gates, int row0, int h, int lane) {
    const float ip = gates[(size_t)(row0 + lane) * 8 + h], fp = gates[(size_t)(row0 + lane) * 8 + 4 + h];
    float b = logsigmoidf_(fp);
#pragma unroll
    for (int o = 1; o < 64; o <<= 1) { const float n = __shfl_up(b, o); if (lane >= o) b += n; }
    sc[lane] = b; sc[64 + lane] = ip;
}
__device__ __forceinline__ void chunk_gates_r(float* sc, float ip, float fp, int lane) {
    float b = logsigmoidf_(fp);
#pragma unroll
    for (int o = 1; o < 64; o <<= 1) { const float n = __shfl_up(b, o); if (lane >= o) b += n; }
    sc[lane] = b; sc[64 + lane] = ip;
}
__device__ __forceinline__ void mlstm_local(const Args& a, unsigned char* lds, int l, int item) {
    const int b = item >> 8, c = (item >> 2) & 63, h = item & 3, row0 = b * SEQ + c * CH, tid = otid(), lane = tid & 63;
    float* Kt = (float*)lds;
    float* Vt = Kt + 64 * 128;
    float* sc = Vt + 64 * 128;
    const bf16_t* z = (const bf16_t*)(a.ws + WS_Z);
    const float* gates = (const float*)(a.ws + WS_SMALL + SM_GATES);
    if (tid < 64) {
        chunk_gates(sc, gates, row0, h, lane);
        const float bl = __shfl(sc[lane], 63), al = bl - sc[lane] + sc[64 + lane];
        const float amax = wave_max(al);
        sc[128 + lane] = __expf(al - amax);
        if (lane == 0) { ((float*)(a.ws + WS_SMALL + SM_BL))[item] = bl; ((float*)(a.ws + WS_SMALL + SM_AMAX))[item] = amax; }
    }
    const float* wc = a.in[I_WCQK] + (size_t)l * 4 * 1024; const float* bc = a.in[I_BCQK] + (size_t)l * 1024;
    for (int i = tid; i < 64 * 128; i += NT) {
        const int ll = i >> 7, d = i & 127, ch = ZK + h * DH + d;
        Kt[i] = siluf_(conv4(z + ch, row0 + ll, c * CH + ll, wc + ch, 1024, bc[ch]));
        Vt[i] = bf2f(z[(size_t)(row0 + ll) * ZW + ZV + h * DH + d]);
    }
    __syncthreads();
    const int d = tid & 127, eg = tid >> 7;
    float acc[33];
#pragma unroll
    for (int i = 0; i < 33; ++i) acc[i] = 0.f;
    for (int ll = 0; ll < 64; ++ll) {
        const float kd = Kt[ll * 128 + d] * sc[128 + ll];
#pragma unroll
        for (int i = 0; i < 32; ++i) acc[i] += Vt[ll * 128 + eg + 4 * i] * kd;
        acc[32] += kd;
    }
    float* ct = (float*)(a.ws + WS_CT) + (size_t)item * EROWS * 128;
#pragma unroll
    for (int i = 0; i < 32; ++i) ct[(eg + 4 * i) * 128 + d] = acc[i];
    if (eg == 0) ct[128 * 128 + d] = acc[32];
    __syncthreads();
}
__device__ __forceinline__ void mlstm_scan(const Args& a, int G) {
    const float* BL = (const float*)(a.ws + WS_SMALL + SM_BL); const float* AM = (const float*)(a.ws + WS_SMALL + SM_AMAX);
    float* MP = (float*)(a.ws + WS_SMALL + SM_MPREV);
    const int tid = otid();
    for (int w = blockIdx.x; w < 16 * 16; w += G) {
        const int bh = w >> 4, sl = w & 15, b = bh >> 2, h = bh & 3;
        unsigned* p = (unsigned*)(a.ws + WS_CT) + (size_t)((b * NC) * NH + h) * 8192 + sl * 512 + tid;
        const bool dn = (sl == 1 && tid < 128);
        float* q = (float*)(a.ws + WS_DN) + (size_t)((b * NC) * NH + h) * 128 + (dn ? tid : 0);
        float s0 = 0.f, s1 = 0.f, sn = 0.f, m = 0.f;
        unsigned x[16], xn[16]; float y[16], yn[16];
#pragma unroll
        for (int j = 0; j < 16; ++j) { x[j] = p[(size_t)j * (NH * 8192)]; y[j] = q[(size_t)j * (NH * 128)]; }
#pragma unroll 1
        for (int c0 = 0; c0 < NC; c0 += 16) {
            const int cn = (c0 + 16 < NC) ? c0 + 16 : c0;
#pragma unroll
            for (int j = 0; j < 16; ++j) { xn[j] = p[(size_t)(cn + j) * (NH * 8192)]; yn[j] = q[(size_t)(cn + j) * (NH * 128)]; }
#pragma unroll
            for (int j = 0; j < 16; ++j) {
                const int item = (b * NC + c0 + j) * NH + h;
                const float bl = BL[item], am = AM[item];
                const float mn = fmaxf(bl + m, am), dec = __expf(bl + m - mn), scl = __expf(am - mn);
                p[(size_t)(c0 + j) * (NH * 8192)] = pk2(s0, s1);
                if (dn) q[(size_t)(c0 + j) * (NH * 128)] = sn;
                if (sl == 0 && tid == 0) MP[item] = m;
                s0 = dec * s0 + scl * bf2f(x[j] & 0xffffu); s1 = dec * s1 + scl * __uint_as_float(x[j] & 0xffff0000u); sn = dec * sn + scl * y[j]; m = mn;
            }
#pragma unroll
            for (int j = 0; j < 16; ++j) { x[j] = xn[j]; y[j] = yn[j]; }
        }
    }
}
__device__ __forceinline__ void mlstm_out(const Args& a, unsigned char* lds, int l, int item) {
    const int b = item >> 8, c = (item >> 2) & 63, h = item & 3, row0 = b * SEQ + c * CH, tid = otid(), lane = tid & 63, wave = tid >> 6;
    float* Q = (float*)lds;
    float* Kt = Q + 64 * 128;
    float* Vt = Kt + 64 * 128;
    float* Sm = Vt + 64 * 128;
    float* sc = Sm + 64 * 64;
    const bf16_t* z = (const bf16_t*)(a.ws + WS_Z);
    const float* gates = (const float*)(a.ws + WS_SMALL + SM_GATES);
    const float mprev = ((const float*)(a.ws + WS_SMALL + SM_MPREV))[item];
    if (tid < 64) {
        chunk_gates(sc, gates, row0, h, lane);
        float g = sc[64 + lane] - sc[lane];
#pragma unroll
        for (int o = 1; o < 64; o <<= 1) { const float n = __shfl_up(g, o); if (lane >= o) g = fmaxf(g, n); }
        const float mrow = sc[lane] + fmaxf(mprev, g);
        sc[128 + lane] = mrow; sc[192 + lane] = __expf(sc[lane] + mprev - mrow);
    }
    const float* wc = a.in[I_WCQK] + (size_t)l * 4 * 1024; const float* bc = a.in[I_BCQK] + (size_t)l * 1024;
    for (int i = tid; i < 64 * 128; i += NT) {
        const int ll = i >> 7, d = i & 127, chq = ZQ + h * DH + d, chk = ZK + h * DH + d;
        Q[i] = siluf_(conv4(z + chq, row0 + ll, c * CH + ll, wc + chq, 1024, bc[chq])) * 0.08838834764831845f;
        Kt[i] = siluf_(conv4(z + chk, row0 + ll, c * CH + ll, wc + chk, 1024, bc[chk]));
        Vt[i] = bf2f(z[(size_t)(row0 + ll) * ZW + ZV + h * DH + d]);
    }
    __syncthreads();
    for (int i = tid; i < 64 * 64; i += NT) {
        const int ll = i >> 6, mm = i & 63; float s = 0.f;
        if (mm <= ll) {
            for (int d = 0; d < 128; ++d) s += Q[ll * 128 + d] * Kt[mm * 128 + d];
            s *= __expf(sc[ll] - sc[mm] + sc[64 + mm] - sc[128 + ll]);
        }
        Sm[i] = s;
    }
    __syncthreads();
    const float* ct = (const float*)(a.ws + WS_CT) + (size_t)item * EROWS * 128;
    if (tid < 64) {
        float di = 0.f, dn = 0.f;
        for (int mm = 0; mm < 64; ++mm) di += Sm[tid * 64 + mm];
        for (int d = 0; d < 128; ++d) dn += Q[tid * 128 + d] * ct[128 * 128 + d];
        const float den = di + sc[192 + tid] * dn;
        sc[256 + tid] = fmaxf(fabsf(den), __expf(-sc[128 + tid]));
    }
    const int e = tid & 127, lg = tid >> 7;
    float acc[16], acc2[16];
#pragma unroll
    for (int i = 0; i < 16; ++i) { acc[i] = 0.f; acc2[i] = 0.f; }
    for (int mm = 0; mm < 64; ++mm) { const float vv = Vt[mm * 128 + e];
#pragma unroll
        for (int i = 0; i < 16; ++i) acc[i] += Sm[(lg * 16 + i) * 64 + mm] * vv; }
    for (int d = 0; d < 128; ++d) { const float cv = ct[e * 128 + d];
#pragma unroll
        for (int i = 0; i < 16; ++i) acc2[i] += Q[(lg * 16 + i) * 128 + d] * cv; }
    __syncthreads();
#pragma unroll
    for (int i = 0; i < 16; ++i) { const int ll = lg * 16 + i;
        const float hv = (acc[i] + sc[192 + ll] * acc2[i]) / sc[256 + ll];
        const float o = sigmoidf_(bf2f(z[(size_t)(row0 + ll) * ZW + ZO + h * DH + e]));
        Kt[ll * 128 + e] = hv * o; }
    __syncthreads();
    const float* gm = a.in[I_GMH] + (size_t)l * DM + h * DH;
    bf16_t* mix = (bf16_t*)(a.ws + WS_MIX);
    for (int ll = wave * 8; ll < wave * 8 + 8; ++ll) {
        const float x0 = Kt[ll * 128 + 2 * lane], x1 = Kt[ll * 128 + 2 * lane + 1];
        const float rs = rsqrtf(wave_sum(x0 * x0 + x1 * x1) * (1.f / 128.f) + EPS);
        *(unsigned*)(mix + (size_t)(row0 + ll) * D + h * DH + 2 * lane) = pk2(x0 * rs * gm[2 * lane], x1 * rs * gm[2 * lane + 1]);
    }
    __syncthreads();
}


typedef short bf16x8 __attribute__((ext_vector_type(8)));
__device__ __forceinline__ f32x4 mfma16(bf16x8 a, bf16x8 b, f32x4 c) { return __builtin_amdgcn_mfma_f32_16x16x32_bf16(a, b, c, 0, 0, 0); }

template <int IN, int AUX>
__device__ __forceinline__ void phase_rowpass_mm(unsigned char* lds, const float* xin, bf16_t* hb, const float* g, float* ssq, const float* auxW, int auxld, const float* auxB,
                                                 float* gates, unsigned char* tok_p, float* tok_g, unsigned char* h8) {
    constexpr int WLD = 1032;
    bf16_t* wl = (bf16_t*)lds; float* gl = (float*)(lds + 8 * WLD * 2);
    const int tid = otid(), lane = tid & 63, wave = tid >> 6;
    for (int i = tid; i < D * 8; i += NT) { const int k = i >> 3, c = i & 7; wl[c * WLD + k] = (bf16_t)f2bf(g[k] * auxW[(size_t)k * auxld + c]); }
    if (AUX == 2) for (int i = tid; i < D; i += NT) gl[i] = g[i];
    __syncthreads();
    const int n = lane & 15, kq = lane >> 4;
    const bf16_t* wrow = wl + (n & 7) * WLD + 8 * kq;
    if (wave < 4) for (int task = blockIdx.x + gridDim.x * wave; task < M / 16; task += gridDim.x * 4) {
        const int row = task * 16 + n;
        f32x4 accL = {0.f, 0.f, 0.f, 0.f}, accS = {0.f, 0.f, 0.f, 0.f};
        u32x4 xr[32];
        if (IN == 1) {
            const u32x4* src = (const u32x4*)(hb + (size_t)row * D + 8 * kq);
#pragma unroll
            for (int s = 0; s < 32; ++s) xr[s] = src[4 * s];
            asm volatile("" ::: "memory");
#pragma unroll
            for (int s = 0; s < 32; ++s) { const bf16x8 xf = __builtin_bit_cast(bf16x8, xr[s]); const bf16x8 wf = *(const bf16x8*)(wrow + 32 * s);
                accL = mfma16(wf, xf, accL); accS = mfma16(xf, xf, accS); }
        } else {
            const f32x4* src = (const f32x4*)(xin + (size_t)row * D + 8 * kq); u32x4* dst = (u32x4*)(hb + (size_t)row * D + 8 * kq);
#pragma unroll
            for (int hf = 0; hf < 2; ++hf) { f32x4 xf32[32]; asm volatile("" ::: "memory");
#pragma unroll
                for (int s = 0; s < 16; ++s) { xf32[2 * s] = src[8 * (16 * hf + s)]; xf32[2 * s + 1] = src[8 * (16 * hf + s) + 1]; }
                asm volatile("" ::: "memory");
#pragma unroll
                for (int s = 0; s < 16; ++s) { const f32x4 a_ = xf32[2 * s], b_ = xf32[2 * s + 1];
                    u32x4 p; p.x = pk2(a_.x, a_.y); p.y = pk2(a_.z, a_.w); p.z = pk2(b_.x, b_.y); p.w = pk2(b_.z, b_.w); dst[4 * (16 * hf + s)] = p;
                    const bf16x8 xf = __builtin_bit_cast(bf16x8, p); const bf16x8 wf = *(const bf16x8*)(wrow + 32 * (16 * hf + s));
                    accL = mfma16(wf, xf, accL); accS = mfma16(xf, xf, accS); } }
        }
        float dv = accS[0]; dv = (n & 3) == 1 ? accS[1] : dv; dv = (n & 3) == 2 ? accS[2] : dv; dv = (n & 3) == 3 ? accS[3] : dv;
        const float tot = __shfl(dv, n + 16 * (n >> 2));
        const float rstd = __builtin_amdgcn_rsqf(tot * (1.f / D) + EPS);
        if (IN == 0) { f32x4 o = {kq == 0 ? tot : 0.f, 0.f, 0.f, 0.f}; *(f32x4*)(ssq + (size_t)row * 16 + 4 * kq) = o; }
        if (AUX == 1) {
            if (kq < 2) { const f32x4 b_ = *(const f32x4*)(auxB + 4 * kq); *(f32x4*)(gates + (size_t)row * 8 + 4 * kq) = accL * rstd + b_; }
        } else {
            const f32x4 lg = accL * rstd;
            float o4[4];
#pragma unroll
            for (int r = 0; r < 4; ++r) o4[r] = __shfl(lg[r], lane + 16);
            if (kq == 0) {
                float acc[8] = {lg[0], lg[1], lg[2], lg[3], o4[0], o4[1], o4[2], o4[3]};
                int e1 = 0; float v1 = acc[0];
#pragma unroll
                for (int c = 1; c < 8; ++c) if (acc[c] > v1) { v1 = acc[c]; e1 = c; }
                int e2 = -1; float v2 = -INFINITY;
#pragma unroll
                for (int c = 0; c < 8; ++c) if (c != e1 && acc[c] > v2) { v2 = acc[c]; e2 = c; }
                const float p2 = __expf(v2 - v1), inv = 1.f / (1.f + p2);
                tok_p[row] = (unsigned char)(e1 | (e2 << 4)); tok_g[row * 2] = inv; tok_g[row * 2 + 1] = p2 * inv;
            }
            if (h8) {
                u32x2* dst = (u32x2*)(h8 + (size_t)row * D + 8 * kq);
#pragma unroll
                for (int s = 0; s < 32; ++s) { if ((s & 3) == 0) asm volatile("" ::: "memory"); const u32x4 w = xr[s]; const f32x4 g0 = *(const f32x4*)(gl + 32 * s + 8 * kq), g1 = *(const f32x4*)(gl + 32 * s + 8 * kq + 4);
                    u32x2 o; o.x = pk4_fp8(bf2f(w.x & 0xffffu) * rstd * g0.x, __uint_as_float(w.x & 0xffff0000u) * rstd * g0.y, bf2f(w.y & 0xffffu) * rstd * g0.z, __uint_as_float(w.y & 0xffff0000u) * rstd * g0.w);
                    o.y = pk4_fp8(bf2f(w.z & 0xffffu) * rstd * g1.x, __uint_as_float(w.z & 0xffff0000u) * rstd * g1.y, bf2f(w.w & 0xffffu) * rstd * g1.z, __uint_as_float(w.w & 0xffff0000u) * rstd * g1.w);
                    dst[4 * s] = o; }
            }
        }
    }
    __syncthreads();
}

__device__ __forceinline__ void conv_load11(const bf16_t* zc, int row0, int l0, bool first_chunk, unsigned (&x)[11]) {
#pragma unroll
    for (int j = 0; j < 11; ++j) { const int ll = l0 - 3 + j; x[j] = (first_chunk && ll < 0) ? 0u : *(const unsigned*)(zc + (ptrdiff_t)(row0 + ll) * ZW); }
}
struct ConvW { float w[4][2]; float b[2]; };
__device__ __forceinline__ void conv_loadw(const float* wc, const float* bc, int col, ConvW& cw) {
#pragma unroll
    for (int j = 0; j < 4; ++j) { cw.w[j][0] = wc[j * 1024 + col]; cw.w[j][1] = wc[j * 1024 + col + 1]; }
    cw.b[0] = bc[col]; cw.b[1] = bc[col + 1];
}
__device__ __forceinline__ void conv_apply(const unsigned (&x)[11], const ConvW& cw, float (&out)[8][2]) {
#pragma unroll
    for (int i = 0; i < 8; ++i) { float a0 = cw.b[0], a1 = cw.b[1];
#pragma unroll
        for (int j = 0; j < 4; ++j) { a0 += cw.w[j][0] * bf2f(x[i + j] & 0xffffu); a1 += cw.w[j][1] * __uint_as_float(x[i + j] & 0xffff0000u); }
        out[i][0] = a0; out[i][1] = a1; }
}
struct MlRegs { unsigned xk[11], v[8]; ConvW cw; float gi, gf; };
__device__ __forceinline__ void ml_load(const Args& a, int l, int item, MlRegs& R) {
    const int b = item >> 8, c = (item >> 2) & 63, h = item & 3, row0 = b * SEQ + c * CH, tid = otid(), lane = tid & 63, wave = tid >> 6;
    const bf16_t* z = (const bf16_t*)(a.ws + WS_Z);
    const float* gates = (const float*)(a.ws + WS_SMALL + SM_GATES);
    const int cp = lane, lg = wave, colk = ZK + h * DH + 2 * cp, colv = ZV + h * DH + 2 * cp;
    conv_load11(z + colk, row0, 8 * lg, c == 0, R.xk);
#pragma unroll
    for (int i = 0; i < 8; ++i) R.v[i] = *(const unsigned*)(z + (size_t)(row0 + 8 * lg + i) * ZW + colv);
    conv_loadw(a.in[I_WCQK] + (size_t)l * 4 * 1024, a.in[I_BCQK] + (size_t)l * 1024, colk, R.cw);
    R.gi = gates[(size_t)(row0 + lane) * 8 + h]; R.gf = gates[(size_t)(row0 + lane) * 8 + 4 + h];
}
__device__ __forceinline__ void ml_compute(const Args& a, unsigned char* lds, int l, int item, MlRegs& R) {
    const int tid = otid(), lane = tid & 63, wave = tid >> 6, fr = lane & 15, fq = lane >> 4;
    unsigned char* KT = lds; unsigned char* VT = lds + 18432; float* RED = (float*)(lds + 36864); float* sc = (float*)(lds + 40960);
    const int cp = lane, lg = wave;
    unsigned (&xk)[11] = R.xk; unsigned (&v)[8] = R.v; ConvW& cw = R.cw;
    if (tid < 64) {
        chunk_gates_r(sc, R.gi, R.gf, lane);
        {
            float g = sc[64 + lane] - sc[lane];
#pragma unroll
            for (int o = 1; o < 64; o <<= 1) { const float n = __shfl_up(g, o); if (lane >= o) g = fmaxf(g, n); }
            float* scal = (float*)(a.ws + WS_SCAL) + (size_t)item * 128; scal[lane] = sc[lane]; scal[64 + lane] = g; }
        const float bl = __shfl(sc[lane], 63), al = bl - sc[lane] + sc[64 + lane];
        const float amax = wave_max(al);
        sc[128 + lane] = __expf(al - amax);
        if (lane == 0) { ((float*)(a.ws + WS_SMALL + SM_BL))[item] = bl; ((float*)(a.ws + WS_SMALL + SM_AMAX))[item] = amax; }
    }
    LDS_BARRIER();
    {
        float kk[8][2];
        conv_apply(xk, cw, kk);
        float n0 = 0.f, n1 = 0.f;
#pragma unroll
        for (int i = 0; i < 8; ++i) { const float wl = sc[128 + 8 * lg + i]; kk[i][0] = siluf_(kk[i][0]) * wl; kk[i][1] = siluf_(kk[i][1]) * wl; n0 += kk[i][0]; n1 += kk[i][1]; }
        u32x4 p0, p1;
#pragma unroll
        for (int i = 0; i < 4; ++i) { p0[i] = pk2(kk[2 * i][0], kk[2 * i + 1][0]); p1[i] = pk2(kk[2 * i][1], kk[2 * i + 1][1]); }
        *(u32x4*)(KT + (2 * cp) * 144 + lg * 16) = p0; *(u32x4*)(KT + (2 * cp + 1) * 144 + lg * 16) = p1;
        RED[lg * 128 + 2 * cp] = n0; RED[lg * 128 + 2 * cp + 1] = n1;
#pragma unroll
        for (int i = 0; i < 4; ++i) { p0[i] = (v[2 * i] & 0xffffu) | (v[2 * i + 1] << 16); p1[i] = (v[2 * i] >> 16) | (v[2 * i + 1] & 0xffff0000u); }
        *(u32x4*)(VT + (2 * cp) * 144 + lg * 16) = p0; *(u32x4*)(VT + (2 * cp + 1) * 144 + lg * 16) = p1;
    }
    LDS_BARRIER();
    bf16_t* ct = (bf16_t*)(a.ws + WS_CT) + (size_t)item * 128 * 128;
    {
        const int et0 = 2 * (wave & 3), dt0 = 4 * (wave >> 2);
        bf16x8 Vf[2][2], Kf[4][2];
#pragma unroll
        for (int i = 0; i < 2; ++i)
#pragma unroll
            for (int ks = 0; ks < 2; ++ks) Vf[i][ks] = *(const bf16x8*)(VT + ((et0 + i) * 16 + fr) * 144 + (ks * 32 + 8 * fq) * 2);
#pragma unroll
        for (int j = 0; j < 4; ++j)
#pragma unroll
            for (int ks = 0; ks < 2; ++ks) Kf[j][ks] = *(const bf16x8*)(KT + ((dt0 + j) * 16 + fr) * 144 + (ks * 32 + 8 * fq) * 2);
#pragma unroll
        for (int i = 0; i < 2; ++i)
#pragma unroll
            for (int j = 0; j < 4; ++j) {
                f32x4 acc = {0.f, 0.f, 0.f, 0.f};
                acc = mfma16(Kf[j][0], Vf[i][0], acc); acc = mfma16(Kf[j][1], Vf[i][1], acc);
                u32x2 w; w.x = pk2(acc[0], acc[1]); w.y = pk2(acc[2], acc[3]);
                *(u32x2*)(ct + ((et0 + i) * 16 + fr) * 128 + (dt0 + j) * 16 + 4 * fq) = w;
            }
    }
    if (tid < 128) { float s_ = 0.f;
#pragma unroll
        for (int g = 0; g < 8; ++g) s_ += RED[g * 128 + tid];
        ((float*)(a.ws + WS_DN))[(size_t)item * 128 + tid] = s_; }
    LDS_BARRIER();
}
struct RgoRegs { u32x4 hv[2], pv[2], yv[2]; f32x4 c0, c1, g0, g1; };
__device__ __forceinline__ void rgo_load(const Args& a, int l, int task, RgoRegs& R) {
    const int item = task >> 2, b = item >> 6, c = item & 63, row0 = b * SEQ + c * CH + (task & 3) * 16, tid = otid(), lane = tid & 63, nb = tid >> 6, ch0 = nb * 64 + (lane & 7) * 8, t0 = lane >> 3;
    const bf16_t* z = (const bf16_t*)(a.ws + WS_Z);
    const bf16_t* hlp = (const bf16_t*)a.out; const bf16_t* ppp = hlp + (size_t)M * DR;
#pragma unroll
    for (int j = 0; j < 2; ++j) { const size_t r = (size_t)(row0 + j * 8 + t0);
        R.hv[j] = *(const u32x4*)(hlp + r * DR + ch0); R.pv[j] = *(const u32x4*)(ppp + r * DR + ch0); R.yv[j] = *(const u32x4*)(z + r * ZW + ZYR + ch0); }
    const float* cp = (const float*)(a.ws + WS_SMALL + SM_RGP) + (size_t)item * DR + ch0; R.c0 = *(const f32x4*)cp; R.c1 = *(const f32x4*)(cp + 4);
    const float* gp = a.in[I_GR] + l * DR + ch0; R.g0 = *(const f32x4*)gp; R.g1 = *(const f32x4*)(gp + 4);
}
__device__ __forceinline__ void rgo_compute(const Args& a, int l, int task, const RgoRegs& R) {
    const int item = task >> 2, b = item >> 6, c = item & 63, row0 = b * SEQ + c * CH + (task & 3) * 16, tid = otid(), lane = tid & 63, nb = tid >> 6, ch0 = nb * 64 + (lane & 7) * 8, t0 = lane >> 3;
    bf16_t* mix = (bf16_t*)(a.ws + WS_MIX);
    const f32x4 g0 = R.g0, g1 = R.g1;
#pragma unroll
    for (int j = 0; j < 2; ++j) {
        f32x4 h0, h1, p0, p1, y0, y1; unpack8(R.hv[j], h0, h1); unpack8(R.pv[j], p0, p1); unpack8(R.yv[j], y0, y1);
        f32x4 o0, o1;
#pragma unroll
        for (int q = 0; q < 4; ++q) { o0[q] = (h0[q] + p0[q] * R.c0[q]) * gelu_tanh(y0[q]); o1[q] = (h1[q] + p1[q] * R.c1[q]) * gelu_tanh(y1[q]); }
        const float rs = __builtin_amdgcn_rsqf(sum8(dot8(o0, o1)) * (1.f / 64.f) + EPS);
        *(u32x4*)(mix + (size_t)(row0 + j * 8 + t0) * D + DM + ch0) = pack8(o0 * rs * g0, o1 * rs * g1);
    }
}
struct MoRegs { unsigned xq[11], xk[11], v[8]; u32x4 og[2]; float gi, gb, gg, mprev; };
__device__ __forceinline__ void mo_load(const Args& a, int l, int item, MoRegs& R) {
    const int b = item >> 8, c = (item >> 2) & 63, h = item & 3, row0 = b * SEQ + c * CH, tid = otid(), lane = tid & 63, wave = tid >> 6;
    const bf16_t* z = (const bf16_t*)(a.ws + WS_Z);
    const float* gates = (const float*)(a.ws + WS_SMALL + SM_GATES);
    const int cp = lane, lg = wave, colq = ZQ + h * DH + 2 * cp, colk = ZK + h * DH + 2 * cp, colv = ZV + h * DH + 2 * cp;
    conv_load11(z + colq, row0, 8 * lg, c == 0, R.xq);
    conv_load11(z + colk, row0, 8 * lg, c == 0, R.xk);
#pragma unroll
    for (int i = 0; i < 8; ++i) R.v[i] = *(const unsigned*)(z + (size_t)(row0 + 8 * lg + i) * ZW + colv);
#pragma unroll
    for (int j = 0; j < 2; ++j) { const int pc = tid + j * NT; R.og[j] = *(const u32x4*)(z + (size_t)(row0 + (pc >> 4)) * ZW + ZO + h * DH + (pc & 15) * 8); }
    R.gi = gates[(size_t)(row0 + lane) * 8 + h];
    { const float* scal = (const float*)(a.ws + WS_SCAL) + (size_t)item * 128; R.gb = scal[lane]; R.gg = scal[64 + lane]; }
    R.mprev = ((const float*)(a.ws + WS_SMALL + SM_MPREV))[item];
}
__device__ __forceinline__ void mo_compute(const Args& a, unsigned char* lds, int l, int item, MoRegs& R, ConvW& cwq, ConvW& cwk, int& hw, RgoRegs& rq) {
    const int b = item >> 8, c = (item >> 2) & 63, h = item & 3, row0 = b * SEQ + c * CH, tid = otid(), lane = tid & 63, wave = tid >> 6, fr = lane & 15, fq = lane >> 4;
    unsigned char* QN = lds; unsigned char* KN = lds + 17408; unsigned char* VT = lds + 34816; unsigned char* SP = lds + 53248;
    float* sc = (float*)(lds + 62464);
    float* HM = (float*)lds;
    const int cp = lane, lg = wave;
    unsigned (&xq)[11] = R.xq; unsigned (&xk)[11] = R.xk; unsigned (&v)[8] = R.v;
    bf16x8 Cf[4]; f32x4 dnv[4];
    { const bf16_t* ct = (const bf16_t*)(a.ws + WS_CT) + (size_t)item * 128 * 128; const float* dn = (const float*)(a.ws + WS_DN) + (size_t)item * 128;
#pragma unroll
      for (int ks = 0; ks < 4; ++ks) Cf[ks] = *(const bf16x8*)(ct + (wave * 16 + fr) * 128 + ks * 32 + 8 * fq);
#pragma unroll
      for (int j = 0; j < 4; ++j) dnv[j] = *(const f32x4*)(dn + (tid & 7) * 16 + 4 * j); }
    f32x4 gmv[2][2];
#pragma unroll
    for (int j = 0; j < 2; ++j) { const float* gp = a.in[I_GMH] + (size_t)l * DM + h * DH + ((tid + j * NT) & 15) * 8; gmv[j][0] = *(const f32x4*)gp; gmv[j][1] = *(const f32x4*)(gp + 4); }
    if (hw != h) { const float* wc = a.in[I_WCQK] + (size_t)l * 4 * 1024; const float* bc = a.in[I_BCQK] + (size_t)l * 1024;
        conv_loadw(wc, bc, ZQ + h * DH + 2 * cp, cwq); conv_loadw(wc, bc, ZK + h * DH + 2 * cp, cwk); hw = h; }
    rgo_load(a, l, item, rq);
    if (tid < 64) {
        const float mprev = R.mprev, mrow = R.gb + fmaxf(mprev, R.gg);
        sc[lane] = R.gb; sc[64 + lane] = R.gi; sc[128 + lane] = mrow; sc[192 + lane] = __expf(R.gb + mprev - mrow);
    }
    {
        float qq[8][2];
        conv_apply(xq, cwq, qq);
#pragma unroll
        for (int i = 0; i < 8; ++i) *(unsigned*)(QN + (8 * lg + i) * 272 + cp * 4) = pk2(siluf_(qq[i][0]) * 0.08838834764831845f, siluf_(qq[i][1]) * 0.08838834764831845f);
        conv_apply(xk, cwk, qq);
#pragma unroll
        for (int i = 0; i < 8; ++i) *(unsigned*)(KN + (8 * lg + i) * 272 + cp * 4) = pk2(siluf_(qq[i][0]), siluf_(qq[i][1]));
        u32x4 p0, p1;
#pragma unroll
        for (int i = 0; i < 4; ++i) { p0[i] = (v[2 * i] & 0xffffu) | (v[2 * i + 1] << 16); p1[i] = (v[2 * i] >> 16) | (v[2 * i + 1] & 0xffff0000u); }
        *(u32x4*)(VT + (2 * cp) * 144 + lg * 16) = p0; *(u32x4*)(VT + (2 * cp + 1) * 144 + lg * 16) = p1;
    }
    LDS_BARRIER();
    {
        const int ll = tid >> 3, part = tid & 7; float s_ = 0.f;
#pragma unroll
        for (int j = 0; j < 4; ++j) { const u32x2 qv = *(const u32x2*)(QN + ll * 272 + (part * 16 + 4 * j) * 2);
            s_ += bf2f(qv.x & 0xffffu) * dnv[j].x + __uint_as_float(qv.x & 0xffff0000u) * dnv[j].y + bf2f(qv.y & 0xffffu) * dnv[j].z + __uint_as_float(qv.y & 0xffff0000u) * dnv[j].w; }
        s_ = sum8(s_);
        if (part == 0) sc[384 + ll] = s_;
    }
    {
        const int lt = wave & 3; const int ll = lt * 16 + fr; const float bl_ = sc[ll], mr = sc[128 + ll]; float dsum = 0.f;
#pragma unroll
        for (int mi = 0; mi < 2; ++mi) {
            const int mt = 2 * (wave >> 2) + mi; u32x2 pk = {0u, 0u};
            if (mt <= lt) {
                f32x4 acc = {0.f, 0.f, 0.f, 0.f};
#pragma unroll
                for (int ks = 0; ks < 4; ++ks) { const bf16x8 A = *(const bf16x8*)(KN + (mt * 16 + fr) * 272 + (ks * 32 + 8 * fq) * 2), B = *(const bf16x8*)(QN + (lt * 16 + fr) * 272 + (ks * 32 + 8 * fq) * 2);
                    acc = mfma16(A, B, acc); }
                float sv[4];
#pragma unroll
                for (int r = 0; r < 4; ++r) { const int mm = mt * 16 + 4 * fq + r; const float wgt = (mm <= ll) ? __expf(bl_ - sc[mm] + sc[64 + mm] - mr) : 0.f; sv[r] = acc[r] * wgt; dsum += sv[r]; }
                pk.x = pk2(sv[0], sv[1]); pk.y = pk2(sv[2], sv[3]);
            }
            *(u32x2*)(SP + ll * 144 + (mt * 16 + 4 * fq) * 2) = pk;
        }
        dsum += __shfl_xor(dsum, 16); dsum += __shfl_xor(dsum, 32);
        if (fq == 0) sc[256 + (wave >> 2) * 64 + ll] = dsum;
    }
    LDS_BARRIER();
    if (tid < 64) { const float den = sc[256 + tid] + sc[320 + tid] + sc[192 + tid] * sc[384 + tid]; sc[448 + tid] = fmaxf(fabsf(den), __expf(-sc[128 + tid])); }
    f32x4 acc1[4], acc2[4];
    {
        bf16x8 Vf[2];
#pragma unroll
        for (int ks = 0; ks < 2; ++ks) Vf[ks] = *(const bf16x8*)(VT + (wave * 16 + fr) * 144 + (ks * 32 + 8 * fq) * 2);
#pragma unroll
        for (int lt = 0; lt < 4; ++lt) {
            acc1[lt] = (f32x4){0.f, 0.f, 0.f, 0.f}; acc2[lt] = (f32x4){0.f, 0.f, 0.f, 0.f};
#pragma unroll
            for (int ks = 0; ks < 2; ++ks) acc1[lt] = mfma16(*(const bf16x8*)(SP + (lt * 16 + fr) * 144 + (ks * 32 + 8 * fq) * 2), Vf[ks], acc1[lt]);
#pragma unroll
            for (int ks = 0; ks < 4; ++ks) acc2[lt] = mfma16(*(const bf16x8*)(QN + (lt * 16 + fr) * 272 + (ks * 32 + 8 * fq) * 2), Cf[ks], acc2[lt]);
        }
    }
    LDS_BARRIER();
#pragma unroll
    for (int lt = 0; lt < 4; ++lt)
#pragma unroll
        for (int r = 0; r < 4; ++r) { const int ll = lt * 16 + 4 * fq + r;
            HM[ll * 132 + wave * 16 + fr] = (acc1[lt][r] + sc[192 + ll] * acc2[lt][r]) * frcp(sc[448 + ll]); }
    LDS_BARRIER();
    {
        bf16_t* mix = (bf16_t*)(a.ws + WS_MIX);
#pragma unroll
        for (int j = 0; j < 2; ++j) { const int pc = tid + j * NT, ll = pc >> 4, q16 = pc & 15;
            const f32x4 h0 = *(const f32x4*)(HM + ll * 132 + q16 * 8), h1 = *(const f32x4*)(HM + ll * 132 + q16 * 8 + 4);
            f32x4 o0, o1; unpack8(R.og[j], o0, o1);
            f32x4 g0, g1;
#pragma unroll
            for (int q = 0; q < 4; ++q) { g0[q] = h0[q] * sigmoidf_(o0[q]); g1[q] = h1[q] * sigmoidf_(o1[q]); }
            const float rs = __builtin_amdgcn_rsqf(sum16(dot8(g0, g1)) * (1.f / 128.f) + EPS);
            *(u32x4*)(mix + (size_t)(row0 + ll) * D + h * DH + q16 * 8) = pack8(g0 * rs * gmv[j][0], g1 * rs * gmv[j][1]); }
    }
    LDS_BARRIER();
}

template <int MODE>
__device__ __forceinline__ void rglru_item(const Args& a, unsigned char* lds, int l, int item) {
    const int b = item >> 6, c = item & 63, row0 = b * SEQ + c * CH, ch = otid(), lane = ch & 63, nb = ch >> 6;
    float* xs = (float*)lds + nb * 64 * 64;
    const bf16_t* z = (const bf16_t*)(a.ws + WS_Z);
    const float* wcr = a.in[I_WCR] + (size_t)l * 4 * DR; const float bcr = a.in[I_BCR][l * DR + ch];
    const float w0 = wcr[ch], w1 = wcr[DR + ch], w2 = wcr[2 * DR + ch], w3 = wcr[3 * DR + ch];
    const bf16_t* zc = z + ZXR + ch;
    float xm3 = 0.f, xm2 = 0.f, xm1 = 0.f;
    { const int s0 = c * CH; if (s0 >= 3) { xm3 = bf2f(zc[(size_t)(row0 - 3) * ZW]); xm2 = bf2f(zc[(size_t)(row0 - 2) * ZW]); xm1 = bf2f(zc[(size_t)(row0 - 1) * ZW]); } }
#pragma unroll 4
    for (int t = 0; t < 64; ++t) { const float x0 = bf2f(zc[(size_t)(row0 + t) * ZW]);
        xs[t * 64 + lane] = bcr + w0 * xm3 + w1 * xm2 + w2 * xm1 + w3 * x0; xm3 = xm2; xm2 = xm1; xm1 = x0; }
    unsigned wa[32], wx[32];
    const float* wra = a.in[I_WRA] + ((size_t)(l * NBR + nb) * 64) * 64 + lane; const float* wri = a.in[I_WRI] + ((size_t)(l * NBR + nb) * 64) * 64 + lane;
#pragma unroll
    for (int d = 0; d < 32; ++d) { wa[d] = pk2(wra[(2 * d) * 64], wra[(2 * d + 1) * 64]); wx[d] = pk2(wri[(2 * d) * 64], wri[(2 * d + 1) * 64]); }
    const float ba = a.in[I_BRA][l * DR + ch], bx = a.in[I_BRI][l * DR + ch];
    const float lam = a.in[I_LAM][l * DR + ch];
    const float sp = fmaxf(-lam, 0.f) + log1pf(__expf(-fabsf(lam)));
    float hst = 0.f, ap = 1.f;
    if (MODE == 1) hst = ((const float*)(a.ws + WS_SMALL + SM_RGP))[(size_t)item * DR + ch];
    const float gr = a.in[I_GR][l * DR + ch];
    bf16_t* mix = (bf16_t*)(a.ws + WS_MIX);
    __syncthreads();
#pragma unroll 1
    for (int t = 0; t < 64; ++t) {
        float ra = ba, ia = bx;
#pragma unroll
        for (int d4 = 0; d4 < 16; ++d4) { const f32x4 xv = *(const f32x4*)(xs + t * 64 + 4 * d4);
#pragma unroll
            for (int q = 0; q < 2; ++q) { const unsigned pa = wa[2 * d4 + q], px = wx[2 * d4 + q];
                ra += xv[2 * q] * __uint_as_float(pa << 16) + xv[2 * q + 1] * __uint_as_float(pa & 0xffff0000u);
                ia += xv[2 * q] * __uint_as_float(px << 16) + xv[2 * q + 1] * __uint_as_float(px & 0xffff0000u); } }
        const float xo = xs[t * 64 + lane];
        const float r = sigmoidf_(ra), ig = sigmoidf_(ia), la = -8.f * r * sp, av = __expf(la);
        const float uu = sqrtf(-expm1f(2.f * la)) * (ig * xo);
        hst = av * hst + uu; ap *= av;
        if (MODE == 1) {
            const float y = bf2f(z[(size_t)(row0 + t) * ZW + ZYR + ch]);
            const float o = hst * gelu_tanh(y);
            const float rs = rsqrtf(wave_sum(o * o) * (1.f / 64.f) + EPS);
            mix[(size_t)(row0 + t) * D + DM + ch] = (bf16_t)f2bf(o * rs * gr);
        }
    }
    if (MODE == 0) { ((float*)(a.ws + WS_SMALL + SM_RGA))[(size_t)item * DR + ch] = ap; ((float*)(a.ws + WS_SMALL + SM_RGH))[(size_t)item * DR + ch] = hst; }
    __syncthreads();
}

template <int MODE>
__device__ __forceinline__ void rglru_fast(const Args& a, unsigned char* lds, int l, int item) {
    const int b = item >> 6, c = item & 63, row0 = b * SEQ + c * CH, ch = otid(), lane = ch & 63, nb = ch >> 6, fr = lane & 15, fq = lane >> 4;
    unsigned char* XA = lds + nb * 9216;
    float* GS = (float*)(lds + 73728 + nb * 8448);
    const bf16_t* z = (const bf16_t*)(a.ws + WS_Z);
    unsigned ypk[32];
    {
        const float* wcr = a.in[I_WCR] + (size_t)l * 4 * DR; const float bcr = a.in[I_BCR][l * DR + ch];
        const float w0 = wcr[ch], w1 = wcr[DR + ch], w2 = wcr[2 * DR + ch], w3 = wcr[3 * DR + ch];
        const bf16_t* zc = z + ZXR + ch;
        bf16_t xin[67];
#pragma unroll
        for (int t = 0; t < 67; ++t) xin[t] = (c == 0 && t < 3) ? (bf16_t)0 : zc[(ptrdiff_t)(row0 + t - 3) * ZW];
        if (MODE == 1) {
            bf16_t yb[64];
#pragma unroll
            for (int t = 0; t < 64; ++t) yb[t] = z[(size_t)(row0 + t) * ZW + ZYR + ch];
#pragma unroll
            for (int t = 0; t < 32; ++t) ypk[t] = (unsigned)yb[2 * t] | ((unsigned)yb[2 * t + 1] << 16);
        }
#pragma unroll
        for (int t = 0; t < 64; ++t)
            *(bf16_t*)(XA + t * 144 + lane * 2) = (bf16_t)f2bf(bcr + w0 * bf2f(xin[t]) + w1 * bf2f(xin[t + 1]) + w2 * bf2f(xin[t + 2]) + w3 * bf2f(xin[t + 3]));
    }
    bf16x8 Bf[8][2];
    { const bf16_t* wt = (const bf16_t*)(a.ws + WS_SMALL + SM_RGW) + (size_t)((l * NBR + nb) * 2) * 64 * 64;
#pragma unroll
        for (int ct = 0; ct < 8; ++ct)
#pragma unroll
            for (int ks = 0; ks < 2; ++ks) Bf[ct][ks] = *(const bf16x8*)(wt + (size_t)((ct >> 2) * 64 + (ct & 3) * 16 + fr) * 64 + ks * 32 + 8 * fq); }
    const float ba = a.in[I_BRA][l * DR + ch], bx = a.in[I_BRI][l * DR + ch];
    const float lam = a.in[I_LAM][l * DR + ch];
    const float sp8 = -8.f * (fmaxf(-lam, 0.f) + log1pf(__expf(-fabsf(lam))));
    float hst = 0.f, ap = 1.f;
    if (MODE == 1) hst = ((const float*)(a.ws + WS_SMALL + SM_RGP))[(size_t)item * DR + ch];
    const float gr = a.in[I_GR][l * DR + ch];
    bf16_t* mix = (bf16_t*)(a.ws + WS_MIX);
    WAVE_LDS_SYNC();
#pragma unroll
    for (int rt = 0; rt < 4; ++rt) {
        bf16x8 Af[2];
#pragma unroll
        for (int ks = 0; ks < 2; ++ks) Af[ks] = *(const bf16x8*)(XA + (rt * 16 + fr) * 144 + (ks * 32 + 8 * fq) * 2);
#pragma unroll
        for (int ct = 0; ct < 8; ++ct) {
            f32x4 acc = {0.f, 0.f, 0.f, 0.f};
            acc = mfma16(Af[0], Bf[ct][0], acc); acc = mfma16(Af[1], Bf[ct][1], acc);
#pragma unroll
            for (int r = 0; r < 4; ++r) GS[(4 * fq + r) * 132 + (ct >> 2) * 64 + (ct & 3) * 16 + fr] = acc[r];
        }
        WAVE_LDS_SYNC();
        {
            float ra[16], ia[16], xo[16], ov_[16], apv_[16];
#pragma unroll
            for (int tt = 0; tt < 16; ++tt) { ra[tt] = GS[tt * 132 + lane]; ia[tt] = GS[tt * 132 + 64 + lane]; xo[tt] = bf2f(*(const bf16_t*)(XA + (rt * 16 + tt) * 144 + lane * 2)); }
#pragma unroll
            for (int tt = 0; tt < 16; ++tt) {
                const float r = sigmoidf_(ra[tt] + ba), ig = sigmoidf_(ia[tt] + bx), la = sp8 * r, av = __expf(la);
                const float uu = __builtin_amdgcn_sqrtf(fmaxf(fmaf(-av, av, 1.f), 0.f)) * (ig * xo[tt]);
                hst = av * hst + uu; ap *= av;
                ov_[tt] = hst; apv_[tt] = ap;
            }
            if (MODE == 0) {
                unsigned char* GB = (unsigned char*)GS;
#pragma unroll
                for (int tt = 0; tt < 16; ++tt) { *(bf16_t*)(GB + tt * 128 + lane * 2) = (bf16_t)f2bf(ov_[tt]); *(bf16_t*)(GB + 2048 + tt * 128 + lane * 2) = (bf16_t)f2bf(apv_[tt]); }
                WAVE_LDS_SYNC();
                bf16_t* hlp = (bf16_t*)a.out; bf16_t* ppp = hlp + (size_t)M * DR;
#pragma unroll
                for (int j = 0; j < 2; ++j) { const int p = lane + 64 * j; const size_t off = (size_t)(row0 + rt * 16 + (p >> 3)) * DR + nb * 64 + (p & 7) * 8;
                    *(u32x4*)(hlp + off) = *(const u32x4*)(GB + p * 16); *(u32x4*)(ppp + off) = *(const u32x4*)(GB + 2048 + p * 16); }
            }
            if (MODE == 1) {
#pragma unroll
                for (int tt = 0; tt < 16; ++tt) *(bf16_t*)(XA + (rt * 16 + tt) * 144 + lane * 2) = (bf16_t)f2bf(ov_[tt] * gelu_tanh((tt & 1) ? __uint_as_float(ypk[rt * 8 + (tt >> 1)] & 0xffff0000u) : bf2f(ypk[rt * 8 + (tt >> 1)] & 0xffffu)));
            }
        }
        WAVE_LDS_SYNC();
    }
    if (MODE == 1) {
        float ss = 0.f;
#pragma unroll
        for (int j = 0; j < 8; ++j) { const u32x4 v = *(const u32x4*)(XA + lane * 144 + j * 16);
#pragma unroll
            for (int q = 0; q < 4; ++q) { const float lo = bf2f(v[q] & 0xffffu), hi = __uint_as_float(v[q] & 0xffff0000u); ss += lo * lo + hi * hi; } }
        const float rs = rsqrtf(ss * (1.f / 64.f) + EPS) ;
#pragma unroll
        for (int t0 = 0; t0 < 64; t0 += 16) { float ovv[16];
#pragma unroll
            for (int tt = 0; tt < 16; ++tt) ovv[tt] = bf2f(*(const bf16_t*)(XA + (t0 + tt) * 144 + lane * 2));
#pragma unroll
            for (int tt = 0; tt < 16; ++tt) { const float rst = __int_as_float(__builtin_amdgcn_readlane(__float_as_int(rs), t0 + tt));
                *(bf16_t*)(XA + (t0 + tt) * 144 + lane * 2) = (bf16_t)f2bf(ovv[tt] * rst * gr); } }
        WAVE_LDS_SYNC();
#pragma unroll
        for (int j = 0; j < 8; ++j) { const int t = j * 8 + (lane >> 3), q16 = lane & 7;
            *(u32x4*)(mix + (size_t)(row0 + t) * D + DM + nb * 64 + q16 * 8) = *(const u32x4*)(XA + t * 144 + q16 * 16); }
    }
    if (MODE == 0) { ((float*)(a.ws + WS_SMALL + SM_RGA))[(size_t)item * DR + ch] = ap; ((float*)(a.ws + WS_SMALL + SM_RGH))[(size_t)item * DR + ch] = hst; }
    LDS_BARRIER();
}
__device__ __forceinline__ void rglru_out(const Args& a, int l, int item) {
    const int b = item >> 6, c = item & 63, row0 = b * SEQ + c * CH, tid = otid(), lane = tid & 63, nb = tid >> 6, ch0 = nb * 64 + (lane & 7) * 8, t0 = lane >> 3;
    const bf16_t* z = (const bf16_t*)(a.ws + WS_Z);
    const bf16_t* hlp = (const bf16_t*)a.out; const bf16_t* ppp = hlp + (size_t)M * DR;
    bf16_t* mix = (bf16_t*)(a.ws + WS_MIX);
    u32x4 hv[8], pv[8], yv[8];
#pragma unroll
    for (int j = 0; j < 8; ++j) { const size_t r = (size_t)(row0 + j * 8 + t0);
        hv[j] = *(const u32x4*)(hlp + r * DR + ch0); pv[j] = *(const u32x4*)(ppp + r * DR + ch0); yv[j] = *(const u32x4*)(z + r * ZW + ZYR + ch0); }
    const float* cp = (const float*)(a.ws + WS_SMALL + SM_RGP) + (size_t)item * DR + ch0; const f32x4 c0 = *(const f32x4*)cp, c1 = *(const f32x4*)(cp + 4);
    const float* gp = a.in[I_GR] + l * DR + ch0; const f32x4 g0 = *(const f32x4*)gp, g1 = *(const f32x4*)(gp + 4);
#pragma unroll
    for (int j = 0; j < 8; ++j) {
        f32x4 h0, h1, p0, p1, y0, y1; unpack8(hv[j], h0, h1); unpack8(pv[j], p0, p1); unpack8(yv[j], y0, y1);
        f32x4 o0, o1;
#pragma unroll
        for (int q = 0; q < 4; ++q) { o0[q] = (h0[q] + p0[q] * c0[q]) * gelu_tanh(y0[q]); o1[q] = (h1[q] + p1[q] * c1[q]) * gelu_tanh(y1[q]); }
        const float rs = __builtin_amdgcn_rsqf(sum8(dot8(o0, o1)) * (1.f / 64.f) + EPS);
        *(u32x4*)(mix + (size_t)(row0 + j * 8 + t0) * D + DM + ch0) = pack8(o0 * rs * g0, o1 * rs * g1);
    }
}
__device__ __forceinline__ void rglru_scan(const Args& a, int G) {
    const int tid = otid(), lane = tid & 63, wave = tid >> 6;
    for (int i = blockIdx.x * 8 + wave; i < NBATCH * DR; i += G * 8) {
        const int b = i / DR, ch = i % DR; const size_t o = (size_t)(b * NC + lane) * DR + ch;
        float A = ((const float*)(a.ws + WS_SMALL + SM_RGA))[o], H = ((const float*)(a.ws + WS_SMALL + SM_RGH))[o];
#pragma unroll
        for (int d = 1; d < 64; d <<= 1) { const float Ap = __shfl_up(A, d), Hp = __shfl_up(H, d); if (lane >= d) { H = A * Hp + H; A = A * Ap; } }
        const float pin = __shfl_up(H, 1);
        ((float*)(a.ws + WS_SMALL + SM_RGP))[o] = lane == 0 ? 0.f : pin;
    }
}

__device__ __forceinline__ void phase_route(const Args& a, unsigned char* lds) {
    unsigned* wtot = (unsigned*)lds;
    int* pre = (int*)(lds + 256);
    int* tot = pre + 8;
    int* ce = tot + 16;
    unsigned* pref = (unsigned*)(lds + 2048);
    const int tid = otid(), lane = tid & 63, wave = tid >> 6, G = gridDim.x;
    const unsigned char* tok_p = (const unsigned char*)(a.ws + WS_SMALL + SM_TOKP); const float* tok_g = (const float*)(a.ws + WS_SMALL + SM_TOKG);
    int* row_tok = (int*)(a.ws + WS_SMALL + SM_ROWTOK); float* row_gate = (float*)(a.ws + WS_SMALL + SM_ROWGATE); int* tile_e = (int*)(a.ws + WS_SMALL + SM_TILEE);
    if (tid < 256) {
        unsigned long long hh = 0ull;
#pragma unroll
        for (int j = 0; j < 4; ++j) { const u32x4 v = ((const u32x4*)(tok_p + tid * 64))[j];
#pragma unroll
            for (int q = 0; q < 4; ++q)
#pragma unroll
                for (int bb = 0; bb < 4; ++bb) { const unsigned by = (v[q] >> (8 * bb)) & 0xffu; hh += (1ull << (8 * (by & 15u))) + (1ull << (8 * (by >> 4))); } }
        unsigned w[4];
#pragma unroll
        for (int i = 0; i < 4; ++i) { const unsigned two = (unsigned)(hh >> (16 * i)) & 0xffffu; w[i] = (two & 0xffu) | ((two >> 8) << 16); }
        unsigned inc[4];
#pragma unroll
        for (int i = 0; i < 4; ++i) { unsigned x = w[i];
#pragma unroll
            for (int o = 1; o < 64; o <<= 1) { const unsigned n = __shfl_up(x, o); if (lane >= o) x += n; }
            inc[i] = x; }
        if (lane == 63) {
#pragma unroll
            for (int i = 0; i < 4; ++i) wtot[wave * 4 + i] = inc[i]; }
        __builtin_amdgcn_s_waitcnt(0);
        __builtin_amdgcn_s_barrier();
#pragma unroll
        for (int i = 0; i < 4; ++i) { unsigned base = 0u;
            for (int ww = 0; ww < wave; ++ww) base += wtot[ww * 4 + i];
            pref[tid * 4 + i] = base + inc[i] - w[i];
            if (tid == 255) { const unsigned t2 = base + inc[i]; tot[2 * i] = (int)(t2 & 0xffffu); tot[2 * i + 1] = (int)(t2 >> 16); } }
    } else {
        __builtin_amdgcn_s_barrier();
    }
    __syncthreads();
    if (tid == 0) { int s_ = 0; for (int e = 0; e < 8; ++e) { tot[8 + e] = s_; s_ += (tot[e] + 255) & ~255; }
        if (blockIdx.x == 0) { int t = 0; for (int e = 0; e < 8; ++e) { const int n = (tot[e] + 255) >> 8; for (int j = 0; j < n; ++j) tile_e[t++] = e; tile_e[256 + e] = t; } tile_e[255] = t; } }
    __syncthreads();
    for (int ck = blockIdx.x; ck < 256; ck += G) {
        if (tid < 128) { const unsigned by = tok_p[ck * 64 + (tid >> 1)]; ce[tid] = (tid & 1) ? (int)(by >> 4) : (int)(by & 15u); }
        __syncthreads();
        if (tid < 128) { const int e = ce[tid];
            int rank = 0, w0cnt = 0;
#pragma unroll
            for (int q = 0; q < 8; ++q) { const unsigned long long mk = __ballot(e == q); if (e == q) rank = __popcll(mk & ((1ull << lane) - 1ull)); if (wave == 0 && lane == 0) ce[128 + q] = __popcll(mk); }
            __builtin_amdgcn_s_waitcnt(0);
            asm volatile("s_barrier" ::: "memory");
            if (wave == 1) rank += ce[128 + e];
            (void)w0cnt;
            const unsigned pw = pref[ck * 4 + (e >> 1)]; const int pr = (int)((e & 1) ? (pw >> 16) : (pw & 0xffffu));
            const int dest = tot[8 + e] + pr + rank;
            row_tok[dest] = ck * 64 + (tid >> 1); row_gate[dest] = tok_g[ck * 128 + tid]; ((int*)(a.ws + WS_SMALL + SM_ROWSLOT))[dest] = tid & 1; }
        else { asm volatile("s_barrier" ::: "memory"); }
        __syncthreads();
    }
}

#ifndef GEMM
#define GEMM gemm_fast
#endif
__global__ void __launch_bounds__(NT, 2) mk_fwd(Args a0) {
    extern __shared__ __attribute__((aligned(16))) unsigned char lds[];
    const int G = gridDim.x, bid = blockIdx.x, ph_lo = a0.ph_lo, ph_hi = a0.ph_hi;
    volatile LAS unsigned* xst = (volatile LAS unsigned*)(lds + LDS_BYTES - 64);
    if (threadIdx.x < 2) xst[threadIdx.x] = 0u;
    __syncthreads();
    const XcdBarrier xb = xcd_barrier_post((unsigned*)(a0.ws + WS_SMALL + SM_BAR), xst);
    int ph = 0;
#ifndef PROBE_CAT
#define PROBE_CAT 0
#define PROBE_N 1
#endif
#define PHASE_BEGIN(cat) if (ph >= ph_lo && ph < ph_hi) { for (int rep_ = 0; rep_ < ((cat) == PROBE_CAT ? PROBE_N : 1); ++rep_) { const bool lastrep = (rep_ + 1 == ((cat) == PROBE_CAT ? PROBE_N : 1)); (void)lastrep; const Args& a = *(const Args*)okarg(); unsigned char* const ws = a.ws; \
    bf16_t* const hn = (bf16_t*)(ws + WS_HN); bf16_t* const z = (bf16_t*)(ws + WS_Z); bf16_t* const mix = (bf16_t*)(ws + WS_MIX); bf16_t* const hid = (bf16_t*)(ws + WS_HID); \
    float* const gates = (float*)(ws + WS_SMALL + SM_GATES); int* const tok_e = (int*)(ws + WS_SMALL + SM_TOKP); float* const tok_g = (float*)(ws + WS_SMALL + SM_TOKG); \
    const int* const row_tok = (const int*)(ws + WS_SMALL + SM_ROWTOK); const float* const row_gate = (const float*)(ws + WS_SMALL + SM_ROWGATE); const int* const tile_e = (const int*)(ws + WS_SMALL + SM_TILEE); \
    (void)hn; (void)z; (void)mix; (void)hid; (void)gates; (void)tok_e; (void)tok_g; (void)row_tok; (void)row_gate; (void)tile_e;
#define PHASE_END(dosync) } for (int rep_ = 0; rep_ < (PROBE_CAT == 6 ? PROBE_N : 1); ++rep_) if ((dosync) && ph + 1 < ph_hi) { xcd_barrier(xb); } } ++ph;

    PHASE_BEGIN(1) phase_prologue(a, lds); __syncthreads();
        phase_rowpass_mm<0, 1>(lds, a.in[I_X], hn, a.in[I_GMIX], (float*)(ws + WS_SSQ), a.in[I_WIN] + 2048, DIN, a.in[I_BIN] + 2048, gates, nullptr, nullptr, nullptr); PHASE_END(true)
    { constexpr int l = 0;
#define LAYER_PTRS bf16_t* const hb = (bf16_t*)(ws + (l ? WS_H1 : WS_HN)); bf16_t* const hbo = (bf16_t*)(ws + (l ? WS_HN : WS_H1)); float* const ssq = (float*)(ws + WS_SSQ + l * SSQ_STRIDE); float* const ssqo = (float*)(ws + WS_SSQ + (1 - l) * SSQ_STRIDE); (void)hb; (void)hbo; (void)ssq; (void)ssqo;
        PHASE_BEGIN(3) LAYER_PTRS { if (l == 1) phase_rowpass_mm<1, 1>(lds, nullptr, hb, a.in[I_GMIX] + l * D, nullptr, a.in[I_WIN] + (size_t)l * D * DIN + 2048, DIN, a.in[I_BIN] + l * DIN + 2048, gates, nullptr, nullptr, nullptr);
            GridOrder S{M / 256, ZW / 256, G, bid}; EpiZ E{z, a.in[I_BIN] + l * DIN, ssq};
            GEMM(lds, hb, (const bf16_t*)(ws + (l ? WS_W_IN1 : WS_W_IN0)), D, S, E); } PHASE_END(true)
        PHASE_BEGIN(4) LAYER_PTRS { MlRegs cur, nxt; int it = bid; if (it < 1024) ml_load(a, l, it, cur); nxt = cur;
            for (; it < 1024; it += G) { if (it + G < 1024) ml_load(a, l, it + G, nxt); ml_compute(a, lds, l, it, cur); cur = nxt; }
            for (; it < 1280; it += G) rglru_fast<0>(a, lds, l, it - 1024); } PHASE_END(true)
        PHASE_BEGIN(0) LAYER_PTRS mlstm_scan(a, G); rglru_scan(a, G); PHASE_END(true)
        PHASE_BEGIN(5) LAYER_PTRS { MoRegs cur, nxt; RgoRegs rq; ConvW cwq, cwk; int hw = -1; int it = bid; if (it < 1024) mo_load(a, l, it, cur); nxt = cur;
            for (; it < 1024; it += G) { if (it + G < 1024) mo_load(a, l, it + G, nxt); mo_compute(a, lds, l, it, cur, cwq, cwk, hw, rq); rgo_compute(a, l, it, rq); cur = nxt; } } PHASE_END(true)
        PHASE_BEGIN(0) LAYER_PTRS { GridOrder S{M / 256, D / 256, G, bid}; EpiHres<l == 0> E{l == 0 ? a.in[I_X] : nullptr, hb, ssq};
            GEMM(lds, mix, (const bf16_t*)(ws + (l ? WS_W_OUT1 : WS_W_OUT0)), D, S, E); } PHASE_END(true)
        if (l == 0) {
            PHASE_BEGIN(3) LAYER_PTRS { GridOrder S{M / 256, 2 * DFF / 256, G, bid}; EpiSwiglu E{hid, ssq, nullptr};
                GEMM(lds, hb, (const bf16_t*)(ws + WS_W_FFGU), D, S, E);
                { constexpr int nun = (M / 256) * (2 * DFF / 256); const int first = nun % G;
                  TailOrder S2{M / 256, D / 256, G, bid, first}; EpiStoreBf16 E2{(bf16_t*)(ws + WS_PP0)};
                  GEMM(lds, (const bf16_t*)(ws + WS_PB0), (const bf16_t*)(ws + WS_W_PP0), DPLE, S2, E2); } } PHASE_END(true)
            PHASE_BEGIN(0) LAYER_PTRS { GridOrder S{M / 256, D / 256, G, bid}; EpiHres<false> E{nullptr, hb, ssq};
                GEMM(lds, hid, (const bf16_t*)(ws + WS_W_FFD), DFF, S, E); } PHASE_END(true)
        } else {
            PHASE_BEGIN(2) LAYER_PTRS phase_rowpass_mm<1, 2>(lds, nullptr, hb, a.in[I_GFFN] + l * D, nullptr, a.in[I_WROUTER], 8, nullptr, nullptr, (unsigned char*)tok_e, tok_g, ws + WS_HN8); PHASE_END(true)
            PHASE_BEGIN(12) LAYER_PTRS phase_route(a, lds); PHASE_END(true)
            PHASE_BEGIN(3) LAYER_PTRS { MoeOrder<true> S{tile_e[255], 2 * DFF / 256, G, bid, row_tok, (size_t)5632 * D}; S.init(tile_e); EpiSwiglu8 E{ws + WS_HID, 1.f / 32.f};
                gemm_fast<true>(lds, (const bf16_t*)(ws + WS_HN8), (const bf16_t*)(ws + WS_W_EGU), D, S, E); } PHASE_END(true)
            PHASE_BEGIN(0) LAYER_PTRS { MoeOrder<false> S{tile_e[255], D / 256, G, bid, nullptr, (size_t)D * DFF}; S.init(tile_e); EpiMoeDown E{hb, (bf16_t*)a.out, row_tok, (const int*)(ws + WS_SMALL + SM_ROWSLOT), row_gate, 1.f / 32.f};
                gemm_fast<true>(lds, (const bf16_t*)(ws + WS_HID), (const bf16_t*)(ws + WS_W_ED), DFF, S, E);
                { const int nun = tile_e[255] * (D / 256); const int first = nun > 2 * G ? nun - 2 * G : 0;
                  TailOrder S2{M / 256, D / 256, G, bid, first < G ? first : 0}; EpiStoreBf16 E2{(bf16_t*)a.out + (size_t)M * D};
                  GEMM(lds, (const bf16_t*)(ws + WS_PB1), (const bf16_t*)(ws + WS_W_PP1), DPLE, S2, E2); } } PHASE_END(true)
            PHASE_BEGIN(0) LAYER_PTRS phase_rowpass<1, 0, 1, true>(lds, nullptr, hb, (const bf16_t*)a.out, nullptr, ssq, nullptr, 0, nullptr, nullptr, nullptr, nullptr, nullptr); PHASE_END(true)
        }
        PHASE_BEGIN(10) LAYER_PTRS { GridOrder S{M / 256, D / 256, G, bid};
            EpiPle E{hb, hbo, l == 0 ? (const bf16_t*)(ws + WS_PP0) : (const bf16_t*)a.out + (size_t)M * D, ssqo, ssq}; GEMM(lds, hb, (const bf16_t*)(ws + WS_W_PG) + (size_t)l * D * D, D, S, E);
            if (l == 0 && bid == 0) { for (int i = otid(); i < D / 2; i += NT) ((unsigned*)(ws + WS_H1 + (size_t)M * D * 2))[i] = 0u; } } PHASE_END(true)
    }
    { constexpr int l = 1;
        PHASE_BEGIN(3) LAYER_PTRS { if (l == 1) phase_rowpass_mm<1, 1>(lds, nullptr, hb, a.in[I_GMIX] + l * D, nullptr, a.in[I_WIN] + (size_t)l * D * DIN + 2048, DIN, a.in[I_BIN] + l * DIN + 2048, gates, nullptr, nullptr, nullptr);
            GridOrder S{M / 256, ZW / 256, G, bid}; EpiZ E{z, a.in[I_BIN] + l * DIN, ssq};
            GEMM(lds, hb, (const bf16_t*)(ws + (l ? WS_W_IN1 : WS_W_IN0)), D, S, E); } PHASE_END(true)
        PHASE_BEGIN(4) LAYER_PTRS { MlRegs cur, nxt; int it = bid; if (it < 1024) ml_load(a, l, it, cur); nxt = cur;
            for (; it < 1024; it += G) { if (it + G < 1024) ml_load(a, l, it + G, nxt); ml_compute(a, lds, l, it, cur); cur = nxt; }
            for (; it < 1280; it += G) rglru_fast<0>(a, lds, l, it - 1024); } PHASE_END(true)
        PHASE_BEGIN(0) LAYER_PTRS mlstm_scan(a, G); rglru_scan(a, G); PHASE_END(true)
        PHASE_BEGIN(5) LAYER_PTRS { MoRegs cur, nxt; RgoRegs rq; ConvW cwq, cwk; int hw = -1; int it = bid; if (it < 1024) mo_load(a, l, it, cur); nxt = cur;
            for (; it < 1024; it += G) { if (it + G < 1024) mo_load(a, l, it + G, nxt); mo_compute(a, lds, l, it, cur, cwq, cwk, hw, rq); rgo_compute(a, l, it, rq); cur = nxt; } } PHASE_END(true)
        PHASE_BEGIN(0) LAYER_PTRS { GridOrder S{M / 256, D / 256, G, bid}; EpiHres<l == 0> E{l == 0 ? a.in[I_X] : nullptr, hb, ssq};
            GEMM(lds, mix, (const bf16_t*)(ws + (l ? WS_W_OUT1 : WS_W_OUT0)), D, S, E); } PHASE_END(true)
        if (l == 0) {
            PHASE_BEGIN(3) LAYER_PTRS { GridOrder S{M / 256, 2 * DFF / 256, G, bid}; EpiSwiglu E{hid, ssq, nullptr};
                GEMM(lds, hb, (const bf16_t*)(ws + WS_W_FFGU), D, S, E);
                { constexpr int nun = (M / 256) * (2 * DFF / 256); const int first = nun % G;
                  TailOrder S2{M / 256, D / 256, G, bid, first}; EpiStoreBf16 E2{(bf16_t*)(ws + WS_PP0)};
                  GEMM(lds, (const bf16_t*)(ws + WS_PB0), (const bf16_t*)(ws + WS_W_PP0), DPLE, S2, E2); } } PHASE_END(true)
            PHASE_BEGIN(0) LAYER_PTRS { GridOrder S{M / 256, D / 256, G, bid}; EpiHres<false> E{nullptr, hb, ssq};
                GEMM(lds, hid, (const bf16_t*)(ws + WS_W_FFD), DFF, S, E); } PHASE_END(true)
        } else {
            PHASE_BEGIN(2) LAYER_PTRS phase_rowpass_mm<1, 2>(lds, nullptr, hb, a.in[I_GFFN] + l * D, nullptr, a.in[I_WROUTER], 8, nullptr, nullptr, (unsigned char*)tok_e, tok_g, ws + WS_HN8); PHASE_END(true)
            PHASE_BEGIN(12) LAYER_PTRS phase_route(a, lds); PHASE_END(true)
            PHASE_BEGIN(3) LAYER_PTRS { MoeOrder<true> S{tile_e[255], 2 * DFF / 256, G, bid, row_tok, (size_t)5632 * D}; S.init(tile_e); EpiSwiglu8 E{ws + WS_HID, 1.f / 32.f};
                gemm_fast<true>(lds, (const bf16_t*)(ws + WS_HN8), (const bf16_t*)(ws + WS_W_EGU), D, S, E); } PHASE_END(true)
            PHASE_BEGIN(0) LAYER_PTRS { MoeOrder<false> S{tile_e[255], D / 256, G, bid, nullptr, (size_t)D * DFF}; S.init(tile_e); EpiMoeDown E{hb, (bf16_t*)a.out, row_tok, (const int*)(ws + WS_SMALL + SM_ROWSLOT), row_gate, 1.f / 32.f};
                gemm_fast<true>(lds, (const bf16_t*)(ws + WS_HID), (const bf16_t*)(ws + WS_W_ED), DFF, S, E);
                { const int nun = tile_e[255] * (D / 256); const int first = nun > 2 * G ? nun - 2 * G : 0;
                  TailOrder S2{M / 256, D / 256, G, bid, first < G ? first : 0}; EpiStoreBf16 E2{(bf16_t*)a.out + (size_t)M * D};
                  GEMM(lds, (const bf16_t*)(ws + WS_PB1), (const bf16_t*)(ws + WS_W_PP1), DPLE, S2, E2); } } PHASE_END(true)
            PHASE_BEGIN(0) LAYER_PTRS phase_rowpass<1, 0, 1, true>(lds, nullptr, hb, (const bf16_t*)a.out, nullptr, ssq, nullptr, 0, nullptr, nullptr, nullptr, nullptr, nullptr); PHASE_END(true)
        }
        PHASE_BEGIN(10) LAYER_PTRS { GridOrder S{M / 256, D / 256, G, bid};
            EpiPle E{hb, hbo, l == 0 ? (const bf16_t*)(ws + WS_PP0) : (const bf16_t*)a.out + (size_t)M * D, ssqo, ssq}; GEMM(lds, hb, (const bf16_t*)(ws + WS_W_PG) + (size_t)l * D * D, D, S, E);
            if (l == 0 && bid == 0) { for (int i = otid(); i < D / 2; i += NT) ((unsigned*)(ws + WS_H1 + (size_t)M * D * 2))[i] = 0u; } } PHASE_END(true)
    }
    PHASE_BEGIN(0) phase_rowpass<1, 0, 2, false>(lds, nullptr, hn, nullptr, a.in[I_GFINAL], nullptr, nullptr, 0, nullptr, nullptr, nullptr, nullptr, a.out); PHASE_END(false)
}

extern "C" void kernel_launch(void* const* d_in, const int* in_sizes, int n_in, void* d_out, int out_size,
                              void* d_ws, size_t ws_size, hipStream_t stream) {
    static int grid = 0;
    if (grid == 0) {
        if (n_in != 29 || out_size != M * D || ws_size < WS_END) { fprintf(stderr, "kernel_launch: unexpected problem (n_in %d out %d ws %zu)\n", n_in, out_size, ws_size); grid = -1; return; }
        int dev = 0, cus = 0, per_cu = 0;
        (void)hipGetDevice(&dev);
        (void)hipDeviceGetAttribute(&cus, hipDeviceAttributeMultiprocessorCount, dev);
        (void)hipFuncSetAttribute((const void*)mk_fwd, hipFuncAttributeMaxDynamicSharedMemorySize, LDS_BYTES);
        (void)hipOccupancyMaxActiveBlocksPerMultiprocessor(&per_cu, (const void*)mk_fwd, NT, LDS_BYTES);
        if (per_cu < 1) { fprintf(stderr, "kernel_launch: occupancy query says %d blocks per CU\n", per_cu); per_cu = 1; }
        grid = cus;
    }
    if (grid < 0) return;
    Args a{};
    for (int i = 0; i < 29; ++i) a.in[i] = (const float*)d_in[i];
    a.out = (float*)d_out; a.ws = (unsigned char*)d_ws; a.ph_lo = 0; a.ph_hi = 1000;
    (void)hipMemsetAsync((unsigned char*)d_ws + WS_SMALL + SM_BAR, 0, 16 * 1024, stream);
    void* args[] = {&a};
    hipError_t e = hipLaunchCooperativeKernel((void*)mk_fwd, dim3(grid), dim3(NT), args, LDS_BYTES, stream);
    if (e != hipSuccess) fprintf(stderr, "cooperative launch failed: %s (grid %d)\n", hipGetErrorString(e), grid);
}
```

```cpp
#include <hip/hip_runtime.h>
#include <hip/hip_cooperative_groups.h>
#include <cstdio>
#include <cstdint>
namespace cg = cooperative_groups;

constexpr int NT = 512;
constexpr int D = 1024, NBATCH = 4, SEQ = 4096, M = NBATCH * SEQ;
constexpr int CH = 64, NC = SEQ / CH, NH = 4, DH = 128, DM = 512, DR = 512, NBR = 8, DBR = 64;
constexpr int DIN = 3080, ZW = 3072, DFF = 2816, NE = 8, DPLE = 256;
constexpr int PMAX = 2 * M + NE * 256, NTILE_MAX = PMAX / 256;
constexpr int EROWS = 129;
constexpr float EPS = 1e-6f;
constexpr int ZQ = 0, ZK = 512, ZV = 1024, ZO = 1536, ZXR = 2048, ZYR = 2560;

constexpr size_t MiB = 1u << 20;
constexpr size_t WS_SMALL = 0;
constexpr size_t WS_W_IN0 = 4 * MiB;
constexpr size_t WS_W_OUT0 = 10 * MiB;
constexpr size_t WS_W_FFGU = 12 * MiB;
constexpr size_t WS_W_FFD = 23 * MiB;
constexpr size_t WS_PB0 = WS_W_FFD + 5632 * 1024;
constexpr size_t WS_W_PP0 = WS_PB0 + 8 * MiB;
constexpr size_t WS_H1 = 4 * MiB;
constexpr size_t WS_W_IN1 = 37 * MiB;
constexpr size_t WS_W_OUT1 = 43 * MiB;
constexpr size_t WS_W_PG = 45 * MiB;
constexpr size_t WS_W_PP1 = 49 * MiB;
constexpr size_t WS_W_EGU = WS_W_PP1 + MiB / 2;
constexpr size_t WS_W_ED = WS_W_EGU + 88 * MiB;
constexpr size_t WS_HN8 = WS_W_EGU + 44 * MiB;
constexpr size_t WS_PB1 = WS_W_ED + 44 * MiB;
constexpr size_t WS_HN = WS_PB1 + 8 * MiB;
static_assert(WS_H1 + (size_t)(M + 1) * D * 2 <= WS_W_IN1 && WS_W_PP0 + 1024 * 256 * 2 <= WS_W_IN1, "map");
constexpr size_t WS_RF = 222 * MiB;
constexpr size_t WS_Z = WS_RF;
constexpr size_t WS_CT = WS_Z + 96 * MiB;
constexpr size_t WS_DN = WS_CT + 32 * MiB;
constexpr size_t WS_MIX = WS_CT + 72 * MiB;
constexpr size_t WS_HID = WS_RF;
constexpr size_t WS_PP0 = WS_RF + 130 * MiB;
constexpr size_t WS_SSQ = WS_RF + 201 * MiB;
constexpr size_t SSQ_STRIDE = (size_t)(M + 16) * 64;
constexpr size_t WS_SCAL = WS_RF + 204 * MiB;
constexpr size_t WS_END = 435 * MiB;
static_assert(WS_MIX + (size_t)M * D * 2 <= WS_SSQ && WS_HID + (size_t)PMAX * DFF * 2 <= WS_SSQ && WS_SSQ + 2 * SSQ_STRIDE <= WS_END, "map");
static_assert(WS_HN + (size_t)(M + 1) * D * 2 <= WS_RF, "map");
static_assert(WS_MIX + (size_t)M * D * 2 <= WS_END, "map");
static_assert(WS_HID + (size_t)PMAX * DFF * 2 <= WS_END, "map");
static_assert(WS_DN + 1024 * 128 * 4 <= WS_PP0 && WS_PP0 + (size_t)M * D * 2 <= WS_MIX && WS_HID + (size_t)M * DFF * 2 <= WS_PP0, "map");
constexpr size_t SM_GATES = 0;
constexpr size_t SM_TOKE = 512 * 1024;
constexpr size_t SM_TOKG = SM_TOKE + 128 * 1024;
constexpr size_t SM_ROWTOK = SM_TOKG + 128 * 1024;
constexpr size_t SM_ROWGATE = SM_ROWTOK + 160 * 1024;
constexpr size_t SM_TILEE = SM_ROWGATE + 160 * 1024;
constexpr size_t SM_ROWSLOT = SM_TILEE + 4 * 1024;
constexpr size_t SM_TOKP = SM_ROWSLOT + 160 * 1024;
constexpr size_t SM_BL = SM_TOKP + 16 * 1024;
constexpr size_t SM_AMAX = SM_BL + 4 * 1024;
constexpr size_t SM_MPREV = SM_AMAX + 4 * 1024;
constexpr size_t SM_RGA = 2 * MiB;
constexpr size_t SM_RGH = SM_RGA + 512 * 1024;
constexpr size_t SM_RGP = SM_RGH + 512 * 1024;
constexpr size_t SM_BAR = SM_RGP + 512 * 1024;
constexpr size_t SM_RGW = SM_BAR + 16 * 1024;
static_assert(SM_MPREV + 4096 <= SM_RGA && SM_RGW + 256 * 1024 <= 4 * MiB, "small map");

constexpr int LDS_BYTES = 147456;

typedef unsigned short bf16_t;
typedef float f32x4 __attribute__((ext_vector_type(4)));
typedef unsigned u32x4 __attribute__((ext_vector_type(4)));
typedef unsigned u32x2 __attribute__((ext_vector_type(2)));

__device__ __forceinline__ float bf2f(unsigned v) { return __uint_as_float(v << 16); }
__device__ __forceinline__ unsigned pk2(float lo, float hi);
__device__ __forceinline__ unsigned f2bf(float f) { return pk2(f, 0.f) & 0xffffu; }
typedef float f32x2_t __attribute__((ext_vector_type(2))); typedef __bf16 bf16x2_t __attribute__((ext_vector_type(2)));
__device__ __forceinline__ unsigned pk2(float lo, float hi) { f32x2_t v = {lo, hi}; bf16x2_t b = __builtin_convertvector(v, bf16x2_t); return __builtin_bit_cast(unsigned, b); }
__device__ __forceinline__ unsigned pk4_fp8(float a, float b, float c, float d) { int w = __builtin_amdgcn_cvt_pk_fp8_f32(a, b, 0, false); w = __builtin_amdgcn_cvt_pk_fp8_f32(c, d, w, true); return (unsigned)w; }
__device__ __forceinline__ float frcp(float x) { return __builtin_amdgcn_rcpf(x); }
__device__ __forceinline__ float sigmoidf_(float x) { return frcp(1.f + __expf(-x)); }
__device__ __forceinline__ float siluf_(float x) { return x * frcp(1.f + __expf(-x)); }
__device__ __forceinline__ float logsigmoidf_(float x) { return fminf(x, 0.f) - log1pf(__expf(-fabsf(x))); }
__device__ __forceinline__ float gelu_tanh(float y) { const float u2 = 1.5957691216057308f * (y + 0.044715f * y * y * y); return y * frcp(1.f + __expf(-u2)); }
__device__ __forceinline__ float wave_sum(float v) {
#pragma unroll
    for (int o = 1; o < 64; o <<= 1) v += __shfl_xor(v, o);
    return v;
}
__device__ __forceinline__ float wave_max(float v) {
#pragma unroll
    for (int o = 1; o < 64; o <<= 1) v = fmaxf(v, __shfl_xor(v, o));
    return v;
}

__device__ __forceinline__ float dpp_f(float v, const int ctrl_sel) {
    const int x = __float_as_int(v); int r;
    if (ctrl_sel == 0) r = __builtin_amdgcn_update_dpp(x, x, 0xB1, 0xF, 0xF, false);
    else if (ctrl_sel == 1) r = __builtin_amdgcn_update_dpp(x, x, 0x4E, 0xF, 0xF, false);
    else if (ctrl_sel == 2) r = __builtin_amdgcn_update_dpp(x, x, 0x141, 0xF, 0xF, false);
    else r = __builtin_amdgcn_update_dpp(x, x, 0x140, 0xF, 0xF, false);
    return __int_as_float(r);
}
__device__ __forceinline__ float sum4(float v) { v += dpp_f(v, 0); v += dpp_f(v, 1); return v; }
__device__ __forceinline__ float sum8(float v) { v = sum4(v); v += dpp_f(v, 2); return v; }
__device__ __forceinline__ float sum16(float v) { v = sum8(v); v += dpp_f(v, 3); return v; }
#define WAVE_LDS_SYNC() asm volatile("s_waitcnt lgkmcnt(0)" ::: "memory")
#define LDS_BARRIER() do { asm volatile("s_waitcnt lgkmcnt(0)" ::: "memory"); __builtin_amdgcn_s_barrier(); asm volatile("" ::: "memory"); } while (0)
__device__ __forceinline__ int otid() { int t = threadIdx.x; asm volatile("" : "+v"(t)); return t; }
__device__ __forceinline__ int oint(int v) { asm volatile("" : "+s"(v)); return v; }
__device__ __forceinline__ const void* okarg() { auto p = __builtin_amdgcn_kernarg_segment_ptr(); asm volatile("" : "+s"(p)); return (const void*)p; }

struct Args { const float* in[29]; float* out; unsigned char* ws; int ph_lo, ph_hi; };
enum { I_X = 0, I_P, I_GMIX, I_WIN, I_BIN, I_WCQK, I_BCQK, I_GMH, I_WCR, I_BCR, I_WRA, I_BRA, I_WRI, I_BRI, I_LAM, I_GR, I_WOUT, I_GFFN,
       I_WFG, I_WFU, I_WFD, I_WROUTER, I_WEG, I_WEU, I_WED, I_GPLE, I_WPG, I_WPP, I_GFINAL };


#define XB_TMO      128
#define XB_XCNT(j)  (256  + 64 * (j))
#define XB_XSUB(j)  (1280 + 64 * (j))
#define XB_XGEN(j)  (2304 + 64 * (j))
#define XB_TOP      3328
#define XB_TOPGEN   3392
#define XCD_BAR_WORDS 3456
#define XB_SPIN_CAP (1u << 18)
#define LAS __attribute__((address_space(3)))
__device__ __forceinline__ unsigned xb_ld(unsigned* p)              { return __hip_atomic_load(p, __ATOMIC_RELAXED, __HIP_MEMORY_SCOPE_AGENT); }
__device__ __forceinline__ unsigned xb_add(unsigned* p, unsigned v) { return __hip_atomic_fetch_add(p, v, __ATOMIC_RELAXED, __HIP_MEMORY_SCOPE_AGENT); }
__device__ __forceinline__ unsigned xb_xcc_id() { return (unsigned)__builtin_amdgcn_s_getreg((3 << 11) | 20) & 0xFu; }
#define XB_SPIN(cond, bar) do { unsigned _sp = 0; while (cond) { __builtin_amdgcn_s_sleep(1); \
    if ((++_sp & 255u) == 0u) { if (xb_ld(&(bar)[XB_TMO])) break; if (_sp > XB_SPIN_CAP) { atomicAdd(&(bar)[XB_TMO], 1u); break; } } } } while (0)
struct XcdBarrier { unsigned* bar; unsigned x; volatile LAS unsigned* st; };
__device__ __forceinline__ XcdBarrier xcd_barrier_post(unsigned* bar, volatile LAS unsigned* st) {
    XcdBarrier b; b.bar = bar; b.x = xb_xcc_id(); b.st = st;
    if (threadIdx.x == 0) (void)xb_add(&bar[XB_XCNT(b.x)], 1u);
    return b;
}
__device__ __forceinline__ void xcd_barrier_complete(unsigned* bar, unsigned x, unsigned& nloc, unsigned& nx) {
    const unsigned G = gridDim.x * gridDim.y * gridDim.z;
    unsigned sum, cnt, mine, sp = 0u;
    for (;;) {
        sum = 0u; cnt = 0u; mine = 0u;
#pragma unroll
        for (unsigned j = 0; j < 16; ++j) { const unsigned c = xb_ld(&bar[XB_XCNT(j)]); sum += c; cnt += (c > 0u) ? 1u : 0u; mine = (j == x) ? c : mine; }
        if (sum == G) break;
        __builtin_amdgcn_s_sleep(1);
        if ((++sp & 255u) == 0u) { if (xb_ld(&bar[XB_TMO])) break; if (sp > XB_SPIN_CAP) { atomicAdd(&bar[XB_TMO], 1u); break; } }
    }
    nloc = mine > 0u ? mine : 1u; nx = cnt > 0u ? cnt : 1u;
}
__device__ __forceinline__ void xcd_barrier(const XcdBarrier& b) {
    asm volatile("s_waitcnt vmcnt(0)" ::: "memory");
    __syncthreads();
    if (threadIdx.x == 0) {
        unsigned* bar = b.bar;
        __builtin_amdgcn_s_waitcnt(0);
        unsigned nloc = b.st[0], nx = b.st[1];
        if (nloc == 0u) { xcd_barrier_complete(bar, b.x, nloc, nx); b.st[0] = nloc; b.st[1] = nx; }
        const unsigned old = xb_add(&bar[XB_XSUB(b.x)], 1u);
        const unsigned gen = old / nloc;
        if (old + 1u == (gen + 1u) * nloc) {
            __builtin_amdgcn_fence(__ATOMIC_RELEASE, "agent");
            asm volatile("s_waitcnt vmcnt(0)" ::: "memory");
            const unsigned og = xb_add(&bar[XB_TOP], 1u);
            const unsigned tg = og / nx;
            if (og + 1u == (tg + 1u) * nx) xb_add(&bar[XB_TOPGEN], 1u);
            else XB_SPIN(xb_ld(&bar[XB_TOPGEN]) == tg, bar);
            __builtin_amdgcn_fence(__ATOMIC_ACQUIRE, "agent");
            xb_add(&bar[XB_XGEN(b.x)], 1u);
            asm volatile("s_waitcnt vmcnt(0)" ::: "memory");
        } else {
            XB_SPIN(xb_ld(&bar[XB_XGEN(b.x)]) == gen, bar);
            __builtin_amdgcn_fence(__ATOMIC_ACQUIRE, "agent");
            asm volatile("s_waitcnt vmcnt(0)" ::: "memory");
        }
    }
    __syncthreads();
}

struct CvtJob { const float* src; bf16_t* dst; int ld, k0, c0, K, n0; const float* gain; int fp8; };
__device__ __forceinline__ void cvt_plain_job(CvtJob& o, const float* src, int K, int N, bf16_t* dst, int tile, const float* gain) {
    const int nt = N / 64, kb = tile / nt, nb = tile % nt; o.src = src; o.dst = dst; o.ld = N; o.k0 = kb * 64; o.c0 = nb * 64; o.K = K; o.n0 = nb * 64; o.gain = gain; o.fp8 = 0;
}
__device__ __forceinline__ void cvt_gu_job(CvtJob& o, const float* g, const float* u, bf16_t* dst, int tile, const float* gain) {
    const int nt = 5632 / 64, kb = tile / nt, nb = tile % nt, n0 = nb * 64, tt = n0 >> 8, half = (n0 >> 7) & 1, w = n0 & 127;
    o.src = half ? u : g; o.dst = dst; o.ld = DFF; o.k0 = kb * 64; o.c0 = tt * 128 + w; o.K = 1024; o.n0 = n0; o.gain = gain; o.fp8 = 0;
}
__device__ __forceinline__ int cvt_tile2x2(int tile, int nt) { const int grp = tile >> 2, sub = tile & 3, gpr = nt >> 1; return ((grp / gpr) * 2 + (sub >> 1)) * nt + (grp % gpr) * 2 + (sub & 1); }
__device__ __forceinline__ void cvt_job(const Args& a, int it, CvtJob& o) {
    unsigned char* ws = a.ws;
    constexpr int T_IN = 16 * 48, T_OUT = 16 * 16, T_GU = 16 * 88, T_FD = 44 * 16, T_PG = 256, T_PP = 4 * 16;
    int r = it;
    if (r < 2 * T_IN) { const int l = r / T_IN, tile = r % T_IN; const int nt = ZW / 64, kb = tile / nt, nb = tile % nt, n0 = nb * 64;
        o.src = a.in[I_WIN] + (size_t)l * D * DIN; o.dst = (bf16_t*)(ws + (l ? WS_W_IN1 : WS_W_IN0)); o.ld = DIN; o.k0 = kb * 64; o.c0 = n0 < 2048 ? n0 : n0 + 8; o.K = D; o.n0 = n0; o.gain = a.in[I_GMIX] + l * D; o.fp8 = 0; return; }
    r -= 2 * T_IN;
    if (r < 2 * T_OUT) { const int l = r / T_OUT; cvt_plain_job(o, a.in[I_WOUT] + (size_t)l * D * D, D, D, (bf16_t*)(ws + (l ? WS_W_OUT1 : WS_W_OUT0)), r % T_OUT, nullptr); return; }
    r -= 2 * T_OUT;
    if (r < T_GU) { cvt_gu_job(o, a.in[I_WFG], a.in[I_WFU], (bf16_t*)(ws + WS_W_FFGU), r, a.in[I_GFFN]); return; }
    r -= T_GU;
    if (r < T_FD) { cvt_plain_job(o, a.in[I_WFD], DFF, D, (bf16_t*)(ws + WS_W_FFD), r, nullptr); return; }
    r -= T_FD;
    if (r < 2 * T_PG) { const int l = r / T_PG; cvt_plain_job(o, a.in[I_WPG] + (size_t)l * D * D, D, D, (bf16_t*)(ws + WS_W_PG) + (size_t)l * D * D, r % T_PG, a.in[I_GPLE] + l * D); return; }
    r -= 2 * T_PG;
    if (r < 2 * T_PP) { const int l = r / T_PP; cvt_plain_job(o, a.in[I_WPP] + (size_t)l * DPLE * D, DPLE, D, (bf16_t*)(ws + (l ? WS_W_PP1 : WS_W_PP0)), r % T_PP, nullptr); return; }
    r -= 2 * T_PP;
    if (r < 8 * T_GU) { const int e = r / T_GU; cvt_gu_job(o, a.in[I_WEG] + (size_t)e * D * DFF, a.in[I_WEU] + (size_t)e * D * DFF, (bf16_t*)(ws + WS_W_EGU + (size_t)e * 5632 * D), cvt_tile2x2(r % T_GU, 5632 / 64), nullptr); o.fp8 = 1; return; }
    r -= 8 * T_GU;
    { const int e = r / T_FD; cvt_plain_job(o, a.in[I_WED] + (size_t)e * DFF * D, DFF, D, (bf16_t*)(ws + WS_W_ED + (size_t)e * D * DFF), cvt_tile2x2(r % T_FD, D / 64), nullptr); o.fp8 = 1; }
}
__device__ __forceinline__ void phase_prologue(const Args& a, unsigned char* lds) {
    unsigned char* ws = a.ws;
    const int G = gridDim.x, t = otid();
    constexpr int T_IN = 16 * 48, T_OUT = 16 * 16, T_GU = 16 * 88, T_FD = 44 * 16, T_PG = 256, T_PP = 4 * 16;
    constexpr int NT_ALL = 2 * T_IN + 2 * T_OUT + T_GU + T_FD + 2 * T_PG + 2 * T_PP + 8 * T_GU + 8 * T_FD;
    constexpr int NB = 4;
    const int kk0 = t >> 4, cc = (t & 15) * 4, n = t >> 3, kg = t & 7;
    float4 v[NB][2], vn[NB][2];
    int it0 = blockIdx.x * NB;
    if (it0 < NT_ALL) {
#pragma unroll
        for (int b = 0; b < NB; ++b) { const int it = it0 + b < NT_ALL ? it0 + b : NT_ALL - 1; CvtJob jq; cvt_job(a, it, jq);
#pragma unroll
            for (int j = 0; j < 2; ++j) v[b][j] = *(const float4*)(jq.src + (size_t)(jq.k0 + kk0 + 32 * j) * jq.ld + jq.c0 + cc); }
    }
    for (; it0 < NT_ALL; it0 += G * NB) {
        const int itn = it0 + G * NB;
        if (itn < NT_ALL) {
#pragma unroll
            for (int b = 0; b < NB; ++b) { const int it = itn + b < NT_ALL ? itn + b : NT_ALL - 1; CvtJob jq; cvt_job(a, it, jq);
#pragma unroll
                for (int j = 0; j < 2; ++j) vn[b][j] = *(const float4*)(jq.src + (size_t)(jq.k0 + kk0 + 32 * j) * jq.ld + jq.c0 + cc); }
        }
#pragma unroll
        for (int b = 0; b < NB; ++b) { float* tl = (float*)lds + b * (64 * 65); const int it = it0 + b < NT_ALL ? it0 + b : NT_ALL - 1; CvtJob jq; cvt_job(a, it, jq);
#pragma unroll
            for (int j = 0; j < 2; ++j) { float4 w = v[b][j];
                if (jq.gain) { const float gk = jq.gain[jq.k0 + kk0 + 32 * j]; w.x *= gk; w.y *= gk; w.z *= gk; w.w *= gk; }
                float* p = tl + (kk0 + 32 * j) * 65 + cc; p[0] = w.x; p[1] = w.y; p[2] = w.z; p[3] = w.w; } }
        LDS_BARRIER();
#pragma unroll
        for (int b = 0; b < NB; ++b) { if (it0 + b >= NT_ALL) break; const float* s_ = (const float*)lds + b * (64 * 65) + (8 * kg) * 65 + n; CvtJob jq; cvt_job(a, it0 + b, jq);
            if (jq.fp8) { u32x2 o; o.x = pk4_fp8(32.f * s_[0], 32.f * s_[65], 32.f * s_[130], 32.f * s_[195]); o.y = pk4_fp8(32.f * s_[260], 32.f * s_[325], 32.f * s_[390], 32.f * s_[455]);
                *(u32x2*)((unsigned char*)jq.dst + (size_t)(jq.n0 + n) * jq.K + jq.k0 + 8 * kg) = o; }
            else { u32x4 o; o.x = pk2(s_[0], s_[65]); o.y = pk2(s_[130], s_[195]); o.z = pk2(s_[260], s_[325]); o.w = pk2(s_[390], s_[455]);
                *(u32x4*)(jq.dst + (size_t)(jq.n0 + n) * jq.K + jq.k0 + 8 * kg) = o; } }
        LDS_BARRIER();
#pragma unroll
        for (int b = 0; b < NB; ++b) { v[b][0] = vn[b][0]; v[b][1] = vn[b][1]; }
    }
    const size_t np4 = (size_t)M * DPLE / 4;
    for (size_t i = (size_t)blockIdx.x * NT + otid(); i < 2 * np4; i += (size_t)G * NT) {
        const float4 v = ((const float4*)a.in[I_P])[i]; u32x2 o; o.x = pk2(v.x, v.y); o.y = pk2(v.z, v.w);
        if (i < np4) ((u32x2*)(ws + WS_PB0))[i] = o; else ((u32x2*)(ws + WS_PB1))[i - np4] = o; }
    for (int i = blockIdx.x * NT + otid(); i < 2 * 8 * 2 * 64 * 64; i += G * NT) {
        const int d = i & 63, e = (i >> 6) & 63, g = (i >> 12) & 1, ln = i >> 13;
        ((bf16_t*)(ws + WS_SMALL + SM_RGW))[i] = (bf16_t)f2bf((g ? a.in[I_WRI] : a.in[I_WRA])[((size_t)ln * 64 + d) * 64 + e]);
    }
    if (blockIdx.x == 0) { for (int i = otid(); i < D / 4; i += NT) ((unsigned*)(ws + WS_HN8 + (size_t)M * D))[i] = 0u; for (int i = otid(); i < D / 2; i += NT) ((unsigned*)(ws + WS_HN + (size_t)M * D * 2))[i] = 0u; if (otid() < 32) ((float*)(ws + WS_SSQ + (otid() >> 4) * SSQ_STRIDE))[(size_t)M * 16 + (otid() & 15)] = 0.f; }
    for (int i = blockIdx.x * NT + otid(); i < PMAX; i += G * NT) { ((int*)(ws + WS_SMALL + SM_ROWTOK))[i] = M; ((float*)(ws + WS_SMALL + SM_ROWGATE))[i] = 0.f; }
}

template <int IN, bool ADDY> struct RawRow {
    f32x4 x[IN == 0 ? 4 : 1]; u32x2 h[IN == 1 ? 4 : 1]; u32x2 y[ADDY ? 4 : 1];
    __device__ __forceinline__ void load(const float* xin, const bf16_t* hb, const bf16_t* y1, int r, int lane) {
#pragma unroll
        for (int j = 0; j < 4; ++j) {
            if (IN == 0) x[j] = ((const f32x4*)(xin + (size_t)r * D) + lane)[64 * j]; else h[j] = ((const u32x2*)(hb + (size_t)r * D) + lane)[64 * j];
            if (ADDY) y[j] = ((const u32x2*)(y1 + (size_t)r * D) + lane)[64 * j]; }
    }
    __device__ __forceinline__ void copy_from(const RawRow& o) {
#pragma unroll
        for (int j = 0; j < 4; ++j) { if (IN == 0) x[j] = o.x[j]; else h[j] = o.h[j]; if (ADDY) y[j] = o.y[j]; }
    }
};
template <int IN, int AUX, int WR, bool ADDY>
__device__ __forceinline__ void phase_rowpass(unsigned char* lds, const float* xin, bf16_t* hb, const bf16_t* y1, const float* g, float* ssq,
                                              const float* auxW, int auxld, const float* auxB, float* gates, unsigned char* tok_p, float* tok_g, float* fout, unsigned char* h8 = nullptr) {
    float* wl = (float*)lds;
    const int tid = otid(), lane = tid & 63, wave = tid >> 6;
    if (AUX) {
        for (int i = tid; i < D * 8; i += NT) wl[i] = auxW[(size_t)(i >> 3) * auxld + (i & 7)];
        __syncthreads();
    }
    f32x4 gv[4];
    if (AUX || WR == 2) {
#pragma unroll
        for (int j = 0; j < 4; ++j) gv[j] = *(const f32x4*)(g + 4 * lane + 256 * j);
    }
    RawRow<1, ADDY> cur, nxt;
    const int rstep = gridDim.x * 8; int row = blockIdx.x * 8 + wave;
    if (IN == 1) { if (row < M) cur.load(xin, hb, y1, row, lane); nxt.copy_from(cur); }
    for (; row < M; row += rstep) {
        if (IN == 1) { if (row + rstep < M) nxt.load(xin, hb, y1, row + rstep, lane); }
        f32x4 v[4]; float ss = 0.f;
#pragma unroll
        for (int j = 0; j < 4; ++j) {
            if (IN == 0) v[j] = ((const f32x4*)(xin + (size_t)row * D) + lane)[64 * j];
            else { const u32x2 w = cur.h[j]; v[j] = (f32x4){bf2f(w.x & 0xffffu), __uint_as_float(w.x & 0xffff0000u), bf2f(w.y & 0xffffu), __uint_as_float(w.y & 0xffff0000u)}; }
            if (ADDY) { const u32x2 y = cur.y[j];
                v[j].x += bf2f(y.x & 0xffffu); v[j].y += __uint_as_float(y.x & 0xffff0000u); v[j].z += bf2f(y.y & 0xffffu); v[j].w += __uint_as_float(y.y & 0xffff0000u); }
            ss += (v[j].x * v[j].x + v[j].y * v[j].y) + (v[j].z * v[j].z + v[j].w * v[j].w); }
        if (IN == 1) cur.copy_from(nxt);
        float tot; { const int ri = __float_as_int(sum16(ss)); tot = (__int_as_float(__builtin_amdgcn_readlane(ri, 0)) + __int_as_float(__builtin_amdgcn_readlane(ri, 16))) + (__int_as_float(__builtin_amdgcn_readlane(ri, 32)) + __int_as_float(__builtin_amdgcn_readlane(ri, 48))); }
        const float rstd = __builtin_amdgcn_rsqf(tot * (1.f / D) + EPS);
        if (WR == 1) {
            u32x2* o = (u32x2*)(hb + (size_t)row * D) + lane;
#pragma unroll
            for (int j = 0; j < 4; ++j) { u32x2 w; w.x = pk2(v[j].x, v[j].y); w.y = pk2(v[j].z, v[j].w); o[64 * j] = w; }
            if (lane < 16) ssq[(size_t)row * 16 + lane] = lane == 0 ? tot : 0.f;
        }
        if (AUX || WR == 2) {
#pragma unroll
            for (int j = 0; j < 4; ++j) v[j] = v[j] * rstd * gv[j];
        }
        if (AUX == 2 && h8) {
#pragma unroll
            for (int j = 0; j < 4; ++j) ((unsigned*)(h8 + (size_t)row * D) + lane)[64 * j] = pk4_fp8(v[j].x, v[j].y, v[j].z, v[j].w);
        }
        if (WR == 2) {
            f32x4* o = (f32x4*)(fout + (size_t)row * D) + lane;
#pragma unroll
            for (int j = 0; j < 4; ++j) o[64 * j] = v[j];
        }
        if (AUX) {
            float acc[8];
#pragma unroll
            for (int c = 0; c < 8; ++c) acc[c] = 0.f;
#pragma unroll
            for (int j = 0; j < 4; ++j)
#pragma unroll
                for (int q = 0; q < 4; ++q) {
                    const int k = 4 * lane + 256 * j + q; const float xv = v[j][q];
                    const f32x4 w0 = *(const f32x4*)(wl + k * 8), w1 = *(const f32x4*)(wl + k * 8 + 4);
                    acc[0] += xv * w0.x; acc[1] += xv * w0.y; acc[2] += xv * w0.z; acc[3] += xv * w0.w;
                    acc[4] += xv * w1.x; acc[5] += xv * w1.y; acc[6] += xv * w1.z; acc[7] += xv * w1.w;
                }
#pragma unroll
            for (int c = 0; c < 8; ++c) { const float r16 = sum16(acc[c]); const int ri = __float_as_int(r16);
                acc[c] = (__int_as_float(__builtin_amdgcn_readlane(ri, 0)) + __int_as_float(__builtin_amdgcn_readlane(ri, 16))) + (__int_as_float(__builtin_amdgcn_readlane(ri, 32)) + __int_as_float(__builtin_amdgcn_readlane(ri, 48))); }
            if (AUX == 1) {
                if (lane < 8) { float s_ = acc[0];
#pragma unroll
                    for (int c = 1; c < 8; ++c) s_ = (lane == c) ? acc[c] : s_;
                    gates[(size_t)row * 8 + lane] = s_ + auxB[lane]; }
            } else {
                if (lane == 0) {
                    int e1 = 0; float v1 = acc[0];
#pragma unroll
                    for (int c = 1; c < 8; ++c) if (acc[c] > v1) { v1 = acc[c]; e1 = c; }
                    int e2 = -1; float v2 = -INFINITY;
#pragma unroll
                    for (int c = 0; c < 8; ++c) if (c != e1 && acc[c] > v2) { v2 = acc[c]; e2 = c; }
                    const float p2 = __expf(v2 - v1), inv = 1.f / (1.f + p2);
                    tok_p[row] = (unsigned char)(e1 | (e2 << 4)); tok_g[row * 2] = inv; tok_g[row * 2 + 1] = p2 * inv;
                }
            }
        }
    }
    __syncthreads();
}

struct Unit { int pm, pn; const int* rows; size_t bofs; };
struct GridOrder {
    static constexpr bool GATHER = false;
    int nM, nN, G, c;
    __device__ __forceinline__ bool next(int i, Unit& u) const {
        const int L0_ = i * G + c, nwg = nM * nN; if (L0_ >= nwg) return false;
        const int q_ = nwg / 8, r_ = nwg % 8, xcd = L0_ % 8, off = L0_ / 8; const int L = (xcd < r_ ? xcd * (q_ + 1) : r_ * (q_ + 1) + (xcd - r_) * q_) + off;
        const int grp = L / (8 * nN), fm = grp * 8, gsz = (nM - fm) < 8 ? (nM - fm) : 8, w = L % (8 * nN);
        u.pm = fm + w % gsz; u.pn = w / gsz; u.rows = nullptr; u.bofs = 0; return true;
    }
};
struct TailOrder {
    static constexpr bool GATHER = false;
    int nM, nN, G, c, first;
    __device__ __forceinline__ bool next(int i, Unit& u) const {
        if (c < first) return false; const int L = i * (G - first) + (c - first); if (L >= nM * nN) return false;
        u.pm = L / nN; u.pn = L % nN; u.rows = nullptr; u.bofs = 0; return true;
    }
};
template <bool GATHER_> struct MoeOrder {
    static constexpr bool GATHER = GATHER_;
    int nM, nN, G, c; const int* rows; size_t estride; int te[8];
    __device__ __forceinline__ void init(const int* tile_e) {
#pragma unroll
        for (int e = 0; e < 8; ++e) te[e] = __builtin_amdgcn_readfirstlane(tile_e[256 + e]);
    }
    __device__ __forceinline__ bool next(int i, Unit& u) const {
        const int L0_ = i * G + c, nwg = nM * nN; if (L0_ >= nwg) return false;
        const int q_ = nwg / 8, r_ = nwg % 8, xcd = L0_ % 8, off = L0_ / 8; const int L = (xcd < r_ ? xcd * (q_ + 1) : r_ * (q_ + 1) + (xcd - r_) * q_) + off;
        const int grp = L / (8 * nN), fm = grp * 8, gsz = (nM - fm) < 8 ? (nM - fm) : 8, w = L % (8 * nN);
        u.pm = fm + w % gsz; u.pn = w / gsz; u.rows = rows; int e = 0;
#pragma unroll
        for (int q = 0; q < 7; ++q) e += (u.pm >= te[q]) ? 1 : 0;
        u.bofs = (size_t)e * estride; return true;
    }
};


namespace pg8 {
#define PG8_LAS __attribute__((address_space(3)))
typedef short bf16x8 __attribute__((ext_vector_type(8)));
constexpr int BM = 256, BK = 64, HALF = 128, HTB = HALF * BK * 2, STAGE_BYTES = 8 * HTB;
__device__ __forceinline__ int lds_byte(int r, int c) { const int st = (r >> 4) * 2 + (c >> 5), rr = r & 15, cc = c & 31, ob = rr * 64 + cc * 2; return st * 1024 + (ob ^ (((ob >> 9) & 1) << 5)); }
__device__ __forceinline__ void stage_rc(int b, int& R, int& C) { const int st = b / 1024, sb = b % 1024, swz = sb ^ (((sb >> 9) & 1) << 5); R = (st >> 1) * 16 + swz / 64; C = (st & 1) * 32 + (swz % 64) / 2; }

typedef int i32x8 __attribute__((ext_vector_type(8))); typedef int i32x4 __attribute__((ext_vector_type(4)));
__device__ __forceinline__ i32x8 cat8(bf16x8 lo, bf16x8 hi) { return __builtin_shufflevector(__builtin_bit_cast(i32x4, lo), __builtin_bit_cast(i32x4, hi), 0, 1, 2, 3, 4, 5, 6, 7); }
__device__ __forceinline__ int perm32(int rho) { const int n = rho >> 4, i = rho & 15; return 8 * (i >> 2) + 4 * n + (i & 3); }
__device__ __forceinline__ void unit_voff(const Unit& u, const int (&R)[2], const int (&C)[2], int KB  , unsigned (&vo)[2][2]) {
#pragma unroll
    for (int h = 0; h < 2; ++h)
#pragma unroll
        for (int i = 0; i < 2; ++i) { int row = u.pm * BM + h * HALF + R[i]; if (u.rows) row = u.rows[row]; vo[h][i] = (unsigned)row * (unsigned)KB + (unsigned)C[i] * 2u; }
}

template <class Epi, class Sched, bool ALIGN_EPI, bool GATHER, bool FP8 = false>
__device__ __forceinline__ void gemm_phase(unsigned char* lds_, const bf16_t* A_, const bf16_t* Bt_, const int K_, const Sched& S, const Epi& E) {
    PG8_LAS unsigned char* lds = (PG8_LAS unsigned char*)lds_;
    const int K = oint(K_);
    const int tid = otid(), wid = __builtin_amdgcn_readfirstlane(tid >> 6), lane = tid & 63, wr = wid >> 2, wc = wid & 3, fr = lane & 15, fq = lane >> 4;
    const int KB = FP8 ? K : 2 * K;
    const int nt = KB / (BK * 2);
    int R[2], C[2]; unsigned voffA[2], voffB[2];
#pragma unroll
    for (int i = 0; i < 2; ++i) { stage_rc(tid * 16 + i * 8192, R[i], C[i]); voffA[i] = (unsigned)(R[i] * KB + C[i] * 2);
        const int Rb = Epi::PERM ? ((R[i] & ~31) + perm32(R[i] & 31)) : R[i]; voffB[i] = (unsigned)(Rb * KB + C[i] * 2); }
    const size_t kstep = (size_t)(BK * 2);
    const size_t hstep = (size_t)HALF * KB;
    const size_t tstep = 2 * hstep;
    const unsigned ldsw = (unsigned)wid * 1024u;
    const int pc0 = FP8 ? 32 * (fq >> 1) + 16 * (fq & 1) : fq * 8; constexpr int KOFF = FP8 ? 16 : 1024;
    const int aoff = lds_byte(wr * 64 + fr, pc0), boff = lds_byte(wc * 32 + fr, pc0);
#define PG8_SA(b, h) (((b) * 2 + (h)) * HTB)
#define PG8_SB(b, h) ((4 + (b) * 2 + (h)) * HTB)
#define PG8_STAGE(bufoff, gbase, voff) do { _Pragma("unroll") for (int _i = 0; _i < 2; ++_i) \
        __builtin_amdgcn_global_load_lds((const unsigned*)((const char*)(gbase) + (voff)[_i]), (PG8_LAS unsigned*)(lds + (bufoff) + ldsw + _i * 8192), 16, 0, 0); } while (0)
#define PG8_STAGE_A(bufoff, base, h, VO) do { if constexpr (GATHER) { PG8_STAGE(bufoff, base, (VO)[h]); } else { PG8_STAGE(bufoff, (base) + (h) * hstep, voffA); } } while (0)
#define PG8_LDA(dst, b, h) do { _Pragma("unroll") for (int m = 0; m < 4; ++m) _Pragma("unroll") for (int k = 0; k < 2; ++k) dst[m][k] = *(const PG8_LAS bf16x8*)(lds + PG8_SA(b, h) + aoff + m * 2048 + k * KOFF); } while (0)
#define PG8_LDB(dst, b, h) do { _Pragma("unroll") for (int n = 0; n < 2; ++n) _Pragma("unroll") for (int k = 0; k < 2; ++k) dst[n][k] = *(const PG8_LAS bf16x8*)(lds + PG8_SB(b, h) + boff + n * 2048 + k * KOFF); } while (0)
#define PG8_MMA(ai, bj, At, Bt) do { __builtin_amdgcn_s_setprio(1); _Pragma("unroll") for (int m = 0; m < 4; ++m) _Pragma("unroll") for (int n = 0; n < 2; ++n) { \
        if constexpr (FP8) { const i32x8 b8_ = cat8(Bt[n][0], Bt[n][1]), a8_ = cat8(At[m][0], At[m][1]); \
            asm volatile("v_mfma_scale_f32_16x16x128_f8f6f4 %0, %1, %2, %0, %3, %3 op_sel_hi:[0,0,0]" : "+v"(acc[ai][bj][m][n]) : "v"(b8_), "v"(a8_), "v"(scale1)); } \
        else { _Pragma("unroll") for (int k = 0; k < 2; ++k) acc[ai][bj][m][n] = __builtin_amdgcn_mfma_f32_16x16x32_bf16(Bt[n][k], At[m][k], acc[ai][bj][m][n], 0, 0, 0); } } __builtin_amdgcn_s_setprio(0); } while (0)
#define PG8_WAIT_V(n) asm volatile("s_waitcnt vmcnt(" #n ")" ::: "memory")
#define PG8_WAIT_L(n) asm volatile("s_waitcnt lgkmcnt(" #n ")" ::: "memory")
#define PG8_BAR __builtin_amdgcn_s_barrier()
#define PG8_SCHED __builtin_amdgcn_sched_barrier(0)
    const int scale1 = 0x7f7f7f7f;
    Unit cur, nxt; int ui = 0;
    if (!S.next(0, cur)) return;
    f32x4 acc[2][2][4][2];
#pragma unroll
    for (int a = 0; a < 2; ++a)
#pragma unroll
        for (int b = 0; b < 2; ++b)
#pragma unroll
            for (int m = 0; m < 4; ++m)
#pragma unroll
                for (int n = 0; n < 2; ++n) acc[a][b][m][n] = (f32x4){0.f, 0.f, 0.f, 0.f};
    bf16x8 At[4][2], B0[2][2], B1[2][2];
    unsigned vc[2][2], vn[2][2];
    if constexpr (GATHER) unit_voff(cur, R, C, KB, vc);
    const char* cA = GATHER ? (const char*)A_ : (const char*)A_ + (size_t)cur.pm * tstep;
    const char* cB = (const char*)Bt_ + cur.bofs * (FP8 ? 1 : 2) + (size_t)cur.pn * tstep;
    PG8_STAGE(PG8_SB(0, 0), cB, voffB); PG8_STAGE(PG8_SB(0, 1), cB + hstep, voffB); PG8_STAGE_A(PG8_SA(0, 0), cA, 0, vc); PG8_STAGE_A(PG8_SA(0, 1), cA, 1, vc);
    if (wr == 1) PG8_BAR;
    PG8_WAIT_V(2); PG8_BAR;
    PG8_STAGE(PG8_SB(1, 0), cB + kstep, voffB); PG8_STAGE_A(PG8_SA(1, 0), cA + kstep, 0, vc); PG8_STAGE(PG8_SB(1, 1), cB + hstep + kstep, voffB);
    PG8_WAIT_V(6); PG8_BAR;
    for (;;) {
        const bool has_next = S.next(ui + 1, nxt);
        const char* nA = cA; const char* nB = cB;
        if (has_next) { nB = (const char*)Bt_ + nxt.bofs * (FP8 ? 1 : 2) + (size_t)nxt.pn * tstep; if constexpr (!GATHER) nA = (const char*)A_ + (size_t)nxt.pm * tstep; }
        int rn[2][2];
        if constexpr (GATHER) {
#pragma unroll
            for (int h = 0; h < 2; ++h)
#pragma unroll
                for (int i = 0; i < 2; ++i) rn[h][i] = cur.rows[(has_next ? nxt.pm : cur.pm) * BM + h * HALF + R[i]]; }
        for (int t = 0; t < nt; t += 2) {
            const bool last = (t == nt - 2);
            if constexpr (GATHER) { if (last) {
#pragma unroll
                for (int h = 0; h < 2; ++h)
#pragma unroll
                    for (int i = 0; i < 2; ++i) { int r_ = rn[h][i]; asm volatile("" : "+v"(r_));
                        vn[h][i] = (unsigned)r_ * (unsigned)KB + (unsigned)C[i] * 2u; } } }
            const char* a1 = cA + (size_t)(t + 1) * kstep;
            const char* a2 = last ? nA : cA + (size_t)(t + 2) * kstep; const char* b2 = last ? nB : cB + (size_t)(t + 2) * kstep;
            const char* a3 = a2 + kstep; const char* b3 = b2 + kstep;
            unsigned v2[2][2];
            if constexpr (GATHER) {
#pragma unroll
                for (int h = 0; h < 2; ++h)
#pragma unroll
                    for (int i = 0; i < 2; ++i) v2[h][i] = last ? vn[h][i] : vc[h][i]; }
            PG8_LDB(B0, 0, 0); PG8_LDB(B1, 0, 1); PG8_SCHED; PG8_LDA(At, 0, 0); PG8_STAGE_A(PG8_SA(1, 1), a1, 1, vc);
            PG8_WAIT_V(8); PG8_WAIT_L(0); PG8_BAR; PG8_MMA(0, 0, At, B0); PG8_MMA(0, 1, At, B1); PG8_BAR; PG8_SCHED;
            PG8_LDA(At, 0, 1); PG8_STAGE(PG8_SB(0, 0), b2, voffB); PG8_STAGE(PG8_SB(0, 1), b2 + hstep, voffB); PG8_STAGE_A(PG8_SA(0, 0), a2, 0, v2);
            PG8_WAIT_V(8); PG8_WAIT_L(0); PG8_BAR; PG8_MMA(1, 0, At, B0); PG8_MMA(1, 1, At, B1); PG8_BAR; PG8_SCHED;
            PG8_LDB(B0, 1, 0); PG8_LDB(B1, 1, 1); PG8_SCHED; PG8_LDA(At, 1, 0); PG8_STAGE_A(PG8_SA(0, 1), a2, 1, v2);
            PG8_WAIT_V(8); PG8_WAIT_L(0); PG8_BAR; PG8_MMA(0, 0, At, B0); PG8_MMA(0, 1, At, B1); PG8_BAR; PG8_SCHED;
            PG8_LDA(At, 1, 1); PG8_STAGE(PG8_SB(1, 0), b3, voffB); PG8_STAGE(PG8_SB(1, 1), b3 + hstep, voffB); PG8_STAGE_A(PG8_SA(1, 0), a3, 0, v2);
            PG8_WAIT_V(8); PG8_WAIT_L(0); PG8_BAR; PG8_MMA(1, 0, At, B0); PG8_MMA(1, 1, At, B1); PG8_BAR; PG8_SCHED;
        }
        if constexpr (ALIGN_EPI) { if (wr == 0) PG8_BAR; }
        { int pm_ = cur.pm, pn_ = cur.pn, fr_ = fr, fq_ = fq;
          asm volatile("" : "+s"(pm_), "+s"(pn_), "+v"(fr_), "+v"(fq_));
          E(acc, pm_, pn_, wr, wc, fr_, fq_); }
        if (!has_next) break;
#pragma unroll
        for (int a = 0; a < 2; ++a)
#pragma unroll
            for (int b = 0; b < 2; ++b)
#pragma unroll
                for (int m = 0; m < 4; ++m)
#pragma unroll
                    for (int n = 0; n < 2; ++n) acc[a][b][m][n] = (f32x4){0.f, 0.f, 0.f, 0.f};
        cur = nxt; cA = nA; cB = nB; ++ui;
        if constexpr (GATHER) {
#pragma unroll
            for (int h = 0; h < 2; ++h)
#pragma unroll
                for (int i = 0; i < 2; ++i) vc[h][i] = vn[h][i]; }
        if constexpr (ALIGN_EPI) { if (wr == 1) PG8_BAR; }
    }
    PG8_WAIT_V(0);
    if constexpr (!ALIGN_EPI) { if (wr == 0) PG8_BAR; }
    PG8_BAR;
#undef PG8_SA
#undef PG8_SB
#undef PG8_STAGE
#undef PG8_STAGE_A
#undef PG8_LDA
#undef PG8_LDB
#undef PG8_MMA
#undef PG8_WAIT_V
#undef PG8_WAIT_L
#undef PG8_BAR
#undef PG8_SCHED
}
}
template <bool FP8 = false, class Epi, class Sched>
__device__ __forceinline__ void gemm_fast(unsigned char* lds, const bf16_t* A, const bf16_t* Bt, int K, const Sched& S, const Epi& E) {
    pg8::gemm_phase<Epi, Sched, true, Sched::GATHER, FP8>(lds, A, Bt, K, S, E);
    __syncthreads();
}

typedef f32x4 AccT[2][2][4][2];
#define EPI_ROW(ai, m) (pm * 256 + (ai) * 128 + wr * 64 + (m) * 16 + fr)
__device__ __forceinline__ void unpack8(const u32x4 w, f32x4& lo, f32x4& hi) {
    lo = (f32x4){bf2f(w.x & 0xffffu), __uint_as_float(w.x & 0xffff0000u), bf2f(w.y & 0xffffu), __uint_as_float(w.y & 0xffff0000u)};
    hi = (f32x4){bf2f(w.z & 0xffffu), __uint_as_float(w.z & 0xffff0000u), bf2f(w.w & 0xffffu), __uint_as_float(w.w & 0xffff0000u)};
}
__device__ __forceinline__ u32x4 pack8(const f32x4 v0, const f32x4 v1) { u32x4 w; w.x = pk2(v0.x, v0.y); w.y = pk2(v0.z, v0.w); w.z = pk2(v1.x, v1.y); w.w = pk2(v1.z, v1.w); return w; }
__device__ __forceinline__ float dot8(const f32x4 a, const f32x4 b) { return ((a.x * a.x + a.y * a.y) + (a.z * a.z + a.w * a.w)) + ((b.x * b.x + b.y * b.y) + (b.z * b.z + b.w * b.w)); }
__device__ __forceinline__ void epi_rstd(const float* ssq, const int* rowmap, int pm, int wr, int fr, int fq, float (&rs)[2][4]) {
    f32x4 p[2][4];
#pragma unroll
    for (int ai = 0; ai < 2; ++ai)
#pragma unroll
        for (int m = 0; m < 4; ++m) { int row = EPI_ROW(ai, m); if (rowmap) row = rowmap[row]; p[ai][m] = *(const f32x4*)((const char*)ssq + ((unsigned)row * 16u + 4u * (unsigned)fq) * 4u); }
#pragma unroll
    for (int ai = 0; ai < 2; ++ai)
#pragma unroll
        for (int m = 0; m < 4; ++m) { float t = (p[ai][m].x + p[ai][m].y) + (p[ai][m].z + p[ai][m].w); t += __shfl_xor(t, 16); t += __shfl_xor(t, 32); rs[ai][m] = __builtin_amdgcn_rsqf(t * (1.f / 1024.f) + EPS); }
}
__device__ __forceinline__ void epi_ssq(float* ssq, int row, int slot, float s_, int fq) { s_ += __shfl_xor(s_, 16); s_ += __shfl_xor(s_, 32); if (fq == 0) *(float*)((char*)ssq + ((unsigned)row * 16u + (unsigned)slot) * 4u) = s_; }

struct EpiZ { static constexpr bool PERM = true; bf16_t* z; const float* bin; const float* ssq;
    __device__ __forceinline__ void operator()(const AccT& acc, int pm, int pn, int wr, int wc, int fr, int fq) const {
        const int c0 = pn * 256 + wc * 32 + 8 * fq; f32x4 bv[2][2]; float rs[2][4];
#pragma unroll
        for (int bj = 0; bj < 2; ++bj)
#pragma unroll
            for (int n = 0; n < 2; ++n) { const int cc = c0 + bj * 128 + n * 4; bv[bj][n] = *(const f32x4*)(bin + (cc < 2048 ? cc : cc + 8)); }
        epi_rstd(ssq, nullptr, pm, wr, fr, fq, rs);
#pragma unroll
        for (int ai = 0; ai < 2; ++ai)
#pragma unroll
            for (int m = 0; m < 4; ++m) { bf16_t* rp = z + (size_t)EPI_ROW(ai, m) * ZW + c0; const float r = rs[ai][m];
#pragma unroll
                for (int bj = 0; bj < 2; ++bj) *(u32x4*)(rp + bj * 128) = pack8(acc[ai][bj][m][0] * r + bv[bj][0], acc[ai][bj][m][1] * r + bv[bj][1]); } } };
template <bool XB> struct EpiHres { static constexpr bool PERM = true; const float* xb; bf16_t* hb; float* ssq;
    __device__ __forceinline__ void operator()(const AccT& acc, int pm, int pn, int wr, int wc, int fr, int fq) const {
        const int c0 = pn * 256 + wc * 32 + 8 * fq;
#pragma unroll
        for (int ai = 0; ai < 2; ++ai) {
            f32x4 lx[4][2][2]; u32x4 lh[4][2];
#pragma unroll
            for (int m = 0; m < 4; ++m)
#pragma unroll
                for (int bj = 0; bj < 2; ++bj) { const size_t o = (size_t)EPI_ROW(ai, m) * D + c0 + bj * 128;
                    if (XB) { lx[m][bj][0] = *(const f32x4*)(xb + o); lx[m][bj][1] = *(const f32x4*)(xb + o + 4); } else lh[m][bj] = *(const u32x4*)(hb + o); }
#pragma unroll
            for (int m = 0; m < 4; ++m) { float s_ = 0.f; const int row = EPI_ROW(ai, m);
#pragma unroll
                for (int bj = 0; bj < 2; ++bj) { f32x4 b0, b1; if (XB) { b0 = lx[m][bj][0]; b1 = lx[m][bj][1]; } else unpack8(lh[m][bj], b0, b1);
                    const f32x4 v0 = b0 + acc[ai][bj][m][0], v1 = b1 + acc[ai][bj][m][1]; s_ += dot8(v0, v1);
                    *(u32x4*)(hb + (size_t)row * D + c0 + bj * 128) = pack8(v0, v1); }
                epi_ssq(ssq, row, pn * 4 + wc, s_, fq); }
        } } };
struct EpiSwiglu { static constexpr bool PERM = true; bf16_t* hid; const float* ssq; const int* rowmap;
    __device__ __forceinline__ void operator()(const AccT& acc, int pm, int pn, int wr, int wc, int fr, int fq) const {
        const int c0 = pn * 128 + wc * 32 + 8 * fq; float rs[2][4];
        epi_rstd(ssq, rowmap, pm, wr, fr, fq, rs);
#pragma unroll
        for (int ai = 0; ai < 2; ++ai)
#pragma unroll
            for (int m = 0; m < 4; ++m) { u32x4 w; const float r = rs[ai][m];
#pragma unroll
                for (int n = 0; n < 2; ++n) { const f32x4 g = acc[ai][0][m][n] * r, u = acc[ai][1][m][n] * r;
                    w[2 * n] = pk2(siluf_(g.x) * u.x, siluf_(g.y) * u.y); w[2 * n + 1] = pk2(siluf_(g.z) * u.z, siluf_(g.w) * u.w); }
                *(u32x4*)(hid + (size_t)EPI_ROW(ai, m) * DFF + c0) = w; } } };
struct EpiSwiglu8 { static constexpr bool PERM = true; unsigned char* hid8; float sc;
    __device__ __forceinline__ void operator()(const AccT& acc, int pm, int pn, int wr, int wc, int fr, int fq) const {
        const int c0 = pn * 128 + wc * 32 + 8 * fq;
#pragma unroll
        for (int ai = 0; ai < 2; ++ai)
#pragma unroll
            for (int m = 0; m < 4; ++m) { u32x2 w;
#pragma unroll
                for (int n = 0; n < 2; ++n) { const f32x4 g = acc[ai][0][m][n] * sc, u = acc[ai][1][m][n] * sc;
                    w[n] = pk4_fp8(siluf_(g.x) * u.x, siluf_(g.y) * u.y, siluf_(g.z) * u.z, siluf_(g.w) * u.w); }
                *(u32x2*)(hid8 + (size_t)EPI_ROW(ai, m) * DFF + c0) = w; } } };
struct EpiMoeDown { static constexpr bool PERM = true; bf16_t* hb; bf16_t* y1; const int* row_tok; const int* row_slot; const float* row_gate; float sc;
    __device__ __forceinline__ void operator()(const AccT& acc, int pm, int pn, int wr, int wc, int fr, int fq) const {
        const int c0 = pn * 256 + wc * 32 + 8 * fq;
        int tok[2][4], slot[2][4]; float gt[2][4];
#pragma unroll
        for (int ai = 0; ai < 2; ++ai)
#pragma unroll
            for (int m = 0; m < 4; ++m) { const int row = EPI_ROW(ai, m); tok[ai][m] = row_tok[row]; slot[ai][m] = row_slot[row]; gt[ai][m] = row_gate[row] * sc; }
#pragma unroll
        for (int ai = 0; ai < 2; ++ai) {
            u32x4 lh[4][2];
#pragma unroll
            for (int m = 0; m < 4; ++m) { const bool rmw = tok[ai][m] < M && slot[ai][m] == 0;
#pragma unroll
                for (int bj = 0; bj < 2; ++bj) lh[m][bj] = rmw ? *(const u32x4*)(hb + (size_t)tok[ai][m] * D + c0 + bj * 128) : (u32x4){0u, 0u, 0u, 0u}; }
#pragma unroll
            for (int m = 0; m < 4; ++m) { if (tok[ai][m] >= M) continue; const size_t o = (size_t)tok[ai][m] * D + c0; const float g = gt[ai][m];
                if (slot[ai][m] == 0) {
#pragma unroll
                    for (int bj = 0; bj < 2; ++bj) { f32x4 b0, b1; unpack8(lh[m][bj], b0, b1); *(u32x4*)(hb + o + bj * 128) = pack8(b0 + g * acc[ai][bj][m][0], b1 + g * acc[ai][bj][m][1]); }
                } else {
#pragma unroll
                    for (int bj = 0; bj < 2; ++bj) *(u32x4*)(y1 + o + bj * 128) = pack8(g * acc[ai][bj][m][0], g * acc[ai][bj][m][1]);
                } }
        } } };
struct EpiStoreBf16 { static constexpr bool PERM = true; bf16_t* out;
    __device__ __forceinline__ void operator()(const AccT& acc, int pm, int pn, int wr, int wc, int fr, int fq) const {
        const int c0 = pn * 256 + wc * 32 + 8 * fq;
#pragma unroll
        for (int ai = 0; ai < 2; ++ai)
#pragma unroll
            for (int m = 0; m < 4; ++m)
#pragma unroll
                for (int bj = 0; bj < 2; ++bj) *(u32x4*)(out + (size_t)EPI_ROW(ai, m) * D + c0 + bj * 128) = pack8(acc[ai][bj][m][0], acc[ai][bj][m][1]); } };
struct EpiPle { static constexpr bool PERM = true; const bf16_t* hin; bf16_t* hb; const bf16_t* pp; float* ssq; const float* ssq_in;
    __device__ __forceinline__ void operator()(const AccT& acc, int pm, int pn, int wr, int wc, int fr, int fq) const {
        const int c0 = pn * 256 + wc * 32 + 8 * fq; float rs[2][4];
        epi_rstd(ssq_in, nullptr, pm, wr, fr, fq, rs);
        u32x4 sg[2][4][2];
#pragma unroll
        for (int ai = 0; ai < 2; ++ai)
#pragma unroll
            for (int m = 0; m < 4; ++m)
#pragma unroll
                for (int bj = 0; bj < 2; ++bj) { f32x4 a0 = acc[ai][bj][m][0] * rs[ai][m], a1 = acc[ai][bj][m][1] * rs[ai][m];
#pragma unroll
                    for (int q = 0; q < 4; ++q) { a0[q] = sigmoidf_(a0[q]); a1[q] = sigmoidf_(a1[q]); }
                    sg[ai][m][bj] = pack8(a0, a1); }
        asm volatile("" ::: "memory");
#pragma unroll
        for (int ai = 0; ai < 2; ++ai) {
            u32x4 lh[4][2], lp[4][2];
#pragma unroll
            for (int m = 0; m < 4; ++m)
#pragma unroll
                for (int bj = 0; bj < 2; ++bj) { const unsigned ob = ((unsigned)EPI_ROW(ai, m) * D + c0 + bj * 128) * 2u;
                    lh[m][bj] = *(const u32x4*)((const char*)hin + ob); lp[m][bj] = *(const u32x4*)((const char*)pp + ob); }
#pragma unroll
            for (int m = 0; m < 4; ++m) { float s_ = 0.f; const int row = EPI_ROW(ai, m);
#pragma unroll
                for (int bj = 0; bj < 2; ++bj) { f32x4 h0, h1, p0, p1, g0, g1; unpack8(lh[m][bj], h0, h1); unpack8(lp[m][bj], p0, p1); unpack8(sg[ai][m][bj], g0, g1);
                    h0 += g0 * p0; h1 += g1 * p1; s_ += dot8(h0, h1);
                    *(u32x4*)((char*)hb + ((unsigned)row * D + c0 + bj * 128) * 2u) = pack8(h0, h1); }
                epi_ssq(ssq, row, pn * 4 + wc, s_, fq); }
        } } };

__device__ __forceinline__ float conv4(const bf16_t* zc, int row, int s, const float* w  , int wstride, float b) {
    float acc = b;
#pragma unroll
    for (int j = 0; j < 4; ++j) { const int ds = 3 - j; if (s - ds >= 0) acc += w[j * wstride] * bf2f(zc[(ptrdiff_t)(row - ds) * ZW]); }
    return acc;
}
__device__ __forceinline__ void chunk_gates(float* sc, const float* gates, int row0, int h, int lane) {
    const float ip = gates[(size_t)(row0 + lane) * 8 + h], fp = gates[(size_t)(row0 + lane) * 8 + 4 + h];
    float b = logsigmoidf_(fp);
#pragma unroll
    for (int o = 1; o < 64; o <<= 1) { const float n = __shfl_up(b, o); if (lane >= o) b += n; }
    sc[lane] = b; sc[64 + lane] = ip;
}
__device__ __forceinline__ void chunk_gates_r(float* sc, float ip, float fp, int lane) {
    float b = logsigmoidf_(fp);
#pragma unroll
    for (int o = 1; o < 64; o <<= 1) { const float n = __shfl_up(b, o); if (lane >= o) b += n; }
    sc[lane] = b; sc[64 + lane] = ip;
}
__device__ __forceinline__ void mlstm_local(const Args& a, unsigned char* lds, int l, int item) {
    const int b = item >> 8, c = (item >> 2) & 63, h = item & 3, row0 = b * SEQ + c * CH, tid = otid(), lane = tid & 63;
    float* Kt = (float*)lds;
    float* Vt = Kt + 64 * 128;
    float* sc = Vt + 64 * 128;
    const bf16_t* z = (const bf16_t*)(a.ws + WS_Z);
    const float* gates = (const float*)(a.ws + WS_SMALL + SM_GATES);
    if (tid < 64) {
        chunk_gates(sc, gates, row0, h, lane);
        const float bl = __shfl(sc[lane], 63), al = bl - sc[lane] + sc[64 + lane];
        const float amax = wave_max(al);
        sc[128 + lane] = __expf(al - amax);
        if (lane == 0) { ((float*)(a.ws + WS_SMALL + SM_BL))[item] = bl; ((float*)(a.ws + WS_SMALL + SM_AMAX))[item] = amax; }
    }
    const float* wc = a.in[I_WCQK] + (size_t)l * 4 * 1024; const float* bc = a.in[I_BCQK] + (size_t)l * 1024;
    for (int i = tid; i < 64 * 128; i += NT) {
        const int ll = i >> 7, d = i & 127, ch = ZK + h * DH + d;
        Kt[i] = siluf_(conv4(z + ch, row0 + ll, c * CH + ll, wc + ch, 1024, bc[ch]));
        Vt[i] = bf2f(z[(size_t)(row0 + ll) * ZW + ZV + h * DH + d]);
    }
    __syncthreads();
    const int d = tid & 127, eg = tid >> 7;
    float acc[33];
#pragma unroll
    for (int i = 0; i < 33; ++i) acc[i] = 0.f;
    for (int ll = 0; ll < 64; ++ll) {
        const float kd = Kt[ll * 128 + d] * sc[128 + ll];
#pragma unroll
        for (int i = 0; i < 32; ++i) acc[i] += Vt[ll * 128 + eg + 4 * i] * kd;
        acc[32] += kd;
    }
    float* ct = (float*)(a.ws + WS_CT) + (size_t)item * EROWS * 128;
#pragma unroll
    for (int i = 0; i < 32; ++i) ct[(eg + 4 * i) * 128 + d] = acc[i];
    if (eg == 0) ct[128 * 128 + d] = acc[32];
    __syncthreads();
}
__device__ __forceinline__ void mlstm_scan(const Args& a, int G) {
    const float* BL = (const float*)(a.ws + WS_SMALL + SM_BL); const float* AM = (const float*)(a.ws + WS_SMALL + SM_AMAX);
    float* MP = (float*)(a.ws + WS_SMALL + SM_MPREV);
    const int tid = otid();
    for (int w = blockIdx.x; w < 16 * 16; w += G) {
        const int bh = w >> 4, sl = w & 15, b = bh >> 2, h = bh & 3;
        unsigned* p = (unsigned*)(a.ws + WS_CT) + (size_t)((b * NC) * NH + h) * 8192 + sl * 512 + tid;
        const bool dn = (sl == 1 && tid < 128);
        float* q = (float*)(a.ws + WS_DN) + (size_t)((b * NC) * NH + h) * 128 + (dn ? tid : 0);
        float s0 = 0.f, s1 = 0.f, sn = 0.f, m = 0.f;
        unsigned x[16], xn[16]; float y[16], yn[16];
#pragma unroll
        for (int j = 0; j < 16; ++j) { x[j] = p[(size_t)j * (NH * 8192)]; y[j] = q[(size_t)j * (NH * 128)]; }
#pragma unroll 1
        for (int c0 = 0; c0 < NC; c0 += 16) {
            const int cn = (c0 + 16 < NC) ? c0 + 16 : c0;
#pragma unroll
            for (int j = 0; j < 16; ++j) { xn[j] = p[(size_t)(cn + j) * (NH * 8192)]; yn[j] = q[(size_t)(cn + j) * (NH * 128)]; }
#pragma unroll
            for (int j = 0; j < 16; ++j) {
                const int item = (b * NC + c0 + j) * NH + h;
                const float bl = BL[item], am = AM[item];
                const float mn = fmaxf(bl + m, am), dec = __expf(bl + m - mn), scl = __expf(am - mn);
                p[(size_t)(c0 + j) * (NH * 8192)] = pk2(s0, s1);
                if (dn) q[(size_t)(c0 + j) * (NH * 128)] = sn;
                if (sl == 0 && tid == 0) MP[item] = m;
                s0 = dec * s0 + scl * bf2f(x[j] & 0xffffu); s1 = dec * s1 + scl * __uint_as_float(x[j] & 0xffff0000u); sn = dec * sn + scl * y[j]; m = mn;
            }
#pragma unroll
            for (int j = 0; j < 16; ++j) { x[j] = xn[j]; y[j] = yn[j]; }
        }
    }
}
__device__ __forceinline__ void mlstm_out(const Args& a, unsigned char* lds, int l, int item) {
    const int b = item >> 8, c = (item >> 2) & 63, h = item & 3, row0 = b * SEQ + c * CH, tid = otid(), lane = tid & 63, wave = tid >> 6;
    float* Q = (float*)lds;
    float* Kt = Q + 64 * 128;
    float* Vt = Kt + 64 * 128;
    float* Sm = Vt + 64 * 128;
    float* sc = Sm + 64 * 64;
    const bf16_t* z = (const bf16_t*)(a.ws + WS_Z);
    const float* gates = (const float*)(a.ws + WS_SMALL + SM_GATES);
    const float mprev = ((const float*)(a.ws + WS_SMALL + SM_MPREV))[item];
    if (tid < 64) {
        chunk_gates(sc, gates, row0, h, lane);
        float g = sc[64 + lane] - sc[lane];
#pragma unroll
        for (int o = 1; o < 64; o <<= 1) { const float n = __shfl_up(g, o); if (lane >= o) g = fmaxf(g, n); }
        const float mrow = sc[lane] + fmaxf(mprev, g);
        sc[128 + lane] = mrow; sc[192 + lane] = __expf(sc[lane] + mprev - mrow);
    }
    const float* wc = a.in[I_WCQK] + (size_t)l * 4 * 1024; const float* bc = a.in[I_BCQK] + (size_t)l * 1024;
    for (int i = tid; i < 64 * 128; i += NT) {
        const int ll = i >> 7, d = i & 127, chq = ZQ + h * DH + d, chk = ZK + h * DH + d;
        Q[i] = siluf_(conv4(z + chq, row0 + ll, c * CH + ll, wc + chq, 1024, bc[chq])) * 0.08838834764831845f;
        Kt[i] = siluf_(conv4(z + chk, row0 + ll, c * CH + ll, wc + chk, 1024, bc[chk]));
        Vt[i] = bf2f(z[(size_t)(row0 + ll) * ZW + ZV + h * DH + d]);
    }
    __syncthreads();
    for (int i = tid; i < 64 * 64; i += NT) {
        const int ll = i >> 6, mm = i & 63; float s = 0.f;
        if (mm <= ll) {
            for (int d = 0; d < 128; ++d) s += Q[ll * 128 + d] * Kt[mm * 128 + d];
            s *= __expf(sc[ll] - sc[mm] + sc[64 + mm] - sc[128 + ll]);
        }
        Sm[i] = s;
    }
    __syncthreads();
    const float* ct = (const float*)(a.ws + WS_CT) + (size_t)item * EROWS * 128;
    if (tid < 64) {
        float di = 0.f, dn = 0.f;
        for (int mm = 0; mm < 64; ++mm) di += Sm[tid * 64 + mm];
        for (int d = 0; d < 128; ++d) dn += Q[tid * 128 + d] * ct[128 * 128 + d];
        const float den = di + sc[192 + tid] * dn;
        sc[256 + tid] = fmaxf(fabsf(den), __expf(-sc[128 + tid]));
    }
    const int e = tid & 127, lg = tid >> 7;
    float acc[16], acc2[16];
#pragma unroll
    for (int i = 0; i < 16; ++i) { acc[i] = 0.f; acc2[i] = 0.f; }
    for (int mm = 0; mm < 64; ++mm) { const float vv = Vt[mm * 128 + e];
#pragma unroll
        for (int i = 0; i < 16; ++i) acc[i] += Sm[(lg * 16 + i) * 64 + mm] * vv; }
    for (int d = 0; d < 128; ++d) { const float cv = ct[e * 128 + d];
#pragma unroll
        for (int i = 0; i < 16; ++i) acc2[i] += Q[(lg * 16 + i) * 128 + d] * cv; }
    __syncthreads();
#pragma unroll
    for (int i = 0; i < 16; ++i) { const int ll = lg * 16 + i;
        const float hv = (acc[i] + sc[192 + ll] * acc2[i]) / sc[256 + ll];
        const float o = sigmoidf_(bf2f(z[(size_t)(row0 + ll) * ZW + ZO + h * DH + e]));
        Kt[ll * 128 + e] = hv * o; }
    __syncthreads();
    const float* gm = a.in[I_GMH] + (size_t)l * DM + h * DH;
    bf16_t* mix = (bf16_t*)(a.ws + WS_MIX);
    for (int ll = wave * 8; ll < wave * 8 + 8; ++ll) {
        const float x0 = Kt[ll * 128 + 2 * lane], x1 = Kt[ll * 128 + 2 * lane + 1];
        const float rs = rsqrtf(wave_sum(x0 * x0 + x1 * x1) * (1.f / 128.f) + EPS);
        *(unsigned*)(mix + (size_t)(row0 + ll) * D + h * DH + 2 * lane) = pk2(x0 * rs * gm[2 * lane], x1 * rs * gm[2 * lane + 1]);
    }
    __syncthreads();
}


typedef short bf16x8 __attribute__((ext_vector_type(8)));
__device__ __forceinline__ f32x4 mfma16(bf16x8 a, bf16x8 b, f32x4 c) { return __builtin_amdgcn_mfma_f32_16x16x32_bf16(a, b, c, 0, 0, 0); }

template <int IN, int AUX>
__device__ __forceinline__ void phase_rowpass_mm(unsigned char* lds, const float* xin, bf16_t* hb, const float* g, float* ssq, const float* auxW, int auxld, const float* auxB,
                                                 float* gates, unsigned char* tok_p, float* tok_g, unsigned char* h8) {
    constexpr int WLD = 1032;
    bf16_t* wl = (bf16_t*)lds; float* gl = (float*)(lds + 8 * WLD * 2);
    const int tid = otid(), lane = tid & 63, wave = tid >> 6;
    for (int i = tid; i < D * 8; i += NT) { const int k = i >> 3, c = i & 7; wl[c * WLD + k] = (bf16_t)f2bf(g[k] * auxW[(size_t)k * auxld + c]); }
    if (AUX == 2) for (int i = tid; i < D; i += NT) gl[i] = g[i];
    __syncthreads();
    const int n = lane & 15, kq = lane >> 4;
    const bf16_t* wrow = wl + (n & 7) * WLD + 8 * kq;
    if (wave < 4) for (int task = blockIdx.x + gridDim.x * wave; task < M / 16; task += gridDim.x * 4) {
        const int row = task * 16 + n;
        f32x4 accL = {0.f, 0.f, 0.f, 0.f}, accS = {0.f, 0.f, 0.f, 0.f};
        u32x4 xr[32];
        if (IN == 1) {
            const u32x4* src = (const u32x4*)(hb + (size_t)row * D + 8 * kq);
#pragma unroll
            for (int s = 0; s < 32; ++s) xr[s] = src[4 * s];
            asm volatile("" ::: "memory");
#pragma unroll
            for (int s = 0; s < 32; ++s) { const bf16x8 xf = __builtin_bit_cast(bf16x8, xr[s]); const bf16x8 wf = *(const bf16x8*)(wrow + 32 * s);
                accL = mfma16(wf, xf, accL); accS = mfma16(xf, xf, accS); }
        } else {
            const f32x4* src = (const f32x4*)(xin + (size_t)row * D + 8 * kq); u32x4* dst = (u32x4*)(hb + (size_t)row * D + 8 * kq);
#pragma unroll
            for (int hf = 0; hf < 2; ++hf) { f32x4 xf32[32]; asm volatile("" ::: "memory");
#pragma unroll
                for (int s = 0; s < 16; ++s) { xf32[2 * s] = src[8 * (16 * hf + s)]; xf32[2 * s + 1] = src[8 * (16 * hf + s) + 1]; }
                asm volatile("" ::: "memory");
#pragma unroll
                for (int s = 0; s < 16; ++s) { const f32x4 a_ = xf32[2 * s], b_ = xf32[2 * s + 1];
                    u32x4 p; p.x = pk2(a_.x, a_.y); p.y = pk2(a_.z, a_.w); p.z = pk2(b_.x, b_.y); p.w = pk2(b_.z, b_.w); dst[4 * (16 * hf + s)] = p;
                    const bf16x8 xf = __builtin_bit_cast(bf16x8, p); const bf16x8 wf = *(const bf16x8*)(wrow + 32 * (16 * hf + s));
                    accL = mfma16(wf, xf, accL); accS = mfma16(xf, xf, accS); } }
        }
        float dv = accS[0]; dv = (n & 3) == 1 ? accS[1] : dv; dv = (n & 3) == 2 ? accS[2] : dv; dv = (n & 3) == 3 ? accS[3] : dv;
        const float tot = __shfl(dv, n + 16 * (n >> 2));
        const float rstd = __builtin_amdgcn_rsqf(tot * (1.f / D) + EPS);
        if (IN == 0) { f32x4 o = {kq == 0 ? tot : 0.f, 0.f, 0.f, 0.f}; *(f32x4*)(ssq + (size_t)row * 16 + 4 * kq) = o; }
        if (AUX == 1) {
            if (kq < 2) { const f32x4 b_ = *(const f32x4*)(auxB + 4 * kq); *(f32x4*)(gates + (size_t)row * 8 + 4 * kq) = accL * rstd + b_; }
        } else {
            const f32x4 lg = accL * rstd;
            float o4[4];
#pragma unroll
            for (int r = 0; r < 4; ++r) o4[r] = __shfl(lg[r], lane + 16);
            if (kq == 0) {
                float acc[8] = {lg[0], lg[1], lg[2], lg[3], o4[0], o4[1], o4[2], o4[3]};
                int e1 = 0; float v1 = acc[0];
#pragma unroll
                for (int c = 1; c < 8; ++c) if (acc[c] > v1) { v1 = acc[c]; e1 = c; }
                int e2 = -1; float v2 = -INFINITY;
#pragma unroll
                for (int c = 0; c < 8; ++c) if (c != e1 && acc[c] > v2) { v2 = acc[c]; e2 = c; }
                const float p2 = __expf(v2 - v1), inv = 1.f / (1.f + p2);
                tok_p[row] = (unsigned char)(e1 | (e2 << 4)); tok_g[row * 2] = inv; tok_g[row * 2 + 1] = p2 * inv;
            }
            if (h8) {
                u32x2* dst = (u32x2*)(h8 + (size_t)row * D + 8 * kq);
#pragma unroll
                for (int s = 0; s < 32; ++s) { if ((s & 3) == 0) asm volatile("" ::: "memory"); const u32x4 w = xr[s]; const f32x4 g0 = *(const f32x4*)(gl + 32 * s + 8 * kq), g1 = *(const f32x4*)(gl + 32 * s + 8 * kq + 4);
                    u32x2 o; o.x = pk4_fp8(bf2f(w.x & 0xffffu) * rstd * g0.x, __uint_as_float(w.x & 0xffff0000u) * rstd * g0.y, bf2f(w.y & 0xffffu) * rstd * g0.z, __uint_as_float(w.y & 0xffff0000u) * rstd * g0.w);
                    o.y = pk4_fp8(bf2f(w.z & 0xffffu) * rstd * g1.x, __uint_as_float(w.z & 0xffff0000u) * rstd * g1.y, bf2f(w.w & 0xffffu) * rstd * g1.z, __uint_as_float(w.w & 0xffff0000u) * rstd * g1.w);
                    dst[4 * s] = o; }
            }
        }
    }
    __syncthreads();
}

__device__ __forceinline__ void conv_load11(const bf16_t* zc, int row0, int l0, bool first_chunk, unsigned (&x)[11]) {
#pragma unroll
    for (int j = 0; j < 11; ++j) { const int ll = l0 - 3 + j; x[j] = (first_chunk && ll < 0) ? 0u : *(const unsigned*)(zc + (ptrdiff_t)(row0 + ll) * ZW); }
}
struct ConvW { float w[4][2]; float b[2]; };
__device__ __forceinline__ void conv_loadw(const float* wc, const float* bc, int col, ConvW& cw) {
#pragma unroll
    for (int j = 0; j < 4; ++j) { cw.w[j][0] = wc[j * 1024 + col]; cw.w[j][1] = wc[j * 1024 + col + 1]; }
    cw.b[0] = bc[col]; cw.b[1] = bc[col + 1];
}
__device__ __forceinline__ void conv_apply(const unsigned (&x)[11], const ConvW& cw, float (&out)[8][2]) {
#pragma unroll
    for (int i = 0; i < 8; ++i) { float a0 = cw.b[0], a1 = cw.b[1];
#pragma unroll
        for (int j = 0; j < 4; ++j) { a0 += cw.w[j][0] * bf2f(x[i + j] & 0xffffu); a1 += cw.w[j][1] * __uint_as_float(x[i + j] & 0xffff0000u); }
        out[i][0] = a0; out[i][1] = a1; }
}
struct MlRegs { unsigned xk[11], v[8]; ConvW cw; float gi, gf; };
__device__ __forceinline__ void ml_load(const Args& a, int l, int item, MlRegs& R) {
    const int b = item >> 8, c = (item >> 2) & 63, h = item & 3, row0 = b * SEQ + c * CH, tid = otid(), lane = tid & 63, wave = tid >> 6;
    const bf16_t* z = (const bf16_t*)(a.ws + WS_Z);
    const float* gates = (const float*)(a.ws + WS_SMALL + SM_GATES);
    const int cp = lane, lg = wave, colk = ZK + h * DH + 2 * cp, colv = ZV + h * DH + 2 * cp;
    conv_load11(z + colk, row0, 8 * lg, c == 0, R.xk);
#pragma unroll
    for (int i = 0; i < 8; ++i) R.v[i] = *(const unsigned*)(z + (size_t)(row0 + 8 * lg + i) * ZW + colv);
    conv_loadw(a.in[I_WCQK] + (size_t)l * 4 * 1024, a.in[I_BCQK] + (size_t)l * 1024, colk, R.cw);
    R.gi = gates[(size_t)(row0 + lane) * 8 + h]; R.gf = gates[(size_t)(row0 + lane) * 8 + 4 + h];
}
__device__ __forceinline__ void ml_compute(const Args& a, unsigned char* lds, int l, int item, MlRegs& R) {
    const int tid = otid(), lane = tid & 63, wave = tid >> 6, fr = lane & 15, fq = lane >> 4;
    unsigned char* KT = lds; unsigned char* VT = lds + 18432; float* RED = (float*)(lds + 36864); float* sc = (float*)(lds + 40960);
    const int cp = lane, lg = wave;
    unsigned (&xk)[11] = R.xk; unsigned (&v)[8] = R.v; ConvW& cw = R.cw;
    if (tid < 64) {
        chunk_gates_r(sc, R.gi, R.gf, lane);
        {
            float g = sc[64 + lane] - sc[lane];
#pragma unroll
            for (int o = 1; o < 64; o <<= 1) { const float n = __shfl_up(g, o); if (lane >= o) g = fmaxf(g, n); }
            float* scal = (float*)(a.ws + WS_SCAL) + (size_t)item * 128; scal[lane] = sc[lane]; scal[64 + lane] = g; }
        const float bl = __shfl(sc[lane], 63), al = bl - sc[lane] + sc[64 + lane];
        const float amax = wave_max(al);
        sc[128 + lane] = __expf(al - amax);
        if (lane == 0) { ((float*)(a.ws + WS_SMALL + SM_BL))[item] = bl; ((float*)(a.ws + WS_SMALL + SM_AMAX))[item] = amax; }
    }
    LDS_BARRIER();
    {
        float kk[8][2];
        conv_apply(xk, cw, kk);
        float n0 = 0.f, n1 = 0.f;
#pragma unroll
        for (int i = 0; i < 8; ++i) { const float wl = sc[128 + 8 * lg + i]; kk[i][0] = siluf_(kk[i][0]) * wl; kk[i][1] = siluf_(kk[i][1]) * wl; n0 += kk[i][0]; n1 += kk[i][1]; }
        u32x4 p0, p1;
#pragma unroll
        for (int i = 0; i < 4; ++i) { p0[i] = pk2(kk[2 * i][0], kk[2 * i + 1][0]); p1[i] = pk2(kk[2 * i][1], kk[2 * i + 1][1]); }
        *(u32x4*)(KT + (2 * cp) * 144 + lg * 16) = p0; *(u32x4*)(KT + (2 * cp + 1) * 144 + lg * 16) = p1;
        RED[lg * 128 + 2 * cp] = n0; RED[lg * 128 + 2 * cp + 1] = n1;
#pragma unroll
        for (int i = 0; i < 4; ++i) { p0[i] = (v[2 * i] & 0xffffu) | (v[2 * i + 1] << 16); p1[i] = (v[2 * i] >> 16) | (v[2 * i + 1] & 0xffff0000u); }
        *(u32x4*)(VT + (2 * cp) * 144 + lg * 16) = p0; *(u32x4*)(VT + (2 * cp + 1) * 144 + lg * 16) = p1;
    }
    LDS_BARRIER();
    bf16_t* ct = (bf16_t*)(a.ws + WS_CT) + (size_t)item * 128 * 128;
    {
        const int et0 = 2 * (wave & 3), dt0 = 4 * (wave >> 2);
        bf16x8 Vf[2][2], Kf[4][2];
#pragma unroll
        for (int i = 0; i < 2; ++i)
#pragma unroll
            for (int ks = 0; ks < 2; ++ks) Vf[i][ks] = *(const bf16x8*)(VT + ((et0 + i) * 16 + fr) * 144 + (ks * 32 + 8 * fq) * 2);
#pragma unroll
        for (int j = 0; j < 4; ++j)
#pragma unroll
            for (int ks = 0; ks < 2; ++ks) Kf[j][ks] = *(const bf16x8*)(KT + ((dt0 + j) * 16 + fr) * 144 + (ks * 32 + 8 * fq) * 2);
#pragma unroll
        for (int i = 0; i < 2; ++i)
#pragma unroll
            for (int j = 0; j < 4; ++j) {
                f32x4 acc = {0.f, 0.f, 0.f, 0.f};
                acc = mfma16(Kf[j][0], Vf[i][0], acc); acc = mfma16(Kf[j][1], Vf[i][1], acc);
                u32x2 w; w.x = pk2(acc[0], acc[1]); w.y = pk2(acc[2], acc[3]);
                *(u32x2*)(ct + ((et0 + i) * 16 + fr) * 128 + (dt0 + j) * 16 + 4 * fq) = w;
            }
    }
    if (tid < 128) { float s_ = 0.f;
#pragma unroll
        for (int g = 0; g < 8; ++g) s_ += RED[g * 128 + tid];
        ((float*)(a.ws + WS_DN))[(size_t)item * 128 + tid] = s_; }
    LDS_BARRIER();
}
struct RgoRegs { u32x4 hv[2], pv[2], yv[2]; f32x4 c0, c1, g0, g1; };
__device__ __forceinline__ void rgo_load(const Args& a, int l, int task, RgoRegs& R) {
    const int item = task >> 2, b = item >> 6, c = item & 63, row0 = b * SEQ + c * CH + (task & 3) * 16, tid = otid(), lane = tid & 63, nb = tid >> 6, ch0 = nb * 64 + (lane & 7) * 8, t0 = lane >> 3;
    const bf16_t* z = (const bf16_t*)(a.ws + WS_Z);
    const bf16_t* hlp = (const bf16_t*)a.out; const bf16_t* ppp = hlp + (size_t)M * DR;
#pragma unroll
    for (int j = 0; j < 2; ++j) { const size_t r = (size_t)(row0 + j * 8 + t0);
        R.hv[j] = *(const u32x4*)(hlp + r * DR + ch0); R.pv[j] = *(const u32x4*)(ppp + r * DR + ch0); R.yv[j] = *(const u32x4*)(z + r * ZW + ZYR + ch0); }
    const float* cp = (const float*)(a.ws + WS_SMALL + SM_RGP) + (size_t)item * DR + ch0; R.c0 = *(const f32x4*)cp; R.c1 = *(const f32x4*)(cp + 4);
    const float* gp = a.in[I_GR] + l * DR + ch0; R.g0 = *(const f32x4*)gp; R.g1 = *(const f32x4*)(gp + 4);
}
__device__ __forceinline__ void rgo_compute(const Args& a, int l, int task, const RgoRegs& R) {
    const int item = task >> 2, b = item >> 6, c = item & 63, row0 = b * SEQ + c * CH + (task & 3) * 16, tid = otid(), lane = tid & 63, nb = tid >> 6, ch0 = nb * 64 + (lane & 7) * 8, t0 = lane >> 3;
    bf16_t* mix = (bf16_t*)(a.ws + WS_MIX);
    const f32x4 g0 = R.g0, g1 = R.g1;
#pragma unroll
    for (int j = 0; j < 2; ++j) {
        f32x4 h0, h1, p0, p1, y0, y1; unpack8(R.hv[j], h0, h1); unpack8(R.pv[j], p0, p1); unpack8(R.yv[j], y0, y1);
        f32x4 o0, o1;
#pragma unroll
        for (int q = 0; q < 4; ++q) { o0[q] = (h0[q] + p0[q] * R.c0[q]) * gelu_tanh(y0[q]); o1[q] = (h1[q] + p1[q] * R.c1[q]) * gelu_tanh(y1[q]); }
        const float rs = __builtin_amdgcn_rsqf(sum8(dot8(o0, o1)) * (1.f / 64.f) + EPS);
        *(u32x4*)(mix + (size_t)(row0 + j * 8 + t0) * D + DM + ch0) = pack8(o0 * rs * g0, o1 * rs * g1);
    }
}
struct MoRegs { unsigned xq[11], xk[11], v[8]; u32x4 og[2]; float gi, gb, gg, mprev; };
__device__ __forceinline__ void mo_load(const Args& a, int l, int item, MoRegs& R) {
    const int b = item >> 8, c = (item >> 2) & 63, h = item & 3, row0 = b * SEQ + c * CH, tid = otid(), lane = tid & 63, wave = tid >> 6;
    const bf16_t* z = (const bf16_t*)(a.ws + WS_Z);
    const float* gates = (const float*)(a.ws + WS_SMALL + SM_GATES);
    const int cp = lane, lg = wave, colq = ZQ + h * DH + 2 * cp, colk = ZK + h * DH + 2 * cp, colv = ZV + h * DH + 2 * cp;
    conv_load11(z + colq, row0, 8 * lg, c == 0, R.xq);
    conv_load11(z + colk, row0, 8 * lg, c == 0, R.xk);
#pragma unroll
    for (int i = 0; i < 8; ++i) R.v[i] = *(const unsigned*)(z + (size_t)(row0 + 8 * lg + i) * ZW + colv);
#pragma unroll
    for (int j = 0; j < 2; ++j) { const int pc = tid + j * NT; R.og[j] = *(const u32x4*)(z + (size_t)(row0 + (pc >> 4)) * ZW + ZO + h * DH + (pc & 15) * 8); }
    R.gi = gates[(size_t)(row0 + lane) * 8 + h];
    { const float* scal = (const float*)(a.ws + WS_SCAL) + (size_t)item * 128; R.gb = scal[lane]; R.gg = scal[64 + lane]; }
    R.mprev = ((const float*)(a.ws + WS_SMALL + SM_MPREV))[item];
}
__device__ __forceinline__ void mo_compute(const Args& a, unsigned char* lds, int l, int item, MoRegs& R, ConvW& cwq, ConvW& cwk, int& hw, RgoRegs& rq) {
    const int b = item >> 8, c = (item >> 2) & 63, h = item & 3, row0 = b * SEQ + c * CH, tid = otid(), lane = tid & 63, wave = tid >> 6, fr = lane & 15, fq = lane >> 4;
    unsigned char* QN = lds; unsigned char* KN = lds + 17408; unsigned char* VT = lds + 34816; unsigned char* SP = lds + 53248;
    float* sc = (float*)(lds + 62464);
    float* HM = (float*)lds;
    const int cp = lane, lg = wave;
    unsigned (&xq)[11] = R.xq; unsigned (&xk)[11] = R.xk; unsigned (&v)[8] = R.v;
    bf16x8 Cf[4]; f32x4 dnv[4];
    { const bf16_t* ct = (const bf16_t*)(a.ws + WS_CT) + (size_t)item * 128 * 128; const float* dn = (const float*)(a.ws + WS_DN) + (size_t)item * 128;
#pragma unroll
      for (int ks = 0; ks < 4; ++ks) Cf[ks] = *(const bf16x8*)(ct + (wave * 16 + fr) * 128 + ks * 32 + 8 * fq);
#pragma unroll
      for (int j = 0; j < 4; ++j) dnv[j] = *(const f32x4*)(dn + (tid & 7) * 16 + 4 * j); }
    f32x4 gmv[2][2];
#pragma unroll
    for (int j = 0; j < 2; ++j) { const float* gp = a.in[I_GMH] + (size_t)l * DM + h * DH + ((tid + j * NT) & 15) * 8; gmv[j][0] = *(const f32x4*)gp; gmv[j][1] = *(const f32x4*)(gp + 4); }
    if (hw != h) { const float* wc = a.in[I_WCQK] + (size_t)l * 4 * 1024; const float* bc = a.in[I_BCQK] + (size_t)l * 1024;
        conv_loadw(wc, bc, ZQ + h * DH + 2 * cp, cwq); conv_loadw(wc, bc, ZK + h * DH + 2 * cp, cwk); hw = h; }
    rgo_load(a, l, item, rq);
    if (tid < 64) {
        const float mprev = R.mprev, mrow = R.gb + fmaxf(mprev, R.gg);
        sc[lane] = R.gb; sc[64 + lane] = R.gi; sc[128 + lane] = mrow; sc[192 + lane] = __expf(R.gb + mprev - mrow);
    }
    {
        float qq[8][2];
        conv_apply(xq, cwq, qq);
#pragma unroll
        for (int i = 0; i < 8; ++i) *(unsigned*)(QN + (8 * lg + i) * 272 + cp * 4) = pk2(siluf_(qq[i][0]) * 0.08838834764831845f, siluf_(qq[i][1]) * 0.08838834764831845f);
        conv_apply(xk, cwk, qq);
#pragma unroll
        for (int i = 0; i < 8; ++i) *(unsigned*)(KN + (8 * lg + i) * 272 + cp * 4) = pk2(siluf_(qq[i][0]), siluf_(qq[i][1]));
        u32x4 p0, p1;
#pragma unroll
        for (int i = 0; i < 4; ++i) { p0[i] = (v[2 * i] & 0xffffu) | (v[2 * i + 1] << 16); p1[i] = (v[2 * i] >> 16) | (v[2 * i + 1] & 0xffff0000u); }
        *(u32x4*)(VT + (2 * cp) * 144 + lg * 16) = p0; *(u32x4*)(VT + (2 * cp + 1) * 144 + lg * 16) = p1;
    }
    LDS_BARRIER();
    {
        const int ll = tid >> 3, part = tid & 7; float s_ = 0.f;
#pragma unroll
        for (int j = 0; j < 4; ++j) { const u32x2 qv = *(const u32x2*)(QN + ll * 272 + (part * 16 + 4 * j) * 2);
            s_ += bf2f(qv.x & 0xffffu) * dnv[j].x + __uint_as_float(qv.x & 0xffff0000u) * dnv[j].y + bf2f(qv.y & 0xffffu) * dnv[j].z + __uint_as_float(qv.y & 0xffff0000u) * dnv[j].w; }
        s_ = sum8(s_);
        if (part == 0) sc[384 + ll] = s_;
    }
    {
        const int lt = wave & 3; const int ll = lt * 16 + fr; const float bl_ = sc[ll], mr = sc[128 + ll]; float dsum = 0.f;
#pragma unroll
        for (int mi = 0; mi < 2; ++mi) {
            const int mt = 2 * (wave >> 2) + mi; u32x2 pk = {0u, 0u};
            if (mt <= lt) {
                f32x4 acc = {0.f, 0.f, 0.f, 0.f};
#pragma unroll
                for (int ks = 0; ks < 4; ++ks) { const bf16x8 A = *(const bf16x8*)(KN + (mt * 16 + fr) * 272 + (ks * 32 + 8 * fq) * 2), B = *(const bf16x8*)(QN + (lt * 16 + fr) * 272 + (ks * 32 + 8 * fq) * 2);
                    acc = mfma16(A, B, acc); }
                float sv[4];
#pragma unroll
                for (int r = 0; r < 4; ++r) { const int mm = mt * 16 + 4 * fq + r; const float wgt = (mm <= ll) ? __expf(bl_ - sc[mm] + sc[64 + mm] - mr) : 0.f; sv[r] = acc[r] * wgt; dsum += sv[r]; }
                pk.x = pk2(sv[0], sv[1]); pk.y = pk2(sv[2], sv[3]);
            }
            *(u32x2*)(SP + ll * 144 + (mt * 16 + 4 * fq) * 2) = pk;
        }
        dsum += __shfl_xor(dsum, 16); dsum += __shfl_xor(dsum, 32);
        if (fq == 0) sc[256 + (wave >> 2) * 64 + ll] = dsum;
    }
    LDS_BARRIER();
    if (tid < 64) { const float den = sc[256 + tid] + sc[320 + tid] + sc[192 + tid] * sc[384 + tid]; sc[448 + tid] = fmaxf(fabsf(den), __expf(-sc[128 + tid])); }
    f32x4 acc1[4], acc2[4];
    {
        bf16x8 Vf[2];
#pragma unroll
        for (int ks = 0; ks < 2; ++ks) Vf[ks] = *(const bf16x8*)(VT + (wave * 16 + fr) * 144 + (ks * 32 + 8 * fq) * 2);
#pragma unroll
        for (int lt = 0; lt < 4; ++lt) {
            acc1[lt] = (f32x4){0.f, 0.f, 0.f, 0.f}; acc2[lt] = (f32x4){0.f, 0.f, 0.f, 0.f};
#pragma unroll
            for (int ks = 0; ks < 2; ++ks) acc1[lt] = mfma16(*(const bf16x8*)(SP + (lt * 16 + fr) * 144 + (ks * 32 + 8 * fq) * 2), Vf[ks], acc1[lt]);
#pragma unroll
            for (int ks = 0; ks < 4; ++ks) acc2[lt] = mfma16(*(const bf16x8*)(QN + (lt * 16 + fr) * 272 + (ks * 32 + 8 * fq) * 2), Cf[ks], acc2[lt]);
        }
    }
    LDS_BARRIER();
#pragma unroll
    for (int lt = 0; lt < 4; ++lt)
#pragma unroll
        for (int r = 0; r < 4; ++r) { const int ll = lt * 16 + 4 * fq + r;
            HM[ll * 132 + wave * 16 + fr] = (acc1[lt][r] + sc[192 + ll] * acc2[lt][r]) * frcp(sc[448 + ll]); }
    LDS_BARRIER();
    {
        bf16_t* mix = (bf16_t*)(a.ws + WS_MIX);
#pragma unroll
        for (int j = 0; j < 2; ++j) { const int pc = tid + j * NT, ll = pc >> 4, q16 = pc & 15;
            const f32x4 h0 = *(const f32x4*)(HM + ll * 132 + q16 * 8), h1 = *(const f32x4*)(HM + ll * 132 + q16 * 8 + 4);
            f32x4 o0, o1; unpack8(R.og[j], o0, o1);
            f32x4 g0, g1;
#pragma unroll
            for (int q = 0; q < 4; ++q) { g0[q] = h0[q] * sigmoidf_(o0[q]); g1[q] = h1[q] * sigmoidf_(o1[q]); }
            const float rs = __builtin_amdgcn_rsqf(sum16(dot8(g0, g1)) * (1.f / 128.f) + EPS);
            *(u32x4*)(mix + (size_t)(row0 + ll) * D + h * DH + q16 * 8) = pack8(g0 * rs * gmv[j][0], g1 * rs * gmv[j][1]); }
    }
    LDS_BARRIER();
}

template <int MODE>
__device__ __forceinline__ void rglru_item(const Args& a, unsigned char* lds, int l, int item) {
    const int b = item >> 6, c = item & 63, row0 = b * SEQ + c * CH, ch = otid(), lane = ch & 63, nb = ch >> 6;
    float* xs = (float*)lds + nb * 64 * 64;
    const bf16_t* z = (const bf16_t*)(a.ws + WS_Z);
    const float* wcr = a.in[I_WCR] + (size_t)l * 4 * DR; const float bcr = a.in[I_BCR][l * DR + ch];
    const float w0 = wcr[ch], w1 = wcr[DR + ch], w2 = wcr[2 * DR + ch], w3 = wcr[3 * DR + ch];
    const bf16_t* zc = z + ZXR + ch;
    float xm3 = 0.f, xm2 = 0.f, xm1 = 0.f;
    { const int s0 = c * CH; if (s0 >= 3) { xm3 = bf2f(zc[(size_t)(row0 - 3) * ZW]); xm2 = bf2f(zc[(size_t)(row0 - 2) * ZW]); xm1 = bf2f(zc[(size_t)(row0 - 1) * ZW]); } }
#pragma unroll 4
    for (int t = 0; t < 64; ++t) { const float x0 = bf2f(zc[(size_t)(row0 + t) * ZW]);
        xs[t * 64 + lane] = bcr + w0 * xm3 + w1 * xm2 + w2 * xm1 + w3 * x0; xm3 = xm2; xm2 = xm1; xm1 = x0; }
    unsigned wa[32], wx[32];
    const float* wra = a.in[I_WRA] + ((size_t)(l * NBR + nb) * 64) * 64 + lane; const float* wri = a.in[I_WRI] + ((size_t)(l * NBR + nb) * 64) * 64 + lane;
#pragma unroll
    for (int d = 0; d < 32; ++d) { wa[d] = pk2(wra[(2 * d) * 64], wra[(2 * d + 1) * 64]); wx[d] = pk2(wri[(2 * d) * 64], wri[(2 * d + 1) * 64]); }
    const float ba = a.in[I_BRA][l * DR + ch], bx = a.in[I_BRI][l * DR + ch];
    const float lam = a.in[I_LAM][l * DR + ch];
    const float sp = fmaxf(-lam, 0.f) + log1pf(__expf(-fabsf(lam)));
    float hst = 0.f, ap = 1.f;
    if (MODE == 1) hst = ((const float*)(a.ws + WS_SMALL + SM_RGP))[(size_t)item * DR + ch];
    const float gr = a.in[I_GR][l * DR + ch];
    bf16_t* mix = (bf16_t*)(a.ws + WS_MIX);
    __syncthreads();
#pragma unroll 1
    for (int t = 0; t < 64; ++t) {
        float ra = ba, ia = bx;
#pragma unroll
        for (int d4 = 0; d4 < 16; ++d4) { const f32x4 xv = *(const f32x4*)(xs + t * 64 + 4 * d4);
#pragma unroll
            for (int q = 0; q < 2; ++q) { const unsigned pa = wa[2 * d4 + q], px = wx[2 * d4 + q];
                ra += xv[2 * q] * __uint_as_float(pa << 16) + xv[2 * q + 1] * __uint_as_float(pa & 0xffff0000u);
                ia += xv[2 * q] * __uint_as_float(px << 16) + xv[2 * q + 1] * __uint_as_float(px & 0xffff0000u); } }
        const float xo = xs[t * 64 + lane];
        const float r = sigmoidf_(ra), ig = sigmoidf_(ia), la = -8.f * r * sp, av = __expf(la);
        const float uu = sqrtf(-expm1f(2.f * la)) * (ig * xo);
        hst = av * hst + uu; ap *= av;
        if (MODE == 1) {
            const float y = bf2f(z[(size_t)(row0 + t) * ZW + ZYR + ch]);
            const float o = hst * gelu_tanh(y);
            const float rs = rsqrtf(wave_sum(o * o) * (1.f / 64.f) + EPS);
            mix[(size_t)(row0 + t) * D + DM + ch] = (bf16_t)f2bf(o * rs * gr);
        }
    }
    if (MODE == 0) { ((float*)(a.ws + WS_SMALL + SM_RGA))[(size_t)item * DR + ch] = ap; ((float*)(a.ws + WS_SMALL + SM_RGH))[(size_t)item * DR + ch] = hst; }
    __syncthreads();
}

template <int MODE>
__device__ __forceinline__ void rglru_fast(const Args& a, unsigned char* lds, int l, int item) {
    const int b = item >> 6, c = item & 63, row0 = b * SEQ + c * CH, ch = otid(), lane = ch & 63, nb = ch >> 6, fr = lane & 15, fq = lane >> 4;
    unsigned char* XA = lds + nb * 9216;
    float* GS = (float*)(lds + 73728 + nb * 8448);
    const bf16_t* z = (const bf16_t*)(a.ws + WS_Z);
    unsigned ypk[32];
    {
        const float* wcr = a.in[I_WCR] + (size_t)l * 4 * DR; const float bcr = a.in[I_BCR][l * DR + ch];
        const float w0 = wcr[ch], w1 = wcr[DR + ch], w2 = wcr[2 * DR + ch], w3 = wcr[3 * DR + ch];
        const bf16_t* zc = z + ZXR + ch;
        bf16_t xin[67];
#pragma unroll
        for (int t = 0; t < 67; ++t) xin[t] = (c == 0 && t < 3) ? (bf16_t)0 : zc[(ptrdiff_t)(row0 + t - 3) * ZW];
        if (MODE == 1) {
            bf16_t yb[64];
#pragma unroll
            for (int t = 0; t < 64; ++t) yb[t] = z[(size_t)(row0 + t) * ZW + ZYR + ch];
#pragma unroll
            for (int t = 0; t < 32; ++t) ypk[t] = (unsigned)yb[2 * t] | ((unsigned)yb[2 * t + 1] << 16);
        }
#pragma unroll
        for (int t = 0; t < 64; ++t)
            *(bf16_t*)(XA + t * 144 + lane * 2) = (bf16_t)f2bf(bcr + w0 * bf2f(xin[t]) + w1 * bf2f(xin[t + 1]) + w2 * bf2f(xin[t + 2]) + w3 * bf2f(xin[t + 3]));
    }
    bf16x8 Bf[8][2];
    { const bf16_t* wt = (const bf16_t*)(a.ws + WS_SMALL + SM_RGW) + (size_t)((l * NBR + nb) * 2) * 64 * 64;
#pragma unroll
        for (int ct = 0; ct < 8; ++ct)
#pragma unroll
            for (int ks = 0; ks < 2; ++ks) Bf[ct][ks] = *(const bf16x8*)(wt + (size_t)((ct >> 2) * 64 + (ct & 3) * 16 + fr) * 64 + ks * 32 + 8 * fq); }
    const float ba = a.in[I_BRA][l * DR + ch], bx = a.in[I_BRI][l * DR + ch];
    const float lam = a.in[I_LAM][l * DR + ch];
    const float sp8 = -8.f * (fmaxf(-lam, 0.f) + log1pf(__expf(-fabsf(lam))));
    float hst = 0.f, ap = 1.f;
    if (MODE == 1) hst = ((const float*)(a.ws + WS_SMALL + SM_RGP))[(size_t)item * DR + ch];
    const float gr = a.in[I_GR][l * DR + ch];
    bf16_t* mix = (bf16_t*)(a.ws + WS_MIX);
    WAVE_LDS_SYNC();
#pragma unroll
    for (int rt = 0; rt < 4; ++rt) {
        bf16x8 Af[2];
#pragma unroll
        for (int ks = 0; ks < 2; ++ks) Af[ks] = *(const bf16x8*)(XA + (rt * 16 + fr) * 144 + (ks * 32 + 8 * fq) * 2);
#pragma unroll
        for (int ct = 0; ct < 8; ++ct) {
            f32x4 acc = {0.f, 0.f, 0.f, 0.f};
            acc = mfma16(Af[0], Bf[ct][0], acc); acc = mfma16(Af[1], Bf[ct][1], acc);
#pragma unroll
            for (int r = 0; r < 4; ++r) GS[(4 * fq + r) * 132 + (ct >> 2) * 64 + (ct & 3) * 16 + fr] = acc[r];
        }
        WAVE_LDS_SYNC();
        {
            float ra[16], ia[16], xo[16], ov_[16], apv_[16];
#pragma unroll
            for (int tt = 0; tt < 16; ++tt) { ra[tt] = GS[tt * 132 + lane]; ia[tt] = GS[tt * 132 + 64 + lane]; xo[tt] = bf2f(*(const bf16_t*)(XA + (rt * 16 + tt) * 144 + lane * 2)); }
#pragma unroll
            for (int tt = 0; tt < 16; ++tt) {
                const float r = sigmoidf_(ra[tt] + ba), ig = sigmoidf_(ia[tt] + bx), la = sp8 * r, av = __expf(la);
                const float uu = __builtin_amdgcn_sqrtf(fmaxf(fmaf(-av, av, 1.f), 0.f)) * (ig * xo[tt]);
                hst = av * hst + uu; ap *= av;
                ov_[tt] = hst; apv_[tt] = ap;
            }
            if (MODE == 0) {
                unsigned char* GB = (unsigned char*)GS;
#pragma unroll
                for (int tt = 0; tt < 16; ++tt) { *(bf16_t*)(GB + tt * 128 + lane * 2) = (bf16_t)f2bf(ov_[tt]); *(bf16_t*)(GB + 2048 + tt * 128 + lane * 2) = (bf16_t)f2bf(apv_[tt]); }
                WAVE_LDS_SYNC();
                bf16_t* hlp = (bf16_t*)a.out; bf16_t* ppp = hlp + (size_t)M * DR;
#pragma unroll
                for (int j = 0; j < 2; ++j) { const int p = lane + 64 * j; const size_t off = (size_t)(row0 + rt * 16 + (p >> 3)) * DR + nb * 64 + (p & 7) * 8;
                    *(u32x4*)(hlp + off) = *(const u32x4*)(GB + p * 16); *(u32x4*)(ppp + off) = *(const u32x4*)(GB + 2048 + p * 16); }
            }
            if (MODE == 1) {
#pragma unroll
                for (int tt = 0; tt < 16; ++tt) *(bf16_t*)(XA + (rt * 16 + tt) * 144 + lane * 2) = (bf16_t)f2bf(ov_[tt] * gelu_tanh((tt & 1) ? __uint_as_float(ypk[rt * 8 + (tt >> 1)] & 0xffff0000u) : bf2f(ypk[rt * 8 + (tt >> 1)] & 0xffffu)));
            }
        }
        WAVE_LDS_SYNC();
    }
    if (MODE == 1) {
        float ss = 0.f;
#pragma unroll
        for (int j = 0; j < 8; ++j) { const u32x4 v = *(const u32x4*)(XA + lane * 144 + j * 16);
#pragma unroll
            for (int q = 0; q < 4; ++q) { const float lo = bf2f(v[q] & 0xffffu), hi = __uint_as_float(v[q] & 0xffff0000u); ss += lo * lo + hi * hi; } }
        const float rs = rsqrtf(ss * (1.f / 64.f) + EPS) ;
#pragma unroll
        for (int t0 = 0; t0 < 64; t0 += 16) { float ovv[16];
#pragma unroll
            for (int tt = 0; tt < 16; ++tt) ovv[tt] = bf2f(*(const bf16_t*)(XA + (t0 + tt) * 144 + lane * 2));
#pragma unroll
            for (int tt = 0; tt < 16; ++tt) { const float rst = __int_as_float(__builtin_amdgcn_readlane(__float_as_int(rs), t0 + tt));
                *(bf16_t*)(XA + (t0 + tt) * 144 + lane * 2) = (bf16_t)f2bf(ovv[tt] * rst * gr); } }
        WAVE_LDS_SYNC();
#pragma unroll
        for (int j = 0; j < 8; ++j) { const int t = j * 8 + (lane >> 3), q16 = lane & 7;
            *(u32x4*)(mix + (size_t)(row0 + t) * D + DM + nb * 64 + q16 * 8) = *(const u32x4*)(XA + t * 144 + q16 * 16); }
    }
    if (MODE == 0) { ((float*)(a.ws + WS_SMALL + SM_RGA))[(size_t)item * DR + ch] = ap; ((float*)(a.ws + WS_SMALL + SM_RGH))[(size_t)item * DR + ch] = hst; }
    LDS_BARRIER();
}
__device__ __forceinline__ void rglru_out(const Args& a, int l, int item) {
    const int b = item >> 6, c = item & 63, row0 = b * SEQ + c * CH, tid = otid(), lane = tid & 63, nb = tid >> 6, ch0 = nb * 64 + (lane & 7) * 8, t0 = lane >> 3;
    const bf16_t* z = (const bf16_t*)(a.ws + WS_Z);
    const bf16_t* hlp = (const bf16_t*)a.out; const bf16_t* ppp = hlp + (size_t)M * DR;
    bf16_t* mix = (bf16_t*)(a.ws + WS_MIX);
    u32x4 hv[8], pv[8], yv[8];
#pragma unroll
    for (int j = 0; j < 8; ++j) { const size_t r = (size_t)(row0 + j * 8 + t0);
        hv[j] = *(const u32x4*)(hlp + r * DR + ch0); pv[j] = *(const u32x4*)(ppp + r * DR + ch0); yv[j] = *(const u32x4*)(z + r * ZW + ZYR + ch0); }
    const float* cp = (const float*)(a.ws + WS_SMALL + SM_RGP) + (size_t)item * DR + ch0; const f32x4 c0 = *(const f32x4*)cp, c1 = *(const f32x4*)(cp + 4);
    const float* gp = a.in[I_GR] + l * DR + ch0; const f32x4 g0 = *(const f32x4*)gp, g1 = *(const f32x4*)(gp + 4);
#pragma unroll
    for (int j = 0; j < 8; ++j) {
        f32x4 h0, h1, p0, p1, y0, y1; unpack8(hv[j], h0, h1); unpack8(pv[j], p0, p1); unpack8(yv[j], y0, y1);
        f32x4 o0, o1;
#pragma unroll
        for (int q = 0; q < 4; ++q) { o0[q] = (h0[q] + p0[q] * c0[q]) * gelu_tanh(y0[q]); o1[q] = (h1[q] + p1[q] * c1[q]) * gelu_tanh(y1[q]); }
        const float rs = __builtin_amdgcn_rsqf(sum8(dot8(o0, o1)) * (1.f / 64.f) + EPS);
        *(u32x4*)(mix + (size_t)(row0 + j * 8 + t0) * D + DM + ch0) = pack8(o0 * rs * g0, o1 * rs * g1);
    }
}
__device__ __forceinline__ void rglru_scan(const Args& a, int G) {
    const int tid = otid(), lane = tid & 63, wave = tid >> 6;
    for (int i = blockIdx.x * 8 + wave; i < NBATCH * DR; i += G * 8) {
        const int b = i / DR, ch = i % DR; const size_t o = (size_t)(b * NC + lane) * DR + ch;
        float A = ((const float*)(a.ws + WS_SMALL + SM_RGA))[o], H = ((const float*)(a.ws + WS_SMALL + SM_RGH))[o];
#pragma unroll
        for (int d = 1; d < 64; d <<= 1) { const float Ap = __shfl_up(A, d), Hp = __shfl_up(H, d); if (lane >= d) { H = A * Hp + H; A = A * Ap; } }
        const float pin = __shfl_up(H, 1);
        ((float*)(a.ws + WS_SMALL + SM_RGP))[o] = lane == 0 ? 0.f : pin;
    }
}

__device__ __forceinline__ void phase_route(const Args& a, unsigned char* lds) {
    unsigned* wtot = (unsigned*)lds;
    int* pre = (int*)(lds + 256);
    int* tot = pre + 8;
    int* ce = tot + 16;
    unsigned* pref = (unsigned*)(lds + 2048);
    const int tid = otid(), lane = tid & 63, wave = tid >> 6, G = gridDim.x;
    const unsigned char* tok_p = (const unsigned char*)(a.ws + WS_SMALL + SM_TOKP); const float* tok_g = (const float*)(a.ws + WS_SMALL + SM_TOKG);
    int* row_tok = (int*)(a.ws + WS_SMALL + SM_ROWTOK); float* row_gate = (float*)(a.ws + WS_SMALL + SM_ROWGATE); int* tile_e = (int*)(a.ws + WS_SMALL + SM_TILEE);
    if (tid < 256) {
        unsigned long long hh = 0ull;
#pragma unroll
        for (int j = 0; j < 4; ++j) { const u32x4 v = ((const u32x4*)(tok_p + tid * 64))[j];
#pragma unroll
            for (int q = 0; q < 4; ++q)
#pragma unroll
                for (int bb = 0; bb < 4; ++bb) { const unsigned by = (v[q] >> (8 * bb)) & 0xffu; hh += (1ull << (8 * (by & 15u))) + (1ull << (8 * (by >> 4))); } }
        unsigned w[4];
#pragma unroll
        for (int i = 0; i < 4; ++i) { const unsigned two = (unsigned)(hh >> (16 * i)) & 0xffffu; w[i] = (two & 0xffu) | ((two >> 8) << 16); }
        unsigned inc[4];
#pragma unroll
        for (int i = 0; i < 4; ++i) { unsigned x = w[i];
#pragma unroll
            for (int o = 1; o < 64; o <<= 1) { const unsigned n = __shfl_up(x, o); if (lane >= o) x += n; }
            inc[i] = x; }
        if (lane == 63) {
#pragma unroll
            for (int i = 0; i < 4; ++i) wtot[wave * 4 + i] = inc[i]; }
        __builtin_amdgcn_s_waitcnt(0);
        __builtin_amdgcn_s_barrier();
#pragma unroll
        for (int i = 0; i < 4; ++i) { unsigned base = 0u;
            for (int ww = 0; ww < wave; ++ww) base += wtot[ww * 4 + i];
            pref[tid * 4 + i] = base + inc[i] - w[i];
            if (tid == 255) { const unsigned t2 = base + inc[i]; tot[2 * i] = (int)(t2 & 0xffffu); tot[2 * i + 1] = (int)(t2 >> 16); } }
    } else {
        __builtin_amdgcn_s_barrier();
    }
    __syncthreads();
    if (tid == 0) { int s_ = 0; for (int e = 0; e < 8; ++e) { tot[8 + e] = s_; s_ += (tot[e] + 255) & ~255; }
        if (blockIdx.x == 0) { int t = 0; for (int e = 0; e < 8; ++e) { const int n = (tot[e] + 255) >> 8; for (int j = 0; j < n; ++j) tile_e[t++] = e; tile_e[256 + e] = t; } tile_e[255] = t; } }
    __syncthreads();
    for (int ck = blockIdx.x; ck < 256; ck += G) {
        if (tid < 128) { const unsigned by = tok_p[ck * 64 + (tid >> 1)]; ce[tid] = (tid & 1) ? (int)(by >> 4) : (int)(by & 15u); }
        __syncthreads();
        if (tid < 128) { const int e = ce[tid];
            int rank = 0, w0cnt = 0;
#pragma unroll
            for (int q = 0; q < 8; ++q) { const unsigned long long mk = __ballot(e == q); if (e == q) rank = __popcll(mk & ((1ull << lane) - 1ull)); if (wave == 0 && lane == 0) ce[128 + q] = __popcll(mk); }
            __builtin_amdgcn_s_waitcnt(0);
            asm volatile("s_barrier" ::: "memory");
            if (wave == 1) rank += ce[128 + e];
            (void)w0cnt;
            const unsigned pw = pref[ck * 4 + (e >> 1)]; const int pr = (int)((e & 1) ? (pw >> 16) : (pw & 0xffffu));
            const int dest = tot[8 + e] + pr + rank;
            row_tok[dest] = ck * 64 + (tid >> 1); row_gate[dest] = tok_g[ck * 128 + tid]; ((int*)(a.ws + WS_SMALL + SM_ROWSLOT))[dest] = tid & 1; }
        else { asm volatile("s_barrier" ::: "memory"); }
        __syncthreads();
    }
}

#ifndef GEMM
#define GEMM gemm_fast
#endif
__global__ void __launch_bounds__(NT, 2) mk_fwd(Args a0) {
    extern __shared__ __attribute__((aligned(16))) unsigned char lds[];
    const int G = gridDim.x, bid = blockIdx.x, ph_lo = a0.ph_lo, ph_hi = a0.ph_hi;
    volatile LAS unsigned* xst = (volatile LAS unsigned*)(lds + LDS_BYTES - 64);
    if (threadIdx.x < 2) xst[threadIdx.x] = 0u;
    __syncthreads();
    const XcdBarrier xb = xcd_barrier_post((unsigned*)(a0.ws + WS_SMALL + SM_BAR), xst);
    int ph = 0;
#ifndef PROBE_CAT
#define PROBE_CAT 0
#define PROBE_N 1
#endif
#define PHASE_BEGIN(cat) if (ph >= ph_lo && ph < ph_hi) { for (int rep_ = 0; rep_ < ((cat) == PROBE_CAT ? PROBE_N : 1); ++rep_) { const bool lastrep = (rep_ + 1 == ((cat) == PROBE_CAT ? PROBE_N : 1)); (void)lastrep; const Args& a = *(const Args*)okarg(); unsigned char* const ws = a.ws; \
    bf16_t* const hn = (bf16_t*)(ws + WS_HN); bf16_t* const z = (bf16_t*)(ws + WS_Z); bf16_t* const mix = (bf16_t*)(ws + WS_MIX); bf16_t* const hid = (bf16_t*)(ws + WS_HID); \
    float* const gates = (float*)(ws + WS_SMALL + SM_GATES); int* const tok_e = (int*)(ws + WS_SMALL + SM_TOKP); float* const tok_g = (float*)(ws + WS_SMALL + SM_TOKG); \
    const int* const row_tok = (const int*)(ws + WS_SMALL + SM_ROWTOK); const float* const row_gate = (const float*)(ws + WS_SMALL + SM_ROWGATE); const int* const tile_e = (const int*)(ws + WS_SMALL + SM_TILEE); \
    (void)hn; (void)z; (void)mix; (void)hid; (void)gates; (void)tok_e; (void)tok_g; (void)row_tok; (void)row_gate; (void)tile_e;
#define PHASE_END(dosync) } for (int rep_ = 0; rep_ < (PROBE_CAT == 6 ? PROBE_N : 1); ++rep_) if ((dosync) && ph + 1 < ph_hi) { xcd_barrier(xb); } } ++ph;

    PHASE_BEGIN(1) phase_prologue(a, lds); __syncthreads();
        phase_rowpass_mm<0, 1>(lds, a.in[I_X], hn, a.in[I_GMIX], (float*)(ws + WS_SSQ), a.in[I_WIN] + 2048, DIN, a.in[I_BIN] + 2048, gates, nullptr, nullptr, nullptr); PHASE_END(true)
    { constexpr int l = 0;
#define LAYER_PTRS bf16_t* const hb = (bf16_t*)(ws + (l ? WS_H1 : WS_HN)); bf16_t* const hbo = (bf16_t*)(ws + (l ? WS_HN : WS_H1)); float* const ssq = (float*)(ws + WS_SSQ + l * SSQ_STRIDE); float* const ssqo = (float*)(ws + WS_SSQ + (1 - l) * SSQ_STRIDE); (void)hb; (void)hbo; (void)ssq; (void)ssqo;
        PHASE_BEGIN(3) LAYER_PTRS { if (l == 1) phase_rowpass_mm<1, 1>(lds, nullptr, hb, a.in[I_GMIX] + l * D, nullptr, a.in[I_WIN] + (size_t)l * D * DIN + 2048, DIN, a.in[I_BIN] + l * DIN + 2048, gates, nullptr, nullptr, nullptr);
            GridOrder S{M / 256, ZW / 256, G, bid}; EpiZ E{z, a.in[I_BIN] + l * DIN, ssq};
            GEMM(lds, hb, (const bf16_t*)(ws + (l ? WS_W_IN1 : WS_W_IN0)), D, S, E); } PHASE_END(true)
        PHASE_BEGIN(4) LAYER_PTRS { MlRegs cur, nxt; int it = bid; if (it < 1024) ml_load(a, l, it, cur); nxt = cur;
            const bool rgfirst = ((bid >> 3) & 1) != 0; bool rgdone = false;
            for (int k = 0; ; ++k) { const bool more = it < 1024;
                if (!rgdone && ((rgfirst && k == 0) || !more)) { for (int i2 = bid; i2 < 256; i2 += G) rglru_fast<0>(a, lds, l, i2); rgdone = true; }
                if (!more) break;
                if (it + G < 1024) ml_load(a, l, it + G, nxt); ml_compute(a, lds, l, it, cur); cur = nxt; it += G; } } PHASE_END(true)
        PHASE_BEGIN(0) LAYER_PTRS mlstm_scan(a, G); rglru_scan(a, G); PHASE_END(true)
        PHASE_BEGIN(5) LAYER_PTRS { MoRegs cur, nxt; RgoRegs rq; ConvW cwq, cwk; int hw = -1; int it = bid; if (it < 1024) mo_load(a, l, it, cur); nxt = cur;
            for (; it < 1024; it += G) { if (it + G < 1024) mo_load(a, l, it + G, nxt); mo_compute(a, lds, l, it, cur, cwq, cwk, hw, rq); rgo_compute(a, l, it, rq); cur = nxt; } } PHASE_END(true)
        PHASE_BEGIN(0) LAYER_PTRS { GridOrder S{M / 256, D / 256, G, bid}; EpiHres<l == 0> E{l == 0 ? a.in[I_X] : nullptr, hb, ssq};
            GEMM(lds, mix, (const bf16_t*)(ws + (l ? WS_W_OUT1 : WS_W_OUT0)), D, S, E); } PHASE_END(true)
        if (l == 0) {
            PHASE_BEGIN(3) LAYER_PTRS { GridOrder S{M / 256, 2 * DFF / 256, G, bid}; EpiSwiglu E{hid, ssq, nullptr};
                GEMM(lds, hb, (const bf16_t*)(ws + WS_W_FFGU), D, S, E);
                { constexpr int nun = (M / 256) * (2 * DFF / 256); const int first = nun % G;
                  TailOrder S2{M / 256, D / 256, G, bid, first}; EpiStoreBf16 E2{(bf16_t*)(ws + WS_PP0)};
                  GEMM(lds, (const bf16_t*)(ws + WS_PB0), (const bf16_t*)(ws + WS_W_PP0), DPLE, S2, E2); } } PHASE_END(true)
            PHASE_BEGIN(0) LAYER_PTRS { GridOrder S{M / 256, D / 256, G, bid}; EpiHres<false> E{nullptr, hb, ssq};
                GEMM(lds, hid, (const bf16_t*)(ws + WS_W_FFD), DFF, S, E); } PHASE_END(true)
        } else {
            PHASE_BEGIN(2) LAYER_PTRS phase_rowpass_mm<1, 2>(lds, nullptr, hb, a.in[I_GFFN] + l * D, nullptr, a.in[I_WROUTER], 8, nullptr, nullptr, (unsigned char*)tok_e, tok_g, ws + WS_HN8); PHASE_END(true)
            PHASE_BEGIN(12) LAYER_PTRS phase_route(a, lds); PHASE_END(true)
            PHASE_BEGIN(3) LAYER_PTRS { MoeOrder<true> S{tile_e[255], 2 * DFF / 256, G, bid, row_tok, (size_t)5632 * D}; S.init(tile_e); EpiSwiglu8 E{ws + WS_HID, 1.f / 32.f};
                gemm_fast<true>(lds, (const bf16_t*)(ws + WS_HN8), (const bf16_t*)(ws + WS_W_EGU), D, S, E); } PHASE_END(true)
            PHASE_BEGIN(0) LAYER_PTRS { MoeOrder<false> S{tile_e[255], D / 256, G, bid, nullptr, (size_t)D * DFF}; S.init(tile_e); EpiMoeDown E{hb, (bf16_t*)a.out, row_tok, (const int*)(ws + WS_SMALL + SM_ROWSLOT), row_gate, 1.f / 32.f};
                gemm_fast<true>(lds, (const bf16_t*)(ws + WS_HID), (const bf16_t*)(ws + WS_W_ED), DFF, S, E);
                { const int nun = tile_e[255] * (D / 256); const int first = nun > 2 * G ? nun - 2 * G : 0;
                  TailOrder S2{M / 256, D / 256, G, bid, first < G ? first : 0}; EpiStoreBf16 E2{(bf16_t*)a.out + (size_t)M * D};
                  GEMM(lds, (const bf16_t*)(ws + WS_PB1), (const bf16_t*)(ws + WS_W_PP1), DPLE, S2, E2); } } PHASE_END(true)
            PHASE_BEGIN(0) LAYER_PTRS phase_rowpass<1, 0, 1, true>(lds, nullptr, hb, (const bf16_t*)a.out, nullptr, ssq, nullptr, 0, nullptr, nullptr, nullptr, nullptr, nullptr); PHASE_END(true)
        }
        PHASE_BEGIN(10) LAYER_PTRS { GridOrder S{M / 256, D / 256, G, bid};
            EpiPle E{hb, hbo, l == 0 ? (const bf16_t*)(ws + WS_PP0) : (const bf16_t*)a.out + (size_t)M * D, ssqo, ssq}; GEMM(lds, hb, (const bf16_t*)(ws + WS_W_PG) + (size_t)l * D * D, D, S, E);
            if (l == 0 && bid == 0) { for (int i = otid(); i < D / 2; i += NT) ((unsigned*)(ws + WS_H1 + (size_t)M * D * 2))[i] = 0u; } } PHASE_END(true)
    }
    { constexpr int l = 1;
        PHASE_BEGIN(3) LAYER_PTRS { if (l == 1) phase_rowpass_mm<1, 1>(lds, nullptr, hb, a.in[I_GMIX] + l * D, nullptr, a.in[I_WIN] + (size_t)l * D * DIN + 2048, DIN, a.in[I_BIN] + l * DIN + 2048, gates, nullptr, nullptr, nullptr);
            GridOrder S{M / 256, ZW / 256, G, bid}; EpiZ E{z, a.in[I_BIN] + l * DIN, ssq};
            GEMM(lds, hb, (const bf16_t*)(ws + (l ? WS_W_IN1 : WS_W_IN0)), D, S, E); } PHASE_END(true)
        PHASE_BEGIN(4) LAYER_PTRS { MlRegs cur, nxt; int it = bid; if (it < 1024) ml_load(a, l, it, cur); nxt = cur;
            const bool rgfirst = ((bid >> 3) & 1) != 0; bool rgdone = false;
            for (int k = 0; ; ++k) { const bool more = it < 1024;
                if (!rgdone && ((rgfirst && k == 0) || !more)) { for (int i2 = bid; i2 < 256; i2 += G) rglru_fast<0>(a, lds, l, i2); rgdone = true; }
                if (!more) break;
                if (it + G < 1024) ml_load(a, l, it + G, nxt); ml_compute(a, lds, l, it, cur); cur = nxt; it += G; } } PHASE_END(true)
        PHASE_BEGIN(0) LAYER_PTRS mlstm_scan(a, G); rglru_scan(a, G); PHASE_END(true)
        PHASE_BEGIN(5) LAYER_PTRS { MoRegs cur, nxt; RgoRegs rq; ConvW cwq, cwk; int hw = -1; int it = bid; if (it < 1024) mo_load(a, l, it, cur); nxt = cur;
            for (; it < 1024; it += G) { if (it + G < 1024) mo_load(a, l, it + G, nxt); mo_compute(a, lds, l, it, cur, cwq, cwk, hw, rq); rgo_compute(a, l, it, rq); cur = nxt; } } PHASE_END(true)
        PHASE_BEGIN(0) LAYER_PTRS { GridOrder S{M / 256, D / 256, G, bid}; EpiHres<l == 0> E{l == 0 ? a.in[I_X] : nullptr, hb, ssq};
            GEMM(lds, mix, (const bf16_t*)(ws + (l ? WS_W_OUT1 : WS_W_OUT0)), D, S, E); } PHASE_END(true)
        if (l == 0) {
            PHASE_BEGIN(3) LAYER_PTRS { GridOrder S{M / 256, 2 * DFF / 256, G, bid}; EpiSwiglu E{hid, ssq, nullptr};
                GEMM(lds, hb, (const bf16_t*)(ws + WS_W_FFGU), D, S, E);
                { constexpr int nun = (M / 256) * (2 * DFF / 256); const int first = nun % G;
                  TailOrder S2{M / 256, D / 256, G, bid, first}; EpiStoreBf16 E2{(bf16_t*)(ws + WS_PP0)};
                  GEMM(lds, (const bf16_t*)(ws + WS_PB0), (const bf16_t*)(ws + WS_W_PP0), DPLE, S2, E2); } } PHASE_END(true)
            PHASE_BEGIN(0) LAYER_PTRS { GridOrder S{M / 256, D / 256, G, bid}; EpiHres<false> E{nullptr, hb, ssq};
                GEMM(lds, hid, (const bf16_t*)(ws + WS_W_FFD), DFF, S, E); } PHASE_END(true)
        } else {
            PHASE_BEGIN(2) LAYER_PTRS phase_rowpass_mm<1, 2>(lds, nullptr, hb, a.in[I_GFFN] + l * D, nullptr, a.in[I_WROUTER], 8, nullptr, nullptr, (unsigned char*)tok_e, tok_g, ws + WS_HN8); PHASE_END(true)
            PHASE_BEGIN(12) LAYER_PTRS phase_route(a, lds); PHASE_END(true)
            PHASE_BEGIN(3) LAYER_PTRS { MoeOrder<true> S{tile_e[255], 2 * DFF / 256, G, bid, row_tok, (size_t)5632 * D}; S.init(tile_e); EpiSwiglu8 E{ws + WS_HID, 1.f / 32.f};
                gemm_fast<true>(lds, (const bf16_t*)(ws + WS_HN8), (const bf16_t*)(ws + WS_W_EGU), D, S, E); } PHASE_END(true)
            PHASE_BEGIN(0) LAYER_PTRS { MoeOrder<false> S{tile_e[255], D / 256, G, bid, nullptr, (size_t)D * DFF}; S.init(tile_e); EpiMoeDown E{hb, (bf16_t*)a.out, row_tok, (const int*)(ws + WS_SMALL + SM_ROWSLOT), row_gate, 1.f / 32.f};
                gemm_fast<true>(lds, (const bf16_t*)(ws + WS_HID), (const bf16_t*)(ws + WS_W_ED), DFF, S, E);
                { const int nun = tile_e[255] * (D / 256); const int first = nun > 2 * G ? nun - 2 * G : 0;
                  TailOrder S2{M / 256, D / 256, G, bid, first < G ? first : 0}; EpiStoreBf16 E2{(bf16_t*)a.out + (size_t)M * D};
                  GEMM(lds, (const bf16_t*)(ws + WS_PB1), (const bf16_t*)(ws + WS_W_PP1), DPLE, S2, E2); } } PHASE_END(true)
            PHASE_BEGIN(0) LAYER_PTRS phase_rowpass<1, 0, 1, true>(lds, nullptr, hb, (const bf16_t*)a.out, nullptr, ssq, nullptr, 0, nullptr, nullptr, nullptr, nullptr, nullptr); PHASE_END(true)
        }
        PHASE_BEGIN(10) LAYER_PTRS { GridOrder S{M / 256, D / 256, G, bid};
            EpiPle E{hb, hbo, l == 0 ? (const bf16_t*)(ws + WS_PP0) : (const bf16_t*)a.out + (size_t)M * D, ssqo, ssq}; GEMM(lds, hb, (const bf16_t*)(ws + WS_W_PG) + (size_t)l * D * D, D, S, E);
            if (l == 0 && bid == 0) { for (int i = otid(); i < D / 2; i += NT) ((unsigned*)(ws + WS_H1 + (size_t)M * D * 2))[i] = 0u; } } PHASE_END(true)
    }
    PHASE_BEGIN(0) phase_rowpass<1, 0, 2, false>(lds, nullptr, hn, nullptr, a.in[I_GFINAL], nullptr, nullptr, 0, nullptr, nullptr, nullptr, nullptr, a.out); PHASE_END(false)
}

extern "C" void kernel_launch(void* const* d_in, const int* in_sizes, int n_in, void* d_out, int out_size,
                              void* d_ws, size_t ws_size, hipStream_t stream) {
    static int grid = 0;
    if (grid == 0) {
        if (n_in != 29 || out_size != M * D || ws_size < WS_END) { fprintf(stderr, "kernel_launch: unexpected problem (n_in %d out %d ws %zu)\n", n_in, out_size, ws_size); grid = -1; return; }
        int dev = 0, cus = 0, per_cu = 0;
        (void)hipGetDevice(&dev);
        (void)hipDeviceGetAttribute(&cus, hipDeviceAttributeMultiprocessorCount, dev);
        (void)hipFuncSetAttribute((const void*)mk_fwd, hipFuncAttributeMaxDynamicSharedMemorySize, LDS_BYTES);
        (void)hipOccupancyMaxActiveBlocksPerMultiprocessor(&per_cu, (const void*)mk_fwd, NT, LDS_BYTES);
        if (per_cu < 1) { fprintf(stderr, "kernel_launch: occupancy query says %d blocks per CU\n", per_cu); per_cu = 1; }
        grid = cus;
    }
    if (grid < 0) return;
    Args a{};
    for (int i = 0; i < 29; ++i) a.in[i] = (const float*)d_in[i];
    a.out = (float*)d_out; a.ws = (unsigned char*)d_ws; a.ph_lo = 0; a.ph_hi = 1000;
    (void)hipMemsetAsync((unsigned char*)d_ws + WS_SMALL + SM_BAR, 0, 16 * 1024, stream);
    void* args[] = {&a};
    hipError_t e = hipLaunchCooperativeKernel((void*)mk_fwd, dim3(grid), dim3(NT), args, LDS_BYTES, stream);
    if (e != hipSuccess) fprintf(stderr, "cooperative launch failed: %s (grid %d)\n", hipGetErrorString(e), grid);
}
```
